# Optimizing an MI355X kernel written in HIP

```python
import math
import jax, jax.numpy as jnp
from jax import lax
import numpy as np

D_MODEL = 1024
BATCH = 8
SEQ = 4096
DEPTH = 2

MIX_WIDTH = D_MODEL
GM_WIDTH = MIX_WIDTH // 2
RW_WIDTH = MIX_WIDTH - GM_WIDTH
HEAD_DIM = 64
GM_HEADS = GM_WIDTH // HEAD_DIM
RW_HEADS = RW_WIDTH // HEAD_DIM
CHUNK = 128
DECAY_RANK = 64
AAA_RANK = 64
GATE_RANK = 128
RW_SHIFT_WIDTH = 3 * RW_WIDTH + DECAY_RANK + AAA_RANK + GATE_RANK
IN_WIDTH = 2 * GM_WIDTH + RW_SHIFT_WIDTH
D_FF = 2816
N_EXPERTS = 8
TOP_K = 2
D_FF_EXPERT = 3584
MOE_BLOCK = 128
N_DENSE = (DEPTH + 1) // 2
N_MOE = DEPTH // 2
RMS_EPS = 1e-6
LN_EPS = 1e-5
GN_EPS = 64e-5

kernel_name = "hybrid_gmlp_rwkv7_moe_trunk"


def rmsnorm(x, g):
    xf = x.astype(jnp.float32)
    y = xf * lax.rsqrt(jnp.mean(xf * xf, axis=-1, keepdims=True) + RMS_EPS)
    return (y * g.astype(jnp.float32)).astype(x.dtype)


def head_layernorm(x, w, b, eps):
    h, n = x.shape[-2], x.shape[-1]
    xf = x.astype(jnp.float32)
    mu = jnp.mean(xf, axis=-1, keepdims=True)
    xc = xf - mu
    var = jnp.mean(xc * xc, axis=-1, keepdims=True)
    y = xc * lax.rsqrt(var + eps)
    y = y * w.astype(jnp.float32).reshape(h, n) + b.astype(jnp.float32).reshape(h, n)
    return y.astype(x.dtype)


def token_shift_mix(p, mu):
    prev = jnp.pad(p, ((0, 0), (1, 0), (0, 0)))[:, :-1]
    return p + (prev - p) * mu


def gmlp_group(pu, pv, ln_w, ln_b, ws, bs):
    b, t, _ = pu.shape
    u = jax.nn.gelu(pu, approximate=False)
    v = jax.nn.gelu(pv, approximate=False)
    v = v.reshape(b, t // CHUNK, CHUNK, GM_HEADS, HEAD_DIM)
    v = head_layernorm(v, ln_w, ln_b, LN_EPS)
    causal = jnp.tril(jnp.ones((CHUNK, CHUNK), dtype=bool))
    w_masked = jnp.where(causal[None], ws, jnp.zeros((), ws.dtype))
    mixed = jnp.einsum('hts,bcshn->bcthn', w_masked, v)
    mixed = mixed + bs.T[None, None, :, :, None]
    return u * mixed.reshape(b, t, GM_WIDTH)


def wkv7_scan(r, w, k, v, a, bb):
    b, t, h, n = r.shape
    xs = tuple(jnp.moveaxis(z, 1, 0) for z in (r, w, k, v, a, bb))

    def step(S, inp):
        r_t, w_t, k_t, v_t, a_t, b_t = inp
        sa = jnp.einsum('bhvk,bhk->bhv', S, a_t)
        S = S * w_t[:, :, None, :] + sa[..., None] * b_t[:, :, None, :] + v_t[..., None] * k_t[:, :, None, :]
        y_t = jnp.einsum('bhvk,bhk->bhv', S, r_t)
        return S, y_t

    S0 = jnp.zeros((b, h, n, n), jnp.float32)
    _, ys = lax.scan(step, S0, xs)
    return jnp.moveaxis(ys, 0, 1)


def rwkv7_group(p, mu, w_up, w0, a_up, a0, g_up, k_k, k_a, r_k, lnx_w, lnx_b):
    b, t, _ = p.shape
    dt = p.dtype
    p = token_shift_mix(p, mu)
    i1, i2, i3 = RW_WIDTH, 2 * RW_WIDTH, 3 * RW_WIDTH
    i4, i5 = i3 + DECAY_RANK, i3 + DECAY_RANK + AAA_RANK
    r, k, v = p[..., :i1], p[..., i1:i2], p[..., i2:i3]
    wd, ad, gd = p[..., i3:i4], p[..., i4:i5], p[..., i5:]
    log_w = -jax.nn.softplus(-(w0 + jnp.tanh(wd) @ w_up)) - 0.5
    decay = jnp.exp(-jnp.exp(log_w.astype(jnp.float32)))
    a = jax.nn.sigmoid(a0 + ad @ a_up)
    g = jax.nn.sigmoid(gd) @ g_up
    heads = lambda z: z.reshape(b, t, RW_HEADS, HEAD_DIM).astype(jnp.float32)
    kk = heads(k * k_k)
    kk = kk / jnp.maximum(jnp.sqrt(jnp.sum(kk * kk, axis=-1, keepdims=True)), 1e-12)
    k = k * (1.0 + (a - 1.0) * k_a)
    rh, kh, vh, ah, wh = heads(r), heads(k), heads(v), heads(a), decay.reshape(b, t, RW_HEADS, HEAD_DIM)
    y = wkv7_scan(rh, wh, kh, vh, -kk, kk * ah)
    y = head_layernorm(y, lnx_w, lnx_b, GN_EPS)
    bonus = jnp.sum(rh * kh * r_k.astype(jnp.float32), axis=-1, keepdims=True) * vh
    y = (y + bonus).reshape(b, t, RW_WIDTH).astype(dt)
    return y * g


def hybrid_mixer(h, w_in, w_out, shift_mu, gm_ln_w, gm_ln_b, gm_ws, gm_bs,
                 rw_w_up, rw_w0, rw_a_up, rw_a0, rw_g_up, rw_k_k, rw_k_a, rw_r_k, rw_lnx_w, rw_lnx_b):
    p = h @ w_in
    y_gm = gmlp_group(p[..., :GM_WIDTH], p[..., GM_WIDTH:2 * GM_WIDTH], gm_ln_w, gm_ln_b, gm_ws, gm_bs)
    y_rw = rwkv7_group(p[..., 2 * GM_WIDTH:], shift_mu, rw_w_up, rw_w0, rw_a_up, rw_a0, rw_g_up,
                       rw_k_k, rw_k_a, rw_r_k, rw_lnx_w, rw_lnx_b)
    y = jnp.concatenate([y_gm, y_rw], axis=-1)
    return y @ w_out


def swiglu(h, wg, wu, wd):
    return (jax.nn.silu(h @ wg) * (h @ wu)) @ wd


def moe_swiglu(xf, router, wg, wu, wd):
    n, d = xf.shape
    logits = (xf @ router).astype(jnp.float32)
    top_val, top_idx = lax.top_k(logits, TOP_K)
    gate = jax.nn.softmax(top_val, axis=-1)
    n_assign = n * TOP_K
    n_rows = ((n_assign + MOE_BLOCK - 1) // MOE_BLOCK + N_EXPERTS) * MOE_BLOCK
    flat_e = top_idx.reshape(-1).astype(jnp.int32)
    flat_tok = jnp.repeat(jnp.arange(n, dtype=jnp.int32), TOP_K)
    flat_gate = gate.reshape(-1)
    order = jnp.argsort(flat_e, stable=True)
    e_sorted = flat_e[order]
    counts = jnp.bincount(flat_e, length=N_EXPERTS)
    padded = (counts + MOE_BLOCK - 1) // MOE_BLOCK * MOE_BLOCK
    pad_end = jnp.cumsum(padded)
    pad_start = pad_end - padded
    grp_start = jnp.cumsum(counts) - counts
    rank = jnp.arange(n_assign, dtype=jnp.int32) - grp_start[e_sorted]
    dest = pad_start[e_sorted] + rank
    row_tok = jnp.full((n_rows,), n, jnp.int32).at[dest].set(flat_tok[order])
    row_gate = jnp.zeros((n_rows,), xf.dtype).at[dest].set(flat_gate[order].astype(xf.dtype))
    block_start = jnp.arange(n_rows // MOE_BLOCK, dtype=jnp.int32) * MOE_BLOCK
    block_expert = jnp.minimum(jnp.searchsorted(pad_end, block_start, side='right'), N_EXPERTS - 1)
    x_pad = jnp.concatenate([xf, jnp.zeros((1, d), xf.dtype)], axis=0)
    xb = x_pad[row_tok].reshape(-1, MOE_BLOCK, d)

    def expert_block(args):
        xblk, e = args
        return (jax.nn.silu(xblk @ wg[e]) * (xblk @ wu[e])) @ wd[e]

    ys = lax.map(expert_block, (xb, block_expert)).reshape(n_rows, d) * row_gate[:, None]
    return jnp.zeros_like(x_pad).at[row_tok].add(ys)[:n]


def setup_inputs(seed: int = 0) -> dict:
    key = jax.random.key(seed)
    ks = jax.random.split(key, 32)
    f32 = jnp.float32
    nrm = lambda k, shape, s: jax.random.normal(k, shape, f32) * s
    L = DEPTH
    return {
        "x": nrm(ks[0], (BATCH, SEQ, D_MODEL), 1.0),
        "norm_mix": 1.0 + nrm(ks[1], (L, D_MODEL), 0.1),
        "w_in": nrm(ks[2], (L, D_MODEL, IN_WIDTH), D_MODEL ** -0.5),
        "w_out": nrm(ks[3], (L, MIX_WIDTH, D_MODEL), MIX_WIDTH ** -0.5),
        "shift_mu": jax.random.uniform(ks[4], (L, RW_SHIFT_WIDTH), f32),
        "gm_ln_w": 1.0 + nrm(ks[5], (L, GM_WIDTH), 0.1),
        "gm_ln_b": nrm(ks[6], (L, GM_WIDTH), 0.1),
        "gm_ws": nrm(ks[7], (L, GM_HEADS, CHUNK, CHUNK), CHUNK ** -0.5),
        "gm_bs": 1.0 + nrm(ks[8], (L, GM_HEADS, CHUNK), 0.1),
        "rw_w_up": nrm(ks[9], (L, DECAY_RANK, RW_WIDTH), 0.1),
        "rw_w0": jax.random.uniform(ks[10], (L, RW_WIDTH), f32, -6.0, -1.0),
        "rw_a_up": nrm(ks[11], (L, AAA_RANK, RW_WIDTH), AAA_RANK ** -0.5),
        "rw_a0": nrm(ks[12], (L, RW_WIDTH), 0.1),
        "rw_g_up": nrm(ks[13], (L, GATE_RANK, RW_WIDTH), GATE_RANK ** -0.5),
        "rw_k_k": 0.85 + nrm(ks[14], (L, RW_WIDTH), 0.1),
        "rw_k_a": 1.0 + nrm(ks[15], (L, RW_WIDTH), 0.1),
        "rw_r_k": nrm(ks[16], (L, RW_HEADS, HEAD_DIM), 0.5),
        "rw_lnx_w": 1.0 + nrm(ks[17], (L, RW_WIDTH), 0.1),
        "rw_lnx_b": nrm(ks[18], (L, RW_WIDTH), 0.1),
        "norm_ffn": 1.0 + nrm(ks[19], (L, D_MODEL), 0.1),
        "ffn_w_gate": nrm(ks[20], (N_DENSE, D_MODEL, D_FF), D_MODEL ** -0.5),
        "ffn_w_up": nrm(ks[21], (N_DENSE, D_MODEL, D_FF), D_MODEL ** -0.5),
        "ffn_w_down": nrm(ks[22], (N_DENSE, D_FF, D_MODEL), D_FF ** -0.5),
        "moe_router": nrm(ks[23], (N_MOE, D_MODEL, N_EXPERTS), D_MODEL ** -0.5),
        "moe_w_gate": nrm(ks[24], (N_MOE, N_EXPERTS, D_MODEL, D_FF_EXPERT), D_MODEL ** -0.5),
        "moe_w_up": nrm(ks[25], (N_MOE, N_EXPERTS, D_MODEL, D_FF_EXPERT), D_MODEL ** -0.5),
        "moe_w_down": nrm(ks[26], (N_MOE, N_EXPERTS, D_FF_EXPERT, D_MODEL), D_FF_EXPERT ** -0.5),
        "norm_final": 1.0 + nrm(ks[27], (D_MODEL,), 0.1),
    }


def reference(x, norm_mix, w_in, w_out, shift_mu, gm_ln_w, gm_ln_b, gm_ws, gm_bs,
              rw_w_up, rw_w0, rw_a_up, rw_a0, rw_g_up, rw_k_k, rw_k_a, rw_r_k, rw_lnx_w, rw_lnx_b,
              norm_ffn, ffn_w_gate, ffn_w_up, ffn_w_down,
              moe_router, moe_w_gate, moe_w_up, moe_w_down, norm_final):
    b, t, d = x.shape
    for i in range(DEPTH):
        h = rmsnorm(x, norm_mix[i])
        x = x + hybrid_mixer(h, w_in[i], w_out[i], shift_mu[i], gm_ln_w[i], gm_ln_b[i], gm_ws[i], gm_bs[i],
                             rw_w_up[i], rw_w0[i], rw_a_up[i], rw_a0[i], rw_g_up[i], rw_k_k[i], rw_k_a[i],
                             rw_r_k[i], rw_lnx_w[i], rw_lnx_b[i])
        h = rmsnorm(x, norm_ffn[i])
        j = i // 2
        if i % 2 == 0:
            x = x + swiglu(h, ffn_w_gate[j], ffn_w_up[j], ffn_w_down[j])
        else:
            y = moe_swiglu(h.reshape(b * t, d), moe_router[j], moe_w_gate[j], moe_w_up[j], moe_w_down[j])
            x = x + y.reshape(b, t, d)
    return rmsnorm(x, norm_final)
```

```cpp
#include <hip/hip_runtime.h>
#include <cstdio>
#include <cstdint>

#ifndef MK_PER_PHASE
#define MK_PER_PHASE 1
#endif

#define GAS __attribute__((address_space(1)))
#define LAS __attribute__((address_space(3)))
typedef unsigned short bf16;
typedef unsigned short bf16_t;
typedef short bf16x8 __attribute__((ext_vector_type(8)));
typedef float f32x4 __attribute__((ext_vector_type(4)));
typedef float f32x2 __attribute__((ext_vector_type(2)));
typedef unsigned u32x4 __attribute__((ext_vector_type(4)));
typedef unsigned u32x2 __attribute__((ext_vector_type(2)));
typedef GAS unsigned gu32;

constexpr int NTOK = 32768, SEQ = 4096, NB = 8, D = 1024, INW = 2816, FF = 2816, FFE = 3584, NE = 8;
constexpr int GMW = 512, RWW = 512, NH = 8, HD = 64, GCH = 128;
constexpr float RMS_EPS = 1e-6f, LN_EPS = 1e-5f, GN_EPS = 64e-5f;
constexpr int MAXPAN = 136;

constexpr size_t MiB = 1u << 20;
constexpr size_t WS_CTL = 0, CTL_ZERO_BYTES = 2 * MiB;
constexpr size_t WS_WIN = 2 * MiB;
constexpr size_t WS_WOUT = 13 * MiB;
constexpr size_t WS_WGU = 17 * MiB;
constexpr size_t WS_WD = 28 * MiB;
constexpr size_t WS_MISC = 34 * MiB;
constexpr size_t WS_XB = 36 * MiB;
constexpr size_t WS_R = 100 * MiB;
constexpr size_t WS_P = WS_R;
constexpr size_t WS_Y = WS_R + 176 * MiB;
constexpr size_t WS_SCR = WS_R + 240 * MiB;
constexpr size_t WS_MOEW_GU = WS_R;
constexpr size_t WS_MOEW_D = WS_R + 112 * MiB;
constexpr size_t WS_MOEH = WS_R + 168 * MiB;
constexpr size_t WS_SSQP = WS_R + 400 * MiB;
constexpr size_t WS_END = WS_R + 408 * MiB;
static_assert(WS_MOEH + (size_t)MAXPAN * 256 * FFE * 2 <= WS_END, "moe hidden fits");
static_assert(WS_WIN + (size_t)2 * INW * D * 2 <= WS_WOUT && WS_WGU + (size_t)2 * FF * D * 2 <= WS_WD && WS_WD + (size_t)D * FF * 2 <= WS_MISC, "weights fit");
constexpr int CW_TMO = 0;
constexpr int CW_BAR = 4096;
constexpr int CW_SSQ = 65536;
static_assert((CW_SSQ + 4 * NTOK) * 4 <= (int)CTL_ZERO_BYTES, "ctl fits");
constexpr size_t MS_TOKE = 0;
constexpr size_t MS_TOKG = 256 * 1024;
constexpr size_t MS_RS = 512 * 1024;
constexpr size_t MS_BCNT = 640 * 1024;
constexpr size_t MS_ROWTOK = 704 * 1024;
constexpr size_t MS_ROWGATE = 1024 * 1024;
constexpr size_t MS_PANEL = 1344 * 1024;
static_assert(MS_ROWTOK + 2 * MAXPAN * 256 * 4 <= MS_ROWGATE && MS_ROWGATE + 2 * MAXPAN * 256 * 4 <= MS_PANEL && MS_PANEL + 2 * 160 * 4 <= 2 * MiB, "misc fits");

constexpr int RING_BYTES = 131072;
constexpr int MISC_OFF = RING_BYTES + 320;
constexpr int LDS_BYTES = 147456;

#define LDS_WAIT() asm volatile("s_waitcnt lgkmcnt(0)" ::: "memory")
#define VM_WAIT() asm volatile("s_waitcnt vmcnt(0)" ::: "memory")
#define RLX_AGENT __ATOMIC_RELAXED, __HIP_MEMORY_SCOPE_AGENT

__device__ __forceinline__ unsigned f2bf(float f) { unsigned u = __builtin_bit_cast(unsigned, f); return (u + 0x7fffu + ((u >> 16) & 1u)) >> 16; }
__device__ __forceinline__ unsigned pk2(float lo, float hi) { return f2bf(lo) | (f2bf(hi) << 16); }
__device__ __forceinline__ float bf2f(bf16 b) { return __builtin_bit_cast(float, (unsigned)b << 16); }
__device__ __forceinline__ unsigned cvt_pk_bf16(float lo, float hi) { unsigned r; asm volatile("v_cvt_pk_bf16_f32 %0, %1, %2" : "=v"(r) : "v"(lo), "v"(hi)); return r; }
__device__ __forceinline__ float wave_sum(float v) {
#pragma unroll
    for (int o = 1; o < 64; o <<= 1) v += __shfl_xor(v, o);
    return v;
}
__device__ __forceinline__ float gelu_erf(float v) { return 0.5f * v * (1.0f + erff(v * 0.70710678f)); }
__device__ __forceinline__ float sigmoidf_(float v) { return 1.0f / (1.0f + __expf(-v)); }
__device__ __forceinline__ float silu_f(float v) { return v * __builtin_amdgcn_rcpf(1.0f + __expf(-v)); }

namespace pg8 {
constexpr int BM = 256, BK = 64, HALF = 128, HTB = HALF * BK * 2, STAGE_BYTES = 8 * HTB, NXCD = 8, WGM = 8;
__host__ __device__ __forceinline__ int lds_byte(int r, int c) { const int st = (r >> 4) * 2 + (c >> 5), rr = r & 15, cc = c & 31, ob = rr * 64 + cc * 2; return st * 1024 + (ob ^ (((ob >> 9) & 1) << 5)); }
__host__ __device__ __forceinline__ void stage_rc(int b, int& R, int& C) { const int st = b / 1024, sb = b % 1024, swz = sb ^ (((sb >> 9) & 1) << 5); R = (st >> 1) * 16 + swz / 64; C = (st & 1) * 32 + (swz % 64) / 2; }
__host__ __device__ __forceinline__ int perm32(int rho) { const int n = rho >> 4, i = rho & 15; return 8 * (i >> 2) + 4 * n + (i & 3); }

struct Unit { int pm, pn, aux; };

struct TileOrder {
    int nM, nN, nwg, G, c;
    __device__ void init(int nM_, int nN_, int G_, int c_) { nM = nM_; nN = nN_; nwg = nM * nN; G = G_; c = c_; }
    __device__ bool tile(int i, int& pm, int& pn) const {
        const long L = (long)i * G + c; if (L >= nwg) return false;
        int wgid = (int)L; { const int q = nwg / NXCD, r = nwg % NXCD, xcd = wgid % NXCD, off = wgid / NXCD; wgid = (xcd < r ? xcd * (q + 1) : r * (q + 1) + (xcd - r) * q) + off; }
        const int nig = WGM * nN, gid = wgid / nig, fm = gid * WGM, gsz = (nM - fm) < WGM ? (nM - fm) : WGM;
        pm = fm + ((wgid % nig) % gsz); pn = (wgid % nig) / gsz; return true;
    }
};
struct DenseSched {
    static constexpr bool GATHER = false;
    TileOrder T; const char* A; const char* Bt; size_t tstep;
    __device__ void init(const bf16_t* A_, const bf16_t* Bt_, int M, int N, int K, int G, int c) { T.init(M / BM, N / BM, G, c); A = (const char*)A_; Bt = (const char*)Bt_; tstep = (size_t)BM * K * 2; }
    __device__ __forceinline__ bool next(int i, Unit& u) const { u.aux = 0; return T.tile(i, u.pm, u.pn); }
    __device__ __forceinline__ const char* a_ptr(const Unit& u) const { return A + (size_t)u.pm * tstep; }
    __device__ __forceinline__ const char* b_ptr(const Unit& u) const { return Bt + (size_t)u.pn * tstep; }
    __device__ __forceinline__ void gather(const Unit&, int, int, int, int, int, unsigned (&)[2][2]) const {}
};
template <bool GATHER_> struct MoeSched {
    static constexpr bool GATHER = GATHER_;
    TileOrder T; const char* A; const char* Bt; size_t a_tstep, b_tstep, b_estep; const int* pexp; const int* row_tok; int K;
    __device__ void init(const bf16_t* A_, const bf16_t* Bt_, int npanels, int N, int K_, const int* pexp_, const int* row_tok_, int G, int c) {
        T.init(npanels, N / BM, G, c); A = (const char*)A_; Bt = (const char*)Bt_; K = K_; a_tstep = (size_t)BM * K_ * 2; b_tstep = (size_t)BM * K_ * 2; b_estep = (size_t)N * K_ * 2; pexp = pexp_; row_tok = row_tok_; }
    __device__ __forceinline__ bool next(int i, Unit& u) const { if (!T.tile(i, u.pm, u.pn)) return false; u.aux = __builtin_amdgcn_readfirstlane(pexp[u.pm]); return true; }
    __device__ __forceinline__ const char* a_ptr(const Unit& u) const { return GATHER ? A : A + (size_t)u.pm * a_tstep; }
    __device__ __forceinline__ const char* b_ptr(const Unit& u) const { return Bt + (size_t)u.aux * b_estep + (size_t)u.pn * b_tstep; }
    __device__ __forceinline__ void gather(const Unit& u, int R0, int R1, int C0, int C1, int, unsigned (&v)[2][2]) const {
#pragma unroll
        for (int h = 0; h < 2; ++h) { int t0 = row_tok[u.pm * BM + h * HALF + R0], t1 = row_tok[u.pm * BM + h * HALF + R1]; t0 = t0 < 0 ? 0 : t0; t1 = t1 < 0 ? 0 : t1;
            v[h][0] = (unsigned)(t0 * K + C0) * 2u; v[h][1] = (unsigned)(t1 * K + C1) * 2u; }
    }
};

template <class Epi, class Sched>
__device__ __forceinline__ void gemm_phase(LAS unsigned char* lds, const int K, const Sched& S, const Epi& E) {
    constexpr bool GATHER = Sched::GATHER;
    const int tid = threadIdx.x, wid = __builtin_amdgcn_readfirstlane(tid >> 6), lane = tid & 63, wr = wid >> 2, wc = wid & 3, fr = lane & 15, fq = lane >> 4;
    const int nt = K / BK;
    unsigned voffA[2], voffB[2]; int sR[2], sC[2];
#pragma unroll
    for (int i = 0; i < 2; ++i) { int R, C; stage_rc(tid * 16 + i * 8192, R, C); const int Rb = Epi::PERM ? ((R & ~31) + perm32(R & 31)) : R; sR[i] = R; sC[i] = C;
        voffA[i] = (unsigned)(R * K + C) * 2u; voffB[i] = (unsigned)(Rb * K + C) * 2u; }
    const size_t kstep = (size_t)(BK * 2);
    const size_t hstep = (size_t)HALF * K * 2;
    const unsigned ldsw = (unsigned)wid * 1024u;
    const int aoff = lds_byte(wr * 64 + fr, fq * 8), boff = lds_byte(wc * 32 + fr, fq * 8);
#define PG8_SA(b, h) (((b) * 2 + (h)) * HTB)
#define PG8_SB(b, h) ((4 + (b) * 2 + (h)) * HTB)
#define PG8_STAGE(bufoff, gbase, voff) do { _Pragma("unroll") for (int _i = 0; _i < 2; ++_i) \
        __builtin_amdgcn_global_load_lds((const unsigned*)((const char*)(gbase) + (voff)[_i]), (LAS unsigned*)(lds + (bufoff) + ldsw + _i * 8192), 16, 0, 0); } while (0)
#define PG8_STAGE_A(bufoff, kptr, half, VG) do { if constexpr (GATHER) { PG8_STAGE(bufoff, kptr, (VG)[half]); } else { PG8_STAGE(bufoff, (kptr) + (half) * hstep, voffA); } } while (0)
#define PG8_LDA(dst, b, h) do { _Pragma("unroll") for (int m = 0; m < 4; ++m) _Pragma("unroll") for (int k = 0; k < 2; ++k) dst[m][k] = *(const LAS bf16x8*)(lds + PG8_SA(b, h) + aoff + m * 2048 + k * 1024); } while (0)
#define PG8_LDB(dst, b, h) do { _Pragma("unroll") for (int n = 0; n < 2; ++n) _Pragma("unroll") for (int k = 0; k < 2; ++k) dst[n][k] = *(const LAS bf16x8*)(lds + PG8_SB(b, h) + boff + n * 2048 + k * 1024); } while (0)
#define PG8_MMA(ai, bj, At, Bt) do { __builtin_amdgcn_s_setprio(1); _Pragma("unroll") for (int m = 0; m < 4; ++m) _Pragma("unroll") for (int n = 0; n < 2; ++n) _Pragma("unroll") for (int k = 0; k < 2; ++k) \
        acc[ai][bj][m][n] = __builtin_amdgcn_mfma_f32_16x16x32_bf16(Bt[n][k], At[m][k], acc[ai][bj][m][n], 0, 0, 0); __builtin_amdgcn_s_setprio(0); } while (0)
#define PG8_WAIT_V(n) asm volatile("s_waitcnt vmcnt(" #n ")" ::: "memory")
#define PG8_WAIT_L(n) asm volatile("s_waitcnt lgkmcnt(" #n ")" ::: "memory")
#define PG8_BAR __builtin_amdgcn_s_barrier()
#define PG8_SCHED __builtin_amdgcn_sched_barrier(0)
    Unit cur, nxt; int ui = 0;
    if (!S.next(0, cur)) return;
    f32x4 acc[2][2][4][2];
#pragma unroll
    for (int a = 0; a < 2; ++a)
#pragma unroll
        for (int b = 0; b < 2; ++b)
#pragma unroll
            for (int m = 0; m < 4; ++m)
#pragma unroll
                for (int n = 0; n < 2; ++n) acc[a][b][m][n] = (f32x4){0.f, 0.f, 0.f, 0.f};
    bf16x8 At[4][2], B0[2][2], B1[2][2];
    const char* cA = S.a_ptr(cur); const char* cB = S.b_ptr(cur);
    unsigned vcur[2][2] = {{0u, 0u}, {0u, 0u}}, vnext[2][2] = {{0u, 0u}, {0u, 0u}}, vt2[2][2] = {{0u, 0u}, {0u, 0u}};
    if constexpr (GATHER) S.gather(cur, sR[0], sR[1], sC[0], sC[1], 0, vcur);
    PG8_STAGE(PG8_SB(0, 0), cB, voffB); PG8_STAGE(PG8_SB(0, 1), cB + hstep, voffB); PG8_STAGE_A(PG8_SA(0, 0), cA, 0, vcur); PG8_STAGE_A(PG8_SA(0, 1), cA, 1, vcur);
    if (wr == 1) PG8_BAR;
    PG8_WAIT_V(2); PG8_BAR;
    PG8_STAGE(PG8_SB(1, 0), cB + kstep, voffB); PG8_STAGE_A(PG8_SA(1, 0), cA + kstep, 0, vcur); PG8_STAGE(PG8_SB(1, 1), cB + hstep + kstep, voffB);
    PG8_WAIT_V(6); PG8_BAR;
    for (;;) {
        const bool has_next = S.next(ui + 1, nxt);
        const char* nA = has_next ? S.a_ptr(nxt) : cA; const char* nB = has_next ? S.b_ptr(nxt) : cB;
        if constexpr (GATHER) { if (has_next) S.gather(nxt, sR[0], sR[1], sC[0], sC[1], 0, vnext); else {
#pragma unroll
            for (int h = 0; h < 2; ++h) { vnext[h][0] = vcur[h][0]; vnext[h][1] = vcur[h][1]; } } }
        for (int t = 0; t < nt; t += 2) {
            const bool last = (t == nt - 2);
            const char* a1 = cA + (size_t)(t + 1) * kstep;
            const char* a2 = last ? nA : cA + (size_t)(t + 2) * kstep; const char* b2 = last ? nB : cB + (size_t)(t + 2) * kstep;
            const char* a3 = a2 + kstep; const char* b3 = b2 + kstep;
            if constexpr (GATHER) {
#pragma unroll
                for (int h = 0; h < 2; ++h) { vt2[h][0] = last ? vnext[h][0] : vcur[h][0]; vt2[h][1] = last ? vnext[h][1] : vcur[h][1]; } }
            PG8_LDB(B0, 0, 0); PG8_LDB(B1, 0, 1); PG8_SCHED; PG8_LDA(At, 0, 0); PG8_STAGE_A(PG8_SA(1, 1), a1, 1, vcur);
            PG8_WAIT_V(8); PG8_WAIT_L(0); PG8_BAR; PG8_MMA(0, 0, At, B0); PG8_MMA(0, 1, At, B1); PG8_BAR; PG8_SCHED;
            PG8_LDA(At, 0, 1); PG8_STAGE(PG8_SB(0, 0), b2, voffB); PG8_STAGE(PG8_SB(0, 1), b2 + hstep, voffB); PG8_STAGE_A(PG8_SA(0, 0), a2, 0, vt2);
            PG8_WAIT_V(8); PG8_WAIT_L(0); PG8_BAR; PG8_MMA(1, 0, At, B0); PG8_MMA(1, 1, At, B1); PG8_BAR; PG8_SCHED;
            PG8_LDB(B0, 1, 0); PG8_LDB(B1, 1, 1); PG8_SCHED; PG8_LDA(At, 1, 0); PG8_STAGE_A(PG8_SA(0, 1), a2, 1, vt2);
            PG8_WAIT_V(8); PG8_WAIT_L(0); PG8_BAR; PG8_MMA(0, 0, At, B0); PG8_MMA(0, 1, At, B1); PG8_BAR; PG8_SCHED;
            PG8_LDA(At, 1, 1); PG8_STAGE(PG8_SB(1, 0), b3, voffB); PG8_STAGE(PG8_SB(1, 1), b3 + hstep, voffB); PG8_STAGE_A(PG8_SA(1, 0), a3, 0, vt2);
            PG8_WAIT_V(8); PG8_WAIT_L(0); PG8_BAR; PG8_MMA(1, 0, At, B0); PG8_MMA(1, 1, At, B1); PG8_BAR; PG8_SCHED;
        }
        if (wr == 0) PG8_BAR;
        E(acc, cur, wr, wc, fr, fq);
        if (!has_next) break;
#pragma unroll
        for (int a = 0; a < 2; ++a)
#pragma unroll
            for (int b = 0; b < 2; ++b)
#pragma unroll
                for (int m = 0; m < 4; ++m)
#pragma unroll
                    for (int n = 0; n < 2; ++n) acc[a][b][m][n] = (f32x4){0.f, 0.f, 0.f, 0.f};
        cur = nxt; cA = nA; cB = nB; ++ui;
        if constexpr (GATHER) {
#pragma unroll
            for (int h = 0; h < 2; ++h) { vcur[h][0] = vnext[h][0]; vcur[h][1] = vnext[h][1]; } }
        if (wr == 1) PG8_BAR;
    }
    PG8_WAIT_V(0);
    PG8_BAR;
#undef PG8_SA
#undef PG8_SB
#undef PG8_STAGE
#undef PG8_STAGE_A
#undef PG8_LDA
#undef PG8_LDB
#undef PG8_MMA
#undef PG8_WAIT_V
#undef PG8_WAIT_L
#undef PG8_BAR
#undef PG8_SCHED
}

template <int NP> __device__ __forceinline__ float row_rs(const float* ssq, int row) {
    float s;
    if constexpr (NP == 1) s = ssq[row];
    else { const f32x4* p = (const f32x4*)(ssq + (size_t)row * 16); const f32x4 a = p[0], b = p[1], c = p[2], d = p[3];
        s = (((a[0] + a[1]) + (a[2] + a[3])) + ((b[0] + b[1]) + (b[2] + b[3]))) + (((c[0] + c[1]) + (c[2] + c[3])) + ((d[0] + d[1]) + (d[2] + d[3]))); }
    return __builtin_amdgcn_rsqf(s * (1.0f / D) + RMS_EPS);
}
template <int NP> struct EpiScaleBf16 {
    static constexpr bool PERM = true;
    bf16_t* O; int ldc; const float* ssq;
    __device__ __forceinline__ void operator()(const f32x4 (&acc)[2][2][4][2], const Unit& u, int wr, int wc, int fr, int fq) const {
        const int row0 = u.pm * BM + wr * 64 + fr, col0 = u.pn * BM + wc * 32 + 8 * fq;
#pragma unroll
        for (int ai = 0; ai < 2; ++ai)
#pragma unroll
            for (int m = 0; m < 4; ++m) { const int row = row0 + ai * HALF + m * 16; const float rs = row_rs<NP>(ssq, row);
                bf16_t* rowp = O + (size_t)row * ldc + col0;
#pragma unroll
                for (int bj = 0; bj < 2; ++bj) { const f32x4 v0 = acc[ai][bj][m][0] * rs, v1 = acc[ai][bj][m][1] * rs;
                    u32x4 w; w.x = cvt_pk_bf16(v0[0], v0[1]); w.y = cvt_pk_bf16(v0[2], v0[3]); w.z = cvt_pk_bf16(v1[0], v1[1]); w.w = cvt_pk_bf16(v1[2], v1[3]);
                    *(u32x4*)(rowp + bj * HALF) = w; } }
    }
};
template <bool SSQ> struct EpiResid {
    static constexpr bool PERM = false;
    const float* base; float* out; bf16_t* xb; float* ssq;
    __device__ __forceinline__ void operator()(const f32x4 (&acc)[2][2][4][2], const Unit& u, int wr, int wc, int fr, int fq) const {
        const int row0 = u.pm * BM + wr * 64 + fr, col0 = u.pn * BM + wc * 32 + 4 * fq;
#pragma unroll
        for (int ai = 0; ai < 2; ++ai)
#pragma unroll
            for (int m = 0; m < 4; ++m) { const int row = row0 + ai * HALF + m * 16; const size_t off = (size_t)row * D + col0; float s = 0.f;
#pragma unroll
                for (int bj = 0; bj < 2; ++bj)
#pragma unroll
                    for (int n = 0; n < 2; ++n) { const f32x4 o = *(const f32x4*)(base + off + bj * HALF + n * 16) + acc[ai][bj][m][n];
                        *(f32x4*)(out + off + bj * HALF + n * 16) = o; u32x2 w; w.x = cvt_pk_bf16(o[0], o[1]); w.y = cvt_pk_bf16(o[2], o[3]);
                        *(u32x2*)(xb + off + bj * HALF + n * 16) = w; s += (o[0] * o[0] + o[1] * o[1]) + (o[2] * o[2] + o[3] * o[3]); }
                if constexpr (SSQ) { s += __shfl_xor(s, 16); s += __shfl_xor(s, 32);
                    if (fq == 0) ssq[(size_t)row * 16 + u.pn * 4 + wc] = s; }
                asm volatile("" ::: "memory"); }
    }
};
template <int NP> struct EpiSwiglu {
    static constexpr bool PERM = true;
    bf16_t* O; int ldc; const float* ssq;
    __device__ __forceinline__ void operator()(const f32x4 (&acc)[2][2][4][2], const Unit& u, int wr, int wc, int fr, int fq) const {
        const int row0 = u.pm * BM + wr * 64 + fr, col0 = u.pn * HALF + wc * 32 + 8 * fq;
#pragma unroll
        for (int ai = 0; ai < 2; ++ai)
#pragma unroll
            for (int m = 0; m < 4; ++m) { const int row = row0 + ai * HALF + m * 16; const float rs = row_rs<NP>(ssq, row);
                float h[8];
#pragma unroll
                for (int n = 0; n < 2; ++n)
#pragma unroll
                    for (int j = 0; j < 4; ++j) h[n * 4 + j] = silu_f(acc[ai][0][m][n][j] * rs) * (acc[ai][1][m][n][j] * rs);
                u32x4 w; w.x = cvt_pk_bf16(h[0], h[1]); w.y = cvt_pk_bf16(h[2], h[3]); w.z = cvt_pk_bf16(h[4], h[5]); w.w = cvt_pk_bf16(h[6], h[7]);
                *(u32x4*)(O + (size_t)row * ldc + col0) = w; }
    }
};
struct EpiSwigluMoe {
    static constexpr bool PERM = true;
    bf16_t* O; int ldc; const float* rsv; const int* row_tok;
    __device__ __forceinline__ void operator()(const f32x4 (&acc)[2][2][4][2], const Unit& u, int wr, int wc, int fr, int fq) const {
        const int row0 = u.pm * BM + wr * 64 + fr, col0 = u.pn * HALF + wc * 32 + 8 * fq;
#pragma unroll
        for (int ai = 0; ai < 2; ++ai)
#pragma unroll
            for (int m = 0; m < 4; ++m) { const int row = row0 + ai * HALF + m * 16; const int tok = row_tok[row]; const float rs = tok >= 0 ? rsv[tok] : 0.f;
                float h[8];
#pragma unroll
                for (int n = 0; n < 2; ++n)
#pragma unroll
                    for (int j = 0; j < 4; ++j) h[n * 4 + j] = silu_f(acc[ai][0][m][n][j] * rs) * (acc[ai][1][m][n][j] * rs);
                u32x4 w; w.x = cvt_pk_bf16(h[0], h[1]); w.y = cvt_pk_bf16(h[2], h[3]); w.z = cvt_pk_bf16(h[4], h[5]); w.w = cvt_pk_bf16(h[6], h[7]);
                *(u32x4*)(O + (size_t)row * ldc + col0) = w; }
    }
};
struct EpiMoeDown {
    static constexpr bool PERM = false;
    float* out; const int* row_tok; const float* row_gate;
    __device__ __forceinline__ void operator()(const f32x4 (&acc)[2][2][4][2], const Unit& u, int wr, int wc, int fr, int fq) const {
        const int row0 = u.pm * BM + wr * 64 + fr, col0 = u.pn * BM + wc * 32 + 4 * fq;
#pragma unroll
        for (int ai = 0; ai < 2; ++ai)
#pragma unroll
            for (int m = 0; m < 4; ++m) { const int row = row0 + ai * HALF + m * 16; const int tok = row_tok[row]; const float g = row_gate[row];
                if (tok >= 0) { float* rp = out + (size_t)tok * D + col0;
#pragma unroll
                    for (int bj = 0; bj < 2; ++bj)
#pragma unroll
                        for (int n = 0; n < 2; ++n) { f32x4* p = (f32x4*)(rp + bj * HALF + n * 16); *p = *p + acc[ai][bj][m][n] * g; } }
                asm volatile("" ::: "memory"); }
    }
};
}

#define XB_TMO      128
#define XB_XCNT(j)  (256  + 64 * (j))
#define XB_XSUB(j)  (1280 + 64 * (j))
#define XB_XGEN(j)  (2304 + 64 * (j))
#define XB_TOP      3328
#define XB_TOPGEN   3392
#define XCD_BAR_WORDS 3456
#define XB_SPIN_CAP (1u << 18)
__device__ __forceinline__ unsigned xb_ld(unsigned* p)              { return __hip_atomic_load(p, __ATOMIC_RELAXED, __HIP_MEMORY_SCOPE_AGENT); }
__device__ __forceinline__ unsigned xb_add(unsigned* p, unsigned v) { return __hip_atomic_fetch_add(p, v, __ATOMIC_RELAXED, __HIP_MEMORY_SCOPE_AGENT); }
__device__ __forceinline__ unsigned xb_xcc_id() { return (unsigned)__builtin_amdgcn_s_getreg((3 << 11) | 20) & 0xFu; }
#define XB_SPIN(cond, bar) do { unsigned _sp = 0; while (cond) { __builtin_amdgcn_s_sleep(1); \
    if ((++_sp & 255u) == 0u) { if (xb_ld(&(bar)[XB_TMO])) break; if (_sp > XB_SPIN_CAP) { atomicAdd(&(bar)[XB_TMO], 1u); break; } } } } while (0)
struct XcdBarrier { unsigned* bar; unsigned x; volatile LAS unsigned* st; };
__device__ __forceinline__ XcdBarrier xcd_barrier_post(unsigned* bar, volatile LAS unsigned* st) {
    XcdBarrier b; b.bar = bar; b.x = xb_xcc_id(); b.st = st;
    if (threadIdx.x == 0) (void)xb_add(&bar[XB_XCNT(b.x)], 1u);
    return b;
}
__device__ __forceinline__ void xcd_barrier_complete(unsigned* bar, unsigned x, unsigned& nloc, unsigned& nx) {
    const unsigned G = gridDim.x * gridDim.y * gridDim.z;
    unsigned sum, cnt, mine, sp = 0u;
    for (;;) {
        sum = 0u; cnt = 0u; mine = 0u;
#pragma unroll
        for (unsigned j = 0; j < 16; ++j) { const unsigned c = xb_ld(&bar[XB_XCNT(j)]); sum += c; cnt += (c > 0u) ? 1u : 0u; mine = (j == x) ? c : mine; }
        if (sum == G) break;
        __builtin_amdgcn_s_sleep(1);
        if ((++sp & 255u) == 0u) { if (xb_ld(&bar[XB_TMO])) break; if (sp > XB_SPIN_CAP) { atomicAdd(&bar[XB_TMO], 1u); break; } }
    }
    nloc = mine > 0u ? mine : 1u; nx = cnt > 0u ? cnt : 1u;
}
__device__ __forceinline__ void xcd_barrier(const XcdBarrier& b) {
    asm volatile("s_waitcnt vmcnt(0)" ::: "memory");
    __syncthreads();
    if (threadIdx.x == 0) {
        unsigned* bar = b.bar;
        __builtin_amdgcn_s_waitcnt(0);
        unsigned nloc = b.st[0], nx = b.st[1];
        if (nloc == 0u) { xcd_barrier_complete(bar, b.x, nloc, nx); b.st[0] = nloc; b.st[1] = nx; }
        const unsigned old = xb_add(&bar[XB_XSUB(b.x)], 1u);
        const unsigned gen = old / nloc;
        if (old + 1u == (gen + 1u) * nloc) {
            __builtin_amdgcn_fence(__ATOMIC_RELEASE, "agent");
            asm volatile("s_waitcnt vmcnt(0)" ::: "memory");
            const unsigned og = xb_add(&bar[XB_TOP], 1u);
            const unsigned tg = og / nx;
            if (og + 1u == (tg + 1u) * nx) xb_add(&bar[XB_TOPGEN], 1u);
            else XB_SPIN(xb_ld(&bar[XB_TOPGEN]) == tg, bar);
            __builtin_amdgcn_fence(__ATOMIC_ACQUIRE, "agent");
            xb_add(&bar[XB_XGEN(b.x)], 1u);
            asm volatile("s_waitcnt vmcnt(0)" ::: "memory");
        } else {
            XB_SPIN(xb_ld(&bar[XB_XGEN(b.x)]) == gen, bar);
            __builtin_amdgcn_fence(__ATOMIC_ACQUIRE, "agent");
            asm volatile("s_waitcnt vmcnt(0)" ::: "memory");
        }
    }
    __syncthreads();
}

constexpr int NIN = 28;
struct Args { const float* in[NIN]; float* out; unsigned char* ws; int ph_lo, ph_hi; };
enum { I_X = 0, I_NORM_MIX, I_W_IN, I_W_OUT, I_SHIFT_MU, I_GM_LN_W, I_GM_LN_B, I_GM_WS, I_GM_BS, I_RW_W_UP, I_RW_W0, I_RW_A_UP, I_RW_A0, I_RW_G_UP, I_RW_K_K, I_RW_K_A, I_RW_R_K,
       I_RW_LNX_W, I_RW_LNX_B, I_NORM_FFN, I_FFN_WG, I_FFN_WU, I_FFN_WD, I_MOE_ROUTER, I_MOE_WG, I_MOE_WU, I_MOE_WD, I_NORM_FINAL };

struct Frame {
    LAS unsigned char* lds;
    int tid, lane, wave, G, gw, NGW;
};

__device__ __forceinline__ void transpose_item(const float* W, int K, int N, bf16* WT, int drow0, int k0, int n0, const float* gain, LAS float* scr, int lane) {
#pragma unroll 8
    for (int i = 0; i < 32; ++i) { const int kk = 2 * i + (lane >> 5); float v = W[(size_t)(k0 + kk) * N + n0 + (lane & 31)]; if (gain) v *= gain[k0 + kk]; scr[kk * 33 + (lane & 31)] = v; }
    LDS_WAIT(); asm volatile("" ::: "memory");
    const int c = lane & 7;
#pragma unroll
    for (int j = 0; j < 4; ++j) { const int n = (lane >> 3) + 8 * j; const LAS float* s = scr + (8 * c) * 33 + n;
        u32x4 o; o.x = pk2(s[0 * 33], s[1 * 33]); o.y = pk2(s[2 * 33], s[3 * 33]); o.z = pk2(s[4 * 33], s[5 * 33]); o.w = pk2(s[6 * 33], s[7 * 33]);
        *(GAS u32x4*)(WT + (size_t)(drow0 + n) * K + k0 + 8 * c) = o; }
    LDS_WAIT(); asm volatile("" ::: "memory");
}
__device__ __forceinline__ void convert_matrix(Frame& F, const float* W, int K, int N, bf16* WT, int gu_mode  , const float* gain, int it0, int& itbase) {
    LAS float* scr = (LAS float*)(F.lds + F.wave * 16384);
    const int nblk = N / 32, nit = (K / 64) * nblk;
    int first = F.gw - (itbase % F.NGW); if (first < 0) first += F.NGW;
    for (int r = first; r < nit; r += F.NGW) { const int kb = r / nblk, nb = r % nblk, n0 = 32 * nb;
        const int drow0 = gu_mode == 0 ? n0 : (n0 / 128) * 256 + (gu_mode == 2 ? 128 : 0) + (n0 % 128);
        transpose_item(W, K, N, WT, drow0, 64 * kb, n0, gain, scr, F.lane); }
    itbase += nit; (void)it0;
}

__device__ __forceinline__ void gmlp_naive(Frame& F, const bf16* P, bf16* Y, const float* ln_w, const float* ln_b, const float* ws, const float* bs) {
    LAS float* V = (LAS float*)F.lds;
    for (int unit = blockIdx.x; unit < NB * (SEQ / GCH) * NH; unit += F.G) {
        const int h = unit % NH, bc = unit / NH; const size_t row0 = (size_t)bc * GCH;
        const float lw = ln_w[h * HD + F.lane], lb = ln_b[h * HD + F.lane];
        for (int i = 0; i < 16; ++i) { const int t = F.wave * 16 + i;
            const float g = gelu_erf(bf2f(P[(row0 + t) * INW + GMW + h * HD + F.lane]));
            const float mean = wave_sum(g) * (1.f / HD); const float d = g - mean; const float var = wave_sum(d * d) * (1.f / HD);
            V[t * HD + F.lane] = d * __builtin_amdgcn_rsqf(var + LN_EPS) * lw + lb; }
        __syncthreads();
        for (int i = 0; i < 16; ++i) { const int t = F.wave * 16 + i; const float* wrow = ws + ((size_t)h * GCH + t) * GCH; float acc = 0.f;
            for (int s = 0; s <= t; ++s) acc += wrow[s] * V[s * HD + F.lane];
            const float mixed = acc + bs[h * GCH + t];
            const float u = gelu_erf(bf2f(P[(row0 + t) * INW + h * HD + F.lane]));
            Y[(row0 + t) * D + h * HD + F.lane] = (bf16)f2bf(u * mixed); }
        __syncthreads();
    }
}
__device__ __forceinline__ float shifted(const bf16* P, size_t row, int t, int col, const float* mu) {
    const float c = bf2f(P[row * INW + col]); const float pr = t > 0 ? bf2f(P[(row - 1) * INW + col]) : 0.f;
    return c + (pr - c) * mu[col - 1024];
}
constexpr int NC = 32;
__device__ __forceinline__ void rwkv_naive(Frame& F, const bf16* P, bf16* Y, const float* mu, const float* w_up, const float* w0, const float* a_up, const float* a0, const float* g_up,
                                           const float* k_k, const float* k_a, const float* r_k, const float* lnx_w, const float* lnx_b) {
    LAS float* LI = (LAS float*)F.lds;
    LAS float* sR = LI + NC * 256; LAS float* sW = sR + NC * 64; LAS float* sK = sW + NC * 64; LAS float* sV = sK + NC * 64; LAS float* sA = sV + NC * 64; LAS float* sB = sA + NC * 64;
    LAS float* sG = sB + NC * 64; LAS float* sBon = sG + NC * 64;
    for (int unit = blockIdx.x; unit < NB * NH; unit += F.G) {
        const int b = unit / NH, h = unit % NH;
        float S[64];
#pragma unroll
        for (int k = 0; k < 64; ++k) S[k] = 0.f;
        for (int c = 0; c < SEQ / NC; ++c) {
            const int t0 = c * NC; const size_t row0 = (size_t)b * SEQ + t0;
            for (int idx = F.tid; idx < NC * 256; idx += 512) { const int tok = idx >> 8, j = idx & 255;
                const float x = shifted(P, row0 + tok, t0 + tok, 2560 + j, mu);
                LI[idx] = j < 64 ? tanhf(x) : (j < 128 ? x : sigmoidf_(x)); }
            __syncthreads();
            { const int ch = F.lane, hc = h * HD + ch;
              for (int i = 0; i < NC / 8; ++i) { const int tok = F.wave + 8 * i; const size_t row = row0 + tok; const int t = t0 + tok;
                const float rr = shifted(P, row, t, 1024 + hc, mu), kx = shifted(P, row, t, 1536 + hc, mu), vv = shifted(P, row, t, 2048 + hc, mu);
                float dw = w0[hc], da = a0[hc], gg = 0.f;
                for (int j = 0; j < 64; ++j) { dw += LI[tok * 256 + j] * w_up[j * RWW + hc]; da += LI[tok * 256 + 64 + j] * a_up[j * RWW + hc]; }
                for (int j = 0; j < 128; ++j) gg += LI[tok * 256 + 128 + j] * g_up[j * RWW + hc];
                const float z = -dw; const float sp = fmaxf(z, 0.f) + log1pf(__expf(-fabsf(z)));
                const float decay = __expf(-__expf(-sp - 0.5f));
                const float alr = sigmoidf_(da);
                const float kkv = kx * k_k[hc]; const float nrm = sqrtf(wave_sum(kkv * kkv)); const float kkn = kkv / fmaxf(nrm, 1e-12f);
                const float kmod = kx * (1.f + (alr - 1.f) * k_a[hc]);
                const float bsc = wave_sum(rr * kmod * r_k[hc]);
                sR[tok * 64 + ch] = rr; sW[tok * 64 + ch] = decay; sK[tok * 64 + ch] = kmod; sV[tok * 64 + ch] = vv; sA[tok * 64 + ch] = -kkn; sB[tok * 64 + ch] = kkn * alr;
                sG[tok * 64 + ch] = gg; sBon[tok * 64 + ch] = bsc * vv; } }
            __syncthreads();
            if (F.wave == 0) {
                for (int t = 0; t < NC; ++t) { float sa = 0.f;
#pragma unroll
                    for (int k = 0; k < 64; ++k) sa += S[k] * sA[t * 64 + k];
                    const float vv = sV[t * 64 + F.lane]; float yv = 0.f;
#pragma unroll
                    for (int k = 0; k < 64; ++k) { S[k] = S[k] * sW[t * 64 + k] + sa * sB[t * 64 + k] + vv * sK[t * 64 + k]; yv += S[k] * sR[t * 64 + k]; }
                    LI[t * 64 + F.lane] = yv; }
            }
            __syncthreads();
            { const int v = F.lane, hv = h * HD + v;
              for (int i = 0; i < NC / 8; ++i) { const int tok = F.wave + 8 * i; const float yv = LI[tok * 64 + v];
                const float mean = wave_sum(yv) * (1.f / HD); const float d = yv - mean; const float var = wave_sum(d * d) * (1.f / HD);
                const float yn = d * __builtin_amdgcn_rsqf(var + GN_EPS) * lnx_w[hv] + lnx_b[hv];
                Y[(row0 + tok) * D + GMW + hv] = (bf16)f2bf((yn + sBon[tok * 64 + v]) * sG[tok * 64 + v]); } }
            __syncthreads();
        }
    }
}

enum Phase { PH_PRO = 0, PH_G1_0, PH_MIX_0, PH_G2_0, PH_G3_0, PH_G4_0, PH_G1_1, PH_MIX_1, PH_G2_1, PH_CV, PH_R2, PH_GU_A, PH_DN_A, PH_GU_B, PH_DN_B, PH_FIN, PH_COUNT };

__global__ void __launch_bounds__(512, 2) fwd(Args args) {
    extern __shared__ __attribute__((aligned(16))) unsigned char lds_raw[];
    Frame F;
    F.lds = (LAS unsigned char*)lds_raw;
    F.tid = threadIdx.x; F.lane = F.tid & 63; F.wave = __builtin_amdgcn_readfirstlane(F.tid >> 6);
    F.G = gridDim.x; F.gw = blockIdx.x * 8 + F.wave; F.NGW = F.G * 8;
    unsigned char* ws = args.ws;
    gu32* ctl = (gu32*)(ws + WS_CTL);
    volatile LAS unsigned* MISC = (volatile LAS unsigned*)(F.lds + MISC_OFF);
    for (int u = F.tid; u < (LDS_BYTES - RING_BYTES) / 4; u += 512) ((LAS unsigned*)(F.lds + RING_BYTES))[u] = 0u;
    __syncthreads();
    XcdBarrier bar; bar.bar = (unsigned*)(ctl + CW_BAR); bar.x = 0; bar.st = nullptr;
#if !MK_PER_PHASE
    bar = xcd_barrier_post((unsigned*)(ctl + CW_BAR), MISC + 8);
#endif
    const int lo = args.ph_lo, hi = args.ph_hi;
#define IN(k) (lo <= (k) && (k) < hi)
#define SEAM(k) do { if (IN(k) && IN((k) + 1)) xcd_barrier(bar); } while (0)

    const float* x_in = args.in[I_X]; float* xres = args.out;
    bf16* WinT = (bf16*)(ws + WS_WIN); bf16* WoutT = (bf16*)(ws + WS_WOUT); bf16* WguT = (bf16*)(ws + WS_WGU); bf16* WdT = (bf16*)(ws + WS_WD);
    bf16* XB = (bf16*)(ws + WS_XB); bf16* PB = (bf16*)(ws + WS_P); bf16* YB = (bf16*)(ws + WS_Y); bf16* HB = (bf16*)(ws + WS_P);
    bf16* MWgu = (bf16*)(ws + WS_MOEW_GU); bf16* MWd = (bf16*)(ws + WS_MOEW_D); bf16* MH = (bf16*)(ws + WS_MOEH);
    float* ssq0 = (float*)(ctl + CW_SSQ); float* ssq1 = (float*)(ws + WS_SSQP); float* ssq2 = ssq1 + (size_t)NTOK * 16;
    unsigned char* misc = ws + WS_MISC;
    int* tok_e = (int*)(misc + MS_TOKE); float* tok_g = (float*)(misc + MS_TOKG); float* rs_moe = (float*)(misc + MS_RS); int* bcnt = (int*)(misc + MS_BCNT);
    int* row_tok = (int*)(misc + MS_ROWTOK); float* row_gate = (float*)(misc + MS_ROWGATE); int* panel = (int*)(misc + MS_PANEL);

    if (IN(PH_PRO)) {
        int itb = 0;
        for (int l = 0; l < 2; ++l) {
            convert_matrix(F, args.in[I_W_IN] + (size_t)l * D * INW, D, INW, WinT + (size_t)l * INW * D, 0, args.in[I_NORM_MIX] + l * D, 0, itb);
            convert_matrix(F, args.in[I_W_OUT] + (size_t)l * D * D, D, D, WoutT + (size_t)l * D * D, 0, nullptr, 0, itb);
        }
        convert_matrix(F, args.in[I_FFN_WG], D, FF, WguT, 1, args.in[I_NORM_FFN], 0, itb);
        convert_matrix(F, args.in[I_FFN_WU], D, FF, WguT, 2, args.in[I_NORM_FFN], 0, itb);
        convert_matrix(F, args.in[I_FFN_WD], FF, D, WdT, 0, nullptr, 0, itb);
        for (int m = F.gw; m < NTOK; m += F.NGW) {
            const GAS f32x4* xr = (const GAS f32x4*)(x_in + (size_t)m * D) + F.lane; GAS u32x2* o8 = (GAS u32x2*)(XB + (size_t)m * D) + F.lane; float s = 0.f;
#pragma unroll
            for (int j = 0; j < 4; ++j) { const f32x4 v = xr[64 * j]; s += (v.x * v.x + v.y * v.y) + (v.z * v.z + v.w * v.w); u32x2 w; w.x = pk2(v.x, v.y); w.y = pk2(v.z, v.w); o8[64 * j] = w; }
            s = wave_sum(s); if (F.lane == 0) ssq0[m] = s;
        }
    }
    SEAM(PH_PRO);

#define LAYER_MIXER(L, PH1, PHM, PH2, XBASE, SSQ_IN, NP_IN, SSQ_OUT, HAS_OUT) \
    if (IN(PH1)) { pg8::DenseSched S; S.init(XB, WinT + (size_t)(L) * INW * D, NTOK, INW, D, F.G, (int)blockIdx.x); \
        pg8::EpiScaleBf16<NP_IN> E{PB, INW, SSQ_IN}; pg8::gemm_phase(F.lds, D, S, E); } \
    SEAM(PH1); \
    if (IN(PHM)) { \
        gmlp_naive(F, PB, YB, args.in[I_GM_LN_W] + (L) * GMW, args.in[I_GM_LN_B] + (L) * GMW, args.in[I_GM_WS] + (size_t)(L) * NH * GCH * GCH, args.in[I_GM_BS] + (L) * NH * GCH); \
        rwkv_naive(F, PB, YB, args.in[I_SHIFT_MU] + (L) * 1792, args.in[I_RW_W_UP] + (L) * 64 * RWW, args.in[I_RW_W0] + (L) * RWW, args.in[I_RW_A_UP] + (L) * 64 * RWW, args.in[I_RW_A0] + (L) * RWW, \
                   args.in[I_RW_G_UP] + (L) * 128 * RWW, args.in[I_RW_K_K] + (L) * RWW, args.in[I_RW_K_A] + (L) * RWW, args.in[I_RW_R_K] + (L) * RWW, args.in[I_RW_LNX_W] + (L) * RWW, args.in[I_RW_LNX_B] + (L) * RWW); } \
    SEAM(PHM); \
    if (IN(PH2)) { pg8::DenseSched S; S.init(YB, WoutT + (size_t)(L) * D * D, NTOK, D, D, F.G, (int)blockIdx.x); \
        pg8::EpiResid<HAS_OUT> E{XBASE, xres, XB, SSQ_OUT}; pg8::gemm_phase(F.lds, D, S, E); } \
    SEAM(PH2);

    LAYER_MIXER(0, PH_G1_0, PH_MIX_0, PH_G2_0, x_in, ssq0, 1, ssq1, true)

    if (IN(PH_G3_0)) { pg8::DenseSched S; S.init(XB, WguT, NTOK, 2 * FF, D, F.G, (int)blockIdx.x);
        pg8::EpiSwiglu<16> E{HB, FF, ssq1}; pg8::gemm_phase(F.lds, D, S, E); }
    SEAM(PH_G3_0);
    if (IN(PH_G4_0)) { pg8::DenseSched S; S.init(HB, WdT, NTOK, D, FF, F.G, (int)blockIdx.x);
        pg8::EpiResid<true> E{xres, xres, XB, ssq2}; pg8::gemm_phase(F.lds, FF, S, E); }
    SEAM(PH_G4_0);

    LAYER_MIXER(1, PH_G1_1, PH_MIX_1, PH_G2_1, xres, ssq2, 16, nullptr, false)

    if (IN(PH_CV)) {
        int itb = 0; const float* gain = args.in[I_NORM_FFN] + D;
        for (int e = 0; e < NE; ++e) {
            convert_matrix(F, args.in[I_MOE_WG] + (size_t)e * D * FFE, D, FFE, MWgu + (size_t)e * 2 * FFE * D, 1, gain, 0, itb);
            convert_matrix(F, args.in[I_MOE_WU] + (size_t)e * D * FFE, D, FFE, MWgu + (size_t)e * 2 * FFE * D, 2, gain, 0, itb);
            convert_matrix(F, args.in[I_MOE_WD] + (size_t)e * FFE * D, FFE, D, MWd + (size_t)e * D * FFE, 0, nullptr, 0, itb);
        }
        __syncthreads();
        LAS float* RW = (LAS float*)F.lds; LAS int* cnt = (LAS int*)(F.lds + 32768);
        for (int i = F.tid; i < D * NE; i += 512) RW[i] = args.in[I_MOE_ROUTER][i] * gain[i >> 3];
        for (size_t i = (size_t)blockIdx.x * 512 + F.tid; i < (size_t)2 * MAXPAN * 256; i += (size_t)F.G * 512) { row_tok[i] = -1; row_gate[i] = 0.f; }
        __syncthreads();
        for (int vb = blockIdx.x; vb < 256; vb += F.G) {
            if (F.tid < 16) cnt[F.tid] = 0;
            __syncthreads();
            for (int i = 0; i < 16; ++i) { const int m = vb * 128 + F.wave * 16 + i;
                const GAS f32x4* xr = (const GAS f32x4*)(xres + (size_t)m * D) + F.lane; float s = 0.f; float lg[8];
#pragma unroll
                for (int e = 0; e < 8; ++e) lg[e] = 0.f;
#pragma unroll
                for (int j = 0; j < 4; ++j) { const f32x4 v = xr[64 * j]; s += (v.x * v.x + v.y * v.y) + (v.z * v.z + v.w * v.w);
                    const int k0 = 256 * j + 4 * F.lane;
#pragma unroll
                    for (int q = 0; q < 4; ++q) { const float xv = v[q]; const LAS f32x4* rw = (const LAS f32x4*)(RW + (k0 + q) * 8); const f32x4 r0 = rw[0], r1 = rw[1];
                        lg[0] += xv * r0.x; lg[1] += xv * r0.y; lg[2] += xv * r0.z; lg[3] += xv * r0.w; lg[4] += xv * r1.x; lg[5] += xv * r1.y; lg[6] += xv * r1.z; lg[7] += xv * r1.w; } }
                s = wave_sum(s);
#pragma unroll
                for (int e = 0; e < 8; ++e) lg[e] = wave_sum(lg[e]);
                const float rs = 1.0f / sqrtf(s * (1.0f / D) + RMS_EPS);
                if (F.lane == 0) {
                    int i1 = 0; float v1 = lg[0];
#pragma unroll
                    for (int e = 1; e < 8; ++e) if (lg[e] > v1) { v1 = lg[e]; i1 = e; }
                    int i2 = -1; float v2 = -3.0e38f;
#pragma unroll
                    for (int e = 0; e < 8; ++e) if (e != i1 && lg[e] > v2) { v2 = lg[e]; i2 = e; }
                    const float g1 = 1.0f / (1.0f + __expf((v2 - v1) * rs)), g2 = 1.0f - g1;
                    tok_e[2 * m] = i1; tok_e[2 * m + 1] = i2; tok_g[2 * m] = g1; tok_g[2 * m + 1] = g2; rs_moe[m] = rs;
                    __hip_atomic_fetch_add(&cnt[i1], 1, __ATOMIC_RELAXED, __HIP_MEMORY_SCOPE_WORKGROUP); __hip_atomic_fetch_add(&cnt[8 + i2], 1, __ATOMIC_RELAXED, __HIP_MEMORY_SCOPE_WORKGROUP);
                } }
            __syncthreads();
            if (F.tid < 16) bcnt[vb * 16 + F.tid] = cnt[F.tid];
            __syncthreads();
        }
    }
    SEAM(PH_CV);

    if (IN(PH_R2)) {
        LAS int* tot = (LAS int*)F.lds;
        for (int vb = blockIdx.x; vb < 256; vb += F.G) {
            if (F.tid < 16) { int t = 0, mine = 0; for (int b2 = 0; b2 < 256; ++b2) { const int c = bcnt[b2 * 16 + F.tid]; if (b2 < vb) mine += c; t += c; } tot[F.tid] = t; tot[32 + F.tid] = mine; }
            __syncthreads();
            if (F.tid < 2) { int ps = 0; for (int e = 0; e < 8; ++e) { tot[16 + F.tid * 8 + e] = ps; ps += (tot[F.tid * 8 + e] + 255) / 256; }
                if (vb == 0) { panel[F.tid * 160] = ps; for (int e = 0; e < 8; ++e) { const int np = (tot[F.tid * 8 + e] + 255) / 256; for (int q = 0; q < np; ++q) panel[F.tid * 160 + 16 + tot[16 + F.tid * 8 + e] + q] = e; } } }
            __syncthreads();
            if (F.tid < 16) { const int set = F.tid >> 3, e = F.tid & 7; int slot = tot[16 + F.tid] * 256 + tot[32 + F.tid];
                for (int r = 0; r < 128; ++r) { const int m = vb * 128 + r; if (tok_e[2 * m + set] == e) { row_tok[set * MAXPAN * 256 + slot] = m; row_gate[set * MAXPAN * 256 + slot] = tok_g[2 * m + set]; ++slot; } } }
            __syncthreads();
        }
    }
    SEAM(PH_R2);

#define MOE_SET(SET, PHGU, PHDN) \
    if (IN(PHGU)) { const int np = __builtin_amdgcn_readfirstlane(panel[(SET) * 160]); pg8::MoeSched<true> S; \
        S.init(XB, MWgu, np, 2 * FFE, D, panel + (SET) * 160 + 16, row_tok + (SET) * MAXPAN * 256, F.G, (int)blockIdx.x); \
        pg8::EpiSwigluMoe E{MH, FFE, rs_moe, row_tok + (SET) * MAXPAN * 256}; pg8::gemm_phase(F.lds, D, S, E); } \
    SEAM(PHGU); \
    if (IN(PHDN)) { const int np = __builtin_amdgcn_readfirstlane(panel[(SET) * 160]); pg8::MoeSched<false> S; \
        S.init(MH, MWd, np, D, FFE, panel + (SET) * 160 + 16, row_tok + (SET) * MAXPAN * 256, F.G, (int)blockIdx.x); \
        pg8::EpiMoeDown E{xres, row_tok + (SET) * MAXPAN * 256, row_gate + (SET) * MAXPAN * 256}; pg8::gemm_phase(F.lds, FFE, S, E); } \
    SEAM(PHDN);
    MOE_SET(0, PH_GU_A, PH_DN_A)
    MOE_SET(1, PH_GU_B, PH_DN_B)

    if (IN(PH_FIN)) {
        const float* gf = args.in[I_NORM_FINAL];
        for (int m = F.gw; m < NTOK; m += F.NGW) {
            GAS f32x4* xr = (GAS f32x4*)(xres + (size_t)m * D) + F.lane; f32x4 v[4]; float s = 0.f;
#pragma unroll
            for (int j = 0; j < 4; ++j) { v[j] = xr[64 * j]; s += (v[j].x * v[j].x + v[j].y * v[j].y) + (v[j].z * v[j].z + v[j].w * v[j].w); }
            const float rs = 1.0f / sqrtf(wave_sum(s) * (1.0f / D) + RMS_EPS);
#pragma unroll
            for (int j = 0; j < 4; ++j) { const f32x4 g = *((const f32x4*)gf + F.lane + 64 * j); xr[64 * j] = v[j] * rs * g; }
        }
    }
#undef IN
#undef SEAM
}

extern "C" void kernel_launch(void* const* d_in, const int* in_sizes, int n_in, void* d_out, int out_size, void* d_ws, size_t ws_size, hipStream_t stream) {
    static int grid = 0;
    if (grid == 0) {
        if (n_in != NIN || in_sizes[0] != NTOK * D || out_size != NTOK * D || ws_size < WS_END) {
            fprintf(stderr, "kernel_launch: unexpected shapes: n_in %d in0 %d out %d ws %zu (need %zu); nothing launched\n", n_in, n_in > 0 ? in_sizes[0] : -1, out_size, ws_size, (size_t)WS_END); grid = -1; return; }
        int dev = 0, cus = 0, per_cu = 0;
        if (hipGetDevice(&dev) != hipSuccess || hipDeviceGetAttribute(&cus, hipDeviceAttributeMultiprocessorCount, dev) != hipSuccess) { grid = -1; return; }
        if (hipFuncSetAttribute((const void*)fwd, hipFuncAttributeMaxDynamicSharedMemorySize, LDS_BYTES) != hipSuccess) { fprintf(stderr, "kernel_launch: hipFuncSetAttribute failed\n"); grid = -1; return; }
        if (hipOccupancyMaxActiveBlocksPerMultiprocessor(&per_cu, (const void*)fwd, 512, LDS_BYTES) != hipSuccess || per_cu < 1) { fprintf(stderr, "kernel_launch: occupancy query says %d\n", per_cu); }
        (void)hipGetLastError();
        grid = cus;
    }
    if (grid < 0) return;
    if (hipMemsetAsync((char*)d_ws + WS_CTL, 0, CTL_ZERO_BYTES, stream) != hipSuccess) return;
    Args a{};
    for (int i = 0; i < NIN; ++i) a.in[i] = (const float*)d_in[i];
    a.out = (float*)d_out; a.ws = (unsigned char*)d_ws;
#if MK_PER_PHASE
    for (int ph = 0; ph < PH_COUNT; ++ph) { a.ph_lo = ph; a.ph_hi = ph + 1; hipLaunchKernelGGL(fwd, dim3(grid), dim3(512), LDS_BYTES, stream, a); }
#else
    a.ph_lo = 0; a.ph_hi = PH_COUNT; hipLaunchKernelGGL(fwd, dim3(grid), dim3(512), LDS_BYTES, stream, a);
#endif
}
```

```cpp
#include <hip/hip_runtime.h>
#include <cstdio>
#include <cstdint>

#ifndef MK_PER_PHASE
#define MK_PER_PHASE 0
#endif

#ifndef DBG_VAR
#define DBG_VAR 0
#endif
#ifndef MIX_MODE
#define MIX_MODE 0
#endif
#define GAS __attribute__((address_space(1)))
#define LAS __attribute__((address_space(3)))
typedef unsigned short bf16;
typedef unsigned short bf16_t;
typedef short bf16x8 __attribute__((ext_vector_type(8)));
typedef float f32x4 __attribute__((ext_vector_type(4)));
typedef float f32x2 __attribute__((ext_vector_type(2)));
typedef unsigned u32x4 __attribute__((ext_vector_type(4)));
typedef unsigned u32x2 __attribute__((ext_vector_type(2)));
typedef GAS unsigned gu32;

constexpr int NTOK = 32768, SEQ = 4096, NB = 8, D = 1024, INW = 2816, FF = 2816, FFE = 3584, NE = 8;
constexpr int GMW = 512, RWW = 512, NH = 8, HD = 64, GCH = 128;
constexpr float RMS_EPS = 1e-6f, LN_EPS = 1e-5f, GN_EPS = 64e-5f;
constexpr int MAXPAN = 136;

constexpr size_t MiB = 1u << 20;
constexpr size_t WS_CTL = 0, CTL_ZERO_BYTES = 2 * MiB;
constexpr size_t WS_WIN = 2 * MiB;
constexpr size_t WS_WOUT = 13 * MiB;
constexpr size_t WS_WGU = 17 * MiB;
constexpr size_t WS_WD = 28 * MiB;
constexpr size_t WS_MISC = 34 * MiB;
constexpr size_t WS_SMALLW = 36 * MiB;
constexpr size_t SW_WUP = 0, SW_AUP = 128 * 1024, SW_GUP = 256 * 1024, SW_WS = 512 * 1024;
constexpr size_t WS_XB = 38 * MiB;
constexpr size_t WS_R = 102 * MiB;
constexpr size_t WS_P = WS_R;
constexpr size_t WS_Y = WS_R + 176 * MiB;
constexpr size_t WS_SCR = WS_R + 240 * MiB;
constexpr size_t WS_MOEW_GU = WS_R;
constexpr size_t WS_MOEW_D = WS_R + 112 * MiB;
constexpr size_t WS_MOEH = WS_R + 168 * MiB;
constexpr size_t WS_SSQP = WS_R + 400 * MiB;
constexpr size_t WS_END = WS_R + 408 * MiB;
static_assert(WS_MOEH + (size_t)MAXPAN * 256 * FFE * 2 <= WS_END, "moe hidden fits");
static_assert(WS_WIN + (size_t)2 * INW * D * 2 <= WS_WOUT && WS_WGU + (size_t)2 * FF * D * 2 <= WS_WD && WS_WD + (size_t)D * FF * 2 <= WS_MISC, "weights fit");
constexpr int CW_TMO = 0;
constexpr int CW_BAR = 4096;
constexpr int CW_SSQ = 65536;
static_assert((CW_SSQ + 4 * NTOK) * 4 <= (int)CTL_ZERO_BYTES, "ctl fits");
constexpr size_t MS_TOKE = 0;
constexpr size_t MS_TOKG = 256 * 1024;
constexpr size_t MS_RS = 512 * 1024;
constexpr size_t MS_BCNT = 640 * 1024;
constexpr size_t MS_ROWTOK = 704 * 1024;
constexpr size_t MS_ROWGATE = 1024 * 1024;
constexpr size_t MS_PANEL = 1344 * 1024;
static_assert(MS_ROWTOK + 2 * MAXPAN * 256 * 4 <= MS_ROWGATE && MS_ROWGATE + 2 * MAXPAN * 256 * 4 <= MS_PANEL && MS_PANEL + 2 * 160 * 4 <= 2 * MiB, "misc fits");

constexpr int RING_BYTES = 131072;
constexpr int LDS_BYTES = 147456;
constexpr int MISC_OFF = LDS_BYTES - 128;

#define LDS_WAIT() asm volatile("s_waitcnt lgkmcnt(0)" ::: "memory")
#define VM_WAIT() asm volatile("s_waitcnt vmcnt(0)" ::: "memory")
#define RLX_AGENT __ATOMIC_RELAXED, __HIP_MEMORY_SCOPE_AGENT

__device__ __forceinline__ unsigned f2bf(float f) { unsigned u = __builtin_bit_cast(unsigned, f); return (u + 0x7fffu + ((u >> 16) & 1u)) >> 16; }
__device__ __forceinline__ unsigned pk2(float lo, float hi) { return f2bf(lo) | (f2bf(hi) << 16); }
__device__ __forceinline__ float bf2f(bf16 b) { return __builtin_bit_cast(float, (unsigned)b << 16); }
__device__ __forceinline__ unsigned cvt_pk_bf16(float lo, float hi) { unsigned r; asm volatile("v_cvt_pk_bf16_f32 %0, %1, %2" : "=v"(r) : "v"(lo), "v"(hi)); return r; }
__device__ __forceinline__ float wave_sum(float v) {
#pragma unroll
    for (int o = 1; o < 64; o <<= 1) v += __shfl_xor(v, o);
    return v;
}
__device__ __forceinline__ float gelu_erf(float v) { return 0.5f * v * (1.0f + erff(v * 0.70710678f)); }
__device__ __forceinline__ float sigmoidf_(float v) { return 1.0f / (1.0f + __expf(-v)); }
__device__ __forceinline__ float silu_f(float v) { return v * __builtin_amdgcn_rcpf(1.0f + __expf(-v)); }

namespace pg8 {
constexpr int BM = 256, BK = 64, HALF = 128, HTB = HALF * BK * 2, STAGE_BYTES = 8 * HTB, NXCD = 8, WGM = 8;
__host__ __device__ __forceinline__ int lds_byte(int r, int c) { const int st = (r >> 4) * 2 + (c >> 5), rr = r & 15, cc = c & 31, ob = rr * 64 + cc * 2; return st * 1024 + (ob ^ (((ob >> 9) & 1) << 5)); }
__host__ __device__ __forceinline__ void stage_rc(int b, int& R, int& C) { const int st = b / 1024, sb = b % 1024, swz = sb ^ (((sb >> 9) & 1) << 5); R = (st >> 1) * 16 + swz / 64; C = (st & 1) * 32 + (swz % 64) / 2; }
__host__ __device__ __forceinline__ int perm32(int rho) { const int n = rho >> 4, i = rho & 15; return 8 * (i >> 2) + 4 * n + (i & 3); }

struct Unit { int pm, pn, aux; };

struct TileOrder {
    int nM, nN, nwg, G, c;
    __device__ void init(int nM_, int nN_, int G_, int c_) { nM = nM_; nN = nN_; nwg = nM * nN; G = G_; c = c_; }
    __device__ bool tile(int i, int& pm, int& pn) const {
        const long L = (long)i * G + c; if (L >= nwg) return false;
        int wgid = (int)L; { const int q = nwg / NXCD, r = nwg % NXCD, xcd = wgid % NXCD, off = wgid / NXCD; wgid = (xcd < r ? xcd * (q + 1) : r * (q + 1) + (xcd - r) * q) + off; }
        const int nig = WGM * nN, gid = wgid / nig, fm = gid * WGM, gsz = (nM - fm) < WGM ? (nM - fm) : WGM;
        pm = fm + ((wgid % nig) % gsz); pn = (wgid % nig) / gsz; return true;
    }
};
struct DenseSched {
    static constexpr bool GATHER = false;
    TileOrder T; const char* A; const char* Bt; size_t tstep;
    __device__ void init(const bf16_t* A_, const bf16_t* Bt_, int M, int N, int K, int G, int c) { T.init(M / BM, N / BM, G, c); A = (const char*)A_; Bt = (const char*)Bt_; tstep = (size_t)BM * K * 2; }
    __device__ __forceinline__ bool next(int i, Unit& u) const { u.aux = 0; return T.tile(i, u.pm, u.pn); }
    __device__ __forceinline__ const char* a_ptr(const Unit& u) const { return A + (size_t)u.pm * tstep; }
    __device__ __forceinline__ const char* b_ptr(const Unit& u) const { return Bt + (size_t)u.pn * tstep; }
    __device__ __forceinline__ void gather(const Unit&, int, int, int, int, int, unsigned (&)[2][2]) const {}
};
template <bool GATHER_> struct MoeSched {
    static constexpr bool GATHER = GATHER_;
    TileOrder T; const char* A; const char* Bt; size_t a_tstep, b_tstep, b_estep; const int* pexp; const int* row_tok; int K;
    __device__ void init(const bf16_t* A_, const bf16_t* Bt_, int npanels, int N, int K_, const int* pexp_, const int* row_tok_, int G, int c) {
        T.init(npanels, N / BM, G, c); A = (const char*)A_; Bt = (const char*)Bt_; K = K_; a_tstep = (size_t)BM * K_ * 2; b_tstep = (size_t)BM * K_ * 2; b_estep = (size_t)N * K_ * 2; pexp = pexp_; row_tok = row_tok_; }
    __device__ __forceinline__ bool next(int i, Unit& u) const { if (!T.tile(i, u.pm, u.pn)) return false; u.aux = __builtin_amdgcn_readfirstlane(pexp[u.pm]); return true; }
    __device__ __forceinline__ const char* a_ptr(const Unit& u) const { return GATHER ? A : A + (size_t)u.pm * a_tstep; }
    __device__ __forceinline__ const char* b_ptr(const Unit& u) const { return Bt + (size_t)u.aux * b_estep + (size_t)u.pn * b_tstep; }
    __device__ __forceinline__ void gather(const Unit& u, int R0, int R1, int C0, int C1, int, unsigned (&v)[2][2]) const {
#pragma unroll
        for (int h = 0; h < 2; ++h) { int t0 = row_tok[u.pm * BM + h * HALF + R0], t1 = row_tok[u.pm * BM + h * HALF + R1]; t0 = t0 < 0 ? 0 : t0; t1 = t1 < 0 ? 0 : t1;
            v[h][0] = (unsigned)(t0 * K + C0) * 2u; v[h][1] = (unsigned)(t1 * K + C1) * 2u; }
    }
};

template <class Epi, class Sched>
__device__ __forceinline__ void gemm_phase(LAS unsigned char* lds, const int K, const Sched& S, const Epi& E) {
    constexpr bool GATHER = Sched::GATHER;
    const int tid = threadIdx.x, wid = __builtin_amdgcn_readfirstlane(tid >> 6), lane = tid & 63, wr = wid >> 2, wc = wid & 3, fr = lane & 15, fq = lane >> 4;
    const int nt = K / BK;
    unsigned voffA[2], voffB[2]; int sR[2], sC[2];
#pragma unroll
    for (int i = 0; i < 2; ++i) { int R, C; stage_rc(tid * 16 + i * 8192, R, C); const int Rb = Epi::PERM ? ((R & ~31) + perm32(R & 31)) : R; sR[i] = R; sC[i] = C;
        voffA[i] = (unsigned)(R * K + C) * 2u; voffB[i] = (unsigned)(Rb * K + C) * 2u; }
    const size_t kstep = (size_t)(BK * 2);
    const size_t hstep = (size_t)HALF * K * 2;
    const unsigned ldsw = (unsigned)wid * 1024u;
    const int aoff = lds_byte(wr * 64 + fr, fq * 8), boff = lds_byte(wc * 32 + fr, fq * 8);
#define PG8_SA(b, h) (((b) * 2 + (h)) * HTB)
#define PG8_SB(b, h) ((4 + (b) * 2 + (h)) * HTB)
#define PG8_STAGE(bufoff, gbase, voff) do { _Pragma("unroll") for (int _i = 0; _i < 2; ++_i) \
        __builtin_amdgcn_global_load_lds((const unsigned*)((const char*)(gbase) + (voff)[_i]), (LAS unsigned*)(lds + (bufoff) + ldsw + _i * 8192), 16, 0, 0); } while (0)
#define PG8_STAGE_A(bufoff, kptr, half, VG) do { if constexpr (GATHER) { PG8_STAGE(bufoff, kptr, (VG)[half]); } else { PG8_STAGE(bufoff, (kptr) + (half) * hstep, voffA); } } while (0)
#define PG8_LDA(dst, b, h) do { _Pragma("unroll") for (int m = 0; m < 4; ++m) _Pragma("unroll") for (int k = 0; k < 2; ++k) dst[m][k] = *(const LAS bf16x8*)(lds + PG8_SA(b, h) + aoff + m * 2048 + k * 1024); } while (0)
#define PG8_LDB(dst, b, h) do { _Pragma("unroll") for (int n = 0; n < 2; ++n) _Pragma("unroll") for (int k = 0; k < 2; ++k) dst[n][k] = *(const LAS bf16x8*)(lds + PG8_SB(b, h) + boff + n * 2048 + k * 1024); } while (0)
#define PG8_MMA(ai, bj, At, Bt) do { __builtin_amdgcn_s_setprio(1); _Pragma("unroll") for (int m = 0; m < 4; ++m) _Pragma("unroll") for (int n = 0; n < 2; ++n) _Pragma("unroll") for (int k = 0; k < 2; ++k) \
        acc[ai][bj][m][n] = __builtin_amdgcn_mfma_f32_16x16x32_bf16(Bt[n][k], At[m][k], acc[ai][bj][m][n], 0, 0, 0); __builtin_amdgcn_s_setprio(0); } while (0)
#define PG8_WAIT_V(n) asm volatile("s_waitcnt vmcnt(" #n ")" ::: "memory")
#define PG8_WAIT_L(n) asm volatile("s_waitcnt lgkmcnt(" #n ")" ::: "memory")
#define PG8_BAR __builtin_amdgcn_s_barrier()
#define PG8_SCHED __builtin_amdgcn_sched_barrier(0)
    Unit cur, nxt; int ui = 0;
    if (!S.next(0, cur)) return;
    f32x4 acc[2][2][4][2];
#pragma unroll
    for (int a = 0; a < 2; ++a)
#pragma unroll
        for (int b = 0; b < 2; ++b)
#pragma unroll
            for (int m = 0; m < 4; ++m)
#pragma unroll
                for (int n = 0; n < 2; ++n) acc[a][b][m][n] = (f32x4){0.f, 0.f, 0.f, 0.f};
    bf16x8 At[4][2], B0[2][2], B1[2][2];
    const char* cA = S.a_ptr(cur); const char* cB = S.b_ptr(cur);
    unsigned vcur[2][2] = {{0u, 0u}, {0u, 0u}}, vnext[2][2] = {{0u, 0u}, {0u, 0u}}, vt2[2][2] = {{0u, 0u}, {0u, 0u}};
    if constexpr (GATHER) S.gather(cur, sR[0], sR[1], sC[0], sC[1], 0, vcur);
    PG8_STAGE(PG8_SB(0, 0), cB, voffB); PG8_STAGE(PG8_SB(0, 1), cB + hstep, voffB); PG8_STAGE_A(PG8_SA(0, 0), cA, 0, vcur); PG8_STAGE_A(PG8_SA(0, 1), cA, 1, vcur);
    if (wr == 1) PG8_BAR;
    PG8_WAIT_V(2); PG8_BAR;
    PG8_STAGE(PG8_SB(1, 0), cB + kstep, voffB); PG8_STAGE_A(PG8_SA(1, 0), cA + kstep, 0, vcur); PG8_STAGE(PG8_SB(1, 1), cB + hstep + kstep, voffB);
    PG8_WAIT_V(6); PG8_BAR;
    for (;;) {
        const bool has_next = S.next(ui + 1, nxt);
        const char* nA = has_next ? S.a_ptr(nxt) : cA; const char* nB = has_next ? S.b_ptr(nxt) : cB;
        if constexpr (GATHER) { if (has_next) S.gather(nxt, sR[0], sR[1], sC[0], sC[1], 0, vnext); else {
#pragma unroll
            for (int h = 0; h < 2; ++h) { vnext[h][0] = vcur[h][0]; vnext[h][1] = vcur[h][1]; } } }
        for (int t = 0; t < nt; t += 2) {
            const bool last = (t == nt - 2);
            const char* a1 = cA + (size_t)(t + 1) * kstep;
            const char* a2 = last ? nA : cA + (size_t)(t + 2) * kstep; const char* b2 = last ? nB : cB + (size_t)(t + 2) * kstep;
            const char* a3 = a2 + kstep; const char* b3 = b2 + kstep;
            if constexpr (GATHER) {
#pragma unroll
                for (int h = 0; h < 2; ++h) { vt2[h][0] = last ? vnext[h][0] : vcur[h][0]; vt2[h][1] = last ? vnext[h][1] : vcur[h][1]; } }
            PG8_LDB(B0, 0, 0); PG8_LDB(B1, 0, 1); PG8_SCHED; PG8_LDA(At, 0, 0); PG8_STAGE_A(PG8_SA(1, 1), a1, 1, vcur);
            PG8_WAIT_V(8); PG8_WAIT_L(0); PG8_BAR; PG8_MMA(0, 0, At, B0); PG8_MMA(0, 1, At, B1); PG8_BAR; PG8_SCHED;
            PG8_LDA(At, 0, 1); PG8_STAGE(PG8_SB(0, 0), b2, voffB); PG8_STAGE(PG8_SB(0, 1), b2 + hstep, voffB); PG8_STAGE_A(PG8_SA(0, 0), a2, 0, vt2);
            PG8_WAIT_V(8); PG8_WAIT_L(0); PG8_BAR; PG8_MMA(1, 0, At, B0); PG8_MMA(1, 1, At, B1); PG8_BAR; PG8_SCHED;
            PG8_LDB(B0, 1, 0); PG8_LDB(B1, 1, 1); PG8_SCHED; PG8_LDA(At, 1, 0); PG8_STAGE_A(PG8_SA(0, 1), a2, 1, vt2);
            PG8_WAIT_V(8); PG8_WAIT_L(0); PG8_BAR; PG8_MMA(0, 0, At, B0); PG8_MMA(0, 1, At, B1); PG8_BAR; PG8_SCHED;
            PG8_LDA(At, 1, 1); PG8_STAGE(PG8_SB(1, 0), b3, voffB); PG8_STAGE(PG8_SB(1, 1), b3 + hstep, voffB); PG8_STAGE_A(PG8_SA(1, 0), a3, 0, vt2);
            PG8_WAIT_V(8); PG8_WAIT_L(0); PG8_BAR; PG8_MMA(1, 0, At, B0); PG8_MMA(1, 1, At, B1); PG8_BAR; PG8_SCHED;
        }
        if (wr == 0) PG8_BAR;
        E(acc, cur, wr, wc, fr, fq);
        if (!has_next) break;
#pragma unroll
        for (int a = 0; a < 2; ++a)
#pragma unroll
            for (int b = 0; b < 2; ++b)
#pragma unroll
                for (int m = 0; m < 4; ++m)
#pragma unroll
                    for (int n = 0; n < 2; ++n) acc[a][b][m][n] = (f32x4){0.f, 0.f, 0.f, 0.f};
        cur = nxt; cA = nA; cB = nB; ++ui;
        if constexpr (GATHER) {
#pragma unroll
            for (int h = 0; h < 2; ++h) { vcur[h][0] = vnext[h][0]; vcur[h][1] = vnext[h][1]; } }
        if (wr == 1) PG8_BAR;
    }
    PG8_WAIT_V(0);
    PG8_BAR;
#undef PG8_SA
#undef PG8_SB
#undef PG8_STAGE
#undef PG8_STAGE_A
#undef PG8_LDA
#undef PG8_LDB
#undef PG8_MMA
#undef PG8_WAIT_V
#undef PG8_WAIT_L
#undef PG8_BAR
#undef PG8_SCHED
}

template <int NP> __device__ __forceinline__ float row_rs(const float* ssq, int row) {
    float s;
    if constexpr (NP == 1) s = ssq[row];
    else { const f32x4* p = (const f32x4*)(ssq + (size_t)row * 16); const f32x4 a = p[0], b = p[1], c = p[2], d = p[3];
        s = (((a[0] + a[1]) + (a[2] + a[3])) + ((b[0] + b[1]) + (b[2] + b[3]))) + (((c[0] + c[1]) + (c[2] + c[3])) + ((d[0] + d[1]) + (d[2] + d[3]))); }
    return __builtin_amdgcn_rsqf(s * (1.0f / D) + RMS_EPS);
}
template <int NP> struct EpiScaleBf16 {
    static constexpr bool PERM = true;
    bf16_t* O; int ldc; const float* ssq;
    __device__ __forceinline__ void operator()(const f32x4 (&acc)[2][2][4][2], const Unit& u, int wr, int wc, int fr, int fq) const {
        const int row0 = u.pm * BM + wr * 64 + fr, col0 = u.pn * BM + wc * 32 + 8 * fq;
#pragma unroll
        for (int ai = 0; ai < 2; ++ai)
#pragma unroll
            for (int m = 0; m < 4; ++m) { const int row = row0 + ai * HALF + m * 16; const float rs = row_rs<NP>(ssq, row);
                bf16_t* rowp = O + (size_t)row * ldc + col0;
#pragma unroll
                for (int bj = 0; bj < 2; ++bj) { const f32x4 v0 = acc[ai][bj][m][0] * rs, v1 = acc[ai][bj][m][1] * rs;
                    u32x4 w; w.x = cvt_pk_bf16(v0[0], v0[1]); w.y = cvt_pk_bf16(v0[2], v0[3]); w.z = cvt_pk_bf16(v1[0], v1[1]); w.w = cvt_pk_bf16(v1[2], v1[3]);
                    *(u32x4*)(rowp + bj * HALF) = w; } }
    }
};
template <bool SSQ> struct EpiResid {
    static constexpr bool PERM = false;
    const float* base; float* out; bf16_t* xb; float* ssq;
    __device__ __forceinline__ void operator()(const f32x4 (&acc)[2][2][4][2], const Unit& u, int wr, int wc, int fr, int fq) const {
        const int row0 = u.pm * BM + wr * 64 + fr, col0 = u.pn * BM + wc * 32 + 4 * fq;
#pragma unroll
        for (int ai = 0; ai < 2; ++ai)
#pragma unroll
            for (int m = 0; m < 4; ++m) { const int row = row0 + ai * HALF + m * 16; const size_t off = (size_t)row * D + col0; float s = 0.f;
#pragma unroll
                for (int bj = 0; bj < 2; ++bj)
#pragma unroll
                    for (int n = 0; n < 2; ++n) { const f32x4 o = *(const f32x4*)(base + off + bj * HALF + n * 16) + acc[ai][bj][m][n];
                        *(f32x4*)(out + off + bj * HALF + n * 16) = o; u32x2 w; w.x = cvt_pk_bf16(o[0], o[1]); w.y = cvt_pk_bf16(o[2], o[3]);
                        *(u32x2*)(xb + off + bj * HALF + n * 16) = w; s += (o[0] * o[0] + o[1] * o[1]) + (o[2] * o[2] + o[3] * o[3]); }
                if constexpr (SSQ) { s += __shfl_xor(s, 16); s += __shfl_xor(s, 32);
                    if (fq == 0) ssq[(size_t)row * 16 + u.pn * 4 + wc] = s; }
                asm volatile("" ::: "memory"); }
    }
};
template <int NP> struct EpiSwiglu {
    static constexpr bool PERM = true;
    bf16_t* O; int ldc; const float* ssq;
    __device__ __forceinline__ void operator()(const f32x4 (&acc)[2][2][4][2], const Unit& u, int wr, int wc, int fr, int fq) const {
        const int row0 = u.pm * BM + wr * 64 + fr, col0 = u.pn * HALF + wc * 32 + 8 * fq;
#pragma unroll
        for (int ai = 0; ai < 2; ++ai)
#pragma unroll
            for (int m = 0; m < 4; ++m) { const int row = row0 + ai * HALF + m * 16; const float rs = row_rs<NP>(ssq, row);
                float h[8];
#pragma unroll
                for (int n = 0; n < 2; ++n)
#pragma unroll
                    for (int j = 0; j < 4; ++j) h[n * 4 + j] = silu_f(acc[ai][0][m][n][j] * rs) * (acc[ai][1][m][n][j] * rs);
                u32x4 w; w.x = cvt_pk_bf16(h[0], h[1]); w.y = cvt_pk_bf16(h[2], h[3]); w.z = cvt_pk_bf16(h[4], h[5]); w.w = cvt_pk_bf16(h[6], h[7]);
                *(u32x4*)(O + (size_t)row * ldc + col0) = w; }
    }
};
struct EpiSwigluMoe {
    static constexpr bool PERM = true;
    bf16_t* O; int ldc; const float* rsv; const int* row_tok;
    __device__ __forceinline__ void operator()(const f32x4 (&acc)[2][2][4][2], const Unit& u, int wr, int wc, int fr, int fq) const {
        const int row0 = u.pm * BM + wr * 64 + fr, col0 = u.pn * HALF + wc * 32 + 8 * fq;
#pragma unroll
        for (int ai = 0; ai < 2; ++ai)
#pragma unroll
            for (int m = 0; m < 4; ++m) { const int row = row0 + ai * HALF + m * 16; const int tok = row_tok[row]; const float rs = tok >= 0 ? rsv[tok] : 0.f;
                float h[8];
#pragma unroll
                for (int n = 0; n < 2; ++n)
#pragma unroll
                    for (int j = 0; j < 4; ++j) h[n * 4 + j] = silu_f(acc[ai][0][m][n][j] * rs) * (acc[ai][1][m][n][j] * rs);
                u32x4 w; w.x = cvt_pk_bf16(h[0], h[1]); w.y = cvt_pk_bf16(h[2], h[3]); w.z = cvt_pk_bf16(h[4], h[5]); w.w = cvt_pk_bf16(h[6], h[7]);
                *(u32x4*)(O + (size_t)row * ldc + col0) = w; }
    }
};
struct EpiMoeDown {
    static constexpr bool PERM = false;
    float* out; const int* row_tok; const float* row_gate;
    __device__ __forceinline__ void operator()(const f32x4 (&acc)[2][2][4][2], const Unit& u, int wr, int wc, int fr, int fq) const {
        const int row0 = u.pm * BM + wr * 64 + fr, col0 = u.pn * BM + wc * 32 + 4 * fq;
#pragma unroll
        for (int ai = 0; ai < 2; ++ai)
#pragma unroll
            for (int m = 0; m < 4; ++m) { const int row = row0 + ai * HALF + m * 16; const int tok = row_tok[row]; const float g = row_gate[row];
                if (tok >= 0) { float* rp = out + (size_t)tok * D + col0;
#pragma unroll
                    for (int bj = 0; bj < 2; ++bj)
#pragma unroll
                        for (int n = 0; n < 2; ++n) { f32x4* p = (f32x4*)(rp + bj * HALF + n * 16); *p = *p + acc[ai][bj][m][n] * g; } }
                asm volatile("" ::: "memory"); }
    }
};
}

#define XB_TMO      128
#define XB_XCNT(j)  (256  + 64 * (j))
#define XB_XSUB(j)  (1280 + 64 * (j))
#define XB_XGEN(j)  (2304 + 64 * (j))
#define XB_TOP      3328
#define XB_TOPGEN   3392
#define XCD_BAR_WORDS 3456
#define XB_SPIN_CAP (1u << 18)
__device__ __forceinline__ unsigned xb_ld(unsigned* p)              { return __hip_atomic_load(p, __ATOMIC_RELAXED, __HIP_MEMORY_SCOPE_AGENT); }
__device__ __forceinline__ unsigned xb_add(unsigned* p, unsigned v) { return __hip_atomic_fetch_add(p, v, __ATOMIC_RELAXED, __HIP_MEMORY_SCOPE_AGENT); }
__device__ __forceinline__ unsigned xb_xcc_id() { return (unsigned)__builtin_amdgcn_s_getreg((3 << 11) | 20) & 0xFu; }
#define XB_SPIN(cond, bar) do { unsigned _sp = 0; while (cond) { __builtin_amdgcn_s_sleep(1); \
    if ((++_sp & 255u) == 0u) { if (xb_ld(&(bar)[XB_TMO])) break; if (_sp > XB_SPIN_CAP) { atomicAdd(&(bar)[XB_TMO], 1u); break; } } } } while (0)
struct XcdBarrier { unsigned* bar; unsigned x; volatile LAS unsigned* st; };
__device__ __forceinline__ XcdBarrier xcd_barrier_post(unsigned* bar, volatile LAS unsigned* st) {
    XcdBarrier b; b.bar = bar; b.x = xb_xcc_id(); b.st = st;
    if (threadIdx.x == 0) (void)xb_add(&bar[XB_XCNT(b.x)], 1u);
    return b;
}
__device__ __forceinline__ void xcd_barrier_complete(unsigned* bar, unsigned x, unsigned& nloc, unsigned& nx) {
    const unsigned G = gridDim.x * gridDim.y * gridDim.z;
    unsigned sum, cnt, mine, sp = 0u;
    for (;;) {
        sum = 0u; cnt = 0u; mine = 0u;
#pragma unroll
        for (unsigned j = 0; j < 16; ++j) { const unsigned c = xb_ld(&bar[XB_XCNT(j)]); sum += c; cnt += (c > 0u) ? 1u : 0u; mine = (j == x) ? c : mine; }
        if (sum == G) break;
        __builtin_amdgcn_s_sleep(1);
        if ((++sp & 255u) == 0u) { if (xb_ld(&bar[XB_TMO])) break; if (sp > XB_SPIN_CAP) { atomicAdd(&bar[XB_TMO], 1u); break; } }
    }
    nloc = mine > 0u ? mine : 1u; nx = cnt > 0u ? cnt : 1u;
}
__device__ __forceinline__ void xcd_barrier(const XcdBarrier& b) {
    asm volatile("s_waitcnt vmcnt(0)" ::: "memory");
    __syncthreads();
    if (threadIdx.x == 0) {
        unsigned* bar = b.bar;
        __builtin_amdgcn_s_waitcnt(0);
        unsigned nloc = b.st[0], nx = b.st[1];
        if (nloc == 0u) { xcd_barrier_complete(bar, b.x, nloc, nx); b.st[0] = nloc; b.st[1] = nx; }
        const unsigned old = xb_add(&bar[XB_XSUB(b.x)], 1u);
        const unsigned gen = old / nloc;
        if (old + 1u == (gen + 1u) * nloc) {
            __builtin_amdgcn_fence(__ATOMIC_RELEASE, "agent");
            asm volatile("s_waitcnt vmcnt(0)" ::: "memory");
            const unsigned og = xb_add(&bar[XB_TOP], 1u);
            const unsigned tg = og / nx;
            if (og + 1u == (tg + 1u) * nx) xb_add(&bar[XB_TOPGEN], 1u);
            else XB_SPIN(xb_ld(&bar[XB_TOPGEN]) == tg, bar);
            __builtin_amdgcn_fence(__ATOMIC_ACQUIRE, "agent");
            xb_add(&bar[XB_XGEN(b.x)], 1u);
            asm volatile("s_waitcnt vmcnt(0)" ::: "memory");
        } else {
            XB_SPIN(xb_ld(&bar[XB_XGEN(b.x)]) == gen, bar);
            __builtin_amdgcn_fence(__ATOMIC_ACQUIRE, "agent");
            asm volatile("s_waitcnt vmcnt(0)" ::: "memory");
        }
    }
    __syncthreads();
}

constexpr int NIN = 28;
struct Args { const float* in[NIN]; float* out; unsigned char* ws; int ph_lo, ph_hi; };
enum { I_X = 0, I_NORM_MIX, I_W_IN, I_W_OUT, I_SHIFT_MU, I_GM_LN_W, I_GM_LN_B, I_GM_WS, I_GM_BS, I_RW_W_UP, I_RW_W0, I_RW_A_UP, I_RW_A0, I_RW_G_UP, I_RW_K_K, I_RW_K_A, I_RW_R_K,
       I_RW_LNX_W, I_RW_LNX_B, I_NORM_FFN, I_FFN_WG, I_FFN_WU, I_FFN_WD, I_MOE_ROUTER, I_MOE_WG, I_MOE_WU, I_MOE_WD, I_NORM_FINAL };

struct Frame {
    LAS unsigned char* lds;
    int tid, lane, wave, G, gw, NGW;
};

__device__ __forceinline__ void transpose_item(const float* W, int K, int N, bf16* WT, int drow0, int k0, int n0, const float* gain, LAS float* scr, int lane) {
#pragma unroll 8
    for (int i = 0; i < 32; ++i) { const int kk = 2 * i + (lane >> 5); float v = W[(size_t)(k0 + kk) * N + n0 + (lane & 31)]; if (gain) v *= gain[k0 + kk]; scr[kk * 33 + (lane & 31)] = v; }
    LDS_WAIT(); asm volatile("" ::: "memory");
    const int c = lane & 7;
#pragma unroll
    for (int j = 0; j < 4; ++j) { const int n = (lane >> 3) + 8 * j; const LAS float* s = scr + (8 * c) * 33 + n;
        u32x4 o; o.x = pk2(s[0 * 33], s[1 * 33]); o.y = pk2(s[2 * 33], s[3 * 33]); o.z = pk2(s[4 * 33], s[5 * 33]); o.w = pk2(s[6 * 33], s[7 * 33]);
        *(GAS u32x4*)(WT + (size_t)(drow0 + n) * K + k0 + 8 * c) = o; }
    LDS_WAIT(); asm volatile("" ::: "memory");
}
__device__ __forceinline__ void convert_matrix(Frame& F, const float* W, int K, int N, bf16* WT, int gu_mode  , const float* gain, int it0, int& itbase) {
    LAS float* scr = (LAS float*)(F.lds + F.wave * 16384);
    const int nblk = N / 32, nit = (K / 64) * nblk;
    int first = F.gw - (itbase % F.NGW); if (first < 0) first += F.NGW;
    for (int r = first; r < nit; r += F.NGW) { const int kb = r / nblk, nb = r % nblk, n0 = 32 * nb;
        const int drow0 = gu_mode == 0 ? n0 : (n0 / 128) * 256 + (gu_mode == 2 ? 128 : 0) + (n0 % 128);
        transpose_item(W, K, N, WT, drow0, 64 * kb, n0, gain, scr, F.lane); }
    itbase += nit; (void)it0;
}

__device__ __forceinline__ void gmlp_naive(Frame& F, const bf16* P, bf16* Y, const float* ln_w, const float* ln_b, const float* ws, const float* bs) {
    LAS float* V = (LAS float*)F.lds;
    for (int unit = blockIdx.x; unit < NB * (SEQ / GCH) * NH; unit += F.G) {
        const int h = unit % NH, bc = unit / NH; const size_t row0 = (size_t)bc * GCH;
        const float lw = ln_w[h * HD + F.lane], lb = ln_b[h * HD + F.lane];
        for (int i = 0; i < 16; ++i) { const int t = F.wave * 16 + i;
            const float g = gelu_erf(bf2f(P[(row0 + t) * INW + GMW + h * HD + F.lane]));
            const float mean = wave_sum(g) * (1.f / HD); const float d = g - mean; const float var = wave_sum(d * d) * (1.f / HD);
            V[t * HD + F.lane] = d * __builtin_amdgcn_rsqf(var + LN_EPS) * lw + lb; }
        __syncthreads();
        for (int i = 0; i < 16; ++i) { const int t = F.wave * 16 + i; const float* wrow = ws + ((size_t)h * GCH + t) * GCH; float acc = 0.f;
            for (int s = 0; s <= t; ++s) acc += wrow[s] * V[s * HD + F.lane];
            const float mixed = acc + bs[h * GCH + t];
            const float u = gelu_erf(bf2f(P[(row0 + t) * INW + h * HD + F.lane]));
            Y[(row0 + t) * D + h * HD + F.lane] = (bf16)f2bf(u * mixed); }
        __syncthreads();
    }
}
__device__ __forceinline__ float shifted(const bf16* P, size_t row, int t, int col, const float* mu) {
    const float c = bf2f(P[row * INW + col]); const float pr = t > 0 ? bf2f(P[(row - 1) * INW + col]) : 0.f;
    return c + (pr - c) * mu[col - 1024];
}
constexpr int NC = 32;
__device__ __forceinline__ void rwkv_naive(Frame& F, const bf16* P, bf16* Y, const float* mu, const float* w_up, const float* w0, const float* a_up, const float* a0, const float* g_up,
                                           const float* k_k, const float* k_a, const float* r_k, const float* lnx_w, const float* lnx_b) {
    LAS float* LI = (LAS float*)F.lds;
    LAS float* sR = LI + NC * 256; LAS float* sW = sR + NC * 64; LAS float* sK = sW + NC * 64; LAS float* sV = sK + NC * 64; LAS float* sA = sV + NC * 64; LAS float* sB = sA + NC * 64;
    LAS float* sG = sB + NC * 64; LAS float* sBon = sG + NC * 64;
    for (int unit = blockIdx.x; unit < NB * NH; unit += F.G) {
        const int b = unit / NH, h = unit % NH;
        float S[64];
#pragma unroll
        for (int k = 0; k < 64; ++k) S[k] = 0.f;
        for (int c = 0; c < SEQ / NC; ++c) {
            const int t0 = c * NC; const size_t row0 = (size_t)b * SEQ + t0;
            for (int idx = F.tid; idx < NC * 256; idx += 512) { const int tok = idx >> 8, j = idx & 255;
                const float x = shifted(P, row0 + tok, t0 + tok, 2560 + j, mu);
                LI[idx] = j < 64 ? tanhf(x) : (j < 128 ? x : sigmoidf_(x)); }
            __syncthreads();
            { const int ch = F.lane, hc = h * HD + ch;
              for (int i = 0; i < NC / 8; ++i) { const int tok = F.wave + 8 * i; const size_t row = row0 + tok; const int t = t0 + tok;
                const float rr = shifted(P, row, t, 1024 + hc, mu), kx = shifted(P, row, t, 1536 + hc, mu), vv = shifted(P, row, t, 2048 + hc, mu);
                float dw = w0[hc], da = a0[hc], gg = 0.f;
                for (int j = 0; j < 64; ++j) { dw += LI[tok * 256 + j] * w_up[j * RWW + hc]; da += LI[tok * 256 + 64 + j] * a_up[j * RWW + hc]; }
                for (int j = 0; j < 128; ++j) gg += LI[tok * 256 + 128 + j] * g_up[j * RWW + hc];
                const float z = -dw; const float sp = fmaxf(z, 0.f) + log1pf(__expf(-fabsf(z)));
                const float decay = __expf(-__expf(-sp - 0.5f));
                const float alr = sigmoidf_(da);
                const float kkv = kx * k_k[hc]; const float nrm = sqrtf(wave_sum(kkv * kkv)); const float kkn = kkv / fmaxf(nrm, 1e-12f);
                const float kmod = kx * (1.f + (alr - 1.f) * k_a[hc]);
                const float bsc = wave_sum(rr * kmod * r_k[hc]);
                sR[tok * 64 + ch] = rr; sW[tok * 64 + ch] = decay; sK[tok * 64 + ch] = kmod; sV[tok * 64 + ch] = vv; sA[tok * 64 + ch] = -kkn; sB[tok * 64 + ch] = kkn * alr;
                sG[tok * 64 + ch] = gg; sBon[tok * 64 + ch] = bsc * vv; } }
            __syncthreads();
            if (F.wave == 0) {
                for (int t = 0; t < NC; ++t) { float sa = 0.f;
#pragma unroll
                    for (int k = 0; k < 64; ++k) sa += S[k] * sA[t * 64 + k];
                    const float vv = sV[t * 64 + F.lane]; float yv = 0.f;
#pragma unroll
                    for (int k = 0; k < 64; ++k) { S[k] = S[k] * sW[t * 64 + k] + sa * sB[t * 64 + k] + vv * sK[t * 64 + k]; yv += S[k] * sR[t * 64 + k]; }
                    LI[t * 64 + F.lane] = yv; }
            }
            __syncthreads();
            { const int v = F.lane, hv = h * HD + v;
              for (int i = 0; i < NC / 8; ++i) { const int tok = F.wave + 8 * i; const float yv = LI[tok * 64 + v];
                const float mean = wave_sum(yv) * (1.f / HD); const float d = yv - mean; const float var = wave_sum(d * d) * (1.f / HD);
                const float yn = d * __builtin_amdgcn_rsqf(var + GN_EPS) * lnx_w[hv] + lnx_b[hv];
                Y[(row0 + tok) * D + GMW + hv] = (bf16)f2bf((yn + sBon[tok * 64 + v]) * sG[tok * 64 + v]); } }
            __syncthreads();
        }
    }
}

typedef short s16x4 __attribute__((ext_vector_type(4)));
typedef short v4i16_t __attribute__((ext_vector_type(4)));
#define MFMA32(a, b, c) __builtin_amdgcn_mfma_f32_16x16x32_bf16((a), (b), (c), 0, 0, 0)
#define MFMA16(a, b, c) __builtin_amdgcn_mfma_f32_16x16x16bf16_1k((a), (b), (c), 0, 0, 0)
__device__ __forceinline__ bf16x8 lds_row8(const LAS bf16* T, int ld, int r0, int k0, int lane) { return *(const LAS bf16x8*)(T + (r0 + (lane & 15)) * ld + k0 + 8 * (lane >> 4)); }
__device__ __forceinline__ s16x4 lds_row4(const LAS bf16* T, int ld, int r0, int k0, int lane) { return *(const LAS s16x4*)(T + (r0 + (lane & 15)) * ld + k0 + 4 * (lane >> 4)); }
__device__ __forceinline__ s16x4 lds_tr4(const LAS bf16* T, int ld, int k0, int c0, int lane) { const int i = lane & 15, g = lane >> 4;
    return __builtin_bit_cast(s16x4, __builtin_amdgcn_ds_read_tr16_b64_v4i16((LAS v4i16_t*)(T + (k0 + 4 * g + (i >> 2)) * ld + c0 + 4 * (i & 3)))); }
__device__ __forceinline__ bf16x8 lds_tr8(const LAS bf16* T, int ld, int k0, int c0, int lane) { const int i = lane & 15, g = lane >> 4;
    const LAS bf16* p = T + (k0 + 8 * g + (i >> 2)) * ld + c0 + 4 * (i & 3);
    const s16x4 lo = __builtin_bit_cast(s16x4, __builtin_amdgcn_ds_read_tr16_b64_v4i16((LAS v4i16_t*)p));
    const s16x4 hi = __builtin_bit_cast(s16x4, __builtin_amdgcn_ds_read_tr16_b64_v4i16((LAS v4i16_t*)(p + 4 * ld)));
    bf16x8 r; r[0] = lo[0]; r[1] = lo[1]; r[2] = lo[2]; r[3] = lo[3]; r[4] = hi[0]; r[5] = hi[1]; r[6] = hi[2]; r[7] = hi[3]; return r; }
typedef __bf16 bf16x2_t __attribute__((ext_vector_type(2)));
__device__ __forceinline__ unsigned cvtpk_c(float lo, float hi) { const f32x2 v = {lo, hi}; const bf16x2_t b = __builtin_convertvector(v, bf16x2_t); return __builtin_bit_cast(unsigned, b); }
__device__ __forceinline__ s16x4 pack4(const f32x4 v) { u32x2 w; w.x = cvtpk_c(v[0], v[1]); w.y = cvtpk_c(v[2], v[3]); return __builtin_bit_cast(s16x4, w); }
__device__ __forceinline__ f32x4 unpack4(const s16x4 v) { f32x4 r; r[0] = bf2f((bf16)v[0]); r[1] = bf2f((bf16)v[1]); r[2] = bf2f((bf16)v[2]); r[3] = bf2f((bf16)v[3]); return r; }
__device__ __forceinline__ void unpack8(const u32x4 w, float (&o)[8]) { o[0] = __builtin_bit_cast(float, w.x << 16); o[1] = __builtin_bit_cast(float, w.x & 0xffff0000u); o[2] = __builtin_bit_cast(float, w.y << 16); o[3] = __builtin_bit_cast(float, w.y & 0xffff0000u);
    o[4] = __builtin_bit_cast(float, w.z << 16); o[5] = __builtin_bit_cast(float, w.z & 0xffff0000u); o[6] = __builtin_bit_cast(float, w.w << 16); o[7] = __builtin_bit_cast(float, w.w & 0xffff0000u); }
__device__ __forceinline__ u32x4 pack8(const float (&v)[8]) { u32x4 w; w.x = cvtpk_c(v[0], v[1]); w.y = cvtpk_c(v[2], v[3]); w.z = cvtpk_c(v[4], v[5]); w.w = cvtpk_c(v[6], v[7]); return w; }
__device__ __forceinline__ float gelu_as(float v) {
    const float av = fabsf(v), t = __builtin_amdgcn_rcpf(av * 0.2316418882f + 1.0f);
    float q = t * 0.5307027145f + (-0.7265760135f); q = q * t + 0.7107068705f; q = q * t + (-0.142248368f); q = q * t + 0.127414796f; q = q * t;
    const float e = __builtin_amdgcn_exp2f((v * v) * (-0.72134752044f)); const float m = v * (q * e); return v < 0.f ? m : v - m;
}

constexpr int GM_V = 0, GM_U = 128 * 72 * 2;
__device__ __forceinline__ void gmlp_unit(Frame& F, int unit, const bf16* P, bf16* Y, const float* ln_w, const float* ln_b, const bf16* WsB, const float* bs) {
    LAS bf16* Vt = (LAS bf16*)(F.lds + GM_V); LAS bf16* Ut = (LAS bf16*)(F.lds + GM_U);
    const int h = unit % NH, bc = unit / NH; const size_t row0 = (size_t)bc * GCH;
    { const int t = F.tid >> 2, cq = F.tid & 3; const bf16* pr = P + (row0 + t) * INW + h * HD + 16 * cq;
      const u32x4 u0 = *(const u32x4*)pr, u1 = *(const u32x4*)(pr + 8), v0 = *(const u32x4*)(pr + GMW), v1 = *(const u32x4*)(pr + GMW + 8);
      float uu[16], vv[16]; { float a[8]; unpack8(u0, a); for (int j = 0; j < 8; ++j) uu[j] = a[j]; unpack8(u1, a); for (int j = 0; j < 8; ++j) uu[8 + j] = a[j]; unpack8(v0, a); for (int j = 0; j < 8; ++j) vv[j] = a[j]; unpack8(v1, a); for (int j = 0; j < 8; ++j) vv[8 + j] = a[j]; }
      float s = 0.f;
#pragma unroll
      for (int j = 0; j < 16; ++j) { uu[j] = gelu_as(uu[j]); vv[j] = gelu_as(vv[j]); s += vv[j]; }
      s += __shfl_xor(s, 1); s += __shfl_xor(s, 2); const float mean = s * (1.f / HD); float q = 0.f;
#pragma unroll
      for (int j = 0; j < 16; ++j) { vv[j] -= mean; q += vv[j] * vv[j]; }
      q += __shfl_xor(q, 1); q += __shfl_xor(q, 2); const float rstd = __builtin_amdgcn_rsqf(q * (1.f / HD) + LN_EPS);
#pragma unroll
      for (int j = 0; j < 16; ++j) vv[j] = vv[j] * rstd * ln_w[h * HD + 16 * cq + j] + ln_b[h * HD + 16 * cq + j];
      float a[8]; for (int j = 0; j < 8; ++j) a[j] = vv[j]; *(LAS u32x4*)(Vt + t * 72 + 16 * cq) = pack8(a); for (int j = 0; j < 8; ++j) a[j] = vv[8 + j]; *(LAS u32x4*)(Vt + t * 72 + 16 * cq + 8) = pack8(a);
      for (int j = 0; j < 8; ++j) a[j] = uu[j]; *(LAS u32x4*)(Ut + t * 72 + 16 * cq) = pack8(a); for (int j = 0; j < 8; ++j) a[j] = uu[8 + j]; *(LAS u32x4*)(Ut + t * 72 + 16 * cq + 8) = pack8(a); }
    __syncthreads();
    { const int w = F.wave, l15 = F.lane & 15, g = F.lane >> 4, t0 = 16 * w, nks = (w >> 1) + 1; const bf16* wrow = WsB + ((size_t)h * GCH + t0 + l15) * GCH + 8 * g;
      f32x4 acc[4] = {{0.f, 0.f, 0.f, 0.f}, {0.f, 0.f, 0.f, 0.f}, {0.f, 0.f, 0.f, 0.f}, {0.f, 0.f, 0.f, 0.f}};
      for (int ks = 0; ks < nks; ++ks) { const bf16x8 a = *(const bf16x8*)(wrow + 32 * ks);
#pragma unroll
          for (int nt = 0; nt < 4; ++nt) acc[nt] = MFMA32(a, lds_tr8(Vt, 72, 32 * ks, 16 * nt, F.lane), acc[nt]); }
#pragma unroll
      for (int reg = 0; reg < 4; ++reg) { const int t = t0 + 4 * g + reg; const float bsv = bs[h * GCH + t];
#pragma unroll
          for (int nt = 0; nt < 4; ++nt) { LAS bf16* up = Ut + t * 72 + 16 * nt + l15; *up = (bf16)f2bf(bf2f(*up) * (acc[nt][reg] + bsv)); } } }
    __syncthreads();
    { const int t = F.tid >> 2, cq = F.tid & 3; bf16* yr = Y + (row0 + t) * D + h * HD + 16 * cq;
      *(u32x4*)yr = *(const LAS u32x4*)(Ut + t * 72 + 16 * cq); *(u32x4*)(yr + 8) = *(const LAS u32x4*)(Ut + t * 72 + 16 * cq + 8); }
    __syncthreads();
}

struct RwkvW { const float *mu, *w0, *a0, *k_k, *k_a, *r_k, *lnx_w, *lnx_b; const bf16 *WupT, *AupT, *GupT; };
struct RwkvS { bf16 *SG, *SH, *SQ, *SS, *Sg, *SY0; float* Sbsc; };
constexpr int M1_LI = 0;
constexpr int M1_PR = 33792;
constexpr int M1_TL = M1_PR + 36864;
constexpr int M1_SEG = M1_TL + 7 * 9216;
constexpr int M1_GAM = M1_SEG + 2048;
constexpr int M1_D = M1_GAM + 256;
constexpr int M1_T = M1_D + 4096;
constexpr int M1_END = M1_T + 2048;
static_assert(M1_END <= MISC_OFF, "M1 LDS map");
__device__ __forceinline__ float fast_tanh(float x) { const float e = __expf(2.f * x); return 1.f - 2.f * __builtin_amdgcn_rcpf(e + 1.f); }

__device__ __forceinline__ void rwkv_m1_unit(Frame& F, int unit  , const bf16* P, const RwkvW& W, const RwkvS& Sc) {
    const int b = unit >> 6, c = unit & 63, t0 = c * 64; const size_t row0 = (size_t)b * SEQ + t0;
    const int w = F.wave, lane = F.lane, l15 = lane & 15, g = lane >> 4;
    LAS bf16* LI = (LAS bf16*)(F.lds + M1_LI);
    LAS float* Ef = (LAS float*)(F.lds + M1_PR); LAS float* ALf = Ef + 64 * 64;
    LAS bf16* Lab = (LAS bf16*)(F.lds + M1_PR); LAS bf16* Lak = Lab + 64 * 72; LAS bf16* Mrb = Lak + 64 * 72; LAS bf16* Mrk = Mrb + 64 * 72;
    LAS bf16* At = (LAS bf16*)(F.lds + M1_TL); LAS bf16* Bt = At + 64 * 72; LAS bf16* Kt = Bt + 64 * 72; LAS bf16* Rt = Kt + 64 * 72; LAS bf16* Bh = Rt + 64 * 72; LAS bf16* Kh = Bh + 64 * 72; LAS bf16* Vt = Kh + 64 * 72;
    LAS float* SEG = (LAS float*)(F.lds + M1_SEG); LAS float* GAM = (LAS float*)(F.lds + M1_GAM); LAS float* Dd = (LAS float*)(F.lds + M1_D); LAS bf16* Tt = (LAS bf16*)(F.lds + M1_T);
#pragma unroll
    for (int it = 0; it < 4; ++it) { const int item = F.tid + 512 * it, tok = item >> 5, jc = item & 31, j0 = 8 * jc; const size_t row = row0 + tok;
        float cv[8], pv[8]; unpack8(*(const u32x4*)(P + row * INW + 2560 + j0), cv);
        if (t0 + tok > 0) unpack8(*(const u32x4*)(P + (row - 1) * INW + 2560 + j0), pv); else { for (int j = 0; j < 8; ++j) pv[j] = 0.f; }
        const f32x4 m0 = *(const f32x4*)(W.mu + 1536 + j0), m1 = *(const f32x4*)(W.mu + 1536 + j0 + 4); float o[8];
#pragma unroll
        for (int j = 0; j < 8; ++j) { const float x = cv[j] + (pv[j] - cv[j]) * (j < 4 ? m0[j] : m1[j - 4]); o[j] = jc < 8 ? fast_tanh(x) : (jc < 16 ? x : sigmoidf_(x)); }
        *(LAS u32x4*)(LI + tok * 264 + j0) = pack8(o); }
    __syncthreads();
    for (int h = 0; h < NH; ++h) {
        const size_t uh = ((size_t)unit * NH + h) * 4096;
        { const int mt = w & 3, ntb = 2 * (w >> 2); const int chrow = h * HD + 16 * mt + l15;
          f32x4 aw[2] = {{0.f, 0.f, 0.f, 0.f}, {0.f, 0.f, 0.f, 0.f}}, aa[2] = {{0.f, 0.f, 0.f, 0.f}, {0.f, 0.f, 0.f, 0.f}}, ag[2] = {{0.f, 0.f, 0.f, 0.f}, {0.f, 0.f, 0.f, 0.f}};
#pragma unroll
          for (int ks = 0; ks < 2; ++ks) { const bf16x8 fw = *(const bf16x8*)(W.WupT + (size_t)chrow * 64 + 32 * ks + 8 * g), fa = *(const bf16x8*)(W.AupT + (size_t)chrow * 64 + 32 * ks + 8 * g);
#pragma unroll
              for (int q = 0; q < 2; ++q) { aw[q] = MFMA32(fw, lds_row8(LI, 264, 16 * (ntb + q), 32 * ks, lane), aw[q]); aa[q] = MFMA32(fa, lds_row8(LI, 264, 16 * (ntb + q), 64 + 32 * ks, lane), aa[q]); } }
#pragma unroll
          for (int ks = 0; ks < 4; ++ks) { const bf16x8 fg = *(const bf16x8*)(W.GupT + (size_t)chrow * 128 + 32 * ks + 8 * g);
#pragma unroll
              for (int q = 0; q < 2; ++q) ag[q] = MFMA32(fg, lds_row8(LI, 264, 16 * (ntb + q), 128 + 32 * ks, lane), ag[q]); }
          const int ch0 = 16 * mt + 4 * g; const f32x4 w0v = *(const f32x4*)(W.w0 + h * HD + ch0), a0v = *(const f32x4*)(W.a0 + h * HD + ch0);
#pragma unroll
          for (int q = 0; q < 2; ++q) { const int tok = 16 * (ntb + q) + l15; f32x4 ev, av;
#pragma unroll
              for (int r = 0; r < 4; ++r) { const float z = -(aw[q][r] + w0v[r]); const float sp = fmaxf(z, 0.f) + __logf(1.f + __expf(-fabsf(z))); ev[r] = -__expf(-sp - 0.5f); av[r] = sigmoidf_(aa[q][r] + a0v[r]); }
              *(LAS f32x4*)(Ef + tok * 64 + ch0) = ev; *(LAS f32x4*)(ALf + tok * 64 + ch0) = av;
              u32x2 gw; gw.x = cvtpk_c(ag[q][0], ag[q][1]); gw.y = cvtpk_c(ag[q][2], ag[q][3]); *(u32x2*)(Sc.Sg + (row0 + tok) * RWW + h * HD + ch0) = gw; } }
        __syncthreads();
        { const int ch = F.tid & 63, seg = F.tid >> 6; float run = 0.f;
#pragma unroll
          for (int i = 0; i < 8; ++i) { run += Ef[(8 * seg + i) * 64 + ch]; Ef[(8 * seg + i) * 64 + ch] = run; }
          SEG[seg * 64 + ch] = run; }
        __syncthreads();
        { const int ch = F.tid & 63, seg = F.tid >> 6; float off = 0.f;
          for (int s2 = 0; s2 < seg; ++s2) off += SEG[s2 * 64 + ch];
#pragma unroll
          for (int i = 0; i < 8; ++i) Ef[(8 * seg + i) * 64 + ch] += off; }
        __syncthreads();
        { const int tok = F.tid >> 3, cg = F.tid & 7, ch0 = 8 * cg, hc0 = h * HD + ch0; const size_t row = row0 + tok; const bool has_prev = (t0 + tok) > 0;
          float rr[8], kx[8], vv[8], tmp[8], pr[8];
#define SHIFT_LOAD(dst, col) do { unpack8(*(const u32x4*)(P + row * INW + (col)), dst); if (has_prev) unpack8(*(const u32x4*)(P + (row - 1) * INW + (col)), pr); else { for (int j = 0; j < 8; ++j) pr[j] = 0.f; } \
              const f32x4 m0 = *(const f32x4*)(W.mu + (col) - 1024), m1 = *(const f32x4*)(W.mu + (col) - 1024 + 4); for (int j = 0; j < 8; ++j) dst[j] = dst[j] + (pr[j] - dst[j]) * (j < 4 ? m0[j] : m1[j - 4]); } while (0)
          SHIFT_LOAD(rr, 1024 + hc0); SHIFT_LOAD(kx, 1536 + hc0); SHIFT_LOAD(vv, 2048 + hc0);
          (void)tmp;
          float Lt[8], Lm[8], Lc[8], al[8];
#pragma unroll
          for (int j = 0; j < 8; ++j) { Lt[j] = Ef[tok * 64 + ch0 + j]; Lm[j] = tok > 0 ? Ef[(tok - 1) * 64 + ch0 + j] : 0.f; Lc[j] = Ef[63 * 64 + ch0 + j]; al[j] = ALf[tok * 64 + ch0 + j]; }
          float kk[8], km[8]; float ss = 0.f, bs_ = 0.f;
#pragma unroll
          for (int j = 0; j < 8; ++j) { kk[j] = kx[j] * W.k_k[hc0 + j]; ss += kk[j] * kk[j]; km[j] = kx[j] * (1.f + (al[j] - 1.f) * W.k_a[hc0 + j]); bs_ += rr[j] * km[j] * W.r_k[hc0 + j]; }
          ss += __shfl_xor(ss, 1); ss += __shfl_xor(ss, 2); ss += __shfl_xor(ss, 4); bs_ += __shfl_xor(bs_, 1); bs_ += __shfl_xor(bs_, 2); bs_ += __shfl_xor(bs_, 4);
          const float inv = 1.f / fmaxf(sqrtf(ss), 1e-12f);
          if (cg == 0) Sc.Sbsc[row * NH + h] = bs_;
          float oA[8], oB[8], oK[8], oR[8], oBh[8], oKh[8];
#pragma unroll
          for (int j = 0; j < 8; ++j) { const float kn = kk[j] * inv, bb = kn * al[j]; const float einv = __expf(-Lt[j]), ec = __expf(Lc[j] - Lt[j]);
              oA[j] = -kn * __expf(Lm[j]); oB[j] = bb * einv; oK[j] = km[j] * einv; oR[j] = rr[j] * __expf(Lt[j]); oBh[j] = bb * ec; oKh[j] = km[j] * ec; }
          *(LAS u32x4*)(At + tok * 72 + ch0) = pack8(oA); *(LAS u32x4*)(Bt + tok * 72 + ch0) = pack8(oB); *(LAS u32x4*)(Kt + tok * 72 + ch0) = pack8(oK); *(LAS u32x4*)(Rt + tok * 72 + ch0) = pack8(oR);
          *(LAS u32x4*)(Bh + tok * 72 + ch0) = pack8(oBh); *(LAS u32x4*)(Kh + tok * 72 + ch0) = pack8(oKh); *(LAS u32x4*)(Vt + tok * 72 + ch0) = pack8(vv);
          if (tok == 63) { for (int j = 0; j < 8; ++j) GAM[ch0 + j] = __expf(Lc[j]); } }
        __syncthreads();
        for (int i5 = 0; i5 < 5; ++i5) { const int q = w + 8 * i5, mat = q / 10, idx = q % 10; const int ti = idx < 1 ? 0 : (idx < 3 ? 1 : (idx < 6 ? 2 : 3)), si = idx - ti * (ti + 1) / 2;
            const LAS bf16* X = mat < 2 ? At : Rt; const LAS bf16* Yk = (mat & 1) ? Kt : Bt; LAS bf16* O = Lab + mat * 64 * 72;
            f32x4 acc = {0.f, 0.f, 0.f, 0.f};
#pragma unroll
            for (int ks = 0; ks < 2; ++ks) acc = MFMA32(lds_row8(Yk, 72, 16 * si, 32 * ks, lane), lds_row8(X, 72, 16 * ti, 32 * ks, lane), acc);
            const int t = 16 * ti + l15, s0 = 16 * si + 4 * g;
#pragma unroll
            for (int r = 0; r < 4; ++r) { const bool keep = mat < 2 ? (s0 + r < t) : (s0 + r <= t); if (!keep) acc[r] = 0.f; }
            *(LAS s16x4*)(O + t * 72 + s0) = pack4(acc);
            if (mat == 0 && ti == si) *(LAS f32x4*)(Dd + ti * 256 + l15 * 16 + 4 * g) = acc; }
        __syncthreads();
        if (w == 7) { const int i = lane >> 4, cc = lane & 15; const LAS float* Db = Dd + i * 256; float tv[16];
#pragma unroll
            for (int r = 0; r < 16; ++r) { float sum = (r == cc) ? 1.f : 0.f;
#pragma unroll
                for (int s2 = 0; s2 < r; ++s2) sum += Db[r * 16 + s2] * tv[s2];
                tv[r] = sum; }
#pragma unroll
            for (int r = 0; r < 16; ++r) Tt[i * 256 + r * 16 + cc] = (bf16)f2bf(tv[r]); }
        __syncthreads();
        { const bool isU = w < 4; const int cw = w & 3;
          f32x4 X[4];
#pragma unroll
          for (int i = 0; i < 4; ++i) { f32x4 z = {0.f, 0.f, 0.f, 0.f};
              if (isU) {
#pragma unroll
                  for (int j = 0; j <= i; ++j) z = MFMA16(lds_row4(Lak, 72, 16 * i, 16 * j, lane), lds_tr4(Vt, 72, 16 * j, 16 * cw, lane), z);
              } else z = unpack4(lds_tr4(At, 72, 16 * i, 16 * cw, lane));
#pragma unroll
              for (int j = 0; j < i; ++j) z = MFMA16(lds_row4(Lab, 72, 16 * i, 16 * j, lane), pack4(X[j]), z);
              const f32x4 zero = {0.f, 0.f, 0.f, 0.f};
              X[i] = MFMA16(lds_row4(Tt + i * 256, 16, 0, 0, lane), pack4(z), zero); }
          s16x4 Xp[4];
#pragma unroll
          for (int i = 0; i < 4; ++i) Xp[i] = pack4(X[i]);
          if (isU) {
#pragma unroll
              for (int nt = 0; nt < 4; ++nt) { f32x4 acc = {0.f, 0.f, 0.f, 0.f};
#pragma unroll
                  for (int i = 0; i < 4; ++i) { acc = MFMA16(Xp[i], lds_tr4(Bh, 72, 16 * i, 16 * nt, lane), acc); acc = MFMA16(lds_tr4(Vt, 72, 16 * i, 16 * cw, lane), lds_tr4(Kh, 72, 16 * i, 16 * nt, lane), acc); }
                  *(s16x4*)(Sc.SH + uh + (size_t)(16 * nt + l15) * 64 + 16 * cw + 4 * g) = pack4(acc); }
#pragma unroll
              for (int mt = 0; mt < 4; ++mt) { f32x4 acc = {0.f, 0.f, 0.f, 0.f};
#pragma unroll
                  for (int i = 0; i <= mt; ++i) { acc = MFMA16(lds_row4(Mrb, 72, 16 * mt, 16 * i, lane), Xp[i], acc); acc = MFMA16(lds_row4(Mrk, 72, 16 * mt, 16 * i, lane), lds_tr4(Vt, 72, 16 * i, 16 * cw, lane), acc); }
                  *(s16x4*)(Sc.SY0 + uh + (size_t)(16 * cw + l15) * 64 + 16 * mt + 4 * g) = pack4(acc); }
          } else {
              const float gamv = GAM[16 * cw + l15];
#pragma unroll
              for (int nt = 0; nt < 4; ++nt) { f32x4 acc = {0.f, 0.f, 0.f, 0.f};
#pragma unroll
                  for (int i = 0; i < 4; ++i) acc = MFMA16(Xp[i], lds_tr4(Bh, 72, 16 * i, 16 * nt, lane), acc);
                  { const float gam = (nt == cw) ? gamv : 0.f;
#pragma unroll
                      for (int r = 0; r < 4; ++r) acc[r] += (l15 == 4 * g + r) ? gam : 0.f; }
                  *(s16x4*)(Sc.SG + uh + (size_t)(16 * nt + l15) * 64 + 16 * cw + 4 * g) = pack4(acc); }
#pragma unroll
              for (int mt = 0; mt < 4; ++mt) { f32x4 acc = unpack4(lds_tr4(Rt, 72, 16 * mt, 16 * cw, lane));
#pragma unroll
                  for (int i = 0; i <= mt; ++i) acc = MFMA16(lds_row4(Mrb, 72, 16 * mt, 16 * i, lane), Xp[i], acc);
                  *(s16x4*)(Sc.SQ + uh + (size_t)(16 * cw + l15) * 64 + 16 * mt + 4 * g) = pack4(acc); }
          } }
        __syncthreads();
    }
}

constexpr int M2_S = 0;
__device__ __forceinline__ void rwkv_m2_unit(Frame& F, int unit  , const RwkvS& Sc) {
    const int b = unit >> 3, h = unit & 7; const int w = F.wave, lane = F.lane, l15 = lane & 15, g = lane >> 4; const int mt = w >> 1, ntb = 2 * (w & 1);
    LAS bf16* Sb = (LAS bf16*)(F.lds + M2_S);
    f32x4 acc[2] = {{0.f, 0.f, 0.f, 0.f}, {0.f, 0.f, 0.f, 0.f}};
    for (int c = 0; c < 64; ++c) {
        const size_t uh = ((size_t)(b * 64 + c) * NH + h) * 4096; LAS bf16* buf = Sb + (c & 1) * 64 * 72;
        bf16x8 Gf[2][2]; u32x2 Hf[2];
#pragma unroll
        for (int q = 0; q < 2; ++q) { const size_t ro = uh + (size_t)(16 * (ntb + q) + l15) * 64;
            Gf[q][0] = *(const bf16x8*)(Sc.SG + ro + 8 * g); Gf[q][1] = *(const bf16x8*)(Sc.SG + ro + 32 + 8 * g); Hf[q] = *(const u32x2*)(Sc.SH + ro + 16 * mt + 4 * g); }
#pragma unroll
        for (int q = 0; q < 2; ++q) { const s16x4 p = pack4(acc[q]); *(LAS s16x4*)(buf + (16 * (ntb + q) + l15) * 72 + 16 * mt + 4 * g) = p; *(s16x4*)(Sc.SS + uh + (size_t)(16 * (ntb + q) + l15) * 64 + 16 * mt + 4 * g) = p; }
        __syncthreads();
        const bf16x8 a0 = lds_tr8(buf, 72, 0, 16 * mt, lane), a1 = lds_tr8(buf, 72, 32, 16 * mt, lane);
#pragma unroll
        for (int q = 0; q < 2; ++q) { f32x4 z; z[0] = __builtin_bit_cast(float, Hf[q].x << 16); z[1] = __builtin_bit_cast(float, Hf[q].x & 0xffff0000u); z[2] = __builtin_bit_cast(float, Hf[q].y << 16); z[3] = __builtin_bit_cast(float, Hf[q].y & 0xffff0000u);
            z = MFMA32(a0, Gf[q][0], z); acc[q] = MFMA32(a1, Gf[q][1], z); }
    }
    __syncthreads();
}

constexpr int M3_SLOT = 9216 * 2 + 64 * 68 * 4;
__device__ __forceinline__ void rwkv_m3_unit(Frame& F, int unit  , const bf16* P, bf16* Y, const RwkvW& W, const RwkvS& Sc) {
    const int b = unit >> 6, c = unit & 63, t0 = c * 64; const size_t row0 = (size_t)b * SEQ + t0;
    const int w = F.wave, lane = F.lane, l15 = lane & 15, g = lane >> 4, hw = w >> 2, mt = w & 3, tl = F.tid & 255;
    LAS bf16* Qt = (LAS bf16*)(F.lds + hw * M3_SLOT); LAS bf16* St = Qt + 64 * 72; LAS float* Out = (LAS float*)(F.lds + hw * M3_SLOT + 2 * 9216);
    for (int hp = 0; hp < 4; ++hp) { const int h = 2 * hp + hw; const size_t uh = ((size_t)unit * NH + h) * 4096;
#pragma unroll
        for (int r = 0; r < 2; ++r) { const int off = 8 * (tl + 256 * r), rr = off >> 6, cc = off & 63;
            *(LAS u32x4*)(Qt + rr * 72 + cc) = *(const u32x4*)(Sc.SQ + uh + off); *(LAS u32x4*)(St + rr * 72 + cc) = *(const u32x4*)(Sc.SS + uh + off); }
        __syncthreads();
        f32x4 acc[4];
#pragma unroll
        for (int nt = 0; nt < 4; ++nt) acc[nt] = unpack4(*(const s16x4*)(Sc.SY0 + uh + (size_t)(16 * nt + l15) * 64 + 16 * mt + 4 * g));
#pragma unroll
        for (int ks = 0; ks < 2; ++ks) { const bf16x8 a = lds_tr8(Qt, 72, 32 * ks, 16 * mt, lane);
#pragma unroll
            for (int nt = 0; nt < 4; ++nt) acc[nt] = MFMA32(a, lds_tr8(St, 72, 32 * ks, 16 * nt, lane), acc[nt]); }
#pragma unroll
        for (int r = 0; r < 4; ++r) { float s = (acc[0][r] + acc[1][r]) + (acc[2][r] + acc[3][r]);
            s += __shfl_xor(s, 1); s += __shfl_xor(s, 2); s += __shfl_xor(s, 4); s += __shfl_xor(s, 8); const float mean = s * (1.f / HD); float q = 0.f;
#pragma unroll
            for (int nt = 0; nt < 4; ++nt) { const float d = acc[nt][r] - mean; q += d * d; }
            q += __shfl_xor(q, 1); q += __shfl_xor(q, 2); q += __shfl_xor(q, 4); q += __shfl_xor(q, 8); const float rstd = __builtin_amdgcn_rsqf(q * (1.f / HD) + GN_EPS);
#pragma unroll
            for (int nt = 0; nt < 4; ++nt) { const int v = 16 * nt + l15; Out[(16 * mt + 4 * g + r) * 68 + v] = (acc[nt][r] - mean) * rstd * W.lnx_w[h * HD + v] + W.lnx_b[h * HD + v]; } }
        __syncthreads();
        { const int t = tl >> 2, cq = tl & 3, v0 = 16 * cq, hv0 = h * HD + v0; const size_t row = row0 + t; const bool has_prev = (t0 + t) > 0; const float bsc = Sc.Sbsc[row * NH + h];
#pragma unroll
          for (int half = 0; half < 2; ++half) { float cv[8], pv[8], gv[8], o[8]; const int col = 2048 + hv0 + 8 * half;
              unpack8(*(const u32x4*)(P + row * INW + col), cv); if (has_prev) unpack8(*(const u32x4*)(P + (row - 1) * INW + col), pv); else { for (int j = 0; j < 8; ++j) pv[j] = 0.f; }
              unpack8(*(const u32x4*)(Sc.Sg + row * RWW + hv0 + 8 * half), gv);
              const f32x4 m0 = *(const f32x4*)(W.mu + col - 1024), m1 = *(const f32x4*)(W.mu + col - 1024 + 4);
#pragma unroll
              for (int j = 0; j < 8; ++j) { const float vs = cv[j] + (pv[j] - cv[j]) * (j < 4 ? m0[j] : m1[j - 4]); o[j] = (Out[t * 68 + v0 + 8 * half + j] + bsc * vs) * gv[j]; }
              *(u32x4*)(Y + row * D + GMW + hv0 + 8 * half) = pack8(o); } }
        __syncthreads();
    }
}


__device__ __forceinline__ void rwkv_apply_naive(Frame& F, int unit, const bf16* P, bf16* Y, const RwkvW& W, const RwkvS& Sc) {
    const int b = unit >> 3, h = unit & 7;
    LAS float* S = (LAS float*)F.lds; LAS float* Gs = S + 64 * 65; LAS float* Hs = Gs + 64 * 65; LAS float* Qs = Hs + 64 * 65; LAS float* Ys = Qs + 64 * 65; LAS float* Sn = Ys + 64 * 65;
    for (int i = F.tid; i < 64 * 65; i += 512) S[i] = 0.f;
    __syncthreads();
    for (int c = 0; c < 64; ++c) { const size_t uh = ((size_t)(b * 64 + c) * NH + h) * 4096; const size_t row0 = (size_t)b * SEQ + c * 64;
        for (int i = F.tid; i < 4096; i += 512) { const int r = i >> 6, cc = i & 63;
            Gs[cc * 65 + r] = bf2f(Sc.SG[uh + i]);
            Hs[cc * 65 + r] = bf2f(Sc.SH[uh + i]);
            Qs[cc * 65 + r] = bf2f(Sc.SQ[uh + i]);
            Ys[cc * 65 + r] = bf2f(Sc.SY0[uh + i]); }
        __syncthreads();
        for (int i = F.tid; i < 4096; i += 512) { const int t = i >> 6, v = i & 63; float a = Ys[t * 65 + v];
            if (DBG_VAR != 1) for (int k = 0; k < 64; ++k) a += Qs[t * 65 + k] * S[v * 65 + k];
            if (DBG_VAR == 2) a = 0.f;
            Ys[t * 65 + v] = a; }
        for (int i = F.tid; i < 4096; i += 512) { const int v = i >> 6, k2 = i & 63; float a = Hs[v * 65 + k2];
            if (DBG_VAR == 6) a += S[v * 65 + k2] * Gs[k2 * 65 + k2]; else if (DBG_VAR != 3) for (int k = 0; k < 64; ++k) a += S[v * 65 + k] * Gs[k * 65 + k2];
            if (DBG_VAR == 7) a = Hs[v * 65 + k2] + 0.5f * (a - Hs[v * 65 + k2]);
            Sn[v * 65 + k2] = a; }
        __syncthreads();
        for (int i = F.tid; i < 4096; i += 512) { const int v = i >> 6, k2 = i & 63; S[v * 65 + k2] = Sn[v * 65 + k2]; }
        { const int t = F.tid >> 3, cg = F.tid & 7, v0 = 8 * cg, hv0 = h * HD + v0; const size_t row = row0 + t; const bool has_prev = (c * 64 + t) > 0; const float bsc = Sc.Sbsc[row * NH + h];
          float yv[8]; float sm = 0.f;
          for (int j = 0; j < 8; ++j) { yv[j] = Ys[t * 65 + v0 + j]; sm += yv[j]; }
          sm += __shfl_xor(sm, 1); sm += __shfl_xor(sm, 2); sm += __shfl_xor(sm, 4); const float mean = sm * (1.f / HD); float q = 0.f;
          for (int j = 0; j < 8; ++j) { yv[j] -= mean; q += yv[j] * yv[j]; }
          q += __shfl_xor(q, 1); q += __shfl_xor(q, 2); q += __shfl_xor(q, 4); const float rstd = __builtin_amdgcn_rsqf(q * (1.f / HD) + GN_EPS);
          float cv[8], pv[8], gv[8], o[8]; const int col = 2048 + hv0;
          unpack8(*(const u32x4*)(P + row * INW + col), cv); if (has_prev) unpack8(*(const u32x4*)(P + (row - 1) * INW + col), pv); else { for (int j = 0; j < 8; ++j) pv[j] = 0.f; }
          unpack8(*(const u32x4*)(Sc.Sg + row * RWW + hv0), gv);
          for (int j = 0; j < 8; ++j) { const float vs = cv[j] + (pv[j] - cv[j]) * W.mu[col - 1024 + j]; o[j] = (yv[j] * rstd * W.lnx_w[hv0 + j] + W.lnx_b[hv0 + j] + bsc * vs) * gv[j]; }
          *(u32x4*)(Y + row * D + GMW + hv0) = pack8(o); }
        __syncthreads();
    }
}

enum Phase { PH_PRO = 0, PH_G1_0, PH_M1_0, PH_M2_0, PH_M3_0, PH_G2_0, PH_G3_0, PH_G4_0, PH_G1_1, PH_M1_1, PH_M2_1, PH_M3_1, PH_G2_1, PH_CV, PH_R2, PH_GU_A, PH_DN_A, PH_GU_B, PH_DN_B, PH_FIN, PH_COUNT };

__global__ void __launch_bounds__(512, 2) fwd(Args args) {
    extern __shared__ __attribute__((aligned(16))) unsigned char lds_raw[];
    Frame F;
    F.lds = (LAS unsigned char*)lds_raw;
    F.tid = threadIdx.x; F.lane = F.tid & 63; F.wave = __builtin_amdgcn_readfirstlane(F.tid >> 6);
    F.G = gridDim.x; F.gw = blockIdx.x * 8 + F.wave; F.NGW = F.G * 8;
    unsigned char* ws = args.ws;
    gu32* ctl = (gu32*)(ws + WS_CTL);
    volatile LAS unsigned* MISC = (volatile LAS unsigned*)(F.lds + MISC_OFF);
    if (F.tid < 32) ((LAS unsigned*)(F.lds + MISC_OFF))[F.tid] = 0u;
    __syncthreads();
    XcdBarrier bar; bar.bar = (unsigned*)(ctl + CW_BAR); bar.x = 0; bar.st = nullptr;
#if !MK_PER_PHASE
    bar = xcd_barrier_post((unsigned*)(ctl + CW_BAR), MISC + 8);
#endif
    const int lo = args.ph_lo, hi = args.ph_hi;
#define IN(k) (lo <= (k) && (k) < hi)
#define SEAM(k) do { if (IN(k) && IN((k) + 1)) xcd_barrier(bar); } while (0)

    const float* x_in = args.in[I_X]; float* xres = args.out;
    bf16* WinT = (bf16*)(ws + WS_WIN); bf16* WoutT = (bf16*)(ws + WS_WOUT); bf16* WguT = (bf16*)(ws + WS_WGU); bf16* WdT = (bf16*)(ws + WS_WD);
    bf16* XB = (bf16*)(ws + WS_XB); bf16* PB = (bf16*)(ws + WS_P); bf16* YB = (bf16*)(ws + WS_Y); bf16* HB = (bf16*)(ws + WS_P);
    bf16* MWgu = (bf16*)(ws + WS_MOEW_GU); bf16* MWd = (bf16*)(ws + WS_MOEW_D); bf16* MH = (bf16*)(ws + WS_MOEH);
    float* ssq0 = (float*)(ctl + CW_SSQ); float* ssq1 = (float*)(ws + WS_SSQP); float* ssq2 = ssq1 + (size_t)NTOK * 16;
    bf16* WupT = (bf16*)(ws + WS_SMALLW + SW_WUP); bf16* AupT = (bf16*)(ws + WS_SMALLW + SW_AUP); bf16* GupT = (bf16*)(ws + WS_SMALLW + SW_GUP); bf16* WsB = (bf16*)(ws + WS_SMALLW + SW_WS);
    RwkvS RS{(bf16*)(ws + WS_SCR), (bf16*)(ws + WS_SCR + 32 * MiB), (bf16*)(ws + WS_SCR + 64 * MiB), (bf16*)(ws + WS_SCR + 96 * MiB), (bf16*)(ws + WS_SCR + 128 * MiB), (bf16*)(ws + WS_XB), (float*)(ws + WS_XB + 32 * MiB)};
    unsigned char* misc = ws + WS_MISC;
    int* tok_e = (int*)(misc + MS_TOKE); float* tok_g = (float*)(misc + MS_TOKG); float* rs_moe = (float*)(misc + MS_RS); int* bcnt = (int*)(misc + MS_BCNT);
    int* row_tok = (int*)(misc + MS_ROWTOK); float* row_gate = (float*)(misc + MS_ROWGATE); int* panel = (int*)(misc + MS_PANEL);

    if (IN(PH_PRO)) {
        int itb = 0;
        for (int l = 0; l < 2; ++l) {
            convert_matrix(F, args.in[I_W_IN] + (size_t)l * D * INW, D, INW, WinT + (size_t)l * INW * D, 0, args.in[I_NORM_MIX] + l * D, 0, itb);
            convert_matrix(F, args.in[I_W_OUT] + (size_t)l * D * D, D, D, WoutT + (size_t)l * D * D, 0, nullptr, 0, itb);
        }
        convert_matrix(F, args.in[I_FFN_WG], D, FF, WguT, 1, args.in[I_NORM_FFN], 0, itb);
        convert_matrix(F, args.in[I_FFN_WU], D, FF, WguT, 2, args.in[I_NORM_FFN], 0, itb);
        convert_matrix(F, args.in[I_FFN_WD], FF, D, WdT, 0, nullptr, 0, itb);
        { const size_t gt = (size_t)blockIdx.x * 512 + F.tid, gn = (size_t)F.G * 512;
          for (size_t i = gt; i < (size_t)2 * RWW * 64; i += gn) { const int l = (int)(i / (RWW * 64)), r = (int)(i % (RWW * 64)), ch = r / 64, j = r % 64;
              WupT[i] = (bf16)f2bf(args.in[I_RW_W_UP][(size_t)l * 64 * RWW + (size_t)j * RWW + ch]); AupT[i] = (bf16)f2bf(args.in[I_RW_A_UP][(size_t)l * 64 * RWW + (size_t)j * RWW + ch]); }
          for (size_t i = gt; i < (size_t)2 * RWW * 128; i += gn) { const int l = (int)(i / (RWW * 128)), r = (int)(i % (RWW * 128)), ch = r / 128, j = r % 128;
              GupT[i] = (bf16)f2bf(args.in[I_RW_G_UP][(size_t)l * 128 * RWW + (size_t)j * RWW + ch]); }
          for (size_t i = gt; i < (size_t)2 * NH * GCH * GCH; i += gn) { const int t = (int)((i / GCH) % GCH), s2 = (int)(i % GCH); WsB[i] = (bf16)(s2 <= t ? f2bf(args.in[I_GM_WS][i]) : 0u); } }
        for (int m = F.gw; m < NTOK; m += F.NGW) {
            const GAS f32x4* xr = (const GAS f32x4*)(x_in + (size_t)m * D) + F.lane; GAS u32x2* o8 = (GAS u32x2*)(XB + (size_t)m * D) + F.lane; float s = 0.f;
#pragma unroll
            for (int j = 0; j < 4; ++j) { const f32x4 v = xr[64 * j]; s += (v.x * v.x + v.y * v.y) + (v.z * v.z + v.w * v.w); u32x2 w; w.x = pk2(v.x, v.y); w.y = pk2(v.z, v.w); o8[64 * j] = w; }
            s = wave_sum(s); if (F.lane == 0) ssq0[m] = s;
        }
    }
    SEAM(PH_PRO);

#define LAYER_MIXER(L, PH1, PHA, PHB, PHC, PH2, XBASE, SSQ_IN, NP_IN, SSQ_OUT, HAS_OUT) \
    if (IN(PH1)) { pg8::DenseSched S; S.init(XB, WinT + (size_t)(L) * INW * D, NTOK, INW, D, F.G, (int)blockIdx.x); \
        pg8::EpiScaleBf16<NP_IN> E{PB, INW, SSQ_IN}; pg8::gemm_phase(F.lds, D, S, E); } \
    SEAM(PH1); \
    { RwkvW RW{args.in[I_SHIFT_MU] + (L) * 1792, args.in[I_RW_W0] + (L) * RWW, args.in[I_RW_A0] + (L) * RWW, args.in[I_RW_K_K] + (L) * RWW, args.in[I_RW_K_A] + (L) * RWW, args.in[I_RW_R_K] + (L) * RWW, \
                 args.in[I_RW_LNX_W] + (L) * RWW, args.in[I_RW_LNX_B] + (L) * RWW, WupT + (size_t)(L) * RWW * 64, AupT + (size_t)(L) * RWW * 64, GupT + (size_t)(L) * RWW * 128}; \
      if (IN(PHA)) { if (MIX_MODE != 1) for (int u = blockIdx.x; u < NB * 64; u += F.G) rwkv_m1_unit(F, u, PB, RW, RS); } \
      SEAM(PHA); \
      if (IN(PHB)) { const int nscan = (F.G >= 128 && MIX_MODE != 1) ? 64 : 0; \
          if (MIX_MODE != 1 && MIX_MODE != 3) { if (nscan) { if ((int)blockIdx.x < 64) rwkv_m2_unit(F, blockIdx.x, RS); } else { for (int u = blockIdx.x; u < 64; u += F.G) rwkv_m2_unit(F, u, RS); } } \
          if (MIX_MODE == 2) gmlp_naive(F, PB, YB, args.in[I_GM_LN_W] + (L) * GMW, args.in[I_GM_LN_B] + (L) * GMW, args.in[I_GM_WS] + (size_t)(L) * NH * GCH * GCH, args.in[I_GM_BS] + (L) * NH * GCH); \
          else if ((int)blockIdx.x >= nscan) for (int u = blockIdx.x - nscan; u < NB * (SEQ / GCH) * NH; u += F.G - nscan) \
              gmlp_unit(F, u, PB, YB, args.in[I_GM_LN_W] + (L) * GMW, args.in[I_GM_LN_B] + (L) * GMW, WsB + (size_t)(L) * NH * GCH * GCH, args.in[I_GM_BS] + (L) * NH * GCH); } \
      SEAM(PHB); \
      if (IN(PHC)) { if (MIX_MODE == 3) { for (int u = blockIdx.x; u < 64; u += F.G) rwkv_apply_naive(F, u, PB, YB, RW, RS); } \
          else if (MIX_MODE != 1) { for (int u = blockIdx.x; u < NB * 64; u += F.G) rwkv_m3_unit(F, u, PB, YB, RW, RS); } \
          else rwkv_naive(F, PB, YB, args.in[I_SHIFT_MU] + (L) * 1792, args.in[I_RW_W_UP] + (L) * 64 * RWW, args.in[I_RW_W0] + (L) * RWW, args.in[I_RW_A_UP] + (L) * 64 * RWW, args.in[I_RW_A0] + (L) * RWW, \
                   args.in[I_RW_G_UP] + (L) * 128 * RWW, args.in[I_RW_K_K] + (L) * RWW, args.in[I_RW_K_A] + (L) * RWW, args.in[I_RW_R_K] + (L) * RWW, args.in[I_RW_LNX_W] + (L) * RWW, args.in[I_RW_LNX_B] + (L) * RWW); } \
      SEAM(PHC); } \
    if (IN(PH2)) { pg8::DenseSched S; S.init(YB, WoutT + (size_t)(L) * D * D, NTOK, D, D, F.G, (int)blockIdx.x); \
        pg8::EpiResid<HAS_OUT> E{XBASE, xres, XB, SSQ_OUT}; pg8::gemm_phase(F.lds, D, S, E); } \
    SEAM(PH2);

    LAYER_MIXER(0, PH_G1_0, PH_M1_0, PH_M2_0, PH_M3_0, PH_G2_0, x_in, ssq0, 1, ssq1, true)

    if (IN(PH_G3_0)) { pg8::DenseSched S; S.init(XB, WguT, NTOK, 2 * FF, D, F.G, (int)blockIdx.x);
        pg8::EpiSwiglu<16> E{HB, FF, ssq1}; pg8::gemm_phase(F.lds, D, S, E); }
    SEAM(PH_G3_0);
    if (IN(PH_G4_0)) { pg8::DenseSched S; S.init(HB, WdT, NTOK, D, FF, F.G, (int)blockIdx.x);
        pg8::EpiResid<true> E{xres, xres, XB, ssq2}; pg8::gemm_phase(F.lds, FF, S, E); }
    SEAM(PH_G4_0);

    LAYER_MIXER(1, PH_G1_1, PH_M1_1, PH_M2_1, PH_M3_1, PH_G2_1, xres, ssq2, 16, nullptr, false)

    if (IN(PH_CV)) {
        int itb = 0; const float* gain = args.in[I_NORM_FFN] + D;
        for (int e = 0; e < NE; ++e) {
            convert_matrix(F, args.in[I_MOE_WG] + (size_t)e * D * FFE, D, FFE, MWgu + (size_t)e * 2 * FFE * D, 1, gain, 0, itb);
            convert_matrix(F, args.in[I_MOE_WU] + (size_t)e * D * FFE, D, FFE, MWgu + (size_t)e * 2 * FFE * D, 2, gain, 0, itb);
            convert_matrix(F, args.in[I_MOE_WD] + (size_t)e * FFE * D, FFE, D, MWd + (size_t)e * D * FFE, 0, nullptr, 0, itb);
        }
        __syncthreads();
        LAS float* RW = (LAS float*)F.lds; LAS int* cnt = (LAS int*)(F.lds + 32768);
        for (int i = F.tid; i < D * NE; i += 512) RW[i] = args.in[I_MOE_ROUTER][i] * gain[i >> 3];
        for (size_t i = (size_t)blockIdx.x * 512 + F.tid; i < (size_t)2 * MAXPAN * 256; i += (size_t)F.G * 512) { row_tok[i] = -1; row_gate[i] = 0.f; }
        __syncthreads();
        for (int vb = blockIdx.x; vb < 256; vb += F.G) {
            if (F.tid < 16) cnt[F.tid] = 0;
            __syncthreads();
            for (int i = 0; i < 16; ++i) { const int m = vb * 128 + F.wave * 16 + i;
                const GAS f32x4* xr = (const GAS f32x4*)(xres + (size_t)m * D) + F.lane; float s = 0.f; float lg[8];
#pragma unroll
                for (int e = 0; e < 8; ++e) lg[e] = 0.f;
#pragma unroll
                for (int j = 0; j < 4; ++j) { const f32x4 v = xr[64 * j]; s += (v.x * v.x + v.y * v.y) + (v.z * v.z + v.w * v.w);
                    const int k0 = 256 * j + 4 * F.lane;
#pragma unroll
                    for (int q = 0; q < 4; ++q) { const float xv = v[q]; const LAS f32x4* rw = (const LAS f32x4*)(RW + (k0 + q) * 8); const f32x4 r0 = rw[0], r1 = rw[1];
                        lg[0] += xv * r0.x; lg[1] += xv * r0.y; lg[2] += xv * r0.z; lg[3] += xv * r0.w; lg[4] += xv * r1.x; lg[5] += xv * r1.y; lg[6] += xv * r1.z; lg[7] += xv * r1.w; } }
                s = wave_sum(s);
#pragma unroll
                for (int e = 0; e < 8; ++e) lg[e] = wave_sum(lg[e]);
                const float rs = 1.0f / sqrtf(s * (1.0f / D) + RMS_EPS);
                if (F.lane == 0) {
                    int i1 = 0; float v1 = lg[0];
#pragma unroll
                    for (int e = 1; e < 8; ++e) if (lg[e] > v1) { v1 = lg[e]; i1 = e; }
                    int i2 = -1; float v2 = -3.0e38f;
#pragma unroll
                    for (int e = 0; e < 8; ++e) if (e != i1 && lg[e] > v2) { v2 = lg[e]; i2 = e; }
                    if (i2 < 0) { i2 = (i1 + 1) & 7; v2 = v1; }
                    const float g1 = 1.0f / (1.0f + __expf((v2 - v1) * rs)), g2 = 1.0f - g1;
                    tok_e[2 * m] = i1; tok_e[2 * m + 1] = i2; tok_g[2 * m] = g1; tok_g[2 * m + 1] = g2; rs_moe[m] = rs;
                    __hip_atomic_fetch_add(&cnt[i1], 1, __ATOMIC_RELAXED, __HIP_MEMORY_SCOPE_WORKGROUP); __hip_atomic_fetch_add(&cnt[8 + i2], 1, __ATOMIC_RELAXED, __HIP_MEMORY_SCOPE_WORKGROUP);
                } }
            __syncthreads();
            if (F.tid < 16) bcnt[vb * 16 + F.tid] = cnt[F.tid];
            __syncthreads();
        }
    }
    SEAM(PH_CV);

    if (IN(PH_R2)) {
        LAS int* tot = (LAS int*)F.lds;
        for (int vb = blockIdx.x; vb < 256; vb += F.G) {
            if (F.tid < 16) { int t = 0, mine = 0; for (int b2 = 0; b2 < 256; ++b2) { const int c = bcnt[b2 * 16 + F.tid]; if (b2 < vb) mine += c; t += c; } tot[F.tid] = t; tot[32 + F.tid] = mine; }
            __syncthreads();
            if (F.tid < 2) { int ps = 0; for (int e = 0; e < 8; ++e) { tot[16 + F.tid * 8 + e] = ps; ps += (tot[F.tid * 8 + e] + 255) / 256; }
                if (vb == 0) { panel[F.tid * 160] = ps; for (int e = 0; e < 8; ++e) { const int np = (tot[F.tid * 8 + e] + 255) / 256; for (int q = 0; q < np; ++q) panel[F.tid * 160 + 16 + tot[16 + F.tid * 8 + e] + q] = e; } } }
            __syncthreads();
            if (F.tid < 16) { const int set = F.tid >> 3, e = F.tid & 7; int slot = tot[16 + F.tid] * 256 + tot[32 + F.tid];
                for (int r = 0; r < 128; ++r) { const int m = vb * 128 + r; if (tok_e[2 * m + set] == e) { row_tok[set * MAXPAN * 256 + slot] = m; row_gate[set * MAXPAN * 256 + slot] = tok_g[2 * m + set]; ++slot; } } }
            __syncthreads();
        }
    }
    SEAM(PH_R2);

#define MOE_SET(SET, PHGU, PHDN) \
    if (IN(PHGU)) { const int np = __builtin_amdgcn_readfirstlane(panel[(SET) * 160]); pg8::MoeSched<true> S; \
        S.init(XB, MWgu, np, 2 * FFE, D, panel + (SET) * 160 + 16, row_tok + (SET) * MAXPAN * 256, F.G, (int)blockIdx.x); \
        pg8::EpiSwigluMoe E{MH, FFE, rs_moe, row_tok + (SET) * MAXPAN * 256}; pg8::gemm_phase(F.lds, D, S, E); } \
    SEAM(PHGU); \
    if (IN(PHDN)) { const int np = __builtin_amdgcn_readfirstlane(panel[(SET) * 160]); pg8::MoeSched<false> S; \
        S.init(MH, MWd, np, D, FFE, panel + (SET) * 160 + 16, row_tok + (SET) * MAXPAN * 256, F.G, (int)blockIdx.x); \
        pg8::EpiMoeDown E{xres, row_tok + (SET) * MAXPAN * 256, row_gate + (SET) * MAXPAN * 256}; pg8::gemm_phase(F.lds, FFE, S, E); } \
    SEAM(PHDN);
    MOE_SET(0, PH_GU_A, PH_DN_A)
    MOE_SET(1, PH_GU_B, PH_DN_B)

    if (IN(PH_FIN)) {
        const float* gf = args.in[I_NORM_FINAL];
        for (int m = F.gw; m < NTOK; m += F.NGW) {
            GAS f32x4* xr = (GAS f32x4*)(xres + (size_t)m * D) + F.lane; f32x4 v[4]; float s = 0.f;
#pragma unroll
            for (int j = 0; j < 4; ++j) { v[j] = xr[64 * j]; s += (v[j].x * v[j].x + v[j].y * v[j].y) + (v[j].z * v[j].z + v[j].w * v[j].w); }
            const float rs = 1.0f / sqrtf(wave_sum(s) * (1.0f / D) + RMS_EPS);
#pragma unroll
            for (int j = 0; j < 4; ++j) { const f32x4 g = *((const f32x4*)gf + F.lane + 64 * j); xr[64 * j] = v[j] * rs * g; }
        }
    }
#undef IN
#undef SEAM
}

extern "C" void kernel_launch(void* const* d_in, const int* in_sizes, int n_in, void* d_out, int out_size, void* d_ws, size_t ws_size, hipStream_t stream) {
    static int grid = 0;
    if (grid == 0) {
        if (n_in != NIN || in_sizes[0] != NTOK * D || out_size != NTOK * D || ws_size < WS_END) {
            fprintf(stderr, "kernel_launch: unexpected shapes: n_in %d in0 %d out %d ws %zu (need %zu); nothing launched\n", n_in, n_in > 0 ? in_sizes[0] : -1, out_size, ws_size, (size_t)WS_END); grid = -1; return; }
        int dev = 0, cus = 0, per_cu = 0;
        if (hipGetDevice(&dev) != hipSuccess || hipDeviceGetAttribute(&cus, hipDeviceAttributeMultiprocessorCount, dev) != hipSuccess) { grid = -1; return; }
        if (hipFuncSetAttribute((const void*)fwd, hipFuncAttributeMaxDynamicSharedMemorySize, LDS_BYTES) != hipSuccess) { fprintf(stderr, "kernel_launch: hipFuncSetAttribute failed\n"); grid = -1; return; }
        if (hipOccupancyMaxActiveBlocksPerMultiprocessor(&per_cu, (const void*)fwd, 512, LDS_BYTES) != hipSuccess || per_cu < 1) { fprintf(stderr, "kernel_launch: occupancy query says %d\n", per_cu); }
        (void)hipGetLastError();
        grid = cus;
    }
    if (grid < 0) return;
    if (hipMemsetAsync((char*)d_ws + WS_CTL, 0, CTL_ZERO_BYTES, stream) != hipSuccess) return;
    Args a{};
    for (int i = 0; i < NIN; ++i) a.in[i] = (const float*)d_in[i];
    a.out = (float*)d_out; a.ws = (unsigned char*)d_ws;
#if MK_PER_PHASE
    for (int ph = 0; ph < PH_COUNT; ++ph) { a.ph_lo = ph; a.ph_hi = ph + 1; hipLaunchKernelGGL(fwd, dim3(grid), dim3(512), LDS_BYTES, stream, a); }
#else
    a.ph_lo = 0; a.ph_hi = PH_COUNT; hipLaunchKernelGGL(fwd, dim3(grid), dim3(512), LDS_BYTES, stream, a);
#endif
}
```

```cpp
#include <hip/hip_runtime.h>
#include <cstdio>
#include <cstdint>

#ifndef MK_PER_PHASE
#define MK_PER_PHASE 0
#endif

#ifndef REP_M1
#define REP_M1 1
#endif
#ifndef REP_M2
#define REP_M2 1
#endif
#ifndef REP_M3
#define REP_M3 1
#endif
#ifndef REP_GU
#define REP_GU 1
#endif
#ifndef REP_CH
#define REP_CH 1
#endif
#ifndef PROBE_STAGE
#define PROBE_STAGE 0
#endif
#ifndef DBG_VAR
#define DBG_VAR 0
#endif
#ifndef MOE8_GU
#define MOE8_GU 1
#endif
#ifndef MOE8_DN
#define MOE8_DN 1
#endif
#ifndef MIX_MODE
#define MIX_MODE 0
#endif
#define GAS __attribute__((address_space(1)))
#define LAS __attribute__((address_space(3)))
typedef unsigned short bf16;
typedef unsigned short bf16_t;
typedef short bf16x8 __attribute__((ext_vector_type(8)));
typedef float f32x4 __attribute__((ext_vector_type(4)));
typedef float f32x2 __attribute__((ext_vector_type(2)));
typedef unsigned u32x4 __attribute__((ext_vector_type(4)));
typedef unsigned u32x2 __attribute__((ext_vector_type(2)));
typedef GAS unsigned gu32;

constexpr int NTOK = 32768, SEQ = 4096, NB = 8, D = 1024, INW = 2816, FF = 2816, FFE = 3584, NE = 8;
constexpr int GMW = 512, RWW = 512, NH = 8, HD = 64, GCH = 128;
constexpr float RMS_EPS = 1e-6f, LN_EPS = 1e-5f, GN_EPS = 64e-5f;
constexpr int MAXPAN = 136;

constexpr size_t MiB = 1u << 20;
constexpr size_t WS_CTL = 0, CTL_ZERO_BYTES = 2 * MiB;
constexpr size_t WS_WIN = 2 * MiB;
constexpr size_t WS_WOUT = 13 * MiB;
constexpr size_t WS_WGU = 17 * MiB;
constexpr size_t WS_WD = 28 * MiB;
constexpr size_t WS_MISC = 34 * MiB;
constexpr size_t WS_SMALLW = 36 * MiB;
constexpr size_t SW_WUP = 0, SW_AUP = 128 * 1024, SW_GUP = 256 * 1024, SW_WS = 512 * 1024;
constexpr size_t WS_XB = 38 * MiB;
constexpr size_t WS_R = 102 * MiB;
constexpr size_t WS_P = WS_R;
constexpr size_t WS_Y = WS_R + 176 * MiB;
constexpr size_t WS_SCR = WS_R + 240 * MiB;
constexpr size_t WS_MOEW_GU = WS_R;
constexpr size_t WS_MOEW_D = WS_R + 112 * MiB;
constexpr size_t WS_MOEH = WS_R + 168 * MiB;
constexpr size_t WS_MOEW8_GU = WS_R;
constexpr size_t WS_MOEW8_D = WS_R + 56 * MiB;
constexpr size_t WS_XB8 = WS_R + 112 * MiB;
constexpr float MOE8_WSCALE_GU = 64.f, MOE8_WSCALE_DN = 128.f;
constexpr size_t WS_SSQP = WS_R + 400 * MiB;
constexpr size_t WS_END = WS_R + 408 * MiB;
static_assert(WS_MOEH + (size_t)MAXPAN * 256 * FFE * 2 <= WS_END, "moe hidden fits");
static_assert(WS_WIN + (size_t)2 * INW * D * 2 <= WS_WOUT && WS_WGU + (size_t)2 * FF * D * 2 <= WS_WD && WS_WD + (size_t)D * FF * 2 <= WS_MISC, "weights fit");
constexpr int CW_TMO = 0;
constexpr int CW_BAR = 4096;
constexpr int CW_SSQ = 65536;
static_assert((CW_SSQ + 4 * NTOK) * 4 <= (int)CTL_ZERO_BYTES, "ctl fits");
constexpr size_t MS_TOKE = 0;
constexpr size_t MS_TOKG = 256 * 1024;
constexpr size_t MS_RS = 512 * 1024;
constexpr size_t MS_BCNT = 640 * 1024;
constexpr size_t MS_ROWTOK = 704 * 1024;
constexpr size_t MS_ROWGATE = 1024 * 1024;
constexpr size_t MS_PANEL = 1344 * 1024;
static_assert(MS_ROWTOK + 2 * MAXPAN * 256 * 4 <= MS_ROWGATE && MS_ROWGATE + 2 * MAXPAN * 256 * 4 <= MS_PANEL && MS_PANEL + 2 * 160 * 4 <= 2 * MiB, "misc fits");

constexpr int RING_BYTES = 131072;
constexpr int LDS_BYTES = 147456;
constexpr int MISC_OFF = LDS_BYTES - 128;

#define LDS_WAIT() asm volatile("s_waitcnt lgkmcnt(0)" ::: "memory")
#define VM_WAIT() asm volatile("s_waitcnt vmcnt(0)" ::: "memory")
#define RLX_AGENT __ATOMIC_RELAXED, __HIP_MEMORY_SCOPE_AGENT

__device__ __forceinline__ unsigned f2bf(float f) { unsigned u = __builtin_bit_cast(unsigned, f); return (u + 0x7fffu + ((u >> 16) & 1u)) >> 16; }
__device__ __forceinline__ unsigned pk2(float lo, float hi) { return f2bf(lo) | (f2bf(hi) << 16); }
__device__ __forceinline__ float bf2f(bf16 b) { return __builtin_bit_cast(float, (unsigned)b << 16); }
__device__ __forceinline__ unsigned cvt_pk_bf16(float lo, float hi) { unsigned r; asm volatile("v_cvt_pk_bf16_f32 %0, %1, %2" : "=v"(r) : "v"(lo), "v"(hi)); return r; }
__device__ __forceinline__ unsigned pk4_fp8(float a, float b, float c, float d) { int v = __builtin_amdgcn_cvt_pk_fp8_f32(a, b, 0, false); v = __builtin_amdgcn_cvt_pk_fp8_f32(c, d, v, true); return (unsigned)v; }
__device__ __forceinline__ float wave_sum(float v) {
#pragma unroll
    for (int o = 1; o < 64; o <<= 1) v += __shfl_xor(v, o);
    return v;
}
__device__ __forceinline__ float gelu_erf(float v) { return 0.5f * v * (1.0f + erff(v * 0.70710678f)); }
__device__ __forceinline__ float sigmoidf_(float v) { return 1.0f / (1.0f + __expf(-v)); }
__device__ __forceinline__ float silu_f(float v) { return v * __builtin_amdgcn_rcpf(1.0f + __expf(-v)); }

namespace pg8 {
constexpr int BM = 256, BK = 64, HALF = 128, HTB = HALF * BK * 2, STAGE_BYTES = 8 * HTB, NXCD = 8, WGM = 8;
__host__ __device__ __forceinline__ int lds_byte(int r, int c) { const int st = (r >> 4) * 2 + (c >> 5), rr = r & 15, cc = c & 31, ob = rr * 64 + cc * 2; return st * 1024 + (ob ^ (((ob >> 9) & 1) << 5)); }
__host__ __device__ __forceinline__ void stage_rc(int b, int& R, int& C) { const int st = b / 1024, sb = b % 1024, swz = sb ^ (((sb >> 9) & 1) << 5); R = (st >> 1) * 16 + swz / 64; C = (st & 1) * 32 + (swz % 64) / 2; }
__host__ __device__ __forceinline__ int perm32(int rho) { const int n = rho >> 4, i = rho & 15; return 8 * (i >> 2) + 4 * n + (i & 3); }

struct Unit { int pm, pn, aux; };

struct TileOrder {
    int nM, nN, nwg, G, c;
    __device__ void init(int nM_, int nN_, int G_, int c_) { nM = nM_; nN = nN_; nwg = nM * nN; G = G_; c = c_; }
    __device__ bool tile(int i, int& pm, int& pn) const {
        const long L = (long)i * G + c; if (L >= nwg) return false;
        int wgid = (int)L; { const int q = nwg / NXCD, r = nwg % NXCD, xcd = wgid % NXCD, off = wgid / NXCD; wgid = (xcd < r ? xcd * (q + 1) : r * (q + 1) + (xcd - r) * q) + off; }
        const int nig = WGM * nN, gid = wgid / nig, fm = gid * WGM, gsz = (nM - fm) < WGM ? (nM - fm) : WGM;
        pm = fm + ((wgid % nig) % gsz); pn = (wgid % nig) / gsz; return true;
    }
};
struct DenseSched {
    static constexpr bool GATHER = false;
    TileOrder T; const char* A; const char* Bt; size_t tstep;
    __device__ void init(const void* A_, const void* Bt_, int M, int N, int KB  , int G, int c) { T.init(M / BM, N / BM, G, c); A = (const char*)A_; Bt = (const char*)Bt_; tstep = (size_t)BM * KB; }
    __device__ __forceinline__ bool next(int i, Unit& u) const { u.aux = 0; return T.tile(i, u.pm, u.pn); }
    __device__ __forceinline__ const char* a_ptr(const Unit& u) const { return A + (size_t)u.pm * tstep; }
    __device__ __forceinline__ const char* b_ptr(const Unit& u) const { return Bt + (size_t)u.pn * tstep; }
    __device__ __forceinline__ void gather(const Unit&, int, int, int, int, int, unsigned (&)[2][2]) const {}
};
template <bool GATHER_> struct MoeSched {
    static constexpr bool GATHER = GATHER_;
    TileOrder T; const char* A; const char* Bt; size_t a_tstep, b_tstep, b_estep; const int* pexp; const int* row_tok; int KB;
    __device__ void init(const void* A_, const void* Bt_, int npanels, int N, int KB_  , const int* pexp_, const int* row_tok_, int G, int c) {
        T.init(npanels, N / BM, G, c); A = (const char*)A_; Bt = (const char*)Bt_; KB = KB_; a_tstep = (size_t)BM * KB_; b_tstep = (size_t)BM * KB_; b_estep = (size_t)N * KB_; pexp = pexp_; row_tok = row_tok_; }
    __device__ __forceinline__ bool next(int i, Unit& u) const { if (!T.tile(i, u.pm, u.pn)) return false; u.aux = __builtin_amdgcn_readfirstlane(pexp[u.pm]); return true; }
    __device__ __forceinline__ const char* a_ptr(const Unit& u) const { return GATHER ? A : A + (size_t)u.pm * a_tstep; }
    __device__ __forceinline__ const char* b_ptr(const Unit& u) const { return Bt + (size_t)u.aux * b_estep + (size_t)u.pn * b_tstep; }
    __device__ __forceinline__ void gather(const Unit& u, int R0, int R1, int C0, int C1, int, unsigned (&v)[2][2]) const {
#pragma unroll
        for (int h = 0; h < 2; ++h) { int t0 = row_tok[u.pm * BM + h * HALF + R0], t1 = row_tok[u.pm * BM + h * HALF + R1]; t0 = t0 < 0 ? 0 : t0; t1 = t1 < 0 ? 0 : t1;
            v[h][0] = (unsigned)(t0 * KB + C0 * 2); v[h][1] = (unsigned)(t1 * KB + C1 * 2); }
    }
};

typedef int v4i_t __attribute__((ext_vector_type(4)));
typedef int v8i_t __attribute__((ext_vector_type(8)));
typedef short s16x16_t __attribute__((ext_vector_type(16)));
__device__ __forceinline__ v8i_t cat8(const bf16x8 lo, const bf16x8 hi) { const v4i_t a = __builtin_bit_cast(v4i_t, lo), b = __builtin_bit_cast(v4i_t, hi); return __builtin_shufflevector(a, b, 0, 1, 2, 3, 4, 5, 6, 7); }
template <class Epi, class Sched, bool FP8 = false>
__device__ __forceinline__ void gemm_phase(LAS unsigned char* lds, const int KB, const Sched& S, const Epi& E) {
    constexpr bool GATHER = Sched::GATHER;
    const int tid = threadIdx.x, wid = __builtin_amdgcn_readfirstlane(tid >> 6), lane = tid & 63, wr = wid >> 2, wc = wid & 3, fr = lane & 15, fq = lane >> 4;
    const int nt = KB / 128;
    unsigned voffA[2], voffB[2]; int sR[2], sC[2];
#pragma unroll
    for (int i = 0; i < 2; ++i) { int R, C; stage_rc(tid * 16 + i * 8192, R, C); const int Rb = Epi::PERM ? ((R & ~31) + perm32(R & 31)) : R; sR[i] = R; sC[i] = C;
        voffA[i] = (unsigned)(R * KB + C * 2); voffB[i] = (unsigned)(Rb * KB + C * 2); }
    const size_t kstep = (size_t)(BK * 2);
    const size_t hstep = (size_t)HALF * KB;
    const unsigned ldsw = (unsigned)wid * 1024u;
    const int aoff = lds_byte(wr * 64 + fr, fq * 8), boff = lds_byte(wc * 32 + fr, fq * 8);
    const int aoff8 = lds_byte(wr * 64 + fr, (fq >> 1) * 32 + (fq & 1) * 16) & ~31, boff8 = lds_byte(wc * 32 + fr, (fq >> 1) * 32 + (fq & 1) * 16) & ~31;
#define PG8_SA(b, h) (((b) * 2 + (h)) * HTB)
#define PG8_SB(b, h) ((4 + (b) * 2 + (h)) * HTB)
#define PG8_STAGE(bufoff, gbase, voff) do { _Pragma("unroll") for (int _i = 0; _i < 2; ++_i) \
        __builtin_amdgcn_global_load_lds((const unsigned*)((const char*)(gbase) + (voff)[_i]), (LAS unsigned*)(lds + (bufoff) + ldsw + _i * 8192), 16, 0, 0); } while (0)
#define PG8_STAGE_A(bufoff, kptr, half, VG) do { if constexpr (GATHER) { PG8_STAGE(bufoff, kptr, (VG)[half]); } else { PG8_STAGE(bufoff, (kptr) + (half) * hstep, voffA); } } while (0)
#define PG8_LDA(dst, b, h) do { if constexpr (FP8) { _Pragma("unroll") for (int m = 0; m < 4; ++m) dst##8[m] = cat8(*(const LAS bf16x8*)(lds + PG8_SA(b, h) + aoff8 + m * 2048), *(const LAS bf16x8*)(lds + PG8_SA(b, h) + aoff8 + m * 2048 + 16)); } \
        else { _Pragma("unroll") for (int m = 0; m < 4; ++m) _Pragma("unroll") for (int k = 0; k < 2; ++k) dst[m][k] = *(const LAS bf16x8*)(lds + PG8_SA(b, h) + aoff + m * 2048 + k * 1024); } } while (0)
#define PG8_LDB(dst, b, h) do { if constexpr (FP8) { _Pragma("unroll") for (int n = 0; n < 2; ++n) dst##8[n] = cat8(*(const LAS bf16x8*)(lds + PG8_SB(b, h) + boff8 + n * 2048), *(const LAS bf16x8*)(lds + PG8_SB(b, h) + boff8 + n * 2048 + 16)); } \
        else { _Pragma("unroll") for (int n = 0; n < 2; ++n) _Pragma("unroll") for (int k = 0; k < 2; ++k) dst[n][k] = *(const LAS bf16x8*)(lds + PG8_SB(b, h) + boff + n * 2048 + k * 1024); } } while (0)
#define PG8_MMA(ai, bj, At, Bt) do { __builtin_amdgcn_s_setprio(1); if constexpr (FP8) { _Pragma("unroll") for (int m = 0; m < 4; ++m) _Pragma("unroll") for (int n = 0; n < 2; ++n) \
        asm volatile("v_mfma_scale_f32_16x16x128_f8f6f4 %0, %1, %2, %0, %3, %3 op_sel_hi:[0,0,0]" : "+v"(acc[ai][bj][m][n]) : "v"(Bt##8[n]), "v"(At##8[m]), "v"(sc8)); } \
        else { _Pragma("unroll") for (int m = 0; m < 4; ++m) _Pragma("unroll") for (int n = 0; n < 2; ++n) _Pragma("unroll") for (int k = 0; k < 2; ++k) \
        acc[ai][bj][m][n] = __builtin_amdgcn_mfma_f32_16x16x32_bf16(Bt[n][k], At[m][k], acc[ai][bj][m][n], 0, 0, 0); } __builtin_amdgcn_s_setprio(0); } while (0)
#define PG8_WAIT_V(n) asm volatile("s_waitcnt vmcnt(" #n ")" ::: "memory")
#define PG8_WAIT_L(n) asm volatile("s_waitcnt lgkmcnt(" #n ")" ::: "memory")
#define PG8_BAR __builtin_amdgcn_s_barrier()
#define PG8_SCHED __builtin_amdgcn_sched_barrier(0)
    Unit cur, nxt; int ui = 0;
    if (!S.next(0, cur)) return;
    f32x4 acc[2][2][4][2];
#pragma unroll
    for (int a = 0; a < 2; ++a)
#pragma unroll
        for (int b = 0; b < 2; ++b)
#pragma unroll
            for (int m = 0; m < 4; ++m)
#pragma unroll
                for (int n = 0; n < 2; ++n) acc[a][b][m][n] = (f32x4){0.f, 0.f, 0.f, 0.f};
    bf16x8 At[4][2], B0[2][2], B1[2][2]; v8i_t At8[4], B08[2], B18[2]; const int sc8 = 0x7f7f7f7f;
    const char* cA = S.a_ptr(cur); const char* cB = S.b_ptr(cur);
    unsigned vcur[2][2] = {{0u, 0u}, {0u, 0u}}, vnext[2][2] = {{0u, 0u}, {0u, 0u}}, vt2[2][2] = {{0u, 0u}, {0u, 0u}};
    if constexpr (GATHER) S.gather(cur, sR[0], sR[1], sC[0], sC[1], 0, vcur);
    PG8_STAGE(PG8_SB(0, 0), cB, voffB); PG8_STAGE(PG8_SB(0, 1), cB + hstep, voffB); PG8_STAGE_A(PG8_SA(0, 0), cA, 0, vcur); PG8_STAGE_A(PG8_SA(0, 1), cA, 1, vcur);
    if (wr == 1) PG8_BAR;
    PG8_WAIT_V(2); PG8_BAR;
    PG8_STAGE(PG8_SB(1, 0), cB + kstep, voffB); PG8_STAGE_A(PG8_SA(1, 0), cA + kstep, 0, vcur); PG8_STAGE(PG8_SB(1, 1), cB + hstep + kstep, voffB);
    PG8_WAIT_V(6); PG8_BAR;
    for (;;) {
        const bool has_next = S.next(ui + 1, nxt);
        const char* nA = has_next ? S.a_ptr(nxt) : cA; const char* nB = has_next ? S.b_ptr(nxt) : cB;
        if constexpr (GATHER) { if (has_next) S.gather(nxt, sR[0], sR[1], sC[0], sC[1], 0, vnext); else {
#pragma unroll
            for (int h = 0; h < 2; ++h) { vnext[h][0] = vcur[h][0]; vnext[h][1] = vcur[h][1]; } } }
        for (int t = 0; t < nt; t += 2) {
            const bool last = (t == nt - 2);
            const char* a1 = cA + (size_t)(t + 1) * kstep;
            const char* a2 = last ? nA : cA + (size_t)(t + 2) * kstep; const char* b2 = last ? nB : cB + (size_t)(t + 2) * kstep;
            const char* a3 = a2 + kstep; const char* b3 = b2 + kstep;
            if constexpr (GATHER) {
#pragma unroll
                for (int h = 0; h < 2; ++h) { vt2[h][0] = last ? vnext[h][0] : vcur[h][0]; vt2[h][1] = last ? vnext[h][1] : vcur[h][1]; } }
            PG8_LDB(B0, 0, 0); PG8_LDB(B1, 0, 1); PG8_SCHED; PG8_LDA(At, 0, 0); PG8_STAGE_A(PG8_SA(1, 1), a1, 1, vcur);
            PG8_WAIT_V(8); PG8_WAIT_L(0); PG8_BAR; PG8_MMA(0, 0, At, B0); PG8_MMA(0, 1, At, B1); PG8_BAR; PG8_SCHED;
            PG8_LDA(At, 0, 1); PG8_STAGE(PG8_SB(0, 0), b2, voffB); PG8_STAGE(PG8_SB(0, 1), b2 + hstep, voffB); PG8_STAGE_A(PG8_SA(0, 0), a2, 0, vt2);
            PG8_WAIT_V(8); PG8_WAIT_L(0); PG8_BAR; PG8_MMA(1, 0, At, B0); PG8_MMA(1, 1, At, B1); PG8_BAR; PG8_SCHED;
            PG8_LDB(B0, 1, 0); PG8_LDB(B1, 1, 1); PG8_SCHED; PG8_LDA(At, 1, 0); PG8_STAGE_A(PG8_SA(0, 1), a2, 1, vt2);
            PG8_WAIT_V(8); PG8_WAIT_L(0); PG8_BAR; PG8_MMA(0, 0, At, B0); PG8_MMA(0, 1, At, B1); PG8_BAR; PG8_SCHED;
            PG8_LDA(At, 1, 1); PG8_STAGE(PG8_SB(1, 0), b3, voffB); PG8_STAGE(PG8_SB(1, 1), b3 + hstep, voffB); PG8_STAGE_A(PG8_SA(1, 0), a3, 0, vt2);
            PG8_WAIT_V(8); PG8_WAIT_L(0); PG8_BAR; PG8_MMA(1, 0, At, B0); PG8_MMA(1, 1, At, B1); PG8_BAR; PG8_SCHED;
        }
        if (wr == 0) PG8_BAR;
        if constexpr (FP8) { asm volatile("s_nop 15\n\ts_nop 15" ::: "memory"); }
        E(acc, cur, wr, wc, fr, fq);
        if (!has_next) break;
#pragma unroll
        for (int a = 0; a < 2; ++a)
#pragma unroll
            for (int b = 0; b < 2; ++b)
#pragma unroll
                for (int m = 0; m < 4; ++m)
#pragma unroll
                    for (int n = 0; n < 2; ++n) acc[a][b][m][n] = (f32x4){0.f, 0.f, 0.f, 0.f};
        cur = nxt; cA = nA; cB = nB; ++ui;
        if constexpr (GATHER) {
#pragma unroll
            for (int h = 0; h < 2; ++h) { vcur[h][0] = vnext[h][0]; vcur[h][1] = vnext[h][1]; } }
        if (wr == 1) PG8_BAR;
    }
    PG8_WAIT_V(0);
    PG8_BAR;
#undef PG8_SA
#undef PG8_SB
#undef PG8_STAGE
#undef PG8_STAGE_A
#undef PG8_LDA
#undef PG8_LDB
#undef PG8_MMA
#undef PG8_WAIT_V
#undef PG8_WAIT_L
#undef PG8_BAR
#undef PG8_SCHED
}

template <int NP> __device__ __forceinline__ float row_rs(const float* ssq, int row) {
    float s;
    if constexpr (NP == 1) s = ssq[row];
    else { const f32x4* p = (const f32x4*)(ssq + (size_t)row * 16); const f32x4 a = p[0], b = p[1], c = p[2], d = p[3];
        s = (((a[0] + a[1]) + (a[2] + a[3])) + ((b[0] + b[1]) + (b[2] + b[3]))) + (((c[0] + c[1]) + (c[2] + c[3])) + ((d[0] + d[1]) + (d[2] + d[3]))); }
    return __builtin_amdgcn_rsqf(s * (1.0f / D) + RMS_EPS);
}
template <int NP> struct EpiScaleBf16 {
    static constexpr bool PERM = true;
    bf16_t* O; int ldc; const float* ssq;
    __device__ __forceinline__ void operator()(const f32x4 (&acc)[2][2][4][2], const Unit& u, int wr, int wc, int fr, int fq) const {
        const int row0 = u.pm * BM + wr * 64 + fr, col0 = u.pn * BM + wc * 32 + 8 * fq;
#pragma unroll
        for (int ai = 0; ai < 2; ++ai)
#pragma unroll
            for (int m = 0; m < 4; ++m) { const int row = row0 + ai * HALF + m * 16; const float rs = row_rs<NP>(ssq, row);
                bf16_t* rowp = O + (size_t)row * ldc + col0;
#pragma unroll
                for (int bj = 0; bj < 2; ++bj) { const f32x4 v0 = acc[ai][bj][m][0] * rs, v1 = acc[ai][bj][m][1] * rs;
                    u32x4 w; w.x = cvt_pk_bf16(v0[0], v0[1]); w.y = cvt_pk_bf16(v0[2], v0[3]); w.z = cvt_pk_bf16(v1[0], v1[1]); w.w = cvt_pk_bf16(v1[2], v1[3]);
                    *(u32x4*)(rowp + bj * HALF) = w; } }
    }
};
template <bool SSQ> struct EpiResid {
    static constexpr bool PERM = false;
    const float* base; float* out; bf16_t* xb; float* ssq;
    __device__ __forceinline__ void operator()(const f32x4 (&acc)[2][2][4][2], const Unit& u, int wr, int wc, int fr, int fq) const {
        const int row0 = u.pm * BM + wr * 64 + fr, col0 = u.pn * BM + wc * 32 + 4 * fq;
#pragma unroll
        for (int ai = 0; ai < 2; ++ai)
#pragma unroll
            for (int m = 0; m < 4; ++m) { const int row = row0 + ai * HALF + m * 16; const size_t off = (size_t)row * D + col0; float s = 0.f;
#pragma unroll
                for (int bj = 0; bj < 2; ++bj)
#pragma unroll
                    for (int n = 0; n < 2; ++n) { const f32x4 o = *(const f32x4*)(base + off + bj * HALF + n * 16) + acc[ai][bj][m][n];
                        *(f32x4*)(out + off + bj * HALF + n * 16) = o; u32x2 w; w.x = cvt_pk_bf16(o[0], o[1]); w.y = cvt_pk_bf16(o[2], o[3]);
                        *(u32x2*)(xb + off + bj * HALF + n * 16) = w; s += (o[0] * o[0] + o[1] * o[1]) + (o[2] * o[2] + o[3] * o[3]); }
                if constexpr (SSQ) { s += __shfl_xor(s, 16); s += __shfl_xor(s, 32);
                    if (fq == 0) ssq[(size_t)row * 16 + u.pn * 4 + wc] = s; }
                asm volatile("" ::: "memory"); }
    }
};
template <int NP> struct EpiSwiglu {
    static constexpr bool PERM = true;
    bf16_t* O; int ldc; const float* ssq;
    __device__ __forceinline__ void operator()(const f32x4 (&acc)[2][2][4][2], const Unit& u, int wr, int wc, int fr, int fq) const {
        const int row0 = u.pm * BM + wr * 64 + fr, col0 = u.pn * HALF + wc * 32 + 8 * fq;
#pragma unroll
        for (int ai = 0; ai < 2; ++ai)
#pragma unroll
            for (int m = 0; m < 4; ++m) { const int row = row0 + ai * HALF + m * 16; const float rs = row_rs<NP>(ssq, row);
                float h[8];
#pragma unroll
                for (int n = 0; n < 2; ++n)
#pragma unroll
                    for (int j = 0; j < 4; ++j) h[n * 4 + j] = silu_f(acc[ai][0][m][n][j] * rs) * (acc[ai][1][m][n][j] * rs);
                u32x4 w; w.x = cvt_pk_bf16(h[0], h[1]); w.y = cvt_pk_bf16(h[2], h[3]); w.z = cvt_pk_bf16(h[4], h[5]); w.w = cvt_pk_bf16(h[6], h[7]);
                *(u32x4*)(O + (size_t)row * ldc + col0) = w; }
    }
};
struct EpiSwigluMoe {
    static constexpr bool PERM = true;
    bf16_t* O; int ldc; const float* rsv; const int* row_tok; float wsinv;
    __device__ __forceinline__ void operator()(const f32x4 (&acc)[2][2][4][2], const Unit& u, int wr, int wc, int fr, int fq) const {
        const int row0 = u.pm * BM + wr * 64 + fr, col0 = u.pn * HALF + wc * 32 + 8 * fq;
#pragma unroll
        for (int ai = 0; ai < 2; ++ai)
#pragma unroll
            for (int m = 0; m < 4; ++m) { const int row = row0 + ai * HALF + m * 16; const int tok = row_tok[row]; const float rs = tok >= 0 ? rsv[tok] * wsinv : 0.f;
                float h[8];
#pragma unroll
                for (int n = 0; n < 2; ++n)
#pragma unroll
                    for (int j = 0; j < 4; ++j) h[n * 4 + j] = silu_f(acc[ai][0][m][n][j] * rs) * (acc[ai][1][m][n][j] * rs);
                u32x4 w; w.x = cvt_pk_bf16(h[0], h[1]); w.y = cvt_pk_bf16(h[2], h[3]); w.z = cvt_pk_bf16(h[4], h[5]); w.w = cvt_pk_bf16(h[6], h[7]);
                *(u32x4*)(O + (size_t)row * ldc + col0) = w; }
    }
};
struct EpiSwigluMoe8 {
    static constexpr bool PERM = true;
    unsigned char* O; int ldc; const float* rsv; const int* row_tok; float wsinv;
    __device__ __forceinline__ void operator()(const f32x4 (&acc)[2][2][4][2], const Unit& u, int wr, int wc, int fr, int fq) const {
        const int row0 = u.pm * BM + wr * 64 + fr, col0 = u.pn * HALF + wc * 32 + 8 * fq;
#pragma unroll
        for (int ai = 0; ai < 2; ++ai)
#pragma unroll
            for (int m = 0; m < 4; ++m) { const int row = row0 + ai * HALF + m * 16; const int tok = row_tok[row]; const float rs = tok >= 0 ? rsv[tok] * wsinv : 0.f;
                float h[8];
#pragma unroll
                for (int n = 0; n < 2; ++n)
#pragma unroll
                    for (int j = 0; j < 4; ++j) h[n * 4 + j] = silu_f(acc[ai][0][m][n][j] * rs) * (acc[ai][1][m][n][j] * rs);
                u32x2 w; w.x = pk4_fp8(h[0], h[1], h[2], h[3]); w.y = pk4_fp8(h[4], h[5], h[6], h[7]);
                *(u32x2*)(O + (size_t)row * ldc + col0) = w; }
    }
};
struct EpiMoeDown {
    static constexpr bool PERM = false;
    float* out; const int* row_tok; const float* row_gate; float sc;
    __device__ __forceinline__ void operator()(const f32x4 (&acc)[2][2][4][2], const Unit& u, int wr, int wc, int fr, int fq) const {
        const int row0 = u.pm * BM + wr * 64 + fr, col0 = u.pn * BM + wc * 32 + 4 * fq;
#pragma unroll
        for (int ai = 0; ai < 2; ++ai)
#pragma unroll
            for (int m = 0; m < 4; ++m) { const int row = row0 + ai * HALF + m * 16; const int tok = row_tok[row]; const float g = row_gate[row] * sc;
                if (tok >= 0) { float* rp = out + (size_t)tok * D + col0;
#pragma unroll
                    for (int bj = 0; bj < 2; ++bj)
#pragma unroll
                        for (int n = 0; n < 2; ++n) { f32x4* p = (f32x4*)(rp + bj * HALF + n * 16); *p = *p + acc[ai][bj][m][n] * g; } }
                asm volatile("" ::: "memory"); }
    }
};
}

#define XB_TMO      128
#define XB_XCNT(j)  (256  + 64 * (j))
#define XB_XSUB(j)  (1280 + 64 * (j))
#define XB_XGEN(j)  (2304 + 64 * (j))
#define XB_TOP      3328
#define XB_TOPGEN   3392
#define XCD_BAR_WORDS 3456
#define XB_SPIN_CAP (1u << 18)
__device__ __forceinline__ unsigned xb_ld(unsigned* p)              { return __hip_atomic_load(p, __ATOMIC_RELAXED, __HIP_MEMORY_SCOPE_AGENT); }
__device__ __forceinline__ unsigned xb_add(unsigned* p, unsigned v) { return __hip_atomic_fetch_add(p, v, __ATOMIC_RELAXED, __HIP_MEMORY_SCOPE_AGENT); }
__device__ __forceinline__ unsigned xb_xcc_id() { return (unsigned)__builtin_amdgcn_s_getreg((3 << 11) | 20) & 0xFu; }
#define XB_SPIN(cond, bar) do { unsigned _sp = 0; while (cond) { __builtin_amdgcn_s_sleep(1); \
    if ((++_sp & 255u) == 0u) { if (xb_ld(&(bar)[XB_TMO])) break; if (_sp > XB_SPIN_CAP) { atomicAdd(&(bar)[XB_TMO], 1u); break; } } } } while (0)
struct XcdBarrier { unsigned* bar; unsigned x; volatile LAS unsigned* st; };
__device__ __forceinline__ XcdBarrier xcd_barrier_post(unsigned* bar, volatile LAS unsigned* st) {
    XcdBarrier b; b.bar = bar; b.x = xb_xcc_id(); b.st = st;
    if (threadIdx.x == 0) (void)xb_add(&bar[XB_XCNT(b.x)], 1u);
    return b;
}
__device__ __forceinline__ void xcd_barrier_complete(unsigned* bar, unsigned x, unsigned& nloc, unsigned& nx) {
    const unsigned G = gridDim.x * gridDim.y * gridDim.z;
    unsigned sum, cnt, mine, sp = 0u;
    for (;;) {
        sum = 0u; cnt = 0u; mine = 0u;
#pragma unroll
        for (unsigned j = 0; j < 16; ++j) { const unsigned c = xb_ld(&bar[XB_XCNT(j)]); sum += c; cnt += (c > 0u) ? 1u : 0u; mine = (j == x) ? c : mine; }
        if (sum == G) break;
        __builtin_amdgcn_s_sleep(1);
        if ((++sp & 255u) == 0u) { if (xb_ld(&bar[XB_TMO])) break; if (sp > XB_SPIN_CAP) { atomicAdd(&bar[XB_TMO], 1u); break; } }
    }
    nloc = mine > 0u ? mine : 1u; nx = cnt > 0u ? cnt : 1u;
}
__device__ __forceinline__ void xcd_barrier(const XcdBarrier& b) {
    asm volatile("s_waitcnt vmcnt(0)" ::: "memory");
    __syncthreads();
    if (threadIdx.x == 0) {
        unsigned* bar = b.bar;
        __builtin_amdgcn_s_waitcnt(0);
        unsigned nloc = b.st[0], nx = b.st[1];
        if (nloc == 0u) { xcd_barrier_complete(bar, b.x, nloc, nx); b.st[0] = nloc; b.st[1] = nx; }
        const unsigned old = xb_add(&bar[XB_XSUB(b.x)], 1u);
        const unsigned gen = old / nloc;
        if (old + 1u == (gen + 1u) * nloc) {
            __builtin_amdgcn_fence(__ATOMIC_RELEASE, "agent");
            asm volatile("s_waitcnt vmcnt(0)" ::: "memory");
            const unsigned og = xb_add(&bar[XB_TOP], 1u);
            const unsigned tg = og / nx;
            if (og + 1u == (tg + 1u) * nx) xb_add(&bar[XB_TOPGEN], 1u);
            else XB_SPIN(xb_ld(&bar[XB_TOPGEN]) == tg, bar);
            __builtin_amdgcn_fence(__ATOMIC_ACQUIRE, "agent");
            xb_add(&bar[XB_XGEN(b.x)], 1u);
            asm volatile("s_waitcnt vmcnt(0)" ::: "memory");
        } else {
            XB_SPIN(xb_ld(&bar[XB_XGEN(b.x)]) == gen, bar);
            __builtin_amdgcn_fence(__ATOMIC_ACQUIRE, "agent");
            asm volatile("s_waitcnt vmcnt(0)" ::: "memory");
        }
    }
    __syncthreads();
}

constexpr int NIN = 28;
struct Args { const float* in[NIN]; float* out; unsigned char* ws; int ph_lo, ph_hi; };
enum { I_X = 0, I_NORM_MIX, I_W_IN, I_W_OUT, I_SHIFT_MU, I_GM_LN_W, I_GM_LN_B, I_GM_WS, I_GM_BS, I_RW_W_UP, I_RW_W0, I_RW_A_UP, I_RW_A0, I_RW_G_UP, I_RW_K_K, I_RW_K_A, I_RW_R_K,
       I_RW_LNX_W, I_RW_LNX_B, I_NORM_FFN, I_FFN_WG, I_FFN_WU, I_FFN_WD, I_MOE_ROUTER, I_MOE_WG, I_MOE_WU, I_MOE_WD, I_NORM_FINAL };

struct Frame {
    LAS unsigned char* lds;
    int tid, lane, wave, G, gw, NGW;
};

__device__ __forceinline__ void transpose_item_fp8(const float* W, int K, int N, unsigned char* WT, int drow0, int k0, int n0, const float* gain, float scale, LAS float* scr, int lane) {
#pragma unroll 8
    for (int i = 0; i < 32; ++i) { const int kk = 2 * i + (lane >> 5); float v = W[(size_t)(k0 + kk) * N + n0 + (lane & 31)] * scale; if (gain) v *= gain[k0 + kk]; scr[kk * 33 + (lane & 31)] = v; }
    LDS_WAIT(); asm volatile("" ::: "memory");
    const int n = lane >> 1, hf = lane & 1; const LAS float* sp = scr + (32 * hf) * 33 + n; u32x4 o0, o1;
    o0.x = pk4_fp8(sp[0 * 33], sp[1 * 33], sp[2 * 33], sp[3 * 33]); o0.y = pk4_fp8(sp[4 * 33], sp[5 * 33], sp[6 * 33], sp[7 * 33]); o0.z = pk4_fp8(sp[8 * 33], sp[9 * 33], sp[10 * 33], sp[11 * 33]); o0.w = pk4_fp8(sp[12 * 33], sp[13 * 33], sp[14 * 33], sp[15 * 33]);
    o1.x = pk4_fp8(sp[16 * 33], sp[17 * 33], sp[18 * 33], sp[19 * 33]); o1.y = pk4_fp8(sp[20 * 33], sp[21 * 33], sp[22 * 33], sp[23 * 33]); o1.z = pk4_fp8(sp[24 * 33], sp[25 * 33], sp[26 * 33], sp[27 * 33]); o1.w = pk4_fp8(sp[28 * 33], sp[29 * 33], sp[30 * 33], sp[31 * 33]);
    unsigned char* dst = WT + (size_t)(drow0 + n) * K + k0 + 32 * hf; *(GAS u32x4*)dst = o0; *(GAS u32x4*)(dst + 16) = o1;
    LDS_WAIT(); asm volatile("" ::: "memory");
}
__device__ __forceinline__ void transpose_item(const float* W, int K, int N, bf16* WT, int drow0, int k0, int n0, const float* gain, LAS float* scr, int lane) {
#pragma unroll 8
    for (int i = 0; i < 32; ++i) { const int kk = 2 * i + (lane >> 5); float v = W[(size_t)(k0 + kk) * N + n0 + (lane & 31)]; if (gain) v *= gain[k0 + kk]; scr[kk * 33 + (lane & 31)] = v; }
    LDS_WAIT(); asm volatile("" ::: "memory");
    const int c = lane & 7;
#pragma unroll
    for (int j = 0; j < 4; ++j) { const int n = (lane >> 3) + 8 * j; const LAS float* s = scr + (8 * c) * 33 + n;
        u32x4 o; o.x = pk2(s[0 * 33], s[1 * 33]); o.y = pk2(s[2 * 33], s[3 * 33]); o.z = pk2(s[4 * 33], s[5 * 33]); o.w = pk2(s[6 * 33], s[7 * 33]);
        *(GAS u32x4*)(WT + (size_t)(drow0 + n) * K + k0 + 8 * c) = o; }
    LDS_WAIT(); asm volatile("" ::: "memory");
}
__device__ __forceinline__ void convert_matrix_fp8(Frame& F, const float* W, int K, int N, unsigned char* WT, int gu_mode  , const float* gain, float scale, int& itbase) {
    LAS float* scr = (LAS float*)(F.lds + F.wave * 16384);
    const int nblk = N / 32, nit = (K / 64) * nblk;
    int first = F.gw - (itbase % F.NGW); if (first < 0) first += F.NGW;
    for (int r = first; r < nit; r += F.NGW) { const int kb = r / nblk, nb = r % nblk, n0 = 32 * nb;
        const int drow0 = gu_mode == 0 ? n0 : (n0 / 128) * 256 + (gu_mode == 2 ? 128 : 0) + (n0 % 128);
        transpose_item_fp8(W, K, N, WT, drow0, 64 * kb, n0, gain, scale, scr, F.lane); }
    itbase += nit;
}
__device__ __forceinline__ void convert_matrix(Frame& F, const float* W, int K, int N, bf16* WT, int gu_mode  , const float* gain, int it0, int& itbase) {
    LAS float* scr = (LAS float*)(F.lds + F.wave * 16384);
    const int nblk = N / 32, nit = (K / 64) * nblk;
    int first = F.gw - (itbase % F.NGW); if (first < 0) first += F.NGW;
    for (int r = first; r < nit; r += F.NGW) { const int kb = r / nblk, nb = r % nblk, n0 = 32 * nb;
        const int drow0 = gu_mode == 0 ? n0 : (n0 / 128) * 256 + (gu_mode == 2 ? 128 : 0) + (n0 % 128);
        transpose_item(W, K, N, WT, drow0, 64 * kb, n0, gain, scr, F.lane); }
    itbase += nit; (void)it0;
}

__device__ __forceinline__ void gmlp_naive(Frame& F, const bf16* P, bf16* Y, const float* ln_w, const float* ln_b, const float* ws, const float* bs) {
    LAS float* V = (LAS float*)F.lds;
    for (int unit = blockIdx.x; unit < NB * (SEQ / GCH) * NH; unit += F.G) {
        const int h = unit % NH, bc = unit / NH; const size_t row0 = (size_t)bc * GCH;
        const float lw = ln_w[h * HD + F.lane], lb = ln_b[h * HD + F.lane];
        for (int i = 0; i < 16; ++i) { const int t = F.wave * 16 + i;
            const float g = gelu_erf(bf2f(P[(row0 + t) * INW + GMW + h * HD + F.lane]));
            const float mean = wave_sum(g) * (1.f / HD); const float d = g - mean; const float var = wave_sum(d * d) * (1.f / HD);
            V[t * HD + F.lane] = d * __builtin_amdgcn_rsqf(var + LN_EPS) * lw + lb; }
        __syncthreads();
        for (int i = 0; i < 16; ++i) { const int t = F.wave * 16 + i; const float* wrow = ws + ((size_t)h * GCH + t) * GCH; float acc = 0.f;
            for (int s = 0; s <= t; ++s) acc += wrow[s] * V[s * HD + F.lane];
            const float mixed = acc + bs[h * GCH + t];
            const float u = gelu_erf(bf2f(P[(row0 + t) * INW + h * HD + F.lane]));
            Y[(row0 + t) * D + h * HD + F.lane] = (bf16)f2bf(u * mixed); }
        __syncthreads();
    }
}
__device__ __forceinline__ float shifted(const bf16* P, size_t row, int t, int col, const float* mu) {
    const float c = bf2f(P[row * INW + col]); const float pr = t > 0 ? bf2f(P[(row - 1) * INW + col]) : 0.f;
    return c + (pr - c) * mu[col - 1024];
}
constexpr int NC = 32;
__device__ __forceinline__ void rwkv_naive(Frame& F, const bf16* P, bf16* Y, const float* mu, const float* w_up, const float* w0, const float* a_up, const float* a0, const float* g_up,
                                           const float* k_k, const float* k_a, const float* r_k, const float* lnx_w, const float* lnx_b) {
    LAS float* LI = (LAS float*)F.lds;
    LAS float* sR = LI + NC * 256; LAS float* sW = sR + NC * 64; LAS float* sK = sW + NC * 64; LAS float* sV = sK + NC * 64; LAS float* sA = sV + NC * 64; LAS float* sB = sA + NC * 64;
    LAS float* sG = sB + NC * 64; LAS float* sBon = sG + NC * 64;
    for (int unit = blockIdx.x; unit < NB * NH; unit += F.G) {
        const int b = unit / NH, h = unit % NH;
        float S[64];
#pragma unroll
        for (int k = 0; k < 64; ++k) S[k] = 0.f;
        for (int c = 0; c < SEQ / NC; ++c) {
            const int t0 = c * NC; const size_t row0 = (size_t)b * SEQ + t0;
            for (int idx = F.tid; idx < NC * 256; idx += 512) { const int tok = idx >> 8, j = idx & 255;
                const float x = shifted(P, row0 + tok, t0 + tok, 2560 + j, mu);
                LI[idx] = j < 64 ? tanhf(x) : (j < 128 ? x : sigmoidf_(x)); }
            __syncthreads();
            { const int ch = F.lane, hc = h * HD + ch;
              for (int i = 0; i < NC / 8; ++i) { const int tok = F.wave + 8 * i; const size_t row = row0 + tok; const int t = t0 + tok;
                const float rr = shifted(P, row, t, 1024 + hc, mu), kx = shifted(P, row, t, 1536 + hc, mu), vv = shifted(P, row, t, 2048 + hc, mu);
                float dw = w0[hc], da = a0[hc], gg = 0.f;
                for (int j = 0; j < 64; ++j) { dw += LI[tok * 256 + j] * w_up[j * RWW + hc]; da += LI[tok * 256 + 64 + j] * a_up[j * RWW + hc]; }
                for (int j = 0; j < 128; ++j) gg += LI[tok * 256 + 128 + j] * g_up[j * RWW + hc];
                const float z = -dw; const float sp = fmaxf(z, 0.f) + log1pf(__expf(-fabsf(z)));
                const float decay = __expf(-__expf(-sp - 0.5f));
                const float alr = sigmoidf_(da);
                const float kkv = kx * k_k[hc]; const float nrm = sqrtf(wave_sum(kkv * kkv)); const float kkn = kkv / fmaxf(nrm, 1e-12f);
                const float kmod = kx * (1.f + (alr - 1.f) * k_a[hc]);
                const float bsc = wave_sum(rr * kmod * r_k[hc]);
                sR[tok * 64 + ch] = rr; sW[tok * 64 + ch] = decay; sK[tok * 64 + ch] = kmod; sV[tok * 64 + ch] = vv; sA[tok * 64 + ch] = -kkn; sB[tok * 64 + ch] = kkn * alr;
                sG[tok * 64 + ch] = gg; sBon[tok * 64 + ch] = bsc * vv; } }
            __syncthreads();
            if (F.wave == 0) {
                for (int t = 0; t < NC; ++t) { float sa = 0.f;
#pragma unroll
                    for (int k = 0; k < 64; ++k) sa += S[k] * sA[t * 64 + k];
                    const float vv = sV[t * 64 + F.lane]; float yv = 0.f;
#pragma unroll
                    for (int k = 0; k < 64; ++k) { S[k] = S[k] * sW[t * 64 + k] + sa * sB[t * 64 + k] + vv * sK[t * 64 + k]; yv += S[k] * sR[t * 64 + k]; }
                    LI[t * 64 + F.lane] = yv; }
            }
            __syncthreads();
            { const int v = F.lane, hv = h * HD + v;
              for (int i = 0; i < NC / 8; ++i) { const int tok = F.wave + 8 * i; const float yv = LI[tok * 64 + v];
                const float mean = wave_sum(yv) * (1.f / HD); const float d = yv - mean; const float var = wave_sum(d * d) * (1.f / HD);
                const float yn = d * __builtin_amdgcn_rsqf(var + GN_EPS) * lnx_w[hv] + lnx_b[hv];
                Y[(row0 + tok) * D + GMW + hv] = (bf16)f2bf((yn + sBon[tok * 64 + v]) * sG[tok * 64 + v]); } }
            __syncthreads();
        }
    }
}

typedef short s16x4 __attribute__((ext_vector_type(4)));
typedef short v4i16_t __attribute__((ext_vector_type(4)));
#define MFMA32(a, b, c) __builtin_amdgcn_mfma_f32_16x16x32_bf16((a), (b), (c), 0, 0, 0)
#define MFMA16(a, b, c) __builtin_amdgcn_mfma_f32_16x16x16bf16_1k((a), (b), (c), 0, 0, 0)
__device__ __forceinline__ bf16x8 lds_row8(const LAS bf16* T, int ld, int r0, int k0, int lane) { return *(const LAS bf16x8*)(T + (r0 + (lane & 15)) * ld + k0 + 8 * (lane >> 4)); }
__device__ __forceinline__ s16x4 lds_row4(const LAS bf16* T, int ld, int r0, int k0, int lane) { return *(const LAS s16x4*)(T + (r0 + (lane & 15)) * ld + k0 + 4 * (lane >> 4)); }
__device__ __forceinline__ s16x4 lds_tr4(const LAS bf16* T, int ld, int k0, int c0, int lane) { const int i = lane & 15, g = lane >> 4;
    return __builtin_bit_cast(s16x4, __builtin_amdgcn_ds_read_tr16_b64_v4i16((LAS v4i16_t*)(T + (k0 + 4 * g + (i >> 2)) * ld + c0 + 4 * (i & 3)))); }
__device__ __forceinline__ bf16x8 lds_tr8(const LAS bf16* T, int ld, int k0, int c0, int lane) { const int i = lane & 15, g = lane >> 4;
    const LAS bf16* p = T + (k0 + 8 * g + (i >> 2)) * ld + c0 + 4 * (i & 3);
    const s16x4 lo = __builtin_bit_cast(s16x4, __builtin_amdgcn_ds_read_tr16_b64_v4i16((LAS v4i16_t*)p));
    const s16x4 hi = __builtin_bit_cast(s16x4, __builtin_amdgcn_ds_read_tr16_b64_v4i16((LAS v4i16_t*)(p + 4 * ld)));
    bf16x8 r; r[0] = lo[0]; r[1] = lo[1]; r[2] = lo[2]; r[3] = lo[3]; r[4] = hi[0]; r[5] = hi[1]; r[6] = hi[2]; r[7] = hi[3]; return r; }
typedef __bf16 bf16x2_t __attribute__((ext_vector_type(2)));
__device__ __forceinline__ unsigned cvtpk_c(float lo, float hi) { const f32x2 v = {lo, hi}; const bf16x2_t b = __builtin_convertvector(v, bf16x2_t); return __builtin_bit_cast(unsigned, b); }
__device__ __forceinline__ s16x4 pack4(const f32x4 v) { u32x2 w; w.x = cvtpk_c(v[0], v[1]); w.y = cvtpk_c(v[2], v[3]); return __builtin_bit_cast(s16x4, w); }
__device__ __forceinline__ f32x4 unpack4(const s16x4 v) { f32x4 r; r[0] = bf2f((bf16)v[0]); r[1] = bf2f((bf16)v[1]); r[2] = bf2f((bf16)v[2]); r[3] = bf2f((bf16)v[3]); return r; }
__device__ __forceinline__ void unpack8(const u32x4 w, float (&o)[8]) { o[0] = __builtin_bit_cast(float, w.x << 16); o[1] = __builtin_bit_cast(float, w.x & 0xffff0000u); o[2] = __builtin_bit_cast(float, w.y << 16); o[3] = __builtin_bit_cast(float, w.y & 0xffff0000u);
    o[4] = __builtin_bit_cast(float, w.z << 16); o[5] = __builtin_bit_cast(float, w.z & 0xffff0000u); o[6] = __builtin_bit_cast(float, w.w << 16); o[7] = __builtin_bit_cast(float, w.w & 0xffff0000u); }
__device__ __forceinline__ u32x4 pack8(const float (&v)[8]) { u32x4 w; w.x = cvtpk_c(v[0], v[1]); w.y = cvtpk_c(v[2], v[3]); w.z = cvtpk_c(v[4], v[5]); w.w = cvtpk_c(v[6], v[7]); return w; }
__device__ __forceinline__ float gelu_as(float v) {
    const float av = fabsf(v), t = __builtin_amdgcn_rcpf(av * 0.2316418882f + 1.0f);
    float q = t * 0.5307027145f + (-0.7265760135f); q = q * t + 0.7107068705f; q = q * t + (-0.142248368f); q = q * t + 0.127414796f; q = q * t;
    const float e = __builtin_amdgcn_exp2f((v * v) * (-0.72134752044f)); const float m = v * (q * e); return v < 0.f ? m : v - m;
}

constexpr int GM_V = 0, GM_U = 128 * 72 * 2;
__device__ __forceinline__ void gmlp_unit(Frame& F, int unit, const bf16* P, bf16* Y, const float* ln_w, const float* ln_b, const bf16* WsB, const float* bs) {
    LAS bf16* Vt = (LAS bf16*)(F.lds + GM_V); LAS bf16* Ut = (LAS bf16*)(F.lds + GM_U);
    const int h = unit % NH, bc = unit / NH; const size_t row0 = (size_t)bc * GCH;
    { const int t = F.tid >> 2, cq = F.tid & 3; const bf16* pr = P + (row0 + t) * INW + h * HD + 16 * cq;
      const u32x4 u0 = *(const u32x4*)pr, u1 = *(const u32x4*)(pr + 8), v0 = *(const u32x4*)(pr + GMW), v1 = *(const u32x4*)(pr + GMW + 8);
      float uu[16], vv[16]; { float a[8]; unpack8(u0, a); for (int j = 0; j < 8; ++j) uu[j] = a[j]; unpack8(u1, a); for (int j = 0; j < 8; ++j) uu[8 + j] = a[j]; unpack8(v0, a); for (int j = 0; j < 8; ++j) vv[j] = a[j]; unpack8(v1, a); for (int j = 0; j < 8; ++j) vv[8 + j] = a[j]; }
      float s = 0.f;
#pragma unroll
      for (int j = 0; j < 16; ++j) { uu[j] = gelu_as(uu[j]); vv[j] = gelu_as(vv[j]); s += vv[j]; }
      s += __shfl_xor(s, 1); s += __shfl_xor(s, 2); const float mean = s * (1.f / HD); float q = 0.f;
#pragma unroll
      for (int j = 0; j < 16; ++j) { vv[j] -= mean; q += vv[j] * vv[j]; }
      q += __shfl_xor(q, 1); q += __shfl_xor(q, 2); const float rstd = __builtin_amdgcn_rsqf(q * (1.f / HD) + LN_EPS);
#pragma unroll
      for (int j = 0; j < 16; ++j) vv[j] = vv[j] * rstd * ln_w[h * HD + 16 * cq + j] + ln_b[h * HD + 16 * cq + j];
      float a[8]; for (int j = 0; j < 8; ++j) a[j] = vv[j]; *(LAS u32x4*)(Vt + t * 72 + 16 * cq) = pack8(a); for (int j = 0; j < 8; ++j) a[j] = vv[8 + j]; *(LAS u32x4*)(Vt + t * 72 + 16 * cq + 8) = pack8(a);
      for (int j = 0; j < 8; ++j) a[j] = uu[j]; *(LAS u32x4*)(Ut + t * 72 + 16 * cq) = pack8(a); for (int j = 0; j < 8; ++j) a[j] = uu[8 + j]; *(LAS u32x4*)(Ut + t * 72 + 16 * cq + 8) = pack8(a); }
    __syncthreads();
    { const int w = F.wave, l15 = F.lane & 15, g = F.lane >> 4, t0 = 16 * w, nks = (w >> 1) + 1; const bf16* wrow = WsB + ((size_t)h * GCH + t0 + l15) * GCH + 8 * g;
      f32x4 acc[4] = {{0.f, 0.f, 0.f, 0.f}, {0.f, 0.f, 0.f, 0.f}, {0.f, 0.f, 0.f, 0.f}, {0.f, 0.f, 0.f, 0.f}};
      for (int ks = 0; ks < nks; ++ks) { const bf16x8 a = *(const bf16x8*)(wrow + 32 * ks);
#pragma unroll
          for (int nt = 0; nt < 4; ++nt) acc[nt] = MFMA32(a, lds_tr8(Vt, 72, 32 * ks, 16 * nt, F.lane), acc[nt]); }
#pragma unroll
      for (int reg = 0; reg < 4; ++reg) { const int t = t0 + 4 * g + reg; const float bsv = bs[h * GCH + t];
#pragma unroll
          for (int nt = 0; nt < 4; ++nt) { LAS bf16* up = Ut + t * 72 + 16 * nt + l15; *up = (bf16)f2bf(bf2f(*up) * (acc[nt][reg] + bsv)); } } }
    __syncthreads();
    { const int t = F.tid >> 2, cq = F.tid & 3; bf16* yr = Y + (row0 + t) * D + h * HD + 16 * cq;
      *(u32x4*)yr = *(const LAS u32x4*)(Ut + t * 72 + 16 * cq); *(u32x4*)(yr + 8) = *(const LAS u32x4*)(Ut + t * 72 + 16 * cq + 8); }
    __syncthreads();
}

struct RwkvW { const float *mu, *w0, *a0, *k_k, *k_a, *r_k, *lnx_w, *lnx_b; const bf16 *WupT, *AupT, *GupT; };
struct RwkvS { bf16 *SG, *SH, *SQ, *SS, *Sg, *SY0; float* Sbsc; };
constexpr int M1_LI = 0;
constexpr int M1_PR = 33792;
constexpr int M1_TL = M1_PR + 36864;
constexpr int M1_SEG = M1_TL + 7 * 9216;
constexpr int M1_GAM = M1_SEG + 2048;
constexpr int M1_D = M1_GAM + 256;
constexpr int M1_T = M1_D + 4096;
constexpr int M1_END = M1_T + 2048;
static_assert(M1_END <= MISC_OFF, "M1 LDS map");
__device__ __forceinline__ float fast_tanh(float x) { const float e = __expf(2.f * x); return 1.f - 2.f * __builtin_amdgcn_rcpf(e + 1.f); }

__device__ __forceinline__ void rwkv_m1_unit(Frame& F, int unit  , const bf16* P, const RwkvW& W, const RwkvS& Sc) {
    const int b = unit >> 6, c = unit & 63, t0 = c * 64; const size_t row0 = (size_t)b * SEQ + t0;
    const int w = F.wave, lane = F.lane, l15 = lane & 15, g = lane >> 4;
    LAS bf16* LI = (LAS bf16*)(F.lds + M1_LI);
    LAS float* Ef = (LAS float*)(F.lds + M1_PR); LAS float* ALf = Ef + 64 * 64;
    LAS bf16* Lab = (LAS bf16*)(F.lds + M1_PR); LAS bf16* Lak = Lab + 64 * 72; LAS bf16* Mrb = Lak + 64 * 72; LAS bf16* Mrk = Mrb + 64 * 72;
    LAS bf16* At = (LAS bf16*)(F.lds + M1_TL); LAS bf16* Bt = At + 64 * 72; LAS bf16* Kt = Bt + 64 * 72; LAS bf16* Rt = Kt + 64 * 72; LAS bf16* Bh = Rt + 64 * 72; LAS bf16* Kh = Bh + 64 * 72; LAS bf16* Vt = Kh + 64 * 72;
    LAS float* SEG = (LAS float*)(F.lds + M1_SEG); LAS float* GAM = (LAS float*)(F.lds + M1_GAM); LAS float* Dd = (LAS float*)(F.lds + M1_D); LAS bf16* Tt = (LAS bf16*)(F.lds + M1_T);
#pragma unroll
    for (int it = 0; it < 4; ++it) { const int item = F.tid + 512 * it, tok = item >> 5, jc = item & 31, j0 = 8 * jc; const size_t row = row0 + tok;
        float cv[8], pv[8]; unpack8(*(const u32x4*)(P + row * INW + 2560 + j0), cv);
        if (t0 + tok > 0) unpack8(*(const u32x4*)(P + (row - 1) * INW + 2560 + j0), pv); else { for (int j = 0; j < 8; ++j) pv[j] = 0.f; }
        const f32x4 m0 = *(const f32x4*)(W.mu + 1536 + j0), m1 = *(const f32x4*)(W.mu + 1536 + j0 + 4); float o[8];
#pragma unroll
        for (int j = 0; j < 8; ++j) { const float x = cv[j] + (pv[j] - cv[j]) * (j < 4 ? m0[j] : m1[j - 4]); o[j] = jc < 8 ? fast_tanh(x) : (jc < 16 ? x : sigmoidf_(x)); }
        *(LAS u32x4*)(LI + tok * 264 + j0) = pack8(o); }
    __syncthreads();
    for (int h = 0; h < NH; ++h) {
        const size_t uh = ((size_t)unit * NH + h) * 4096;
        { const int mt = w & 3, ntb = 2 * (w >> 2); const int chrow = h * HD + 16 * mt + l15;
          f32x4 aw[2] = {{0.f, 0.f, 0.f, 0.f}, {0.f, 0.f, 0.f, 0.f}}, aa[2] = {{0.f, 0.f, 0.f, 0.f}, {0.f, 0.f, 0.f, 0.f}}, ag[2] = {{0.f, 0.f, 0.f, 0.f}, {0.f, 0.f, 0.f, 0.f}};
#pragma unroll
          for (int ks = 0; ks < 2; ++ks) { const bf16x8 fw = *(const bf16x8*)(W.WupT + (size_t)chrow * 64 + 32 * ks + 8 * g), fa = *(const bf16x8*)(W.AupT + (size_t)chrow * 64 + 32 * ks + 8 * g);
#pragma unroll
              for (int q = 0; q < 2; ++q) { aw[q] = MFMA32(fw, lds_row8(LI, 264, 16 * (ntb + q), 32 * ks, lane), aw[q]); aa[q] = MFMA32(fa, lds_row8(LI, 264, 16 * (ntb + q), 64 + 32 * ks, lane), aa[q]); } }
#pragma unroll
          for (int ks = 0; ks < 4; ++ks) { const bf16x8 fg = *(const bf16x8*)(W.GupT + (size_t)chrow * 128 + 32 * ks + 8 * g);
#pragma unroll
              for (int q = 0; q < 2; ++q) ag[q] = MFMA32(fg, lds_row8(LI, 264, 16 * (ntb + q), 128 + 32 * ks, lane), ag[q]); }
          const int ch0 = 16 * mt + 4 * g; const f32x4 w0v = *(const f32x4*)(W.w0 + h * HD + ch0), a0v = *(const f32x4*)(W.a0 + h * HD + ch0);
#pragma unroll
          for (int q = 0; q < 2; ++q) { const int tok = 16 * (ntb + q) + l15; f32x4 ev, av;
#pragma unroll
              for (int r = 0; r < 4; ++r) { const float z = -(aw[q][r] + w0v[r]); const float sp = fmaxf(z, 0.f) + __logf(1.f + __expf(-fabsf(z))); ev[r] = -__expf(-sp - 0.5f); av[r] = sigmoidf_(aa[q][r] + a0v[r]); }
              *(LAS f32x4*)(Ef + tok * 64 + ch0) = ev; *(LAS f32x4*)(ALf + tok * 64 + ch0) = av;
              u32x2 gw; gw.x = cvtpk_c(ag[q][0], ag[q][1]); gw.y = cvtpk_c(ag[q][2], ag[q][3]); *(u32x2*)(Sc.Sg + (row0 + tok) * RWW + h * HD + ch0) = gw; } }
        __syncthreads();
        { const int ch = F.tid & 63, seg = F.tid >> 6; float run = 0.f;
#pragma unroll
          for (int i = 0; i < 8; ++i) { run += Ef[(8 * seg + i) * 64 + ch]; Ef[(8 * seg + i) * 64 + ch] = run; }
          SEG[seg * 64 + ch] = run; }
        __syncthreads();
        { const int ch = F.tid & 63, seg = F.tid >> 6; float off = 0.f;
          for (int s2 = 0; s2 < seg; ++s2) off += SEG[s2 * 64 + ch];
#pragma unroll
          for (int i = 0; i < 8; ++i) Ef[(8 * seg + i) * 64 + ch] += off; }
        __syncthreads();
        { const int tok = F.tid >> 3, cg = F.tid & 7, ch0 = 8 * cg, hc0 = h * HD + ch0; const size_t row = row0 + tok; const bool has_prev = (t0 + tok) > 0;
          float rr[8], kx[8], vv[8], tmp[8], pr[8];
#define SHIFT_LOAD(dst, col) do { unpack8(*(const u32x4*)(P + row * INW + (col)), dst); if (has_prev) unpack8(*(const u32x4*)(P + (row - 1) * INW + (col)), pr); else { for (int j = 0; j < 8; ++j) pr[j] = 0.f; } \
              const f32x4 m0 = *(const f32x4*)(W.mu + (col) - 1024), m1 = *(const f32x4*)(W.mu + (col) - 1024 + 4); for (int j = 0; j < 8; ++j) dst[j] = dst[j] + (pr[j] - dst[j]) * (j < 4 ? m0[j] : m1[j - 4]); } while (0)
          SHIFT_LOAD(rr, 1024 + hc0); SHIFT_LOAD(kx, 1536 + hc0); SHIFT_LOAD(vv, 2048 + hc0);
          (void)tmp;
          float Lt[8], Lm[8], Lc[8], al[8];
#pragma unroll
          for (int j = 0; j < 8; ++j) { Lt[j] = Ef[tok * 64 + ch0 + j]; Lm[j] = tok > 0 ? Ef[(tok - 1) * 64 + ch0 + j] : 0.f; Lc[j] = Ef[63 * 64 + ch0 + j]; al[j] = ALf[tok * 64 + ch0 + j]; }
          float kk[8], km[8]; float ss = 0.f, bs_ = 0.f;
#pragma unroll
          for (int j = 0; j < 8; ++j) { kk[j] = kx[j] * W.k_k[hc0 + j]; ss += kk[j] * kk[j]; km[j] = kx[j] * (1.f + (al[j] - 1.f) * W.k_a[hc0 + j]); bs_ += rr[j] * km[j] * W.r_k[hc0 + j]; }
          ss += __shfl_xor(ss, 1); ss += __shfl_xor(ss, 2); ss += __shfl_xor(ss, 4); bs_ += __shfl_xor(bs_, 1); bs_ += __shfl_xor(bs_, 2); bs_ += __shfl_xor(bs_, 4);
          const float inv = 1.f / fmaxf(sqrtf(ss), 1e-12f);
          if (cg == 0) Sc.Sbsc[row * NH + h] = bs_;
          float oA[8], oB[8], oK[8], oR[8], oBh[8], oKh[8];
#pragma unroll
          for (int j = 0; j < 8; ++j) { const float kn = kk[j] * inv, bb = kn * al[j]; const float einv = __expf(-Lt[j]), ec = __expf(Lc[j] - Lt[j]);
              oA[j] = -kn * __expf(Lm[j]); oB[j] = bb * einv; oK[j] = km[j] * einv; oR[j] = rr[j] * __expf(Lt[j]); oBh[j] = bb * ec; oKh[j] = km[j] * ec; }
          *(LAS u32x4*)(At + tok * 72 + ch0) = pack8(oA); *(LAS u32x4*)(Bt + tok * 72 + ch0) = pack8(oB); *(LAS u32x4*)(Kt + tok * 72 + ch0) = pack8(oK); *(LAS u32x4*)(Rt + tok * 72 + ch0) = pack8(oR);
          *(LAS u32x4*)(Bh + tok * 72 + ch0) = pack8(oBh); *(LAS u32x4*)(Kh + tok * 72 + ch0) = pack8(oKh); *(LAS u32x4*)(Vt + tok * 72 + ch0) = pack8(vv);
          if (tok == 63) { for (int j = 0; j < 8; ++j) GAM[ch0 + j] = __expf(Lc[j]); } }
        __syncthreads();
        for (int i5 = 0; i5 < 5; ++i5) { const int q = w + 8 * i5, mat = q / 10, idx = q % 10; const int ti = idx < 1 ? 0 : (idx < 3 ? 1 : (idx < 6 ? 2 : 3)), si = idx - ti * (ti + 1) / 2;
            const LAS bf16* X = mat < 2 ? At : Rt; const LAS bf16* Yk = (mat & 1) ? Kt : Bt; LAS bf16* O = Lab + mat * 64 * 72;
            f32x4 acc = {0.f, 0.f, 0.f, 0.f};
#pragma unroll
            for (int ks = 0; ks < 2; ++ks) acc = MFMA32(lds_row8(Yk, 72, 16 * si, 32 * ks, lane), lds_row8(X, 72, 16 * ti, 32 * ks, lane), acc);
            const int t = 16 * ti + l15, s0 = 16 * si + 4 * g;
#pragma unroll
            for (int r = 0; r < 4; ++r) { const bool keep = mat < 2 ? (s0 + r < t) : (s0 + r <= t); if (!keep) acc[r] = 0.f; }
            *(LAS s16x4*)(O + t * 72 + s0) = pack4(acc);
            if (mat == 0 && ti == si) *(LAS f32x4*)(Dd + ti * 256 + l15 * 16 + 4 * g) = acc; }
        __syncthreads();
        if (w == 7) { const int i = lane >> 4, cc = lane & 15; const LAS float* Db = Dd + i * 256; float tv[16];
#pragma unroll
            for (int r = 0; r < 16; ++r) { float sum = (r == cc) ? 1.f : 0.f;
#pragma unroll
                for (int s2 = 0; s2 < r; ++s2) sum += Db[r * 16 + s2] * tv[s2];
                tv[r] = sum; }
#pragma unroll
            for (int r = 0; r < 16; ++r) Tt[i * 256 + r * 16 + cc] = (bf16)f2bf(tv[r]); }
        __syncthreads();
        { const bool isU = w < 4; const int cw = w & 3;
          f32x4 X[4];
#pragma unroll
          for (int i = 0; i < 4; ++i) { f32x4 z = {0.f, 0.f, 0.f, 0.f};
              if (isU) {
#pragma unroll
                  for (int j = 0; j <= i; ++j) z = MFMA16(lds_row4(Lak, 72, 16 * i, 16 * j, lane), lds_tr4(Vt, 72, 16 * j, 16 * cw, lane), z);
              } else z = unpack4(lds_tr4(At, 72, 16 * i, 16 * cw, lane));
#pragma unroll
              for (int j = 0; j < i; ++j) z = MFMA16(lds_row4(Lab, 72, 16 * i, 16 * j, lane), pack4(X[j]), z);
              const f32x4 zero = {0.f, 0.f, 0.f, 0.f};
              X[i] = MFMA16(lds_row4(Tt + i * 256, 16, 0, 0, lane), pack4(z), zero); }
          s16x4 Xp[4];
#pragma unroll
          for (int i = 0; i < 4; ++i) Xp[i] = pack4(X[i]);
          if (isU) {
#pragma unroll
              for (int nt = 0; nt < 4; ++nt) { f32x4 acc = {0.f, 0.f, 0.f, 0.f};
#pragma unroll
                  for (int i = 0; i < 4; ++i) { acc = MFMA16(Xp[i], lds_tr4(Bh, 72, 16 * i, 16 * nt, lane), acc); acc = MFMA16(lds_tr4(Vt, 72, 16 * i, 16 * cw, lane), lds_tr4(Kh, 72, 16 * i, 16 * nt, lane), acc); }
                  *(s16x4*)(Sc.SH + uh + (size_t)(16 * nt + l15) * 64 + 16 * cw + 4 * g) = pack4(acc); }
#pragma unroll
              for (int mt = 0; mt < 4; ++mt) { f32x4 acc = {0.f, 0.f, 0.f, 0.f};
#pragma unroll
                  for (int i = 0; i <= mt; ++i) { acc = MFMA16(lds_row4(Mrb, 72, 16 * mt, 16 * i, lane), Xp[i], acc); acc = MFMA16(lds_row4(Mrk, 72, 16 * mt, 16 * i, lane), lds_tr4(Vt, 72, 16 * i, 16 * cw, lane), acc); }
                  *(s16x4*)(Sc.SY0 + uh + (size_t)(16 * cw + l15) * 64 + 16 * mt + 4 * g) = pack4(acc); }
          } else {
              const float gamv = GAM[16 * cw + l15];
#pragma unroll
              for (int nt = 0; nt < 4; ++nt) { f32x4 acc = {0.f, 0.f, 0.f, 0.f};
#pragma unroll
                  for (int i = 0; i < 4; ++i) acc = MFMA16(Xp[i], lds_tr4(Bh, 72, 16 * i, 16 * nt, lane), acc);
                  { const float gam = (nt == cw) ? gamv : 0.f;
#pragma unroll
                      for (int r = 0; r < 4; ++r) acc[r] += (l15 == 4 * g + r) ? gam : 0.f; }
                  *(s16x4*)(Sc.SG + uh + (size_t)(16 * nt + l15) * 64 + 16 * cw + 4 * g) = pack4(acc); }
#pragma unroll
              for (int mt = 0; mt < 4; ++mt) { f32x4 acc = unpack4(lds_tr4(Rt, 72, 16 * mt, 16 * cw, lane));
#pragma unroll
                  for (int i = 0; i <= mt; ++i) acc = MFMA16(lds_row4(Mrb, 72, 16 * mt, 16 * i, lane), Xp[i], acc);
                  *(s16x4*)(Sc.SQ + uh + (size_t)(16 * cw + l15) * 64 + 16 * mt + 4 * g) = pack4(acc); }
          } }
        __syncthreads();
    }
}

constexpr int M1V_LI = 0;
constexpr int M1V_PR = 33792;
constexpr int M1V_TL = M1V_PR + 36864;
constexpr int M1V_SEG = M1V_TL + 5 * 9216;
constexpr int M1V_GAM = M1V_SEG + 2048;
constexpr int M1V_CST = M1V_GAM + 256;
constexpr int M1V_END = M1V_CST + 8 * 2048;
static_assert(M1V_END <= MISC_OFF, "M1 v2 LDS map");
__device__ __forceinline__ void rwkv_m1_consts(Frame& F, const RwkvW& W) {
    LAS float* CST = (LAS float*)(F.lds + M1V_CST);
    for (int i = F.tid; i < 1536; i += 512) CST[i] = W.mu[i];
    CST[3 * 512 + F.tid] = W.k_k[F.tid]; CST[4 * 512 + F.tid] = W.k_a[F.tid]; CST[5 * 512 + F.tid] = W.r_k[F.tid]; CST[6 * 512 + F.tid] = W.w0[F.tid]; CST[7 * 512 + F.tid] = W.a0[F.tid];
    __syncthreads();
}
__device__ __forceinline__ void rwkv_m1v2_unit(Frame& F, int unit  , const bf16* P, const RwkvW& W, const RwkvS& Sc) {
    const int b = unit >> 6, c = unit & 63, t0 = c * 64; const size_t row0 = (size_t)b * SEQ + t0;
    const int w = F.wave, lane = F.lane, l15 = lane & 15, g = lane >> 4;
    LAS bf16* LI = (LAS bf16*)(F.lds + M1V_LI);
    LAS float* Ef = (LAS float*)(F.lds + M1V_PR); constexpr int ES = 68; LAS float* ALf = Ef + 64 * ES;
    LAS bf16* Lab = (LAS bf16*)(F.lds + M1V_PR); LAS bf16* Lak = Lab + 64 * 72; LAS bf16* Mrb = Lak + 64 * 72; LAS bf16* Mrk = Mrb + 64 * 72;
    LAS bf16* At = (LAS bf16*)(F.lds + M1V_TL); LAS bf16* Bt = At + 64 * 72; LAS bf16* Kt = Bt + 64 * 72; LAS bf16* Rt = Kt + 64 * 72; LAS bf16* Vt = Rt + 64 * 72;
    LAS float* SEG = (LAS float*)(F.lds + M1V_SEG); LAS float* GAM = (LAS float*)(F.lds + M1V_GAM); const LAS float* CST = (const LAS float*)(F.lds + M1V_CST);
    bf16x8 wfw[2], wfa[2], wfg[4]; u32x4 pfc[3], pfp[3];
    const int ea_mt = w & 3, ea_ntb = 2 * (w >> 2);
    const int eb_tok = F.tid >> 3, eb_cg = F.tid & 7; const size_t eb_row = row0 + eb_tok; const bool eb_prev = (t0 + eb_tok) > 0;
#define M1_LOAD_W(hh) do { const int chrow_ = (hh) * HD + 16 * ea_mt + l15; \
        wfw[0] = *(const bf16x8*)(W.WupT + (size_t)chrow_ * 64 + 8 * g); wfw[1] = *(const bf16x8*)(W.WupT + (size_t)chrow_ * 64 + 32 + 8 * g); \
        wfa[0] = *(const bf16x8*)(W.AupT + (size_t)chrow_ * 64 + 8 * g); wfa[1] = *(const bf16x8*)(W.AupT + (size_t)chrow_ * 64 + 32 + 8 * g); \
        _Pragma("unroll") for (int ks_ = 0; ks_ < 4; ++ks_) wfg[ks_] = *(const bf16x8*)(W.GupT + (size_t)chrow_ * 128 + 32 * ks_ + 8 * g); } while (0)
#define M1_LOAD_P(hh) do { const int hc_ = (hh) * HD + 8 * eb_cg; \
        _Pragma("unroll") for (int a_ = 0; a_ < 3; ++a_) { pfc[a_] = *(const u32x4*)(P + eb_row * INW + 1024 + 512 * a_ + hc_); \
            if (eb_prev) pfp[a_] = *(const u32x4*)(P + (eb_row - 1) * INW + 1024 + 512 * a_ + hc_); else pfp[a_] = (u32x4){0u, 0u, 0u, 0u}; } } while (0)
#pragma unroll
    for (int it = 0; it < 4; ++it) { const int item = F.tid + 512 * it, tok = item >> 5, jc = item & 31, j0 = 8 * jc; const size_t row = row0 + tok;
        float cv[8], pv[8]; unpack8(*(const u32x4*)(P + row * INW + 2560 + j0), cv);
        if (t0 + tok > 0) unpack8(*(const u32x4*)(P + (row - 1) * INW + 2560 + j0), pv); else { for (int j = 0; j < 8; ++j) pv[j] = 0.f; }
        const f32x4 m0 = *(const f32x4*)(W.mu + 1536 + j0), m1 = *(const f32x4*)(W.mu + 1536 + j0 + 4); float o[8];
#pragma unroll
        for (int j = 0; j < 8; ++j) { const float x = cv[j] + (pv[j] - cv[j]) * (j < 4 ? m0[j] : m1[j - 4]); o[j] = jc < 8 ? fast_tanh(x) : (jc < 16 ? x : sigmoidf_(x)); }
        *(LAS u32x4*)(LI + tok * 264 + j0) = pack8(o); }
    __syncthreads();
    const int rp_ea = (PROBE_STAGE == 1) ? 2 - (F.G > 100000) : 1, rp_eb = (PROBE_STAGE == 2) ? 2 - (F.G > 100000) : 1, rp_p1 = (PROBE_STAGE == 3) ? 2 - (F.G > 100000) : 1, rp_ch = (PROBE_STAGE == 4) ? 2 - (F.G > 100000) : 1;
    for (int hi_ = 0; hi_ < NH; ++hi_) { const int h = (hi_ + (int)blockIdx.x) & (NH - 1);
        const size_t uh = ((size_t)unit * NH + h) * 4096;
        for (int rp = 0; rp < rp_ea; ++rp) { M1_LOAD_W(h);
          f32x4 aw[2] = {{0.f, 0.f, 0.f, 0.f}, {0.f, 0.f, 0.f, 0.f}}, aa[2] = {{0.f, 0.f, 0.f, 0.f}, {0.f, 0.f, 0.f, 0.f}}, ag[2] = {{0.f, 0.f, 0.f, 0.f}, {0.f, 0.f, 0.f, 0.f}};
#pragma unroll
          for (int ks = 0; ks < 2; ++ks)
#pragma unroll
              for (int q = 0; q < 2; ++q) { aw[q] = MFMA32(wfw[ks], lds_row8(LI, 264, 16 * (ea_ntb + q), 32 * ks, lane), aw[q]); aa[q] = MFMA32(wfa[ks], lds_row8(LI, 264, 16 * (ea_ntb + q), 64 + 32 * ks, lane), aa[q]); }
#pragma unroll
          for (int ks = 0; ks < 4; ++ks)
#pragma unroll
              for (int q = 0; q < 2; ++q) ag[q] = MFMA32(wfg[ks], lds_row8(LI, 264, 16 * (ea_ntb + q), 128 + 32 * ks, lane), ag[q]);
          const int ch0 = 16 * ea_mt + 4 * g; const f32x4 w0v = *(const LAS f32x4*)(CST + 6 * 512 + h * HD + ch0), a0v = *(const LAS f32x4*)(CST + 7 * 512 + h * HD + ch0);
#pragma unroll
          for (int q = 0; q < 2; ++q) { const int tok = 16 * (ea_ntb + q) + l15; f32x4 ev, av;
#pragma unroll
              for (int r = 0; r < 4; ++r) { ev[r] = -0.60653066f * __builtin_amdgcn_rcpf(1.f + __expf(-(aw[q][r] + w0v[r]))); av[r] = __builtin_amdgcn_rcpf(1.f + __expf(-(aa[q][r] + a0v[r]))); }
              *(LAS f32x4*)(Ef + tok * ES + ch0) = ev; *(LAS f32x4*)(ALf + tok * ES + ch0) = av;
              u32x2 gw; gw.x = cvtpk_c(ag[q][0], ag[q][1]); gw.y = cvtpk_c(ag[q][2], ag[q][3]); *(u32x2*)(Sc.Sg + (row0 + tok) * RWW + h * HD + ch0) = gw; } }
        __syncthreads();
        { const int ch = F.tid & 63, seg = F.tid >> 6; float run = 0.f;
#pragma unroll
          for (int i = 0; i < 8; ++i) { run += Ef[(8 * seg + i) * ES + ch]; Ef[(8 * seg + i) * ES + ch] = run; }
          SEG[seg * 64 + ch] = run; }
        __syncthreads();
        { const int ch = F.tid & 63, seg = F.tid >> 6; float off = 0.f;
          for (int s2 = 0; s2 < seg; ++s2) off += SEG[s2 * 64 + ch];
#pragma unroll
          for (int i = 0; i < 8; ++i) Ef[(8 * seg + i) * ES + ch] += off; }
        __syncthreads();
        for (int rp = 0; rp < rp_eb; ++rp) { const int tok = eb_tok, ch0 = 8 * eb_cg, hc0 = h * HD + ch0;
          float rr[8], kx[8], vv[8], pr[8];
#define M1_SHIFT(dst, a_) do { unpack8(pfc[a_], dst); unpack8(pfp[a_], pr); const f32x4 m0 = *(const LAS f32x4*)(CST + (a_) * 512 + hc0), m1 = *(const LAS f32x4*)(CST + (a_) * 512 + hc0 + 4); \
              _Pragma("unroll") for (int j = 0; j < 8; ++j) dst[j] = dst[j] + (pr[j] - dst[j]) * (j < 4 ? m0[j] : m1[j - 4]); } while (0)
          M1_LOAD_P(h); M1_SHIFT(rr, 0); M1_SHIFT(kx, 1); M1_SHIFT(vv, 2);
          float Lt[8], Lm[8], al[8], ckk[8], cka[8], crk[8];
#pragma unroll
          for (int j = 0; j < 8; ++j) { Lt[j] = Ef[tok * ES + ch0 + j]; Lm[j] = tok > 0 ? Ef[(tok - 1) * ES + ch0 + j] : 0.f; al[j] = ALf[tok * ES + ch0 + j]; ckk[j] = CST[3 * 512 + hc0 + j]; cka[j] = CST[4 * 512 + hc0 + j]; crk[j] = CST[5 * 512 + hc0 + j]; }
          float kk[8], km[8]; float ss = 0.f, bs_ = 0.f;
#pragma unroll
          for (int j = 0; j < 8; ++j) { kk[j] = kx[j] * ckk[j]; ss += kk[j] * kk[j]; km[j] = kx[j] * (1.f + (al[j] - 1.f) * cka[j]); bs_ += rr[j] * km[j] * crk[j]; }
          ss += __shfl_xor(ss, 1); ss += __shfl_xor(ss, 2); ss += __shfl_xor(ss, 4); bs_ += __shfl_xor(bs_, 1); bs_ += __shfl_xor(bs_, 2); bs_ += __shfl_xor(bs_, 4);
          const float inv = 1.f / fmaxf(sqrtf(ss), 1e-12f);
          if (eb_cg == 0) Sc.Sbsc[eb_row * NH + h] = bs_;
          float oA[8], oB[8], oK[8], oR[8];
#pragma unroll
          for (int j = 0; j < 8; ++j) { const float kn = kk[j] * inv, bb = kn * al[j]; const float eL = __expf(Lt[j]), einv = __builtin_amdgcn_rcpf(eL);
              oA[j] = -kn * __expf(Lm[j]); oB[j] = bb * einv; oK[j] = km[j] * einv; oR[j] = rr[j] * eL; if (tok == 63) GAM[ch0 + j] = eL; }
          *(LAS u32x4*)(At + tok * 72 + ch0) = pack8(oA); *(LAS u32x4*)(Bt + tok * 72 + ch0) = pack8(oB); *(LAS u32x4*)(Kt + tok * 72 + ch0) = pack8(oK); *(LAS u32x4*)(Rt + tok * 72 + ch0) = pack8(oR);
          *(LAS u32x4*)(Vt + tok * 72 + ch0) = pack8(vv); }
        __syncthreads();
        for (int rp = 0; rp < rp_p1; ++rp) for (int i5 = 0; i5 < 5; ++i5) { const int q = w + 8 * i5, mat = q / 10, idx = q % 10; const int ti = idx < 1 ? 0 : (idx < 3 ? 1 : (idx < 6 ? 2 : 3)), si = idx - ti * (ti + 1) / 2;
            const LAS bf16* X = mat < 2 ? At : Rt; const LAS bf16* Yk = (mat & 1) ? Kt : Bt; LAS bf16* O = Lab + mat * 64 * 72;
            f32x4 acc = {0.f, 0.f, 0.f, 0.f};
#pragma unroll
            for (int ks = 0; ks < 2; ++ks) acc = MFMA32(lds_row8(Yk, 72, 16 * si, 32 * ks, lane), lds_row8(X, 72, 16 * ti, 32 * ks, lane), acc);
            const int t = 16 * ti + l15, s0 = 16 * si + 4 * g; const int lim = mat < 2 ? t : t + 1;
#pragma unroll
            for (int r = 0; r < 4; ++r) acc[r] = (s0 + r < lim) ? acc[r] : 0.f;
            *(LAS s16x4*)(O + t * 72 + s0) = pack4(acc); }
        __syncthreads();
        for (int rp = 0; rp < rp_ch; ++rp) { const bool isU = w < 4; const int cw = w & 3; const f32x4 zero = {0.f, 0.f, 0.f, 0.f};
          s16x4 TTp[4];
#pragma unroll
          for (int hb = 0; hb < 2; ++hb) { s16x4 fr[2], ft[2];
#pragma unroll
            for (int i = 0; i < 2; ++i) { fr[i] = lds_row4(Lab, 72, 16 * (2 * hb + i), 16 * (2 * hb + i), lane); ft[i] = lds_tr4(Lab, 72, 16 * (2 * hb + i), 16 * (2 * hb + i), lane); }
            f32x4 L2[2], L2T[2], L4[2], L4T[2], L8[2], TT[2]; s16x4 pL2[2], pL2T[2], pL4[2], pL4T[2];
#pragma unroll
            for (int i = 0; i < 2; ++i) { L2[i] = MFMA16(fr[i], ft[i], zero); L2T[i] = MFMA16(ft[i], fr[i], zero); }
#pragma unroll
            for (int i = 0; i < 2; ++i) { pL2[i] = pack4(L2[i]); pL2T[i] = pack4(L2T[i]); TT[i] = unpack4(fr[i]);
#pragma unroll
                for (int r = 0; r < 4; ++r) TT[i][r] += (l15 == 4 * g + r) ? 1.f : 0.f; }
#pragma unroll
            for (int i = 0; i < 2; ++i) { L4[i] = MFMA16(pL2T[i], pL2[i], zero); L4T[i] = MFMA16(pL2[i], pL2T[i], zero); TT[i] = MFMA16(pL2[i], pack4(TT[i]), TT[i]); }
#pragma unroll
            for (int i = 0; i < 2; ++i) { pL4[i] = pack4(L4[i]); pL4T[i] = pack4(L4T[i]); }
#pragma unroll
            for (int i = 0; i < 2; ++i) { L8[i] = MFMA16(pL4T[i], pL4[i], zero); TT[i] = MFMA16(pL4[i], pack4(TT[i]), TT[i]); }
#pragma unroll
            for (int i = 0; i < 2; ++i) { TT[i] = MFMA16(pack4(L8[i]), pack4(TT[i]), TT[i]); TTp[2 * hb + i] = pack4(TT[i]); } }
          s16x4 Vf[4]; f32x4 z[4];
          if (isU) { s16x4 lk[10];
#pragma unroll
              for (int j = 0; j < 4; ++j) Vf[j] = lds_tr4(Vt, 72, 16 * j, 16 * cw, lane);
#pragma unroll
              for (int i = 0; i < 4; ++i)
#pragma unroll
                  for (int j = 0; j <= i; ++j) lk[i * (i + 1) / 2 + j] = lds_row4(Lak, 72, 16 * i, 16 * j, lane);
#pragma unroll
              for (int i = 0; i < 4; ++i) { z[i] = zero;
#pragma unroll
                  for (int j = 0; j <= i; ++j) z[i] = MFMA16(lk[i * (i + 1) / 2 + j], Vf[j], z[i]); }
          } else {
#pragma unroll
              for (int i = 0; i < 4; ++i) { Vf[i] = (s16x4){0, 0, 0, 0}; z[i] = unpack4(lds_tr4(At, 72, 16 * i, 16 * cw, lane)); } }
          s16x4 Xp[4];
          { s16x4 lb[6];
#pragma unroll
            for (int i = 1; i < 4; ++i)
#pragma unroll
                for (int j = 0; j < i; ++j) lb[i * (i - 1) / 2 + j] = lds_row4(Lab, 72, 16 * i, 16 * j, lane);
#pragma unroll
            for (int i = 0; i < 4; ++i) { f32x4 zz = z[i];
#pragma unroll
                for (int j = 0; j < i; ++j) zz = MFMA16(lb[i * (i - 1) / 2 + j], Xp[j], zz);
                Xp[i] = pack4(MFMA16(TTp[i], pack4(zz), zero)); } }
          if (isU) {
#pragma unroll
              for (int nt = 0; nt < 4; ++nt) { s16x4 bf_[4], kf_[4];
#pragma unroll
                  for (int i = 0; i < 4; ++i) { bf_[i] = lds_tr4(Bt, 72, 16 * i, 16 * nt, lane); kf_[i] = lds_tr4(Kt, 72, 16 * i, 16 * nt, lane); }
                  f32x4 a1 = zero, a2 = zero;
#pragma unroll
                  for (int i = 0; i < 4; ++i) { a1 = MFMA16(Xp[i], bf_[i], a1); a2 = MFMA16(Vf[i], kf_[i], a2); }
                  const float gm = GAM[16 * nt + l15]; const f32x4 acc = (a1 + a2) * gm;
                  *(s16x4*)(Sc.SH + uh + (size_t)(16 * nt + l15) * 64 + 16 * cw + 4 * g) = pack4(acc); }
#pragma unroll
              for (int mt = 0; mt < 4; ++mt) { s16x4 mb[4], mk[4];
#pragma unroll
                  for (int i = 0; i <= mt; ++i) { mb[i] = lds_row4(Mrb, 72, 16 * mt, 16 * i, lane); mk[i] = lds_row4(Mrk, 72, 16 * mt, 16 * i, lane); }
                  f32x4 a1 = zero, a2 = zero;
#pragma unroll
                  for (int i = 0; i <= mt; ++i) { a1 = MFMA16(mb[i], Xp[i], a1); a2 = MFMA16(mk[i], Vf[i], a2); }
                  *(s16x4*)(Sc.SY0 + uh + (size_t)(16 * cw + l15) * 64 + 16 * mt + 4 * g) = pack4(a1 + a2); }
          } else {
#pragma unroll
              for (int nt = 0; nt < 4; ++nt) { s16x4 bf_[4];
#pragma unroll
                  for (int i = 0; i < 4; ++i) bf_[i] = lds_tr4(Bt, 72, 16 * i, 16 * nt, lane);
                  f32x4 a1 = zero, a2 = zero;
                  a1 = MFMA16(Xp[0], bf_[0], a1); a2 = MFMA16(Xp[1], bf_[1], a2); a1 = MFMA16(Xp[2], bf_[2], a1); a2 = MFMA16(Xp[3], bf_[3], a2);
                  f32x4 acc = a1 + a2; const float gm = GAM[16 * nt + l15]; const float dg = (nt == cw) ? 1.f : 0.f;
#pragma unroll
                  for (int r = 0; r < 4; ++r) acc[r] = (acc[r] + ((l15 == 4 * g + r) ? dg : 0.f)) * gm;
                  *(s16x4*)(Sc.SG + uh + (size_t)(16 * nt + l15) * 64 + 16 * cw + 4 * g) = pack4(acc); }
#pragma unroll
              for (int mt = 0; mt < 4; ++mt) { s16x4 mb[4]; const s16x4 rf = lds_tr4(Rt, 72, 16 * mt, 16 * cw, lane);
#pragma unroll
                  for (int i = 0; i <= mt; ++i) mb[i] = lds_row4(Mrb, 72, 16 * mt, 16 * i, lane);
                  f32x4 acc = unpack4(rf);
#pragma unroll
                  for (int i = 0; i <= mt; ++i) acc = MFMA16(mb[i], Xp[i], acc);
                  *(s16x4*)(Sc.SQ + uh + (size_t)(16 * cw + l15) * 64 + 16 * mt + 4 * g) = pack4(acc); }
          } }
        __syncthreads();
    }
#undef M1_LOAD_W
#undef M1_LOAD_P
#undef M1_SHIFT
}

constexpr int M2_S = 0;
__device__ __forceinline__ void rwkv_m2_unit(Frame& F, int unit  , const RwkvS& Sc) {
    const int b = unit >> 3, h = unit & 7; const int w = F.wave, lane = F.lane, l15 = lane & 15, g = lane >> 4; const int mt = w >> 1, ntb = 2 * (w & 1);
    LAS bf16* Sb = (LAS bf16*)(F.lds + M2_S);
    f32x4 acc[2] = {{0.f, 0.f, 0.f, 0.f}, {0.f, 0.f, 0.f, 0.f}};
    for (int c = 0; c < 64; ++c) {
        const size_t uh = ((size_t)(b * 64 + c) * NH + h) * 4096; LAS bf16* buf = Sb + (c & 1) * 64 * 72;
        bf16x8 Gf[2][2]; u32x2 Hf[2];
#pragma unroll
        for (int q = 0; q < 2; ++q) { const size_t ro = uh + (size_t)(16 * (ntb + q) + l15) * 64;
            Gf[q][0] = *(const bf16x8*)(Sc.SG + ro + 8 * g); Gf[q][1] = *(const bf16x8*)(Sc.SG + ro + 32 + 8 * g); Hf[q] = *(const u32x2*)(Sc.SH + ro + 16 * mt + 4 * g); }
#pragma unroll
        for (int q = 0; q < 2; ++q) { const s16x4 p = pack4(acc[q]); *(LAS s16x4*)(buf + (16 * (ntb + q) + l15) * 72 + 16 * mt + 4 * g) = p; *(s16x4*)(Sc.SS + uh + (size_t)(16 * (ntb + q) + l15) * 64 + 16 * mt + 4 * g) = p; }
        __syncthreads();
        const bf16x8 a0 = lds_tr8(buf, 72, 0, 16 * mt, lane), a1 = lds_tr8(buf, 72, 32, 16 * mt, lane);
#pragma unroll
        for (int q = 0; q < 2; ++q) { f32x4 z; z[0] = __builtin_bit_cast(float, Hf[q].x << 16); z[1] = __builtin_bit_cast(float, Hf[q].x & 0xffff0000u); z[2] = __builtin_bit_cast(float, Hf[q].y << 16); z[3] = __builtin_bit_cast(float, Hf[q].y & 0xffff0000u);
            z = MFMA32(a0, Gf[q][0], z); acc[q] = MFMA32(a1, Gf[q][1], z); }
    }
    __syncthreads();
}

constexpr int M3_SLOT = 9216 * 2 + 64 * 68 * 4;
__device__ __forceinline__ void rwkv_m3_unit(Frame& F, int unit  , const bf16* P, bf16* Y, const RwkvW& W, const RwkvS& Sc) {
    const int b = unit >> 6, c = unit & 63, t0 = c * 64; const size_t row0 = (size_t)b * SEQ + t0;
    const int w = F.wave, lane = F.lane, l15 = lane & 15, g = lane >> 4, hw = w >> 2, mt = w & 3, tl = F.tid & 255;
    LAS bf16* Qt = (LAS bf16*)(F.lds + hw * M3_SLOT); LAS bf16* St = Qt + 64 * 72; LAS float* Out = (LAS float*)(F.lds + hw * M3_SLOT + 2 * 9216);
    for (int hp = 0; hp < 4; ++hp) { const int h = 2 * hp + hw; const size_t uh = ((size_t)unit * NH + h) * 4096;
#pragma unroll
        for (int r = 0; r < 2; ++r) { const int off = 8 * (tl + 256 * r), rr = off >> 6, cc = off & 63;
            *(LAS u32x4*)(Qt + rr * 72 + cc) = *(const u32x4*)(Sc.SQ + uh + off); *(LAS u32x4*)(St + rr * 72 + cc) = *(const u32x4*)(Sc.SS + uh + off); }
        __syncthreads();
        f32x4 acc[4];
#pragma unroll
        for (int nt = 0; nt < 4; ++nt) acc[nt] = unpack4(*(const s16x4*)(Sc.SY0 + uh + (size_t)(16 * nt + l15) * 64 + 16 * mt + 4 * g));
#pragma unroll
        for (int ks = 0; ks < 2; ++ks) { const bf16x8 a = lds_tr8(Qt, 72, 32 * ks, 16 * mt, lane);
#pragma unroll
            for (int nt = 0; nt < 4; ++nt) acc[nt] = MFMA32(a, lds_tr8(St, 72, 32 * ks, 16 * nt, lane), acc[nt]); }
#pragma unroll
        for (int r = 0; r < 4; ++r) { float s = (acc[0][r] + acc[1][r]) + (acc[2][r] + acc[3][r]);
            s += __shfl_xor(s, 1); s += __shfl_xor(s, 2); s += __shfl_xor(s, 4); s += __shfl_xor(s, 8); const float mean = s * (1.f / HD); float q = 0.f;
#pragma unroll
            for (int nt = 0; nt < 4; ++nt) { const float d = acc[nt][r] - mean; q += d * d; }
            q += __shfl_xor(q, 1); q += __shfl_xor(q, 2); q += __shfl_xor(q, 4); q += __shfl_xor(q, 8); const float rstd = __builtin_amdgcn_rsqf(q * (1.f / HD) + GN_EPS);
#pragma unroll
            for (int nt = 0; nt < 4; ++nt) { const int v = 16 * nt + l15; Out[(16 * mt + 4 * g + r) * 68 + v] = (acc[nt][r] - mean) * rstd * W.lnx_w[h * HD + v] + W.lnx_b[h * HD + v]; } }
        __syncthreads();
        { const int t = tl >> 2, cq = tl & 3, v0 = 16 * cq, hv0 = h * HD + v0; const size_t row = row0 + t; const bool has_prev = (t0 + t) > 0; const float bsc = Sc.Sbsc[row * NH + h];
#pragma unroll
          for (int half = 0; half < 2; ++half) { float cv[8], pv[8], gv[8], o[8]; const int col = 2048 + hv0 + 8 * half;
              unpack8(*(const u32x4*)(P + row * INW + col), cv); if (has_prev) unpack8(*(const u32x4*)(P + (row - 1) * INW + col), pv); else { for (int j = 0; j < 8; ++j) pv[j] = 0.f; }
              unpack8(*(const u32x4*)(Sc.Sg + row * RWW + hv0 + 8 * half), gv);
              const f32x4 m0 = *(const f32x4*)(W.mu + col - 1024), m1 = *(const f32x4*)(W.mu + col - 1024 + 4);
#pragma unroll
              for (int j = 0; j < 8; ++j) { const float vs = cv[j] + (pv[j] - cv[j]) * (j < 4 ? m0[j] : m1[j - 4]); o[j] = (Out[t * 68 + v0 + 8 * half + j] + bsc * vs) * gv[j]; }
              *(u32x4*)(Y + row * D + GMW + hv0 + 8 * half) = pack8(o); } }
        __syncthreads();
    }
}


__device__ __forceinline__ void rwkv_apply_naive(Frame& F, int unit, const bf16* P, bf16* Y, const RwkvW& W, const RwkvS& Sc) {
    const int b = unit >> 3, h = unit & 7;
    LAS float* S = (LAS float*)F.lds; LAS float* Gs = S + 64 * 65; LAS float* Hs = Gs + 64 * 65; LAS float* Qs = Hs + 64 * 65; LAS float* Ys = Qs + 64 * 65; LAS float* Sn = Ys + 64 * 65;
    for (int i = F.tid; i < 64 * 65; i += 512) S[i] = 0.f;
    __syncthreads();
    for (int c = 0; c < 64; ++c) { const size_t uh = ((size_t)(b * 64 + c) * NH + h) * 4096; const size_t row0 = (size_t)b * SEQ + c * 64;
        for (int i = F.tid; i < 4096; i += 512) { const int r = i >> 6, cc = i & 63;
            Gs[cc * 65 + r] = bf2f(Sc.SG[uh + i]);
            Hs[cc * 65 + r] = bf2f(Sc.SH[uh + i]);
            Qs[cc * 65 + r] = bf2f(Sc.SQ[uh + i]);
            Ys[cc * 65 + r] = bf2f(Sc.SY0[uh + i]); }
        __syncthreads();
        for (int i = F.tid; i < 4096; i += 512) { const int t = i >> 6, v = i & 63; float a = Ys[t * 65 + v];
            if (DBG_VAR != 1) for (int k = 0; k < 64; ++k) a += Qs[t * 65 + k] * S[v * 65 + k];
            if (DBG_VAR == 2) a = 0.f;
            Ys[t * 65 + v] = a; }
        for (int i = F.tid; i < 4096; i += 512) { const int v = i >> 6, k2 = i & 63; float a = Hs[v * 65 + k2];
            if (DBG_VAR == 6) a += S[v * 65 + k2] * Gs[k2 * 65 + k2]; else if (DBG_VAR != 3) for (int k = 0; k < 64; ++k) a += S[v * 65 + k] * Gs[k * 65 + k2];
            if (DBG_VAR == 7) a = Hs[v * 65 + k2] + 0.5f * (a - Hs[v * 65 + k2]);
            Sn[v * 65 + k2] = a; }
        __syncthreads();
        for (int i = F.tid; i < 4096; i += 512) { const int v = i >> 6, k2 = i & 63; S[v * 65 + k2] = Sn[v * 65 + k2]; }
        { const int t = F.tid >> 3, cg = F.tid & 7, v0 = 8 * cg, hv0 = h * HD + v0; const size_t row = row0 + t; const bool has_prev = (c * 64 + t) > 0; const float bsc = Sc.Sbsc[row * NH + h];
          float yv[8]; float sm = 0.f;
          for (int j = 0; j < 8; ++j) { yv[j] = Ys[t * 65 + v0 + j]; sm += yv[j]; }
          sm += __shfl_xor(sm, 1); sm += __shfl_xor(sm, 2); sm += __shfl_xor(sm, 4); const float mean = sm * (1.f / HD); float q = 0.f;
          for (int j = 0; j < 8; ++j) { yv[j] -= mean; q += yv[j] * yv[j]; }
          q += __shfl_xor(q, 1); q += __shfl_xor(q, 2); q += __shfl_xor(q, 4); const float rstd = __builtin_amdgcn_rsqf(q * (1.f / HD) + GN_EPS);
          float cv[8], pv[8], gv[8], o[8]; const int col = 2048 + hv0;
          unpack8(*(const u32x4*)(P + row * INW + col), cv); if (has_prev) unpack8(*(const u32x4*)(P + (row - 1) * INW + col), pv); else { for (int j = 0; j < 8; ++j) pv[j] = 0.f; }
          unpack8(*(const u32x4*)(Sc.Sg + row * RWW + hv0), gv);
          for (int j = 0; j < 8; ++j) { const float vs = cv[j] + (pv[j] - cv[j]) * W.mu[col - 1024 + j]; o[j] = (yv[j] * rstd * W.lnx_w[hv0 + j] + W.lnx_b[hv0 + j] + bsc * vs) * gv[j]; }
          *(u32x4*)(Y + row * D + GMW + hv0) = pack8(o); }
        __syncthreads();
    }
}

enum Phase { PH_PRO = 0, PH_G1_0, PH_M1_0, PH_M2_0, PH_M3_0, PH_G2_0, PH_G3_0, PH_G4_0, PH_G1_1, PH_M1_1, PH_M2_1, PH_M3_1, PH_G2_1, PH_CV, PH_R2, PH_GU_A, PH_DN_A, PH_GU_B, PH_DN_B, PH_FIN, PH_COUNT };

__global__ void __launch_bounds__(512, 2) fwd(Args args) {
    extern __shared__ __attribute__((aligned(16))) unsigned char lds_raw[];
    Frame F;
    F.lds = (LAS unsigned char*)lds_raw;
    F.tid = threadIdx.x; F.lane = F.tid & 63; F.wave = __builtin_amdgcn_readfirstlane(F.tid >> 6);
    F.G = gridDim.x; F.gw = blockIdx.x * 8 + F.wave; F.NGW = F.G * 8;
    unsigned char* ws = args.ws;
    gu32* ctl = (gu32*)(ws + WS_CTL);
    volatile LAS unsigned* MISC = (volatile LAS unsigned*)(F.lds + MISC_OFF);
    if (F.tid < 32) ((LAS unsigned*)(F.lds + MISC_OFF))[F.tid] = 0u;
    __syncthreads();
    XcdBarrier bar; bar.bar = (unsigned*)(ctl + CW_BAR); bar.x = 0; bar.st = nullptr;
#if !MK_PER_PHASE
    bar = xcd_barrier_post((unsigned*)(ctl + CW_BAR), MISC + 8);
#endif
    const int lo = args.ph_lo, hi = args.ph_hi;
#define IN(k) (lo <= (k) && (k) < hi)
#define SEAM(k) do { if (IN(k) && IN((k) + 1)) xcd_barrier(bar); } while (0)

    const float* x_in = args.in[I_X]; float* xres = args.out;
    bf16* WinT = (bf16*)(ws + WS_WIN); bf16* WoutT = (bf16*)(ws + WS_WOUT); bf16* WguT = (bf16*)(ws + WS_WGU); bf16* WdT = (bf16*)(ws + WS_WD);
    bf16* XB = (bf16*)(ws + WS_XB); bf16* PB = (bf16*)(ws + WS_P); bf16* YB = (bf16*)(ws + WS_Y); bf16* HB = (bf16*)(ws + WS_P);
    bf16* MWgu = (bf16*)(ws + WS_MOEW_GU); bf16* MWd = (bf16*)(ws + (MOE8_GU ? WS_MOEW8_D : WS_MOEW_D)); bf16* MH = (bf16*)(ws + WS_MOEH);
    unsigned char* MWgu8 = ws + WS_MOEW8_GU; unsigned char* MWd8 = ws + WS_MOEW8_D; unsigned char* MH8 = ws + WS_MOEH; unsigned char* XB8 = ws + WS_XB8;
    float* ssq0 = (float*)(ctl + CW_SSQ); float* ssq1 = (float*)(ws + WS_SSQP); float* ssq2 = ssq1 + (size_t)NTOK * 16;
    bf16* WupT = (bf16*)(ws + WS_SMALLW + SW_WUP); bf16* AupT = (bf16*)(ws + WS_SMALLW + SW_AUP); bf16* GupT = (bf16*)(ws + WS_SMALLW + SW_GUP); bf16* WsB = (bf16*)(ws + WS_SMALLW + SW_WS);
    RwkvS RS{(bf16*)(ws + WS_SCR), (bf16*)(ws + WS_SCR + 32 * MiB), (bf16*)(ws + WS_SCR + 64 * MiB), (bf16*)(ws + WS_SCR + 96 * MiB), (bf16*)(ws + WS_SCR + 128 * MiB), (bf16*)(ws + WS_XB), (float*)(ws + WS_XB + 32 * MiB)};
    unsigned char* misc = ws + WS_MISC;
    int* tok_e = (int*)(misc + MS_TOKE); float* tok_g = (float*)(misc + MS_TOKG); float* rs_moe = (float*)(misc + MS_RS); int* bcnt = (int*)(misc + MS_BCNT);
    int* row_tok = (int*)(misc + MS_ROWTOK); float* row_gate = (float*)(misc + MS_ROWGATE); int* panel = (int*)(misc + MS_PANEL);

    if (IN(PH_PRO)) {
        int itb = 0;
        for (int l = 0; l < 2; ++l) {
            convert_matrix(F, args.in[I_W_IN] + (size_t)l * D * INW, D, INW, WinT + (size_t)l * INW * D, 0, args.in[I_NORM_MIX] + l * D, 0, itb);
            convert_matrix(F, args.in[I_W_OUT] + (size_t)l * D * D, D, D, WoutT + (size_t)l * D * D, 0, nullptr, 0, itb);
        }
        convert_matrix(F, args.in[I_FFN_WG], D, FF, WguT, 1, args.in[I_NORM_FFN], 0, itb);
        convert_matrix(F, args.in[I_FFN_WU], D, FF, WguT, 2, args.in[I_NORM_FFN], 0, itb);
        convert_matrix(F, args.in[I_FFN_WD], FF, D, WdT, 0, nullptr, 0, itb);
        { const size_t gt = (size_t)blockIdx.x * 512 + F.tid, gn = (size_t)F.G * 512;
          for (size_t i = gt; i < (size_t)2 * RWW * 64; i += gn) { const int l = (int)(i / (RWW * 64)), r = (int)(i % (RWW * 64)), ch = r / 64, j = r % 64;
              WupT[i] = (bf16)f2bf(args.in[I_RW_W_UP][(size_t)l * 64 * RWW + (size_t)j * RWW + ch]); AupT[i] = (bf16)f2bf(args.in[I_RW_A_UP][(size_t)l * 64 * RWW + (size_t)j * RWW + ch]); }
          for (size_t i = gt; i < (size_t)2 * RWW * 128; i += gn) { const int l = (int)(i / (RWW * 128)), r = (int)(i % (RWW * 128)), ch = r / 128, j = r % 128;
              GupT[i] = (bf16)f2bf(args.in[I_RW_G_UP][(size_t)l * 128 * RWW + (size_t)j * RWW + ch]); }
          for (size_t i = gt; i < (size_t)2 * NH * GCH * GCH; i += gn) { const int t = (int)((i / GCH) % GCH), s2 = (int)(i % GCH); WsB[i] = (bf16)(s2 <= t ? f2bf(args.in[I_GM_WS][i]) : 0u); } }
        for (int m = F.gw; m < NTOK; m += F.NGW) {
            const GAS f32x4* xr = (const GAS f32x4*)(x_in + (size_t)m * D) + F.lane; GAS u32x2* o8 = (GAS u32x2*)(XB + (size_t)m * D) + F.lane; float s = 0.f;
#pragma unroll
            for (int j = 0; j < 4; ++j) { const f32x4 v = xr[64 * j]; s += (v.x * v.x + v.y * v.y) + (v.z * v.z + v.w * v.w); u32x2 w; w.x = pk2(v.x, v.y); w.y = pk2(v.z, v.w); o8[64 * j] = w; }
            s = wave_sum(s); if (F.lane == 0) ssq0[m] = s;
        }
    }
    SEAM(PH_PRO);

#define LAYER_MIXER(L, PH1, PHA, PHB, PHC, PH2, XBASE, SSQ_IN, NP_IN, SSQ_OUT, HAS_OUT) \
    if (IN(PH1)) { pg8::DenseSched S; S.init(XB, WinT + (size_t)(L) * INW * D, NTOK, INW, 2 * D, F.G, (int)blockIdx.x); \
        pg8::EpiScaleBf16<NP_IN> E{PB, INW, SSQ_IN}; pg8::gemm_phase(F.lds, 2 * D, S, E); } \
    SEAM(PH1); \
    { RwkvW RW{args.in[I_SHIFT_MU] + (L) * 1792, args.in[I_RW_W0] + (L) * RWW, args.in[I_RW_A0] + (L) * RWW, args.in[I_RW_K_K] + (L) * RWW, args.in[I_RW_K_A] + (L) * RWW, args.in[I_RW_R_K] + (L) * RWW, \
                 args.in[I_RW_LNX_W] + (L) * RWW, args.in[I_RW_LNX_B] + (L) * RWW, WupT + (size_t)(L) * RWW * 64, AupT + (size_t)(L) * RWW * 64, GupT + (size_t)(L) * RWW * 128}; \
      if (IN(PHA)) { if (MIX_MODE != 1) for (int rep = 0; rep < REP_M1; ++rep) { rwkv_m1_consts(F, RW); for (int u = blockIdx.x; u < NB * 64; u += F.G) rwkv_m1v2_unit(F, u, PB, RW, RS); } } \
      SEAM(PHA); \
      if (IN(PHB)) for (int rep = 0; rep < REP_M2; ++rep) { const int nscan = (F.G >= 128 && MIX_MODE != 1) ? 64 : 0; \
          if (MIX_MODE != 1 && MIX_MODE != 3) { if (nscan) { if ((int)blockIdx.x < 64) rwkv_m2_unit(F, blockIdx.x, RS); } else { for (int u = blockIdx.x; u < 64; u += F.G) rwkv_m2_unit(F, u, RS); } } \
          if (MIX_MODE == 2) gmlp_naive(F, PB, YB, args.in[I_GM_LN_W] + (L) * GMW, args.in[I_GM_LN_B] + (L) * GMW, args.in[I_GM_WS] + (size_t)(L) * NH * GCH * GCH, args.in[I_GM_BS] + (L) * NH * GCH); \
          else if ((int)blockIdx.x >= nscan) for (int u = blockIdx.x - nscan; u < NB * (SEQ / GCH) * NH; u += F.G - nscan) \
              gmlp_unit(F, u, PB, YB, args.in[I_GM_LN_W] + (L) * GMW, args.in[I_GM_LN_B] + (L) * GMW, WsB + (size_t)(L) * NH * GCH * GCH, args.in[I_GM_BS] + (L) * NH * GCH); } \
      SEAM(PHB); \
      if (IN(PHC)) { if (MIX_MODE == 3) { for (int u = blockIdx.x; u < 64; u += F.G) rwkv_apply_naive(F, u, PB, YB, RW, RS); } \
          else if (MIX_MODE != 1) { for (int rep = 0; rep < REP_M3; ++rep) for (int u = blockIdx.x; u < NB * 64; u += F.G) rwkv_m3_unit(F, u, PB, YB, RW, RS); } \
          else rwkv_naive(F, PB, YB, args.in[I_SHIFT_MU] + (L) * 1792, args.in[I_RW_W_UP] + (L) * 64 * RWW, args.in[I_RW_W0] + (L) * RWW, args.in[I_RW_A_UP] + (L) * 64 * RWW, args.in[I_RW_A0] + (L) * RWW, \
                   args.in[I_RW_G_UP] + (L) * 128 * RWW, args.in[I_RW_K_K] + (L) * RWW, args.in[I_RW_K_A] + (L) * RWW, args.in[I_RW_R_K] + (L) * RWW, args.in[I_RW_LNX_W] + (L) * RWW, args.in[I_RW_LNX_B] + (L) * RWW); } \
      SEAM(PHC); } \
    if (IN(PH2)) { pg8::DenseSched S; S.init(YB, WoutT + (size_t)(L) * D * D, NTOK, D, 2 * D, F.G, (int)blockIdx.x); \
        pg8::EpiResid<HAS_OUT> E{XBASE, xres, XB, SSQ_OUT}; pg8::gemm_phase(F.lds, 2 * D, S, E); } \
    SEAM(PH2);

    LAYER_MIXER(0, PH_G1_0, PH_M1_0, PH_M2_0, PH_M3_0, PH_G2_0, x_in, ssq0, 1, ssq1, true)

    if (IN(PH_G3_0)) { pg8::DenseSched S; S.init(XB, WguT, NTOK, 2 * FF, 2 * D, F.G, (int)blockIdx.x);
        pg8::EpiSwiglu<16> E{HB, FF, ssq1}; pg8::gemm_phase(F.lds, 2 * D, S, E); }
    SEAM(PH_G3_0);
    if (IN(PH_G4_0)) { pg8::DenseSched S; S.init(HB, WdT, NTOK, D, 2 * FF, F.G, (int)blockIdx.x);
        pg8::EpiResid<true> E{xres, xres, XB, ssq2}; pg8::gemm_phase(F.lds, 2 * FF, S, E); }
    SEAM(PH_G4_0);

    LAYER_MIXER(1, PH_G1_1, PH_M1_1, PH_M2_1, PH_M3_1, PH_G2_1, xres, ssq2, 16, nullptr, false)

    if (IN(PH_CV)) {
        int itb = 0; const float* gain = args.in[I_NORM_FFN] + D;
        for (int e = 0; e < NE; ++e) {
            if (MOE8_GU) { convert_matrix_fp8(F, args.in[I_MOE_WG] + (size_t)e * D * FFE, D, FFE, MWgu8 + (size_t)e * 2 * FFE * D, 1, gain, MOE8_WSCALE_GU, itb);
                           convert_matrix_fp8(F, args.in[I_MOE_WU] + (size_t)e * D * FFE, D, FFE, MWgu8 + (size_t)e * 2 * FFE * D, 2, gain, MOE8_WSCALE_GU, itb); }
            else { convert_matrix(F, args.in[I_MOE_WG] + (size_t)e * D * FFE, D, FFE, MWgu + (size_t)e * 2 * FFE * D, 1, gain, 0, itb);
                   convert_matrix(F, args.in[I_MOE_WU] + (size_t)e * D * FFE, D, FFE, MWgu + (size_t)e * 2 * FFE * D, 2, gain, 0, itb); }
            if (MOE8_DN) convert_matrix_fp8(F, args.in[I_MOE_WD] + (size_t)e * FFE * D, FFE, D, MWd8 + (size_t)e * D * FFE, 0, nullptr, MOE8_WSCALE_DN, itb);
            else convert_matrix(F, args.in[I_MOE_WD] + (size_t)e * FFE * D, FFE, D, MWd + (size_t)e * D * FFE, 0, nullptr, 0, itb);
        }
        __syncthreads();
        LAS float* RW = (LAS float*)F.lds; LAS int* cnt = (LAS int*)(F.lds + 32768);
        for (int i = F.tid; i < D * NE; i += 512) RW[i] = args.in[I_MOE_ROUTER][i] * gain[i >> 3];
        for (size_t i = (size_t)blockIdx.x * 512 + F.tid; i < (size_t)2 * MAXPAN * 256; i += (size_t)F.G * 512) { row_tok[i] = -1; row_gate[i] = 0.f; }
        __syncthreads();
        for (int vb = blockIdx.x; vb < 256; vb += F.G) {
            if (F.tid < 16) cnt[F.tid] = 0;
            __syncthreads();
            for (int i = 0; i < 16; ++i) { const int m = vb * 128 + F.wave * 16 + i;
                const GAS f32x4* xr = (const GAS f32x4*)(xres + (size_t)m * D) + F.lane; float s = 0.f; float lg[8];
#pragma unroll
                for (int e = 0; e < 8; ++e) lg[e] = 0.f;
#pragma unroll
                for (int j = 0; j < 4; ++j) { const f32x4 v = xr[64 * j]; s += (v.x * v.x + v.y * v.y) + (v.z * v.z + v.w * v.w);
                    if (MOE8_GU) *(unsigned*)(XB8 + (size_t)m * D + 256 * j + 4 * F.lane) = pk4_fp8(v.x, v.y, v.z, v.w);
                    const int k0 = 256 * j + 4 * F.lane;
#pragma unroll
                    for (int q = 0; q < 4; ++q) { const float xv = v[q]; const LAS f32x4* rw = (const LAS f32x4*)(RW + (k0 + q) * 8); const f32x4 r0 = rw[0], r1 = rw[1];
                        lg[0] += xv * r0.x; lg[1] += xv * r0.y; lg[2] += xv * r0.z; lg[3] += xv * r0.w; lg[4] += xv * r1.x; lg[5] += xv * r1.y; lg[6] += xv * r1.z; lg[7] += xv * r1.w; } }
                s = wave_sum(s);
#pragma unroll
                for (int e = 0; e < 8; ++e) lg[e] = wave_sum(lg[e]);
                const float rs = 1.0f / sqrtf(s * (1.0f / D) + RMS_EPS);
                if (F.lane == 0) {
                    int i1 = 0; float v1 = lg[0];
#pragma unroll
                    for (int e = 1; e < 8; ++e) if (lg[e] > v1) { v1 = lg[e]; i1 = e; }
                    int i2 = -1; float v2 = -3.0e38f;
#pragma unroll
                    for (int e = 0; e < 8; ++e) if (e != i1 && lg[e] > v2) { v2 = lg[e]; i2 = e; }
                    if (i2 < 0) { i2 = (i1 + 1) & 7; v2 = v1; }
                    const float g1 = 1.0f / (1.0f + __expf((v2 - v1) * rs)), g2 = 1.0f - g1;
                    tok_e[2 * m] = i1; tok_e[2 * m + 1] = i2; tok_g[2 * m] = g1; tok_g[2 * m + 1] = g2; rs_moe[m] = rs;
                    __hip_atomic_fetch_add(&cnt[i1], 1, __ATOMIC_RELAXED, __HIP_MEMORY_SCOPE_WORKGROUP); __hip_atomic_fetch_add(&cnt[8 + i2], 1, __ATOMIC_RELAXED, __HIP_MEMORY_SCOPE_WORKGROUP);
                } }
            __syncthreads();
            if (F.tid < 16) bcnt[vb * 16 + F.tid] = cnt[F.tid];
            __syncthreads();
        }
    }
    SEAM(PH_CV);

    if (IN(PH_R2)) {
        LAS int* tot = (LAS int*)F.lds;
        for (int vb = blockIdx.x; vb < 256; vb += F.G) {
            if (F.tid < 16) { int t = 0, mine = 0; for (int b2 = 0; b2 < 256; ++b2) { const int c = bcnt[b2 * 16 + F.tid]; if (b2 < vb) mine += c; t += c; } tot[F.tid] = t; tot[32 + F.tid] = mine; }
            __syncthreads();
            if (F.tid < 2) { int ps = 0; for (int e = 0; e < 8; ++e) { tot[16 + F.tid * 8 + e] = ps; ps += (tot[F.tid * 8 + e] + 255) / 256; }
                if (vb == 0) { panel[F.tid * 160] = ps; for (int e = 0; e < 8; ++e) { const int np = (tot[F.tid * 8 + e] + 255) / 256; for (int q = 0; q < np; ++q) panel[F.tid * 160 + 16 + tot[16 + F.tid * 8 + e] + q] = e; } } }
            __syncthreads();
            if (F.tid < 16) { const int set = F.tid >> 3, e = F.tid & 7; int slot = tot[16 + F.tid] * 256 + tot[32 + F.tid];
                for (int r = 0; r < 128; ++r) { const int m = vb * 128 + r; if (tok_e[2 * m + set] == e) { row_tok[set * MAXPAN * 256 + slot] = m; row_gate[set * MAXPAN * 256 + slot] = tok_g[2 * m + set]; ++slot; } } }
            __syncthreads();
        }
    }
    SEAM(PH_R2);

#define MOE_SET(SET, PHGU, PHDN) \
    if (IN(PHGU)) for (int rep = 0; rep < REP_GU; ++rep) { const int np = __builtin_amdgcn_readfirstlane(panel[(SET) * 160]); pg8::MoeSched<true> S; \
        if (MOE8_GU) { S.init(XB8, MWgu8, np, 2 * FFE, D, panel + (SET) * 160 + 16, row_tok + (SET) * MAXPAN * 256, F.G, (int)blockIdx.x); \
            if (MOE8_DN) { pg8::EpiSwigluMoe8 E{MH8, FFE, rs_moe, row_tok + (SET) * MAXPAN * 256, 1.0f / MOE8_WSCALE_GU}; pg8::gemm_phase<pg8::EpiSwigluMoe8, pg8::MoeSched<true>, true>(F.lds, D, S, E); } \
            else { pg8::EpiSwigluMoe E{MH, FFE, rs_moe, row_tok + (SET) * MAXPAN * 256, 1.0f / MOE8_WSCALE_GU}; pg8::gemm_phase<pg8::EpiSwigluMoe, pg8::MoeSched<true>, true>(F.lds, D, S, E); } } \
        else { S.init(XB, MWgu, np, 2 * FFE, 2 * D, panel + (SET) * 160 + 16, row_tok + (SET) * MAXPAN * 256, F.G, (int)blockIdx.x); \
            pg8::EpiSwigluMoe E{MH, FFE, rs_moe, row_tok + (SET) * MAXPAN * 256, 1.0f}; pg8::gemm_phase(F.lds, 2 * D, S, E); } } \
    SEAM(PHGU); \
    if (IN(PHDN)) { const int np = __builtin_amdgcn_readfirstlane(panel[(SET) * 160]); pg8::MoeSched<false> S; \
        if (MOE8_DN) { S.init(MH8, MWd8, np, D, FFE, panel + (SET) * 160 + 16, row_tok + (SET) * MAXPAN * 256, F.G, (int)blockIdx.x); \
            pg8::EpiMoeDown E{xres, row_tok + (SET) * MAXPAN * 256, row_gate + (SET) * MAXPAN * 256, 1.0f / MOE8_WSCALE_DN}; pg8::gemm_phase<pg8::EpiMoeDown, pg8::MoeSched<false>, true>(F.lds, FFE, S, E); } \
        else { S.init(MH, MWd, np, D, 2 * FFE, panel + (SET) * 160 + 16, row_tok + (SET) * MAXPAN * 256, F.G, (int)blockIdx.x); \
            pg8::EpiMoeDown E{xres, row_tok + (SET) * MAXPAN * 256, row_gate + (SET) * MAXPAN * 256, 1.0f}; pg8::gemm_phase(F.lds, 2 * FFE, S, E); } } \
    SEAM(PHDN);
    MOE_SET(0, PH_GU_A, PH_DN_A)
    MOE_SET(1, PH_GU_B, PH_DN_B)

    if (IN(PH_FIN)) {
        const float* gf = args.in[I_NORM_FINAL];
        for (int m = F.gw; m < NTOK; m += F.NGW) {
            GAS f32x4* xr = (GAS f32x4*)(xres + (size_t)m * D) + F.lane; f32x4 v[4]; float s = 0.f;
#pragma unroll
            for (int j = 0; j < 4; ++j) { v[j] = xr[64 * j]; s += (v[j].x * v[j].x + v[j].y * v[j].y) + (v[j].z * v[j].z + v[j].w * v[j].w); }
            const float rs = 1.0f / sqrtf(wave_sum(s) * (1.0f / D) + RMS_EPS);
#pragma unroll
            for (int j = 0; j < 4; ++j) { const f32x4 g = *((const f32x4*)gf + F.lane + 64 * j); xr[64 * j] = v[j] * rs * g; }
        }
    }
#undef IN
#undef SEAM
}

extern "C" void kernel_launch(void* const* d_in, const int* in_sizes, int n_in, void* d_out, int out_size, void* d_ws, size_t ws_size, hipStream_t stream) {
    static int grid = 0;
    if (grid == 0) {
        if (n_in != NIN || in_sizes[0] != NTOK * D || out_size != NTOK * D || ws_size < WS_END) {
            fprintf(stderr, "kernel_launch: unexpected shapes: n_in %d in0 %d out %d ws %zu (need %zu); nothing launched\n", n_in, n_in > 0 ? in_sizes[0] : -1, out_size, ws_size, (size_t)WS_END); grid = -1; return; }
        int dev = 0, cus = 0, per_cu = 0;
        if (hipGetDevice(&dev) != hipSuccess || hipDeviceGetAttribute(&cus, hipDeviceAttributeMultiprocessorCount, dev) != hipSuccess) { grid = -1; return; }
        if (hipFuncSetAttribute((const void*)fwd, hipFuncAttributeMaxDynamicSharedMemorySize, LDS_BYTES) != hipSuccess) { fprintf(stderr, "kernel_launch: hipFuncSetAttribute failed\n"); grid = -1; return; }
        if (hipOccupancyMaxActiveBlocksPerMultiprocessor(&per_cu, (const void*)fwd, 512, LDS_BYTES) != hipSuccess || per_cu < 1) { fprintf(stderr, "kernel_launch: occupancy query says %d\n", per_cu); }
        (void)hipGetLastError();
        grid = cus;
    }
    if (grid < 0) return;
    if (hipMemsetAsync((char*)d_ws + WS_CTL, 0, CTL_ZERO_BYTES, stream) != hipSuccess) return;
    Args a{};
    for (int i = 0; i < NIN; ++i) a.in[i] = (const float*)d_in[i];
    a.out = (float*)d_out; a.ws = (unsigned char*)d_ws;
#if MK_PER_PHASE
    for (int ph = 0; ph < PH_COUNT; ++ph) { a.ph_lo = ph; a.ph_hi = ph + 1; hipLaunchKernelGGL(fwd, dim3(grid), dim3(512), LDS_BYTES, stream, a); }
#else
    a.ph_lo = 0; a.ph_hi = PH_COUNT; hipLaunchKernelGGL(fwd, dim3(grid), dim3(512), LDS_BYTES, stream, a);
#endif
}
```

```cpp
#include <hip/hip_runtime.h>
#include <cstdio>
#include <cstdint>

#ifndef MK_PER_PHASE
#define MK_PER_PHASE 0
#endif

#ifndef REP_M1
#define REP_M1 1
#endif
#ifndef REP_M2
#define REP_M2 1
#endif
#ifndef REP_M3
#define REP_M3 1
#endif
#ifndef REP_GU
#define REP_GU 1
#endif
#ifndef REP_CH
#define REP_CH 1
#endif
#ifndef PROBE_STAGE
#define PROBE_STAGE 0
#endif
#ifndef REP_CV
#define REP_CV 1
#endif
#ifndef REP_EPI
#define REP_EPI 1
#endif
#ifndef REP_G3
#define REP_G3 1
#endif
#ifndef DBG_VAR
#define DBG_VAR 0
#endif
#ifndef MOE8_GU
#define MOE8_GU 1
#endif
#ifndef MOE8_DN
#define MOE8_DN 1
#endif
#ifndef MIX_MODE
#define MIX_MODE 0
#endif
#define GAS __attribute__((address_space(1)))
#define LAS __attribute__((address_space(3)))
typedef unsigned short bf16;
typedef unsigned short bf16_t;
typedef short bf16x8 __attribute__((ext_vector_type(8)));
typedef float f32x4 __attribute__((ext_vector_type(4)));
typedef float f32x2 __attribute__((ext_vector_type(2)));
typedef unsigned u32x4 __attribute__((ext_vector_type(4)));
typedef unsigned u32x2 __attribute__((ext_vector_type(2)));
typedef GAS unsigned gu32;

constexpr int NTOK = 32768, SEQ = 4096, NB = 8, D = 1024, INW = 2816, FF = 2816, FFE = 3584, NE = 8;
constexpr int GMW = 512, RWW = 512, NH = 8, HD = 64, GCH = 128;
constexpr float RMS_EPS = 1e-6f, LN_EPS = 1e-5f, GN_EPS = 64e-5f;
constexpr int MAXPAN = 136;

constexpr size_t MiB = 1u << 20;
constexpr size_t WS_CTL = 0, CTL_ZERO_BYTES = 2 * MiB;
constexpr size_t WS_WIN = 2 * MiB;
constexpr size_t WS_WOUT = 13 * MiB;
constexpr size_t WS_WGU = 17 * MiB;
constexpr size_t WS_WD = 28 * MiB;
constexpr size_t WS_MISC = 34 * MiB;
constexpr size_t WS_SMALLW = 36 * MiB;
constexpr size_t SW_WUP = 0, SW_AUP = 128 * 1024, SW_GUP = 256 * 1024, SW_WS = 512 * 1024;
constexpr size_t WS_XB = 38 * MiB;
constexpr size_t WS_R = 102 * MiB;
constexpr size_t WS_P = WS_R;
constexpr size_t WS_Y = WS_R + 176 * MiB;
constexpr size_t WS_SCR = WS_R + 240 * MiB;
constexpr size_t WS_MOEW_GU = WS_R;
constexpr size_t WS_MOEW_D = WS_R + 112 * MiB;
constexpr size_t WS_MOEH = WS_R + 168 * MiB;
constexpr size_t WS_MOEW8_GU = WS_R;
constexpr size_t WS_MOEW8_D = WS_R + 56 * MiB;
constexpr size_t WS_XB8 = WS_R + 112 * MiB;
constexpr float MOE8_WSCALE_GU = 64.f, MOE8_WSCALE_DN = 128.f;
constexpr size_t WS_SSQP = WS_R + 400 * MiB;
constexpr size_t WS_END = WS_R + 408 * MiB;
static_assert(WS_MOEH + (size_t)MAXPAN * 256 * FFE * 2 <= WS_END, "moe hidden fits");
static_assert(WS_WIN + (size_t)2 * INW * D * 2 <= WS_WOUT && WS_WGU + (size_t)2 * FF * D * 2 <= WS_WD && WS_WD + (size_t)D * FF * 2 <= WS_MISC, "weights fit");
constexpr int CW_TMO = 0;
constexpr int CW_BAR = 4096;
constexpr int CW_SSQ = 65536;
static_assert((CW_SSQ + 4 * NTOK) * 4 <= (int)CTL_ZERO_BYTES, "ctl fits");
constexpr size_t MS_TOKE = 0;
constexpr size_t MS_TOKG = 256 * 1024;
constexpr size_t MS_RS = 512 * 1024;
constexpr size_t MS_BCNT = 640 * 1024;
constexpr size_t MS_ROWTOK = 704 * 1024;
constexpr size_t MS_ROWGATE = 1024 * 1024;
constexpr size_t MS_PANEL = 1344 * 1024;
static_assert(MS_ROWTOK + 2 * MAXPAN * 256 * 4 <= MS_ROWGATE && MS_ROWGATE + 2 * MAXPAN * 256 * 4 <= MS_PANEL && MS_PANEL + 2 * 160 * 4 <= 2 * MiB, "misc fits");

constexpr int RING_BYTES = 131072;
constexpr int LDS_BYTES = 147456;
constexpr int MISC_OFF = LDS_BYTES - 128;

#define LDS_WAIT() asm volatile("s_waitcnt lgkmcnt(0)" ::: "memory")
#define VM_WAIT() asm volatile("s_waitcnt vmcnt(0)" ::: "memory")
#define RLX_AGENT __ATOMIC_RELAXED, __HIP_MEMORY_SCOPE_AGENT

__device__ __forceinline__ unsigned f2bf(float f) { unsigned u = __builtin_bit_cast(unsigned, f); return (u + 0x7fffu + ((u >> 16) & 1u)) >> 16; }
__device__ __forceinline__ unsigned pk2(float lo, float hi) { return f2bf(lo) | (f2bf(hi) << 16); }
__device__ __forceinline__ float bf2f(bf16 b) { return __builtin_bit_cast(float, (unsigned)b << 16); }
__device__ __forceinline__ unsigned cvt_pk_bf16(float lo, float hi) { unsigned r; asm volatile("v_cvt_pk_bf16_f32 %0, %1, %2" : "=v"(r) : "v"(lo), "v"(hi)); return r; }
__device__ __forceinline__ unsigned pk4_fp8(float a, float b, float c, float d) { int v = __builtin_amdgcn_cvt_pk_fp8_f32(a, b, 0, false); v = __builtin_amdgcn_cvt_pk_fp8_f32(c, d, v, true); return (unsigned)v; }
__device__ __forceinline__ float wave_sum(float v) {
#pragma unroll
    for (int o = 1; o < 64; o <<= 1) v += __shfl_xor(v, o);
    return v;
}
__device__ __forceinline__ float gelu_erf(float v) { return 0.5f * v * (1.0f + erff(v * 0.70710678f)); }
__device__ __forceinline__ float sigmoidf_(float v) { return 1.0f / (1.0f + __expf(-v)); }
__device__ __forceinline__ float silu_f(float v) { return v * __builtin_amdgcn_rcpf(1.0f + __expf(-v)); }

namespace pg8 {
constexpr int BM = 256, BK = 64, HALF = 128, HTB = HALF * BK * 2, STAGE_BYTES = 8 * HTB, NXCD = 8, WGM = 8;
__host__ __device__ __forceinline__ int lds_byte(int r, int c) { const int st = (r >> 4) * 2 + (c >> 5), rr = r & 15, cc = c & 31, ob = rr * 64 + cc * 2; return st * 1024 + (ob ^ (((ob >> 9) & 1) << 5)); }
__host__ __device__ __forceinline__ void stage_rc(int b, int& R, int& C) { const int st = b / 1024, sb = b % 1024, swz = sb ^ (((sb >> 9) & 1) << 5); R = (st >> 1) * 16 + swz / 64; C = (st & 1) * 32 + (swz % 64) / 2; }
__host__ __device__ __forceinline__ int perm32(int rho) { const int n = rho >> 4, i = rho & 15; return 8 * (i >> 2) + 4 * n + (i & 3); }

struct Unit { int pm, pn, aux; };

struct TileOrder {
    int nM, nN, nwg, G, c, sx, sr;
    __device__ void init(int nM_, int nN_, int G_, int c_) { nM = nM_; nN = nN_; nwg = nM * nN; G = G_; c = c_; sx = 0; sr = 0; }
    __device__ bool tile(int i, int& pm, int& pn) const {
        long L;
        if (sx == 0) L = (long)i * G + c;
        else if (c < sx) L = (long)sr * (G - sx) + (long)i * G + c;
        else L = i < sr ? (long)i * (G - sx) + (c - sx) : (long)sr * (G - sx) + (long)(i - sr) * G + c;
        if (L >= nwg) return false;
        int wgid = (int)L; { const int q = nwg / NXCD, r = nwg % NXCD, xcd = wgid % NXCD, off = wgid / NXCD; wgid = (xcd < r ? xcd * (q + 1) : r * (q + 1) + (xcd - r) * q) + off; }
        const int nig = WGM * nN, gid = wgid / nig, fm = gid * WGM, gsz = (nM - fm) < WGM ? (nM - fm) : WGM;
        pm = fm + ((wgid % nig) % gsz); pn = (wgid % nig) / gsz; return true;
    }
};
struct DenseSched {
    static constexpr bool GATHER = false;
    TileOrder T; const char* A; const char* Bt; size_t tstep;
    __device__ void init(const void* A_, const void* Bt_, int M, int N, int KB  , int G, int c) { T.init(M / BM, N / BM, G, c); A = (const char*)A_; Bt = (const char*)Bt_; tstep = (size_t)BM * KB; }
    __device__ __forceinline__ bool next(int i, Unit& u) const { u.aux = 0; return T.tile(i, u.pm, u.pn); }
    __device__ __forceinline__ const char* a_ptr(const Unit& u) const { return A + (size_t)u.pm * tstep; }
    __device__ __forceinline__ const char* b_ptr(const Unit& u) const { return Bt + (size_t)u.pn * tstep; }
    __device__ __forceinline__ void gather(const Unit&, int, int, int, int, int, unsigned (&)[2][2]) const {}
};
template <bool GATHER_> struct MoeSched {
    static constexpr bool GATHER = GATHER_;
    TileOrder T; const char* A; const char* Bt; size_t a_tstep, b_tstep, b_estep; const int* pexp; const int* row_tok; int KB;
    __device__ void init(const void* A_, const void* Bt_, int npanels, int N, int KB_  , const int* pexp_, const int* row_tok_, int G, int c) {
        T.init(npanels, N / BM, G, c); A = (const char*)A_; Bt = (const char*)Bt_; KB = KB_; a_tstep = (size_t)BM * KB_; b_tstep = (size_t)BM * KB_; b_estep = (size_t)N * KB_; pexp = pexp_; row_tok = row_tok_; }
    __device__ __forceinline__ bool next(int i, Unit& u) const { if (!T.tile(i, u.pm, u.pn)) return false; u.aux = __builtin_amdgcn_readfirstlane(pexp[u.pm]); return true; }
    __device__ __forceinline__ const char* a_ptr(const Unit& u) const { return GATHER ? A : A + (size_t)u.pm * a_tstep; }
    __device__ __forceinline__ const char* b_ptr(const Unit& u) const { return Bt + (size_t)u.aux * b_estep + (size_t)u.pn * b_tstep; }
    __device__ __forceinline__ void gather(const Unit& u, int R0, int R1, int C0, int C1, int, unsigned (&v)[2][2]) const {
#pragma unroll
        for (int h = 0; h < 2; ++h) { int t0 = row_tok[u.pm * BM + h * HALF + R0], t1 = row_tok[u.pm * BM + h * HALF + R1]; t0 = t0 < 0 ? 0 : t0; t1 = t1 < 0 ? 0 : t1;
            v[h][0] = (unsigned)(t0 * KB + C0 * 2); v[h][1] = (unsigned)(t1 * KB + C1 * 2); }
    }
};

typedef int v4i_t __attribute__((ext_vector_type(4)));
typedef int v8i_t __attribute__((ext_vector_type(8)));
typedef short s16x16_t __attribute__((ext_vector_type(16)));
__device__ __forceinline__ v8i_t cat8(const bf16x8 lo, const bf16x8 hi) { const v4i_t a = __builtin_bit_cast(v4i_t, lo), b = __builtin_bit_cast(v4i_t, hi); return __builtin_shufflevector(a, b, 0, 1, 2, 3, 4, 5, 6, 7); }
template <class Epi, class Sched, bool FP8 = false>
__device__ __forceinline__ void gemm_phase(LAS unsigned char* lds, const int KB, const Sched& S, const Epi& E) {
    constexpr bool GATHER = Sched::GATHER;
    const int tid = threadIdx.x, wid = __builtin_amdgcn_readfirstlane(tid >> 6), lane = tid & 63, wr = wid >> 2, wc = wid & 3, fr = lane & 15, fq = lane >> 4;
    const int nt = KB / 128;
    unsigned voffA[2], voffB[2]; int sR[2], sC[2];
#pragma unroll
    for (int i = 0; i < 2; ++i) { int R, C; stage_rc(tid * 16 + i * 8192, R, C); const int Rb = Epi::PERM ? ((R & ~31) + perm32(R & 31)) : R; sR[i] = R; sC[i] = C;
        voffA[i] = (unsigned)(R * KB + C * 2); voffB[i] = (unsigned)(Rb * KB + C * 2); }
    const size_t kstep = (size_t)(BK * 2);
    const size_t hstep = (size_t)HALF * KB;
    const unsigned ldsw = (unsigned)wid * 1024u;
    const int aoff = lds_byte(wr * 64 + fr, fq * 8), boff = lds_byte(wc * 32 + fr, fq * 8);
    const int aoff8 = lds_byte(wr * 64 + fr, (fq >> 1) * 32 + (fq & 1) * 16) & ~31, boff8 = lds_byte(wc * 32 + fr, (fq >> 1) * 32 + (fq & 1) * 16) & ~31;
#define PG8_SA(b, h) (((b) * 2 + (h)) * HTB)
#define PG8_SB(b, h) ((4 + (b) * 2 + (h)) * HTB)
#define PG8_STAGE(bufoff, gbase, voff) do { _Pragma("unroll") for (int _i = 0; _i < 2; ++_i) \
        __builtin_amdgcn_global_load_lds((const unsigned*)((const char*)(gbase) + (voff)[_i]), (LAS unsigned*)(lds + (bufoff) + ldsw + _i * 8192), 16, 0, 0); } while (0)
#define PG8_STAGE_A(bufoff, kptr, half, VG) do { if constexpr (GATHER) { PG8_STAGE(bufoff, kptr, (VG)[half]); } else { PG8_STAGE(bufoff, (kptr) + (half) * hstep, voffA); } } while (0)
#define PG8_LDA(dst, b, h) do { if constexpr (FP8) { _Pragma("unroll") for (int m = 0; m < 4; ++m) dst##8[m] = cat8(*(const LAS bf16x8*)(lds + PG8_SA(b, h) + aoff8 + m * 2048), *(const LAS bf16x8*)(lds + PG8_SA(b, h) + aoff8 + m * 2048 + 16)); } \
        else { _Pragma("unroll") for (int m = 0; m < 4; ++m) _Pragma("unroll") for (int k = 0; k < 2; ++k) dst[m][k] = *(const LAS bf16x8*)(lds + PG8_SA(b, h) + aoff + m * 2048 + k * 1024); } } while (0)
#define PG8_LDB(dst, b, h) do { if constexpr (FP8) { _Pragma("unroll") for (int n = 0; n < 2; ++n) dst##8[n] = cat8(*(const LAS bf16x8*)(lds + PG8_SB(b, h) + boff8 + n * 2048), *(const LAS bf16x8*)(lds + PG8_SB(b, h) + boff8 + n * 2048 + 16)); } \
        else { _Pragma("unroll") for (int n = 0; n < 2; ++n) _Pragma("unroll") for (int k = 0; k < 2; ++k) dst[n][k] = *(const LAS bf16x8*)(lds + PG8_SB(b, h) + boff + n * 2048 + k * 1024); } } while (0)
#define PG8_MMA(ai, bj, At, Bt) do { __builtin_amdgcn_s_setprio(1); if constexpr (FP8) { _Pragma("unroll") for (int m = 0; m < 4; ++m) _Pragma("unroll") for (int n = 0; n < 2; ++n) \
        asm volatile("v_mfma_scale_f32_16x16x128_f8f6f4 %0, %1, %2, %0, %3, %3 op_sel_hi:[0,0,0]" : "+v"(acc[ai][bj][m][n]) : "v"(Bt##8[n]), "v"(At##8[m]), "v"(sc8)); } \
        else { _Pragma("unroll") for (int m = 0; m < 4; ++m) _Pragma("unroll") for (int n = 0; n < 2; ++n) _Pragma("unroll") for (int k = 0; k < 2; ++k) \
        acc[ai][bj][m][n] = __builtin_amdgcn_mfma_f32_16x16x32_bf16(Bt[n][k], At[m][k], acc[ai][bj][m][n], 0, 0, 0); } __builtin_amdgcn_s_setprio(0); } while (0)
#define PG8_WAIT_V(n) asm volatile("s_waitcnt vmcnt(" #n ")" ::: "memory")
#define PG8_WAIT_L(n) asm volatile("s_waitcnt lgkmcnt(" #n ")" ::: "memory")
#define PG8_BAR __builtin_amdgcn_s_barrier()
#define PG8_SCHED __builtin_amdgcn_sched_barrier(0)
    Unit cur, nxt; int ui = 0;
    if (!S.next(0, cur)) return;
    f32x4 acc[2][2][4][2];
#pragma unroll
    for (int a = 0; a < 2; ++a)
#pragma unroll
        for (int b = 0; b < 2; ++b)
#pragma unroll
            for (int m = 0; m < 4; ++m)
#pragma unroll
                for (int n = 0; n < 2; ++n) acc[a][b][m][n] = (f32x4){0.f, 0.f, 0.f, 0.f};
    bf16x8 At[4][2], B0[2][2], B1[2][2]; v8i_t At8[4], B08[2], B18[2]; const int sc8 = 0x7f7f7f7f;
    const char* cA = S.a_ptr(cur); const char* cB = S.b_ptr(cur);
    unsigned vcur[2][2] = {{0u, 0u}, {0u, 0u}}, vnext[2][2] = {{0u, 0u}, {0u, 0u}}, vt2[2][2] = {{0u, 0u}, {0u, 0u}};
    if constexpr (GATHER) S.gather(cur, sR[0], sR[1], sC[0], sC[1], 0, vcur);
    PG8_STAGE(PG8_SB(0, 0), cB, voffB); PG8_STAGE(PG8_SB(0, 1), cB + hstep, voffB); PG8_STAGE_A(PG8_SA(0, 0), cA, 0, vcur); PG8_STAGE_A(PG8_SA(0, 1), cA, 1, vcur);
    if (wr == 1) PG8_BAR;
    PG8_WAIT_V(2); PG8_BAR;
    PG8_STAGE(PG8_SB(1, 0), cB + kstep, voffB); PG8_STAGE_A(PG8_SA(1, 0), cA + kstep, 0, vcur); PG8_STAGE(PG8_SB(1, 1), cB + hstep + kstep, voffB);
    PG8_WAIT_V(6); PG8_BAR;
    for (;;) {
        const bool has_next = S.next(ui + 1, nxt);
        const char* nA = has_next ? S.a_ptr(nxt) : cA; const char* nB = has_next ? S.b_ptr(nxt) : cB;
        if constexpr (GATHER) { if (has_next) S.gather(nxt, sR[0], sR[1], sC[0], sC[1], 0, vnext); else {
#pragma unroll
            for (int h = 0; h < 2; ++h) { vnext[h][0] = vcur[h][0]; vnext[h][1] = vcur[h][1]; } } }
        for (int t = 0; t < nt; t += 2) {
            const bool last = (t == nt - 2);
            const char* a1 = cA + (size_t)(t + 1) * kstep;
            const char* a2 = last ? nA : cA + (size_t)(t + 2) * kstep; const char* b2 = last ? nB : cB + (size_t)(t + 2) * kstep;
            const char* a3 = a2 + kstep; const char* b3 = b2 + kstep;
            if constexpr (GATHER) {
#pragma unroll
                for (int h = 0; h < 2; ++h) { vt2[h][0] = last ? vnext[h][0] : vcur[h][0]; vt2[h][1] = last ? vnext[h][1] : vcur[h][1]; } }
            PG8_LDB(B0, 0, 0); PG8_LDB(B1, 0, 1); PG8_SCHED; PG8_LDA(At, 0, 0); PG8_STAGE_A(PG8_SA(1, 1), a1, 1, vcur);
            PG8_WAIT_V(8); PG8_WAIT_L(0); PG8_BAR; PG8_MMA(0, 0, At, B0); PG8_MMA(0, 1, At, B1); PG8_BAR; PG8_SCHED;
            PG8_LDA(At, 0, 1); PG8_STAGE(PG8_SB(0, 0), b2, voffB); PG8_STAGE(PG8_SB(0, 1), b2 + hstep, voffB); PG8_STAGE_A(PG8_SA(0, 0), a2, 0, vt2);
            PG8_WAIT_V(8); PG8_WAIT_L(0); PG8_BAR; PG8_MMA(1, 0, At, B0); PG8_MMA(1, 1, At, B1); PG8_BAR; PG8_SCHED;
            PG8_LDB(B0, 1, 0); PG8_LDB(B1, 1, 1); PG8_SCHED; PG8_LDA(At, 1, 0); PG8_STAGE_A(PG8_SA(0, 1), a2, 1, vt2);
            PG8_WAIT_V(8); PG8_WAIT_L(0); PG8_BAR; PG8_MMA(0, 0, At, B0); PG8_MMA(0, 1, At, B1); PG8_BAR; PG8_SCHED;
            PG8_LDA(At, 1, 1); PG8_STAGE(PG8_SB(1, 0), b3, voffB); PG8_STAGE(PG8_SB(1, 1), b3 + hstep, voffB); PG8_STAGE_A(PG8_SA(1, 0), a3, 0, vt2);
            PG8_WAIT_V(8); PG8_WAIT_L(0); PG8_BAR; PG8_MMA(1, 0, At, B0); PG8_MMA(1, 1, At, B1); PG8_BAR; PG8_SCHED;
        }
        if (wr == 0) PG8_BAR;
        if constexpr (FP8) { asm volatile("s_nop 15\n\ts_nop 15" ::: "memory"); }
        for (int rp_ = 0; rp_ < Epi::REPS; ++rp_) E(acc, cur, wr, wc, fr, fq);
        if (!has_next) break;
#pragma unroll
        for (int a = 0; a < 2; ++a)
#pragma unroll
            for (int b = 0; b < 2; ++b)
#pragma unroll
                for (int m = 0; m < 4; ++m)
#pragma unroll
                    for (int n = 0; n < 2; ++n) acc[a][b][m][n] = (f32x4){0.f, 0.f, 0.f, 0.f};
        cur = nxt; cA = nA; cB = nB; ++ui;
        if constexpr (GATHER) {
#pragma unroll
            for (int h = 0; h < 2; ++h) { vcur[h][0] = vnext[h][0]; vcur[h][1] = vnext[h][1]; } }
        if (wr == 1) PG8_BAR;
    }
    PG8_WAIT_V(0);
    PG8_BAR;
#undef PG8_SA
#undef PG8_SB
#undef PG8_STAGE
#undef PG8_STAGE_A
#undef PG8_LDA
#undef PG8_LDB
#undef PG8_MMA
#undef PG8_WAIT_V
#undef PG8_WAIT_L
#undef PG8_BAR
#undef PG8_SCHED
}

template <int NP> __device__ __forceinline__ float row_rs(const float* ssq, int row) {
    float s;
    if constexpr (NP == 1) s = ssq[row];
    else { const f32x4* p = (const f32x4*)(ssq + (size_t)row * 16); const f32x4 a = p[0], b = p[1], c = p[2], d = p[3];
        s = (((a[0] + a[1]) + (a[2] + a[3])) + ((b[0] + b[1]) + (b[2] + b[3]))) + (((c[0] + c[1]) + (c[2] + c[3])) + ((d[0] + d[1]) + (d[2] + d[3]))); }
    return __builtin_amdgcn_rsqf(s * (1.0f / D) + RMS_EPS);
}
template <int NP> struct EpiScaleBf16 {
    static constexpr bool PERM = true; static constexpr int REPS = 1;
    bf16_t* O; int ldc; const float* ssq;
    __device__ __forceinline__ void operator()(const f32x4 (&acc)[2][2][4][2], const Unit& u, int wr, int wc, int fr, int fq) const {
        const int row0 = u.pm * BM + wr * 64 + fr, col0 = u.pn * BM + wc * 32 + 8 * fq;
#pragma unroll
        for (int ai = 0; ai < 2; ++ai)
#pragma unroll
            for (int m = 0; m < 4; ++m) { const int row = row0 + ai * HALF + m * 16; const float rs = row_rs<NP>(ssq, row);
                bf16_t* rowp = O + (size_t)row * ldc + col0;
#pragma unroll
                for (int bj = 0; bj < 2; ++bj) { const f32x4 v0 = acc[ai][bj][m][0] * rs, v1 = acc[ai][bj][m][1] * rs;
                    u32x4 w; w.x = cvt_pk_bf16(v0[0], v0[1]); w.y = cvt_pk_bf16(v0[2], v0[3]); w.z = cvt_pk_bf16(v1[0], v1[1]); w.w = cvt_pk_bf16(v1[2], v1[3]);
                    *(u32x4*)(rowp + bj * HALF) = w; } }
    }
};
template <bool SSQ> struct EpiResid {
    static constexpr bool PERM = false; static constexpr int REPS = 1;
    const float* base; float* out; bf16_t* xb; float* ssq;
    __device__ __forceinline__ void operator()(const f32x4 (&acc)[2][2][4][2], const Unit& u, int wr, int wc, int fr, int fq) const {
        const int row0 = u.pm * BM + wr * 64 + fr, col0 = u.pn * BM + wc * 32 + 4 * fq;
#pragma unroll
        for (int ai = 0; ai < 2; ++ai)
#pragma unroll
            for (int m = 0; m < 4; ++m) { const int row = row0 + ai * HALF + m * 16; const size_t off = (size_t)row * D + col0; float s = 0.f;
#pragma unroll
                for (int bj = 0; bj < 2; ++bj)
#pragma unroll
                    for (int n = 0; n < 2; ++n) { const f32x4 o = *(const f32x4*)(base + off + bj * HALF + n * 16) + acc[ai][bj][m][n];
                        *(f32x4*)(out + off + bj * HALF + n * 16) = o; u32x2 w; w.x = cvt_pk_bf16(o[0], o[1]); w.y = cvt_pk_bf16(o[2], o[3]);
                        *(u32x2*)(xb + off + bj * HALF + n * 16) = w; s += (o[0] * o[0] + o[1] * o[1]) + (o[2] * o[2] + o[3] * o[3]); }
                if constexpr (SSQ) { s += __shfl_xor(s, 16); s += __shfl_xor(s, 32);
                    if (fq == 0) ssq[(size_t)row * 16 + u.pn * 4 + wc] = s; }
                asm volatile("" ::: "memory"); }
    }
};
template <int NP> struct EpiSwiglu {
    static constexpr bool PERM = true; static constexpr int REPS = REP_EPI;
    bf16_t* O; int ldc; const float* ssq;
    __device__ __forceinline__ void operator()(const f32x4 (&acc)[2][2][4][2], const Unit& u, int wr, int wc, int fr, int fq) const {
        const int row0 = u.pm * BM + wr * 64 + fr, col0 = u.pn * HALF + wc * 32 + 8 * fq;
#pragma unroll
        for (int ai = 0; ai < 2; ++ai)
#pragma unroll
            for (int m = 0; m < 4; ++m) { const int row = row0 + ai * HALF + m * 16; const float rs = row_rs<NP>(ssq, row);
                float h[8];
#pragma unroll
                for (int n = 0; n < 2; ++n)
#pragma unroll
                    for (int j = 0; j < 4; ++j) h[n * 4 + j] = silu_f(acc[ai][0][m][n][j] * rs) * (acc[ai][1][m][n][j] * rs);
                u32x4 w; w.x = cvt_pk_bf16(h[0], h[1]); w.y = cvt_pk_bf16(h[2], h[3]); w.z = cvt_pk_bf16(h[4], h[5]); w.w = cvt_pk_bf16(h[6], h[7]);
                *(u32x4*)(O + (size_t)row * ldc + col0) = w; }
    }
};
struct EpiSwigluMoe {
    static constexpr bool PERM = true; static constexpr int REPS = 1;
    bf16_t* O; int ldc; const float* rsv; const int* row_tok; float wsinv;
    __device__ __forceinline__ void operator()(const f32x4 (&acc)[2][2][4][2], const Unit& u, int wr, int wc, int fr, int fq) const {
        const int row0 = u.pm * BM + wr * 64 + fr, col0 = u.pn * HALF + wc * 32 + 8 * fq;
#pragma unroll
        for (int ai = 0; ai < 2; ++ai)
#pragma unroll
            for (int m = 0; m < 4; ++m) { const int row = row0 + ai * HALF + m * 16; const int tok = row_tok[row]; const float rs = tok >= 0 ? rsv[tok] * wsinv : 0.f;
                float h[8];
#pragma unroll
                for (int n = 0; n < 2; ++n)
#pragma unroll
                    for (int j = 0; j < 4; ++j) h[n * 4 + j] = silu_f(acc[ai][0][m][n][j] * rs) * (acc[ai][1][m][n][j] * rs);
                u32x4 w; w.x = cvt_pk_bf16(h[0], h[1]); w.y = cvt_pk_bf16(h[2], h[3]); w.z = cvt_pk_bf16(h[4], h[5]); w.w = cvt_pk_bf16(h[6], h[7]);
                *(u32x4*)(O + (size_t)row * ldc + col0) = w; }
    }
};
struct EpiSwigluMoe8 {
    static constexpr bool PERM = true; static constexpr int REPS = 1;
    unsigned char* O; int ldc; const float* rsv; const int* row_tok; float wsinv;
    __device__ __forceinline__ void operator()(const f32x4 (&acc)[2][2][4][2], const Unit& u, int wr, int wc, int fr, int fq) const {
        const int row0 = u.pm * BM + wr * 64 + fr, col0 = u.pn * HALF + wc * 32 + 8 * fq;
#pragma unroll
        for (int ai = 0; ai < 2; ++ai)
#pragma unroll
            for (int m = 0; m < 4; ++m) { const int row = row0 + ai * HALF + m * 16; const int tok = row_tok[row]; const float rs = tok >= 0 ? rsv[tok] * wsinv : 0.f;
                float h[8];
#pragma unroll
                for (int n = 0; n < 2; ++n)
#pragma unroll
                    for (int j = 0; j < 4; ++j) h[n * 4 + j] = silu_f(acc[ai][0][m][n][j] * rs) * (acc[ai][1][m][n][j] * rs);
                u32x2 w; w.x = pk4_fp8(h[0], h[1], h[2], h[3]); w.y = pk4_fp8(h[4], h[5], h[6], h[7]);
                *(u32x2*)(O + (size_t)row * ldc + col0) = w; }
    }
};
struct EpiMoeDown {
    static constexpr bool PERM = false; static constexpr int REPS = 1;
    float* out; const int* row_tok; const float* row_gate; float sc;
    __device__ __forceinline__ void operator()(const f32x4 (&acc)[2][2][4][2], const Unit& u, int wr, int wc, int fr, int fq) const {
        const int row0 = u.pm * BM + wr * 64 + fr, col0 = u.pn * BM + wc * 32 + 4 * fq;
#pragma unroll
        for (int ai = 0; ai < 2; ++ai)
#pragma unroll
            for (int m = 0; m < 4; ++m) { const int row = row0 + ai * HALF + m * 16; const int tok = row_tok[row]; const float g = row_gate[row] * sc;
                if (tok >= 0) { float* rp = out + (size_t)tok * D + col0;
#pragma unroll
                    for (int bj = 0; bj < 2; ++bj)
#pragma unroll
                        for (int n = 0; n < 2; ++n) { f32x4* p = (f32x4*)(rp + bj * HALF + n * 16); *p = *p + acc[ai][bj][m][n] * g; } }
                asm volatile("" ::: "memory"); }
    }
};
}

#define XB_TMO      128
#define XB_XCNT(j)  (256  + 64 * (j))
#define XB_XSUB(j)  (1280 + 64 * (j))
#define XB_XGEN(j)  (2304 + 64 * (j))
#define XB_TOP      3328
#define XB_TOPGEN   3392
#define XCD_BAR_WORDS 3456
#define XB_SPIN_CAP (1u << 18)
__device__ __forceinline__ unsigned xb_ld(unsigned* p)              { return __hip_atomic_load(p, __ATOMIC_RELAXED, __HIP_MEMORY_SCOPE_AGENT); }
__device__ __forceinline__ unsigned xb_add(unsigned* p, unsigned v) { return __hip_atomic_fetch_add(p, v, __ATOMIC_RELAXED, __HIP_MEMORY_SCOPE_AGENT); }
__device__ __forceinline__ unsigned xb_xcc_id() { return (unsigned)__builtin_amdgcn_s_getreg((3 << 11) | 20) & 0xFu; }
#define XB_SPIN(cond, bar) do { unsigned _sp = 0; while (cond) { __builtin_amdgcn_s_sleep(1); \
    if ((++_sp & 255u) == 0u) { if (xb_ld(&(bar)[XB_TMO])) break; if (_sp > XB_SPIN_CAP) { atomicAdd(&(bar)[XB_TMO], 1u); break; } } } } while (0)
struct XcdBarrier { unsigned* bar; unsigned x; volatile LAS unsigned* st; };
__device__ __forceinline__ XcdBarrier xcd_barrier_post(unsigned* bar, volatile LAS unsigned* st) {
    XcdBarrier b; b.bar = bar; b.x = xb_xcc_id(); b.st = st;
    if (threadIdx.x == 0) (void)xb_add(&bar[XB_XCNT(b.x)], 1u);
    return b;
}
__device__ __forceinline__ void xcd_barrier_complete(unsigned* bar, unsigned x, unsigned& nloc, unsigned& nx) {
    const unsigned G = gridDim.x * gridDim.y * gridDim.z;
    unsigned sum, cnt, mine, sp = 0u;
    for (;;) {
        sum = 0u; cnt = 0u; mine = 0u;
#pragma unroll
        for (unsigned j = 0; j < 16; ++j) { const unsigned c = xb_ld(&bar[XB_XCNT(j)]); sum += c; cnt += (c > 0u) ? 1u : 0u; mine = (j == x) ? c : mine; }
        if (sum == G) break;
        __builtin_amdgcn_s_sleep(1);
        if ((++sp & 255u) == 0u) { if (xb_ld(&bar[XB_TMO])) break; if (sp > XB_SPIN_CAP) { atomicAdd(&bar[XB_TMO], 1u); break; } }
    }
    nloc = mine > 0u ? mine : 1u; nx = cnt > 0u ? cnt : 1u;
}
__device__ __forceinline__ void xcd_barrier(const XcdBarrier& b) {
    asm volatile("s_waitcnt vmcnt(0)" ::: "memory");
    __syncthreads();
    if (threadIdx.x == 0) {
        unsigned* bar = b.bar;
        __builtin_amdgcn_s_waitcnt(0);
        unsigned nloc = b.st[0], nx = b.st[1];
        if (nloc == 0u) { xcd_barrier_complete(bar, b.x, nloc, nx); b.st[0] = nloc; b.st[1] = nx; }
        const unsigned old = xb_add(&bar[XB_XSUB(b.x)], 1u);
        const unsigned gen = old / nloc;
        if (old + 1u == (gen + 1u) * nloc) {
            __builtin_amdgcn_fence(__ATOMIC_RELEASE, "agent");
            asm volatile("s_waitcnt vmcnt(0)" ::: "memory");
            const unsigned og = xb_add(&bar[XB_TOP], 1u);
            const unsigned tg = og / nx;
            if (og + 1u == (tg + 1u) * nx) xb_add(&bar[XB_TOPGEN], 1u);
            else XB_SPIN(xb_ld(&bar[XB_TOPGEN]) == tg, bar);
            __builtin_amdgcn_fence(__ATOMIC_ACQUIRE, "agent");
            xb_add(&bar[XB_XGEN(b.x)], 1u);
            asm volatile("s_waitcnt vmcnt(0)" ::: "memory");
        } else {
            XB_SPIN(xb_ld(&bar[XB_XGEN(b.x)]) == gen, bar);
            __builtin_amdgcn_fence(__ATOMIC_ACQUIRE, "agent");
            asm volatile("s_waitcnt vmcnt(0)" ::: "memory");
        }
    }
    __syncthreads();
}

constexpr int NIN = 28;
struct Args { const float* in[NIN]; float* out; unsigned char* ws; int ph_lo, ph_hi; };
enum { I_X = 0, I_NORM_MIX, I_W_IN, I_W_OUT, I_SHIFT_MU, I_GM_LN_W, I_GM_LN_B, I_GM_WS, I_GM_BS, I_RW_W_UP, I_RW_W0, I_RW_A_UP, I_RW_A0, I_RW_G_UP, I_RW_K_K, I_RW_K_A, I_RW_R_K,
       I_RW_LNX_W, I_RW_LNX_B, I_NORM_FFN, I_FFN_WG, I_FFN_WU, I_FFN_WD, I_MOE_ROUTER, I_MOE_WG, I_MOE_WU, I_MOE_WD, I_NORM_FINAL };

struct Frame {
    LAS unsigned char* lds;
    int tid, lane, wave, G, gw, NGW;
};

struct CvItem { f32x4 v[8]; float gn[8]; };
__device__ __forceinline__ void cv_load(CvItem& it, const float* W, int N, int k0, int n0, const float* gain, float scale, int lane) {
    const int kr = lane >> 3, nq = lane & 7;
#pragma unroll
    for (int i = 0; i < 8; ++i) { it.v[i] = *(const GAS f32x4*)(W + (size_t)(k0 + 8 * i + kr) * N + n0 + 4 * nq); it.gn[i] = gain ? gain[k0 + 8 * i + kr] * scale : scale; }
}
__device__ __forceinline__ void cv_store_fp8(const CvItem& it, int K, unsigned char* WT, int drow0, int k0, LAS float* scr, int lane) {
    { const int kr = lane >> 3, nq = lane & 7;
#pragma unroll
      for (int i = 0; i < 8; ++i) { LAS float* d = scr + (8 * i + kr) * 33 + 4 * nq; d[0] = it.v[i][0] * it.gn[i]; d[1] = it.v[i][1] * it.gn[i]; d[2] = it.v[i][2] * it.gn[i]; d[3] = it.v[i][3] * it.gn[i]; } }
    LDS_WAIT(); asm volatile("" ::: "memory");
    const int n = lane >> 1, hf = lane & 1; const LAS float* sp = scr + (32 * hf) * 33 + n; u32x4 o0, o1;
    o0.x = pk4_fp8(sp[0 * 33], sp[1 * 33], sp[2 * 33], sp[3 * 33]); o0.y = pk4_fp8(sp[4 * 33], sp[5 * 33], sp[6 * 33], sp[7 * 33]); o0.z = pk4_fp8(sp[8 * 33], sp[9 * 33], sp[10 * 33], sp[11 * 33]); o0.w = pk4_fp8(sp[12 * 33], sp[13 * 33], sp[14 * 33], sp[15 * 33]);
    o1.x = pk4_fp8(sp[16 * 33], sp[17 * 33], sp[18 * 33], sp[19 * 33]); o1.y = pk4_fp8(sp[20 * 33], sp[21 * 33], sp[22 * 33], sp[23 * 33]); o1.z = pk4_fp8(sp[24 * 33], sp[25 * 33], sp[26 * 33], sp[27 * 33]); o1.w = pk4_fp8(sp[28 * 33], sp[29 * 33], sp[30 * 33], sp[31 * 33]);
    unsigned char* dst = WT + (size_t)(drow0 + n) * K + k0 + 32 * hf; *(GAS u32x4*)dst = o0; *(GAS u32x4*)(dst + 16) = o1;
    LDS_WAIT(); asm volatile("" ::: "memory");
}
__device__ __forceinline__ void transpose_item(const float* W, int K, int N, bf16* WT, int drow0, int k0, int n0, const float* gain, LAS float* scr, int lane) {
    { const int kr = lane >> 3, nq = lane & 7; f32x4 v[8]; float gn[8];
#pragma unroll
      for (int i = 0; i < 8; ++i) { v[i] = *(const GAS f32x4*)(W + (size_t)(k0 + 8 * i + kr) * N + n0 + 4 * nq); gn[i] = gain ? gain[k0 + 8 * i + kr] : 1.f; }
#pragma unroll
      for (int i = 0; i < 8; ++i) { LAS float* d = scr + (8 * i + kr) * 33 + 4 * nq; d[0] = v[i][0] * gn[i]; d[1] = v[i][1] * gn[i]; d[2] = v[i][2] * gn[i]; d[3] = v[i][3] * gn[i]; } }
    LDS_WAIT(); asm volatile("" ::: "memory");
    const int c = lane & 7;
#pragma unroll
    for (int j = 0; j < 4; ++j) { const int n = (lane >> 3) + 8 * j; const LAS float* s = scr + (8 * c) * 33 + n;
        u32x4 o; o.x = pk2(s[0 * 33], s[1 * 33]); o.y = pk2(s[2 * 33], s[3 * 33]); o.z = pk2(s[4 * 33], s[5 * 33]); o.w = pk2(s[6 * 33], s[7 * 33]);
        *(GAS u32x4*)(WT + (size_t)(drow0 + n) * K + k0 + 8 * c) = o; }
    LDS_WAIT(); asm volatile("" ::: "memory");
}
__device__ __forceinline__ void convert_matrix_fp8(Frame& F, const float* W, int K, int N, unsigned char* WT, int gu_mode  , const float* gain, float scale, int& itbase) {
    LAS float* scr = (LAS float*)(F.lds + F.wave * 16384);
    const int nblk = N / 32, nit = (K / 64) * nblk;
    int first = F.gw - (itbase % F.NGW); if (first < 0) first += F.NGW;
    CvItem nx;
    if (first < nit) cv_load(nx, W, N, 64 * (first / nblk), 32 * (first % nblk), gain, scale, F.lane);
    for (int r = first; r < nit; r += F.NGW) { const int kb = r / nblk, nb = r % nblk, n0 = 32 * nb;
        const int drow0 = gu_mode == 0 ? n0 : (n0 / 128) * 256 + (gu_mode == 2 ? 128 : 0) + (n0 % 128);
        const CvItem cur = nx; const int r2 = r + F.NGW;
        if (r2 < nit) cv_load(nx, W, N, 64 * (r2 / nblk), 32 * (r2 % nblk), gain, scale, F.lane);
        cv_store_fp8(cur, K, WT, drow0, 64 * kb, scr, F.lane); }
    itbase += nit;
}
__device__ __forceinline__ void convert_matrix(Frame& F, const float* W, int K, int N, bf16* WT, int gu_mode  , const float* gain, int it0, int& itbase) {
    LAS float* scr = (LAS float*)(F.lds + F.wave * 16384);
    const int nblk = N / 32, nit = (K / 64) * nblk;
    int first = F.gw - (itbase % F.NGW); if (first < 0) first += F.NGW;
    for (int r = first; r < nit; r += F.NGW) { const int kb = r / nblk, nb = r % nblk, n0 = 32 * nb;
        const int drow0 = gu_mode == 0 ? n0 : (n0 / 128) * 256 + (gu_mode == 2 ? 128 : 0) + (n0 % 128);
        transpose_item(W, K, N, WT, drow0, 64 * kb, n0, gain, scr, F.lane); }
    itbase += nit; (void)it0;
}

__device__ __forceinline__ void gmlp_naive(Frame& F, const bf16* P, bf16* Y, const float* ln_w, const float* ln_b, const float* ws, const float* bs) {
    LAS float* V = (LAS float*)F.lds;
    for (int unit = blockIdx.x; unit < NB * (SEQ / GCH) * NH; unit += F.G) {
        const int h = unit % NH, bc = unit / NH; const size_t row0 = (size_t)bc * GCH;
        const float lw = ln_w[h * HD + F.lane], lb = ln_b[h * HD + F.lane];
        for (int i = 0; i < 16; ++i) { const int t = F.wave * 16 + i;
            const float g = gelu_erf(bf2f(P[(row0 + t) * INW + GMW + h * HD + F.lane]));
            const float mean = wave_sum(g) * (1.f / HD); const float d = g - mean; const float var = wave_sum(d * d) * (1.f / HD);
            V[t * HD + F.lane] = d * __builtin_amdgcn_rsqf(var + LN_EPS) * lw + lb; }
        __syncthreads();
        for (int i = 0; i < 16; ++i) { const int t = F.wave * 16 + i; const float* wrow = ws + ((size_t)h * GCH + t) * GCH; float acc = 0.f;
            for (int s = 0; s <= t; ++s) acc += wrow[s] * V[s * HD + F.lane];
            const float mixed = acc + bs[h * GCH + t];
            const float u = gelu_erf(bf2f(P[(row0 + t) * INW + h * HD + F.lane]));
            Y[(row0 + t) * D + h * HD + F.lane] = (bf16)f2bf(u * mixed); }
        __syncthreads();
    }
}
__device__ __forceinline__ float shifted(const bf16* P, size_t row, int t, int col, const float* mu) {
    const float c = bf2f(P[row * INW + col]); const float pr = t > 0 ? bf2f(P[(row - 1) * INW + col]) : 0.f;
    return c + (pr - c) * mu[col - 1024];
}
constexpr int NC = 32;
__device__ __forceinline__ void rwkv_naive(Frame& F, const bf16* P, bf16* Y, const float* mu, const float* w_up, const float* w0, const float* a_up, const float* a0, const float* g_up,
                                           const float* k_k, const float* k_a, const float* r_k, const float* lnx_w, const float* lnx_b) {
    LAS float* LI = (LAS float*)F.lds;
    LAS float* sR = LI + NC * 256; LAS float* sW = sR + NC * 64; LAS float* sK = sW + NC * 64; LAS float* sV = sK + NC * 64; LAS float* sA = sV + NC * 64; LAS float* sB = sA + NC * 64;
    LAS float* sG = sB + NC * 64; LAS float* sBon = sG + NC * 64;
    for (int unit = blockIdx.x; unit < NB * NH; unit += F.G) {
        const int b = unit / NH, h = unit % NH;
        float S[64];
#pragma unroll
        for (int k = 0; k < 64; ++k) S[k] = 0.f;
        for (int c = 0; c < SEQ / NC; ++c) {
            const int t0 = c * NC; const size_t row0 = (size_t)b * SEQ + t0;
            for (int idx = F.tid; idx < NC * 256; idx += 512) { const int tok = idx >> 8, j = idx & 255;
                const float x = shifted(P, row0 + tok, t0 + tok, 2560 + j, mu);
                LI[idx] = j < 64 ? tanhf(x) : (j < 128 ? x : sigmoidf_(x)); }
            __syncthreads();
            { const int ch = F.lane, hc = h * HD + ch;
              for (int i = 0; i < NC / 8; ++i) { const int tok = F.wave + 8 * i; const size_t row = row0 + tok; const int t = t0 + tok;
                const float rr = shifted(P, row, t, 1024 + hc, mu), kx = shifted(P, row, t, 1536 + hc, mu), vv = shifted(P, row, t, 2048 + hc, mu);
                float dw = w0[hc], da = a0[hc], gg = 0.f;
                for (int j = 0; j < 64; ++j) { dw += LI[tok * 256 + j] * w_up[j * RWW + hc]; da += LI[tok * 256 + 64 + j] * a_up[j * RWW + hc]; }
                for (int j = 0; j < 128; ++j) gg += LI[tok * 256 + 128 + j] * g_up[j * RWW + hc];
                const float z = -dw; const float sp = fmaxf(z, 0.f) + log1pf(__expf(-fabsf(z)));
                const float decay = __expf(-__expf(-sp - 0.5f));
                const float alr = sigmoidf_(da);
                const float kkv = kx * k_k[hc]; const float nrm = sqrtf(wave_sum(kkv * kkv)); const float kkn = kkv / fmaxf(nrm, 1e-12f);
                const float kmod = kx * (1.f + (alr - 1.f) * k_a[hc]);
                const float bsc = wave_sum(rr * kmod * r_k[hc]);
                sR[tok * 64 + ch] = rr; sW[tok * 64 + ch] = decay; sK[tok * 64 + ch] = kmod; sV[tok * 64 + ch] = vv; sA[tok * 64 + ch] = -kkn; sB[tok * 64 + ch] = kkn * alr;
                sG[tok * 64 + ch] = gg; sBon[tok * 64 + ch] = bsc * vv; } }
            __syncthreads();
            if (F.wave == 0) {
                for (int t = 0; t < NC; ++t) { float sa = 0.f;
#pragma unroll
                    for (int k = 0; k < 64; ++k) sa += S[k] * sA[t * 64 + k];
                    const float vv = sV[t * 64 + F.lane]; float yv = 0.f;
#pragma unroll
                    for (int k = 0; k < 64; ++k) { S[k] = S[k] * sW[t * 64 + k] + sa * sB[t * 64 + k] + vv * sK[t * 64 + k]; yv += S[k] * sR[t * 64 + k]; }
                    LI[t * 64 + F.lane] = yv; }
            }
            __syncthreads();
            { const int v = F.lane, hv = h * HD + v;
              for (int i = 0; i < NC / 8; ++i) { const int tok = F.wave + 8 * i; const float yv = LI[tok * 64 + v];
                const float mean = wave_sum(yv) * (1.f / HD); const float d = yv - mean; const float var = wave_sum(d * d) * (1.f / HD);
                const float yn = d * __builtin_amdgcn_rsqf(var + GN_EPS) * lnx_w[hv] + lnx_b[hv];
                Y[(row0 + tok) * D + GMW + hv] = (bf16)f2bf((yn + sBon[tok * 64 + v]) * sG[tok * 64 + v]); } }
            __syncthreads();
        }
    }
}

typedef short s16x4 __attribute__((ext_vector_type(4)));
typedef short v4i16_t __attribute__((ext_vector_type(4)));
#define MFMA32(a, b, c) __builtin_amdgcn_mfma_f32_16x16x32_bf16((a), (b), (c), 0, 0, 0)
#define MFMA16(a, b, c) __builtin_amdgcn_mfma_f32_16x16x16bf16_1k((a), (b), (c), 0, 0, 0)
__device__ __forceinline__ bf16x8 lds_row8(const LAS bf16* T, int ld, int r0, int k0, int lane) { return *(const LAS bf16x8*)(T + (r0 + (lane & 15)) * ld + k0 + 8 * (lane >> 4)); }
__device__ __forceinline__ s16x4 lds_row4(const LAS bf16* T, int ld, int r0, int k0, int lane) { return *(const LAS s16x4*)(T + (r0 + (lane & 15)) * ld + k0 + 4 * (lane >> 4)); }
__device__ __forceinline__ s16x4 lds_tr4(const LAS bf16* T, int ld, int k0, int c0, int lane) { const int i = lane & 15, g = lane >> 4;
    return __builtin_bit_cast(s16x4, __builtin_amdgcn_ds_read_tr16_b64_v4i16((LAS v4i16_t*)(T + (k0 + 4 * g + (i >> 2)) * ld + c0 + 4 * (i & 3)))); }
__device__ __forceinline__ bf16x8 lds_tr8(const LAS bf16* T, int ld, int k0, int c0, int lane) { const int i = lane & 15, g = lane >> 4;
    const LAS bf16* p = T + (k0 + 8 * g + (i >> 2)) * ld + c0 + 4 * (i & 3);
    const s16x4 lo = __builtin_bit_cast(s16x4, __builtin_amdgcn_ds_read_tr16_b64_v4i16((LAS v4i16_t*)p));
    const s16x4 hi = __builtin_bit_cast(s16x4, __builtin_amdgcn_ds_read_tr16_b64_v4i16((LAS v4i16_t*)(p + 4 * ld)));
    bf16x8 r; r[0] = lo[0]; r[1] = lo[1]; r[2] = lo[2]; r[3] = lo[3]; r[4] = hi[0]; r[5] = hi[1]; r[6] = hi[2]; r[7] = hi[3]; return r; }
typedef __bf16 bf16x2_t __attribute__((ext_vector_type(2)));
__device__ __forceinline__ unsigned cvtpk_c(float lo, float hi) { const f32x2 v = {lo, hi}; const bf16x2_t b = __builtin_convertvector(v, bf16x2_t); return __builtin_bit_cast(unsigned, b); }
__device__ __forceinline__ s16x4 pack4(const f32x4 v) { u32x2 w; w.x = cvtpk_c(v[0], v[1]); w.y = cvtpk_c(v[2], v[3]); return __builtin_bit_cast(s16x4, w); }
__device__ __forceinline__ f32x4 unpack4(const s16x4 v) { f32x4 r; r[0] = bf2f((bf16)v[0]); r[1] = bf2f((bf16)v[1]); r[2] = bf2f((bf16)v[2]); r[3] = bf2f((bf16)v[3]); return r; }
__device__ __forceinline__ void unpack8(const u32x4 w, float (&o)[8]) { o[0] = __builtin_bit_cast(float, w.x << 16); o[1] = __builtin_bit_cast(float, w.x & 0xffff0000u); o[2] = __builtin_bit_cast(float, w.y << 16); o[3] = __builtin_bit_cast(float, w.y & 0xffff0000u);
    o[4] = __builtin_bit_cast(float, w.z << 16); o[5] = __builtin_bit_cast(float, w.z & 0xffff0000u); o[6] = __builtin_bit_cast(float, w.w << 16); o[7] = __builtin_bit_cast(float, w.w & 0xffff0000u); }
__device__ __forceinline__ u32x4 pack8(const float (&v)[8]) { u32x4 w; w.x = cvtpk_c(v[0], v[1]); w.y = cvtpk_c(v[2], v[3]); w.z = cvtpk_c(v[4], v[5]); w.w = cvtpk_c(v[6], v[7]); return w; }
__device__ __forceinline__ float gelu_as(float v) {
    const float av = fabsf(v), t = __builtin_amdgcn_rcpf(av * 0.2316418882f + 1.0f);
    float q = t * 0.5307027145f + (-0.7265760135f); q = q * t + 0.7107068705f; q = q * t + (-0.142248368f); q = q * t + 0.127414796f; q = q * t;
    const float e = __builtin_amdgcn_exp2f((v * v) * (-0.72134752044f)); const float m = v * (q * e); return v < 0.f ? m : v - m;
}

constexpr int GM_V = 0, GM_U = 128 * 72 * 2;
__device__ __forceinline__ void gmlp_unit(Frame& F, int unit, const bf16* P, bf16* Y, const float* ln_w, const float* ln_b, const bf16* WsB, const float* bs) {
    LAS bf16* Vt = (LAS bf16*)(F.lds + GM_V); LAS bf16* Ut = (LAS bf16*)(F.lds + GM_U);
    const int h = unit % NH, bc = unit / NH; const size_t row0 = (size_t)bc * GCH;
    { const int t = F.tid >> 2, cq = F.tid & 3; const bf16* pr = P + (row0 + t) * INW + h * HD + 16 * cq;
      const u32x4 u0 = *(const u32x4*)pr, u1 = *(const u32x4*)(pr + 8), v0 = *(const u32x4*)(pr + GMW), v1 = *(const u32x4*)(pr + GMW + 8);
      float uu[16], vv[16]; { float a[8]; unpack8(u0, a); for (int j = 0; j < 8; ++j) uu[j] = a[j]; unpack8(u1, a); for (int j = 0; j < 8; ++j) uu[8 + j] = a[j]; unpack8(v0, a); for (int j = 0; j < 8; ++j) vv[j] = a[j]; unpack8(v1, a); for (int j = 0; j < 8; ++j) vv[8 + j] = a[j]; }
      float s = 0.f;
#pragma unroll
      for (int j = 0; j < 16; ++j) { uu[j] = gelu_as(uu[j]); vv[j] = gelu_as(vv[j]); s += vv[j]; }
      s += __shfl_xor(s, 1); s += __shfl_xor(s, 2); const float mean = s * (1.f / HD); float q = 0.f;
#pragma unroll
      for (int j = 0; j < 16; ++j) { vv[j] -= mean; q += vv[j] * vv[j]; }
      q += __shfl_xor(q, 1); q += __shfl_xor(q, 2); const float rstd = __builtin_amdgcn_rsqf(q * (1.f / HD) + LN_EPS);
#pragma unroll
      for (int j = 0; j < 16; ++j) vv[j] = vv[j] * rstd * ln_w[h * HD + 16 * cq + j] + ln_b[h * HD + 16 * cq + j];
      float a[8]; for (int j = 0; j < 8; ++j) a[j] = vv[j]; *(LAS u32x4*)(Vt + t * 72 + 16 * cq) = pack8(a); for (int j = 0; j < 8; ++j) a[j] = vv[8 + j]; *(LAS u32x4*)(Vt + t * 72 + 16 * cq + 8) = pack8(a);
      for (int j = 0; j < 8; ++j) a[j] = uu[j]; *(LAS u32x4*)(Ut + t * 72 + 16 * cq) = pack8(a); for (int j = 0; j < 8; ++j) a[j] = uu[8 + j]; *(LAS u32x4*)(Ut + t * 72 + 16 * cq + 8) = pack8(a); }
    __syncthreads();
    { const int w = F.wave, l15 = F.lane & 15, g = F.lane >> 4, t0 = 16 * w, nks = (w >> 1) + 1; const bf16* wrow = WsB + ((size_t)h * GCH + t0 + l15) * GCH + 8 * g;
      f32x4 acc[4] = {{0.f, 0.f, 0.f, 0.f}, {0.f, 0.f, 0.f, 0.f}, {0.f, 0.f, 0.f, 0.f}, {0.f, 0.f, 0.f, 0.f}};
      for (int ks = 0; ks < nks; ++ks) { const bf16x8 a = *(const bf16x8*)(wrow + 32 * ks);
#pragma unroll
          for (int nt = 0; nt < 4; ++nt) acc[nt] = MFMA32(a, lds_tr8(Vt, 72, 32 * ks, 16 * nt, F.lane), acc[nt]); }
#pragma unroll
      for (int reg = 0; reg < 4; ++reg) { const int t = t0 + 4 * g + reg; const float bsv = bs[h * GCH + t];
#pragma unroll
          for (int nt = 0; nt < 4; ++nt) { LAS bf16* up = Ut + t * 72 + 16 * nt + l15; *up = (bf16)f2bf(bf2f(*up) * (acc[nt][reg] + bsv)); } } }
    __syncthreads();
    { const int t = F.tid >> 2, cq = F.tid & 3; bf16* yr = Y + (row0 + t) * D + h * HD + 16 * cq;
      *(u32x4*)yr = *(const LAS u32x4*)(Ut + t * 72 + 16 * cq); *(u32x4*)(yr + 8) = *(const LAS u32x4*)(Ut + t * 72 + 16 * cq + 8); }
    __syncthreads();
}

struct RwkvW { const float *mu, *w0, *a0, *k_k, *k_a, *r_k, *lnx_w, *lnx_b; const bf16 *WupT, *AupT, *GupT; };
struct RwkvS { bf16 *SG, *SH, *SQ, *SS, *Sg, *SY0; float* Sbsc; };
constexpr int M1_LI = 0;
constexpr int M1_PR = 33792;
constexpr int M1_TL = M1_PR + 36864;
constexpr int M1_SEG = M1_TL + 7 * 9216;
constexpr int M1_GAM = M1_SEG + 2048;
constexpr int M1_D = M1_GAM + 256;
constexpr int M1_T = M1_D + 4096;
constexpr int M1_END = M1_T + 2048;
static_assert(M1_END <= MISC_OFF, "M1 LDS map");
__device__ __forceinline__ float fast_tanh(float x) { const float e = __expf(2.f * x); return 1.f - 2.f * __builtin_amdgcn_rcpf(e + 1.f); }

__device__ __forceinline__ void rwkv_m1_unit(Frame& F, int unit  , const bf16* P, const RwkvW& W, const RwkvS& Sc) {
    const int b = unit >> 6, c = unit & 63, t0 = c * 64; const size_t row0 = (size_t)b * SEQ + t0;
    const int w = F.wave, lane = F.lane, l15 = lane & 15, g = lane >> 4;
    LAS bf16* LI = (LAS bf16*)(F.lds + M1_LI);
    LAS float* Ef = (LAS float*)(F.lds + M1_PR); LAS float* ALf = Ef + 64 * 64;
    LAS bf16* Lab = (LAS bf16*)(F.lds + M1_PR); LAS bf16* Lak = Lab + 64 * 72; LAS bf16* Mrb = Lak + 64 * 72; LAS bf16* Mrk = Mrb + 64 * 72;
    LAS bf16* At = (LAS bf16*)(F.lds + M1_TL); LAS bf16* Bt = At + 64 * 72; LAS bf16* Kt = Bt + 64 * 72; LAS bf16* Rt = Kt + 64 * 72; LAS bf16* Bh = Rt + 64 * 72; LAS bf16* Kh = Bh + 64 * 72; LAS bf16* Vt = Kh + 64 * 72;
    LAS float* SEG = (LAS float*)(F.lds + M1_SEG); LAS float* GAM = (LAS float*)(F.lds + M1_GAM); LAS float* Dd = (LAS float*)(F.lds + M1_D); LAS bf16* Tt = (LAS bf16*)(F.lds + M1_T);
#pragma unroll
    for (int it = 0; it < 4; ++it) { const int item = F.tid + 512 * it, tok = item >> 5, jc = item & 31, j0 = 8 * jc; const size_t row = row0 + tok;
        float cv[8], pv[8]; unpack8(*(const u32x4*)(P + row * INW + 2560 + j0), cv);
        if (t0 + tok > 0) unpack8(*(const u32x4*)(P + (row - 1) * INW + 2560 + j0), pv); else { for (int j = 0; j < 8; ++j) pv[j] = 0.f; }
        const f32x4 m0 = *(const f32x4*)(W.mu + 1536 + j0), m1 = *(const f32x4*)(W.mu + 1536 + j0 + 4); float o[8];
#pragma unroll
        for (int j = 0; j < 8; ++j) { const float x = cv[j] + (pv[j] - cv[j]) * (j < 4 ? m0[j] : m1[j - 4]); o[j] = jc < 8 ? fast_tanh(x) : (jc < 16 ? x : sigmoidf_(x)); }
        *(LAS u32x4*)(LI + tok * 264 + j0) = pack8(o); }
    __syncthreads();
    for (int h = 0; h < NH; ++h) {
        const size_t uh = ((size_t)unit * NH + h) * 4096;
        { const int mt = w & 3, ntb = 2 * (w >> 2); const int chrow = h * HD + 16 * mt + l15;
          f32x4 aw[2] = {{0.f, 0.f, 0.f, 0.f}, {0.f, 0.f, 0.f, 0.f}}, aa[2] = {{0.f, 0.f, 0.f, 0.f}, {0.f, 0.f, 0.f, 0.f}}, ag[2] = {{0.f, 0.f, 0.f, 0.f}, {0.f, 0.f, 0.f, 0.f}};
#pragma unroll
          for (int ks = 0; ks < 2; ++ks) { const bf16x8 fw = *(const bf16x8*)(W.WupT + (size_t)chrow * 64 + 32 * ks + 8 * g), fa = *(const bf16x8*)(W.AupT + (size_t)chrow * 64 + 32 * ks + 8 * g);
#pragma unroll
              for (int q = 0; q < 2; ++q) { aw[q] = MFMA32(fw, lds_row8(LI, 264, 16 * (ntb + q), 32 * ks, lane), aw[q]); aa[q] = MFMA32(fa, lds_row8(LI, 264, 16 * (ntb + q), 64 + 32 * ks, lane), aa[q]); } }
#pragma unroll
          for (int ks = 0; ks < 4; ++ks) { const bf16x8 fg = *(const bf16x8*)(W.GupT + (size_t)chrow * 128 + 32 * ks + 8 * g);
#pragma unroll
              for (int q = 0; q < 2; ++q) ag[q] = MFMA32(fg, lds_row8(LI, 264, 16 * (ntb + q), 128 + 32 * ks, lane), ag[q]); }
          const int ch0 = 16 * mt + 4 * g; const f32x4 w0v = *(const f32x4*)(W.w0 + h * HD + ch0), a0v = *(const f32x4*)(W.a0 + h * HD + ch0);
#pragma unroll
          for (int q = 0; q < 2; ++q) { const int tok = 16 * (ntb + q) + l15; f32x4 ev, av;
#pragma unroll
              for (int r = 0; r < 4; ++r) { const float z = -(aw[q][r] + w0v[r]); const float sp = fmaxf(z, 0.f) + __logf(1.f + __expf(-fabsf(z))); ev[r] = -__expf(-sp - 0.5f); av[r] = sigmoidf_(aa[q][r] + a0v[r]); }
              *(LAS f32x4*)(Ef + tok * 64 + ch0) = ev; *(LAS f32x4*)(ALf + tok * 64 + ch0) = av;
              u32x2 gw; gw.x = cvtpk_c(ag[q][0], ag[q][1]); gw.y = cvtpk_c(ag[q][2], ag[q][3]); *(u32x2*)(Sc.Sg + (row0 + tok) * RWW + h * HD + ch0) = gw; } }
        __syncthreads();
        { const int ch = F.tid & 63, seg = F.tid >> 6; float run = 0.f;
#pragma unroll
          for (int i = 0; i < 8; ++i) { run += Ef[(8 * seg + i) * 64 + ch]; Ef[(8 * seg + i) * 64 + ch] = run; }
          SEG[seg * 64 + ch] = run; }
        __syncthreads();
        { const int ch = F.tid & 63, seg = F.tid >> 6; float off = 0.f;
          for (int s2 = 0; s2 < seg; ++s2) off += SEG[s2 * 64 + ch];
#pragma unroll
          for (int i = 0; i < 8; ++i) Ef[(8 * seg + i) * 64 + ch] += off; }
        __syncthreads();
        { const int tok = F.tid >> 3, cg = F.tid & 7, ch0 = 8 * cg, hc0 = h * HD + ch0; const size_t row = row0 + tok; const bool has_prev = (t0 + tok) > 0;
          float rr[8], kx[8], vv[8], tmp[8], pr[8];
#define SHIFT_LOAD(dst, col) do { unpack8(*(const u32x4*)(P + row * INW + (col)), dst); if (has_prev) unpack8(*(const u32x4*)(P + (row - 1) * INW + (col)), pr); else { for (int j = 0; j < 8; ++j) pr[j] = 0.f; } \
              const f32x4 m0 = *(const f32x4*)(W.mu + (col) - 1024), m1 = *(const f32x4*)(W.mu + (col) - 1024 + 4); for (int j = 0; j < 8; ++j) dst[j] = dst[j] + (pr[j] - dst[j]) * (j < 4 ? m0[j] : m1[j - 4]); } while (0)
          SHIFT_LOAD(rr, 1024 + hc0); SHIFT_LOAD(kx, 1536 + hc0); SHIFT_LOAD(vv, 2048 + hc0);
          (void)tmp;
          float Lt[8], Lm[8], Lc[8], al[8];
#pragma unroll
          for (int j = 0; j < 8; ++j) { Lt[j] = Ef[tok * 64 + ch0 + j]; Lm[j] = tok > 0 ? Ef[(tok - 1) * 64 + ch0 + j] : 0.f; Lc[j] = Ef[63 * 64 + ch0 + j]; al[j] = ALf[tok * 64 + ch0 + j]; }
          float kk[8], km[8]; float ss = 0.f, bs_ = 0.f;
#pragma unroll
          for (int j = 0; j < 8; ++j) { kk[j] = kx[j] * W.k_k[hc0 + j]; ss += kk[j] * kk[j]; km[j] = kx[j] * (1.f + (al[j] - 1.f) * W.k_a[hc0 + j]); bs_ += rr[j] * km[j] * W.r_k[hc0 + j]; }
          ss += __shfl_xor(ss, 1); ss += __shfl_xor(ss, 2); ss += __shfl_xor(ss, 4); bs_ += __shfl_xor(bs_, 1); bs_ += __shfl_xor(bs_, 2); bs_ += __shfl_xor(bs_, 4);
          const float inv = 1.f / fmaxf(sqrtf(ss), 1e-12f);
          if (cg == 0) Sc.Sbsc[row * NH + h] = bs_;
          float oA[8], oB[8], oK[8], oR[8], oBh[8], oKh[8];
#pragma unroll
          for (int j = 0; j < 8; ++j) { const float kn = kk[j] * inv, bb = kn * al[j]; const float einv = __expf(-Lt[j]), ec = __expf(Lc[j] - Lt[j]);
              oA[j] = -kn * __expf(Lm[j]); oB[j] = bb * einv; oK[j] = km[j] * einv; oR[j] = rr[j] * __expf(Lt[j]); oBh[j] = bb * ec; oKh[j] = km[j] * ec; }
          *(LAS u32x4*)(At + tok * 72 + ch0) = pack8(oA); *(LAS u32x4*)(Bt + tok * 72 + ch0) = pack8(oB); *(LAS u32x4*)(Kt + tok * 72 + ch0) = pack8(oK); *(LAS u32x4*)(Rt + tok * 72 + ch0) = pack8(oR);
          *(LAS u32x4*)(Bh + tok * 72 + ch0) = pack8(oBh); *(LAS u32x4*)(Kh + tok * 72 + ch0) = pack8(oKh); *(LAS u32x4*)(Vt + tok * 72 + ch0) = pack8(vv);
          if (tok == 63) { for (int j = 0; j < 8; ++j) GAM[ch0 + j] = __expf(Lc[j]); } }
        __syncthreads();
        for (int i5 = 0; i5 < 5; ++i5) { const int q = w + 8 * i5, mat = q / 10, idx = q % 10; const int ti = idx < 1 ? 0 : (idx < 3 ? 1 : (idx < 6 ? 2 : 3)), si = idx - ti * (ti + 1) / 2;
            const LAS bf16* X = mat < 2 ? At : Rt; const LAS bf16* Yk = (mat & 1) ? Kt : Bt; LAS bf16* O = Lab + mat * 64 * 72;
            f32x4 acc = {0.f, 0.f, 0.f, 0.f};
#pragma unroll
            for (int ks = 0; ks < 2; ++ks) acc = MFMA32(lds_row8(Yk, 72, 16 * si, 32 * ks, lane), lds_row8(X, 72, 16 * ti, 32 * ks, lane), acc);
            const int t = 16 * ti + l15, s0 = 16 * si + 4 * g;
#pragma unroll
            for (int r = 0; r < 4; ++r) { const bool keep = mat < 2 ? (s0 + r < t) : (s0 + r <= t); if (!keep) acc[r] = 0.f; }
            *(LAS s16x4*)(O + t * 72 + s0) = pack4(acc);
            if (mat == 0 && ti == si) *(LAS f32x4*)(Dd + ti * 256 + l15 * 16 + 4 * g) = acc; }
        __syncthreads();
        if (w == 7) { const int i = lane >> 4, cc = lane & 15; const LAS float* Db = Dd + i * 256; float tv[16];
#pragma unroll
            for (int r = 0; r < 16; ++r) { float sum = (r == cc) ? 1.f : 0.f;
#pragma unroll
                for (int s2 = 0; s2 < r; ++s2) sum += Db[r * 16 + s2] * tv[s2];
                tv[r] = sum; }
#pragma unroll
            for (int r = 0; r < 16; ++r) Tt[i * 256 + r * 16 + cc] = (bf16)f2bf(tv[r]); }
        __syncthreads();
        { const bool isU = w < 4; const int cw = w & 3;
          f32x4 X[4];
#pragma unroll
          for (int i = 0; i < 4; ++i) { f32x4 z = {0.f, 0.f, 0.f, 0.f};
              if (isU) {
#pragma unroll
                  for (int j = 0; j <= i; ++j) z = MFMA16(lds_row4(Lak, 72, 16 * i, 16 * j, lane), lds_tr4(Vt, 72, 16 * j, 16 * cw, lane), z);
              } else z = unpack4(lds_tr4(At, 72, 16 * i, 16 * cw, lane));
#pragma unroll
              for (int j = 0; j < i; ++j) z = MFMA16(lds_row4(Lab, 72, 16 * i, 16 * j, lane), pack4(X[j]), z);
              const f32x4 zero = {0.f, 0.f, 0.f, 0.f};
              X[i] = MFMA16(lds_row4(Tt + i * 256, 16, 0, 0, lane), pack4(z), zero); }
          s16x4 Xp[4];
#pragma unroll
          for (int i = 0; i < 4; ++i) Xp[i] = pack4(X[i]);
          if (isU) {
#pragma unroll
              for (int nt = 0; nt < 4; ++nt) { f32x4 acc = {0.f, 0.f, 0.f, 0.f};
#pragma unroll
                  for (int i = 0; i < 4; ++i) { acc = MFMA16(Xp[i], lds_tr4(Bh, 72, 16 * i, 16 * nt, lane), acc); acc = MFMA16(lds_tr4(Vt, 72, 16 * i, 16 * cw, lane), lds_tr4(Kh, 72, 16 * i, 16 * nt, lane), acc); }
                  *(s16x4*)(Sc.SH + uh + (size_t)(16 * nt + l15) * 64 + 16 * cw + 4 * g) = pack4(acc); }
#pragma unroll
              for (int mt = 0; mt < 4; ++mt) { f32x4 acc = {0.f, 0.f, 0.f, 0.f};
#pragma unroll
                  for (int i = 0; i <= mt; ++i) { acc = MFMA16(lds_row4(Mrb, 72, 16 * mt, 16 * i, lane), Xp[i], acc); acc = MFMA16(lds_row4(Mrk, 72, 16 * mt, 16 * i, lane), lds_tr4(Vt, 72, 16 * i, 16 * cw, lane), acc); }
                  *(s16x4*)(Sc.SY0 + uh + (size_t)(16 * cw + l15) * 64 + 16 * mt + 4 * g) = pack4(acc); }
          } else {
              const float gamv = GAM[16 * cw + l15];
#pragma unroll
              for (int nt = 0; nt < 4; ++nt) { f32x4 acc = {0.f, 0.f, 0.f, 0.f};
#pragma unroll
                  for (int i = 0; i < 4; ++i) acc = MFMA16(Xp[i], lds_tr4(Bh, 72, 16 * i, 16 * nt, lane), acc);
                  { const float gam = (nt == cw) ? gamv : 0.f;
#pragma unroll
                      for (int r = 0; r < 4; ++r) acc[r] += (l15 == 4 * g + r) ? gam : 0.f; }
                  *(s16x4*)(Sc.SG + uh + (size_t)(16 * nt + l15) * 64 + 16 * cw + 4 * g) = pack4(acc); }
#pragma unroll
              for (int mt = 0; mt < 4; ++mt) { f32x4 acc = unpack4(lds_tr4(Rt, 72, 16 * mt, 16 * cw, lane));
#pragma unroll
                  for (int i = 0; i <= mt; ++i) acc = MFMA16(lds_row4(Mrb, 72, 16 * mt, 16 * i, lane), Xp[i], acc);
                  *(s16x4*)(Sc.SQ + uh + (size_t)(16 * cw + l15) * 64 + 16 * mt + 4 * g) = pack4(acc); }
          } }
        __syncthreads();
    }
}

constexpr int M1V_LI = 0;
constexpr int M1V_PR = 33792;
constexpr int M1V_TL = M1V_PR + 36864;
constexpr int M1V_SEG = M1V_TL + 5 * 9216;
constexpr int M1V_GAM = M1V_SEG + 2048;
constexpr int M1V_CST = M1V_GAM + 256;
constexpr int M1V_END = M1V_CST + 8 * 2048;
static_assert(M1V_END <= MISC_OFF, "M1 v2 LDS map");
__device__ __forceinline__ void rwkv_m1_consts(Frame& F, const RwkvW& W) {
    LAS float* CST = (LAS float*)(F.lds + M1V_CST);
    for (int i = F.tid; i < 1536; i += 512) CST[i] = W.mu[i];
    CST[3 * 512 + F.tid] = W.k_k[F.tid]; CST[4 * 512 + F.tid] = W.k_a[F.tid]; CST[5 * 512 + F.tid] = W.r_k[F.tid]; CST[6 * 512 + F.tid] = W.w0[F.tid]; CST[7 * 512 + F.tid] = W.a0[F.tid];
    __syncthreads();
}
__device__ __forceinline__ void rwkv_m1v2_unit(Frame& F, int unit  , const bf16* P, const RwkvW& W, const RwkvS& Sc) {
    const int b = unit >> 6, c = unit & 63, t0 = c * 64; const size_t row0 = (size_t)b * SEQ + t0;
    const int w = F.wave, lane = F.lane, l15 = lane & 15, g = lane >> 4;
    LAS bf16* LI = (LAS bf16*)(F.lds + M1V_LI);
    LAS float* Ef = (LAS float*)(F.lds + M1V_PR); constexpr int ES = 68; LAS float* ALf = Ef + 64 * ES;
    LAS bf16* Lab = (LAS bf16*)(F.lds + M1V_PR); LAS bf16* Lak = Lab + 64 * 72; LAS bf16* Mrb = Lak + 64 * 72; LAS bf16* Mrk = Mrb + 64 * 72;
    LAS bf16* At = (LAS bf16*)(F.lds + M1V_TL); LAS bf16* Bt = At + 64 * 72; LAS bf16* Kt = Bt + 64 * 72; LAS bf16* Rt = Kt + 64 * 72; LAS bf16* Vt = Rt + 64 * 72;
    LAS float* SEG = (LAS float*)(F.lds + M1V_SEG); LAS float* GAM = (LAS float*)(F.lds + M1V_GAM); const LAS float* CST = (const LAS float*)(F.lds + M1V_CST);
    bf16x8 wfw[2], wfa[2], wfg[4]; u32x4 pfc[3], pfp[3];
    const int ea_mt = w & 3, ea_ntb = 2 * (w >> 2);
    const int eb_tok = F.tid >> 3, eb_cg = F.tid & 7; const size_t eb_row = row0 + eb_tok; const bool eb_prev = (t0 + eb_tok) > 0;
#define M1_LOAD_W(hh) do { const int chrow_ = (hh) * HD + 16 * ea_mt + l15; \
        wfw[0] = *(const bf16x8*)(W.WupT + (size_t)chrow_ * 64 + 8 * g); wfw[1] = *(const bf16x8*)(W.WupT + (size_t)chrow_ * 64 + 32 + 8 * g); \
        wfa[0] = *(const bf16x8*)(W.AupT + (size_t)chrow_ * 64 + 8 * g); wfa[1] = *(const bf16x8*)(W.AupT + (size_t)chrow_ * 64 + 32 + 8 * g); \
        _Pragma("unroll") for (int ks_ = 0; ks_ < 4; ++ks_) wfg[ks_] = *(const bf16x8*)(W.GupT + (size_t)chrow_ * 128 + 32 * ks_ + 8 * g); } while (0)
#define M1_LOAD_P(hh) do { const int hc_ = (hh) * HD + 8 * eb_cg; \
        _Pragma("unroll") for (int a_ = 0; a_ < 3; ++a_) { pfc[a_] = *(const u32x4*)(P + eb_row * INW + 1024 + 512 * a_ + hc_); \
            if (eb_prev) pfp[a_] = *(const u32x4*)(P + (eb_row - 1) * INW + 1024 + 512 * a_ + hc_); else pfp[a_] = (u32x4){0u, 0u, 0u, 0u}; } } while (0)
#pragma unroll
    for (int it = 0; it < 4; ++it) { const int item = F.tid + 512 * it, tok = item >> 5, jc = item & 31, j0 = 8 * jc; const size_t row = row0 + tok;
        float cv[8], pv[8]; unpack8(*(const u32x4*)(P + row * INW + 2560 + j0), cv);
        if (t0 + tok > 0) unpack8(*(const u32x4*)(P + (row - 1) * INW + 2560 + j0), pv); else { for (int j = 0; j < 8; ++j) pv[j] = 0.f; }
        const f32x4 m0 = *(const f32x4*)(W.mu + 1536 + j0), m1 = *(const f32x4*)(W.mu + 1536 + j0 + 4); float o[8];
#pragma unroll
        for (int j = 0; j < 8; ++j) { const float x = cv[j] + (pv[j] - cv[j]) * (j < 4 ? m0[j] : m1[j - 4]); o[j] = jc < 8 ? fast_tanh(x) : (jc < 16 ? x : sigmoidf_(x)); }
        *(LAS u32x4*)(LI + tok * 264 + j0) = pack8(o); }
    __syncthreads();
    const int rp_ea = (PROBE_STAGE == 1) ? 2 - (F.G > 100000) : 1, rp_eb = (PROBE_STAGE == 2) ? 2 - (F.G > 100000) : 1, rp_p1 = (PROBE_STAGE == 3) ? 2 - (F.G > 100000) : 1, rp_ch = (PROBE_STAGE == 4) ? 2 - (F.G > 100000) : 1;
    for (int hi_ = 0; hi_ < NH; ++hi_) { const int h = (hi_ + (int)blockIdx.x) & (NH - 1);
        const size_t uh = ((size_t)unit * NH + h) * 4096;
        for (int rp = 0; rp < rp_ea; ++rp) { M1_LOAD_W(h);
          f32x4 aw[2] = {{0.f, 0.f, 0.f, 0.f}, {0.f, 0.f, 0.f, 0.f}}, aa[2] = {{0.f, 0.f, 0.f, 0.f}, {0.f, 0.f, 0.f, 0.f}}, ag[2] = {{0.f, 0.f, 0.f, 0.f}, {0.f, 0.f, 0.f, 0.f}};
#pragma unroll
          for (int ks = 0; ks < 2; ++ks)
#pragma unroll
              for (int q = 0; q < 2; ++q) { aw[q] = MFMA32(wfw[ks], lds_row8(LI, 264, 16 * (ea_ntb + q), 32 * ks, lane), aw[q]); aa[q] = MFMA32(wfa[ks], lds_row8(LI, 264, 16 * (ea_ntb + q), 64 + 32 * ks, lane), aa[q]); }
#pragma unroll
          for (int ks = 0; ks < 4; ++ks)
#pragma unroll
              for (int q = 0; q < 2; ++q) ag[q] = MFMA32(wfg[ks], lds_row8(LI, 264, 16 * (ea_ntb + q), 128 + 32 * ks, lane), ag[q]);
          const int ch0 = 16 * ea_mt + 4 * g; const f32x4 w0v = *(const LAS f32x4*)(CST + 6 * 512 + h * HD + ch0), a0v = *(const LAS f32x4*)(CST + 7 * 512 + h * HD + ch0);
#pragma unroll
          for (int q = 0; q < 2; ++q) { const int tok = 16 * (ea_ntb + q) + l15; f32x4 ev, av;
#pragma unroll
              for (int r = 0; r < 4; ++r) { ev[r] = -0.60653066f * __builtin_amdgcn_rcpf(1.f + __expf(-(aw[q][r] + w0v[r]))); av[r] = __builtin_amdgcn_rcpf(1.f + __expf(-(aa[q][r] + a0v[r]))); }
              *(LAS f32x4*)(Ef + tok * ES + ch0) = ev; *(LAS f32x4*)(ALf + tok * ES + ch0) = av;
              u32x2 gw; gw.x = cvtpk_c(ag[q][0], ag[q][1]); gw.y = cvtpk_c(ag[q][2], ag[q][3]); *(u32x2*)(Sc.Sg + (row0 + tok) * RWW + h * HD + ch0) = gw; } }
        __syncthreads();
        { const int ch = F.tid & 63, seg = F.tid >> 6; float run = 0.f;
#pragma unroll
          for (int i = 0; i < 8; ++i) { run += Ef[(8 * seg + i) * ES + ch]; Ef[(8 * seg + i) * ES + ch] = run; }
          SEG[seg * 64 + ch] = run; }
        __syncthreads();
        { const int ch = F.tid & 63, seg = F.tid >> 6; float off = 0.f;
          for (int s2 = 0; s2 < seg; ++s2) off += SEG[s2 * 64 + ch];
#pragma unroll
          for (int i = 0; i < 8; ++i) Ef[(8 * seg + i) * ES + ch] += off; }
        __syncthreads();
        for (int rp = 0; rp < rp_eb; ++rp) { const int tok = eb_tok, ch0 = 8 * eb_cg, hc0 = h * HD + ch0;
          float rr[8], kx[8], vv[8], pr[8];
#define M1_SHIFT(dst, a_) do { unpack8(pfc[a_], dst); unpack8(pfp[a_], pr); const f32x4 m0 = *(const LAS f32x4*)(CST + (a_) * 512 + hc0), m1 = *(const LAS f32x4*)(CST + (a_) * 512 + hc0 + 4); \
              _Pragma("unroll") for (int j = 0; j < 8; ++j) dst[j] = dst[j] + (pr[j] - dst[j]) * (j < 4 ? m0[j] : m1[j - 4]); } while (0)
          M1_LOAD_P(h); M1_SHIFT(rr, 0); M1_SHIFT(kx, 1); M1_SHIFT(vv, 2);
          float Lt[8], Lm[8], al[8], ckk[8], cka[8], crk[8];
#pragma unroll
          for (int j = 0; j < 8; ++j) { Lt[j] = Ef[tok * ES + ch0 + j]; Lm[j] = tok > 0 ? Ef[(tok - 1) * ES + ch0 + j] : 0.f; al[j] = ALf[tok * ES + ch0 + j]; ckk[j] = CST[3 * 512 + hc0 + j]; cka[j] = CST[4 * 512 + hc0 + j]; crk[j] = CST[5 * 512 + hc0 + j]; }
          float kk[8], km[8]; float ss = 0.f, bs_ = 0.f;
#pragma unroll
          for (int j = 0; j < 8; ++j) { kk[j] = kx[j] * ckk[j]; ss += kk[j] * kk[j]; km[j] = kx[j] * (1.f + (al[j] - 1.f) * cka[j]); bs_ += rr[j] * km[j] * crk[j]; }
          ss += __shfl_xor(ss, 1); ss += __shfl_xor(ss, 2); ss += __shfl_xor(ss, 4); bs_ += __shfl_xor(bs_, 1); bs_ += __shfl_xor(bs_, 2); bs_ += __shfl_xor(bs_, 4);
          const float inv = 1.f / fmaxf(sqrtf(ss), 1e-12f);
          if (eb_cg == 0) Sc.Sbsc[eb_row * NH + h] = bs_;
          float oA[8], oB[8], oK[8], oR[8];
#pragma unroll
          for (int j = 0; j < 8; ++j) { const float kn = kk[j] * inv, bb = kn * al[j]; const float eL = __expf(Lt[j]), einv = __builtin_amdgcn_rcpf(eL);
              oA[j] = -kn * __expf(Lm[j]); oB[j] = bb * einv; oK[j] = km[j] * einv; oR[j] = rr[j] * eL; if (tok == 63) GAM[ch0 + j] = eL; }
          *(LAS u32x4*)(At + tok * 72 + ch0) = pack8(oA); *(LAS u32x4*)(Bt + tok * 72 + ch0) = pack8(oB); *(LAS u32x4*)(Kt + tok * 72 + ch0) = pack8(oK); *(LAS u32x4*)(Rt + tok * 72 + ch0) = pack8(oR);
          *(LAS u32x4*)(Vt + tok * 72 + ch0) = pack8(vv); }
        __syncthreads();
        for (int rp = 0; rp < rp_p1; ++rp) for (int i5 = 0; i5 < 5; ++i5) { const int q = w + 8 * i5, mat = q / 10, idx = q % 10; const int ti = idx < 1 ? 0 : (idx < 3 ? 1 : (idx < 6 ? 2 : 3)), si = idx - ti * (ti + 1) / 2;
            const LAS bf16* X = mat < 2 ? At : Rt; const LAS bf16* Yk = (mat & 1) ? Kt : Bt; LAS bf16* O = Lab + mat * 64 * 72;
            f32x4 acc = {0.f, 0.f, 0.f, 0.f};
#pragma unroll
            for (int ks = 0; ks < 2; ++ks) acc = MFMA32(lds_row8(Yk, 72, 16 * si, 32 * ks, lane), lds_row8(X, 72, 16 * ti, 32 * ks, lane), acc);
            const int t = 16 * ti + l15, s0 = 16 * si + 4 * g; const int lim = mat < 2 ? t : t + 1;
#pragma unroll
            for (int r = 0; r < 4; ++r) acc[r] = (s0 + r < lim) ? acc[r] : 0.f;
            *(LAS s16x4*)(O + t * 72 + s0) = pack4(acc); }
        __syncthreads();
        for (int rp = 0; rp < rp_ch; ++rp) { const bool isU = w < 4; const int cw = w & 3; const f32x4 zero = {0.f, 0.f, 0.f, 0.f};
          s16x4 TTp[4];
#pragma unroll
          for (int hb = 0; hb < 2; ++hb) { s16x4 fr[2], ft[2];
#pragma unroll
            for (int i = 0; i < 2; ++i) { fr[i] = lds_row4(Lab, 72, 16 * (2 * hb + i), 16 * (2 * hb + i), lane); ft[i] = lds_tr4(Lab, 72, 16 * (2 * hb + i), 16 * (2 * hb + i), lane); }
            f32x4 L2[2], L2T[2], L4[2], L4T[2], L8[2], TT[2]; s16x4 pL2[2], pL2T[2], pL4[2], pL4T[2];
#pragma unroll
            for (int i = 0; i < 2; ++i) { L2[i] = MFMA16(fr[i], ft[i], zero); L2T[i] = MFMA16(ft[i], fr[i], zero); }
#pragma unroll
            for (int i = 0; i < 2; ++i) { pL2[i] = pack4(L2[i]); pL2T[i] = pack4(L2T[i]); TT[i] = unpack4(fr[i]);
#pragma unroll
                for (int r = 0; r < 4; ++r) TT[i][r] += (l15 == 4 * g + r) ? 1.f : 0.f; }
#pragma unroll
            for (int i = 0; i < 2; ++i) { L4[i] = MFMA16(pL2T[i], pL2[i], zero); L4T[i] = MFMA16(pL2[i], pL2T[i], zero); TT[i] = MFMA16(pL2[i], pack4(TT[i]), TT[i]); }
#pragma unroll
            for (int i = 0; i < 2; ++i) { pL4[i] = pack4(L4[i]); pL4T[i] = pack4(L4T[i]); }
#pragma unroll
            for (int i = 0; i < 2; ++i) { L8[i] = MFMA16(pL4T[i], pL4[i], zero); TT[i] = MFMA16(pL4[i], pack4(TT[i]), TT[i]); }
#pragma unroll
            for (int i = 0; i < 2; ++i) { TT[i] = MFMA16(pack4(L8[i]), pack4(TT[i]), TT[i]); TTp[2 * hb + i] = pack4(TT[i]); } }
          s16x4 Vf[4]; f32x4 z[4];
          if (isU) { s16x4 lk[10];
#pragma unroll
              for (int j = 0; j < 4; ++j) Vf[j] = lds_tr4(Vt, 72, 16 * j, 16 * cw, lane);
#pragma unroll
              for (int i = 0; i < 4; ++i)
#pragma unroll
                  for (int j = 0; j <= i; ++j) lk[i * (i + 1) / 2 + j] = lds_row4(Lak, 72, 16 * i, 16 * j, lane);
#pragma unroll
              for (int i = 0; i < 4; ++i) { z[i] = zero;
#pragma unroll
                  for (int j = 0; j <= i; ++j) z[i] = MFMA16(lk[i * (i + 1) / 2 + j], Vf[j], z[i]); }
          } else {
#pragma unroll
              for (int i = 0; i < 4; ++i) { Vf[i] = (s16x4){0, 0, 0, 0}; z[i] = unpack4(lds_tr4(At, 72, 16 * i, 16 * cw, lane)); } }
          s16x4 Xp[4];
          { s16x4 lb[6];
#pragma unroll
            for (int i = 1; i < 4; ++i)
#pragma unroll
                for (int j = 0; j < i; ++j) lb[i * (i - 1) / 2 + j] = lds_row4(Lab, 72, 16 * i, 16 * j, lane);
#pragma unroll
            for (int i = 0; i < 4; ++i) { f32x4 zz = z[i];
#pragma unroll
                for (int j = 0; j < i; ++j) zz = MFMA16(lb[i * (i - 1) / 2 + j], Xp[j], zz);
                Xp[i] = pack4(MFMA16(TTp[i], pack4(zz), zero)); } }
          if (isU) {
#pragma unroll
              for (int nt = 0; nt < 4; ++nt) { s16x4 bf_[4], kf_[4];
#pragma unroll
                  for (int i = 0; i < 4; ++i) { bf_[i] = lds_tr4(Bt, 72, 16 * i, 16 * nt, lane); kf_[i] = lds_tr4(Kt, 72, 16 * i, 16 * nt, lane); }
                  f32x4 a1 = zero, a2 = zero;
#pragma unroll
                  for (int i = 0; i < 4; ++i) { a1 = MFMA16(Xp[i], bf_[i], a1); a2 = MFMA16(Vf[i], kf_[i], a2); }
                  const float gm = GAM[16 * nt + l15]; const f32x4 acc = (a1 + a2) * gm;
                  *(s16x4*)(Sc.SH + uh + (size_t)(16 * nt + l15) * 64 + 16 * cw + 4 * g) = pack4(acc); }
#pragma unroll
              for (int mt = 0; mt < 4; ++mt) { s16x4 mb[4], mk[4];
#pragma unroll
                  for (int i = 0; i <= mt; ++i) { mb[i] = lds_row4(Mrb, 72, 16 * mt, 16 * i, lane); mk[i] = lds_row4(Mrk, 72, 16 * mt, 16 * i, lane); }
                  f32x4 a1 = zero, a2 = zero;
#pragma unroll
                  for (int i = 0; i <= mt; ++i) { a1 = MFMA16(mb[i], Xp[i], a1); a2 = MFMA16(mk[i], Vf[i], a2); }
                  *(s16x4*)(Sc.SY0 + uh + (size_t)(16 * cw + l15) * 64 + 16 * mt + 4 * g) = pack4(a1 + a2); }
          } else {
#pragma unroll
              for (int nt = 0; nt < 4; ++nt) { s16x4 bf_[4];
#pragma unroll
                  for (int i = 0; i < 4; ++i) bf_[i] = lds_tr4(Bt, 72, 16 * i, 16 * nt, lane);
                  f32x4 a1 = zero, a2 = zero;
                  a1 = MFMA16(Xp[0], bf_[0], a1); a2 = MFMA16(Xp[1], bf_[1], a2); a1 = MFMA16(Xp[2], bf_[2], a1); a2 = MFMA16(Xp[3], bf_[3], a2);
                  f32x4 acc = a1 + a2; const float gm = GAM[16 * nt + l15]; const float dg = (nt == cw) ? 1.f : 0.f;
#pragma unroll
                  for (int r = 0; r < 4; ++r) acc[r] = (acc[r] + ((l15 == 4 * g + r) ? dg : 0.f)) * gm;
                  *(s16x4*)(Sc.SG + uh + (size_t)(16 * nt + l15) * 64 + 16 * cw + 4 * g) = pack4(acc); }
#pragma unroll
              for (int mt = 0; mt < 4; ++mt) { s16x4 mb[4]; const s16x4 rf = lds_tr4(Rt, 72, 16 * mt, 16 * cw, lane);
#pragma unroll
                  for (int i = 0; i <= mt; ++i) mb[i] = lds_row4(Mrb, 72, 16 * mt, 16 * i, lane);
                  f32x4 acc = unpack4(rf);
#pragma unroll
                  for (int i = 0; i <= mt; ++i) acc = MFMA16(mb[i], Xp[i], acc);
                  *(s16x4*)(Sc.SQ + uh + (size_t)(16 * cw + l15) * 64 + 16 * mt + 4 * g) = pack4(acc); }
          } }
        __syncthreads();
    }
#undef M1_LOAD_W
#undef M1_LOAD_P
#undef M1_SHIFT
}

constexpr int M2_S = 0;
__device__ __forceinline__ void rwkv_m2_unit(Frame& F, int unit  , const RwkvS& Sc) {
    const int b = unit >> 3, h = unit & 7; const int w = F.wave, lane = F.lane, l15 = lane & 15, g = lane >> 4; const int mt = w >> 1, ntb = 2 * (w & 1);
    LAS bf16* Sb = (LAS bf16*)(F.lds + M2_S);
    f32x4 acc[2] = {{0.f, 0.f, 0.f, 0.f}, {0.f, 0.f, 0.f, 0.f}};
    constexpr int PF = 8;
    bf16x8 Gf[PF][2][2]; u32x2 Hf[PF][2];
#define M2_LOAD(slot, cc) do { const size_t uh_ = ((size_t)(b * 64 + (cc)) * NH + h) * 4096; _Pragma("unroll") for (int q = 0; q < 2; ++q) { const size_t ro = uh_ + (size_t)(16 * (ntb + q) + l15) * 64; \
        Gf[slot][q][0] = *(const bf16x8*)(Sc.SG + ro + 8 * g); Gf[slot][q][1] = *(const bf16x8*)(Sc.SG + ro + 32 + 8 * g); Hf[slot][q] = *(const u32x2*)(Sc.SH + ro + 16 * mt + 4 * g); } } while (0)
#pragma unroll
    for (int u = 0; u < PF; ++u) M2_LOAD(u, u);
    for (int c0 = 0; c0 < 64; c0 += PF) {
#pragma unroll
        for (int u = 0; u < PF; ++u) { const int c = c0 + u;
            const size_t uh = ((size_t)(b * 64 + c) * NH + h) * 4096; LAS bf16* buf = Sb + (u & 1) * 64 * 72;
#pragma unroll
            for (int q = 0; q < 2; ++q) { const s16x4 p = pack4(acc[q]); *(LAS s16x4*)(buf + (16 * (ntb + q) + l15) * 72 + 16 * mt + 4 * g) = p; *(s16x4*)(Sc.SS + uh + (size_t)(16 * (ntb + q) + l15) * 64 + 16 * mt + 4 * g) = p; }
            __syncthreads();
            const bf16x8 a0 = lds_tr8(buf, 72, 0, 16 * mt, lane), a1 = lds_tr8(buf, 72, 32, 16 * mt, lane);
#pragma unroll
            for (int q = 0; q < 2; ++q) { f32x4 z; z[0] = __builtin_bit_cast(float, Hf[u][q].x << 16); z[1] = __builtin_bit_cast(float, Hf[u][q].x & 0xffff0000u); z[2] = __builtin_bit_cast(float, Hf[u][q].y << 16); z[3] = __builtin_bit_cast(float, Hf[u][q].y & 0xffff0000u);
                z = MFMA32(a0, Gf[u][q][0], z); acc[q] = MFMA32(a1, Gf[u][q][1], z); }
            if (c + PF < 64) M2_LOAD(u, c + PF); }
    }
#undef M2_LOAD
    __syncthreads();
}

constexpr int M3_SLOT = 9216 * 2 + 64 * 68 * 4;
__device__ __forceinline__ void rwkv_m3_unit(Frame& F, int unit  , const bf16* P, bf16* Y, const RwkvW& W, const RwkvS& Sc) {
    const int b = unit >> 6, c = unit & 63, t0 = c * 64; const size_t row0 = (size_t)b * SEQ + t0;
    const int w = F.wave, lane = F.lane, l15 = lane & 15, g = lane >> 4, hw = w >> 2, mt = w & 3, tl = F.tid & 255;
    LAS bf16* Qt = (LAS bf16*)(F.lds + hw * M3_SLOT); LAS bf16* St = Qt + 64 * 72; LAS float* Out = (LAS float*)(F.lds + hw * M3_SLOT + 2 * 9216);
    for (int hp = 0; hp < 4; ++hp) { const int h = 2 * hp + hw; const size_t uh = ((size_t)unit * NH + h) * 4096;
#pragma unroll
        for (int r = 0; r < 2; ++r) { const int off = 8 * (tl + 256 * r), rr = off >> 6, cc = off & 63;
            *(LAS u32x4*)(Qt + rr * 72 + cc) = *(const u32x4*)(Sc.SQ + uh + off); *(LAS u32x4*)(St + rr * 72 + cc) = *(const u32x4*)(Sc.SS + uh + off); }
        __syncthreads();
        f32x4 acc[4];
#pragma unroll
        for (int nt = 0; nt < 4; ++nt) acc[nt] = unpack4(*(const s16x4*)(Sc.SY0 + uh + (size_t)(16 * nt + l15) * 64 + 16 * mt + 4 * g));
#pragma unroll
        for (int ks = 0; ks < 2; ++ks) { const bf16x8 a = lds_tr8(Qt, 72, 32 * ks, 16 * mt, lane);
#pragma unroll
            for (int nt = 0; nt < 4; ++nt) acc[nt] = MFMA32(a, lds_tr8(St, 72, 32 * ks, 16 * nt, lane), acc[nt]); }
#pragma unroll
        for (int r = 0; r < 4; ++r) { float s = (acc[0][r] + acc[1][r]) + (acc[2][r] + acc[3][r]);
            s += __shfl_xor(s, 1); s += __shfl_xor(s, 2); s += __shfl_xor(s, 4); s += __shfl_xor(s, 8); const float mean = s * (1.f / HD); float q = 0.f;
#pragma unroll
            for (int nt = 0; nt < 4; ++nt) { const float d = acc[nt][r] - mean; q += d * d; }
            q += __shfl_xor(q, 1); q += __shfl_xor(q, 2); q += __shfl_xor(q, 4); q += __shfl_xor(q, 8); const float rstd = __builtin_amdgcn_rsqf(q * (1.f / HD) + GN_EPS);
#pragma unroll
            for (int nt = 0; nt < 4; ++nt) { const int v = 16 * nt + l15; Out[(16 * mt + 4 * g + r) * 68 + v] = (acc[nt][r] - mean) * rstd * W.lnx_w[h * HD + v] + W.lnx_b[h * HD + v]; } }
        __syncthreads();
        { const int t = tl >> 2, cq = tl & 3, v0 = 16 * cq, hv0 = h * HD + v0; const size_t row = row0 + t; const bool has_prev = (t0 + t) > 0; const float bsc = Sc.Sbsc[row * NH + h];
#pragma unroll
          for (int half = 0; half < 2; ++half) { float cv[8], pv[8], gv[8], o[8]; const int col = 2048 + hv0 + 8 * half;
              unpack8(*(const u32x4*)(P + row * INW + col), cv); if (has_prev) unpack8(*(const u32x4*)(P + (row - 1) * INW + col), pv); else { for (int j = 0; j < 8; ++j) pv[j] = 0.f; }
              unpack8(*(const u32x4*)(Sc.Sg + row * RWW + hv0 + 8 * half), gv);
              const f32x4 m0 = *(const f32x4*)(W.mu + col - 1024), m1 = *(const f32x4*)(W.mu + col - 1024 + 4);
#pragma unroll
              for (int j = 0; j < 8; ++j) { const float vs = cv[j] + (pv[j] - cv[j]) * (j < 4 ? m0[j] : m1[j - 4]); o[j] = (Out[t * 68 + v0 + 8 * half + j] + bsc * vs) * gv[j]; }
              *(u32x4*)(Y + row * D + GMW + hv0 + 8 * half) = pack8(o); } }
        __syncthreads();
    }
}


__device__ __forceinline__ void rwkv_apply_naive(Frame& F, int unit, const bf16* P, bf16* Y, const RwkvW& W, const RwkvS& Sc) {
    const int b = unit >> 3, h = unit & 7;
    LAS float* S = (LAS float*)F.lds; LAS float* Gs = S + 64 * 65; LAS float* Hs = Gs + 64 * 65; LAS float* Qs = Hs + 64 * 65; LAS float* Ys = Qs + 64 * 65; LAS float* Sn = Ys + 64 * 65;
    for (int i = F.tid; i < 64 * 65; i += 512) S[i] = 0.f;
    __syncthreads();
    for (int c = 0; c < 64; ++c) { const size_t uh = ((size_t)(b * 64 + c) * NH + h) * 4096; const size_t row0 = (size_t)b * SEQ + c * 64;
        for (int i = F.tid; i < 4096; i += 512) { const int r = i >> 6, cc = i & 63;
            Gs[cc * 65 + r] = bf2f(Sc.SG[uh + i]);
            Hs[cc * 65 + r] = bf2f(Sc.SH[uh + i]);
            Qs[cc * 65 + r] = bf2f(Sc.SQ[uh + i]);
            Ys[cc * 65 + r] = bf2f(Sc.SY0[uh + i]); }
        __syncthreads();
        for (int i = F.tid; i < 4096; i += 512) { const int t = i >> 6, v = i & 63; float a = Ys[t * 65 + v];
            if (DBG_VAR != 1) for (int k = 0; k < 64; ++k) a += Qs[t * 65 + k] * S[v * 65 + k];
            if (DBG_VAR == 2) a = 0.f;
            Ys[t * 65 + v] = a; }
        for (int i = F.tid; i < 4096; i += 512) { const int v = i >> 6, k2 = i & 63; float a = Hs[v * 65 + k2];
            if (DBG_VAR == 6) a += S[v * 65 + k2] * Gs[k2 * 65 + k2]; else if (DBG_VAR != 3) for (int k = 0; k < 64; ++k) a += S[v * 65 + k] * Gs[k * 65 + k2];
            if (DBG_VAR == 7) a = Hs[v * 65 + k2] + 0.5f * (a - Hs[v * 65 + k2]);
            Sn[v * 65 + k2] = a; }
        __syncthreads();
        for (int i = F.tid; i < 4096; i += 512) { const int v = i >> 6, k2 = i & 63; S[v * 65 + k2] = Sn[v * 65 + k2]; }
        { const int t = F.tid >> 3, cg = F.tid & 7, v0 = 8 * cg, hv0 = h * HD + v0; const size_t row = row0 + t; const bool has_prev = (c * 64 + t) > 0; const float bsc = Sc.Sbsc[row * NH + h];
          float yv[8]; float sm = 0.f;
          for (int j = 0; j < 8; ++j) { yv[j] = Ys[t * 65 + v0 + j]; sm += yv[j]; }
          sm += __shfl_xor(sm, 1); sm += __shfl_xor(sm, 2); sm += __shfl_xor(sm, 4); const float mean = sm * (1.f / HD); float q = 0.f;
          for (int j = 0; j < 8; ++j) { yv[j] -= mean; q += yv[j] * yv[j]; }
          q += __shfl_xor(q, 1); q += __shfl_xor(q, 2); q += __shfl_xor(q, 4); const float rstd = __builtin_amdgcn_rsqf(q * (1.f / HD) + GN_EPS);
          float cv[8], pv[8], gv[8], o[8]; const int col = 2048 + hv0;
          unpack8(*(const u32x4*)(P + row * INW + col), cv); if (has_prev) unpack8(*(const u32x4*)(P + (row - 1) * INW + col), pv); else { for (int j = 0; j < 8; ++j) pv[j] = 0.f; }
          unpack8(*(const u32x4*)(Sc.Sg + row * RWW + hv0), gv);
          for (int j = 0; j < 8; ++j) { const float vs = cv[j] + (pv[j] - cv[j]) * W.mu[col - 1024 + j]; o[j] = (yv[j] * rstd * W.lnx_w[hv0 + j] + W.lnx_b[hv0 + j] + bsc * vs) * gv[j]; }
          *(u32x4*)(Y + row * D + GMW + hv0) = pack8(o); }
        __syncthreads();
    }
}

enum Phase { PH_PRO = 0, PH_G1_0, PH_M1_0, PH_M2_0, PH_M3_0, PH_G2_0, PH_G3_0, PH_G4_0, PH_G1_1, PH_M1_1, PH_M2_1, PH_M3_1, PH_G2_1, PH_CV, PH_R2, PH_GU_A, PH_DN_A, PH_GU_B, PH_DN_B, PH_FIN, PH_COUNT };

__global__ void __launch_bounds__(512, 2) fwd(Args args) {
    extern __shared__ __attribute__((aligned(16))) unsigned char lds_raw[];
    Frame F;
    F.lds = (LAS unsigned char*)lds_raw;
    F.tid = threadIdx.x; F.lane = F.tid & 63; F.wave = __builtin_amdgcn_readfirstlane(F.tid >> 6);
    F.G = gridDim.x; F.gw = blockIdx.x * 8 + F.wave; F.NGW = F.G * 8;
    unsigned char* ws = args.ws;
    gu32* ctl = (gu32*)(ws + WS_CTL);
    volatile LAS unsigned* MISC = (volatile LAS unsigned*)(F.lds + MISC_OFF);
    if (F.tid < 32) ((LAS unsigned*)(F.lds + MISC_OFF))[F.tid] = 0u;
    __syncthreads();
    XcdBarrier bar; bar.bar = (unsigned*)(ctl + CW_BAR); bar.x = 0; bar.st = nullptr;
#if !MK_PER_PHASE
    bar = xcd_barrier_post((unsigned*)(ctl + CW_BAR), MISC + 8);
#endif
    const int lo = args.ph_lo, hi = args.ph_hi;
#define IN(k) (lo <= (k) && (k) < hi)
#define SEAM(k) do { if (IN(k) && IN((k) + 1)) xcd_barrier(bar); } while (0)

    const float* x_in = args.in[I_X]; float* xres = args.out;
    bf16* WinT = (bf16*)(ws + WS_WIN); bf16* WoutT = (bf16*)(ws + WS_WOUT); bf16* WguT = (bf16*)(ws + WS_WGU); bf16* WdT = (bf16*)(ws + WS_WD);
    bf16* XB = (bf16*)(ws + WS_XB); bf16* PB = (bf16*)(ws + WS_P); bf16* YB = (bf16*)(ws + WS_Y); bf16* HB = (bf16*)(ws + WS_P);
    bf16* MWgu = (bf16*)(ws + WS_MOEW_GU); bf16* MWd = (bf16*)(ws + (MOE8_GU ? WS_MOEW8_D : WS_MOEW_D)); bf16* MH = (bf16*)(ws + WS_MOEH);
    unsigned char* MWgu8 = ws + WS_MOEW8_GU; unsigned char* MWd8 = ws + WS_MOEW8_D; unsigned char* MH8 = ws + WS_MOEH; unsigned char* MH8b = ws + WS_MOEH + 119 * MiB; unsigned char* XB8 = ws + WS_XB8;
    float* ssq0 = (float*)(ctl + CW_SSQ); float* ssq1 = (float*)(ws + WS_SSQP); float* ssq2 = ssq1 + (size_t)NTOK * 16;
    bf16* WupT = (bf16*)(ws + WS_SMALLW + SW_WUP); bf16* AupT = (bf16*)(ws + WS_SMALLW + SW_AUP); bf16* GupT = (bf16*)(ws + WS_SMALLW + SW_GUP); bf16* WsB = (bf16*)(ws + WS_SMALLW + SW_WS);
    RwkvS RS{(bf16*)(ws + WS_SCR), (bf16*)(ws + WS_SCR + 32 * MiB), (bf16*)(ws + WS_SCR + 64 * MiB), (bf16*)(ws + WS_SCR + 96 * MiB), (bf16*)(ws + WS_SCR + 128 * MiB), (bf16*)(ws + WS_XB), (float*)(ws + WS_XB + 32 * MiB)};
    unsigned char* misc = ws + WS_MISC;
    int* tok_e = (int*)(misc + MS_TOKE); float* tok_g = (float*)(misc + MS_TOKG); float* rs_moe = (float*)(misc + MS_RS); int* bcnt = (int*)(misc + MS_BCNT);
    int* row_tok = (int*)(misc + MS_ROWTOK); float* row_gate = (float*)(misc + MS_ROWGATE); int* panel = (int*)(misc + MS_PANEL);

    if (IN(PH_PRO)) {
        int itb = 0;
        for (int l = 0; l < 2; ++l) {
            convert_matrix(F, args.in[I_W_IN] + (size_t)l * D * INW, D, INW, WinT + (size_t)l * INW * D, 0, args.in[I_NORM_MIX] + l * D, 0, itb);
            convert_matrix(F, args.in[I_W_OUT] + (size_t)l * D * D, D, D, WoutT + (size_t)l * D * D, 0, nullptr, 0, itb);
        }
        convert_matrix(F, args.in[I_FFN_WG], D, FF, WguT, 1, args.in[I_NORM_FFN], 0, itb);
        convert_matrix(F, args.in[I_FFN_WU], D, FF, WguT, 2, args.in[I_NORM_FFN], 0, itb);
        convert_matrix(F, args.in[I_FFN_WD], FF, D, WdT, 0, nullptr, 0, itb);
        { const size_t gt = (size_t)blockIdx.x * 512 + F.tid, gn = (size_t)F.G * 512;
          for (size_t i = gt; i < (size_t)2 * RWW * 64; i += gn) { const int l = (int)(i / (RWW * 64)), r = (int)(i % (RWW * 64)), ch = r / 64, j = r % 64;
              WupT[i] = (bf16)f2bf(args.in[I_RW_W_UP][(size_t)l * 64 * RWW + (size_t)j * RWW + ch]); AupT[i] = (bf16)f2bf(args.in[I_RW_A_UP][(size_t)l * 64 * RWW + (size_t)j * RWW + ch]); }
          for (size_t i = gt; i < (size_t)2 * RWW * 128; i += gn) { const int l = (int)(i / (RWW * 128)), r = (int)(i % (RWW * 128)), ch = r / 128, j = r % 128;
              GupT[i] = (bf16)f2bf(args.in[I_RW_G_UP][(size_t)l * 128 * RWW + (size_t)j * RWW + ch]); }
          for (size_t i = gt; i < (size_t)2 * NH * GCH * GCH; i += gn) { const int t = (int)((i / GCH) % GCH), s2 = (int)(i % GCH); WsB[i] = (bf16)(s2 <= t ? f2bf(args.in[I_GM_WS][i]) : 0u); } }
        for (int m = F.gw; m < NTOK; m += F.NGW) {
            const GAS f32x4* xr = (const GAS f32x4*)(x_in + (size_t)m * D) + F.lane; GAS u32x2* o8 = (GAS u32x2*)(XB + (size_t)m * D) + F.lane; float s = 0.f;
#pragma unroll
            for (int j = 0; j < 4; ++j) { const f32x4 v = xr[64 * j]; s += (v.x * v.x + v.y * v.y) + (v.z * v.z + v.w * v.w); u32x2 w; w.x = pk2(v.x, v.y); w.y = pk2(v.z, v.w); o8[64 * j] = w; }
            s = wave_sum(s); if (F.lane == 0) ssq0[m] = s;
        }
    }
    SEAM(PH_PRO);

#define LAYER_MIXER(L, PH1, PHA, PHB, PHC, PH2, XBASE, SSQ_IN, NP_IN, SSQ_OUT, HAS_OUT) \
    if (IN(PH1)) { pg8::DenseSched S; S.init(XB, WinT + (size_t)(L) * INW * D, NTOK, INW, 2 * D, F.G, (int)blockIdx.x); \
        pg8::EpiScaleBf16<NP_IN> E{PB, INW, SSQ_IN}; pg8::gemm_phase(F.lds, 2 * D, S, E); } \
    SEAM(PH1); \
    { RwkvW RW{args.in[I_SHIFT_MU] + (L) * 1792, args.in[I_RW_W0] + (L) * RWW, args.in[I_RW_A0] + (L) * RWW, args.in[I_RW_K_K] + (L) * RWW, args.in[I_RW_K_A] + (L) * RWW, args.in[I_RW_R_K] + (L) * RWW, \
                 args.in[I_RW_LNX_W] + (L) * RWW, args.in[I_RW_LNX_B] + (L) * RWW, WupT + (size_t)(L) * RWW * 64, AupT + (size_t)(L) * RWW * 64, GupT + (size_t)(L) * RWW * 128}; \
      if (IN(PHA)) { if (MIX_MODE != 1) for (int rep = 0; rep < REP_M1; ++rep) { rwkv_m1_consts(F, RW); for (int u = blockIdx.x; u < NB * 64; u += F.G) rwkv_m1v2_unit(F, u, PB, RW, RS); } } \
      SEAM(PHA); \
      if (IN(PHB)) for (int rep = 0; rep < REP_M2; ++rep) { const int nscan = (F.G >= 128 && MIX_MODE != 1) ? 64 : 0; \
          if (MIX_MODE != 1 && MIX_MODE != 3) { if (nscan) { if ((int)blockIdx.x < 64) rwkv_m2_unit(F, blockIdx.x, RS); } else { for (int u = blockIdx.x; u < 64; u += F.G) rwkv_m2_unit(F, u, RS); } } \
          if (MIX_MODE == 2) gmlp_naive(F, PB, YB, args.in[I_GM_LN_W] + (L) * GMW, args.in[I_GM_LN_B] + (L) * GMW, args.in[I_GM_WS] + (size_t)(L) * NH * GCH * GCH, args.in[I_GM_BS] + (L) * NH * GCH); \
          else if ((int)blockIdx.x >= nscan) for (int u = blockIdx.x - nscan; u < NB * (SEQ / GCH) * NH; u += F.G - nscan) \
              gmlp_unit(F, u, PB, YB, args.in[I_GM_LN_W] + (L) * GMW, args.in[I_GM_LN_B] + (L) * GMW, WsB + (size_t)(L) * NH * GCH * GCH, args.in[I_GM_BS] + (L) * NH * GCH); } \
      SEAM(PHB); \
      if (IN(PHC)) { if (MIX_MODE == 3) { for (int u = blockIdx.x; u < 64; u += F.G) rwkv_apply_naive(F, u, PB, YB, RW, RS); } \
          else if (MIX_MODE != 1) { for (int rep = 0; rep < REP_M3; ++rep) for (int u = blockIdx.x; u < NB * 64; u += F.G) rwkv_m3_unit(F, u, PB, YB, RW, RS); } \
          else rwkv_naive(F, PB, YB, args.in[I_SHIFT_MU] + (L) * 1792, args.in[I_RW_W_UP] + (L) * 64 * RWW, args.in[I_RW_W0] + (L) * RWW, args.in[I_RW_A_UP] + (L) * 64 * RWW, args.in[I_RW_A0] + (L) * RWW, \
                   args.in[I_RW_G_UP] + (L) * 128 * RWW, args.in[I_RW_K_K] + (L) * RWW, args.in[I_RW_K_A] + (L) * RWW, args.in[I_RW_R_K] + (L) * RWW, args.in[I_RW_LNX_W] + (L) * RWW, args.in[I_RW_LNX_B] + (L) * RWW); } \
      SEAM(PHC); } \
    if (IN(PH2)) { pg8::DenseSched S; S.init(YB, WoutT + (size_t)(L) * D * D, NTOK, D, 2 * D, F.G, (int)blockIdx.x); \
        pg8::EpiResid<HAS_OUT> E{XBASE, xres, XB, SSQ_OUT}; pg8::gemm_phase(F.lds, 2 * D, S, E); } \
    SEAM(PH2);

    LAYER_MIXER(0, PH_G1_0, PH_M1_0, PH_M2_0, PH_M3_0, PH_G2_0, x_in, ssq0, 1, ssq1, true)

    if (IN(PH_G3_0)) { pg8::DenseSched S; S.init(XB, WguT, NTOK, 2 * FF, 2 * D, F.G, (int)blockIdx.x);
        pg8::EpiSwiglu<16> E{HB, FF, ssq1}; pg8::gemm_phase(F.lds, 2 * D, S, E); }
#if REP_G3 == 2
    if (IN(PH_G3_0)) { pg8::DenseSched S; S.init(XB, WguT, NTOK, 2 * FF, 2 * D, F.G, (int)blockIdx.x);
        pg8::EpiSwiglu<16> E{HB, FF, ssq1}; pg8::gemm_phase(F.lds, 2 * D, S, E); }
#endif
    SEAM(PH_G3_0);
    if (IN(PH_G4_0)) { pg8::DenseSched S; S.init(HB, WdT, NTOK, D, 2 * FF, F.G, (int)blockIdx.x);
        pg8::EpiResid<true> E{xres, xres, XB, ssq2}; pg8::gemm_phase(F.lds, 2 * FF, S, E); }
    SEAM(PH_G4_0);

    LAYER_MIXER(1, PH_G1_1, PH_M1_1, PH_M2_1, PH_M3_1, PH_G2_1, xres, ssq2, 16, nullptr, false)

    if (IN(PH_CV)) for (int rep = 0; rep < REP_CV; ++rep) {
        int itb = 0; const float* gain = args.in[I_NORM_FFN] + D;
        for (int e = 0; e < NE; ++e) {
            if (MOE8_GU) { convert_matrix_fp8(F, args.in[I_MOE_WG] + (size_t)e * D * FFE, D, FFE, MWgu8 + (size_t)e * 2 * FFE * D, 1, gain, MOE8_WSCALE_GU, itb);
                           convert_matrix_fp8(F, args.in[I_MOE_WU] + (size_t)e * D * FFE, D, FFE, MWgu8 + (size_t)e * 2 * FFE * D, 2, gain, MOE8_WSCALE_GU, itb); }
            else { convert_matrix(F, args.in[I_MOE_WG] + (size_t)e * D * FFE, D, FFE, MWgu + (size_t)e * 2 * FFE * D, 1, gain, 0, itb);
                   convert_matrix(F, args.in[I_MOE_WU] + (size_t)e * D * FFE, D, FFE, MWgu + (size_t)e * 2 * FFE * D, 2, gain, 0, itb); }
            if (MOE8_DN) convert_matrix_fp8(F, args.in[I_MOE_WD] + (size_t)e * FFE * D, FFE, D, MWd8 + (size_t)e * D * FFE, 0, nullptr, MOE8_WSCALE_DN, itb);
            else convert_matrix(F, args.in[I_MOE_WD] + (size_t)e * FFE * D, FFE, D, MWd + (size_t)e * D * FFE, 0, nullptr, 0, itb);
        }
        __syncthreads();
        LAS float* RW = (LAS float*)F.lds; LAS int* cnt = (LAS int*)(F.lds + 32768);
        for (int i = F.tid; i < D * NE; i += 512) { const int k = i >> 3, e = i & 7, j = k >> 8, ln = (k & 255) >> 2, q = k & 3; RW[(((j * 4 + q) * 64 + ln) << 3) + e] = args.in[I_MOE_ROUTER][i] * gain[k]; }
        for (size_t i = (size_t)blockIdx.x * 512 + F.tid; i < (size_t)2 * MAXPAN * 256; i += (size_t)F.G * 512) { row_tok[i] = -1; row_gate[i] = 0.f; }
        __syncthreads();
        for (int vb = blockIdx.x; vb < 256; vb += F.G) {
            if (F.tid < 16) cnt[F.tid] = 0;
            __syncthreads();
            f32x4 xv4[4];
            { const GAS f32x4* xr0 = (const GAS f32x4*)(xres + (size_t)(vb * 128 + F.wave * 16) * D) + F.lane;
#pragma unroll
              for (int j = 0; j < 4; ++j) xv4[j] = xr0[64 * j]; }
            for (int i = 0; i < 16; ++i) { const int m = vb * 128 + F.wave * 16 + i;
                float s = 0.f; float lg[8]; f32x4 cur4[4];
#pragma unroll
                for (int j = 0; j < 4; ++j) cur4[j] = xv4[j];
                if (i + 1 < 16) { const GAS f32x4* xr1 = (const GAS f32x4*)(xres + (size_t)(m + 1) * D) + F.lane;
#pragma unroll
                    for (int j = 0; j < 4; ++j) xv4[j] = xr1[64 * j]; }
#pragma unroll
                for (int e = 0; e < 8; ++e) lg[e] = 0.f;
#pragma unroll
                for (int j = 0; j < 4; ++j) { const f32x4 v = cur4[j]; s += (v.x * v.x + v.y * v.y) + (v.z * v.z + v.w * v.w);
                    if (MOE8_GU) *(unsigned*)(XB8 + (size_t)m * D + 256 * j + 4 * F.lane) = pk4_fp8(v.x, v.y, v.z, v.w);
#pragma unroll
                    for (int q = 0; q < 4; ++q) { const float xv = v[q]; const LAS f32x4* rw = (const LAS f32x4*)(RW + (((j * 4 + q) * 64 + F.lane) << 3)); const f32x4 r0 = rw[0], r1 = rw[1];
                        lg[0] += xv * r0.x; lg[1] += xv * r0.y; lg[2] += xv * r0.z; lg[3] += xv * r0.w; lg[4] += xv * r1.x; lg[5] += xv * r1.y; lg[6] += xv * r1.z; lg[7] += xv * r1.w; } }
                s = wave_sum(s);
#pragma unroll
                for (int e = 0; e < 8; ++e) lg[e] = wave_sum(lg[e]);
                const float rs = 1.0f / sqrtf(s * (1.0f / D) + RMS_EPS);
                if (F.lane == 0) {
                    int i1 = 0; float v1 = lg[0];
#pragma unroll
                    for (int e = 1; e < 8; ++e) if (lg[e] > v1) { v1 = lg[e]; i1 = e; }
                    int i2 = -1; float v2 = -3.0e38f;
#pragma unroll
                    for (int e = 0; e < 8; ++e) if (e != i1 && lg[e] > v2) { v2 = lg[e]; i2 = e; }
                    if (i2 < 0) { i2 = (i1 + 1) & 7; v2 = v1; }
                    const float g1 = 1.0f / (1.0f + __expf((v2 - v1) * rs)), g2 = 1.0f - g1;
                    tok_e[2 * m] = i1; tok_e[2 * m + 1] = i2; tok_g[2 * m] = g1; tok_g[2 * m + 1] = g2; rs_moe[m] = rs;
                    __hip_atomic_fetch_add(&cnt[i1], 1, __ATOMIC_RELAXED, __HIP_MEMORY_SCOPE_WORKGROUP); __hip_atomic_fetch_add(&cnt[8 + i2], 1, __ATOMIC_RELAXED, __HIP_MEMORY_SCOPE_WORKGROUP);
                } }
            __syncthreads();
            if (F.tid < 16) bcnt[vb * 16 + F.tid] = cnt[F.tid];
            __syncthreads();
        }
    }
    SEAM(PH_CV);

    if (IN(PH_R2)) {
        LAS int* tot = (LAS int*)F.lds;
        for (int vb = blockIdx.x; vb < 256; vb += F.G) {
            if (F.tid < 16) { int t = 0, mine = 0; for (int b2 = 0; b2 < 256; ++b2) { const int c = bcnt[b2 * 16 + F.tid]; if (b2 < vb) mine += c; t += c; } tot[F.tid] = t; tot[32 + F.tid] = mine; }
            __syncthreads();
            if (F.tid < 2) { int ps = 0; for (int e = 0; e < 8; ++e) { tot[16 + F.tid * 8 + e] = ps; ps += (tot[F.tid * 8 + e] + 255) / 256; }
                if (vb == 0) { panel[F.tid * 160] = ps; for (int e = 0; e < 8; ++e) { const int np = (tot[F.tid * 8 + e] + 255) / 256; for (int q = 0; q < np; ++q) panel[F.tid * 160 + 16 + tot[16 + F.tid * 8 + e] + q] = e; } } }
            __syncthreads();
            if (F.tid < 16) { const int set = F.tid >> 3, e = F.tid & 7; int slot = tot[16 + F.tid] * 256 + tot[32 + F.tid];
                for (int r = 0; r < 128; ++r) { const int m = vb * 128 + r; if (tok_e[2 * m + set] == e) { row_tok[set * MAXPAN * 256 + slot] = m; row_gate[set * MAXPAN * 256 + slot] = tok_g[2 * m + set]; ++slot; } } }
            __syncthreads();
        }
    }
    SEAM(PH_R2);

#define MOE_SET(SET, PHGU, PHDN) \
    if (IN(PHGU)) for (int rep = 0; rep < REP_GU; ++rep) { const int np = __builtin_amdgcn_readfirstlane(panel[(SET) * 160]); pg8::MoeSched<true> S; \
        if (MOE8_GU) { S.init(XB8, MWgu8, np, 2 * FFE, D, panel + (SET) * 160 + 16, row_tok + (SET) * MAXPAN * 256, F.G, (int)blockIdx.x); \
            if (MOE8_DN) { pg8::EpiSwigluMoe8 E{MH8, FFE, rs_moe, row_tok + (SET) * MAXPAN * 256, 1.0f / MOE8_WSCALE_GU}; pg8::gemm_phase<pg8::EpiSwigluMoe8, pg8::MoeSched<true>, true>(F.lds, D, S, E); } \
            else { pg8::EpiSwigluMoe E{MH, FFE, rs_moe, row_tok + (SET) * MAXPAN * 256, 1.0f / MOE8_WSCALE_GU}; pg8::gemm_phase<pg8::EpiSwigluMoe, pg8::MoeSched<true>, true>(F.lds, D, S, E); } } \
        else { S.init(XB, MWgu, np, 2 * FFE, 2 * D, panel + (SET) * 160 + 16, row_tok + (SET) * MAXPAN * 256, F.G, (int)blockIdx.x); \
            pg8::EpiSwigluMoe E{MH, FFE, rs_moe, row_tok + (SET) * MAXPAN * 256, 1.0f}; pg8::gemm_phase(F.lds, 2 * D, S, E); } } \
    SEAM(PHGU); \
    if (IN(PHDN)) { const int np = __builtin_amdgcn_readfirstlane(panel[(SET) * 160]); pg8::MoeSched<false> S; \
        if (MOE8_DN) { S.init(MH8, MWd8, np, D, FFE, panel + (SET) * 160 + 16, row_tok + (SET) * MAXPAN * 256, F.G, (int)blockIdx.x); \
            pg8::EpiMoeDown E{xres, row_tok + (SET) * MAXPAN * 256, row_gate + (SET) * MAXPAN * 256, 1.0f / MOE8_WSCALE_DN}; pg8::gemm_phase<pg8::EpiMoeDown, pg8::MoeSched<false>, true>(F.lds, FFE, S, E); } \
        else { S.init(MH, MWd, np, D, 2 * FFE, panel + (SET) * 160 + 16, row_tok + (SET) * MAXPAN * 256, F.G, (int)blockIdx.x); \
            pg8::EpiMoeDown E{xres, row_tok + (SET) * MAXPAN * 256, row_gate + (SET) * MAXPAN * 256, 1.0f}; pg8::gemm_phase(F.lds, 2 * FFE, S, E); } } \
    SEAM(PHDN);
#if MOE8_GU && MOE8_DN
#define MOE_GU8(SET, HBUF, SKX, SKR) do { const int np = __builtin_amdgcn_readfirstlane(panel[(SET) * 160]); pg8::MoeSched<true> S; \
        S.init(XB8, MWgu8, np, 2 * FFE, D, panel + (SET) * 160 + 16, row_tok + (SET) * MAXPAN * 256, F.G, (int)blockIdx.x); S.T.sx = (SKX); S.T.sr = (SKR); \
        pg8::EpiSwigluMoe8 E{HBUF, FFE, rs_moe, row_tok + (SET) * MAXPAN * 256, 1.0f / MOE8_WSCALE_GU}; pg8::gemm_phase<pg8::EpiSwigluMoe8, pg8::MoeSched<true>, true>(F.lds, D, S, E); } while (0)
#define MOE_DN8(SET, HBUF) do { const int np = __builtin_amdgcn_readfirstlane(panel[(SET) * 160]); pg8::MoeSched<false> S; \
        S.init(HBUF, MWd8, np, D, FFE, panel + (SET) * 160 + 16, row_tok + (SET) * MAXPAN * 256, F.G, (int)blockIdx.x); \
        pg8::EpiMoeDown E{xres, row_tok + (SET) * MAXPAN * 256, row_gate + (SET) * MAXPAN * 256, 1.0f / MOE8_WSCALE_DN}; pg8::gemm_phase<pg8::EpiMoeDown, pg8::MoeSched<false>, true>(F.lds, FFE, S, E); } while (0)
    if (IN(PH_GU_A)) MOE_GU8(0, MH8, 0, 0);
    SEAM(PH_GU_A);
    if (IN(PH_DN_A)) { MOE_DN8(0, MH8);
        const int ndn = __builtin_amdgcn_readfirstlane(panel[0]) * (D / 256); const int sx = ndn % F.G;
        MOE_GU8(1, MH8b, sx, sx ? 3 : 0); }
    if (IN(PH_DN_A) && IN(PH_DN_B)) xcd_barrier(bar);
    if (IN(PH_DN_B)) MOE_DN8(1, MH8b);
    SEAM(PH_DN_B);
#else
    MOE_SET(0, PH_GU_A, PH_DN_A)
    MOE_SET(1, PH_GU_B, PH_DN_B)
#endif

    if (IN(PH_FIN)) {
        const float* gf = args.in[I_NORM_FINAL];
        for (int m = F.gw; m < NTOK; m += F.NGW) {
            GAS f32x4* xr = (GAS f32x4*)(xres + (size_t)m * D) + F.lane; f32x4 v[4]; float s = 0.f;
#pragma unroll
            for (int j = 0; j < 4; ++j) { v[j] = xr[64 * j]; s += (v[j].x * v[j].x + v[j].y * v[j].y) + (v[j].z * v[j].z + v[j].w * v[j].w); }
            const float rs = 1.0f / sqrtf(wave_sum(s) * (1.0f / D) + RMS_EPS);
#pragma unroll
            for (int j = 0; j < 4; ++j) { const f32x4 g = *((const f32x4*)gf + F.lane + 64 * j); xr[64 * j] = v[j] * rs * g; }
        }
    }
#undef IN
#undef SEAM
}

extern "C" void kernel_launch(void* const* d_in, const int* in_sizes, int n_in, void* d_out, int out_size, void* d_ws, size_t ws_size, hipStream_t stream) {
    static int grid = 0;
    if (grid == 0) {
        if (n_in != NIN || in_sizes[0] != NTOK * D || out_size != NTOK * D || ws_size < WS_END) {
            fprintf(stderr, "kernel_launch: unexpected shapes: n_in %d in0 %d out %d ws %zu (need %zu); nothing launched\n", n_in, n_in > 0 ? in_sizes[0] : -1, out_size, ws_size, (size_t)WS_END); grid = -1; return; }
        int dev = 0, cus = 0, per_cu = 0;
        if (hipGetDevice(&dev) != hipSuccess || hipDeviceGetAttribute(&cus, hipDeviceAttributeMultiprocessorCount, dev) != hipSuccess) { grid = -1; return; }
        if (hipFuncSetAttribute((const void*)fwd, hipFuncAttributeMaxDynamicSharedMemorySize, LDS_BYTES) != hipSuccess) { fprintf(stderr, "kernel_launch: hipFuncSetAttribute failed\n"); grid = -1; return; }
        if (hipOccupancyMaxActiveBlocksPerMultiprocessor(&per_cu, (const void*)fwd, 512, LDS_BYTES) != hipSuccess || per_cu < 1) { fprintf(stderr, "kernel_launch: occupancy query says %d\n", per_cu); }
        (void)hipGetLastError();
        grid = cus;
    }
    if (grid < 0) return;
    if (hipMemsetAsync((char*)d_ws + WS_CTL, 0, CTL_ZERO_BYTES, stream) != hipSuccess) return;
    Args a{};
    for (int i = 0; i < NIN; ++i) a.in[i] = (const float*)d_in[i];
    a.out = (float*)d_out; a.ws = (unsigned char*)d_ws;
#if MK_PER_PHASE
    for (int ph = 0; ph < PH_COUNT; ++ph) { a.ph_lo = ph; a.ph_hi = ph + 1; hipLaunchKernelGGL(fwd, dim3(grid), dim3(512), LDS_BYTES, stream, a); }
#else
    a.ph_lo = 0; a.ph_hi = PH_COUNT; hipLaunchKernelGGL(fwd, dim3(grid), dim3(512), LDS_BYTES, stream, a);
#endif
}
```

```cpp
#include <hip/hip_runtime.h>
#include <cstdio>
#include <cstdint>

#ifndef MK_PER_PHASE
#define MK_PER_PHASE 0
#endif

#ifndef REP_M1
#define REP_M1 1
#endif
#ifndef REP_M2
#define REP_M2 1
#endif
#ifndef REP_M3
#define REP_M3 1
#endif
#ifndef REP_GU
#define REP_GU 1
#endif
#ifndef REP_CH
#define REP_CH 1
#endif
#ifndef PROBE_STAGE
#define PROBE_STAGE 0
#endif
#ifndef REP_CV
#define REP_CV 1
#endif
#ifndef REP_EPI
#define REP_EPI 1
#endif
#ifndef REP_G3
#define REP_G3 1
#endif
#ifndef PROBE_DUP
#define PROBE_DUP 0
#endif
#ifndef DBG_VAR
#define DBG_VAR 0
#endif
#ifndef MOE8_GU
#define MOE8_GU 1
#endif
#ifndef MOE8_DN
#define MOE8_DN 1
#endif
#ifndef MIX_MODE
#define MIX_MODE 0
#endif
#define GAS __attribute__((address_space(1)))
#define LAS __attribute__((address_space(3)))
typedef unsigned short bf16;
typedef unsigned short bf16_t;
typedef short bf16x8 __attribute__((ext_vector_type(8)));
typedef float f32x4 __attribute__((ext_vector_type(4)));
typedef float f32x2 __attribute__((ext_vector_type(2)));
typedef unsigned u32x4 __attribute__((ext_vector_type(4)));
typedef unsigned u32x2 __attribute__((ext_vector_type(2)));
typedef GAS unsigned gu32;

constexpr int NTOK = 32768, SEQ = 4096, NB = 8, D = 1024, INW = 2816, FF = 2816, FFE = 3584, NE = 8;
constexpr int GMW = 512, RWW = 512, NH = 8, HD = 64, GCH = 128;
constexpr float RMS_EPS = 1e-6f, LN_EPS = 1e-5f, GN_EPS = 64e-5f;
constexpr int MAXPAN = 136;

constexpr size_t MiB = 1u << 20;
constexpr size_t WS_CTL = 0, CTL_ZERO_BYTES = 2 * MiB;
constexpr size_t WS_WIN = 2 * MiB;
constexpr size_t WS_WOUT = 13 * MiB;
constexpr size_t WS_WGU = 17 * MiB;
constexpr size_t WS_WD = 28 * MiB;
constexpr size_t WS_MISC = 34 * MiB;
constexpr size_t WS_SMALLW = 36 * MiB;
constexpr size_t SW_WUP = 0, SW_AUP = 128 * 1024, SW_GUP = 256 * 1024, SW_WS = 512 * 1024;
constexpr size_t WS_XB = 38 * MiB;
constexpr size_t WS_R = 102 * MiB;
constexpr size_t WS_P = WS_R;
constexpr size_t WS_Y = WS_R + 176 * MiB;
constexpr size_t WS_SCR = WS_R + 240 * MiB;
constexpr size_t WS_MOEW_GU = WS_R;
constexpr size_t WS_MOEW_D = WS_R + 112 * MiB;
constexpr size_t WS_MOEH = WS_R + 168 * MiB;
constexpr size_t WS_MOEW8_GU = WS_R;
constexpr size_t WS_MOEW8_D = WS_R + 56 * MiB;
constexpr size_t WS_XB8 = WS_R + 112 * MiB;
constexpr float MOE8_WSCALE_GU = 64.f, MOE8_WSCALE_DN = 128.f;
constexpr size_t WS_SSQP = WS_R + 400 * MiB;
constexpr size_t WS_END = WS_R + 408 * MiB;
static_assert(WS_MOEH + (size_t)MAXPAN * 256 * FFE * 2 <= WS_END, "moe hidden fits");
static_assert(WS_WIN + (size_t)2 * INW * D * 2 <= WS_WOUT && WS_WGU + (size_t)2 * FF * D * 2 <= WS_WD && WS_WD + (size_t)D * FF * 2 <= WS_MISC, "weights fit");
constexpr int CW_TMO = 0;
constexpr int CW_BAR = 4096;
constexpr int CW_SSQ = 65536;
static_assert((CW_SSQ + 4 * NTOK) * 4 <= (int)CTL_ZERO_BYTES, "ctl fits");
constexpr size_t MS_TOKE = 0;
constexpr size_t MS_TOKG = 256 * 1024;
constexpr size_t MS_RS = 512 * 1024;
constexpr size_t MS_BCNT = 640 * 1024;
constexpr size_t MS_ROWTOK = 704 * 1024;
constexpr size_t MS_ROWGATE = 1024 * 1024;
constexpr size_t MS_PANEL = 1344 * 1024;
constexpr size_t MS_ROWRS = 1408 * 1024;
static_assert(MS_ROWTOK + 2 * MAXPAN * 256 * 4 <= MS_ROWGATE && MS_ROWGATE + 2 * MAXPAN * 256 * 4 <= MS_PANEL && MS_PANEL + 2 * 160 * 4 <= MS_ROWRS && MS_ROWRS + 2 * MAXPAN * 256 * 4 <= 2 * MiB, "misc fits");

constexpr int RING_BYTES = 131072;
constexpr int LDS_BYTES = 147456;
constexpr int MISC_OFF = LDS_BYTES - 128;

#define LDS_WAIT() asm volatile("s_waitcnt lgkmcnt(0)" ::: "memory")
#define VM_WAIT() asm volatile("s_waitcnt vmcnt(0)" ::: "memory")
#define RLX_AGENT __ATOMIC_RELAXED, __HIP_MEMORY_SCOPE_AGENT
#define LDS_BARRIER() do { asm volatile("s_waitcnt lgkmcnt(0)" ::: "memory"); __builtin_amdgcn_s_barrier(); asm volatile("" ::: "memory"); } while (0)

__device__ __forceinline__ unsigned f2bf(float f) { unsigned u = __builtin_bit_cast(unsigned, f); return (u + 0x7fffu + ((u >> 16) & 1u)) >> 16; }
__device__ __forceinline__ unsigned pk2(float lo, float hi) { return f2bf(lo) | (f2bf(hi) << 16); }
__device__ __forceinline__ float bf2f(bf16 b) { return __builtin_bit_cast(float, (unsigned)b << 16); }
__device__ __forceinline__ unsigned cvt_pk_bf16(float lo, float hi) { unsigned r; asm volatile("v_cvt_pk_bf16_f32 %0, %1, %2" : "=v"(r) : "v"(lo), "v"(hi)); return r; }
__device__ __forceinline__ unsigned pk4_fp8(float a, float b, float c, float d) { int v = __builtin_amdgcn_cvt_pk_fp8_f32(a, b, 0, false); v = __builtin_amdgcn_cvt_pk_fp8_f32(c, d, v, true); return (unsigned)v; }
__device__ __forceinline__ float wave_sum(float v) {
#pragma unroll
    for (int o = 1; o < 64; o <<= 1) v += __shfl_xor(v, o);
    return v;
}
__device__ __forceinline__ float gelu_erf(float v) { return 0.5f * v * (1.0f + erff(v * 0.70710678f)); }
__device__ __forceinline__ float sigmoidf_(float v) { return 1.0f / (1.0f + __expf(-v)); }
__device__ __forceinline__ float silu_f(float v) { return v * __builtin_amdgcn_rcpf(1.0f + __expf(-v)); }

namespace pg8 {
constexpr int BM = 256, BK = 64, HALF = 128, HTB = HALF * BK * 2, STAGE_BYTES = 8 * HTB, NXCD = 8, WGM = 8;
__host__ __device__ __forceinline__ int lds_byte(int r, int c) { const int st = (r >> 4) * 2 + (c >> 5), rr = r & 15, cc = c & 31, ob = rr * 64 + cc * 2; return st * 1024 + (ob ^ (((ob >> 9) & 1) << 5)); }
__host__ __device__ __forceinline__ void stage_rc(int b, int& R, int& C) { const int st = b / 1024, sb = b % 1024, swz = sb ^ (((sb >> 9) & 1) << 5); R = (st >> 1) * 16 + swz / 64; C = (st & 1) * 32 + (swz % 64) / 2; }
__host__ __device__ __forceinline__ int perm32(int rho) { const int n = rho >> 4, i = rho & 15; return 8 * (i >> 2) + 4 * n + (i & 3); }

struct Unit { int pm, pn, aux; };

struct TileOrder {
    int nM, nN, nwg, G, c, sx, sr;
    __device__ void init(int nM_, int nN_, int G_, int c_) { nM = nM_; nN = nN_; nwg = nM * nN; G = G_; c = c_; sx = 0; sr = 0; }
    __device__ bool tile(int i, int& pm, int& pn) const {
        long L;
        if (sx == 0) L = (long)i * G + c;
        else if (c < sx) L = (long)sr * (G - sx) + (long)i * G + c;
        else L = i < sr ? (long)i * (G - sx) + (c - sx) : (long)sr * (G - sx) + (long)(i - sr) * G + c;
        if (L >= nwg) return false;
        int wgid = (int)L; { const int q = nwg / NXCD, r = nwg % NXCD, xcd = wgid % NXCD, off = wgid / NXCD; wgid = (xcd < r ? xcd * (q + 1) : r * (q + 1) + (xcd - r) * q) + off; }
        const int nig = WGM * nN, gid = wgid / nig, fm = gid * WGM, gsz = (nM - fm) < WGM ? (nM - fm) : WGM;
        pm = fm + ((wgid % nig) % gsz); pn = (wgid % nig) / gsz; return true;
    }
};
struct DenseSched {
    static constexpr bool GATHER = false;
    TileOrder T; const char* A; const char* Bt; size_t tstep;
    __device__ void init(const void* A_, const void* Bt_, int M, int N, int KB  , int G, int c) { T.init(M / BM, N / BM, G, c); A = (const char*)A_; Bt = (const char*)Bt_; tstep = (size_t)BM * KB; }
    __device__ __forceinline__ bool next(int i, Unit& u) const { u.aux = 0; return T.tile(i, u.pm, u.pn); }
    __device__ __forceinline__ const char* a_ptr(const Unit& u) const { return A + (size_t)u.pm * tstep; }
    __device__ __forceinline__ const char* b_ptr(const Unit& u) const { return Bt + (size_t)u.pn * tstep; }
    __device__ __forceinline__ void gather(const Unit&, int, int, int, int, int, unsigned (&)[2][2]) const {}
};
template <bool GATHER_> struct MoeSched {
    static constexpr bool GATHER = GATHER_;
    TileOrder T; const char* A; const char* Bt; size_t a_tstep, b_tstep, b_estep; const int* pexp; const int* row_tok; int KB;
    __device__ void init(const void* A_, const void* Bt_, int npanels, int N, int KB_  , const int* pexp_, const int* row_tok_, int G, int c) {
        T.init(npanels, N / BM, G, c); A = (const char*)A_; Bt = (const char*)Bt_; KB = KB_; a_tstep = (size_t)BM * KB_; b_tstep = (size_t)BM * KB_; b_estep = (size_t)N * KB_; pexp = pexp_; row_tok = row_tok_; }
    __device__ __forceinline__ bool next(int i, Unit& u) const { if (!T.tile(i, u.pm, u.pn)) return false; u.aux = __builtin_amdgcn_readfirstlane(pexp[u.pm]); return true; }
    __device__ __forceinline__ const char* a_ptr(const Unit& u) const { return GATHER ? A : A + (size_t)u.pm * a_tstep; }
    __device__ __forceinline__ const char* b_ptr(const Unit& u) const { return Bt + (size_t)u.aux * b_estep + (size_t)u.pn * b_tstep; }
    __device__ __forceinline__ void gather(const Unit& u, int R0, int R1, int C0, int C1, int, unsigned (&v)[2][2]) const {
#pragma unroll
        for (int h = 0; h < 2; ++h) { int t0 = row_tok[u.pm * BM + h * HALF + R0], t1 = row_tok[u.pm * BM + h * HALF + R1]; t0 = t0 < 0 ? 0 : t0; t1 = t1 < 0 ? 0 : t1;
            v[h][0] = (unsigned)(t0 * KB + C0 * 2); v[h][1] = (unsigned)(t1 * KB + C1 * 2); }
    }
};

typedef int v4i_t __attribute__((ext_vector_type(4)));
typedef int v8i_t __attribute__((ext_vector_type(8)));
typedef short s16x16_t __attribute__((ext_vector_type(16)));
__device__ __forceinline__ v8i_t cat8(const bf16x8 lo, const bf16x8 hi) { const v4i_t a = __builtin_bit_cast(v4i_t, lo), b = __builtin_bit_cast(v4i_t, hi); return __builtin_shufflevector(a, b, 0, 1, 2, 3, 4, 5, 6, 7); }
template <class Epi, class Sched, bool FP8 = false>
__device__ __forceinline__ void gemm_phase(LAS unsigned char* lds, const int KB, const Sched& S, const Epi& E) {
    constexpr bool GATHER = Sched::GATHER;
    const int tid = threadIdx.x, wid = __builtin_amdgcn_readfirstlane(tid >> 6), lane = tid & 63, wr = wid >> 2, wc = wid & 3, fr = lane & 15, fq = lane >> 4;
    const int nt = KB / 128;
    unsigned voffA[2], voffB[2]; int sR[2], sC[2];
#pragma unroll
    for (int i = 0; i < 2; ++i) { int R, C; stage_rc(tid * 16 + i * 8192, R, C); const int Rb = Epi::PERM ? ((R & ~31) + perm32(R & 31)) : R; sR[i] = R; sC[i] = C;
        voffA[i] = (unsigned)(R * KB + C * 2); voffB[i] = (unsigned)(Rb * KB + C * 2); }
    const size_t kstep = (size_t)(BK * 2);
    const size_t hstep = (size_t)HALF * KB;
    const unsigned ldsw = (unsigned)wid * 1024u;
    const int aoff = lds_byte(wr * 64 + fr, fq * 8), boff = lds_byte(wc * 32 + fr, fq * 8);
    const int aoff8 = lds_byte(wr * 64 + fr, (fq >> 1) * 32 + (fq & 1) * 16) & ~31, boff8 = lds_byte(wc * 32 + fr, (fq >> 1) * 32 + (fq & 1) * 16) & ~31;
#define PG8_SA(b, h) (((b) * 2 + (h)) * HTB)
#define PG8_SB(b, h) ((4 + (b) * 2 + (h)) * HTB)
#define PG8_STAGE(bufoff, gbase, voff) do { _Pragma("unroll") for (int _i = 0; _i < 2; ++_i) \
        __builtin_amdgcn_global_load_lds((const unsigned*)((const char*)(gbase) + (voff)[_i]), (LAS unsigned*)(lds + (bufoff) + ldsw + _i * 8192), 16, 0, 0); } while (0)
#define PG8_STAGE_A(bufoff, kptr, half, VG) do { if constexpr (GATHER) { PG8_STAGE(bufoff, kptr, (VG)[half]); } else { PG8_STAGE(bufoff, (kptr) + (half) * hstep, voffA); } } while (0)
#define PG8_LDA(dst, b, h) do { if constexpr (FP8) { _Pragma("unroll") for (int m = 0; m < 4; ++m) dst##8[m] = cat8(*(const LAS bf16x8*)(lds + PG8_SA(b, h) + aoff8 + m * 2048), *(const LAS bf16x8*)(lds + PG8_SA(b, h) + aoff8 + m * 2048 + 16)); } \
        else { _Pragma("unroll") for (int m = 0; m < 4; ++m) _Pragma("unroll") for (int k = 0; k < 2; ++k) dst[m][k] = *(const LAS bf16x8*)(lds + PG8_SA(b, h) + aoff + m * 2048 + k * 1024); } } while (0)
#define PG8_LDB(dst, b, h) do { if constexpr (FP8) { _Pragma("unroll") for (int n = 0; n < 2; ++n) dst##8[n] = cat8(*(const LAS bf16x8*)(lds + PG8_SB(b, h) + boff8 + n * 2048), *(const LAS bf16x8*)(lds + PG8_SB(b, h) + boff8 + n * 2048 + 16)); } \
        else { _Pragma("unroll") for (int n = 0; n < 2; ++n) _Pragma("unroll") for (int k = 0; k < 2; ++k) dst[n][k] = *(const LAS bf16x8*)(lds + PG8_SB(b, h) + boff + n * 2048 + k * 1024); } } while (0)
#define PG8_MMA(ai, bj, At, Bt) do { __builtin_amdgcn_s_setprio(1); if constexpr (FP8) { _Pragma("unroll") for (int m = 0; m < 4; ++m) _Pragma("unroll") for (int n = 0; n < 2; ++n) \
        asm volatile("v_mfma_scale_f32_16x16x128_f8f6f4 %0, %1, %2, %0, %3, %3 op_sel_hi:[0,0,0]" : "+v"(acc[ai][bj][m][n]) : "v"(Bt##8[n]), "v"(At##8[m]), "v"(sc8)); } \
        else { _Pragma("unroll") for (int m = 0; m < 4; ++m) _Pragma("unroll") for (int n = 0; n < 2; ++n) _Pragma("unroll") for (int k = 0; k < 2; ++k) \
        acc[ai][bj][m][n] = __builtin_amdgcn_mfma_f32_16x16x32_bf16(Bt[n][k], At[m][k], acc[ai][bj][m][n], 0, 0, 0); } __builtin_amdgcn_s_setprio(0); } while (0)
#define PG8_WAIT_V(n) asm volatile("s_waitcnt vmcnt(" #n ")" ::: "memory")
#define PG8_WAIT_L(n) asm volatile("s_waitcnt lgkmcnt(" #n ")" ::: "memory")
#define PG8_BAR __builtin_amdgcn_s_barrier()
#define PG8_SCHED __builtin_amdgcn_sched_barrier(0)
    Unit cur, nxt; int ui = 0;
    if (!S.next(0, cur)) return;
    f32x4 acc[2][2][4][2];
#pragma unroll
    for (int a = 0; a < 2; ++a)
#pragma unroll
        for (int b = 0; b < 2; ++b)
#pragma unroll
            for (int m = 0; m < 4; ++m)
#pragma unroll
                for (int n = 0; n < 2; ++n) acc[a][b][m][n] = (f32x4){0.f, 0.f, 0.f, 0.f};
    bf16x8 At[4][2], B0[2][2], B1[2][2]; v8i_t At8[4], B08[2], B18[2]; const int sc8 = 0x7f7f7f7f;
    const char* cA = S.a_ptr(cur); const char* cB = S.b_ptr(cur);
    unsigned vcur[2][2] = {{0u, 0u}, {0u, 0u}}, vnext[2][2] = {{0u, 0u}, {0u, 0u}}, vt2[2][2] = {{0u, 0u}, {0u, 0u}};
    if constexpr (GATHER) S.gather(cur, sR[0], sR[1], sC[0], sC[1], 0, vcur);
    PG8_STAGE(PG8_SB(0, 0), cB, voffB); PG8_STAGE(PG8_SB(0, 1), cB + hstep, voffB); PG8_STAGE_A(PG8_SA(0, 0), cA, 0, vcur); PG8_STAGE_A(PG8_SA(0, 1), cA, 1, vcur);
    if (wr == 1) PG8_BAR;
    PG8_WAIT_V(2); PG8_BAR;
    PG8_STAGE(PG8_SB(1, 0), cB + kstep, voffB); PG8_STAGE_A(PG8_SA(1, 0), cA + kstep, 0, vcur); PG8_STAGE(PG8_SB(1, 1), cB + hstep + kstep, voffB);
    PG8_WAIT_V(6); PG8_BAR;
    for (;;) {
        const bool has_next = S.next(ui + 1, nxt);
        const char* nA = has_next ? S.a_ptr(nxt) : cA; const char* nB = has_next ? S.b_ptr(nxt) : cB;
        if constexpr (GATHER) { if (has_next) S.gather(nxt, sR[0], sR[1], sC[0], sC[1], 0, vnext); else {
#pragma unroll
            for (int h = 0; h < 2; ++h) { vnext[h][0] = vcur[h][0]; vnext[h][1] = vcur[h][1]; } } }
        for (int t = 0; t < nt; t += 2) {
            const bool last = (t == nt - 2);
            const char* a1 = cA + (size_t)(t + 1) * kstep;
            const char* a2 = last ? nA : cA + (size_t)(t + 2) * kstep; const char* b2 = last ? nB : cB + (size_t)(t + 2) * kstep;
            const char* a3 = a2 + kstep; const char* b3 = b2 + kstep;
            if constexpr (GATHER) {
#pragma unroll
                for (int h = 0; h < 2; ++h) { vt2[h][0] = last ? vnext[h][0] : vcur[h][0]; vt2[h][1] = last ? vnext[h][1] : vcur[h][1]; } }
            PG8_LDB(B0, 0, 0); PG8_LDB(B1, 0, 1); PG8_SCHED; PG8_LDA(At, 0, 0); PG8_STAGE_A(PG8_SA(1, 1), a1, 1, vcur);
            PG8_WAIT_V(8); PG8_WAIT_L(0); PG8_BAR; PG8_MMA(0, 0, At, B0); PG8_MMA(0, 1, At, B1); PG8_BAR; PG8_SCHED;
            PG8_LDA(At, 0, 1); PG8_STAGE(PG8_SB(0, 0), b2, voffB); PG8_STAGE(PG8_SB(0, 1), b2 + hstep, voffB); PG8_STAGE_A(PG8_SA(0, 0), a2, 0, vt2);
            PG8_WAIT_V(8); PG8_WAIT_L(0); PG8_BAR; PG8_MMA(1, 0, At, B0); PG8_MMA(1, 1, At, B1); PG8_BAR; PG8_SCHED;
            PG8_LDB(B0, 1, 0); PG8_LDB(B1, 1, 1); PG8_SCHED; PG8_LDA(At, 1, 0); PG8_STAGE_A(PG8_SA(0, 1), a2, 1, vt2);
            PG8_WAIT_V(8); PG8_WAIT_L(0); PG8_BAR; PG8_MMA(0, 0, At, B0); PG8_MMA(0, 1, At, B1); PG8_BAR; PG8_SCHED;
            PG8_LDA(At, 1, 1); PG8_STAGE(PG8_SB(1, 0), b3, voffB); PG8_STAGE(PG8_SB(1, 1), b3 + hstep, voffB); PG8_STAGE_A(PG8_SA(1, 0), a3, 0, vt2);
            PG8_WAIT_V(8); PG8_WAIT_L(0); PG8_BAR; PG8_MMA(1, 0, At, B0); PG8_MMA(1, 1, At, B1); PG8_BAR; PG8_SCHED;
        }
        if (wr == 0) PG8_BAR;
        if constexpr (FP8) { asm volatile("s_nop 15\n\ts_nop 15" ::: "memory"); }
        for (int rp_ = 0; rp_ < Epi::REPS; ++rp_) E(acc, cur, wr, wc, fr, fq);
        if (!has_next) break;
#pragma unroll
        for (int a = 0; a < 2; ++a)
#pragma unroll
            for (int b = 0; b < 2; ++b)
#pragma unroll
                for (int m = 0; m < 4; ++m)
#pragma unroll
                    for (int n = 0; n < 2; ++n) acc[a][b][m][n] = (f32x4){0.f, 0.f, 0.f, 0.f};
        cur = nxt; cA = nA; cB = nB; ++ui;
        if constexpr (GATHER) {
#pragma unroll
            for (int h = 0; h < 2; ++h) { vcur[h][0] = vnext[h][0]; vcur[h][1] = vnext[h][1]; } }
        if (wr == 1) PG8_BAR;
    }
    PG8_WAIT_V(0);
    PG8_BAR;
#undef PG8_SA
#undef PG8_SB
#undef PG8_STAGE
#undef PG8_STAGE_A
#undef PG8_LDA
#undef PG8_LDB
#undef PG8_MMA
#undef PG8_WAIT_V
#undef PG8_WAIT_L
#undef PG8_BAR
#undef PG8_SCHED
}

template <int NP> __device__ __forceinline__ float row_rs(const float* ssq, int row) {
    float s;
    if constexpr (NP == 1) s = ssq[row];
    else { const f32x4* p = (const f32x4*)(ssq + (size_t)row * 16); const f32x4 a = p[0], b = p[1], c = p[2], d = p[3];
        s = (((a[0] + a[1]) + (a[2] + a[3])) + ((b[0] + b[1]) + (b[2] + b[3]))) + (((c[0] + c[1]) + (c[2] + c[3])) + ((d[0] + d[1]) + (d[2] + d[3]))); }
    return __builtin_amdgcn_rsqf(s * (1.0f / D) + RMS_EPS);
}
template <int NP> struct EpiScaleBf16 {
    static constexpr bool PERM = true; static constexpr int REPS = 1;
    bf16_t* O; int ldc; const float* ssq;
    __device__ __forceinline__ void operator()(const f32x4 (&acc)[2][2][4][2], const Unit& u, int wr, int wc, int fr, int fq) const {
        const int row0 = u.pm * BM + wr * 64 + fr, col0 = u.pn * BM + wc * 32 + 8 * fq;
#pragma unroll
        for (int ai = 0; ai < 2; ++ai)
#pragma unroll
            for (int m = 0; m < 4; ++m) { const int row = row0 + ai * HALF + m * 16; const float rs = row_rs<NP>(ssq, row);
                bf16_t* rowp = O + (size_t)row * ldc + col0;
#pragma unroll
                for (int bj = 0; bj < 2; ++bj) { const f32x4 v0 = acc[ai][bj][m][0] * rs, v1 = acc[ai][bj][m][1] * rs;
                    u32x4 w; w.x = cvt_pk_bf16(v0[0], v0[1]); w.y = cvt_pk_bf16(v0[2], v0[3]); w.z = cvt_pk_bf16(v1[0], v1[1]); w.w = cvt_pk_bf16(v1[2], v1[3]);
                    *(u32x4*)(rowp + bj * HALF) = w; } }
    }
};
template <bool SSQ, bool BASE32> struct EpiResid {
    static constexpr bool PERM = false; static constexpr int REPS = 1;
    const float* base32; bf16_t* xb; float* ssq;
    __device__ __forceinline__ void operator()(const f32x4 (&acc)[2][2][4][2], const Unit& u, int wr, int wc, int fr, int fq) const {
        const int row0 = u.pm * BM + wr * 64 + fr, col0 = u.pn * BM + wc * 32 + 4 * fq;
#pragma unroll
        for (int ai = 0; ai < 2; ++ai) {
            f32x4 bs[4][2][2];
#pragma unroll
            for (int m = 0; m < 4; ++m)
#pragma unroll
                for (int bj = 0; bj < 2; ++bj)
#pragma unroll
                    for (int n = 0; n < 2; ++n) { const size_t off = (size_t)(row0 + ai * HALF + m * 16) * D + col0 + bj * HALF + n * 16;
                        if constexpr (BASE32) bs[m][bj][n] = *(const f32x4*)(base32 + off);
                        else { const u32x2 r = *(const u32x2*)(xb + off); bs[m][bj][n] = (f32x4){__builtin_bit_cast(float, r.x << 16), __builtin_bit_cast(float, r.x & 0xffff0000u), __builtin_bit_cast(float, r.y << 16), __builtin_bit_cast(float, r.y & 0xffff0000u)}; } }
            asm volatile("" ::: "memory");
#pragma unroll
            for (int m = 0; m < 4; ++m) { const int row = row0 + ai * HALF + m * 16; const size_t off = (size_t)row * D + col0; float s = 0.f;
#pragma unroll
                for (int bj = 0; bj < 2; ++bj)
#pragma unroll
                    for (int n = 0; n < 2; ++n) { const f32x4 o = bs[m][bj][n] + acc[ai][bj][m][n];
                        u32x2 w; w.x = cvt_pk_bf16(o[0], o[1]); w.y = cvt_pk_bf16(o[2], o[3]); *(u32x2*)(xb + off + bj * HALF + n * 16) = w;
                        if constexpr (SSQ) { const float r0 = __builtin_bit_cast(float, w.x << 16), r1 = __builtin_bit_cast(float, w.x & 0xffff0000u), r2 = __builtin_bit_cast(float, w.y << 16), r3 = __builtin_bit_cast(float, w.y & 0xffff0000u);
                            s += (r0 * r0 + r1 * r1) + (r2 * r2 + r3 * r3); } }
                if constexpr (SSQ) { s += __shfl_xor(s, 16); s += __shfl_xor(s, 32);
                    if (fq == 0) ssq[(size_t)row * 16 + u.pn * 4 + wc] = s; } }
            asm volatile("" ::: "memory"); }
    }
};
template <int NP> struct EpiSwiglu {
    static constexpr bool PERM = true; static constexpr int REPS = REP_EPI;
    bf16_t* O; int ldc; const float* ssq;
    __device__ __forceinline__ void operator()(const f32x4 (&acc)[2][2][4][2], const Unit& u, int wr, int wc, int fr, int fq) const {
        const int row0 = u.pm * BM + wr * 64 + fr, col0 = u.pn * HALF + wc * 32 + 8 * fq;
#pragma unroll
        for (int ai = 0; ai < 2; ++ai)
#pragma unroll
            for (int m = 0; m < 4; ++m) { const int row = row0 + ai * HALF + m * 16; const float rs = row_rs<NP>(ssq, row);
                float h[8];
#pragma unroll
                for (int n = 0; n < 2; ++n)
#pragma unroll
                    for (int j = 0; j < 4; ++j) h[n * 4 + j] = silu_f(acc[ai][0][m][n][j] * rs) * (acc[ai][1][m][n][j] * rs);
                u32x4 w; w.x = cvt_pk_bf16(h[0], h[1]); w.y = cvt_pk_bf16(h[2], h[3]); w.z = cvt_pk_bf16(h[4], h[5]); w.w = cvt_pk_bf16(h[6], h[7]);
                *(u32x4*)(O + (size_t)row * ldc + col0) = w; }
    }
};
struct EpiSwigluMoe {
    static constexpr bool PERM = true; static constexpr int REPS = 1;
    bf16_t* O; int ldc; const float* rsv; const int* row_tok; float wsinv;
    __device__ __forceinline__ void operator()(const f32x4 (&acc)[2][2][4][2], const Unit& u, int wr, int wc, int fr, int fq) const {
        const int row0 = u.pm * BM + wr * 64 + fr, col0 = u.pn * HALF + wc * 32 + 8 * fq;
#pragma unroll
        for (int ai = 0; ai < 2; ++ai)
#pragma unroll
            for (int m = 0; m < 4; ++m) { const int row = row0 + ai * HALF + m * 16; const int tok = row_tok[row]; const float rs = tok >= 0 ? rsv[tok] * wsinv : 0.f;
                float h[8];
#pragma unroll
                for (int n = 0; n < 2; ++n)
#pragma unroll
                    for (int j = 0; j < 4; ++j) h[n * 4 + j] = silu_f(acc[ai][0][m][n][j] * rs) * (acc[ai][1][m][n][j] * rs);
                u32x4 w; w.x = cvt_pk_bf16(h[0], h[1]); w.y = cvt_pk_bf16(h[2], h[3]); w.z = cvt_pk_bf16(h[4], h[5]); w.w = cvt_pk_bf16(h[6], h[7]);
                *(u32x4*)(O + (size_t)row * ldc + col0) = w; }
    }
};
struct EpiSwigluMoe8 {
    static constexpr bool PERM = true; static constexpr int REPS = 1;
    unsigned char* O; int ldc; const float* row_rs; float wsinv;
    __device__ __forceinline__ void operator()(const f32x4 (&acc)[2][2][4][2], const Unit& u, int wr, int wc, int fr, int fq) const {
        const int row0 = u.pm * BM + wr * 64 + fr, col0 = u.pn * HALF + wc * 32 + 8 * fq;
        float rsr[2][4];
#pragma unroll
        for (int ai = 0; ai < 2; ++ai)
#pragma unroll
            for (int m = 0; m < 4; ++m) rsr[ai][m] = row_rs[row0 + ai * HALF + m * 16];
#pragma unroll
        for (int ai = 0; ai < 2; ++ai)
#pragma unroll
            for (int m = 0; m < 4; ++m) { const int row = row0 + ai * HALF + m * 16; const float rs = rsr[ai][m] * wsinv;
                float h[8];
#pragma unroll
                for (int n = 0; n < 2; ++n)
#pragma unroll
                    for (int j = 0; j < 4; ++j) h[n * 4 + j] = silu_f(acc[ai][0][m][n][j] * rs) * (acc[ai][1][m][n][j] * rs);
                u32x2 w; w.x = pk4_fp8(h[0], h[1], h[2], h[3]); w.y = pk4_fp8(h[4], h[5], h[6], h[7]);
                *(u32x2*)(O + (size_t)row * ldc + col0) = w; }
    }
};
struct EpiMoeDown {
    static constexpr bool PERM = false; static constexpr int REPS = 1;
    bf16_t* out; const int* row_tok; const float* row_gate; float sc;
    __device__ __forceinline__ void operator()(const f32x4 (&acc)[2][2][4][2], const Unit& u, int wr, int wc, int fr, int fq) const {
        const int row0 = u.pm * BM + wr * 64 + fr, col0 = u.pn * BM + wc * 32 + 4 * fq;
        int tk[2][4]; float gt[2][4];
#pragma unroll
        for (int ai = 0; ai < 2; ++ai)
#pragma unroll
            for (int m = 0; m < 4; ++m) { tk[ai][m] = row_tok[row0 + ai * HALF + m * 16]; gt[ai][m] = row_gate[row0 + ai * HALF + m * 16]; }
#pragma unroll
        for (int ai = 0; ai < 2; ++ai)
#pragma unroll
            for (int m = 0; m < 4; ++m) { const int tok = tk[ai][m]; const float g = gt[ai][m] * sc;
                if (tok >= 0) { bf16_t* rp = out + (size_t)tok * D + col0; u32x2 cur[2][2];
#pragma unroll
                    for (int bj = 0; bj < 2; ++bj)
#pragma unroll
                        for (int n = 0; n < 2; ++n) cur[bj][n] = *(const u32x2*)(rp + bj * HALF + n * 16);
#pragma unroll
                    for (int bj = 0; bj < 2; ++bj)
#pragma unroll
                        for (int n = 0; n < 2; ++n) { const u32x2 r = cur[bj][n]; const f32x4 a = acc[ai][bj][m][n] * g;
                            u32x2 w; w.x = cvt_pk_bf16(__builtin_bit_cast(float, r.x << 16) + a[0], __builtin_bit_cast(float, r.x & 0xffff0000u) + a[1]);
                            w.y = cvt_pk_bf16(__builtin_bit_cast(float, r.y << 16) + a[2], __builtin_bit_cast(float, r.y & 0xffff0000u) + a[3]); *(u32x2*)(rp + bj * HALF + n * 16) = w; } }
                asm volatile("" ::: "memory"); }
    }
};
}

#define XB_TMO      128
#define XB_XCNT(j)  (256  + 64 * (j))
#define XB_XSUB(j)  (1280 + 64 * (j))
#define XB_XGEN(j)  (2304 + 64 * (j))
#define XB_TOP      3328
#define XB_TOPGEN   3392
#define XCD_BAR_WORDS 3456
#define XB_SPIN_CAP (1u << 18)
__device__ __forceinline__ unsigned xb_ld(unsigned* p)              { return __hip_atomic_load(p, __ATOMIC_RELAXED, __HIP_MEMORY_SCOPE_AGENT); }
__device__ __forceinline__ unsigned xb_add(unsigned* p, unsigned v) { return __hip_atomic_fetch_add(p, v, __ATOMIC_RELAXED, __HIP_MEMORY_SCOPE_AGENT); }
__device__ __forceinline__ unsigned xb_xcc_id() { return (unsigned)__builtin_amdgcn_s_getreg((3 << 11) | 20) & 0xFu; }
#define XB_SPIN(cond, bar) do { unsigned _sp = 0; while (cond) { __builtin_amdgcn_s_sleep(1); \
    if ((++_sp & 255u) == 0u) { if (xb_ld(&(bar)[XB_TMO])) break; if (_sp > XB_SPIN_CAP) { atomicAdd(&(bar)[XB_TMO], 1u); break; } } } } while (0)
struct XcdBarrier { unsigned* bar; unsigned x; volatile LAS unsigned* st; };
__device__ __forceinline__ XcdBarrier xcd_barrier_post(unsigned* bar, volatile LAS unsigned* st) {
    XcdBarrier b; b.bar = bar; b.x = xb_xcc_id(); b.st = st;
    if (threadIdx.x == 0) (void)xb_add(&bar[XB_XCNT(b.x)], 1u);
    return b;
}
__device__ __forceinline__ void xcd_barrier_complete(unsigned* bar, unsigned x, unsigned& nloc, unsigned& nx) {
    const unsigned G = gridDim.x * gridDim.y * gridDim.z;
    unsigned sum, cnt, mine, sp = 0u;
    for (;;) {
        sum = 0u; cnt = 0u; mine = 0u;
#pragma unroll
        for (unsigned j = 0; j < 16; ++j) { const unsigned c = xb_ld(&bar[XB_XCNT(j)]); sum += c; cnt += (c > 0u) ? 1u : 0u; mine = (j == x) ? c : mine; }
        if (sum == G) break;
        __builtin_amdgcn_s_sleep(1);
        if ((++sp & 255u) == 0u) { if (xb_ld(&bar[XB_TMO])) break; if (sp > XB_SPIN_CAP) { atomicAdd(&bar[XB_TMO], 1u); break; } }
    }
    nloc = mine > 0u ? mine : 1u; nx = cnt > 0u ? cnt : 1u;
}
__device__ __forceinline__ void xcd_barrier(const XcdBarrier& b) {
    asm volatile("s_waitcnt vmcnt(0)" ::: "memory");
    __syncthreads();
    if (threadIdx.x == 0) {
        unsigned* bar = b.bar;
        __builtin_amdgcn_s_waitcnt(0);
        unsigned nloc = b.st[0], nx = b.st[1];
        if (nloc == 0u) { xcd_barrier_complete(bar, b.x, nloc, nx); b.st[0] = nloc; b.st[1] = nx; }
        const unsigned old = xb_add(&bar[XB_XSUB(b.x)], 1u);
        const unsigned gen = old / nloc;
        if (old + 1u == (gen + 1u) * nloc) {
            __builtin_amdgcn_fence(__ATOMIC_RELEASE, "agent");
            asm volatile("s_waitcnt vmcnt(0)" ::: "memory");
            const unsigned og = xb_add(&bar[XB_TOP], 1u);
            const unsigned tg = og / nx;
            if (og + 1u == (tg + 1u) * nx) xb_add(&bar[XB_TOPGEN], 1u);
            else XB_SPIN(xb_ld(&bar[XB_TOPGEN]) == tg, bar);
            __builtin_amdgcn_fence(__ATOMIC_ACQUIRE, "agent");
            xb_add(&bar[XB_XGEN(b.x)], 1u);
            asm volatile("s_waitcnt vmcnt(0)" ::: "memory");
        } else {
            XB_SPIN(xb_ld(&bar[XB_XGEN(b.x)]) == gen, bar);
            __builtin_amdgcn_fence(__ATOMIC_ACQUIRE, "agent");
            asm volatile("s_waitcnt vmcnt(0)" ::: "memory");
        }
    }
    __syncthreads();
}

constexpr int NIN = 28;
struct Args { const float* in[NIN]; float* out; unsigned char* ws; int ph_lo, ph_hi; };
enum { I_X = 0, I_NORM_MIX, I_W_IN, I_W_OUT, I_SHIFT_MU, I_GM_LN_W, I_GM_LN_B, I_GM_WS, I_GM_BS, I_RW_W_UP, I_RW_W0, I_RW_A_UP, I_RW_A0, I_RW_G_UP, I_RW_K_K, I_RW_K_A, I_RW_R_K,
       I_RW_LNX_W, I_RW_LNX_B, I_NORM_FFN, I_FFN_WG, I_FFN_WU, I_FFN_WD, I_MOE_ROUTER, I_MOE_WG, I_MOE_WU, I_MOE_WD, I_NORM_FINAL };

struct Frame {
    LAS unsigned char* lds;
    int tid, lane, wave, G, gw, NGW;
};

struct CvItem { f32x4 v[8]; float gn[8]; };
__device__ __forceinline__ void cv_load(CvItem& it, const float* W, int N, int k0, int n0, const float* gain, float scale, int lane) {
    const int kr = lane >> 3, nq = lane & 7;
#pragma unroll
    for (int i = 0; i < 8; ++i) { it.v[i] = *(const GAS f32x4*)(W + (size_t)(k0 + 8 * i + kr) * N + n0 + 4 * nq); it.gn[i] = gain ? gain[k0 + 8 * i + kr] * scale : scale; }
}
__device__ __forceinline__ void cv_store_fp8(const CvItem& it, int K, unsigned char* WT, int drow0, int k0, LAS float* scr, int lane) {
    { const int kr = lane >> 3, nq = lane & 7;
#pragma unroll
      for (int i = 0; i < 8; ++i) { LAS float* d = scr + (8 * i + kr) * 33 + 4 * nq; d[0] = it.v[i][0] * it.gn[i]; d[1] = it.v[i][1] * it.gn[i]; d[2] = it.v[i][2] * it.gn[i]; d[3] = it.v[i][3] * it.gn[i]; } }
    LDS_WAIT(); asm volatile("" ::: "memory");
    const int n = lane >> 1, hf = lane & 1; const LAS float* sp = scr + (32 * hf) * 33 + n; u32x4 o0, o1;
    o0.x = pk4_fp8(sp[0 * 33], sp[1 * 33], sp[2 * 33], sp[3 * 33]); o0.y = pk4_fp8(sp[4 * 33], sp[5 * 33], sp[6 * 33], sp[7 * 33]); o0.z = pk4_fp8(sp[8 * 33], sp[9 * 33], sp[10 * 33], sp[11 * 33]); o0.w = pk4_fp8(sp[12 * 33], sp[13 * 33], sp[14 * 33], sp[15 * 33]);
    o1.x = pk4_fp8(sp[16 * 33], sp[17 * 33], sp[18 * 33], sp[19 * 33]); o1.y = pk4_fp8(sp[20 * 33], sp[21 * 33], sp[22 * 33], sp[23 * 33]); o1.z = pk4_fp8(sp[24 * 33], sp[25 * 33], sp[26 * 33], sp[27 * 33]); o1.w = pk4_fp8(sp[28 * 33], sp[29 * 33], sp[30 * 33], sp[31 * 33]);
    unsigned char* dst = WT + (size_t)(drow0 + n) * K + k0 + 32 * hf; *(GAS u32x4*)dst = o0; *(GAS u32x4*)(dst + 16) = o1;
    LDS_WAIT(); asm volatile("" ::: "memory");
}
__device__ __forceinline__ void transpose_item(const float* W, int K, int N, bf16* WT, int drow0, int k0, int n0, const float* gain, LAS float* scr, int lane) {
    { const int kr = lane >> 3, nq = lane & 7; f32x4 v[8]; float gn[8];
#pragma unroll
      for (int i = 0; i < 8; ++i) { v[i] = *(const GAS f32x4*)(W + (size_t)(k0 + 8 * i + kr) * N + n0 + 4 * nq); gn[i] = gain ? gain[k0 + 8 * i + kr] : 1.f; }
#pragma unroll
      for (int i = 0; i < 8; ++i) { LAS float* d = scr + (8 * i + kr) * 33 + 4 * nq; d[0] = v[i][0] * gn[i]; d[1] = v[i][1] * gn[i]; d[2] = v[i][2] * gn[i]; d[3] = v[i][3] * gn[i]; } }
    LDS_WAIT(); asm volatile("" ::: "memory");
    const int c = lane & 7;
#pragma unroll
    for (int j = 0; j < 4; ++j) { const int n = (lane >> 3) + 8 * j; const LAS float* s = scr + (8 * c) * 33 + n;
        u32x4 o; o.x = pk2(s[0 * 33], s[1 * 33]); o.y = pk2(s[2 * 33], s[3 * 33]); o.z = pk2(s[4 * 33], s[5 * 33]); o.w = pk2(s[6 * 33], s[7 * 33]);
        *(GAS u32x4*)(WT + (size_t)(drow0 + n) * K + k0 + 8 * c) = o; }
    LDS_WAIT(); asm volatile("" ::: "memory");
}
__device__ __forceinline__ void convert_matrix_fp8(Frame& F, const float* W, int K, int N, unsigned char* WT, int gu_mode  , const float* gain, float scale, int& itbase) {
    LAS float* scr = (LAS float*)(F.lds + F.wave * 16384);
    const int nblk = N / 32, nit = (K / 64) * nblk;
    int first = F.gw - (itbase % F.NGW); if (first < 0) first += F.NGW;
    CvItem nx;
    if (first < nit) cv_load(nx, W, N, 64 * (first / nblk), 32 * (first % nblk), gain, scale, F.lane);
    for (int r = first; r < nit; r += F.NGW) { const int kb = r / nblk, nb = r % nblk, n0 = 32 * nb;
        const int drow0 = gu_mode == 0 ? n0 : (n0 / 128) * 256 + (gu_mode == 2 ? 128 : 0) + (n0 % 128);
        const CvItem cur = nx; const int r2 = r + F.NGW;
        if (r2 < nit) cv_load(nx, W, N, 64 * (r2 / nblk), 32 * (r2 % nblk), gain, scale, F.lane);
        cv_store_fp8(cur, K, WT, drow0, 64 * kb, scr, F.lane); }
    itbase += nit;
}
__device__ __forceinline__ void convert_matrix(Frame& F, const float* W, int K, int N, bf16* WT, int gu_mode  , const float* gain, int it0, int& itbase) {
    LAS float* scr = (LAS float*)(F.lds + F.wave * 16384);
    const int nblk = N / 32, nit = (K / 64) * nblk;
    int first = F.gw - (itbase % F.NGW); if (first < 0) first += F.NGW;
    for (int r = first; r < nit; r += F.NGW) { const int kb = r / nblk, nb = r % nblk, n0 = 32 * nb;
        const int drow0 = gu_mode == 0 ? n0 : (n0 / 128) * 256 + (gu_mode == 2 ? 128 : 0) + (n0 % 128);
        transpose_item(W, K, N, WT, drow0, 64 * kb, n0, gain, scr, F.lane); }
    itbase += nit; (void)it0;
}

__device__ __forceinline__ void gmlp_naive(Frame& F, const bf16* P, bf16* Y, const float* ln_w, const float* ln_b, const float* ws, const float* bs) {
    LAS float* V = (LAS float*)F.lds;
    for (int unit = blockIdx.x; unit < NB * (SEQ / GCH) * NH; unit += F.G) {
        const int h = unit % NH, bc = unit / NH; const size_t row0 = (size_t)bc * GCH;
        const float lw = ln_w[h * HD + F.lane], lb = ln_b[h * HD + F.lane];
        for (int i = 0; i < 16; ++i) { const int t = F.wave * 16 + i;
            const float g = gelu_erf(bf2f(P[(row0 + t) * INW + GMW + h * HD + F.lane]));
            const float mean = wave_sum(g) * (1.f / HD); const float d = g - mean; const float var = wave_sum(d * d) * (1.f / HD);
            V[t * HD + F.lane] = d * __builtin_amdgcn_rsqf(var + LN_EPS) * lw + lb; }
        __syncthreads();
        for (int i = 0; i < 16; ++i) { const int t = F.wave * 16 + i; const float* wrow = ws + ((size_t)h * GCH + t) * GCH; float acc = 0.f;
            for (int s = 0; s <= t; ++s) acc += wrow[s] * V[s * HD + F.lane];
            const float mixed = acc + bs[h * GCH + t];
            const float u = gelu_erf(bf2f(P[(row0 + t) * INW + h * HD + F.lane]));
            Y[(row0 + t) * D + h * HD + F.lane] = (bf16)f2bf(u * mixed); }
        __syncthreads();
    }
}
__device__ __forceinline__ float shifted(const bf16* P, size_t row, int t, int col, const float* mu) {
    const float c = bf2f(P[row * INW + col]); const float pr = t > 0 ? bf2f(P[(row - 1) * INW + col]) : 0.f;
    return c + (pr - c) * mu[col - 1024];
}
constexpr int NC = 32;
__device__ __forceinline__ void rwkv_naive(Frame& F, const bf16* P, bf16* Y, const float* mu, const float* w_up, const float* w0, const float* a_up, const float* a0, const float* g_up,
                                           const float* k_k, const float* k_a, const float* r_k, const float* lnx_w, const float* lnx_b) {
    LAS float* LI = (LAS float*)F.lds;
    LAS float* sR = LI + NC * 256; LAS float* sW = sR + NC * 64; LAS float* sK = sW + NC * 64; LAS float* sV = sK + NC * 64; LAS float* sA = sV + NC * 64; LAS float* sB = sA + NC * 64;
    LAS float* sG = sB + NC * 64; LAS float* sBon = sG + NC * 64;
    for (int unit = blockIdx.x; unit < NB * NH; unit += F.G) {
        const int b = unit / NH, h = unit % NH;
        float S[64];
#pragma unroll
        for (int k = 0; k < 64; ++k) S[k] = 0.f;
        for (int c = 0; c < SEQ / NC; ++c) {
            const int t0 = c * NC; const size_t row0 = (size_t)b * SEQ + t0;
            for (int idx = F.tid; idx < NC * 256; idx += 512) { const int tok = idx >> 8, j = idx & 255;
                const float x = shifted(P, row0 + tok, t0 + tok, 2560 + j, mu);
                LI[idx] = j < 64 ? tanhf(x) : (j < 128 ? x : sigmoidf_(x)); }
            __syncthreads();
            { const int ch = F.lane, hc = h * HD + ch;
              for (int i = 0; i < NC / 8; ++i) { const int tok = F.wave + 8 * i; const size_t row = row0 + tok; const int t = t0 + tok;
                const float rr = shifted(P, row, t, 1024 + hc, mu), kx = shifted(P, row, t, 1536 + hc, mu), vv = shifted(P, row, t, 2048 + hc, mu);
                float dw = w0[hc], da = a0[hc], gg = 0.f;
                for (int j = 0; j < 64; ++j) { dw += LI[tok * 256 + j] * w_up[j * RWW + hc]; da += LI[tok * 256 + 64 + j] * a_up[j * RWW + hc]; }
                for (int j = 0; j < 128; ++j) gg += LI[tok * 256 + 128 + j] * g_up[j * RWW + hc];
                const float z = -dw; const float sp = fmaxf(z, 0.f) + log1pf(__expf(-fabsf(z)));
                const float decay = __expf(-__expf(-sp - 0.5f));
                const float alr = sigmoidf_(da);
                const float kkv = kx * k_k[hc]; const float nrm = sqrtf(wave_sum(kkv * kkv)); const float kkn = kkv / fmaxf(nrm, 1e-12f);
                const float kmod = kx * (1.f + (alr - 1.f) * k_a[hc]);
                const float bsc = wave_sum(rr * kmod * r_k[hc]);
                sR[tok * 64 + ch] = rr; sW[tok * 64 + ch] = decay; sK[tok * 64 + ch] = kmod; sV[tok * 64 + ch] = vv; sA[tok * 64 + ch] = -kkn; sB[tok * 64 + ch] = kkn * alr;
                sG[tok * 64 + ch] = gg; sBon[tok * 64 + ch] = bsc * vv; } }
            __syncthreads();
            if (F.wave == 0) {
                for (int t = 0; t < NC; ++t) { float sa = 0.f;
#pragma unroll
                    for (int k = 0; k < 64; ++k) sa += S[k] * sA[t * 64 + k];
                    const float vv = sV[t * 64 + F.lane]; float yv = 0.f;
#pragma unroll
                    for (int k = 0; k < 64; ++k) { S[k] = S[k] * sW[t * 64 + k] + sa * sB[t * 64 + k] + vv * sK[t * 64 + k]; yv += S[k] * sR[t * 64 + k]; }
                    LI[t * 64 + F.lane] = yv; }
            }
            __syncthreads();
            { const int v = F.lane, hv = h * HD + v;
              for (int i = 0; i < NC / 8; ++i) { const int tok = F.wave + 8 * i; const float yv = LI[tok * 64 + v];
                const float mean = wave_sum(yv) * (1.f / HD); const float d = yv - mean; const float var = wave_sum(d * d) * (1.f / HD);
                const float yn = d * __builtin_amdgcn_rsqf(var + GN_EPS) * lnx_w[hv] + lnx_b[hv];
                Y[(row0 + tok) * D + GMW + hv] = (bf16)f2bf((yn + sBon[tok * 64 + v]) * sG[tok * 64 + v]); } }
            __syncthreads();
        }
    }
}

typedef short s16x4 __attribute__((ext_vector_type(4)));
typedef short v4i16_t __attribute__((ext_vector_type(4)));
#define MFMA32(a, b, c) __builtin_amdgcn_mfma_f32_16x16x32_bf16((a), (b), (c), 0, 0, 0)
#define MFMA16(a, b, c) __builtin_amdgcn_mfma_f32_16x16x16bf16_1k((a), (b), (c), 0, 0, 0)
__device__ __forceinline__ bf16x8 lds_row8(const LAS bf16* T, int ld, int r0, int k0, int lane) { return *(const LAS bf16x8*)(T + (r0 + (lane & 15)) * ld + k0 + 8 * (lane >> 4)); }
__device__ __forceinline__ s16x4 lds_row4(const LAS bf16* T, int ld, int r0, int k0, int lane) { return *(const LAS s16x4*)(T + (r0 + (lane & 15)) * ld + k0 + 4 * (lane >> 4)); }
__device__ __forceinline__ s16x4 lds_tr4(const LAS bf16* T, int ld, int k0, int c0, int lane) { const int i = lane & 15, g = lane >> 4;
    return __builtin_bit_cast(s16x4, __builtin_amdgcn_ds_read_tr16_b64_v4i16((LAS v4i16_t*)(T + (k0 + 4 * g + (i >> 2)) * ld + c0 + 4 * (i & 3)))); }
__device__ __forceinline__ bf16x8 lds_tr8(const LAS bf16* T, int ld, int k0, int c0, int lane) { const int i = lane & 15, g = lane >> 4;
    const LAS bf16* p = T + (k0 + 8 * g + (i >> 2)) * ld + c0 + 4 * (i & 3);
    const s16x4 lo = __builtin_bit_cast(s16x4, __builtin_amdgcn_ds_read_tr16_b64_v4i16((LAS v4i16_t*)p));
    const s16x4 hi = __builtin_bit_cast(s16x4, __builtin_amdgcn_ds_read_tr16_b64_v4i16((LAS v4i16_t*)(p + 4 * ld)));
    bf16x8 r; r[0] = lo[0]; r[1] = lo[1]; r[2] = lo[2]; r[3] = lo[3]; r[4] = hi[0]; r[5] = hi[1]; r[6] = hi[2]; r[7] = hi[3]; return r; }
typedef __bf16 bf16x2_t __attribute__((ext_vector_type(2)));
__device__ __forceinline__ unsigned cvtpk_c(float lo, float hi) { const f32x2 v = {lo, hi}; const bf16x2_t b = __builtin_convertvector(v, bf16x2_t); return __builtin_bit_cast(unsigned, b); }
__device__ __forceinline__ s16x4 pack4(const f32x4 v) { u32x2 w; w.x = cvtpk_c(v[0], v[1]); w.y = cvtpk_c(v[2], v[3]); return __builtin_bit_cast(s16x4, w); }
__device__ __forceinline__ f32x4 unpack4(const s16x4 v) { f32x4 r; r[0] = bf2f((bf16)v[0]); r[1] = bf2f((bf16)v[1]); r[2] = bf2f((bf16)v[2]); r[3] = bf2f((bf16)v[3]); return r; }
__device__ __forceinline__ void unpack8(const u32x4 w, float (&o)[8]) { o[0] = __builtin_bit_cast(float, w.x << 16); o[1] = __builtin_bit_cast(float, w.x & 0xffff0000u); o[2] = __builtin_bit_cast(float, w.y << 16); o[3] = __builtin_bit_cast(float, w.y & 0xffff0000u);
    o[4] = __builtin_bit_cast(float, w.z << 16); o[5] = __builtin_bit_cast(float, w.z & 0xffff0000u); o[6] = __builtin_bit_cast(float, w.w << 16); o[7] = __builtin_bit_cast(float, w.w & 0xffff0000u); }
__device__ __forceinline__ u32x4 pack8(const float (&v)[8]) { u32x4 w; w.x = cvtpk_c(v[0], v[1]); w.y = cvtpk_c(v[2], v[3]); w.z = cvtpk_c(v[4], v[5]); w.w = cvtpk_c(v[6], v[7]); return w; }
__device__ __forceinline__ float gelu_as(float v) {
    const float av = fabsf(v), t = __builtin_amdgcn_rcpf(av * 0.2316418882f + 1.0f);
    float q = t * 0.5307027145f + (-0.7265760135f); q = q * t + 0.7107068705f; q = q * t + (-0.142248368f); q = q * t + 0.127414796f; q = q * t;
    const float e = __builtin_amdgcn_exp2f((v * v) * (-0.72134752044f)); const float m = v * (q * e); return v < 0.f ? m : v - m;
}

constexpr int GM_V = 0, GM_U = 128 * 72 * 2;
__device__ __forceinline__ void gmlp_unit(Frame& F, int unit, const bf16* P, bf16* Y, const float* ln_w, const float* ln_b, const bf16* WsB, const float* bs) {
    LAS bf16* Vt = (LAS bf16*)(F.lds + GM_V); LAS bf16* Ut = (LAS bf16*)(F.lds + GM_U);
    const int h = unit % NH, bc = unit / NH; const size_t row0 = (size_t)bc * GCH;
    { const int t = F.tid >> 2, cq = F.tid & 3; const bf16* pr = P + (row0 + t) * INW + h * HD + 16 * cq;
      const u32x4 u0 = *(const u32x4*)pr, u1 = *(const u32x4*)(pr + 8), v0 = *(const u32x4*)(pr + GMW), v1 = *(const u32x4*)(pr + GMW + 8);
      float uu[16], vv[16]; { float a[8]; unpack8(u0, a); for (int j = 0; j < 8; ++j) uu[j] = a[j]; unpack8(u1, a); for (int j = 0; j < 8; ++j) uu[8 + j] = a[j]; unpack8(v0, a); for (int j = 0; j < 8; ++j) vv[j] = a[j]; unpack8(v1, a); for (int j = 0; j < 8; ++j) vv[8 + j] = a[j]; }
      float s = 0.f;
#pragma unroll
      for (int j = 0; j < 16; ++j) { uu[j] = gelu_as(uu[j]); vv[j] = gelu_as(vv[j]); s += vv[j]; }
      s += __shfl_xor(s, 1); s += __shfl_xor(s, 2); const float mean = s * (1.f / HD); float q = 0.f;
#pragma unroll
      for (int j = 0; j < 16; ++j) { vv[j] -= mean; q += vv[j] * vv[j]; }
      q += __shfl_xor(q, 1); q += __shfl_xor(q, 2); const float rstd = __builtin_amdgcn_rsqf(q * (1.f / HD) + LN_EPS);
#pragma unroll
      for (int j = 0; j < 16; ++j) vv[j] = vv[j] * rstd * ln_w[h * HD + 16 * cq + j] + ln_b[h * HD + 16 * cq + j];
      float a[8]; for (int j = 0; j < 8; ++j) a[j] = vv[j]; *(LAS u32x4*)(Vt + t * 72 + 16 * cq) = pack8(a); for (int j = 0; j < 8; ++j) a[j] = vv[8 + j]; *(LAS u32x4*)(Vt + t * 72 + 16 * cq + 8) = pack8(a);
      for (int j = 0; j < 8; ++j) a[j] = uu[j]; *(LAS u32x4*)(Ut + t * 72 + 16 * cq) = pack8(a); for (int j = 0; j < 8; ++j) a[j] = uu[8 + j]; *(LAS u32x4*)(Ut + t * 72 + 16 * cq + 8) = pack8(a); }
    __syncthreads();
    { const int w = F.wave, l15 = F.lane & 15, g = F.lane >> 4, t0 = 16 * w, nks = (w >> 1) + 1; const bf16* wrow = WsB + ((size_t)h * GCH + t0 + l15) * GCH + 8 * g;
      f32x4 acc[4] = {{0.f, 0.f, 0.f, 0.f}, {0.f, 0.f, 0.f, 0.f}, {0.f, 0.f, 0.f, 0.f}, {0.f, 0.f, 0.f, 0.f}};
      for (int ks = 0; ks < nks; ++ks) { const bf16x8 a = *(const bf16x8*)(wrow + 32 * ks);
#pragma unroll
          for (int nt = 0; nt < 4; ++nt) acc[nt] = MFMA32(a, lds_tr8(Vt, 72, 32 * ks, 16 * nt, F.lane), acc[nt]); }
#pragma unroll
      for (int reg = 0; reg < 4; ++reg) { const int t = t0 + 4 * g + reg; const float bsv = bs[h * GCH + t];
#pragma unroll
          for (int nt = 0; nt < 4; ++nt) { LAS bf16* up = Ut + t * 72 + 16 * nt + l15; *up = (bf16)f2bf(bf2f(*up) * (acc[nt][reg] + bsv)); } } }
    __syncthreads();
    { const int t = F.tid >> 2, cq = F.tid & 3; bf16* yr = Y + (row0 + t) * D + h * HD + 16 * cq;
      *(u32x4*)yr = *(const LAS u32x4*)(Ut + t * 72 + 16 * cq); *(u32x4*)(yr + 8) = *(const LAS u32x4*)(Ut + t * 72 + 16 * cq + 8); }
    __syncthreads();
}

__device__ __forceinline__ void gmlp_units(Frame& F, int u0, int ustep, int nunits, const bf16* P, bf16* Y, const float* ln_w, const float* ln_b, const bf16* WsB, const float* bs) {
    if (u0 >= nunits) return;
    const int t = F.tid >> 2, cq = F.tid & 3; const int w = F.wave, l15 = F.lane & 15, g = F.lane >> 4, t0 = 16 * w, nks = (w >> 1) + 1;
    u32x4 pu0, pu1, pv0, pv1;
#define GM_LOAD(uu_) do { const int h_ = (uu_) % NH, bc_ = (uu_) / NH; const bf16* pr_ = P + ((size_t)bc_ * GCH + t) * INW + h_ * HD + 16 * cq; \
        pu0 = *(const u32x4*)pr_; pu1 = *(const u32x4*)(pr_ + 8); pv0 = *(const u32x4*)(pr_ + GMW); pv1 = *(const u32x4*)(pr_ + GMW + 8); } while (0)
    GM_LOAD(u0);
    int it = 0;
    for (int unit = u0; unit < nunits; unit += ustep, ++it) {
        LAS bf16* Vt = (LAS bf16*)(F.lds + (it & 1) * (2 * 128 * 72 * 2)); LAS bf16* Ut = Vt + 128 * 72;
        const int h = unit % NH, bc = unit / NH; const size_t row0 = (size_t)bc * GCH;
        const bf16* wrow = WsB + ((size_t)h * GCH + t0 + l15) * GCH + 8 * g; bf16x8 af[4];
#pragma unroll
        for (int ks = 0; ks < 4; ++ks) af[ks] = *(const bf16x8*)(wrow + 32 * (ks < nks ? ks : 0));
        const f32x4 bsv = *(const f32x4*)(bs + h * GCH + t0 + 4 * g);
        float uu[16], vv[16]; { float a[8]; unpack8(pu0, a); for (int j = 0; j < 8; ++j) uu[j] = a[j]; unpack8(pu1, a); for (int j = 0; j < 8; ++j) uu[8 + j] = a[j]; unpack8(pv0, a); for (int j = 0; j < 8; ++j) vv[j] = a[j]; unpack8(pv1, a); for (int j = 0; j < 8; ++j) vv[8 + j] = a[j]; }
        if (unit + ustep < nunits) GM_LOAD(unit + ustep);
        float sm = 0.f;
#pragma unroll
        for (int j = 0; j < 16; ++j) { uu[j] = gelu_as(uu[j]); vv[j] = gelu_as(vv[j]); sm += vv[j]; }
        sm += __shfl_xor(sm, 1); sm += __shfl_xor(sm, 2); const float mean = sm * (1.f / HD); float q = 0.f;
#pragma unroll
        for (int j = 0; j < 16; ++j) { vv[j] -= mean; q += vv[j] * vv[j]; }
        q += __shfl_xor(q, 1); q += __shfl_xor(q, 2); const float rstd = __builtin_amdgcn_rsqf(q * (1.f / HD) + LN_EPS);
#pragma unroll
        for (int j = 0; j < 16; ++j) vv[j] = vv[j] * rstd * ln_w[h * HD + 16 * cq + j] + ln_b[h * HD + 16 * cq + j];
        { float a[8]; for (int j = 0; j < 8; ++j) a[j] = vv[j]; *(LAS u32x4*)(Vt + t * 72 + 16 * cq) = pack8(a); for (int j = 0; j < 8; ++j) a[j] = vv[8 + j]; *(LAS u32x4*)(Vt + t * 72 + 16 * cq + 8) = pack8(a);
          for (int j = 0; j < 8; ++j) a[j] = uu[j]; *(LAS u32x4*)(Ut + t * 72 + 16 * cq) = pack8(a); for (int j = 0; j < 8; ++j) a[j] = uu[8 + j]; *(LAS u32x4*)(Ut + t * 72 + 16 * cq + 8) = pack8(a); }
        LDS_BARRIER();
        { f32x4 acc[4] = {{0.f, 0.f, 0.f, 0.f}, {0.f, 0.f, 0.f, 0.f}, {0.f, 0.f, 0.f, 0.f}, {0.f, 0.f, 0.f, 0.f}};
#pragma unroll
          for (int ks = 0; ks < 4; ++ks) if (ks < nks) {
#pragma unroll
              for (int nt = 0; nt < 4; ++nt) acc[nt] = MFMA32(af[ks], lds_tr8(Vt, 72, 32 * ks, 16 * nt, F.lane), acc[nt]); }
#pragma unroll
          for (int reg = 0; reg < 4; ++reg) { const int tt = t0 + 4 * g + reg;
#pragma unroll
              for (int nt = 0; nt < 4; ++nt) { LAS bf16* up = Ut + tt * 72 + 16 * nt + l15; *up = (bf16)f2bf(bf2f(*up) * (acc[nt][reg] + bsv[reg])); } } }
        LDS_BARRIER();
        { bf16* yr = Y + (row0 + t) * D + h * HD + 16 * cq;
          *(u32x4*)yr = *(const LAS u32x4*)(Ut + t * 72 + 16 * cq); *(u32x4*)(yr + 8) = *(const LAS u32x4*)(Ut + t * 72 + 16 * cq + 8); }
    }
#undef GM_LOAD
    LDS_BARRIER();
}

struct RwkvW { const float *mu, *w0, *a0, *k_k, *k_a, *r_k, *lnx_w, *lnx_b; const bf16 *WupT, *AupT, *GupT; };
struct RwkvS { bf16 *SG, *SH, *SQ, *SS, *Sg, *SY0; float* Sbsc; };
constexpr int M1_LI = 0;
constexpr int M1_PR = 33792;
constexpr int M1_TL = M1_PR + 36864;
constexpr int M1_SEG = M1_TL + 7 * 9216;
constexpr int M1_GAM = M1_SEG + 2048;
constexpr int M1_D = M1_GAM + 256;
constexpr int M1_T = M1_D + 4096;
constexpr int M1_END = M1_T + 2048;
static_assert(M1_END <= MISC_OFF, "M1 LDS map");
__device__ __forceinline__ float fast_tanh(float x) { const float e = __expf(2.f * x); return 1.f - 2.f * __builtin_amdgcn_rcpf(e + 1.f); }

__device__ __forceinline__ void rwkv_m1_unit(Frame& F, int unit  , const bf16* P, const RwkvW& W, const RwkvS& Sc) {
    const int b = unit >> 6, c = unit & 63, t0 = c * 64; const size_t row0 = (size_t)b * SEQ + t0;
    const int w = F.wave, lane = F.lane, l15 = lane & 15, g = lane >> 4;
    LAS bf16* LI = (LAS bf16*)(F.lds + M1_LI);
    LAS float* Ef = (LAS float*)(F.lds + M1_PR); LAS float* ALf = Ef + 64 * 64;
    LAS bf16* Lab = (LAS bf16*)(F.lds + M1_PR); LAS bf16* Lak = Lab + 64 * 72; LAS bf16* Mrb = Lak + 64 * 72; LAS bf16* Mrk = Mrb + 64 * 72;
    LAS bf16* At = (LAS bf16*)(F.lds + M1_TL); LAS bf16* Bt = At + 64 * 72; LAS bf16* Kt = Bt + 64 * 72; LAS bf16* Rt = Kt + 64 * 72; LAS bf16* Bh = Rt + 64 * 72; LAS bf16* Kh = Bh + 64 * 72; LAS bf16* Vt = Kh + 64 * 72;
    LAS float* SEG = (LAS float*)(F.lds + M1_SEG); LAS float* GAM = (LAS float*)(F.lds + M1_GAM); LAS float* Dd = (LAS float*)(F.lds + M1_D); LAS bf16* Tt = (LAS bf16*)(F.lds + M1_T);
#pragma unroll
    for (int it = 0; it < 4; ++it) { const int item = F.tid + 512 * it, tok = item >> 5, jc = item & 31, j0 = 8 * jc; const size_t row = row0 + tok;
        float cv[8], pv[8]; unpack8(*(const u32x4*)(P + row * INW + 2560 + j0), cv);
        if (t0 + tok > 0) unpack8(*(const u32x4*)(P + (row - 1) * INW + 2560 + j0), pv); else { for (int j = 0; j < 8; ++j) pv[j] = 0.f; }
        const f32x4 m0 = *(const f32x4*)(W.mu + 1536 + j0), m1 = *(const f32x4*)(W.mu + 1536 + j0 + 4); float o[8];
#pragma unroll
        for (int j = 0; j < 8; ++j) { const float x = cv[j] + (pv[j] - cv[j]) * (j < 4 ? m0[j] : m1[j - 4]); o[j] = jc < 8 ? fast_tanh(x) : (jc < 16 ? x : sigmoidf_(x)); }
        *(LAS u32x4*)(LI + tok * 264 + j0) = pack8(o); }
    __syncthreads();
    for (int h = 0; h < NH; ++h) {
        const size_t uh = ((size_t)unit * NH + h) * 4096;
        { const int mt = w & 3, ntb = 2 * (w >> 2); const int chrow = h * HD + 16 * mt + l15;
          f32x4 aw[2] = {{0.f, 0.f, 0.f, 0.f}, {0.f, 0.f, 0.f, 0.f}}, aa[2] = {{0.f, 0.f, 0.f, 0.f}, {0.f, 0.f, 0.f, 0.f}}, ag[2] = {{0.f, 0.f, 0.f, 0.f}, {0.f, 0.f, 0.f, 0.f}};
#pragma unroll
          for (int ks = 0; ks < 2; ++ks) { const bf16x8 fw = *(const bf16x8*)(W.WupT + (size_t)chrow * 64 + 32 * ks + 8 * g), fa = *(const bf16x8*)(W.AupT + (size_t)chrow * 64 + 32 * ks + 8 * g);
#pragma unroll
              for (int q = 0; q < 2; ++q) { aw[q] = MFMA32(fw, lds_row8(LI, 264, 16 * (ntb + q), 32 * ks, lane), aw[q]); aa[q] = MFMA32(fa, lds_row8(LI, 264, 16 * (ntb + q), 64 + 32 * ks, lane), aa[q]); } }
#pragma unroll
          for (int ks = 0; ks < 4; ++ks) { const bf16x8 fg = *(const bf16x8*)(W.GupT + (size_t)chrow * 128 + 32 * ks + 8 * g);
#pragma unroll
              for (int q = 0; q < 2; ++q) ag[q] = MFMA32(fg, lds_row8(LI, 264, 16 * (ntb + q), 128 + 32 * ks, lane), ag[q]); }
          const int ch0 = 16 * mt + 4 * g; const f32x4 w0v = *(const f32x4*)(W.w0 + h * HD + ch0), a0v = *(const f32x4*)(W.a0 + h * HD + ch0);
#pragma unroll
          for (int q = 0; q < 2; ++q) { const int tok = 16 * (ntb + q) + l15; f32x4 ev, av;
#pragma unroll
              for (int r = 0; r < 4; ++r) { const float z = -(aw[q][r] + w0v[r]); const float sp = fmaxf(z, 0.f) + __logf(1.f + __expf(-fabsf(z))); ev[r] = -__expf(-sp - 0.5f); av[r] = sigmoidf_(aa[q][r] + a0v[r]); }
              *(LAS f32x4*)(Ef + tok * 64 + ch0) = ev; *(LAS f32x4*)(ALf + tok * 64 + ch0) = av;
              u32x2 gw; gw.x = cvtpk_c(ag[q][0], ag[q][1]); gw.y = cvtpk_c(ag[q][2], ag[q][3]); *(u32x2*)(Sc.Sg + (row0 + tok) * RWW + h * HD + ch0) = gw; } }
        __syncthreads();
        { const int ch = F.tid & 63, seg = F.tid >> 6; float run = 0.f;
#pragma unroll
          for (int i = 0; i < 8; ++i) { run += Ef[(8 * seg + i) * 64 + ch]; Ef[(8 * seg + i) * 64 + ch] = run; }
          SEG[seg * 64 + ch] = run; }
        __syncthreads();
        { const int ch = F.tid & 63, seg = F.tid >> 6; float off = 0.f;
          for (int s2 = 0; s2 < seg; ++s2) off += SEG[s2 * 64 + ch];
#pragma unroll
          for (int i = 0; i < 8; ++i) Ef[(8 * seg + i) * 64 + ch] += off; }
        __syncthreads();
        { const int tok = F.tid >> 3, cg = F.tid & 7, ch0 = 8 * cg, hc0 = h * HD + ch0; const size_t row = row0 + tok; const bool has_prev = (t0 + tok) > 0;
          float rr[8], kx[8], vv[8], tmp[8], pr[8];
#define SHIFT_LOAD(dst, col) do { unpack8(*(const u32x4*)(P + row * INW + (col)), dst); if (has_prev) unpack8(*(const u32x4*)(P + (row - 1) * INW + (col)), pr); else { for (int j = 0; j < 8; ++j) pr[j] = 0.f; } \
              const f32x4 m0 = *(const f32x4*)(W.mu + (col) - 1024), m1 = *(const f32x4*)(W.mu + (col) - 1024 + 4); for (int j = 0; j < 8; ++j) dst[j] = dst[j] + (pr[j] - dst[j]) * (j < 4 ? m0[j] : m1[j - 4]); } while (0)
          SHIFT_LOAD(rr, 1024 + hc0); SHIFT_LOAD(kx, 1536 + hc0); SHIFT_LOAD(vv, 2048 + hc0);
          (void)tmp;
          float Lt[8], Lm[8], Lc[8], al[8];
#pragma unroll
          for (int j = 0; j < 8; ++j) { Lt[j] = Ef[tok * 64 + ch0 + j]; Lm[j] = tok > 0 ? Ef[(tok - 1) * 64 + ch0 + j] : 0.f; Lc[j] = Ef[63 * 64 + ch0 + j]; al[j] = ALf[tok * 64 + ch0 + j]; }
          float kk[8], km[8]; float ss = 0.f, bs_ = 0.f;
#pragma unroll
          for (int j = 0; j < 8; ++j) { kk[j] = kx[j] * W.k_k[hc0 + j]; ss += kk[j] * kk[j]; km[j] = kx[j] * (1.f + (al[j] - 1.f) * W.k_a[hc0 + j]); bs_ += rr[j] * km[j] * W.r_k[hc0 + j]; }
          ss += __shfl_xor(ss, 1); ss += __shfl_xor(ss, 2); ss += __shfl_xor(ss, 4); bs_ += __shfl_xor(bs_, 1); bs_ += __shfl_xor(bs_, 2); bs_ += __shfl_xor(bs_, 4);
          const float inv = 1.f / fmaxf(sqrtf(ss), 1e-12f);
          if (cg == 0) Sc.Sbsc[row * NH + h] = bs_;
          float oA[8], oB[8], oK[8], oR[8], oBh[8], oKh[8];
#pragma unroll
          for (int j = 0; j < 8; ++j) { const float kn = kk[j] * inv, bb = kn * al[j]; const float einv = __expf(-Lt[j]), ec = __expf(Lc[j] - Lt[j]);
              oA[j] = -kn * __expf(Lm[j]); oB[j] = bb * einv; oK[j] = km[j] * einv; oR[j] = rr[j] * __expf(Lt[j]); oBh[j] = bb * ec; oKh[j] = km[j] * ec; }
          *(LAS u32x4*)(At + tok * 72 + ch0) = pack8(oA); *(LAS u32x4*)(Bt + tok * 72 + ch0) = pack8(oB); *(LAS u32x4*)(Kt + tok * 72 + ch0) = pack8(oK); *(LAS u32x4*)(Rt + tok * 72 + ch0) = pack8(oR);
          *(LAS u32x4*)(Bh + tok * 72 + ch0) = pack8(oBh); *(LAS u32x4*)(Kh + tok * 72 + ch0) = pack8(oKh); *(LAS u32x4*)(Vt + tok * 72 + ch0) = pack8(vv);
          if (tok == 63) { for (int j = 0; j < 8; ++j) GAM[ch0 + j] = __expf(Lc[j]); } }
        __syncthreads();
        for (int i5 = 0; i5 < 5; ++i5) { const int q = w + 8 * i5, mat = q / 10, idx = q % 10; const int ti = idx < 1 ? 0 : (idx < 3 ? 1 : (idx < 6 ? 2 : 3)), si = idx - ti * (ti + 1) / 2;
            const LAS bf16* X = mat < 2 ? At : Rt; const LAS bf16* Yk = (mat & 1) ? Kt : Bt; LAS bf16* O = Lab + mat * 64 * 72;
            f32x4 acc = {0.f, 0.f, 0.f, 0.f};
#pragma unroll
            for (int ks = 0; ks < 2; ++ks) acc = MFMA32(lds_row8(Yk, 72, 16 * si, 32 * ks, lane), lds_row8(X, 72, 16 * ti, 32 * ks, lane), acc);
            const int t = 16 * ti + l15, s0 = 16 * si + 4 * g;
#pragma unroll
            for (int r = 0; r < 4; ++r) { const bool keep = mat < 2 ? (s0 + r < t) : (s0 + r <= t); if (!keep) acc[r] = 0.f; }
            *(LAS s16x4*)(O + t * 72 + s0) = pack4(acc);
            if (mat == 0 && ti == si) *(LAS f32x4*)(Dd + ti * 256 + l15 * 16 + 4 * g) = acc; }
        __syncthreads();
        if (w == 7) { const int i = lane >> 4, cc = lane & 15; const LAS float* Db = Dd + i * 256; float tv[16];
#pragma unroll
            for (int r = 0; r < 16; ++r) { float sum = (r == cc) ? 1.f : 0.f;
#pragma unroll
                for (int s2 = 0; s2 < r; ++s2) sum += Db[r * 16 + s2] * tv[s2];
                tv[r] = sum; }
#pragma unroll
            for (int r = 0; r < 16; ++r) Tt[i * 256 + r * 16 + cc] = (bf16)f2bf(tv[r]); }
        __syncthreads();
        { const bool isU = w < 4; const int cw = w & 3;
          f32x4 X[4];
#pragma unroll
          for (int i = 0; i < 4; ++i) { f32x4 z = {0.f, 0.f, 0.f, 0.f};
              if (isU) {
#pragma unroll
                  for (int j = 0; j <= i; ++j) z = MFMA16(lds_row4(Lak, 72, 16 * i, 16 * j, lane), lds_tr4(Vt, 72, 16 * j, 16 * cw, lane), z);
              } else z = unpack4(lds_tr4(At, 72, 16 * i, 16 * cw, lane));
#pragma unroll
              for (int j = 0; j < i; ++j) z = MFMA16(lds_row4(Lab, 72, 16 * i, 16 * j, lane), pack4(X[j]), z);
              const f32x4 zero = {0.f, 0.f, 0.f, 0.f};
              X[i] = MFMA16(lds_row4(Tt + i * 256, 16, 0, 0, lane), pack4(z), zero); }
          s16x4 Xp[4];
#pragma unroll
          for (int i = 0; i < 4; ++i) Xp[i] = pack4(X[i]);
          if (isU) {
#pragma unroll
              for (int nt = 0; nt < 4; ++nt) { f32x4 acc = {0.f, 0.f, 0.f, 0.f};
#pragma unroll
                  for (int i = 0; i < 4; ++i) { acc = MFMA16(Xp[i], lds_tr4(Bh, 72, 16 * i, 16 * nt, lane), acc); acc = MFMA16(lds_tr4(Vt, 72, 16 * i, 16 * cw, lane), lds_tr4(Kh, 72, 16 * i, 16 * nt, lane), acc); }
                  *(s16x4*)(Sc.SH + uh + (size_t)(16 * nt + l15) * 64 + 16 * cw + 4 * g) = pack4(acc); }
#pragma unroll
              for (int mt = 0; mt < 4; ++mt) { f32x4 acc = {0.f, 0.f, 0.f, 0.f};
#pragma unroll
                  for (int i = 0; i <= mt; ++i) { acc = MFMA16(lds_row4(Mrb, 72, 16 * mt, 16 * i, lane), Xp[i], acc); acc = MFMA16(lds_row4(Mrk, 72, 16 * mt, 16 * i, lane), lds_tr4(Vt, 72, 16 * i, 16 * cw, lane), acc); }
                  *(s16x4*)(Sc.SY0 + uh + (size_t)(16 * cw + l15) * 64 + 16 * mt + 4 * g) = pack4(acc); }
          } else {
              const float gamv = GAM[16 * cw + l15];
#pragma unroll
              for (int nt = 0; nt < 4; ++nt) { f32x4 acc = {0.f, 0.f, 0.f, 0.f};
#pragma unroll
                  for (int i = 0; i < 4; ++i) acc = MFMA16(Xp[i], lds_tr4(Bh, 72, 16 * i, 16 * nt, lane), acc);
                  { const float gam = (nt == cw) ? gamv : 0.f;
#pragma unroll
                      for (int r = 0; r < 4; ++r) acc[r] += (l15 == 4 * g + r) ? gam : 0.f; }
                  *(s16x4*)(Sc.SG + uh + (size_t)(16 * nt + l15) * 64 + 16 * cw + 4 * g) = pack4(acc); }
#pragma unroll
              for (int mt = 0; mt < 4; ++mt) { f32x4 acc = unpack4(lds_tr4(Rt, 72, 16 * mt, 16 * cw, lane));
#pragma unroll
                  for (int i = 0; i <= mt; ++i) acc = MFMA16(lds_row4(Mrb, 72, 16 * mt, 16 * i, lane), Xp[i], acc);
                  *(s16x4*)(Sc.SQ + uh + (size_t)(16 * cw + l15) * 64 + 16 * mt + 4 * g) = pack4(acc); }
          } }
        __syncthreads();
    }
}

constexpr int M1V_LI = 0;
constexpr int M1V_PR = 33792;
constexpr int M1V_TL = M1V_PR + 36864;
constexpr int M1V_SEG = M1V_TL + 5 * 9216;
constexpr int M1V_GAM = M1V_SEG + 2048;
constexpr int M1V_CST = M1V_GAM + 256;
constexpr int M1V_END = M1V_CST + 8 * 2048;
static_assert(M1V_END <= MISC_OFF, "M1 v2 LDS map");
__device__ __forceinline__ void rwkv_m1_consts(Frame& F, const RwkvW& W) {
    LAS float* CST = (LAS float*)(F.lds + M1V_CST);
    for (int i = F.tid; i < 1536; i += 512) CST[i] = W.mu[i];
    CST[3 * 512 + F.tid] = W.k_k[F.tid]; CST[4 * 512 + F.tid] = W.k_a[F.tid]; CST[5 * 512 + F.tid] = W.r_k[F.tid]; CST[6 * 512 + F.tid] = W.w0[F.tid]; CST[7 * 512 + F.tid] = W.a0[F.tid];
    __syncthreads();
}
__device__ __forceinline__ void rwkv_m1v2_unit(Frame& F, int unit  , const bf16* P, const RwkvW& W, const RwkvS& Sc) {
    const int b = unit >> 6, c = unit & 63, t0 = c * 64; const size_t row0 = (size_t)b * SEQ + t0;
    const int w = F.wave, lane = F.lane, l15 = lane & 15, g = lane >> 4;
    LAS bf16* LI = (LAS bf16*)(F.lds + M1V_LI);
    LAS float* Ef = (LAS float*)(F.lds + M1V_PR); constexpr int ES = 68; LAS float* ALf = Ef + 64 * ES;
    LAS bf16* Lab = (LAS bf16*)(F.lds + M1V_PR); LAS bf16* Lak = Lab + 64 * 72; LAS bf16* Mrb = Lak + 64 * 72; LAS bf16* Mrk = Mrb + 64 * 72;
    LAS bf16* At = (LAS bf16*)(F.lds + M1V_TL); LAS bf16* Bt = At + 64 * 72; LAS bf16* Kt = Bt + 64 * 72; LAS bf16* Rt = Kt + 64 * 72; LAS bf16* Vt = Rt + 64 * 72;
    LAS float* SEG = (LAS float*)(F.lds + M1V_SEG); LAS float* GAM = (LAS float*)(F.lds + M1V_GAM); const LAS float* CST = (const LAS float*)(F.lds + M1V_CST);
    bf16x8 wfw[2], wfa[2], wfg[4]; u32x4 pfc[3], pfp[3];
    const int ea_mt = w & 3, ea_ntb = 2 * (w >> 2);
    const int eb_tok = F.tid >> 3, eb_cg = F.tid & 7; const size_t eb_row = row0 + eb_tok; const bool eb_prev = (t0 + eb_tok) > 0;
#define M1_LOAD_W(hh) do { const int chrow_ = (hh) * HD + 16 * ea_mt + l15; \
        wfw[0] = *(const bf16x8*)(W.WupT + (size_t)chrow_ * 64 + 8 * g); wfw[1] = *(const bf16x8*)(W.WupT + (size_t)chrow_ * 64 + 32 + 8 * g); \
        wfa[0] = *(const bf16x8*)(W.AupT + (size_t)chrow_ * 64 + 8 * g); wfa[1] = *(const bf16x8*)(W.AupT + (size_t)chrow_ * 64 + 32 + 8 * g); \
        _Pragma("unroll") for (int ks_ = 0; ks_ < 4; ++ks_) wfg[ks_] = *(const bf16x8*)(W.GupT + (size_t)chrow_ * 128 + 32 * ks_ + 8 * g); } while (0)
#define M1_LOAD_P(hh) do { const int hc_ = (hh) * HD + 8 * eb_cg; \
        _Pragma("unroll") for (int a_ = 0; a_ < 3; ++a_) { pfc[a_] = *(const u32x4*)(P + eb_row * INW + 1024 + 512 * a_ + hc_); \
            if (eb_prev) pfp[a_] = *(const u32x4*)(P + (eb_row - 1) * INW + 1024 + 512 * a_ + hc_); else pfp[a_] = (u32x4){0u, 0u, 0u, 0u}; } } while (0)
#pragma unroll
    for (int it = 0; it < 4; ++it) { const int item = F.tid + 512 * it, tok = item >> 5, jc = item & 31, j0 = 8 * jc; const size_t row = row0 + tok;
        float cv[8], pv[8]; unpack8(*(const u32x4*)(P + row * INW + 2560 + j0), cv);
        if (t0 + tok > 0) unpack8(*(const u32x4*)(P + (row - 1) * INW + 2560 + j0), pv); else { for (int j = 0; j < 8; ++j) pv[j] = 0.f; }
        const f32x4 m0 = *(const f32x4*)(W.mu + 1536 + j0), m1 = *(const f32x4*)(W.mu + 1536 + j0 + 4); float o[8];
#pragma unroll
        for (int j = 0; j < 8; ++j) { const float x = cv[j] + (pv[j] - cv[j]) * (j < 4 ? m0[j] : m1[j - 4]); o[j] = jc < 8 ? fast_tanh(x) : (jc < 16 ? x : sigmoidf_(x)); }
        *(LAS u32x4*)(LI + tok * 264 + j0) = pack8(o); }
    LDS_BARRIER();
    const int rp_ea = (PROBE_STAGE == 1) ? 2 - (F.G > 100000) : 1, rp_eb = (PROBE_STAGE == 2) ? 2 - (F.G > 100000) : 1, rp_p1 = (PROBE_STAGE == 3) ? 2 - (F.G > 100000) : 1, rp_ch = (PROBE_STAGE == 4) ? 2 - (F.G > 100000) : 1, rp_cs = (PROBE_STAGE == 5) ? 2 - (F.G > 100000) : 1;
    for (int hi_ = 0; hi_ < NH; ++hi_) { const int h = (hi_ + (int)blockIdx.x) & (NH - 1);
        const size_t uh = ((size_t)unit * NH + h) * 4096;
        for (int rp = 0; rp < rp_ea; ++rp) { M1_LOAD_W(h);
          f32x4 aw[2] = {{0.f, 0.f, 0.f, 0.f}, {0.f, 0.f, 0.f, 0.f}}, aa[2] = {{0.f, 0.f, 0.f, 0.f}, {0.f, 0.f, 0.f, 0.f}}, ag[2] = {{0.f, 0.f, 0.f, 0.f}, {0.f, 0.f, 0.f, 0.f}};
#pragma unroll
          for (int ks = 0; ks < 2; ++ks)
#pragma unroll
              for (int q = 0; q < 2; ++q) { aw[q] = MFMA32(wfw[ks], lds_row8(LI, 264, 16 * (ea_ntb + q), 32 * ks, lane), aw[q]); aa[q] = MFMA32(wfa[ks], lds_row8(LI, 264, 16 * (ea_ntb + q), 64 + 32 * ks, lane), aa[q]); }
#pragma unroll
          for (int ks = 0; ks < 4; ++ks)
#pragma unroll
              for (int q = 0; q < 2; ++q) ag[q] = MFMA32(wfg[ks], lds_row8(LI, 264, 16 * (ea_ntb + q), 128 + 32 * ks, lane), ag[q]);
          const int ch0 = 16 * ea_mt + 4 * g; const f32x4 w0v = *(const LAS f32x4*)(CST + 6 * 512 + h * HD + ch0), a0v = *(const LAS f32x4*)(CST + 7 * 512 + h * HD + ch0);
#pragma unroll
          for (int q = 0; q < 2; ++q) { const int tok = 16 * (ea_ntb + q) + l15; f32x4 ev, av;
#pragma unroll
              for (int r = 0; r < 4; ++r) { ev[r] = -0.60653066f * __builtin_amdgcn_rcpf(1.f + __expf(-(aw[q][r] + w0v[r]))); av[r] = __builtin_amdgcn_rcpf(1.f + __expf(-(aa[q][r] + a0v[r]))); }
              *(LAS f32x4*)(Ef + tok * ES + ch0) = ev; *(LAS f32x4*)(ALf + tok * ES + ch0) = av;
              u32x2 gw; gw.x = cvtpk_c(ag[q][0], ag[q][1]); gw.y = cvtpk_c(ag[q][2], ag[q][3]); *(u32x2*)(Sc.Sg + (row0 + tok) * RWW + h * HD + ch0) = gw; } }
        LDS_BARRIER();
        for (int rp = 0; rp < rp_cs; ++rp) {
        { const int ch = F.tid & 63, seg = F.tid >> 6; float run = 0.f;
#pragma unroll
          for (int i = 0; i < 8; ++i) { run += Ef[(8 * seg + i) * ES + ch]; Ef[(8 * seg + i) * ES + ch] = run; }
          SEG[seg * 64 + ch] = run; }
        LDS_BARRIER();
        { const int ch = F.tid & 63, seg = F.tid >> 6; float off = 0.f;
          for (int s2 = 0; s2 < seg; ++s2) off += SEG[s2 * 64 + ch];
#pragma unroll
          for (int i = 0; i < 8; ++i) Ef[(8 * seg + i) * ES + ch] += off; }
        LDS_BARRIER();
        }
        for (int rp = 0; rp < rp_eb; ++rp) { const int tok = eb_tok, ch0 = 8 * eb_cg, hc0 = h * HD + ch0;
          float rr[8], kx[8], vv[8], pr[8];
#define M1_SHIFT(dst, a_) do { unpack8(pfc[a_], dst); unpack8(pfp[a_], pr); const f32x4 m0 = *(const LAS f32x4*)(CST + (a_) * 512 + hc0), m1 = *(const LAS f32x4*)(CST + (a_) * 512 + hc0 + 4); \
              _Pragma("unroll") for (int j = 0; j < 8; ++j) dst[j] = dst[j] + (pr[j] - dst[j]) * (j < 4 ? m0[j] : m1[j - 4]); } while (0)
          M1_LOAD_P(h); M1_SHIFT(rr, 0); M1_SHIFT(kx, 1); M1_SHIFT(vv, 2);
          float Lt[8], Lm[8], al[8], ckk[8], cka[8], crk[8];
#pragma unroll
          for (int j = 0; j < 8; ++j) { Lt[j] = Ef[tok * ES + ch0 + j]; Lm[j] = tok > 0 ? Ef[(tok - 1) * ES + ch0 + j] : 0.f; al[j] = ALf[tok * ES + ch0 + j]; ckk[j] = CST[3 * 512 + hc0 + j]; cka[j] = CST[4 * 512 + hc0 + j]; crk[j] = CST[5 * 512 + hc0 + j]; }
          float kk[8], km[8]; float ss = 0.f, bs_ = 0.f;
#pragma unroll
          for (int j = 0; j < 8; ++j) { kk[j] = kx[j] * ckk[j]; ss += kk[j] * kk[j]; km[j] = kx[j] * (1.f + (al[j] - 1.f) * cka[j]); bs_ += rr[j] * km[j] * crk[j]; }
          ss += __shfl_xor(ss, 1); ss += __shfl_xor(ss, 2); ss += __shfl_xor(ss, 4); bs_ += __shfl_xor(bs_, 1); bs_ += __shfl_xor(bs_, 2); bs_ += __shfl_xor(bs_, 4);
          const float inv = 1.f / fmaxf(sqrtf(ss), 1e-12f);
          if (eb_cg == 0) Sc.Sbsc[eb_row * NH + h] = bs_;
          float oA[8], oB[8], oK[8], oR[8];
#pragma unroll
          for (int j = 0; j < 8; ++j) { const float kn = kk[j] * inv, bb = kn * al[j]; const float eL = __expf(Lt[j]), einv = __builtin_amdgcn_rcpf(eL);
              oA[j] = -kn * __expf(Lm[j]); oB[j] = bb * einv; oK[j] = km[j] * einv; oR[j] = rr[j] * eL; if (tok == 63) GAM[ch0 + j] = eL; }
          *(LAS u32x4*)(At + tok * 72 + ch0) = pack8(oA); *(LAS u32x4*)(Bt + tok * 72 + ch0) = pack8(oB); *(LAS u32x4*)(Kt + tok * 72 + ch0) = pack8(oK); *(LAS u32x4*)(Rt + tok * 72 + ch0) = pack8(oR);
          *(LAS u32x4*)(Vt + tok * 72 + ch0) = pack8(vv); }
        LDS_BARRIER();
        for (int rp = 0; rp < rp_p1; ++rp) for (int i5 = 0; i5 < 5; ++i5) { const int q = w + 8 * i5, mat = q / 10, idx = q % 10; const int ti = idx < 1 ? 0 : (idx < 3 ? 1 : (idx < 6 ? 2 : 3)), si = idx - ti * (ti + 1) / 2;
            const LAS bf16* X = mat < 2 ? At : Rt; const LAS bf16* Yk = (mat & 1) ? Kt : Bt; LAS bf16* O = Lab + mat * 64 * 72;
            f32x4 acc = {0.f, 0.f, 0.f, 0.f};
#pragma unroll
            for (int ks = 0; ks < 2; ++ks) acc = MFMA32(lds_row8(Yk, 72, 16 * si, 32 * ks, lane), lds_row8(X, 72, 16 * ti, 32 * ks, lane), acc);
            const int t = 16 * ti + l15, s0 = 16 * si + 4 * g; const int lim = mat < 2 ? t : t + 1;
#pragma unroll
            for (int r = 0; r < 4; ++r) acc[r] = (s0 + r < lim) ? acc[r] : 0.f;
            *(LAS s16x4*)(O + t * 72 + s0) = pack4(acc); }
        LDS_BARRIER();
        for (int rp = 0; rp < rp_ch; ++rp) { const bool isU = w < 4; const int cw = w & 3; const f32x4 zero = {0.f, 0.f, 0.f, 0.f};
          s16x4 TTp[4];
#pragma unroll
          for (int hb = 0; hb < 2; ++hb) { s16x4 fr[2], ft[2];
#pragma unroll
            for (int i = 0; i < 2; ++i) { fr[i] = lds_row4(Lab, 72, 16 * (2 * hb + i), 16 * (2 * hb + i), lane); ft[i] = lds_tr4(Lab, 72, 16 * (2 * hb + i), 16 * (2 * hb + i), lane); }
            f32x4 L2[2], L2T[2], L4[2], L4T[2], L8[2], TT[2]; s16x4 pL2[2], pL2T[2], pL4[2], pL4T[2];
#pragma unroll
            for (int i = 0; i < 2; ++i) { L2[i] = MFMA16(fr[i], ft[i], zero); L2T[i] = MFMA16(ft[i], fr[i], zero); }
#pragma unroll
            for (int i = 0; i < 2; ++i) { pL2[i] = pack4(L2[i]); pL2T[i] = pack4(L2T[i]); TT[i] = unpack4(fr[i]);
#pragma unroll
                for (int r = 0; r < 4; ++r) TT[i][r] += (l15 == 4 * g + r) ? 1.f : 0.f; }
#pragma unroll
            for (int i = 0; i < 2; ++i) { L4[i] = MFMA16(pL2T[i], pL2[i], zero); L4T[i] = MFMA16(pL2[i], pL2T[i], zero); TT[i] = MFMA16(pL2[i], pack4(TT[i]), TT[i]); }
#pragma unroll
            for (int i = 0; i < 2; ++i) { pL4[i] = pack4(L4[i]); pL4T[i] = pack4(L4T[i]); }
#pragma unroll
            for (int i = 0; i < 2; ++i) { L8[i] = MFMA16(pL4T[i], pL4[i], zero); TT[i] = MFMA16(pL4[i], pack4(TT[i]), TT[i]); }
#pragma unroll
            for (int i = 0; i < 2; ++i) { TT[i] = MFMA16(pack4(L8[i]), pack4(TT[i]), TT[i]); TTp[2 * hb + i] = pack4(TT[i]); } }
          s16x4 Vf[4]; f32x4 z[4];
          if (isU) { s16x4 lk[10];
#pragma unroll
              for (int j = 0; j < 4; ++j) Vf[j] = lds_tr4(Vt, 72, 16 * j, 16 * cw, lane);
#pragma unroll
              for (int i = 0; i < 4; ++i)
#pragma unroll
                  for (int j = 0; j <= i; ++j) lk[i * (i + 1) / 2 + j] = lds_row4(Lak, 72, 16 * i, 16 * j, lane);
#pragma unroll
              for (int i = 0; i < 4; ++i) { z[i] = zero;
#pragma unroll
                  for (int j = 0; j <= i; ++j) z[i] = MFMA16(lk[i * (i + 1) / 2 + j], Vf[j], z[i]); }
          } else {
#pragma unroll
              for (int i = 0; i < 4; ++i) { Vf[i] = (s16x4){0, 0, 0, 0}; z[i] = unpack4(lds_tr4(At, 72, 16 * i, 16 * cw, lane)); } }
          s16x4 Xp[4];
          { s16x4 lb[6];
#pragma unroll
            for (int i = 1; i < 4; ++i)
#pragma unroll
                for (int j = 0; j < i; ++j) lb[i * (i - 1) / 2 + j] = lds_row4(Lab, 72, 16 * i, 16 * j, lane);
#pragma unroll
            for (int i = 0; i < 4; ++i) { f32x4 zz = z[i];
#pragma unroll
                for (int j = 0; j < i; ++j) zz = MFMA16(lb[i * (i - 1) / 2 + j], Xp[j], zz);
                Xp[i] = pack4(MFMA16(TTp[i], pack4(zz), zero)); } }
          if (isU) {
#pragma unroll
              for (int nt = 0; nt < 4; ++nt) { s16x4 bf_[4], kf_[4];
#pragma unroll
                  for (int i = 0; i < 4; ++i) { bf_[i] = lds_tr4(Bt, 72, 16 * i, 16 * nt, lane); kf_[i] = lds_tr4(Kt, 72, 16 * i, 16 * nt, lane); }
                  f32x4 a1 = zero, a2 = zero;
#pragma unroll
                  for (int i = 0; i < 4; ++i) { a1 = MFMA16(Xp[i], bf_[i], a1); a2 = MFMA16(Vf[i], kf_[i], a2); }
                  const float gm = GAM[16 * nt + l15]; const f32x4 acc = (a1 + a2) * gm;
                  *(s16x4*)(Sc.SH + uh + (size_t)(16 * nt + l15) * 64 + 16 * cw + 4 * g) = pack4(acc); }
#pragma unroll
              for (int mt = 0; mt < 4; ++mt) { s16x4 mb[4], mk[4];
#pragma unroll
                  for (int i = 0; i <= mt; ++i) { mb[i] = lds_row4(Mrb, 72, 16 * mt, 16 * i, lane); mk[i] = lds_row4(Mrk, 72, 16 * mt, 16 * i, lane); }
                  f32x4 a1 = zero, a2 = zero;
#pragma unroll
                  for (int i = 0; i <= mt; ++i) { a1 = MFMA16(mb[i], Xp[i], a1); a2 = MFMA16(mk[i], Vf[i], a2); }
                  *(s16x4*)(Sc.SY0 + uh + (size_t)(16 * cw + l15) * 64 + 16 * mt + 4 * g) = pack4(a1 + a2); }
          } else {
#pragma unroll
              for (int nt = 0; nt < 4; ++nt) { s16x4 bf_[4];
#pragma unroll
                  for (int i = 0; i < 4; ++i) bf_[i] = lds_tr4(Bt, 72, 16 * i, 16 * nt, lane);
                  f32x4 a1 = zero, a2 = zero;
                  a1 = MFMA16(Xp[0], bf_[0], a1); a2 = MFMA16(Xp[1], bf_[1], a2); a1 = MFMA16(Xp[2], bf_[2], a1); a2 = MFMA16(Xp[3], bf_[3], a2);
                  f32x4 acc = a1 + a2; const float gm = GAM[16 * nt + l15]; const float dg = (nt == cw) ? 1.f : 0.f;
#pragma unroll
                  for (int r = 0; r < 4; ++r) acc[r] = (acc[r] + ((l15 == 4 * g + r) ? dg : 0.f)) * gm;
                  *(s16x4*)(Sc.SG + uh + (size_t)(16 * nt + l15) * 64 + 16 * cw + 4 * g) = pack4(acc); }
#pragma unroll
              for (int mt = 0; mt < 4; ++mt) { s16x4 mb[4]; const s16x4 rf = lds_tr4(Rt, 72, 16 * mt, 16 * cw, lane);
#pragma unroll
                  for (int i = 0; i <= mt; ++i) mb[i] = lds_row4(Mrb, 72, 16 * mt, 16 * i, lane);
                  f32x4 acc = unpack4(rf);
#pragma unroll
                  for (int i = 0; i <= mt; ++i) acc = MFMA16(mb[i], Xp[i], acc);
                  *(s16x4*)(Sc.SQ + uh + (size_t)(16 * cw + l15) * 64 + 16 * mt + 4 * g) = pack4(acc); }
          } }
        LDS_BARRIER();
    }
#undef M1_LOAD_W
#undef M1_LOAD_P
#undef M1_SHIFT
}

constexpr int M2_S = 0;
__device__ __forceinline__ void rwkv_m2_unit(Frame& F, int unit  , const RwkvS& Sc) {
    const int b = unit >> 3, h = unit & 7; const int w = F.wave, lane = F.lane, l15 = lane & 15, g = lane >> 4; const int mt = w >> 1, ntb = 2 * (w & 1);
    LAS bf16* Sb = (LAS bf16*)(F.lds + M2_S);
    f32x4 acc[2] = {{0.f, 0.f, 0.f, 0.f}, {0.f, 0.f, 0.f, 0.f}};
    constexpr int PF = 8;
    bf16x8 Gf[PF][2][2]; u32x2 Hf[PF][2];
#define M2_LOAD(slot, cc) do { const size_t uh_ = ((size_t)(b * 64 + (cc)) * NH + h) * 4096; _Pragma("unroll") for (int q = 0; q < 2; ++q) { const size_t ro = uh_ + (size_t)(16 * (ntb + q) + l15) * 64; \
        Gf[slot][q][0] = *(const bf16x8*)(Sc.SG + ro + 8 * g); Gf[slot][q][1] = *(const bf16x8*)(Sc.SG + ro + 32 + 8 * g); Hf[slot][q] = *(const u32x2*)(Sc.SH + ro + 16 * mt + 4 * g); } } while (0)
#pragma unroll
    for (int u = 0; u < PF; ++u) M2_LOAD(u, u);
    for (int c0 = 0; c0 < 64; c0 += PF) {
#pragma unroll
        for (int u = 0; u < PF; ++u) { const int c = c0 + u;
            const size_t uh = ((size_t)(b * 64 + c) * NH + h) * 4096; LAS bf16* buf = Sb + (u & 1) * 64 * 72;
#pragma unroll
            for (int q = 0; q < 2; ++q) { const s16x4 p = pack4(acc[q]); *(LAS s16x4*)(buf + (16 * (ntb + q) + l15) * 72 + 16 * mt + 4 * g) = p; *(s16x4*)(Sc.SS + uh + (size_t)(16 * (ntb + q) + l15) * 64 + 16 * mt + 4 * g) = p; }
            LDS_BARRIER();
            const bf16x8 a0 = lds_tr8(buf, 72, 0, 16 * mt, lane), a1 = lds_tr8(buf, 72, 32, 16 * mt, lane);
#pragma unroll
            for (int q = 0; q < 2; ++q) { f32x4 z; z[0] = __builtin_bit_cast(float, Hf[u][q].x << 16); z[1] = __builtin_bit_cast(float, Hf[u][q].x & 0xffff0000u); z[2] = __builtin_bit_cast(float, Hf[u][q].y << 16); z[3] = __builtin_bit_cast(float, Hf[u][q].y & 0xffff0000u);
                z = MFMA32(a0, Gf[u][q][0], z); acc[q] = MFMA32(a1, Gf[u][q][1], z); }
            { const int cn = c + PF < 64 ? c + PF : 63; M2_LOAD(u, cn); } }
    }
#undef M2_LOAD
    LDS_BARRIER();
}

constexpr int M3_SLOT = 9216 * 2 + 64 * 68 * 4;
__device__ __forceinline__ void rwkv_m3_unit(Frame& F, int unit  , const bf16* P, bf16* Y, const RwkvW& W, const RwkvS& Sc) {
    const int b = unit >> 6, c = unit & 63, t0 = c * 64; const size_t row0 = (size_t)b * SEQ + t0;
    const int w = F.wave, lane = F.lane, l15 = lane & 15, g = lane >> 4, hw = w >> 2, mt = w & 3, tl = F.tid & 255;
    LAS bf16* Qt = (LAS bf16*)(F.lds + hw * M3_SLOT); LAS bf16* St = Qt + 64 * 72; LAS float* Out = (LAS float*)(F.lds + hw * M3_SLOT + 2 * 9216);
    for (int hp = 0; hp < 4; ++hp) { const int h = 2 * hp + hw; const size_t uh = ((size_t)unit * NH + h) * 4096;
#pragma unroll
        for (int r = 0; r < 2; ++r) { const int off = 8 * (tl + 256 * r), rr = off >> 6, cc = off & 63;
            *(LAS u32x4*)(Qt + rr * 72 + cc) = *(const u32x4*)(Sc.SQ + uh + off); *(LAS u32x4*)(St + rr * 72 + cc) = *(const u32x4*)(Sc.SS + uh + off); }
        LDS_BARRIER();
        f32x4 acc[4];
#pragma unroll
        for (int nt = 0; nt < 4; ++nt) acc[nt] = unpack4(*(const s16x4*)(Sc.SY0 + uh + (size_t)(16 * nt + l15) * 64 + 16 * mt + 4 * g));
#pragma unroll
        for (int ks = 0; ks < 2; ++ks) { const bf16x8 a = lds_tr8(Qt, 72, 32 * ks, 16 * mt, lane);
#pragma unroll
            for (int nt = 0; nt < 4; ++nt) acc[nt] = MFMA32(a, lds_tr8(St, 72, 32 * ks, 16 * nt, lane), acc[nt]); }
#pragma unroll
        for (int r = 0; r < 4; ++r) { float s = (acc[0][r] + acc[1][r]) + (acc[2][r] + acc[3][r]);
            s += __shfl_xor(s, 1); s += __shfl_xor(s, 2); s += __shfl_xor(s, 4); s += __shfl_xor(s, 8); const float mean = s * (1.f / HD); float q = 0.f;
#pragma unroll
            for (int nt = 0; nt < 4; ++nt) { const float d = acc[nt][r] - mean; q += d * d; }
            q += __shfl_xor(q, 1); q += __shfl_xor(q, 2); q += __shfl_xor(q, 4); q += __shfl_xor(q, 8); const float rstd = __builtin_amdgcn_rsqf(q * (1.f / HD) + GN_EPS);
#pragma unroll
            for (int nt = 0; nt < 4; ++nt) { const int v = 16 * nt + l15; Out[(16 * mt + 4 * g + r) * 68 + v] = (acc[nt][r] - mean) * rstd * W.lnx_w[h * HD + v] + W.lnx_b[h * HD + v]; } }
        LDS_BARRIER();
        { const int t = tl >> 2, cq = tl & 3, v0 = 16 * cq, hv0 = h * HD + v0; const size_t row = row0 + t; const bool has_prev = (t0 + t) > 0; const float bsc = Sc.Sbsc[row * NH + h];
#pragma unroll
          for (int half = 0; half < 2; ++half) { float cv[8], pv[8], gv[8], o[8]; const int col = 2048 + hv0 + 8 * half;
              unpack8(*(const u32x4*)(P + row * INW + col), cv); if (has_prev) unpack8(*(const u32x4*)(P + (row - 1) * INW + col), pv); else { for (int j = 0; j < 8; ++j) pv[j] = 0.f; }
              unpack8(*(const u32x4*)(Sc.Sg + row * RWW + hv0 + 8 * half), gv);
              const f32x4 m0 = *(const f32x4*)(W.mu + col - 1024), m1 = *(const f32x4*)(W.mu + col - 1024 + 4);
#pragma unroll
              for (int j = 0; j < 8; ++j) { const float vs = cv[j] + (pv[j] - cv[j]) * (j < 4 ? m0[j] : m1[j - 4]); o[j] = (Out[t * 68 + v0 + 8 * half + j] + bsc * vs) * gv[j]; }
              *(u32x4*)(Y + row * D + GMW + hv0 + 8 * half) = pack8(o); } }
        LDS_BARRIER();
    }
}


__device__ __forceinline__ void rwkv_m3_units(Frame& F, int u0, int ustep, int nunits, const bf16* P, bf16* Y, const RwkvW& W, const RwkvS& Sc) {
    if (u0 >= nunits) return;
    const int w = F.wave, lane = F.lane, l15 = lane & 15, g = lane >> 4, hw = w >> 2, mt = w & 3, tl = F.tid & 255;
    LAS bf16* Qt = (LAS bf16*)(F.lds + hw * M3_SLOT); LAS bf16* St = Qt + 64 * 72; LAS float* Out = (LAS float*)(F.lds + hw * M3_SLOT + 2 * 9216);
    const int nu = (nunits - u0 + ustep - 1) / ustep, niter = nu * 4;
    u32x4 qf[2], sf[2]; s16x4 y0f[4];
#define M3_PREF(itn) do { const int un_ = u0 + ((itn) >> 2) * ustep, hn_ = 2 * ((itn) & 3) + hw; const size_t uhn_ = ((size_t)un_ * NH + hn_) * 4096; \
        _Pragma("unroll") for (int r = 0; r < 2; ++r) { qf[r] = *(const u32x4*)(Sc.SQ + uhn_ + 8 * (tl + 256 * r)); sf[r] = *(const u32x4*)(Sc.SS + uhn_ + 8 * (tl + 256 * r)); } \
        _Pragma("unroll") for (int nt = 0; nt < 4; ++nt) y0f[nt] = *(const s16x4*)(Sc.SY0 + uhn_ + (size_t)(16 * nt + l15) * 64 + 16 * mt + 4 * g); } while (0)
    M3_PREF(0);
    for (int it = 0; it < niter; ++it) {
        const int unit = u0 + (it >> 2) * ustep, h = 2 * (it & 3) + hw; const int b = unit >> 6, c = unit & 63, t0 = c * 64; const size_t row0 = (size_t)b * SEQ + t0;
#pragma unroll
        for (int r = 0; r < 2; ++r) { const int off = 8 * (tl + 256 * r), rr = off >> 6, cc = off & 63; *(LAS u32x4*)(Qt + rr * 72 + cc) = qf[r]; *(LAS u32x4*)(St + rr * 72 + cc) = sf[r]; }
        f32x4 acc[4];
#pragma unroll
        for (int nt = 0; nt < 4; ++nt) acc[nt] = unpack4(y0f[nt]);
        const int t = tl >> 2, cq = tl & 3, v0 = 16 * cq, hv0 = h * HD + v0; const size_t row = row0 + t; const bool has_prev = (t0 + t) > 0;
        u32x4 cvr[2], pvr[2], gvr[2]; const float bsc = Sc.Sbsc[row * NH + h];
#pragma unroll
        for (int half = 0; half < 2; ++half) { const int col = 2048 + hv0 + 8 * half; cvr[half] = *(const u32x4*)(P + row * INW + col);
            pvr[half] = *(const u32x4*)(P + (has_prev ? row - 1 : row) * INW + col); gvr[half] = *(const u32x4*)(Sc.Sg + row * RWW + hv0 + 8 * half); }
        { const int itn = it + 1 < niter ? it + 1 : it; M3_PREF(itn); }
        LDS_BARRIER();
#pragma unroll
        for (int ks = 0; ks < 2; ++ks) { const bf16x8 a = lds_tr8(Qt, 72, 32 * ks, 16 * mt, lane);
#pragma unroll
            for (int nt = 0; nt < 4; ++nt) acc[nt] = MFMA32(a, lds_tr8(St, 72, 32 * ks, 16 * nt, lane), acc[nt]); }
#pragma unroll
        for (int r = 0; r < 4; ++r) { float s2 = (acc[0][r] + acc[1][r]) + (acc[2][r] + acc[3][r]);
            s2 += __shfl_xor(s2, 1); s2 += __shfl_xor(s2, 2); s2 += __shfl_xor(s2, 4); s2 += __shfl_xor(s2, 8); const float mean = s2 * (1.f / HD); float q = 0.f;
#pragma unroll
            for (int nt = 0; nt < 4; ++nt) { const float d = acc[nt][r] - mean; q += d * d; }
            q += __shfl_xor(q, 1); q += __shfl_xor(q, 2); q += __shfl_xor(q, 4); q += __shfl_xor(q, 8); const float rstd = __builtin_amdgcn_rsqf(q * (1.f / HD) + GN_EPS);
#pragma unroll
            for (int nt = 0; nt < 4; ++nt) { const int v = 16 * nt + l15; Out[(16 * mt + 4 * g + r) * 68 + v] = (acc[nt][r] - mean) * rstd * W.lnx_w[h * HD + v] + W.lnx_b[h * HD + v]; } }
        LDS_BARRIER();
#pragma unroll
        for (int half = 0; half < 2; ++half) { float cv[8], pv[8], gv[8], o[8]; const int col = 2048 + hv0 + 8 * half;
            unpack8(cvr[half], cv); unpack8(pvr[half], pv); unpack8(gvr[half], gv);
            const f32x4 m0 = *(const f32x4*)(W.mu + col - 1024), m1 = *(const f32x4*)(W.mu + col - 1024 + 4);
#pragma unroll
            for (int j = 0; j < 8; ++j) { const float pvj = has_prev ? pv[j] : 0.f; const float vs = cv[j] + (pvj - cv[j]) * (j < 4 ? m0[j] : m1[j - 4]); o[j] = (Out[t * 68 + v0 + 8 * half + j] + bsc * vs) * gv[j]; }
            *(u32x4*)(Y + row * D + GMW + hv0 + 8 * half) = pack8(o); }
    }
#undef M3_PREF
    LDS_BARRIER();
}

__device__ __forceinline__ void rwkv_apply_naive(Frame& F, int unit, const bf16* P, bf16* Y, const RwkvW& W, const RwkvS& Sc) {
    const int b = unit >> 3, h = unit & 7;
    LAS float* S = (LAS float*)F.lds; LAS float* Gs = S + 64 * 65; LAS float* Hs = Gs + 64 * 65; LAS float* Qs = Hs + 64 * 65; LAS float* Ys = Qs + 64 * 65; LAS float* Sn = Ys + 64 * 65;
    for (int i = F.tid; i < 64 * 65; i += 512) S[i] = 0.f;
    __syncthreads();
    for (int c = 0; c < 64; ++c) { const size_t uh = ((size_t)(b * 64 + c) * NH + h) * 4096; const size_t row0 = (size_t)b * SEQ + c * 64;
        for (int i = F.tid; i < 4096; i += 512) { const int r = i >> 6, cc = i & 63;
            Gs[cc * 65 + r] = bf2f(Sc.SG[uh + i]);
            Hs[cc * 65 + r] = bf2f(Sc.SH[uh + i]);
            Qs[cc * 65 + r] = bf2f(Sc.SQ[uh + i]);
            Ys[cc * 65 + r] = bf2f(Sc.SY0[uh + i]); }
        __syncthreads();
        for (int i = F.tid; i < 4096; i += 512) { const int t = i >> 6, v = i & 63; float a = Ys[t * 65 + v];
            if (DBG_VAR != 1) for (int k = 0; k < 64; ++k) a += Qs[t * 65 + k] * S[v * 65 + k];
            if (DBG_VAR == 2) a = 0.f;
            Ys[t * 65 + v] = a; }
        for (int i = F.tid; i < 4096; i += 512) { const int v = i >> 6, k2 = i & 63; float a = Hs[v * 65 + k2];
            if (DBG_VAR == 6) a += S[v * 65 + k2] * Gs[k2 * 65 + k2]; else if (DBG_VAR != 3) for (int k = 0; k < 64; ++k) a += S[v * 65 + k] * Gs[k * 65 + k2];
            if (DBG_VAR == 7) a = Hs[v * 65 + k2] + 0.5f * (a - Hs[v * 65 + k2]);
            Sn[v * 65 + k2] = a; }
        __syncthreads();
        for (int i = F.tid; i < 4096; i += 512) { const int v = i >> 6, k2 = i & 63; S[v * 65 + k2] = Sn[v * 65 + k2]; }
        { const int t = F.tid >> 3, cg = F.tid & 7, v0 = 8 * cg, hv0 = h * HD + v0; const size_t row = row0 + t; const bool has_prev = (c * 64 + t) > 0; const float bsc = Sc.Sbsc[row * NH + h];
          float yv[8]; float sm = 0.f;
          for (int j = 0; j < 8; ++j) { yv[j] = Ys[t * 65 + v0 + j]; sm += yv[j]; }
          sm += __shfl_xor(sm, 1); sm += __shfl_xor(sm, 2); sm += __shfl_xor(sm, 4); const float mean = sm * (1.f / HD); float q = 0.f;
          for (int j = 0; j < 8; ++j) { yv[j] -= mean; q += yv[j] * yv[j]; }
          q += __shfl_xor(q, 1); q += __shfl_xor(q, 2); q += __shfl_xor(q, 4); const float rstd = __builtin_amdgcn_rsqf(q * (1.f / HD) + GN_EPS);
          float cv[8], pv[8], gv[8], o[8]; const int col = 2048 + hv0;
          unpack8(*(const u32x4*)(P + row * INW + col), cv); if (has_prev) unpack8(*(const u32x4*)(P + (row - 1) * INW + col), pv); else { for (int j = 0; j < 8; ++j) pv[j] = 0.f; }
          unpack8(*(const u32x4*)(Sc.Sg + row * RWW + hv0), gv);
          for (int j = 0; j < 8; ++j) { const float vs = cv[j] + (pv[j] - cv[j]) * W.mu[col - 1024 + j]; o[j] = (yv[j] * rstd * W.lnx_w[hv0 + j] + W.lnx_b[hv0 + j] + bsc * vs) * gv[j]; }
          *(u32x4*)(Y + row * D + GMW + hv0) = pack8(o); }
        __syncthreads();
    }
}

enum Phase { PH_PRO = 0, PH_G1_0, PH_M1_0, PH_M2_0, PH_M3_0, PH_G2_0, PH_G3_0, PH_G4_0, PH_G1_1, PH_M1_1, PH_M2_1, PH_M3_1, PH_G2_1, PH_CV, PH_R2, PH_GU_A, PH_DN_A, PH_GU_B, PH_DN_B, PH_FIN, PH_COUNT };

__global__ void __launch_bounds__(512, 2) fwd(Args args) {
    extern __shared__ __attribute__((aligned(16))) unsigned char lds_raw[];
    Frame F;
    F.lds = (LAS unsigned char*)lds_raw;
    F.tid = threadIdx.x; F.lane = F.tid & 63; F.wave = __builtin_amdgcn_readfirstlane(F.tid >> 6);
    F.G = gridDim.x; F.gw = blockIdx.x * 8 + F.wave; F.NGW = F.G * 8;
    unsigned char* ws = args.ws;
    gu32* ctl = (gu32*)(ws + WS_CTL);
    volatile LAS unsigned* MISC = (volatile LAS unsigned*)(F.lds + MISC_OFF);
    if (F.tid < 32) ((LAS unsigned*)(F.lds + MISC_OFF))[F.tid] = 0u;
    __syncthreads();
    XcdBarrier bar; bar.bar = (unsigned*)(ctl + CW_BAR); bar.x = 0; bar.st = nullptr;
#if !MK_PER_PHASE
    bar = xcd_barrier_post((unsigned*)(ctl + CW_BAR), MISC + 8);
#endif
    const int lo = args.ph_lo, hi = args.ph_hi;
#define IN(k) (lo <= (k) && (k) < hi)
#define SEAM(k) do { if (IN(k) && IN((k) + 1)) xcd_barrier(bar); } while (0)

    const float* x_in = args.in[I_X];
    bf16* WinT = (bf16*)(ws + WS_WIN); bf16* WoutT = (bf16*)(ws + WS_WOUT); bf16* WguT = (bf16*)(ws + WS_WGU); bf16* WdT = (bf16*)(ws + WS_WD);
    bf16* XB = (bf16*)(ws + WS_XB); bf16* PB = (bf16*)(ws + WS_P); bf16* YB = (bf16*)(ws + WS_Y); bf16* HB = (bf16*)(ws + WS_P);
    bf16* MWgu = (bf16*)(ws + WS_MOEW_GU); bf16* MWd = (bf16*)(ws + (MOE8_GU ? WS_MOEW8_D : WS_MOEW_D)); bf16* MH = (bf16*)(ws + WS_MOEH);
    unsigned char* MWgu8 = ws + WS_MOEW8_GU; unsigned char* MWd8 = ws + WS_MOEW8_D; unsigned char* MH8 = ws + WS_MOEH; unsigned char* MH8b = ws + WS_MOEH + 119 * MiB; unsigned char* XB8 = ws + WS_XB8;
    float* ssq0 = (float*)(ctl + CW_SSQ); float* ssq1 = (float*)(ws + WS_SSQP); float* ssq2 = ssq1 + (size_t)NTOK * 16;
    bf16* WupT = (bf16*)(ws + WS_SMALLW + SW_WUP); bf16* AupT = (bf16*)(ws + WS_SMALLW + SW_AUP); bf16* GupT = (bf16*)(ws + WS_SMALLW + SW_GUP); bf16* WsB = (bf16*)(ws + WS_SMALLW + SW_WS);
    RwkvS RS{(bf16*)(ws + WS_SCR), (bf16*)(ws + WS_SCR + 32 * MiB), (bf16*)(ws + WS_SCR + 64 * MiB), (bf16*)(ws + WS_SCR + 96 * MiB), (bf16*)(ws + WS_SCR + 128 * MiB), (bf16*)((unsigned char*)args.out), (float*)((unsigned char*)args.out + 32 * MiB)};
    unsigned char* misc = ws + WS_MISC;
    int* tok_e = (int*)(misc + MS_TOKE); float* tok_g = (float*)(misc + MS_TOKG); float* rs_moe = (float*)(misc + MS_RS); int* bcnt = (int*)(misc + MS_BCNT);
    int* row_tok = (int*)(misc + MS_ROWTOK); float* row_gate = (float*)(misc + MS_ROWGATE); int* panel = (int*)(misc + MS_PANEL); float* row_rs = (float*)(misc + MS_ROWRS);

    if (IN(PH_PRO)) for (int rep = 0; rep < (PROBE_DUP == 4 ? 2 : 1); ++rep) {
        int itb = 0;
        for (int l = 0; l < 2; ++l) {
            convert_matrix(F, args.in[I_W_IN] + (size_t)l * D * INW, D, INW, WinT + (size_t)l * INW * D, 0, args.in[I_NORM_MIX] + l * D, 0, itb);
            convert_matrix(F, args.in[I_W_OUT] + (size_t)l * D * D, D, D, WoutT + (size_t)l * D * D, 0, nullptr, 0, itb);
        }
        convert_matrix(F, args.in[I_FFN_WG], D, FF, WguT, 1, args.in[I_NORM_FFN], 0, itb);
        convert_matrix(F, args.in[I_FFN_WU], D, FF, WguT, 2, args.in[I_NORM_FFN], 0, itb);
        convert_matrix(F, args.in[I_FFN_WD], FF, D, WdT, 0, nullptr, 0, itb);
        { const size_t gt = (size_t)blockIdx.x * 512 + F.tid, gn = (size_t)F.G * 512;
          for (size_t i = gt; i < (size_t)2 * RWW * 64; i += gn) { const int l = (int)(i / (RWW * 64)), r = (int)(i % (RWW * 64)), ch = r / 64, j = r % 64;
              WupT[i] = (bf16)f2bf(args.in[I_RW_W_UP][(size_t)l * 64 * RWW + (size_t)j * RWW + ch]); AupT[i] = (bf16)f2bf(args.in[I_RW_A_UP][(size_t)l * 64 * RWW + (size_t)j * RWW + ch]); }
          for (size_t i = gt; i < (size_t)2 * RWW * 128; i += gn) { const int l = (int)(i / (RWW * 128)), r = (int)(i % (RWW * 128)), ch = r / 128, j = r % 128;
              GupT[i] = (bf16)f2bf(args.in[I_RW_G_UP][(size_t)l * 128 * RWW + (size_t)j * RWW + ch]); }
          for (size_t i = gt; i < (size_t)2 * NH * GCH * GCH; i += gn) { const int t = (int)((i / GCH) % GCH), s2 = (int)(i % GCH); WsB[i] = (bf16)(s2 <= t ? f2bf(args.in[I_GM_WS][i]) : 0u); } }
        for (int m = F.gw; m < NTOK; m += F.NGW) {
            const GAS f32x4* xr = (const GAS f32x4*)(x_in + (size_t)m * D) + F.lane; GAS u32x2* o8 = (GAS u32x2*)(XB + (size_t)m * D) + F.lane; float s = 0.f;
#pragma unroll
            for (int j = 0; j < 4; ++j) { const f32x4 v = xr[64 * j]; s += (v.x * v.x + v.y * v.y) + (v.z * v.z + v.w * v.w); u32x2 w; w.x = pk2(v.x, v.y); w.y = pk2(v.z, v.w); o8[64 * j] = w; }
            s = wave_sum(s); if (F.lane == 0) ssq0[m] = s;
        }
    }
    SEAM(PH_PRO);

#define LAYER_MIXER(L, PH1, PHA, PHB, PHC, PH2, XBASE, BASE32, SSQ_IN, NP_IN, SSQ_OUT, HAS_OUT) \
    if (IN(PH1)) { pg8::DenseSched S; S.init(XB, WinT + (size_t)(L) * INW * D, NTOK, INW, 2 * D, F.G, (int)blockIdx.x); \
        pg8::EpiScaleBf16<NP_IN> E{PB, INW, SSQ_IN}; pg8::gemm_phase(F.lds, 2 * D, S, E); } \
    if (PROBE_DUP == 1 && (L) == 0 && IN(PH1)) { pg8::DenseSched S; S.init(XB, WinT + (size_t)(L) * INW * D, NTOK, INW, 2 * D, F.G, (int)blockIdx.x); \
        pg8::EpiScaleBf16<NP_IN> E{PB, INW, SSQ_IN}; pg8::gemm_phase(F.lds, 2 * D, S, E); } \
    SEAM(PH1); \
    { RwkvW RW{args.in[I_SHIFT_MU] + (L) * 1792, args.in[I_RW_W0] + (L) * RWW, args.in[I_RW_A0] + (L) * RWW, args.in[I_RW_K_K] + (L) * RWW, args.in[I_RW_K_A] + (L) * RWW, args.in[I_RW_R_K] + (L) * RWW, \
                 args.in[I_RW_LNX_W] + (L) * RWW, args.in[I_RW_LNX_B] + (L) * RWW, WupT + (size_t)(L) * RWW * 64, AupT + (size_t)(L) * RWW * 64, GupT + (size_t)(L) * RWW * 128}; \
      if (IN(PHA)) { if (MIX_MODE != 1) for (int rep = 0; rep < REP_M1; ++rep) { rwkv_m1_consts(F, RW); for (int u = blockIdx.x; u < NB * 64; u += F.G) rwkv_m1v2_unit(F, u, PB, RW, RS); } } \
      SEAM(PHA); \
      if (IN(PHB)) for (int rep = 0; rep < REP_M2; ++rep) { const int nscan = (F.G >= 128 && MIX_MODE != 1) ? 64 : 0; \
          if (MIX_MODE != 1 && MIX_MODE != 3) { if (nscan) { if ((int)blockIdx.x < 64) rwkv_m2_unit(F, blockIdx.x, RS); } else { for (int u = blockIdx.x; u < 64; u += F.G) rwkv_m2_unit(F, u, RS); } } \
          if (MIX_MODE == 2) gmlp_naive(F, PB, YB, args.in[I_GM_LN_W] + (L) * GMW, args.in[I_GM_LN_B] + (L) * GMW, args.in[I_GM_WS] + (size_t)(L) * NH * GCH * GCH, args.in[I_GM_BS] + (L) * NH * GCH); \
          else { const int NU = NB * (SEQ / GCH) * NH; const int nsplit = (nscan && F.G == 256) ? 1920 : NU;         \
              if ((int)blockIdx.x >= nscan) gmlp_units(F, blockIdx.x - nscan, F.G - nscan, nsplit, PB, YB, args.in[I_GM_LN_W] + (L) * GMW, args.in[I_GM_LN_B] + (L) * GMW, WsB + (size_t)(L) * NH * GCH * GCH, args.in[I_GM_BS] + (L) * NH * GCH); \
              else if (nsplit < NU) gmlp_units(F, nsplit + blockIdx.x, nscan, NU, PB, YB, args.in[I_GM_LN_W] + (L) * GMW, args.in[I_GM_LN_B] + (L) * GMW, WsB + (size_t)(L) * NH * GCH * GCH, args.in[I_GM_BS] + (L) * NH * GCH); } } \
      SEAM(PHB); \
      if (IN(PHC)) { if (MIX_MODE == 3) { for (int u = blockIdx.x; u < 64; u += F.G) rwkv_apply_naive(F, u, PB, YB, RW, RS); } \
          else if (MIX_MODE != 1) { for (int rep = 0; rep < REP_M3; ++rep) rwkv_m3_units(F, blockIdx.x, F.G, NB * 64, PB, YB, RW, RS); } \
          else rwkv_naive(F, PB, YB, args.in[I_SHIFT_MU] + (L) * 1792, args.in[I_RW_W_UP] + (L) * 64 * RWW, args.in[I_RW_W0] + (L) * RWW, args.in[I_RW_A_UP] + (L) * 64 * RWW, args.in[I_RW_A0] + (L) * RWW, \
                   args.in[I_RW_G_UP] + (L) * 128 * RWW, args.in[I_RW_K_K] + (L) * RWW, args.in[I_RW_K_A] + (L) * RWW, args.in[I_RW_R_K] + (L) * RWW, args.in[I_RW_LNX_W] + (L) * RWW, args.in[I_RW_LNX_B] + (L) * RWW); } \
      SEAM(PHC); } \
    if (IN(PH2)) { pg8::DenseSched S; S.init(YB, WoutT + (size_t)(L) * D * D, NTOK, D, 2 * D, F.G, (int)blockIdx.x); \
        pg8::EpiResid<HAS_OUT, BASE32> E{XBASE, XB, SSQ_OUT}; pg8::gemm_phase(F.lds, 2 * D, S, E); } \
    if (PROBE_DUP == 2 && (L) == 0 && IN(PH2)) { pg8::DenseSched S; S.init(YB, WoutT + (size_t)(L) * D * D, NTOK, D, 2 * D, F.G, (int)blockIdx.x); \
        pg8::EpiResid<HAS_OUT, BASE32> E{XBASE, XB, SSQ_OUT}; pg8::gemm_phase(F.lds, 2 * D, S, E); } \
    SEAM(PH2);

    LAYER_MIXER(0, PH_G1_0, PH_M1_0, PH_M2_0, PH_M3_0, PH_G2_0, x_in, true, ssq0, 1, ssq1, true)

    if (IN(PH_G3_0)) { pg8::DenseSched S; S.init(XB, WguT, NTOK, 2 * FF, 2 * D, F.G, (int)blockIdx.x);
        pg8::EpiSwiglu<16> E{HB, FF, ssq1}; pg8::gemm_phase(F.lds, 2 * D, S, E); }
#if REP_G3 == 2
    if (IN(PH_G3_0)) { pg8::DenseSched S; S.init(XB, WguT, NTOK, 2 * FF, 2 * D, F.G, (int)blockIdx.x);
        pg8::EpiSwiglu<16> E{HB, FF, ssq1}; pg8::gemm_phase(F.lds, 2 * D, S, E); }
#endif
    SEAM(PH_G3_0);
    if (IN(PH_G4_0)) { pg8::DenseSched S; S.init(HB, WdT, NTOK, D, 2 * FF, F.G, (int)blockIdx.x);
        pg8::EpiResid<true, false> E{nullptr, XB, ssq2}; pg8::gemm_phase(F.lds, 2 * FF, S, E); }
    SEAM(PH_G4_0);

    LAYER_MIXER(1, PH_G1_1, PH_M1_1, PH_M2_1, PH_M3_1, PH_G2_1, nullptr, false, ssq2, 16, nullptr, false)

    if (IN(PH_CV)) for (int rep = 0; rep < REP_CV; ++rep) {
        int itb = 0; const float* gain = args.in[I_NORM_FFN] + D;
        for (int e = 0; e < NE; ++e) {
            if (MOE8_GU) { convert_matrix_fp8(F, args.in[I_MOE_WG] + (size_t)e * D * FFE, D, FFE, MWgu8 + (size_t)e * 2 * FFE * D, 1, gain, MOE8_WSCALE_GU, itb);
                           convert_matrix_fp8(F, args.in[I_MOE_WU] + (size_t)e * D * FFE, D, FFE, MWgu8 + (size_t)e * 2 * FFE * D, 2, gain, MOE8_WSCALE_GU, itb); }
            else { convert_matrix(F, args.in[I_MOE_WG] + (size_t)e * D * FFE, D, FFE, MWgu + (size_t)e * 2 * FFE * D, 1, gain, 0, itb);
                   convert_matrix(F, args.in[I_MOE_WU] + (size_t)e * D * FFE, D, FFE, MWgu + (size_t)e * 2 * FFE * D, 2, gain, 0, itb); }
            if (MOE8_DN) convert_matrix_fp8(F, args.in[I_MOE_WD] + (size_t)e * FFE * D, FFE, D, MWd8 + (size_t)e * D * FFE, 0, nullptr, MOE8_WSCALE_DN, itb);
            else convert_matrix(F, args.in[I_MOE_WD] + (size_t)e * FFE * D, FFE, D, MWd + (size_t)e * D * FFE, 0, nullptr, 0, itb);
        }
        __syncthreads();
        LAS float* RW = (LAS float*)F.lds; LAS int* cnt = (LAS int*)(F.lds + 32768);
        for (int i = F.tid; i < D * NE; i += 512) { const int k = i >> 3, e = i & 7, jj = k >> 9, ln = (k & 511) >> 3, q = k & 7; RW[(((jj * 8 + q) * 64 + ln) << 3) + e] = args.in[I_MOE_ROUTER][i] * gain[k]; }
        for (size_t i = (size_t)blockIdx.x * 512 + F.tid; i < (size_t)2 * MAXPAN * 256; i += (size_t)F.G * 512) { row_tok[i] = -1; row_gate[i] = 0.f; row_rs[i] = 0.f; }
        __syncthreads();
        for (int vb = blockIdx.x; vb < 256; vb += F.G) {
            if (F.tid < 16) cnt[F.tid] = 0;
            __syncthreads();
            u32x4 xv4[2];
            { const GAS u32x4* xr0 = (const GAS u32x4*)(XB + (size_t)(vb * 128 + F.wave * 16) * D) + F.lane; xv4[0] = xr0[0]; xv4[1] = xr0[64]; }
            for (int i = 0; i < 16; ++i) { const int m = vb * 128 + F.wave * 16 + i;
                float s = 0.f; float lg[8]; u32x4 cur4[2]; cur4[0] = xv4[0]; cur4[1] = xv4[1];
                if (i + 1 < 16) { const GAS u32x4* xr1 = (const GAS u32x4*)(XB + (size_t)(m + 1) * D) + F.lane; xv4[0] = xr1[0]; xv4[1] = xr1[64]; }
#pragma unroll
                for (int e = 0; e < 8; ++e) lg[e] = 0.f;
#pragma unroll
                for (int jj = 0; jj < 2; ++jj) { float v[8]; unpack8(cur4[jj], v);
                    if (MOE8_GU) { u32x2 w8; w8.x = pk4_fp8(v[0], v[1], v[2], v[3]); w8.y = pk4_fp8(v[4], v[5], v[6], v[7]); *(u32x2*)(XB8 + (size_t)m * D + 512 * jj + 8 * F.lane) = w8; }
#pragma unroll
                    for (int q = 0; q < 8; ++q) { const float xv = v[q]; s += xv * xv; const LAS f32x4* rw = (const LAS f32x4*)(RW + (((jj * 8 + q) * 64 + F.lane) << 3)); const f32x4 r0 = rw[0], r1 = rw[1];
                        lg[0] += xv * r0.x; lg[1] += xv * r0.y; lg[2] += xv * r0.z; lg[3] += xv * r0.w; lg[4] += xv * r1.x; lg[5] += xv * r1.y; lg[6] += xv * r1.z; lg[7] += xv * r1.w; } }
                s = wave_sum(s);
#pragma unroll
                for (int e = 0; e < 8; ++e) lg[e] = wave_sum(lg[e]);
                const float rs = 1.0f / sqrtf(s * (1.0f / D) + RMS_EPS);
                if (F.lane == 0) {
                    int i1 = 0; float v1 = lg[0];
#pragma unroll
                    for (int e = 1; e < 8; ++e) if (lg[e] > v1) { v1 = lg[e]; i1 = e; }
                    int i2 = -1; float v2 = -3.0e38f;
#pragma unroll
                    for (int e = 0; e < 8; ++e) if (e != i1 && lg[e] > v2) { v2 = lg[e]; i2 = e; }
                    if (i2 < 0) { i2 = (i1 + 1) & 7; v2 = v1; }
                    const float g1 = 1.0f / (1.0f + __expf((v2 - v1) * rs)), g2 = 1.0f - g1;
                    tok_e[2 * m] = i1; tok_e[2 * m + 1] = i2; tok_g[2 * m] = g1; tok_g[2 * m + 1] = g2; rs_moe[m] = rs;
                    __hip_atomic_fetch_add(&cnt[i1], 1, __ATOMIC_RELAXED, __HIP_MEMORY_SCOPE_WORKGROUP); __hip_atomic_fetch_add(&cnt[8 + i2], 1, __ATOMIC_RELAXED, __HIP_MEMORY_SCOPE_WORKGROUP);
                } }
            __syncthreads();
            if (F.tid < 16) bcnt[vb * 16 + F.tid] = cnt[F.tid];
            __syncthreads();
        }
    }
    SEAM(PH_CV);

    if (IN(PH_R2)) for (int rep = 0; rep < (PROBE_DUP == 5 ? 2 : 1); ++rep) {
        LAS int* tot = (LAS int*)F.lds;
        for (int vb = blockIdx.x; vb < 256; vb += F.G) {
            if (F.tid < 16) { int t = 0, mine = 0; for (int b2 = 0; b2 < 256; ++b2) { const int c = bcnt[b2 * 16 + F.tid]; if (b2 < vb) mine += c; t += c; } tot[F.tid] = t; tot[32 + F.tid] = mine; }
            __syncthreads();
            if (F.tid < 2) { int ps = 0; for (int e = 0; e < 8; ++e) { tot[16 + F.tid * 8 + e] = ps; ps += (tot[F.tid * 8 + e] + 255) / 256; }
                if (vb == 0) { panel[F.tid * 160] = ps; for (int e = 0; e < 8; ++e) { const int np = (tot[F.tid * 8 + e] + 255) / 256; for (int q = 0; q < np; ++q) panel[F.tid * 160 + 16 + tot[16 + F.tid * 8 + e] + q] = e; } } }
            __syncthreads();
            if (F.tid < 16) { const int set = F.tid >> 3, e = F.tid & 7; int slot = tot[16 + F.tid] * 256 + tot[32 + F.tid];
                for (int r = 0; r < 128; ++r) { const int m = vb * 128 + r; if (tok_e[2 * m + set] == e) { row_tok[set * MAXPAN * 256 + slot] = m; row_gate[set * MAXPAN * 256 + slot] = tok_g[2 * m + set]; row_rs[set * MAXPAN * 256 + slot] = rs_moe[m]; ++slot; } } }
            __syncthreads();
        }
    }
    SEAM(PH_R2);

#define MOE_SET(SET, PHGU, PHDN) \
    if (IN(PHGU)) for (int rep = 0; rep < REP_GU; ++rep) { const int np = __builtin_amdgcn_readfirstlane(panel[(SET) * 160]); pg8::MoeSched<true> S; \
        if (MOE8_GU) { S.init(XB8, MWgu8, np, 2 * FFE, D, panel + (SET) * 160 + 16, row_tok + (SET) * MAXPAN * 256, F.G, (int)blockIdx.x); \
            if (MOE8_DN) { pg8::EpiSwigluMoe8 E{MH8, FFE, row_rs + (SET) * MAXPAN * 256, 1.0f / MOE8_WSCALE_GU}; pg8::gemm_phase<pg8::EpiSwigluMoe8, pg8::MoeSched<true>, true>(F.lds, D, S, E); } \
            else { pg8::EpiSwigluMoe E{MH, FFE, rs_moe, row_tok + (SET) * MAXPAN * 256, 1.0f / MOE8_WSCALE_GU}; pg8::gemm_phase<pg8::EpiSwigluMoe, pg8::MoeSched<true>, true>(F.lds, D, S, E); } } \
        else { S.init(XB, MWgu, np, 2 * FFE, 2 * D, panel + (SET) * 160 + 16, row_tok + (SET) * MAXPAN * 256, F.G, (int)blockIdx.x); \
            pg8::EpiSwigluMoe E{MH, FFE, rs_moe, row_tok + (SET) * MAXPAN * 256, 1.0f}; pg8::gemm_phase(F.lds, 2 * D, S, E); } } \
    SEAM(PHGU); \
    if (IN(PHDN)) { const int np = __builtin_amdgcn_readfirstlane(panel[(SET) * 160]); pg8::MoeSched<false> S; \
        if (MOE8_DN) { S.init(MH8, MWd8, np, D, FFE, panel + (SET) * 160 + 16, row_tok + (SET) * MAXPAN * 256, F.G, (int)blockIdx.x); \
            pg8::EpiMoeDown E{XB, row_tok + (SET) * MAXPAN * 256, row_gate + (SET) * MAXPAN * 256, 1.0f / MOE8_WSCALE_DN}; pg8::gemm_phase<pg8::EpiMoeDown, pg8::MoeSched<false>, true>(F.lds, FFE, S, E); } \
        else { S.init(MH, MWd, np, D, 2 * FFE, panel + (SET) * 160 + 16, row_tok + (SET) * MAXPAN * 256, F.G, (int)blockIdx.x); \
            pg8::EpiMoeDown E{XB, row_tok + (SET) * MAXPAN * 256, row_gate + (SET) * MAXPAN * 256, 1.0f}; pg8::gemm_phase(F.lds, 2 * FFE, S, E); } } \
    SEAM(PHDN);
#if MOE8_GU && MOE8_DN
#define MOE_GU8(SET, HBUF, SKX, SKR) do { const int np = __builtin_amdgcn_readfirstlane(panel[(SET) * 160]); pg8::MoeSched<true> S; \
        S.init(XB8, MWgu8, np, 2 * FFE, D, panel + (SET) * 160 + 16, row_tok + (SET) * MAXPAN * 256, F.G, (int)blockIdx.x); S.T.sx = (SKX); S.T.sr = (SKR); \
        pg8::EpiSwigluMoe8 E{HBUF, FFE, row_rs + (SET) * MAXPAN * 256, 1.0f / MOE8_WSCALE_GU}; pg8::gemm_phase<pg8::EpiSwigluMoe8, pg8::MoeSched<true>, true>(F.lds, D, S, E); } while (0)
#define MOE_DN8(SET, HBUF) do { const int np = __builtin_amdgcn_readfirstlane(panel[(SET) * 160]); pg8::MoeSched<false> S; \
        S.init(HBUF, MWd8, np, D, FFE, panel + (SET) * 160 + 16, row_tok + (SET) * MAXPAN * 256, F.G, (int)blockIdx.x); \
        pg8::EpiMoeDown E{XB, row_tok + (SET) * MAXPAN * 256, row_gate + (SET) * MAXPAN * 256, 1.0f / MOE8_WSCALE_DN}; pg8::gemm_phase<pg8::EpiMoeDown, pg8::MoeSched<false>, true>(F.lds, FFE, S, E); } while (0)
    if (IN(PH_GU_A)) MOE_GU8(0, MH8, 0, 0);
    if (PROBE_DUP == 3 && IN(PH_GU_A)) MOE_GU8(0, MH8, 0, 0);
    SEAM(PH_GU_A);
    if (IN(PH_DN_A)) { MOE_DN8(0, MH8);
        const int ndn = __builtin_amdgcn_readfirstlane(panel[0]) * (D / 256); const int sx = ndn % F.G;
        MOE_GU8(1, MH8b, sx, sx ? 3 : 0); }
    if (IN(PH_DN_A) && IN(PH_DN_B)) xcd_barrier(bar);
    if (IN(PH_DN_B)) MOE_DN8(1, MH8b);
    SEAM(PH_DN_B);
#else
    MOE_SET(0, PH_GU_A, PH_DN_A)
    MOE_SET(1, PH_GU_B, PH_DN_B)
#endif

    if (IN(PH_FIN)) {
        const float* gf = args.in[I_NORM_FINAL];
        for (int m = F.gw; m < NTOK; m += F.NGW) {
            const GAS u32x4* xr = (const GAS u32x4*)(XB + (size_t)m * D) + F.lane; float v[2][8]; float s = 0.f;
#pragma unroll
            for (int jj = 0; jj < 2; ++jj) { unpack8(xr[64 * jj], v[jj]);
#pragma unroll
                for (int q = 0; q < 8; ++q) s += v[jj][q] * v[jj][q]; }
            const float rs = 1.0f / sqrtf(wave_sum(s) * (1.0f / D) + RMS_EPS);
#pragma unroll
            for (int jj = 0; jj < 2; ++jj) { const f32x4 g0 = *((const f32x4*)(gf + 512 * jj + 8 * F.lane)), g1 = *((const f32x4*)(gf + 512 * jj + 8 * F.lane + 4));
                GAS f32x4* o = (GAS f32x4*)(args.out + (size_t)m * D + 512 * jj + 8 * F.lane);
                o[0] = (f32x4){v[jj][0] * rs * g0.x, v[jj][1] * rs * g0.y, v[jj][2] * rs * g0.z, v[jj][3] * rs * g0.w}; o[1] = (f32x4){v[jj][4] * rs * g1.x, v[jj][5] * rs * g1.y, v[jj][6] * rs * g1.z, v[jj][7] * rs * g1.w}; }
        }
    }
#undef IN
#undef SEAM
}

extern "C" void kernel_launch(void* const* d_in, const int* in_sizes, int n_in, void* d_out, int out_size, void* d_ws, size_t ws_size, hipStream_t stream) {
    static int grid = 0;
    if (grid == 0) {
        if (n_in != NIN || in_sizes[0] != NTOK * D || out_size != NTOK * D || ws_size < WS_END) {
            fprintf(stderr, "kernel_launch: unexpected shapes: n_in %d in0 %d out %d ws %zu (need %zu); nothing launched\n", n_in, n_in > 0 ? in_sizes[0] : -1, out_size, ws_size, (size_t)WS_END); grid = -1; return; }
        int dev = 0, cus = 0, per_cu = 0;
        if (hipGetDevice(&dev) != hipSuccess || hipDeviceGetAttribute(&cus, hipDeviceAttributeMultiprocessorCount, dev) != hipSuccess) { grid = -1; return; }
        if (hipFuncSetAttribute((const void*)fwd, hipFuncAttributeMaxDynamicSharedMemorySize, LDS_BYTES) != hipSuccess) { fprintf(stderr, "kernel_launch: hipFuncSetAttribute failed\n"); grid = -1; return; }
        if (hipOccupancyMaxActiveBlocksPerMultiprocessor(&per_cu, (const void*)fwd, 512, LDS_BYTES) != hipSuccess || per_cu < 1) { fprintf(stderr, "kernel_launch: occupancy query says %d\n", per_cu); }
        (void)hipGetLastError();
        grid = cus;
    }
    if (grid < 0) return;
    if (hipMemsetAsync((char*)d_ws + WS_CTL, 0, CTL_ZERO_BYTES, stream) != hipSuccess) return;
    Args a{};
    for (int i = 0; i < NIN; ++i) a.in[i] = (const float*)d_in[i];
    a.out = (float*)d_out; a.ws = (unsigned char*)d_ws;
#if MK_PER_PHASE
    for (int ph = 0; ph < PH_COUNT; ++ph) { a.ph_lo = ph; a.ph_hi = ph + 1; hipLaunchKernelGGL(fwd, dim3(grid), dim3(512), LDS_BYTES, stream, a); }
#else
    a.ph_lo = 0; a.ph_hi = PH_COUNT; hipLaunchKernelGGL(fwd, dim3(grid), dim3(512), LDS_BYTES, stream, a);
#endif
}
```

```cpp
#include <hip/hip_runtime.h>
#include <cstdio>
#include <cstdint>

#ifndef MK_PER_PHASE
#define MK_PER_PHASE 0
#endif

#ifndef REP_M1
#define REP_M1 1
#endif
#ifndef REP_M2
#define REP_M2 1
#endif
#ifndef REP_M3
#define REP_M3 1
#endif
#ifndef REP_GU
#define REP_GU 1
#endif
#ifndef REP_CH
#define REP_CH 1
#endif
#ifndef PROBE_STAGE
#define PROBE_STAGE 0
#endif
#ifndef REP_CV
#define REP_CV 1
#endif
#ifndef REP_EPI
#define REP_EPI 1
#endif
#ifndef REP_G3
#define REP_G3 1
#endif
#ifndef PROBE_DUP
#define PROBE_DUP 0
#endif
#ifndef STAGGER_TICKS
#define STAGGER_TICKS 0
#endif
#ifndef DEFER_CONVERT
#define DEFER_CONVERT 1
#endif
#ifndef DBG_VAR
#define DBG_VAR 0
#endif
#ifndef MOE8_GU
#define MOE8_GU 1
#endif
#ifndef MOE8_DN
#define MOE8_DN 1
#endif
#ifndef MIX_MODE
#define MIX_MODE 0
#endif
#define GAS __attribute__((address_space(1)))
#define LAS __attribute__((address_space(3)))
typedef unsigned short bf16;
typedef unsigned short bf16_t;
typedef short bf16x8 __attribute__((ext_vector_type(8)));
typedef float f32x4 __attribute__((ext_vector_type(4)));
typedef float f32x2 __attribute__((ext_vector_type(2)));
typedef unsigned u32x4 __attribute__((ext_vector_type(4)));
typedef unsigned u32x2 __attribute__((ext_vector_type(2)));
typedef GAS unsigned gu32;

constexpr int NTOK = 32768, SEQ = 4096, NB = 8, D = 1024, INW = 2816, FF = 2816, FFE = 3584, NE = 8;
constexpr int GMW = 512, RWW = 512, NH = 8, HD = 64, GCH = 128;
constexpr float RMS_EPS = 1e-6f, LN_EPS = 1e-5f, GN_EPS = 64e-5f;
constexpr int MAXPAN = 136;

constexpr size_t MiB = 1u << 20;
constexpr size_t WS_CTL = 0, CTL_ZERO_BYTES = 2 * MiB;
constexpr size_t WS_WIN = 2 * MiB;
constexpr size_t WS_WOUT = 13 * MiB;
constexpr size_t WS_WGU = 17 * MiB;
constexpr size_t WS_WD = 28 * MiB;
constexpr size_t WS_MISC = 34 * MiB;
constexpr size_t WS_SMALLW = 36 * MiB;
constexpr size_t SW_WUP = 0, SW_AUP = 128 * 1024, SW_GUP = 256 * 1024, SW_WS = 512 * 1024;
constexpr size_t WS_XB = 38 * MiB;
constexpr size_t WS_R = 102 * MiB;
constexpr size_t WS_P = WS_R;
constexpr size_t WS_Y = WS_R + 176 * MiB;
constexpr size_t WS_SCR = WS_R + 240 * MiB;
constexpr size_t WS_MOEW_GU = WS_R;
constexpr size_t WS_MOEW_D = WS_R + 112 * MiB;
constexpr size_t WS_MOEH = WS_R + 168 * MiB;
constexpr size_t WS_MOEW8_GU = WS_R;
constexpr size_t WS_MOEW8_D = WS_R + 56 * MiB;
constexpr size_t WS_XB8 = WS_R + 112 * MiB;
constexpr float MOE8_WSCALE_GU = 64.f, MOE8_WSCALE_DN = 128.f;
constexpr size_t WS_SSQP = WS_R + 400 * MiB;
constexpr size_t WS_END = WS_R + 408 * MiB;
static_assert(WS_MOEH + (size_t)MAXPAN * 256 * FFE * 2 <= WS_END, "moe hidden fits");
static_assert(WS_WIN + (size_t)2 * INW * D * 2 <= WS_WOUT && WS_WGU + (size_t)2 * FF * D * 2 <= WS_WD && WS_WD + (size_t)D * FF * 2 <= WS_MISC, "weights fit");
constexpr int CW_TMO = 0;
constexpr int CW_BAR = 4096;
constexpr int CW_HND = 8192;
constexpr int CW_SSQ = 65536;
static_assert((CW_SSQ + 4 * NTOK) * 4 <= (int)CTL_ZERO_BYTES, "ctl fits");
constexpr size_t MS_TOKE = 0;
constexpr size_t MS_TOKG = 256 * 1024;
constexpr size_t MS_RS = 512 * 1024;
constexpr size_t MS_BCNT = 640 * 1024;
constexpr size_t MS_ROWTOK = 704 * 1024;
constexpr size_t MS_ROWGATE = 1024 * 1024;
constexpr size_t MS_PANEL = 1344 * 1024;
constexpr size_t MS_ROWRS = 1408 * 1024;
static_assert(MS_ROWTOK + 2 * MAXPAN * 256 * 4 <= MS_ROWGATE && MS_ROWGATE + 2 * MAXPAN * 256 * 4 <= MS_PANEL && MS_PANEL + 2 * 160 * 4 <= MS_ROWRS && MS_ROWRS + 2 * MAXPAN * 256 * 4 <= 2 * MiB, "misc fits");

constexpr int RING_BYTES = 131072;
constexpr int LDS_BYTES = 147456;
constexpr int MISC_OFF = LDS_BYTES - 128;

#define LDS_WAIT() asm volatile("s_waitcnt lgkmcnt(0)" ::: "memory")
#define VM_WAIT() asm volatile("s_waitcnt vmcnt(0)" ::: "memory")
#define RLX_AGENT __ATOMIC_RELAXED, __HIP_MEMORY_SCOPE_AGENT
#define LDS_BARRIER() do { asm volatile("s_waitcnt lgkmcnt(0)" ::: "memory"); __builtin_amdgcn_s_barrier(); asm volatile("" ::: "memory"); } while (0)

__device__ __forceinline__ unsigned f2bf(float f) { unsigned u = __builtin_bit_cast(unsigned, f); return (u + 0x7fffu + ((u >> 16) & 1u)) >> 16; }
__device__ __forceinline__ unsigned pk2(float lo, float hi) { return f2bf(lo) | (f2bf(hi) << 16); }
__device__ __forceinline__ float bf2f(bf16 b) { return __builtin_bit_cast(float, (unsigned)b << 16); }
__device__ __forceinline__ unsigned cvt_pk_bf16(float lo, float hi) { unsigned r; asm volatile("v_cvt_pk_bf16_f32 %0, %1, %2" : "=v"(r) : "v"(lo), "v"(hi)); return r; }
__device__ __forceinline__ unsigned pk4_fp8(float a, float b, float c, float d) { int v = __builtin_amdgcn_cvt_pk_fp8_f32(a, b, 0, false); v = __builtin_amdgcn_cvt_pk_fp8_f32(c, d, v, true); return (unsigned)v; }
__device__ __forceinline__ float wave_sum(float v) {
#pragma unroll
    for (int o = 1; o < 64; o <<= 1) v += __shfl_xor(v, o);
    return v;
}
__device__ __forceinline__ float gelu_erf(float v) { return 0.5f * v * (1.0f + erff(v * 0.70710678f)); }
__device__ __forceinline__ float sigmoidf_(float v) { return 1.0f / (1.0f + __expf(-v)); }
__device__ __forceinline__ float silu_f(float v) { return v * __builtin_amdgcn_rcpf(1.0f + __expf(-v)); }

__device__ __forceinline__ f32x2 swiglu2(f32x2 g, f32x2 u, float rs) {
    const float c1 = rs * (-1.44269504f), ic2 = rs != 0.f ? __builtin_amdgcn_rcpf(rs * rs) : 1.0e30f;
    const f32x2 a = g * c1, p = g * u;
    f32x2 e; e.x = __builtin_amdgcn_exp2f(a.x); e.y = __builtin_amdgcn_exp2f(a.y);
    const f32x2 d = e * ic2 + ic2; f32x2 r; r.x = __builtin_amdgcn_rcpf(d.x); r.y = __builtin_amdgcn_rcpf(d.y);
    return p * r;
}
namespace pg8 {
constexpr int BM = 256, BK = 64, HALF = 128, HTB = HALF * BK * 2, STAGE_BYTES = 8 * HTB, NXCD = 8, WGM = 8;
__host__ __device__ __forceinline__ int lds_byte(int r, int c) { const int st = (r >> 4) * 2 + (c >> 5), rr = r & 15, cc = c & 31, ob = rr * 64 + cc * 2; return st * 1024 + (ob ^ (((ob >> 9) & 1) << 5)); }
__host__ __device__ __forceinline__ void stage_rc(int b, int& R, int& C) { const int st = b / 1024, sb = b % 1024, swz = sb ^ (((sb >> 9) & 1) << 5); R = (st >> 1) * 16 + swz / 64; C = (st & 1) * 32 + (swz % 64) / 2; }
__host__ __device__ __forceinline__ int perm32(int rho) { const int n = rho >> 4, i = rho & 15; return 8 * (i >> 2) + 4 * n + (i & 3); }

struct Unit { int pm, pn, aux; };

struct TileOrder {
    int nM, nN, nwg, G, c, sx, sr;
    __device__ void init(int nM_, int nN_, int G_, int c_) { nM = nM_; nN = nN_; nwg = nM * nN; G = G_; c = c_; sx = 0; sr = 0; }
    __device__ bool tile(int i, int& pm, int& pn) const {
        long L;
        if (sx == 0) L = (long)i * G + c;
        else if (c < sx) L = (long)sr * (G - sx) + (long)i * G + c;
        else L = i < sr ? (long)i * (G - sx) + (c - sx) : (long)sr * (G - sx) + (long)(i - sr) * G + c;
        if (L >= nwg) return false;
        int wgid = (int)L; { const int q = nwg / NXCD, r = nwg % NXCD, xcd = wgid % NXCD, off = wgid / NXCD; wgid = (xcd < r ? xcd * (q + 1) : r * (q + 1) + (xcd - r) * q) + off; }
        const int nig = WGM * nN, gid = wgid / nig, fm = gid * WGM, gsz = (nM - fm) < WGM ? (nM - fm) : WGM;
        pm = fm + ((wgid % nig) % gsz); pn = (wgid % nig) / gsz; return true;
    }
};
struct DenseSched {
    static constexpr bool GATHER = false;
    TileOrder T; const char* A; const char* Bt; size_t tstep;
    __device__ void init(const void* A_, const void* Bt_, int M, int N, int KB  , int G, int c) { T.init(M / BM, N / BM, G, c); A = (const char*)A_; Bt = (const char*)Bt_; tstep = (size_t)BM * KB; }
    __device__ __forceinline__ bool next(int i, Unit& u) const { u.aux = 0; return T.tile(i, u.pm, u.pn); }
    __device__ __forceinline__ const char* a_ptr(const Unit& u) const { return A + (size_t)u.pm * tstep; }
    __device__ __forceinline__ const char* b_ptr(const Unit& u) const { return Bt + (size_t)u.pn * tstep; }
    __device__ __forceinline__ void gather(const Unit&, int, int, int, int, int, unsigned (&)[2][2]) const {}
};
template <bool GATHER_> struct MoeSched {
    static constexpr bool GATHER = GATHER_;
    TileOrder T; const char* A; const char* Bt; size_t a_tstep, b_tstep, b_estep; const LAS int* pexp; const int* row_tok; int KB; int p0 = 0;
    __device__ void init(const void* A_, const void* Bt_, int npanels, int N, int KB_  , const LAS int* pexp_, const int* row_tok_, int G, int c) {
        T.init(npanels, N / BM, G, c); A = (const char*)A_; Bt = (const char*)Bt_; KB = KB_; a_tstep = (size_t)BM * KB_; b_tstep = (size_t)BM * KB_; b_estep = (size_t)N * KB_; pexp = pexp_; row_tok = row_tok_; }
    __device__ __forceinline__ bool next(int i, Unit& u) const { if (!T.tile(i, u.pm, u.pn)) return false; u.pm += p0; u.aux = __builtin_amdgcn_readfirstlane(pexp[u.pm]); return true; }
    __device__ __forceinline__ const char* a_ptr(const Unit& u) const { return GATHER ? A : A + (size_t)u.pm * a_tstep; }
    __device__ __forceinline__ const char* b_ptr(const Unit& u) const { return Bt + (size_t)u.aux * b_estep + (size_t)u.pn * b_tstep; }
    __device__ __forceinline__ void gather(const Unit& u, int R0, int R1, int C0, int C1, int, unsigned (&v)[2][2]) const {
#pragma unroll
        for (int h = 0; h < 2; ++h) { int t0 = row_tok[u.pm * BM + h * HALF + R0], t1 = row_tok[u.pm * BM + h * HALF + R1]; t0 = t0 < 0 ? 0 : t0; t1 = t1 < 0 ? 0 : t1;
            v[h][0] = (unsigned)(t0 * KB + C0 * 2); v[h][1] = (unsigned)(t1 * KB + C1 * 2); }
    }
};

typedef int v4i_t __attribute__((ext_vector_type(4)));
typedef int v8i_t __attribute__((ext_vector_type(8)));
typedef short s16x16_t __attribute__((ext_vector_type(16)));
__device__ __forceinline__ v8i_t cat8(const bf16x8 lo, const bf16x8 hi) { const v4i_t a = __builtin_bit_cast(v4i_t, lo), b = __builtin_bit_cast(v4i_t, hi); return __builtin_shufflevector(a, b, 0, 1, 2, 3, 4, 5, 6, 7); }
template <class Epi, class Sched, bool FP8 = false>
__device__ __forceinline__ void gemm_phase(LAS unsigned char* lds, const int KB, const Sched& S, const Epi& E) {
    constexpr bool GATHER = Sched::GATHER;
    const int tid = threadIdx.x, wid = __builtin_amdgcn_readfirstlane(tid >> 6), lane = tid & 63, wr = wid >> 2, wc = wid & 3, fr = lane & 15, fq = lane >> 4;
    const int nt = KB / 128;
    unsigned voffA[2], voffB[2], voffBa[2][2]; int sR[2], sC[2];
#pragma unroll
    for (int i = 0; i < 2; ++i) { int R, C; stage_rc(tid * 16 + i * 8192, R, C); const int Rb = Epi::PERM ? ((R & ~31) + perm32(R & 31)) : R; sR[i] = R; sC[i] = C;
        voffA[i] = (unsigned)(R * KB + C * 2); voffB[i] = (unsigned)(Rb * KB + C * 2);
        voffBa[0][i] = (unsigned)((64 * (R >> 5) + perm32(R & 31)) * KB + C * 2); voffBa[1][i] = (unsigned)((64 * (R >> 5) + 32 + perm32(R & 31)) * KB + C * 2); }
    const size_t kstep = (size_t)(BK * 2);
    const size_t hstep = (size_t)HALF * KB;
    const unsigned ldsw = (unsigned)wid * 1024u;
    const int aoff = lds_byte(wr * 64 + fr, fq * 8), boff = lds_byte(wc * 32 + fr, fq * 8);
    const int aoff8 = lds_byte(wr * 64 + fr, (fq >> 1) * 32 + (fq & 1) * 16) & ~31, boff8 = lds_byte(wc * 32 + fr, (fq >> 1) * 32 + (fq & 1) * 16) & ~31;
#define PG8_SA(b, h) (((b) * 2 + (h)) * HTB)
#define PG8_SB(b, h) ((4 + (b) * 2 + (h)) * HTB)
#define PG8_STAGE(bufoff, gbase, voff) do { _Pragma("unroll") for (int _i = 0; _i < 2; ++_i) \
        __builtin_amdgcn_global_load_lds((const unsigned*)((const char*)(gbase) + (voff)[_i]), (LAS unsigned*)(lds + (bufoff) + ldsw + _i * 8192), 16, 0, 0); } while (0)
#define PG8_STAGE_B(bufoff, kptr, half) do { if constexpr (Epi::ADJ) { PG8_STAGE(bufoff, kptr, voffBa[half]); } else { PG8_STAGE(bufoff, (kptr) + (half) * hstep, voffB); } } while (0)
#define PG8_STAGE_A(bufoff, kptr, half, VG) do { if constexpr (GATHER) { PG8_STAGE(bufoff, kptr, (VG)[half]); } else { PG8_STAGE(bufoff, (kptr) + (half) * hstep, voffA); } } while (0)
#define PG8_LDA(dst, b, h) do { if constexpr (FP8) { _Pragma("unroll") for (int m = 0; m < 4; ++m) dst##8[m] = cat8(*(const LAS bf16x8*)(lds + PG8_SA(b, h) + aoff8 + m * 2048), *(const LAS bf16x8*)(lds + PG8_SA(b, h) + aoff8 + m * 2048 + 16)); } \
        else { _Pragma("unroll") for (int m = 0; m < 4; ++m) _Pragma("unroll") for (int k = 0; k < 2; ++k) dst[m][k] = *(const LAS bf16x8*)(lds + PG8_SA(b, h) + aoff + m * 2048 + k * 1024); } } while (0)
#define PG8_LDB(dst, b, h) do { if constexpr (FP8) { _Pragma("unroll") for (int n = 0; n < 2; ++n) dst##8[n] = cat8(*(const LAS bf16x8*)(lds + PG8_SB(b, h) + boff8 + n * 2048), *(const LAS bf16x8*)(lds + PG8_SB(b, h) + boff8 + n * 2048 + 16)); } \
        else { _Pragma("unroll") for (int n = 0; n < 2; ++n) _Pragma("unroll") for (int k = 0; k < 2; ++k) dst[n][k] = *(const LAS bf16x8*)(lds + PG8_SB(b, h) + boff + n * 2048 + k * 1024); } } while (0)
#define PG8_MMA(ai, bj, At, Bt) do { __builtin_amdgcn_s_setprio(1); if constexpr (FP8) { _Pragma("unroll") for (int m = 0; m < 4; ++m) _Pragma("unroll") for (int n = 0; n < 2; ++n) \
        asm volatile("v_mfma_scale_f32_16x16x128_f8f6f4 %0, %1, %2, %0, %3, %4 op_sel_hi:[0,0,0]" : "+v"(acc[ai][bj][m][n]) : "v"(Bt##8[n]), "v"(At##8[m]), "v"(sc8w), "v"(sc8)); } \
        else { _Pragma("unroll") for (int k = 0; k < 2; ++k) _Pragma("unroll") for (int m = 0; m < 4; ++m) _Pragma("unroll") for (int n = 0; n < 2; ++n) \
        asm volatile("v_mfma_f32_16x16x32_bf16 %0, %1, %2, %0" : "+v"(acc[ai][bj][m][n]) : "v"(Bt[n][k]), "v"(At[m][k])); } __builtin_amdgcn_s_setprio(0); } while (0)
#define PG8_MMA0(ai, bj, At, Bt) do { __builtin_amdgcn_s_setprio(1); if constexpr (FP8) { _Pragma("unroll") for (int m = 0; m < 4; ++m) _Pragma("unroll") for (int n = 0; n < 2; ++n) \
        asm volatile("v_mfma_scale_f32_16x16x128_f8f6f4 %0, %1, %2, 0, %3, %4 op_sel_hi:[0,0,0]" : "=v"(acc[ai][bj][m][n]) : "v"(Bt##8[n]), "v"(At##8[m]), "v"(sc8w), "v"(sc8)); } \
        else { _Pragma("unroll") for (int m = 0; m < 4; ++m) _Pragma("unroll") for (int n = 0; n < 2; ++n) \
        asm volatile("v_mfma_f32_16x16x32_bf16 %0, %1, %2, 0" : "=v"(acc[ai][bj][m][n]) : "v"(Bt[n][0]), "v"(At[m][0])); \
        _Pragma("unroll") for (int m = 0; m < 4; ++m) _Pragma("unroll") for (int n = 0; n < 2; ++n) \
        asm volatile("v_mfma_f32_16x16x32_bf16 %0, %1, %2, %0" : "+v"(acc[ai][bj][m][n]) : "v"(Bt[n][1]), "v"(At[m][1])); } __builtin_amdgcn_s_setprio(0); } while (0)
#define PG8_WAIT_V(n) asm volatile("s_waitcnt vmcnt(" #n ")" ::: "memory")
#define PG8_WAIT_L(n) asm volatile("s_waitcnt lgkmcnt(" #n ")" ::: "memory")
#define PG8_BAR __builtin_amdgcn_s_barrier()
#define PG8_SCHED __builtin_amdgcn_sched_barrier(0)
    Unit cur, nxt; int ui = 0;
    if (!S.next(0, cur)) return;
    f32x4 acc[2][2][4][2];
#pragma unroll
    for (int a = 0; a < 2; ++a)
#pragma unroll
        for (int b = 0; b < 2; ++b)
#pragma unroll
            for (int m = 0; m < 4; ++m)
#pragma unroll
                for (int n = 0; n < 2; ++n) asm volatile("" : "=v"(acc[a][b][m][n]));
    bf16x8 At[4][2], B0[2][2], B1[2][2]; v8i_t At8[4], B08[2], B18[2]; const int sc8 = 0x7f7f7f7f; int sc8w = 0x7f7f7f7f; if constexpr (FP8) sc8w = Epi::SCW;
    const char* cA = S.a_ptr(cur); const char* cB = S.b_ptr(cur);
    unsigned vcur[2][2] = {{0u, 0u}, {0u, 0u}}, vnext[2][2] = {{0u, 0u}, {0u, 0u}}, vt2[2][2] = {{0u, 0u}, {0u, 0u}};
    if constexpr (GATHER) S.gather(cur, sR[0], sR[1], sC[0], sC[1], 0, vcur);
    PG8_STAGE_B(PG8_SB(0, 0), cB, 0); PG8_STAGE_B(PG8_SB(0, 1), cB, 1); PG8_STAGE_A(PG8_SA(0, 0), cA, 0, vcur); PG8_STAGE_A(PG8_SA(0, 1), cA, 1, vcur);
    if (wr == 1) PG8_BAR;
    PG8_WAIT_V(2); PG8_BAR;
    PG8_STAGE_B(PG8_SB(1, 0), cB + kstep, 0); PG8_STAGE_A(PG8_SA(1, 0), cA + kstep, 0, vcur); PG8_STAGE_B(PG8_SB(1, 1), cB + kstep, 1);
    PG8_WAIT_V(6); PG8_BAR;
    for (;;) {
        const bool has_next = S.next(ui + 1, nxt);
        const char* nA = has_next ? S.a_ptr(nxt) : cA; const char* nB = has_next ? S.b_ptr(nxt) : cB;
        if constexpr (GATHER) { if (has_next) S.gather(nxt, sR[0], sR[1], sC[0], sC[1], 0, vnext); else {
#pragma unroll
            for (int h = 0; h < 2; ++h) { vnext[h][0] = vcur[h][0]; vnext[h][1] = vcur[h][1]; } } }
#define PG8_KITER(t, MM) do { \
            const bool last = (t == nt - 2); \
            const char* a1 = cA + (size_t)(t + 1) * kstep; \
            const char* a2 = last ? nA : cA + (size_t)(t + 2) * kstep; const char* b2 = last ? nB : cB + (size_t)(t + 2) * kstep; \
            const char* a3 = a2 + kstep; const char* b3 = b2 + kstep; \
            if constexpr (GATHER) { \
            _Pragma("unroll") \
                for (int h = 0; h < 2; ++h) { vt2[h][0] = last ? vnext[h][0] : vcur[h][0]; vt2[h][1] = last ? vnext[h][1] : vcur[h][1]; } } \
            PG8_LDB(B0, 0, 0); PG8_LDB(B1, 0, 1); PG8_SCHED; PG8_LDA(At, 0, 0); PG8_STAGE_A(PG8_SA(1, 1), a1, 1, vcur); \
            PG8_WAIT_V(8); PG8_WAIT_L(0); PG8_BAR; MM(0, 0, At, B0); MM(0, 1, At, B1); PG8_BAR; PG8_SCHED; \
            PG8_LDA(At, 0, 1); PG8_STAGE_B(PG8_SB(0, 0), b2, 0); PG8_STAGE_B(PG8_SB(0, 1), b2, 1); PG8_STAGE_A(PG8_SA(0, 0), a2, 0, vt2); \
            PG8_WAIT_V(8); PG8_WAIT_L(0); PG8_BAR; MM(1, 0, At, B0); MM(1, 1, At, B1); PG8_BAR; PG8_SCHED; \
            PG8_LDB(B0, 1, 0); PG8_LDB(B1, 1, 1); PG8_SCHED; PG8_LDA(At, 1, 0); PG8_STAGE_A(PG8_SA(0, 1), a2, 1, vt2); \
            PG8_WAIT_V(8); PG8_WAIT_L(0); PG8_BAR; PG8_MMA(0, 0, At, B0); PG8_MMA(0, 1, At, B1); PG8_BAR; PG8_SCHED; \
            PG8_LDA(At, 1, 1); PG8_STAGE_B(PG8_SB(1, 0), b3, 0); PG8_STAGE_B(PG8_SB(1, 1), b3, 1); PG8_STAGE_A(PG8_SA(1, 0), a3, 0, vt2); \
            PG8_WAIT_V(8); PG8_WAIT_L(0); PG8_BAR; PG8_MMA(1, 0, At, B0); PG8_MMA(1, 1, At, B1); PG8_BAR; PG8_SCHED; \
        } while (0)
        { const int t = 0; PG8_KITER(t, PG8_MMA0); }
        for (int t = 2; t < nt; t += 2) { PG8_KITER(t, PG8_MMA); }
#undef PG8_KITER
        if (wr == 0) PG8_BAR;
        asm volatile("s_nop 15\n\ts_nop 15" ::: "memory");
        for (int rp_ = 0; rp_ < Epi::REPS; ++rp_) E(acc, cur, wr, wc, fr, fq);
        if (!has_next) break;
        cur = nxt; cA = nA; cB = nB; ++ui;
        if constexpr (GATHER) {
#pragma unroll
            for (int h = 0; h < 2; ++h) { vcur[h][0] = vnext[h][0]; vcur[h][1] = vnext[h][1]; } }
        if (wr == 1) PG8_BAR;
    }
    PG8_WAIT_V(0);
    PG8_BAR;
#undef PG8_SA
#undef PG8_SB
#undef PG8_STAGE
#undef PG8_STAGE_A
#undef PG8_STAGE_B
#undef PG8_LDA
#undef PG8_LDB
#undef PG8_MMA
#undef PG8_MMA0
#undef PG8_WAIT_V
#undef PG8_WAIT_L
#undef PG8_BAR
#undef PG8_SCHED
}

__device__ __forceinline__ void store_lines(unsigned char* rowbase  , size_t pitch, int fr, int fq, const u32x4 w0, const u32x4 w1) {
    const bool lo = fr < 8; const u32x4 snd = lo ? w1 : w0; u32x4 rcv;
    rcv.x = (unsigned)__builtin_amdgcn_mov_dpp((int)snd.x, 0x128, 0xf, 0xf, true); rcv.y = (unsigned)__builtin_amdgcn_mov_dpp((int)snd.y, 0x128, 0xf, 0xf, true);
    rcv.z = (unsigned)__builtin_amdgcn_mov_dpp((int)snd.z, 0x128, 0xf, 0xf, true); rcv.w = (unsigned)__builtin_amdgcn_mov_dpp((int)snd.w, 0x128, 0xf, 0xf, true);
    unsigned char* p = rowbase + (size_t)(fr & 7) * pitch + (lo ? 0 : 64) + 16 * fq;
    *(u32x4*)p = lo ? w0 : rcv;
    *(u32x4*)(p + 8 * pitch) = lo ? rcv : w1;
}
template <int NP> __device__ __forceinline__ float row_rs(const float* ssq, int row) {
    float s;
    if constexpr (NP == 1) s = ssq[row];
    else { const f32x4* p = (const f32x4*)(ssq + (size_t)row * 16); const f32x4 a = p[0], b = p[1], c = p[2], d = p[3];
        s = (((a[0] + a[1]) + (a[2] + a[3])) + ((b[0] + b[1]) + (b[2] + b[3]))) + (((c[0] + c[1]) + (c[2] + c[3])) + ((d[0] + d[1]) + (d[2] + d[3]))); }
    return __builtin_amdgcn_rsqf(s * (1.0f / D) + RMS_EPS);
}
__device__ __forceinline__ void panel_rs_to_lds(const float* ssq, int pm, LAS float* rsl) {
    if (threadIdx.x < 256) rsl[threadIdx.x] = row_rs<16>(ssq, pm * 256 + (int)threadIdx.x);
    asm volatile("s_waitcnt lgkmcnt(0)" ::: "memory"); __builtin_amdgcn_s_barrier(); asm volatile("" ::: "memory");
}
template <int NP> struct EpiScaleBf16 {
    static constexpr bool PERM = true; static constexpr bool ADJ = true; static constexpr int REPS = 1;
    bf16_t* O; int ldc; const float* ssq; LAS float* rsl;
    __device__ __forceinline__ void operator()(const f32x4 (&acc)[2][2][4][2], const Unit& u, int wr, int wc, int fr, int fq) const {
        const int rowg = u.pm * BM + wr * 64, colw = u.pn * BM + wc * 64;
        if constexpr (NP == 16) panel_rs_to_lds(ssq, u.pm, rsl);
#pragma unroll
        for (int ai = 0; ai < 2; ++ai)
#pragma unroll
            for (int m = 0; m < 4; ++m) { const int row = rowg + ai * HALF + m * 16 + fr; float rs; if constexpr (NP == 16) rs = rsl[wr * 64 + ai * HALF + m * 16 + fr]; else rs = row_rs<NP>(ssq, row);
                u32x4 w[2];
#pragma unroll
                for (int bj = 0; bj < 2; ++bj) { const f32x4 v0 = acc[ai][bj][m][0] * rs, v1 = acc[ai][bj][m][1] * rs;
                    w[bj].x = cvt_pk_bf16(v0[0], v0[1]); w[bj].y = cvt_pk_bf16(v0[2], v0[3]); w[bj].z = cvt_pk_bf16(v1[0], v1[1]); w[bj].w = cvt_pk_bf16(v1[2], v1[3]); }
                store_lines((unsigned char*)(O + (size_t)(rowg + ai * HALF + m * 16) * ldc + colw), (size_t)ldc * 2, fr, fq, w[0], w[1]); }
    }
};
template <bool SSQ, bool BASE32> struct EpiResid {
    static constexpr bool PERM = true; static constexpr bool ADJ = true; static constexpr int REPS = 1;
    const float* base32; bf16_t* xb; float* ssq;
    __device__ __forceinline__ void operator()(const f32x4 (&acc)[2][2][4][2], const Unit& u, int wr, int wc, int fr, int fq) const {
        const int rowg = u.pm * BM + wr * 64, colw = u.pn * BM + wc * 64;
#pragma unroll
        for (int ai = 0; ai < 2; ++ai) {
            float bs[4][2][8];
#pragma unroll
            for (int m = 0; m < 4; ++m)
#pragma unroll
                for (int bj = 0; bj < 2; ++bj) { const size_t off = (size_t)(rowg + ai * HALF + m * 16 + fr) * D + colw + 32 * bj + 8 * fq;
                    if constexpr (BASE32) { const f32x4 a = *(const f32x4*)(base32 + off), b = *(const f32x4*)(base32 + off + 4);
                        bs[m][bj][0] = a[0]; bs[m][bj][1] = a[1]; bs[m][bj][2] = a[2]; bs[m][bj][3] = a[3]; bs[m][bj][4] = b[0]; bs[m][bj][5] = b[1]; bs[m][bj][6] = b[2]; bs[m][bj][7] = b[3]; }
                    else { const u32x4 r = *(const u32x4*)(xb + off);
                        bs[m][bj][0] = __builtin_bit_cast(float, r.x << 16); bs[m][bj][1] = __builtin_bit_cast(float, r.x & 0xffff0000u); bs[m][bj][2] = __builtin_bit_cast(float, r.y << 16); bs[m][bj][3] = __builtin_bit_cast(float, r.y & 0xffff0000u);
                        bs[m][bj][4] = __builtin_bit_cast(float, r.z << 16); bs[m][bj][5] = __builtin_bit_cast(float, r.z & 0xffff0000u); bs[m][bj][6] = __builtin_bit_cast(float, r.w << 16); bs[m][bj][7] = __builtin_bit_cast(float, r.w & 0xffff0000u); } }
            asm volatile("" ::: "memory");
#pragma unroll
            for (int m = 0; m < 4; ++m) { const int row = rowg + ai * HALF + m * 16 + fr; float s = 0.f; u32x4 w[2];
#pragma unroll
                for (int bj = 0; bj < 2; ++bj) { float o[8];
#pragma unroll
                    for (int n = 0; n < 2; ++n)
#pragma unroll
                        for (int j = 0; j < 4; ++j) o[n * 4 + j] = bs[m][bj][n * 4 + j] + acc[ai][bj][m][n][j];
                    w[bj].x = cvt_pk_bf16(o[0], o[1]); w[bj].y = cvt_pk_bf16(o[2], o[3]); w[bj].z = cvt_pk_bf16(o[4], o[5]); w[bj].w = cvt_pk_bf16(o[6], o[7]);
                    if constexpr (SSQ) { const unsigned ww[4] = {w[bj].x, w[bj].y, w[bj].z, w[bj].w};
#pragma unroll
                        for (int q = 0; q < 4; ++q) { const float r0 = __builtin_bit_cast(float, ww[q] << 16), r1 = __builtin_bit_cast(float, ww[q] & 0xffff0000u); s += r0 * r0 + r1 * r1; } } }
                store_lines((unsigned char*)(xb + (size_t)(rowg + ai * HALF + m * 16) * D + colw), (size_t)D * 2, fr, fq, w[0], w[1]);
                if constexpr (SSQ) { s += __shfl_xor(s, 16); s += __shfl_xor(s, 32);
                    if (fq == 0) ssq[(size_t)row * 16 + u.pn * 4 + wc] = s; } }
            asm volatile("" ::: "memory"); }
    }
};
template <int NP> struct EpiSwiglu {
    static constexpr bool PERM = true; static constexpr bool ADJ = false; static constexpr int REPS = REP_EPI;
    bf16_t* O; int ldc; const float* ssq; LAS float* rsl;
    __device__ __forceinline__ void operator()(const f32x4 (&acc)[2][2][4][2], const Unit& u, int wr, int wc, int fr, int fq) const {
        const int row0 = u.pm * BM + wr * 64 + fr, col0 = u.pn * HALF + wc * 32 + 8 * fq;
        if constexpr (NP == 16) panel_rs_to_lds(ssq, u.pm, rsl);
#pragma unroll
        for (int ai = 0; ai < 2; ++ai)
#pragma unroll
            for (int m = 0; m < 4; ++m) { const int row = row0 + ai * HALF + m * 16; float rs; if constexpr (NP == 16) rs = rsl[wr * 64 + fr + ai * HALF + m * 16]; else rs = row_rs<NP>(ssq, row);
                float h[8];
#pragma unroll
                for (int n = 0; n < 2; ++n)
#pragma unroll
                    for (int j = 0; j < 4; j += 2) { const f32x2 hh = swiglu2((f32x2){acc[ai][0][m][n][j], acc[ai][0][m][n][j + 1]}, (f32x2){acc[ai][1][m][n][j], acc[ai][1][m][n][j + 1]}, rs); h[n * 4 + j] = hh.x; h[n * 4 + j + 1] = hh.y; }
                u32x4 w; w.x = cvt_pk_bf16(h[0], h[1]); w.y = cvt_pk_bf16(h[2], h[3]); w.z = cvt_pk_bf16(h[4], h[5]); w.w = cvt_pk_bf16(h[6], h[7]);
                *(u32x4*)(O + (size_t)row * ldc + col0) = w; }
    }
};
struct EpiSwigluMoe {
    static constexpr bool PERM = true; static constexpr bool ADJ = false; static constexpr int REPS = 1; static constexpr int SCW = 0x7f7f7f7f;
    bf16_t* O; int ldc; const float* rsv; const int* row_tok; float wsinv;
    __device__ __forceinline__ void operator()(const f32x4 (&acc)[2][2][4][2], const Unit& u, int wr, int wc, int fr, int fq) const {
        const int row0 = u.pm * BM + wr * 64 + fr, col0 = u.pn * HALF + wc * 32 + 8 * fq;
#pragma unroll
        for (int ai = 0; ai < 2; ++ai)
#pragma unroll
            for (int m = 0; m < 4; ++m) { const int row = row0 + ai * HALF + m * 16; const int tok = row_tok[row]; const float rs = tok >= 0 ? rsv[tok] * wsinv : 0.f;
                float h[8];
#pragma unroll
                for (int n = 0; n < 2; ++n)
#pragma unroll
                    for (int j = 0; j < 4; j += 2) { const f32x2 hh = swiglu2((f32x2){acc[ai][0][m][n][j], acc[ai][0][m][n][j + 1]}, (f32x2){acc[ai][1][m][n][j], acc[ai][1][m][n][j + 1]}, rs); h[n * 4 + j] = hh.x; h[n * 4 + j + 1] = hh.y; }
                u32x4 w; w.x = cvt_pk_bf16(h[0], h[1]); w.y = cvt_pk_bf16(h[2], h[3]); w.z = cvt_pk_bf16(h[4], h[5]); w.w = cvt_pk_bf16(h[6], h[7]);
                *(u32x4*)(O + (size_t)row * ldc + col0) = w; }
    }
};
struct EpiSwigluMoe8 {
    static constexpr bool PERM = true; static constexpr bool ADJ = false; static constexpr int REPS = 1; static constexpr int SCW = 0x79797979;
    unsigned char* O; int ldc;
    __device__ __forceinline__ void operator()(const f32x4 (&acc)[2][2][4][2], const Unit& u, int wr, int wc, int fr, int fq) const {
        const int row0 = u.pm * BM + wr * 64 + fr, col0 = u.pn * HALF + wc * 32 + 8 * fq;
        constexpr float K = -1.44269504f;
#pragma unroll
        for (int ai = 0; ai < 2; ++ai)
#pragma unroll
            for (int m = 0; m < 4; ++m) { const int row = row0 + ai * HALF + m * 16;
                float h[8];
#pragma unroll
                for (int n = 0; n < 2; ++n)
#pragma unroll
                    for (int j = 0; j < 4; j += 2) { const f32x2 a = {acc[ai][0][m][n][j], acc[ai][0][m][n][j + 1]}, uu = {acc[ai][1][m][n][j], acc[ai][1][m][n][j + 1]};
                        f32x2 e; e.x = __builtin_amdgcn_exp2f(a.x); e.y = __builtin_amdgcn_exp2f(a.y);
                        const f32x2 d = e * K + K, p = a * uu; f32x2 r; r.x = __builtin_amdgcn_rcpf(d.x); r.y = __builtin_amdgcn_rcpf(d.y);
                        const f32x2 hh = p * r; h[n * 4 + j] = hh.x; h[n * 4 + j + 1] = hh.y; }
                u32x2 w; w.x = pk4_fp8(h[0], h[1], h[2], h[3]); w.y = pk4_fp8(h[4], h[5], h[6], h[7]);
                *(u32x2*)(O + (size_t)row * ldc + col0) = w; }
    }
};
struct EpiMoeDown {
    static constexpr bool PERM = false; static constexpr bool ADJ = false; static constexpr int REPS = 1; static constexpr int SCW = 0x7f7f7f7f;
    bf16_t* out; const int* row_tok; const float* row_gate; float sc; LAS int* tkl;
    __device__ __forceinline__ void operator()(const f32x4 (&acc)[2][2][4][2], const Unit& u, int wr, int wc, int fr, int fq) const {
        const int row0 = u.pm * BM + wr * 64 + fr, col0 = u.pn * BM + wc * 32 + 4 * fq;
        if (threadIdx.x < 256) { tkl[threadIdx.x] = row_tok[u.pm * BM + (int)threadIdx.x]; ((LAS float*)tkl)[256 + threadIdx.x] = row_gate[u.pm * BM + (int)threadIdx.x]; }
        asm volatile("s_waitcnt lgkmcnt(0)" ::: "memory"); __builtin_amdgcn_s_barrier(); asm volatile("" ::: "memory");
        int tk[2][4]; float gt[2][4];
#pragma unroll
        for (int ai = 0; ai < 2; ++ai)
#pragma unroll
            for (int m = 0; m < 4; ++m) { const int rl = wr * 64 + fr + ai * HALF + m * 16; tk[ai][m] = tkl[rl]; gt[ai][m] = ((const LAS float*)tkl)[256 + rl]; }
#pragma unroll
        for (int ai = 0; ai < 2; ++ai)
#pragma unroll
            for (int m = 0; m < 4; ++m) { const int tok = tk[ai][m]; const float g = gt[ai][m] * sc;
                if (tok >= 0) { bf16_t* rp = out + (size_t)tok * D + col0; u32x2 cur[2][2];
#pragma unroll
                    for (int bj = 0; bj < 2; ++bj)
#pragma unroll
                        for (int n = 0; n < 2; ++n) cur[bj][n] = *(const u32x2*)(rp + bj * HALF + n * 16);
#pragma unroll
                    for (int bj = 0; bj < 2; ++bj)
#pragma unroll
                        for (int n = 0; n < 2; ++n) { const u32x2 r = cur[bj][n]; const f32x4 a = acc[ai][bj][m][n] * g;
                            u32x2 w; w.x = cvt_pk_bf16(__builtin_bit_cast(float, r.x << 16) + a[0], __builtin_bit_cast(float, r.x & 0xffff0000u) + a[1]);
                            w.y = cvt_pk_bf16(__builtin_bit_cast(float, r.y << 16) + a[2], __builtin_bit_cast(float, r.y & 0xffff0000u) + a[3]); *(u32x2*)(rp + bj * HALF + n * 16) = w; } }
                asm volatile("" ::: "memory"); }
    }
};
}

#define XB_TMO      128
#define XB_XCNT(j)  (256  + 64 * (j))
#define XB_XSUB(j)  (1280 + 64 * (j))
#define XB_XGEN(j)  (2304 + 64 * (j))
#define XB_TOP      3328
#define XB_TOPGEN   3392
#define XCD_BAR_WORDS 3456
#define XB_SPIN_CAP (1u << 18)
__device__ __forceinline__ unsigned xb_ld(unsigned* p)              { return __hip_atomic_load(p, __ATOMIC_RELAXED, __HIP_MEMORY_SCOPE_AGENT); }
__device__ __forceinline__ unsigned xb_add(unsigned* p, unsigned v) { return __hip_atomic_fetch_add(p, v, __ATOMIC_RELAXED, __HIP_MEMORY_SCOPE_AGENT); }
__device__ __forceinline__ unsigned xb_xcc_id() { return (unsigned)__builtin_amdgcn_s_getreg((3 << 11) | 20) & 0xFu; }
#define XB_SPIN(cond, bar) do { unsigned _sp = 0; while (cond) { __builtin_amdgcn_s_sleep(1); \
    if ((++_sp & 255u) == 0u) { if (xb_ld(&(bar)[XB_TMO])) break; if (_sp > XB_SPIN_CAP) { atomicAdd(&(bar)[XB_TMO], 1u); break; } } } } while (0)
struct XcdBarrier { unsigned* bar; unsigned x; volatile LAS unsigned* st; };
__device__ __forceinline__ XcdBarrier xcd_barrier_post(unsigned* bar, volatile LAS unsigned* st) {
    XcdBarrier b; b.bar = bar; b.x = xb_xcc_id(); b.st = st;
    if (threadIdx.x == 0) (void)xb_add(&bar[XB_XCNT(b.x)], 1u);
    return b;
}
__device__ __forceinline__ void xcd_barrier_complete(unsigned* bar, unsigned x, unsigned& nloc, unsigned& nx) {
    const unsigned G = gridDim.x * gridDim.y * gridDim.z;
    unsigned sum, cnt, mine, sp = 0u;
    for (;;) {
        sum = 0u; cnt = 0u; mine = 0u;
#pragma unroll
        for (unsigned j = 0; j < 16; ++j) { const unsigned c = xb_ld(&bar[XB_XCNT(j)]); sum += c; cnt += (c > 0u) ? 1u : 0u; mine = (j == x) ? c : mine; }
        if (sum == G) break;
        __builtin_amdgcn_s_sleep(1);
        if ((++sp & 255u) == 0u) { if (xb_ld(&bar[XB_TMO])) break; if (sp > XB_SPIN_CAP) { atomicAdd(&bar[XB_TMO], 1u); break; } }
    }
    nloc = mine > 0u ? mine : 1u; nx = cnt > 0u ? cnt : 1u;
}
__device__ __forceinline__ void xcd_barrier(const XcdBarrier& b) {
    asm volatile("s_waitcnt vmcnt(0)" ::: "memory");
    __syncthreads();
    if (threadIdx.x == 0) {
        unsigned* bar = b.bar;
        __builtin_amdgcn_s_waitcnt(0);
        unsigned nloc = b.st[0], nx = b.st[1];
        if (nloc == 0u) { xcd_barrier_complete(bar, b.x, nloc, nx); b.st[0] = nloc; b.st[1] = nx; }
        const unsigned old = xb_add(&bar[XB_XSUB(b.x)], 1u);
        const unsigned gen = old / nloc;
        if (old + 1u == (gen + 1u) * nloc) {
            __builtin_amdgcn_fence(__ATOMIC_RELEASE, "agent");
            asm volatile("s_waitcnt vmcnt(0)" ::: "memory");
            const unsigned og = xb_add(&bar[XB_TOP], 1u);
            const unsigned tg = og / nx;
            if (og + 1u == (tg + 1u) * nx) xb_add(&bar[XB_TOPGEN], 1u);
            else XB_SPIN(xb_ld(&bar[XB_TOPGEN]) == tg, bar);
            __builtin_amdgcn_fence(__ATOMIC_ACQUIRE, "agent");
            xb_add(&bar[XB_XGEN(b.x)], 1u);
            asm volatile("s_waitcnt vmcnt(0)" ::: "memory");
        } else {
            XB_SPIN(xb_ld(&bar[XB_XGEN(b.x)]) == gen, bar);
            __builtin_amdgcn_fence(__ATOMIC_ACQUIRE, "agent");
            asm volatile("s_waitcnt vmcnt(0)" ::: "memory");
        }
    }
    __syncthreads();
}

__device__ __forceinline__ void hnd_arrive(unsigned* w) {
    asm volatile("s_waitcnt vmcnt(0)" ::: "memory");
    __syncthreads();
    if (threadIdx.x == 0) { __builtin_amdgcn_fence(__ATOMIC_RELEASE, "agent"); asm volatile("s_waitcnt vmcnt(0)" ::: "memory"); (void)xb_add(w, 1u); }
}
__device__ __forceinline__ void hnd_wait(unsigned* w, unsigned target, unsigned* bar) {
    if (threadIdx.x == 0) { XB_SPIN(xb_ld(w) < target, bar); __builtin_amdgcn_fence(__ATOMIC_ACQUIRE, "agent"); asm volatile("s_waitcnt vmcnt(0)" ::: "memory"); }
    __syncthreads();
}

constexpr int NIN = 28;
struct Args { const float* in[NIN]; float* out; unsigned char* ws; int ph_lo, ph_hi; };
enum { I_X = 0, I_NORM_MIX, I_W_IN, I_W_OUT, I_SHIFT_MU, I_GM_LN_W, I_GM_LN_B, I_GM_WS, I_GM_BS, I_RW_W_UP, I_RW_W0, I_RW_A_UP, I_RW_A0, I_RW_G_UP, I_RW_K_K, I_RW_K_A, I_RW_R_K,
       I_RW_LNX_W, I_RW_LNX_B, I_NORM_FFN, I_FFN_WG, I_FFN_WU, I_FFN_WD, I_MOE_ROUTER, I_MOE_WG, I_MOE_WU, I_MOE_WD, I_NORM_FINAL };

struct Frame {
    LAS unsigned char* lds;
    int tid, lane, wave, G, gw, NGW;
};

struct CvItem { f32x4 v[8]; float gn[8]; };
__device__ __forceinline__ void cv_load(CvItem& it, const float* W, int N, int k0, int n0, const float* gain, float scale, int lane) {
    const int kr = lane >> 3, nq = lane & 7;
#pragma unroll
    for (int i = 0; i < 8; ++i) { it.v[i] = *(const GAS f32x4*)(W + (size_t)(k0 + 8 * i + kr) * N + n0 + 4 * nq); it.gn[i] = gain ? gain[k0 + 8 * i + kr] * scale : scale; }
}
__device__ __forceinline__ void cv_store_fp8(const CvItem& it, int K, unsigned char* WT, int drow0, int k0, LAS float* scr, int lane) {
    { const int kr = lane >> 3, nq = lane & 7;
#pragma unroll
      for (int i = 0; i < 8; ++i) { LAS float* d = scr + (8 * i + kr) * 33 + 4 * nq; d[0] = it.v[i][0] * it.gn[i]; d[1] = it.v[i][1] * it.gn[i]; d[2] = it.v[i][2] * it.gn[i]; d[3] = it.v[i][3] * it.gn[i]; } }
    LDS_WAIT(); asm volatile("" ::: "memory");
    const int n = lane >> 1, hf = lane & 1; const LAS float* sp = scr + (32 * hf) * 33 + n; u32x4 o0, o1;
    o0.x = pk4_fp8(sp[0 * 33], sp[1 * 33], sp[2 * 33], sp[3 * 33]); o0.y = pk4_fp8(sp[4 * 33], sp[5 * 33], sp[6 * 33], sp[7 * 33]); o0.z = pk4_fp8(sp[8 * 33], sp[9 * 33], sp[10 * 33], sp[11 * 33]); o0.w = pk4_fp8(sp[12 * 33], sp[13 * 33], sp[14 * 33], sp[15 * 33]);
    o1.x = pk4_fp8(sp[16 * 33], sp[17 * 33], sp[18 * 33], sp[19 * 33]); o1.y = pk4_fp8(sp[20 * 33], sp[21 * 33], sp[22 * 33], sp[23 * 33]); o1.z = pk4_fp8(sp[24 * 33], sp[25 * 33], sp[26 * 33], sp[27 * 33]); o1.w = pk4_fp8(sp[28 * 33], sp[29 * 33], sp[30 * 33], sp[31 * 33]);
    unsigned char* dst = WT + (size_t)(drow0 + n) * K + k0 + 32 * hf; *(GAS u32x4*)dst = o0; *(GAS u32x4*)(dst + 16) = o1;
    LDS_WAIT(); asm volatile("" ::: "memory");
}
__device__ __forceinline__ void transpose_item(const float* W, int K, int N, bf16* WT, int drow0, int k0, int n0, const float* gain, LAS float* scr, int lane) {
    { const int kr = lane >> 3, nq = lane & 7; f32x4 v[8]; float gn[8];
#pragma unroll
      for (int i = 0; i < 8; ++i) { v[i] = *(const GAS f32x4*)(W + (size_t)(k0 + 8 * i + kr) * N + n0 + 4 * nq); gn[i] = gain ? gain[k0 + 8 * i + kr] : 1.f; }
#pragma unroll
      for (int i = 0; i < 8; ++i) { LAS float* d = scr + (8 * i + kr) * 33 + 4 * nq; d[0] = v[i][0] * gn[i]; d[1] = v[i][1] * gn[i]; d[2] = v[i][2] * gn[i]; d[3] = v[i][3] * gn[i]; } }
    LDS_WAIT(); asm volatile("" ::: "memory");
    const int c = lane & 7;
#pragma unroll
    for (int j = 0; j < 4; ++j) { const int n = (lane >> 3) + 8 * j; const LAS float* s = scr + (8 * c) * 33 + n;
        u32x4 o; o.x = pk2(s[0 * 33], s[1 * 33]); o.y = pk2(s[2 * 33], s[3 * 33]); o.z = pk2(s[4 * 33], s[5 * 33]); o.w = pk2(s[6 * 33], s[7 * 33]);
        *(GAS u32x4*)(WT + (size_t)(drow0 + n) * K + k0 + 8 * c) = o; }
    LDS_WAIT(); asm volatile("" ::: "memory");
}
__device__ __forceinline__ void convert_matrix_fp8(Frame& F, const float* W, int K, int N, unsigned char* WT, int gu_mode  , const float* gain, float scale, int& itbase) {
    LAS float* scr = (LAS float*)(F.lds + F.wave * 16384);
    const int nblk = N / 32, nit = (K / 64) * nblk;
    int first = F.gw - (itbase % F.NGW); if (first < 0) first += F.NGW;
    CvItem nx;
    if (first < nit) cv_load(nx, W, N, 64 * (first / nblk), 32 * (first % nblk), gain, scale, F.lane);
    for (int r = first; r < nit; r += F.NGW) { const int kb = r / nblk, nb = r % nblk, n0 = 32 * nb;
        const int drow0 = gu_mode == 0 ? n0 : (n0 / 128) * 256 + (gu_mode == 2 ? 128 : 0) + (n0 % 128);
        const CvItem cur = nx; const int r2 = r + F.NGW;
        if (r2 < nit) cv_load(nx, W, N, 64 * (r2 / nblk), 32 * (r2 % nblk), gain, scale, F.lane);
        cv_store_fp8(cur, K, WT, drow0, 64 * kb, scr, F.lane); }
    itbase += nit;
}
__device__ __forceinline__ void convert_matrix(Frame& F, const float* W, int K, int N, bf16* WT, int gu_mode  , const float* gain, int it0, int& itbase) {
    LAS float* scr = (LAS float*)(F.lds + F.wave * 16384);
    const int nblk = N / 32, nit = (K / 64) * nblk;
    int first = F.gw - (itbase % F.NGW); if (first < 0) first += F.NGW;
    for (int r = first; r < nit; r += F.NGW) { const int kb = r / nblk, nb = r % nblk, n0 = 32 * nb;
        const int drow0 = gu_mode == 0 ? n0 : (n0 / 128) * 256 + (gu_mode == 2 ? 128 : 0) + (n0 % 128);
        transpose_item(W, K, N, WT, drow0, 64 * kb, n0, gain, scr, F.lane); }
    itbase += nit; (void)it0;
}

__device__ __forceinline__ void gmlp_naive(Frame& F, const bf16* P, bf16* Y, const float* ln_w, const float* ln_b, const float* ws, const float* bs) {
    LAS float* V = (LAS float*)F.lds;
    for (int unit = blockIdx.x; unit < NB * (SEQ / GCH) * NH; unit += F.G) {
        const int h = unit % NH, bc = unit / NH; const size_t row0 = (size_t)bc * GCH;
        const float lw = ln_w[h * HD + F.lane], lb = ln_b[h * HD + F.lane];
        for (int i = 0; i < 16; ++i) { const int t = F.wave * 16 + i;
            const float g = gelu_erf(bf2f(P[(row0 + t) * INW + GMW + h * HD + F.lane]));
            const float mean = wave_sum(g) * (1.f / HD); const float d = g - mean; const float var = wave_sum(d * d) * (1.f / HD);
            V[t * HD + F.lane] = d * __builtin_amdgcn_rsqf(var + LN_EPS) * lw + lb; }
        __syncthreads();
        for (int i = 0; i < 16; ++i) { const int t = F.wave * 16 + i; const float* wrow = ws + ((size_t)h * GCH + t) * GCH; float acc = 0.f;
            for (int s = 0; s <= t; ++s) acc += wrow[s] * V[s * HD + F.lane];
            const float mixed = acc + bs[h * GCH + t];
            const float u = gelu_erf(bf2f(P[(row0 + t) * INW + h * HD + F.lane]));
            Y[(row0 + t) * D + h * HD + F.lane] = (bf16)f2bf(u * mixed); }
        __syncthreads();
    }
}
__device__ __forceinline__ float shifted(const bf16* P, size_t row, int t, int col, const float* mu) {
    const float c = bf2f(P[row * INW + col]); const float pr = t > 0 ? bf2f(P[(row - 1) * INW + col]) : 0.f;
    return c + (pr - c) * mu[col - 1024];
}
constexpr int NC = 32;
__device__ __forceinline__ void rwkv_naive(Frame& F, const bf16* P, bf16* Y, const float* mu, const float* w_up, const float* w0, const float* a_up, const float* a0, const float* g_up,
                                           const float* k_k, const float* k_a, const float* r_k, const float* lnx_w, const float* lnx_b) {
    LAS float* LI = (LAS float*)F.lds;
    LAS float* sR = LI + NC * 256; LAS float* sW = sR + NC * 64; LAS float* sK = sW + NC * 64; LAS float* sV = sK + NC * 64; LAS float* sA = sV + NC * 64; LAS float* sB = sA + NC * 64;
    LAS float* sG = sB + NC * 64; LAS float* sBon = sG + NC * 64;
    for (int unit = blockIdx.x; unit < NB * NH; unit += F.G) {
        const int b = unit / NH, h = unit % NH;
        float S[64];
#pragma unroll
        for (int k = 0; k < 64; ++k) S[k] = 0.f;
        for (int c = 0; c < SEQ / NC; ++c) {
            const int t0 = c * NC; const size_t row0 = (size_t)b * SEQ + t0;
            for (int idx = F.tid; idx < NC * 256; idx += 512) { const int tok = idx >> 8, j = idx & 255;
                const float x = shifted(P, row0 + tok, t0 + tok, 2560 + j, mu);
                LI[idx] = j < 64 ? tanhf(x) : (j < 128 ? x : sigmoidf_(x)); }
            __syncthreads();
            { const int ch = F.lane, hc = h * HD + ch;
              for (int i = 0; i < NC / 8; ++i) { const int tok = F.wave + 8 * i; const size_t row = row0 + tok; const int t = t0 + tok;
                const float rr = shifted(P, row, t, 1024 + hc, mu), kx = shifted(P, row, t, 1536 + hc, mu), vv = shifted(P, row, t, 2048 + hc, mu);
                float dw = w0[hc], da = a0[hc], gg = 0.f;
                for (int j = 0; j < 64; ++j) { dw += LI[tok * 256 + j] * w_up[j * RWW + hc]; da += LI[tok * 256 + 64 + j] * a_up[j * RWW + hc]; }
                for (int j = 0; j < 128; ++j) gg += LI[tok * 256 + 128 + j] * g_up[j * RWW + hc];
                const float z = -dw; const float sp = fmaxf(z, 0.f) + log1pf(__expf(-fabsf(z)));
                const float decay = __expf(-__expf(-sp - 0.5f));
                const float alr = sigmoidf_(da);
                const float kkv = kx * k_k[hc]; const float nrm = sqrtf(wave_sum(kkv * kkv)); const float kkn = kkv / fmaxf(nrm, 1e-12f);
                const float kmod = kx * (1.f + (alr - 1.f) * k_a[hc]);
                const float bsc = wave_sum(rr * kmod * r_k[hc]);
                sR[tok * 64 + ch] = rr; sW[tok * 64 + ch] = decay; sK[tok * 64 + ch] = kmod; sV[tok * 64 + ch] = vv; sA[tok * 64 + ch] = -kkn; sB[tok * 64 + ch] = kkn * alr;
                sG[tok * 64 + ch] = gg; sBon[tok * 64 + ch] = bsc * vv; } }
            __syncthreads();
            if (F.wave == 0) {
                for (int t = 0; t < NC; ++t) { float sa = 0.f;
#pragma unroll
                    for (int k = 0; k < 64; ++k) sa += S[k] * sA[t * 64 + k];
                    const float vv = sV[t * 64 + F.lane]; float yv = 0.f;
#pragma unroll
                    for (int k = 0; k < 64; ++k) { S[k] = S[k] * sW[t * 64 + k] + sa * sB[t * 64 + k] + vv * sK[t * 64 + k]; yv += S[k] * sR[t * 64 + k]; }
                    LI[t * 64 + F.lane] = yv; }
            }
            __syncthreads();
            { const int v = F.lane, hv = h * HD + v;
              for (int i = 0; i < NC / 8; ++i) { const int tok = F.wave + 8 * i; const float yv = LI[tok * 64 + v];
                const float mean = wave_sum(yv) * (1.f / HD); const float d = yv - mean; const float var = wave_sum(d * d) * (1.f / HD);
                const float yn = d * __builtin_amdgcn_rsqf(var + GN_EPS) * lnx_w[hv] + lnx_b[hv];
                Y[(row0 + tok) * D + GMW + hv] = (bf16)f2bf((yn + sBon[tok * 64 + v]) * sG[tok * 64 + v]); } }
            __syncthreads();
        }
    }
}

typedef short s16x4 __attribute__((ext_vector_type(4)));
typedef short v4i16_t __attribute__((ext_vector_type(4)));
#define MFMA32(a, b, c) __builtin_amdgcn_mfma_f32_16x16x32_bf16((a), (b), (c), 0, 0, 0)
#define MFMA16(a, b, c) __builtin_amdgcn_mfma_f32_16x16x16bf16_1k((a), (b), (c), 0, 0, 0)
__device__ __forceinline__ bf16x8 lds_row8(const LAS bf16* T, int ld, int r0, int k0, int lane) { return *(const LAS bf16x8*)(T + (r0 + (lane & 15)) * ld + k0 + 8 * (lane >> 4)); }
__device__ __forceinline__ s16x4 lds_row4(const LAS bf16* T, int ld, int r0, int k0, int lane) { return *(const LAS s16x4*)(T + (r0 + (lane & 15)) * ld + k0 + 4 * (lane >> 4)); }
__device__ __forceinline__ s16x4 lds_tr4(const LAS bf16* T, int ld, int k0, int c0, int lane) { const int i = lane & 15, g = lane >> 4;
    return __builtin_bit_cast(s16x4, __builtin_amdgcn_ds_read_tr16_b64_v4i16((LAS v4i16_t*)(T + (k0 + 4 * g + (i >> 2)) * ld + c0 + 4 * (i & 3)))); }
__device__ __forceinline__ bf16x8 lds_tr8(const LAS bf16* T, int ld, int k0, int c0, int lane) { const int i = lane & 15, g = lane >> 4;
    const LAS bf16* p = T + (k0 + 8 * g + (i >> 2)) * ld + c0 + 4 * (i & 3);
    const s16x4 lo = __builtin_bit_cast(s16x4, __builtin_amdgcn_ds_read_tr16_b64_v4i16((LAS v4i16_t*)p));
    const s16x4 hi = __builtin_bit_cast(s16x4, __builtin_amdgcn_ds_read_tr16_b64_v4i16((LAS v4i16_t*)(p + 4 * ld)));
    bf16x8 r; r[0] = lo[0]; r[1] = lo[1]; r[2] = lo[2]; r[3] = lo[3]; r[4] = hi[0]; r[5] = hi[1]; r[6] = hi[2]; r[7] = hi[3]; return r; }
typedef __bf16 bf16x2_t __attribute__((ext_vector_type(2)));
__device__ __forceinline__ unsigned cvtpk_c(float lo, float hi) { const f32x2 v = {lo, hi}; const bf16x2_t b = __builtin_convertvector(v, bf16x2_t); return __builtin_bit_cast(unsigned, b); }
__device__ __forceinline__ s16x4 pack4(const f32x4 v) { u32x2 w; w.x = cvtpk_c(v[0], v[1]); w.y = cvtpk_c(v[2], v[3]); return __builtin_bit_cast(s16x4, w); }
__device__ __forceinline__ f32x4 unpack4(const s16x4 v) { f32x4 r; r[0] = bf2f((bf16)v[0]); r[1] = bf2f((bf16)v[1]); r[2] = bf2f((bf16)v[2]); r[3] = bf2f((bf16)v[3]); return r; }
__device__ __forceinline__ void unpack8(const u32x4 w, float (&o)[8]) { o[0] = __builtin_bit_cast(float, w.x << 16); o[1] = __builtin_bit_cast(float, w.x & 0xffff0000u); o[2] = __builtin_bit_cast(float, w.y << 16); o[3] = __builtin_bit_cast(float, w.y & 0xffff0000u);
    o[4] = __builtin_bit_cast(float, w.z << 16); o[5] = __builtin_bit_cast(float, w.z & 0xffff0000u); o[6] = __builtin_bit_cast(float, w.w << 16); o[7] = __builtin_bit_cast(float, w.w & 0xffff0000u); }
__device__ __forceinline__ u32x4 pack8(const float (&v)[8]) { u32x4 w; w.x = cvtpk_c(v[0], v[1]); w.y = cvtpk_c(v[2], v[3]); w.z = cvtpk_c(v[4], v[5]); w.w = cvtpk_c(v[6], v[7]); return w; }
__device__ __forceinline__ float gelu_as(float v) {
    const float av = fabsf(v), t = __builtin_amdgcn_rcpf(av * 0.2316418882f + 1.0f);
    float q = t * 0.5307027145f + (-0.7265760135f); q = q * t + 0.7107068705f; q = q * t + (-0.142248368f); q = q * t + 0.127414796f; q = q * t;
    const float e = __builtin_amdgcn_exp2f((v * v) * (-0.72134752044f)); const float m = v * (q * e); return v < 0.f ? m : v - m;
}

__device__ __forceinline__ f32x2 gelu_pk2(f32x2 v) {
    const f32x2 av = __builtin_elementwise_abs(v), d = av * 0.2316418882f + 1.0f;
    f32x2 t; t.x = __builtin_amdgcn_rcpf(d.x); t.y = __builtin_amdgcn_rcpf(d.y);
    f32x2 q = t * 0.5307027145f + (-0.7265760135f); q = q * t + 0.7107068705f; q = q * t + (-0.142248368f); q = q * t + 0.127414796f; q = q * t;
    const f32x2 s2 = (v * v) * (-0.72134752044f);
    f32x2 e; e.x = __builtin_amdgcn_exp2f(s2.x); e.y = __builtin_amdgcn_exp2f(s2.y);
    const f32x2 m = v * (q * e), r = v - m;
    f32x2 o; o.x = v.x < 0.f ? m.x : r.x; o.y = v.y < 0.f ? m.y : r.y; return o;
}
constexpr int GM_V = 0, GM_U = 128 * 72 * 2;
__device__ __forceinline__ void gmlp_unit(Frame& F, int unit, const bf16* P, bf16* Y, const float* ln_w, const float* ln_b, const bf16* WsB, const float* bs) {
    LAS bf16* Vt = (LAS bf16*)(F.lds + GM_V); LAS bf16* Ut = (LAS bf16*)(F.lds + GM_U);
    const int h = unit % NH, bc = unit / NH; const size_t row0 = (size_t)bc * GCH;
    { const int t = F.tid >> 2, cq = F.tid & 3; const bf16* pr = P + (row0 + t) * INW + h * HD + 16 * cq;
      const u32x4 u0 = *(const u32x4*)pr, u1 = *(const u32x4*)(pr + 8), v0 = *(const u32x4*)(pr + GMW), v1 = *(const u32x4*)(pr + GMW + 8);
      float uu[16], vv[16]; { float a[8]; unpack8(u0, a); for (int j = 0; j < 8; ++j) uu[j] = a[j]; unpack8(u1, a); for (int j = 0; j < 8; ++j) uu[8 + j] = a[j]; unpack8(v0, a); for (int j = 0; j < 8; ++j) vv[j] = a[j]; unpack8(v1, a); for (int j = 0; j < 8; ++j) vv[8 + j] = a[j]; }
      float s = 0.f;
#pragma unroll
      for (int j = 0; j < 16; ++j) { uu[j] = gelu_as(uu[j]); vv[j] = gelu_as(vv[j]); s += vv[j]; }
      s += __shfl_xor(s, 1); s += __shfl_xor(s, 2); const float mean = s * (1.f / HD); float q = 0.f;
#pragma unroll
      for (int j = 0; j < 16; ++j) { vv[j] -= mean; q += vv[j] * vv[j]; }
      q += __shfl_xor(q, 1); q += __shfl_xor(q, 2); const float rstd = __builtin_amdgcn_rsqf(q * (1.f / HD) + LN_EPS);
#pragma unroll
      for (int j = 0; j < 16; ++j) vv[j] = vv[j] * rstd * ln_w[h * HD + 16 * cq + j] + ln_b[h * HD + 16 * cq + j];
      float a[8]; for (int j = 0; j < 8; ++j) a[j] = vv[j]; *(LAS u32x4*)(Vt + t * 72 + 16 * cq) = pack8(a); for (int j = 0; j < 8; ++j) a[j] = vv[8 + j]; *(LAS u32x4*)(Vt + t * 72 + 16 * cq + 8) = pack8(a);
      for (int j = 0; j < 8; ++j) a[j] = uu[j]; *(LAS u32x4*)(Ut + t * 72 + 16 * cq) = pack8(a); for (int j = 0; j < 8; ++j) a[j] = uu[8 + j]; *(LAS u32x4*)(Ut + t * 72 + 16 * cq + 8) = pack8(a); }
    __syncthreads();
    { const int w = F.wave, l15 = F.lane & 15, g = F.lane >> 4, t0 = 16 * w, nks = (w >> 1) + 1; const bf16* wrow = WsB + ((size_t)h * GCH + t0 + l15) * GCH + 8 * g;
      f32x4 acc[4] = {{0.f, 0.f, 0.f, 0.f}, {0.f, 0.f, 0.f, 0.f}, {0.f, 0.f, 0.f, 0.f}, {0.f, 0.f, 0.f, 0.f}};
      for (int ks = 0; ks < nks; ++ks) { const bf16x8 a = *(const bf16x8*)(wrow + 32 * ks);
#pragma unroll
          for (int nt = 0; nt < 4; ++nt) acc[nt] = MFMA32(a, lds_tr8(Vt, 72, 32 * ks, 16 * nt, F.lane), acc[nt]); }
#pragma unroll
      for (int reg = 0; reg < 4; ++reg) { const int t = t0 + 4 * g + reg; const float bsv = bs[h * GCH + t];
#pragma unroll
          for (int nt = 0; nt < 4; ++nt) { LAS bf16* up = Ut + t * 72 + 16 * nt + l15; *up = (bf16)f2bf(bf2f(*up) * (acc[nt][reg] + bsv)); } } }
    __syncthreads();
    { const int t = F.tid >> 2, cq = F.tid & 3; bf16* yr = Y + (row0 + t) * D + h * HD + 16 * cq;
      *(u32x4*)yr = *(const LAS u32x4*)(Ut + t * 72 + 16 * cq); *(u32x4*)(yr + 8) = *(const LAS u32x4*)(Ut + t * 72 + 16 * cq + 8); }
    __syncthreads();
}

__device__ __forceinline__ void gmlp_units(Frame& F, int u0, int ustep, int nunits, const bf16* P, bf16* Y, const float* ln_w, const float* ln_b, const bf16* WsB, const float* bs) {
    if (u0 >= nunits) return;
    const int t = F.tid >> 2, cq = F.tid & 3; const int w = F.wave, l15 = F.lane & 15, g = F.lane >> 4, t0 = 16 * w, nks = (w >> 1) + 1;
    LAS float* TB = (LAS float*)(F.lds + 73728);
    TB[F.tid] = ln_w[F.tid]; TB[512 + F.tid] = ln_b[F.tid]; TB[1024 + F.tid] = bs[F.tid]; TB[1536 + F.tid] = bs[512 + F.tid];
    LDS_BARRIER();
    u32x4 pu0, pu1, pv0, pv1;
#define GM_LOAD(uu_) do { const int h_ = (uu_) % NH, bc_ = (uu_) / NH; const bf16* pr_ = P + ((size_t)bc_ * GCH + t) * INW + h_ * HD + 16 * cq; \
        pu0 = *(const u32x4*)pr_; pu1 = *(const u32x4*)(pr_ + 8); pv0 = *(const u32x4*)(pr_ + GMW); pv1 = *(const u32x4*)(pr_ + GMW + 8); } while (0)
    GM_LOAD(u0);
    int it = 0;
    for (int unit = u0; unit < nunits; unit += ustep, ++it) {
        LAS bf16* Vt = (LAS bf16*)(F.lds + (it & 1) * (2 * 128 * 72 * 2)); LAS bf16* Ut = Vt + 128 * 72;
        const int h = unit % NH, bc = unit / NH; const size_t row0 = (size_t)bc * GCH;
        const bf16* wrow = WsB + ((size_t)h * GCH + t0 + l15) * GCH + 8 * g; bf16x8 af[4];
#pragma unroll
        for (int ks = 0; ks < 4; ++ks) af[ks] = *(const bf16x8*)(wrow + 32 * (ks < nks ? ks : 0));
        const f32x4 bsv = *(const LAS f32x4*)(TB + 1024 + h * GCH + t0 + 4 * g);
        float uu[16], vv[16]; { float a[8]; unpack8(pu0, a); for (int j = 0; j < 8; ++j) uu[j] = a[j]; unpack8(pu1, a); for (int j = 0; j < 8; ++j) uu[8 + j] = a[j]; unpack8(pv0, a); for (int j = 0; j < 8; ++j) vv[j] = a[j]; unpack8(pv1, a); for (int j = 0; j < 8; ++j) vv[8 + j] = a[j]; }
        if (unit + ustep < nunits) GM_LOAD(unit + ustep);
        float sm = 0.f;
#pragma unroll
        for (int j = 0; j < 16; j += 2) { const f32x2 gu = gelu_pk2((f32x2){uu[j], uu[j + 1]}), gv = gelu_pk2((f32x2){vv[j], vv[j + 1]}); uu[j] = gu.x; uu[j + 1] = gu.y; vv[j] = gv.x; vv[j + 1] = gv.y; sm += gv.x + gv.y; }
        sm += __shfl_xor(sm, 1); sm += __shfl_xor(sm, 2); const float mean = sm * (1.f / HD); float q = 0.f;
#pragma unroll
        for (int j = 0; j < 16; ++j) { vv[j] -= mean; q += vv[j] * vv[j]; }
        q += __shfl_xor(q, 1); q += __shfl_xor(q, 2); const float rstd = __builtin_amdgcn_rsqf(q * (1.f / HD) + LN_EPS);
#pragma unroll
        for (int j = 0; j < 16; ++j) vv[j] = vv[j] * rstd * TB[h * HD + 16 * cq + j] + TB[512 + h * HD + 16 * cq + j];
        { float a[8]; for (int j = 0; j < 8; ++j) a[j] = vv[j]; *(LAS u32x4*)(Vt + t * 72 + 16 * cq) = pack8(a); for (int j = 0; j < 8; ++j) a[j] = vv[8 + j]; *(LAS u32x4*)(Vt + t * 72 + 16 * cq + 8) = pack8(a);
          for (int j = 0; j < 8; ++j) a[j] = uu[j]; *(LAS u32x4*)(Ut + t * 72 + 16 * cq) = pack8(a); for (int j = 0; j < 8; ++j) a[j] = uu[8 + j]; *(LAS u32x4*)(Ut + t * 72 + 16 * cq + 8) = pack8(a); }
        LDS_BARRIER();
        { f32x4 acc[4] = {{0.f, 0.f, 0.f, 0.f}, {0.f, 0.f, 0.f, 0.f}, {0.f, 0.f, 0.f, 0.f}, {0.f, 0.f, 0.f, 0.f}};
#pragma unroll
          for (int ks = 0; ks < 4; ++ks) if (ks < nks) {
#pragma unroll
              for (int nt = 0; nt < 4; ++nt) acc[nt] = MFMA32(af[ks], lds_tr8(Vt, 72, 32 * ks, 16 * nt, F.lane), acc[nt]); }
#pragma unroll
          for (int reg = 0; reg < 4; ++reg) { const int tt = t0 + 4 * g + reg;
#pragma unroll
              for (int nt = 0; nt < 4; ++nt) { LAS bf16* up = Ut + tt * 72 + 16 * nt + l15; *up = (bf16)f2bf(bf2f(*up) * (acc[nt][reg] + bsv[reg])); } } }
        LDS_BARRIER();
        { bf16* yr = Y + (row0 + t) * D + h * HD + 16 * cq;
          *(u32x4*)yr = *(const LAS u32x4*)(Ut + t * 72 + 16 * cq); *(u32x4*)(yr + 8) = *(const LAS u32x4*)(Ut + t * 72 + 16 * cq + 8); }
    }
#undef GM_LOAD
    LDS_BARRIER();
}

struct RwkvW { const float *mu, *w0, *a0, *k_k, *k_a, *r_k, *lnx_w, *lnx_b; const bf16 *WupT, *AupT, *GupT; };
struct RwkvS { bf16 *SG, *SH, *SQ, *SS, *Sg, *SY0; float* Sbsc; };
constexpr int M1_LI = 0;
constexpr int M1_PR = 33792;
constexpr int M1_TL = M1_PR + 36864;
constexpr int M1_SEG = M1_TL + 7 * 9216;
constexpr int M1_GAM = M1_SEG + 2048;
constexpr int M1_D = M1_GAM + 256;
constexpr int M1_T = M1_D + 4096;
constexpr int M1_END = M1_T + 2048;
static_assert(M1_END <= MISC_OFF, "M1 LDS map");
__device__ __forceinline__ float fast_tanh(float x) { const float e = __expf(2.f * x); return 1.f - 2.f * __builtin_amdgcn_rcpf(e + 1.f); }

__device__ __forceinline__ void rwkv_m1_unit(Frame& F, int unit  , const bf16* P, const RwkvW& W, const RwkvS& Sc) {
    const int b = unit >> 6, c = unit & 63, t0 = c * 64; const size_t row0 = (size_t)b * SEQ + t0;
    const int w = F.wave, lane = F.lane, l15 = lane & 15, g = lane >> 4;
    LAS bf16* LI = (LAS bf16*)(F.lds + M1_LI);
    LAS float* Ef = (LAS float*)(F.lds + M1_PR); LAS float* ALf = Ef + 64 * 64;
    LAS bf16* Lab = (LAS bf16*)(F.lds + M1_PR); LAS bf16* Lak = Lab + 64 * 72; LAS bf16* Mrb = Lak + 64 * 72; LAS bf16* Mrk = Mrb + 64 * 72;
    LAS bf16* At = (LAS bf16*)(F.lds + M1_TL); LAS bf16* Bt = At + 64 * 72; LAS bf16* Kt = Bt + 64 * 72; LAS bf16* Rt = Kt + 64 * 72; LAS bf16* Bh = Rt + 64 * 72; LAS bf16* Kh = Bh + 64 * 72; LAS bf16* Vt = Kh + 64 * 72;
    LAS float* SEG = (LAS float*)(F.lds + M1_SEG); LAS float* GAM = (LAS float*)(F.lds + M1_GAM); LAS float* Dd = (LAS float*)(F.lds + M1_D); LAS bf16* Tt = (LAS bf16*)(F.lds + M1_T);
#pragma unroll
    for (int it = 0; it < 4; ++it) { const int item = F.tid + 512 * it, tok = item >> 5, jc = item & 31, j0 = 8 * jc; const size_t row = row0 + tok;
        float cv[8], pv[8]; unpack8(*(const u32x4*)(P + row * INW + 2560 + j0), cv);
        if (t0 + tok > 0) unpack8(*(const u32x4*)(P + (row - 1) * INW + 2560 + j0), pv); else { for (int j = 0; j < 8; ++j) pv[j] = 0.f; }
        const f32x4 m0 = *(const f32x4*)(W.mu + 1536 + j0), m1 = *(const f32x4*)(W.mu + 1536 + j0 + 4); float o[8];
#pragma unroll
        for (int j = 0; j < 8; ++j) { const float x = cv[j] + (pv[j] - cv[j]) * (j < 4 ? m0[j] : m1[j - 4]); o[j] = jc < 8 ? fast_tanh(x) : (jc < 16 ? x : sigmoidf_(x)); }
        *(LAS u32x4*)(LI + tok * 264 + j0) = pack8(o); }
    __syncthreads();
    for (int h = 0; h < NH; ++h) {
        const size_t uh = ((size_t)unit * NH + h) * 4096;
        { const int mt = w & 3, ntb = 2 * (w >> 2); const int chrow = h * HD + 16 * mt + l15;
          f32x4 aw[2] = {{0.f, 0.f, 0.f, 0.f}, {0.f, 0.f, 0.f, 0.f}}, aa[2] = {{0.f, 0.f, 0.f, 0.f}, {0.f, 0.f, 0.f, 0.f}}, ag[2] = {{0.f, 0.f, 0.f, 0.f}, {0.f, 0.f, 0.f, 0.f}};
#pragma unroll
          for (int ks = 0; ks < 2; ++ks) { const bf16x8 fw = *(const bf16x8*)(W.WupT + (size_t)chrow * 64 + 32 * ks + 8 * g), fa = *(const bf16x8*)(W.AupT + (size_t)chrow * 64 + 32 * ks + 8 * g);
#pragma unroll
              for (int q = 0; q < 2; ++q) { aw[q] = MFMA32(fw, lds_row8(LI, 264, 16 * (ntb + q), 32 * ks, lane), aw[q]); aa[q] = MFMA32(fa, lds_row8(LI, 264, 16 * (ntb + q), 64 + 32 * ks, lane), aa[q]); } }
#pragma unroll
          for (int ks = 0; ks < 4; ++ks) { const bf16x8 fg = *(const bf16x8*)(W.GupT + (size_t)chrow * 128 + 32 * ks + 8 * g);
#pragma unroll
              for (int q = 0; q < 2; ++q) ag[q] = MFMA32(fg, lds_row8(LI, 264, 16 * (ntb + q), 128 + 32 * ks, lane), ag[q]); }
          const int ch0 = 16 * mt + 4 * g; const f32x4 w0v = *(const f32x4*)(W.w0 + h * HD + ch0), a0v = *(const f32x4*)(W.a0 + h * HD + ch0);
#pragma unroll
          for (int q = 0; q < 2; ++q) { const int tok = 16 * (ntb + q) + l15; f32x4 ev, av;
#pragma unroll
              for (int r = 0; r < 4; ++r) { const float z = -(aw[q][r] + w0v[r]); const float sp = fmaxf(z, 0.f) + __logf(1.f + __expf(-fabsf(z))); ev[r] = -__expf(-sp - 0.5f); av[r] = sigmoidf_(aa[q][r] + a0v[r]); }
              *(LAS f32x4*)(Ef + tok * 64 + ch0) = ev; *(LAS f32x4*)(ALf + tok * 64 + ch0) = av;
              u32x2 gw; gw.x = cvtpk_c(ag[q][0], ag[q][1]); gw.y = cvtpk_c(ag[q][2], ag[q][3]); *(u32x2*)(Sc.Sg + (row0 + tok) * RWW + h * HD + ch0) = gw; } }
        __syncthreads();
        { const int ch = F.tid & 63, seg = F.tid >> 6; float run = 0.f;
#pragma unroll
          for (int i = 0; i < 8; ++i) { run += Ef[(8 * seg + i) * 64 + ch]; Ef[(8 * seg + i) * 64 + ch] = run; }
          SEG[seg * 64 + ch] = run; }
        __syncthreads();
        { const int ch = F.tid & 63, seg = F.tid >> 6; float off = 0.f;
          for (int s2 = 0; s2 < seg; ++s2) off += SEG[s2 * 64 + ch];
#pragma unroll
          for (int i = 0; i < 8; ++i) Ef[(8 * seg + i) * 64 + ch] += off; }
        __syncthreads();
        { const int tok = F.tid >> 3, cg = F.tid & 7, ch0 = 8 * cg, hc0 = h * HD + ch0; const size_t row = row0 + tok; const bool has_prev = (t0 + tok) > 0;
          float rr[8], kx[8], vv[8], tmp[8], pr[8];
#define SHIFT_LOAD(dst, col) do { unpack8(*(const u32x4*)(P + row * INW + (col)), dst); if (has_prev) unpack8(*(const u32x4*)(P + (row - 1) * INW + (col)), pr); else { for (int j = 0; j < 8; ++j) pr[j] = 0.f; } \
              const f32x4 m0 = *(const f32x4*)(W.mu + (col) - 1024), m1 = *(const f32x4*)(W.mu + (col) - 1024 + 4); for (int j = 0; j < 8; ++j) dst[j] = dst[j] + (pr[j] - dst[j]) * (j < 4 ? m0[j] : m1[j - 4]); } while (0)
          SHIFT_LOAD(rr, 1024 + hc0); SHIFT_LOAD(kx, 1536 + hc0); SHIFT_LOAD(vv, 2048 + hc0);
          (void)tmp;
          float Lt[8], Lm[8], Lc[8], al[8];
#pragma unroll
          for (int j = 0; j < 8; ++j) { Lt[j] = Ef[tok * 64 + ch0 + j]; Lm[j] = tok > 0 ? Ef[(tok - 1) * 64 + ch0 + j] : 0.f; Lc[j] = Ef[63 * 64 + ch0 + j]; al[j] = ALf[tok * 64 + ch0 + j]; }
          float kk[8], km[8]; float ss = 0.f, bs_ = 0.f;
#pragma unroll
          for (int j = 0; j < 8; ++j) { kk[j] = kx[j] * W.k_k[hc0 + j]; ss += kk[j] * kk[j]; km[j] = kx[j] * (1.f + (al[j] - 1.f) * W.k_a[hc0 + j]); bs_ += rr[j] * km[j] * W.r_k[hc0 + j]; }
          ss += __shfl_xor(ss, 1); ss += __shfl_xor(ss, 2); ss += __shfl_xor(ss, 4); bs_ += __shfl_xor(bs_, 1); bs_ += __shfl_xor(bs_, 2); bs_ += __shfl_xor(bs_, 4);
          const float inv = 1.f / fmaxf(sqrtf(ss), 1e-12f);
          if (cg == 0) Sc.Sbsc[row * NH + h] = bs_;
          float oA[8], oB[8], oK[8], oR[8], oBh[8], oKh[8];
#pragma unroll
          for (int j = 0; j < 8; ++j) { const float kn = kk[j] * inv, bb = kn * al[j]; const float einv = __expf(-Lt[j]), ec = __expf(Lc[j] - Lt[j]);
              oA[j] = -kn * __expf(Lm[j]); oB[j] = bb * einv; oK[j] = km[j] * einv; oR[j] = rr[j] * __expf(Lt[j]); oBh[j] = bb * ec; oKh[j] = km[j] * ec; }
          *(LAS u32x4*)(At + tok * 72 + ch0) = pack8(oA); *(LAS u32x4*)(Bt + tok * 72 + ch0) = pack8(oB); *(LAS u32x4*)(Kt + tok * 72 + ch0) = pack8(oK); *(LAS u32x4*)(Rt + tok * 72 + ch0) = pack8(oR);
          *(LAS u32x4*)(Bh + tok * 72 + ch0) = pack8(oBh); *(LAS u32x4*)(Kh + tok * 72 + ch0) = pack8(oKh); *(LAS u32x4*)(Vt + tok * 72 + ch0) = pack8(vv);
          if (tok == 63) { for (int j = 0; j < 8; ++j) GAM[ch0 + j] = __expf(Lc[j]); } }
        __syncthreads();
        for (int i5 = 0; i5 < 5; ++i5) { const int q = w + 8 * i5, mat = q / 10, idx = q % 10; const int ti = idx < 1 ? 0 : (idx < 3 ? 1 : (idx < 6 ? 2 : 3)), si = idx - ti * (ti + 1) / 2;
            const LAS bf16* X = mat < 2 ? At : Rt; const LAS bf16* Yk = (mat & 1) ? Kt : Bt; LAS bf16* O = Lab + mat * 64 * 72;
            f32x4 acc = {0.f, 0.f, 0.f, 0.f};
#pragma unroll
            for (int ks = 0; ks < 2; ++ks) acc = MFMA32(lds_row8(Yk, 72, 16 * si, 32 * ks, lane), lds_row8(X, 72, 16 * ti, 32 * ks, lane), acc);
            const int t = 16 * ti + l15, s0 = 16 * si + 4 * g;
#pragma unroll
            for (int r = 0; r < 4; ++r) { const bool keep = mat < 2 ? (s0 + r < t) : (s0 + r <= t); if (!keep) acc[r] = 0.f; }
            *(LAS s16x4*)(O + t * 72 + s0) = pack4(acc);
            if (mat == 0 && ti == si) *(LAS f32x4*)(Dd + ti * 256 + l15 * 16 + 4 * g) = acc; }
        __syncthreads();
        if (w == 7) { const int i = lane >> 4, cc = lane & 15; const LAS float* Db = Dd + i * 256; float tv[16];
#pragma unroll
            for (int r = 0; r < 16; ++r) { float sum = (r == cc) ? 1.f : 0.f;
#pragma unroll
                for (int s2 = 0; s2 < r; ++s2) sum += Db[r * 16 + s2] * tv[s2];
                tv[r] = sum; }
#pragma unroll
            for (int r = 0; r < 16; ++r) Tt[i * 256 + r * 16 + cc] = (bf16)f2bf(tv[r]); }
        __syncthreads();
        { const bool isU = w < 4; const int cw = w & 3;
          f32x4 X[4];
#pragma unroll
          for (int i = 0; i < 4; ++i) { f32x4 z = {0.f, 0.f, 0.f, 0.f};
              if (isU) {
#pragma unroll
                  for (int j = 0; j <= i; ++j) z = MFMA16(lds_row4(Lak, 72, 16 * i, 16 * j, lane), lds_tr4(Vt, 72, 16 * j, 16 * cw, lane), z);
              } else z = unpack4(lds_tr4(At, 72, 16 * i, 16 * cw, lane));
#pragma unroll
              for (int j = 0; j < i; ++j) z = MFMA16(lds_row4(Lab, 72, 16 * i, 16 * j, lane), pack4(X[j]), z);
              const f32x4 zero = {0.f, 0.f, 0.f, 0.f};
              X[i] = MFMA16(lds_row4(Tt + i * 256, 16, 0, 0, lane), pack4(z), zero); }
          s16x4 Xp[4];
#pragma unroll
          for (int i = 0; i < 4; ++i) Xp[i] = pack4(X[i]);
          if (isU) {
#pragma unroll
              for (int nt = 0; nt < 4; ++nt) { f32x4 acc = {0.f, 0.f, 0.f, 0.f};
#pragma unroll
                  for (int i = 0; i < 4; ++i) { acc = MFMA16(Xp[i], lds_tr4(Bh, 72, 16 * i, 16 * nt, lane), acc); acc = MFMA16(lds_tr4(Vt, 72, 16 * i, 16 * cw, lane), lds_tr4(Kh, 72, 16 * i, 16 * nt, lane), acc); }
                  *(s16x4*)(Sc.SH + uh + (size_t)(16 * nt + l15) * 64 + 16 * cw + 4 * g) = pack4(acc); }
#pragma unroll
              for (int mt = 0; mt < 4; ++mt) { f32x4 acc = {0.f, 0.f, 0.f, 0.f};
#pragma unroll
                  for (int i = 0; i <= mt; ++i) { acc = MFMA16(lds_row4(Mrb, 72, 16 * mt, 16 * i, lane), Xp[i], acc); acc = MFMA16(lds_row4(Mrk, 72, 16 * mt, 16 * i, lane), lds_tr4(Vt, 72, 16 * i, 16 * cw, lane), acc); }
                  *(s16x4*)(Sc.SY0 + uh + (size_t)(16 * cw + l15) * 64 + 16 * mt + 4 * g) = pack4(acc); }
          } else {
              const float gamv = GAM[16 * cw + l15];
#pragma unroll
              for (int nt = 0; nt < 4; ++nt) { f32x4 acc = {0.f, 0.f, 0.f, 0.f};
#pragma unroll
                  for (int i = 0; i < 4; ++i) acc = MFMA16(Xp[i], lds_tr4(Bh, 72, 16 * i, 16 * nt, lane), acc);
                  { const float gam = (nt == cw) ? gamv : 0.f;
#pragma unroll
                      for (int r = 0; r < 4; ++r) acc[r] += (l15 == 4 * g + r) ? gam : 0.f; }
                  *(s16x4*)(Sc.SG + uh + (size_t)(16 * nt + l15) * 64 + 16 * cw + 4 * g) = pack4(acc); }
#pragma unroll
              for (int mt = 0; mt < 4; ++mt) { f32x4 acc = unpack4(lds_tr4(Rt, 72, 16 * mt, 16 * cw, lane));
#pragma unroll
                  for (int i = 0; i <= mt; ++i) acc = MFMA16(lds_row4(Mrb, 72, 16 * mt, 16 * i, lane), Xp[i], acc);
                  *(s16x4*)(Sc.SQ + uh + (size_t)(16 * cw + l15) * 64 + 16 * mt + 4 * g) = pack4(acc); }
          } }
        __syncthreads();
    }
}

constexpr int M1V_LI = 0;
constexpr int M1V_PR = 33792;
constexpr int M1V_TL = M1V_PR + 36864;
constexpr int M1V_SEG = M1V_TL + 5 * 9216;
constexpr int M1V_GAM = M1V_SEG + 2048;
constexpr int M1V_CST = M1V_GAM + 256;
constexpr int M1V_END = M1V_CST + 8 * 2048;
static_assert(M1V_END <= MISC_OFF, "M1 v2 LDS map");
__device__ __forceinline__ void rwkv_m1_consts(Frame& F, const RwkvW& W) {
    LAS float* CST = (LAS float*)(F.lds + M1V_CST);
    for (int i = F.tid; i < 1536; i += 512) CST[i] = W.mu[i];
    CST[3 * 512 + F.tid] = W.k_k[F.tid]; CST[4 * 512 + F.tid] = W.k_a[F.tid]; CST[5 * 512 + F.tid] = W.r_k[F.tid]; CST[6 * 512 + F.tid] = W.w0[F.tid]; CST[7 * 512 + F.tid] = W.a0[F.tid];
    __syncthreads();
}
__device__ __forceinline__ void rwkv_m1v2_unit(Frame& F, int unit  , const bf16* P, const RwkvW& W, const RwkvS& Sc) {
    const int b = unit >> 6, c = unit & 63, t0 = c * 64; const size_t row0 = (size_t)b * SEQ + t0;
    const int w = F.wave, lane = F.lane, l15 = lane & 15, g = lane >> 4;
    LAS bf16* LI = (LAS bf16*)(F.lds + M1V_LI);
    LAS float* Ef = (LAS float*)(F.lds + M1V_PR); constexpr int ES = 68; LAS float* ALf = Ef + 64 * ES;
    LAS bf16* Lab = (LAS bf16*)(F.lds + M1V_PR); LAS bf16* Lak = Lab + 64 * 72; LAS bf16* Mrb = Lak + 64 * 72; LAS bf16* Mrk = Mrb + 64 * 72;
    LAS bf16* At = (LAS bf16*)(F.lds + M1V_TL); LAS bf16* Bt = At + 64 * 72; LAS bf16* Kt = Bt + 64 * 72; LAS bf16* Rt = Kt + 64 * 72; LAS bf16* Vt = Rt + 64 * 72;
    LAS float* SEG = (LAS float*)(F.lds + M1V_SEG); LAS float* GAM = (LAS float*)(F.lds + M1V_GAM); const LAS float* CST = (const LAS float*)(F.lds + M1V_CST);
    bf16x8 wfw[2], wfa[2], wfg[4]; u32x4 pfc[3], pfp[3];
    const int ea_mt = w & 3, ea_ntb = 2 * (w >> 2);
    const int eb_tok = F.tid >> 3, eb_cg = F.tid & 7; const size_t eb_row = row0 + eb_tok; const bool eb_prev = (t0 + eb_tok) > 0;
#define M1_LOAD_W(hh) do { const int chrow_ = (hh) * HD + 16 * ea_mt + l15; \
        wfw[0] = *(const bf16x8*)(W.WupT + (size_t)chrow_ * 64 + 8 * g); wfw[1] = *(const bf16x8*)(W.WupT + (size_t)chrow_ * 64 + 32 + 8 * g); \
        wfa[0] = *(const bf16x8*)(W.AupT + (size_t)chrow_ * 64 + 8 * g); wfa[1] = *(const bf16x8*)(W.AupT + (size_t)chrow_ * 64 + 32 + 8 * g); \
        _Pragma("unroll") for (int ks_ = 0; ks_ < 4; ++ks_) wfg[ks_] = *(const bf16x8*)(W.GupT + (size_t)chrow_ * 128 + 32 * ks_ + 8 * g); } while (0)
#define M1_LOAD_P(hh) do { const int hc_ = (hh) * HD + 8 * eb_cg; \
        _Pragma("unroll") for (int a_ = 0; a_ < 3; ++a_) { pfc[a_] = *(const u32x4*)(P + eb_row * INW + 1024 + 512 * a_ + hc_); \
            if (eb_prev) pfp[a_] = *(const u32x4*)(P + (eb_row - 1) * INW + 1024 + 512 * a_ + hc_); else pfp[a_] = (u32x4){0u, 0u, 0u, 0u}; } } while (0)
#pragma unroll
    for (int it = 0; it < 4; ++it) { const int item = F.tid + 512 * it, tok = item >> 5, jc = item & 31, j0 = 8 * jc; const size_t row = row0 + tok;
        float cv[8], pv[8]; unpack8(*(const u32x4*)(P + row * INW + 2560 + j0), cv);
        if (t0 + tok > 0) unpack8(*(const u32x4*)(P + (row - 1) * INW + 2560 + j0), pv); else { for (int j = 0; j < 8; ++j) pv[j] = 0.f; }
        const f32x4 m0 = *(const f32x4*)(W.mu + 1536 + j0), m1 = *(const f32x4*)(W.mu + 1536 + j0 + 4); float o[8];
#pragma unroll
        for (int j = 0; j < 8; ++j) { const float x = cv[j] + (pv[j] - cv[j]) * (j < 4 ? m0[j] : m1[j - 4]); o[j] = jc < 8 ? fast_tanh(x) : (jc < 16 ? x : sigmoidf_(x)); }
        *(LAS u32x4*)(LI + tok * 264 + j0) = pack8(o); }
    LDS_BARRIER();
    M1_LOAD_W(((int)blockIdx.x) & (NH - 1));
    const int rp_ea = (PROBE_STAGE == 1) ? 2 - (F.G > 100000) : 1, rp_eb = (PROBE_STAGE == 2) ? 2 - (F.G > 100000) : 1, rp_p1 = (PROBE_STAGE == 3) ? 2 - (F.G > 100000) : 1, rp_ch = (PROBE_STAGE == 4) ? 2 - (F.G > 100000) : 1, rp_cs = (PROBE_STAGE == 5) ? 2 - (F.G > 100000) : 1;
    for (int hi_ = 0; hi_ < NH; ++hi_) { const int h = (hi_ + (int)blockIdx.x) & (NH - 1);
        const size_t uh = ((size_t)unit * NH + h) * 4096;
        M1_LOAD_P(h);
        for (int rp = 0; rp < rp_ea; ++rp) {
          f32x4 aw[2] = {{0.f, 0.f, 0.f, 0.f}, {0.f, 0.f, 0.f, 0.f}}, aa[2] = {{0.f, 0.f, 0.f, 0.f}, {0.f, 0.f, 0.f, 0.f}}, ag[2] = {{0.f, 0.f, 0.f, 0.f}, {0.f, 0.f, 0.f, 0.f}};
#pragma unroll
          for (int q = 0; q < 2; ++q) { bf16x8 lf[8];
#pragma unroll
              for (int ks = 0; ks < 8; ++ks) lf[ks] = lds_row8(LI, 264, 16 * (ea_ntb + q), 32 * ks, lane);
#pragma unroll
              for (int ks = 0; ks < 2; ++ks) { aw[q] = MFMA32(wfw[ks], lf[ks], aw[q]); aa[q] = MFMA32(wfa[ks], lf[2 + ks], aa[q]); }
#pragma unroll
              for (int ks = 0; ks < 4; ++ks) ag[q] = MFMA32(wfg[ks], lf[4 + ks], ag[q]); }
          const int ch0 = 16 * ea_mt + 4 * g; const f32x4 w0v = *(const LAS f32x4*)(CST + 6 * 512 + h * HD + ch0), a0v = *(const LAS f32x4*)(CST + 7 * 512 + h * HD + ch0);
#pragma unroll
          for (int q = 0; q < 2; ++q) { const int tok = 16 * (ea_ntb + q) + l15; f32x4 ev, av;
#pragma unroll
              for (int r = 0; r < 4; ++r) { ev[r] = -0.60653066f * __builtin_amdgcn_rcpf(1.f + __expf(-(aw[q][r] + w0v[r]))); av[r] = __builtin_amdgcn_rcpf(1.f + __expf(-(aa[q][r] + a0v[r]))); }
              *(LAS f32x4*)(Ef + tok * ES + ch0) = ev; *(LAS f32x4*)(ALf + tok * ES + ch0) = av;
              u32x2 gw; gw.x = cvtpk_c(ag[q][0], ag[q][1]); gw.y = cvtpk_c(ag[q][2], ag[q][3]); *(u32x2*)(Sc.Sg + (row0 + tok) * RWW + h * HD + ch0) = gw; } }
        LDS_BARRIER();
        for (int rp = 0; rp < rp_cs; ++rp) {
        float csv[8];
        { const int ch = F.tid & 63, seg = F.tid >> 6;
#pragma unroll
          for (int i = 0; i < 8; ++i) csv[i] = Ef[(8 * seg + i) * ES + ch];
#pragma unroll
          for (int i = 1; i < 8; ++i) csv[i] += csv[i - 1];
          SEG[seg * 64 + ch] = csv[7]; }
        LDS_BARRIER();
        { const int ch = F.tid & 63, seg = F.tid >> 6; float sg[8];
#pragma unroll
          for (int s2 = 0; s2 < 7; ++s2) sg[s2] = SEG[s2 * 64 + ch];
          float off = 0.f;
#pragma unroll
          for (int s2 = 0; s2 < 7; ++s2) off += (s2 < seg) ? sg[s2] : 0.f;
#pragma unroll
          for (int i = 0; i < 8; ++i) Ef[(8 * seg + i) * ES + ch] = csv[i] + off; }
        LDS_BARRIER();
        }
        for (int rp = 0; rp < rp_eb; ++rp) { const int tok = eb_tok, ch0 = 8 * eb_cg, hc0 = h * HD + ch0;
          float rr[8], kx[8], vv[8], pr[8];
#define M1_SHIFT(dst, a_) do { unpack8(pfc[a_], dst); unpack8(pfp[a_], pr); const f32x4 m0 = *(const LAS f32x4*)(CST + (a_) * 512 + hc0), m1 = *(const LAS f32x4*)(CST + (a_) * 512 + hc0 + 4); \
              _Pragma("unroll") for (int j = 0; j < 8; ++j) dst[j] = dst[j] + (pr[j] - dst[j]) * (j < 4 ? m0[j] : m1[j - 4]); } while (0)
          M1_SHIFT(rr, 0); M1_SHIFT(kx, 1); M1_SHIFT(vv, 2);
          float Lt[8], Lm[8], al[8], ckk[8], cka[8], crk[8];
#pragma unroll
          for (int j = 0; j < 8; ++j) { Lt[j] = Ef[tok * ES + ch0 + j]; Lm[j] = tok > 0 ? Ef[(tok - 1) * ES + ch0 + j] : 0.f; al[j] = ALf[tok * ES + ch0 + j]; ckk[j] = CST[3 * 512 + hc0 + j]; cka[j] = CST[4 * 512 + hc0 + j]; crk[j] = CST[5 * 512 + hc0 + j]; }
          float kk[8], km[8]; float ss = 0.f, bs_ = 0.f;
#pragma unroll
          for (int j = 0; j < 8; ++j) { kk[j] = kx[j] * ckk[j]; ss += kk[j] * kk[j]; km[j] = kx[j] * (1.f + (al[j] - 1.f) * cka[j]); bs_ += rr[j] * km[j] * crk[j]; }
          ss += __shfl_xor(ss, 1); ss += __shfl_xor(ss, 2); ss += __shfl_xor(ss, 4); bs_ += __shfl_xor(bs_, 1); bs_ += __shfl_xor(bs_, 2); bs_ += __shfl_xor(bs_, 4);
          const float inv = 1.f / fmaxf(sqrtf(ss), 1e-12f);
          if (eb_cg == 0) Sc.Sbsc[eb_row * NH + h] = bs_;
          float oA[8], oB[8], oK[8], oR[8];
#pragma unroll
          for (int j = 0; j < 8; ++j) { const float kn = kk[j] * inv, bb = kn * al[j]; const float eL = __expf(Lt[j]), einv = __builtin_amdgcn_rcpf(eL);
              oA[j] = -kn * __expf(Lm[j]); oB[j] = bb * einv; oK[j] = km[j] * einv; oR[j] = rr[j] * eL; if (tok == 63) GAM[ch0 + j] = eL; }
          *(LAS u32x4*)(At + tok * 72 + ch0) = pack8(oA); *(LAS u32x4*)(Bt + tok * 72 + ch0) = pack8(oB); *(LAS u32x4*)(Kt + tok * 72 + ch0) = pack8(oK); *(LAS u32x4*)(Rt + tok * 72 + ch0) = pack8(oR);
          *(LAS u32x4*)(Vt + tok * 72 + ch0) = pack8(vv); }
        { const int hn_ = ((hi_ + 1 < NH ? hi_ + 1 : hi_) + (int)blockIdx.x) & (NH - 1); M1_LOAD_W(hn_); }
        LDS_BARRIER();
        for (int rp = 0; rp < rp_p1; ++rp) for (int i5 = 0; i5 < 5; ++i5) { const int q = w + 8 * i5, mat = q / 10, idx = q % 10; const int ti = idx < 1 ? 0 : (idx < 3 ? 1 : (idx < 6 ? 2 : 3)), si = idx - ti * (ti + 1) / 2;
            const LAS bf16* X = mat < 2 ? At : Rt; const LAS bf16* Yk = (mat & 1) ? Kt : Bt; LAS bf16* O = Lab + mat * 64 * 72;
            f32x4 acc = {0.f, 0.f, 0.f, 0.f};
#pragma unroll
            for (int ks = 0; ks < 2; ++ks) acc = MFMA32(lds_row8(Yk, 72, 16 * si, 32 * ks, lane), lds_row8(X, 72, 16 * ti, 32 * ks, lane), acc);
            const int t = 16 * ti + l15, s0 = 16 * si + 4 * g; const int lim = mat < 2 ? t : t + 1;
#pragma unroll
            for (int r = 0; r < 4; ++r) acc[r] = (s0 + r < lim) ? acc[r] : 0.f;
            *(LAS s16x4*)(O + t * 72 + s0) = pack4(acc); }
        LDS_BARRIER();
        for (int rp = 0; rp < rp_ch; ++rp) { const bool isU = w < 4; const int cw = w & 3; const f32x4 zero = {0.f, 0.f, 0.f, 0.f};
          s16x4 TTp[4];
#pragma unroll
          for (int hb = 0; hb < 2; ++hb) { s16x4 fr[2], ft[2];
#pragma unroll
            for (int i = 0; i < 2; ++i) { fr[i] = lds_row4(Lab, 72, 16 * (2 * hb + i), 16 * (2 * hb + i), lane); ft[i] = lds_tr4(Lab, 72, 16 * (2 * hb + i), 16 * (2 * hb + i), lane); }
            f32x4 L2[2], L2T[2], L4[2], L4T[2], L8[2], TT[2]; s16x4 pL2[2], pL2T[2], pL4[2], pL4T[2];
#pragma unroll
            for (int i = 0; i < 2; ++i) { L2[i] = MFMA16(fr[i], ft[i], zero); L2T[i] = MFMA16(ft[i], fr[i], zero); }
#pragma unroll
            for (int i = 0; i < 2; ++i) { pL2[i] = pack4(L2[i]); pL2T[i] = pack4(L2T[i]); TT[i] = unpack4(fr[i]);
#pragma unroll
                for (int r = 0; r < 4; ++r) TT[i][r] += (l15 == 4 * g + r) ? 1.f : 0.f; }
#pragma unroll
            for (int i = 0; i < 2; ++i) { L4[i] = MFMA16(pL2T[i], pL2[i], zero); L4T[i] = MFMA16(pL2[i], pL2T[i], zero); TT[i] = MFMA16(pL2[i], pack4(TT[i]), TT[i]); }
#pragma unroll
            for (int i = 0; i < 2; ++i) { pL4[i] = pack4(L4[i]); pL4T[i] = pack4(L4T[i]); }
#pragma unroll
            for (int i = 0; i < 2; ++i) { L8[i] = MFMA16(pL4T[i], pL4[i], zero); TT[i] = MFMA16(pL4[i], pack4(TT[i]), TT[i]); }
#pragma unroll
            for (int i = 0; i < 2; ++i) { TT[i] = MFMA16(pack4(L8[i]), pack4(TT[i]), TT[i]); TTp[2 * hb + i] = pack4(TT[i]); } }
          s16x4 Vf[4]; f32x4 z[4];
          if (isU) { s16x4 lk[10];
#pragma unroll
              for (int j = 0; j < 4; ++j) Vf[j] = lds_tr4(Vt, 72, 16 * j, 16 * cw, lane);
#pragma unroll
              for (int i = 0; i < 4; ++i)
#pragma unroll
                  for (int j = 0; j <= i; ++j) lk[i * (i + 1) / 2 + j] = lds_row4(Lak, 72, 16 * i, 16 * j, lane);
#pragma unroll
              for (int i = 0; i < 4; ++i) { z[i] = zero;
#pragma unroll
                  for (int j = 0; j <= i; ++j) z[i] = MFMA16(lk[i * (i + 1) / 2 + j], Vf[j], z[i]); }
          } else {
#pragma unroll
              for (int i = 0; i < 4; ++i) { Vf[i] = (s16x4){0, 0, 0, 0}; z[i] = unpack4(lds_tr4(At, 72, 16 * i, 16 * cw, lane)); } }
          s16x4 Xp[4];
          { s16x4 lb[6];
#pragma unroll
            for (int i = 1; i < 4; ++i)
#pragma unroll
                for (int j = 0; j < i; ++j) lb[i * (i - 1) / 2 + j] = lds_row4(Lab, 72, 16 * i, 16 * j, lane);
#pragma unroll
            for (int i = 0; i < 4; ++i) { f32x4 zz = z[i];
#pragma unroll
                for (int j = 0; j < i; ++j) zz = MFMA16(lb[i * (i - 1) / 2 + j], Xp[j], zz);
                Xp[i] = pack4(MFMA16(TTp[i], pack4(zz), zero)); } }
          if (isU) {
#pragma unroll
              for (int nt = 0; nt < 4; ++nt) { s16x4 bf_[4], kf_[4];
#pragma unroll
                  for (int i = 0; i < 4; ++i) { bf_[i] = lds_tr4(Bt, 72, 16 * i, 16 * nt, lane); kf_[i] = lds_tr4(Kt, 72, 16 * i, 16 * nt, lane); }
                  f32x4 a1 = zero, a2 = zero;
#pragma unroll
                  for (int i = 0; i < 4; ++i) { a1 = MFMA16(Xp[i], bf_[i], a1); a2 = MFMA16(Vf[i], kf_[i], a2); }
                  const float gm = GAM[16 * nt + l15]; const f32x4 acc = (a1 + a2) * gm;
                  *(s16x4*)(Sc.SH + uh + (size_t)(16 * nt + l15) * 64 + 16 * cw + 4 * g) = pack4(acc); }
#pragma unroll
              for (int mt = 0; mt < 4; ++mt) { s16x4 mb[4], mk[4];
#pragma unroll
                  for (int i = 0; i <= mt; ++i) { mb[i] = lds_row4(Mrb, 72, 16 * mt, 16 * i, lane); mk[i] = lds_row4(Mrk, 72, 16 * mt, 16 * i, lane); }
                  f32x4 a1 = zero, a2 = zero;
#pragma unroll
                  for (int i = 0; i <= mt; ++i) { a1 = MFMA16(mb[i], Xp[i], a1); a2 = MFMA16(mk[i], Vf[i], a2); }
                  *(s16x4*)(Sc.SY0 + uh + (size_t)(16 * cw + l15) * 64 + 16 * mt + 4 * g) = pack4(a1 + a2); }
          } else {
#pragma unroll
              for (int nt = 0; nt < 4; ++nt) { s16x4 bf_[4];
#pragma unroll
                  for (int i = 0; i < 4; ++i) bf_[i] = lds_tr4(Bt, 72, 16 * i, 16 * nt, lane);
                  f32x4 a1 = zero, a2 = zero;
                  a1 = MFMA16(Xp[0], bf_[0], a1); a2 = MFMA16(Xp[1], bf_[1], a2); a1 = MFMA16(Xp[2], bf_[2], a1); a2 = MFMA16(Xp[3], bf_[3], a2);
                  f32x4 acc = a1 + a2; const float gm = GAM[16 * nt + l15]; const float dg = (nt == cw) ? 1.f : 0.f;
#pragma unroll
                  for (int r = 0; r < 4; ++r) acc[r] = (acc[r] + ((l15 == 4 * g + r) ? dg : 0.f)) * gm;
                  *(s16x4*)(Sc.SG + uh + (size_t)(16 * nt + l15) * 64 + 16 * cw + 4 * g) = pack4(acc); }
#pragma unroll
              for (int mt = 0; mt < 4; ++mt) { s16x4 mb[4]; const s16x4 rf = lds_tr4(Rt, 72, 16 * mt, 16 * cw, lane);
#pragma unroll
                  for (int i = 0; i <= mt; ++i) mb[i] = lds_row4(Mrb, 72, 16 * mt, 16 * i, lane);
                  f32x4 acc = unpack4(rf);
#pragma unroll
                  for (int i = 0; i <= mt; ++i) acc = MFMA16(mb[i], Xp[i], acc);
                  *(s16x4*)(Sc.SQ + uh + (size_t)(16 * cw + l15) * 64 + 16 * mt + 4 * g) = pack4(acc); }
          } }
        LDS_BARRIER();
    }
#undef M1_LOAD_W
#undef M1_LOAD_P
#undef M1_SHIFT
}

constexpr int M2_S = 0;
__device__ __forceinline__ void rwkv_m2_unit(Frame& F, int unit  , const RwkvS& Sc) {
    const int b = unit >> 3, h = unit & 7; const int w = F.wave, lane = F.lane, l15 = lane & 15, g = lane >> 4; const int mt = w >> 1, ntb = 2 * (w & 1);
    LAS bf16* Sb = (LAS bf16*)(F.lds + M2_S);
    f32x4 acc[2] = {{0.f, 0.f, 0.f, 0.f}, {0.f, 0.f, 0.f, 0.f}};
    constexpr int PF = 8;
    bf16x8 Gf[PF][2][2]; u32x2 Hf[PF][2];
#define M2_LOAD(slot, cc) do { const size_t uh_ = ((size_t)(b * 64 + (cc)) * NH + h) * 4096; _Pragma("unroll") for (int q = 0; q < 2; ++q) { const size_t ro = uh_ + (size_t)(16 * (ntb + q) + l15) * 64; \
        Gf[slot][q][0] = *(const bf16x8*)(Sc.SG + ro + 8 * g); Gf[slot][q][1] = *(const bf16x8*)(Sc.SG + ro + 32 + 8 * g); Hf[slot][q] = *(const u32x2*)(Sc.SH + ro + 16 * mt + 4 * g); } } while (0)
#pragma unroll
    for (int u = 0; u < PF; ++u) M2_LOAD(u, u);
    for (int c0 = 0; c0 < 64; c0 += PF) {
#pragma unroll
        for (int u = 0; u < PF; ++u) { const int c = c0 + u;
            const size_t uh = ((size_t)(b * 64 + c) * NH + h) * 4096; LAS bf16* buf = Sb + (u & 1) * 64 * 72;
#pragma unroll
            for (int q = 0; q < 2; ++q) { const s16x4 p = pack4(acc[q]); *(LAS s16x4*)(buf + (16 * (ntb + q) + l15) * 72 + 16 * mt + 4 * g) = p; *(s16x4*)(Sc.SS + uh + (size_t)(16 * (ntb + q) + l15) * 64 + 16 * mt + 4 * g) = p; }
            LDS_BARRIER();
            const bf16x8 a0 = lds_tr8(buf, 72, 0, 16 * mt, lane), a1 = lds_tr8(buf, 72, 32, 16 * mt, lane);
#pragma unroll
            for (int q = 0; q < 2; ++q) { f32x4 z; z[0] = __builtin_bit_cast(float, Hf[u][q].x << 16); z[1] = __builtin_bit_cast(float, Hf[u][q].x & 0xffff0000u); z[2] = __builtin_bit_cast(float, Hf[u][q].y << 16); z[3] = __builtin_bit_cast(float, Hf[u][q].y & 0xffff0000u);
                z = MFMA32(a0, Gf[u][q][0], z); acc[q] = MFMA32(a1, Gf[u][q][1], z); }
            { const int cn = c + PF < 64 ? c + PF : 63; M2_LOAD(u, cn); } }
    }
#undef M2_LOAD
    LDS_BARRIER();
}

constexpr int M3_SLOT = 9216 * 2 + 64 * 68 * 4;
__device__ __forceinline__ void rwkv_m3_unit(Frame& F, int unit  , const bf16* P, bf16* Y, const RwkvW& W, const RwkvS& Sc) {
    const int b = unit >> 6, c = unit & 63, t0 = c * 64; const size_t row0 = (size_t)b * SEQ + t0;
    const int w = F.wave, lane = F.lane, l15 = lane & 15, g = lane >> 4, hw = w >> 2, mt = w & 3, tl = F.tid & 255;
    LAS bf16* Qt = (LAS bf16*)(F.lds + hw * M3_SLOT); LAS bf16* St = Qt + 64 * 72; LAS float* Out = (LAS float*)(F.lds + hw * M3_SLOT + 2 * 9216);
    for (int hp = 0; hp < 4; ++hp) { const int h = 2 * hp + hw; const size_t uh = ((size_t)unit * NH + h) * 4096;
#pragma unroll
        for (int r = 0; r < 2; ++r) { const int off = 8 * (tl + 256 * r), rr = off >> 6, cc = off & 63;
            *(LAS u32x4*)(Qt + rr * 72 + cc) = *(const u32x4*)(Sc.SQ + uh + off); *(LAS u32x4*)(St + rr * 72 + cc) = *(const u32x4*)(Sc.SS + uh + off); }
        LDS_BARRIER();
        f32x4 acc[4];
#pragma unroll
        for (int nt = 0; nt < 4; ++nt) acc[nt] = unpack4(*(const s16x4*)(Sc.SY0 + uh + (size_t)(16 * nt + l15) * 64 + 16 * mt + 4 * g));
#pragma unroll
        for (int ks = 0; ks < 2; ++ks) { const bf16x8 a = lds_tr8(Qt, 72, 32 * ks, 16 * mt, lane);
#pragma unroll
            for (int nt = 0; nt < 4; ++nt) acc[nt] = MFMA32(a, lds_tr8(St, 72, 32 * ks, 16 * nt, lane), acc[nt]); }
#pragma unroll
        for (int r = 0; r < 4; ++r) { float s = (acc[0][r] + acc[1][r]) + (acc[2][r] + acc[3][r]);
            s += __shfl_xor(s, 1); s += __shfl_xor(s, 2); s += __shfl_xor(s, 4); s += __shfl_xor(s, 8); const float mean = s * (1.f / HD); float q = 0.f;
#pragma unroll
            for (int nt = 0; nt < 4; ++nt) { const float d = acc[nt][r] - mean; q += d * d; }
            q += __shfl_xor(q, 1); q += __shfl_xor(q, 2); q += __shfl_xor(q, 4); q += __shfl_xor(q, 8); const float rstd = __builtin_amdgcn_rsqf(q * (1.f / HD) + GN_EPS);
#pragma unroll
            for (int nt = 0; nt < 4; ++nt) { const int v = 16 * nt + l15; Out[(16 * mt + 4 * g + r) * 68 + v] = (acc[nt][r] - mean) * rstd * W.lnx_w[h * HD + v] + W.lnx_b[h * HD + v]; } }
        LDS_BARRIER();
        { const int t = tl >> 2, cq = tl & 3, v0 = 16 * cq, hv0 = h * HD + v0; const size_t row = row0 + t; const bool has_prev = (t0 + t) > 0; const float bsc = Sc.Sbsc[row * NH + h];
#pragma unroll
          for (int half = 0; half < 2; ++half) { float cv[8], pv[8], gv[8], o[8]; const int col = 2048 + hv0 + 8 * half;
              unpack8(*(const u32x4*)(P + row * INW + col), cv); if (has_prev) unpack8(*(const u32x4*)(P + (row - 1) * INW + col), pv); else { for (int j = 0; j < 8; ++j) pv[j] = 0.f; }
              unpack8(*(const u32x4*)(Sc.Sg + row * RWW + hv0 + 8 * half), gv);
              const f32x4 m0 = *(const f32x4*)(W.mu + col - 1024), m1 = *(const f32x4*)(W.mu + col - 1024 + 4);
#pragma unroll
              for (int j = 0; j < 8; ++j) { const float vs = cv[j] + (pv[j] - cv[j]) * (j < 4 ? m0[j] : m1[j - 4]); o[j] = (Out[t * 68 + v0 + 8 * half + j] + bsc * vs) * gv[j]; }
              *(u32x4*)(Y + row * D + GMW + hv0 + 8 * half) = pack8(o); } }
        LDS_BARRIER();
    }
}


__device__ __forceinline__ void rwkv_m3_units(Frame& F, int u0, int ustep, int nunits, const bf16* P, bf16* Y, const RwkvW& W, const RwkvS& Sc) {
    if (u0 >= nunits) return;
    const int w = F.wave, lane = F.lane, l15 = lane & 15, g = lane >> 4, hw = w >> 2, mt = w & 3, tl = F.tid & 255;
    LAS bf16* Qt = (LAS bf16*)(F.lds + hw * M3_SLOT); LAS bf16* St = Qt + 64 * 72; LAS float* Out = (LAS float*)(F.lds + hw * M3_SLOT + 2 * 9216);
    const int nu = (nunits - u0 + ustep - 1) / ustep, niter = nu * 4;
    LAS float* TB = (LAS float*)(F.lds + 73728);
    TB[F.tid] = W.lnx_w[F.tid]; TB[512 + F.tid] = W.lnx_b[F.tid]; TB[1024 + F.tid] = W.mu[1024 + F.tid];
    u32x4 qf[2], sf[2]; s16x4 y0f[4];
#define M3_PREF(itn) do { const int un_ = u0 + ((itn) >> 2) * ustep, hn_ = 2 * ((itn) & 3) + hw; const size_t uhn_ = ((size_t)un_ * NH + hn_) * 4096; \
        _Pragma("unroll") for (int r = 0; r < 2; ++r) { qf[r] = *(const u32x4*)(Sc.SQ + uhn_ + 8 * (tl + 256 * r)); sf[r] = *(const u32x4*)(Sc.SS + uhn_ + 8 * (tl + 256 * r)); } \
        _Pragma("unroll") for (int nt = 0; nt < 4; ++nt) y0f[nt] = *(const s16x4*)(Sc.SY0 + uhn_ + (size_t)(16 * nt + l15) * 64 + 16 * mt + 4 * g); } while (0)
    M3_PREF(0);
    for (int it = 0; it < niter; ++it) {
        const int unit = u0 + (it >> 2) * ustep, h = 2 * (it & 3) + hw; const int b = unit >> 6, c = unit & 63, t0 = c * 64; const size_t row0 = (size_t)b * SEQ + t0;
#pragma unroll
        for (int r = 0; r < 2; ++r) { const int off = 8 * (tl + 256 * r), rr = off >> 6, cc = off & 63; *(LAS u32x4*)(Qt + rr * 72 + cc) = qf[r]; *(LAS u32x4*)(St + rr * 72 + cc) = sf[r]; }
        f32x4 acc[4];
#pragma unroll
        for (int nt = 0; nt < 4; ++nt) acc[nt] = unpack4(y0f[nt]);
        const int t = tl >> 2, cq = tl & 3, v0 = 16 * cq, hv0 = h * HD + v0; const size_t row = row0 + t; const bool has_prev = (t0 + t) > 0;
        u32x4 cvr[2], pvr[2], gvr[2]; const float bsc = Sc.Sbsc[row * NH + h];
#pragma unroll
        for (int half = 0; half < 2; ++half) { const int col = 2048 + hv0 + 8 * half; cvr[half] = *(const u32x4*)(P + row * INW + col);
            pvr[half] = *(const u32x4*)(P + (has_prev ? row - 1 : row) * INW + col); gvr[half] = *(const u32x4*)(Sc.Sg + row * RWW + hv0 + 8 * half); }
        { const int itn = it + 1 < niter ? it + 1 : it; M3_PREF(itn); }
        LDS_BARRIER();
#pragma unroll
        for (int ks = 0; ks < 2; ++ks) { const bf16x8 a = lds_tr8(Qt, 72, 32 * ks, 16 * mt, lane);
#pragma unroll
            for (int nt = 0; nt < 4; ++nt) acc[nt] = MFMA32(a, lds_tr8(St, 72, 32 * ks, 16 * nt, lane), acc[nt]); }
#pragma unroll
        for (int r = 0; r < 4; ++r) { float s2 = (acc[0][r] + acc[1][r]) + (acc[2][r] + acc[3][r]);
            s2 += __shfl_xor(s2, 1); s2 += __shfl_xor(s2, 2); s2 += __shfl_xor(s2, 4); s2 += __shfl_xor(s2, 8); const float mean = s2 * (1.f / HD); float q = 0.f;
#pragma unroll
            for (int nt = 0; nt < 4; ++nt) { const float d = acc[nt][r] - mean; q += d * d; }
            q += __shfl_xor(q, 1); q += __shfl_xor(q, 2); q += __shfl_xor(q, 4); q += __shfl_xor(q, 8); const float rstd = __builtin_amdgcn_rsqf(q * (1.f / HD) + GN_EPS);
#pragma unroll
            for (int nt = 0; nt < 4; ++nt) { const int v = 16 * nt + l15; Out[(16 * mt + 4 * g + r) * 68 + v] = (acc[nt][r] - mean) * rstd * TB[h * HD + v] + TB[512 + h * HD + v]; } }
        LDS_BARRIER();
#pragma unroll
        for (int half = 0; half < 2; ++half) { float cv[8], pv[8], gv[8], o[8];
            unpack8(cvr[half], cv); unpack8(pvr[half], pv); unpack8(gvr[half], gv);
            const f32x4 m0 = *(const LAS f32x4*)(TB + 1024 + hv0 + 8 * half), m1 = *(const LAS f32x4*)(TB + 1024 + hv0 + 8 * half + 4);
#pragma unroll
            for (int j = 0; j < 8; ++j) { const float pvj = has_prev ? pv[j] : 0.f; const float vs = cv[j] + (pvj - cv[j]) * (j < 4 ? m0[j] : m1[j - 4]); o[j] = (Out[t * 68 + v0 + 8 * half + j] + bsc * vs) * gv[j]; }
            *(u32x4*)(Y + row * D + GMW + hv0 + 8 * half) = pack8(o); }
    }
#undef M3_PREF
    LDS_BARRIER();
}

__device__ __forceinline__ void rwkv_apply_naive(Frame& F, int unit, const bf16* P, bf16* Y, const RwkvW& W, const RwkvS& Sc) {
    const int b = unit >> 3, h = unit & 7;
    LAS float* S = (LAS float*)F.lds; LAS float* Gs = S + 64 * 65; LAS float* Hs = Gs + 64 * 65; LAS float* Qs = Hs + 64 * 65; LAS float* Ys = Qs + 64 * 65; LAS float* Sn = Ys + 64 * 65;
    for (int i = F.tid; i < 64 * 65; i += 512) S[i] = 0.f;
    __syncthreads();
    for (int c = 0; c < 64; ++c) { const size_t uh = ((size_t)(b * 64 + c) * NH + h) * 4096; const size_t row0 = (size_t)b * SEQ + c * 64;
        for (int i = F.tid; i < 4096; i += 512) { const int r = i >> 6, cc = i & 63;
            Gs[cc * 65 + r] = bf2f(Sc.SG[uh + i]);
            Hs[cc * 65 + r] = bf2f(Sc.SH[uh + i]);
            Qs[cc * 65 + r] = bf2f(Sc.SQ[uh + i]);
            Ys[cc * 65 + r] = bf2f(Sc.SY0[uh + i]); }
        __syncthreads();
        for (int i = F.tid; i < 4096; i += 512) { const int t = i >> 6, v = i & 63; float a = Ys[t * 65 + v];
            if (DBG_VAR != 1) for (int k = 0; k < 64; ++k) a += Qs[t * 65 + k] * S[v * 65 + k];
            if (DBG_VAR == 2) a = 0.f;
            Ys[t * 65 + v] = a; }
        for (int i = F.tid; i < 4096; i += 512) { const int v = i >> 6, k2 = i & 63; float a = Hs[v * 65 + k2];
            if (DBG_VAR == 6) a += S[v * 65 + k2] * Gs[k2 * 65 + k2]; else if (DBG_VAR != 3) for (int k = 0; k < 64; ++k) a += S[v * 65 + k] * Gs[k * 65 + k2];
            if (DBG_VAR == 7) a = Hs[v * 65 + k2] + 0.5f * (a - Hs[v * 65 + k2]);
            Sn[v * 65 + k2] = a; }
        __syncthreads();
        for (int i = F.tid; i < 4096; i += 512) { const int v = i >> 6, k2 = i & 63; S[v * 65 + k2] = Sn[v * 65 + k2]; }
        { const int t = F.tid >> 3, cg = F.tid & 7, v0 = 8 * cg, hv0 = h * HD + v0; const size_t row = row0 + t; const bool has_prev = (c * 64 + t) > 0; const float bsc = Sc.Sbsc[row * NH + h];
          float yv[8]; float sm = 0.f;
          for (int j = 0; j < 8; ++j) { yv[j] = Ys[t * 65 + v0 + j]; sm += yv[j]; }
          sm += __shfl_xor(sm, 1); sm += __shfl_xor(sm, 2); sm += __shfl_xor(sm, 4); const float mean = sm * (1.f / HD); float q = 0.f;
          for (int j = 0; j < 8; ++j) { yv[j] -= mean; q += yv[j] * yv[j]; }
          q += __shfl_xor(q, 1); q += __shfl_xor(q, 2); q += __shfl_xor(q, 4); const float rstd = __builtin_amdgcn_rsqf(q * (1.f / HD) + GN_EPS);
          float cv[8], pv[8], gv[8], o[8]; const int col = 2048 + hv0;
          unpack8(*(const u32x4*)(P + row * INW + col), cv); if (has_prev) unpack8(*(const u32x4*)(P + (row - 1) * INW + col), pv); else { for (int j = 0; j < 8; ++j) pv[j] = 0.f; }
          unpack8(*(const u32x4*)(Sc.Sg + row * RWW + hv0), gv);
          for (int j = 0; j < 8; ++j) { const float vs = cv[j] + (pv[j] - cv[j]) * W.mu[col - 1024 + j]; o[j] = (yv[j] * rstd * W.lnx_w[hv0 + j] + W.lnx_b[hv0 + j] + bsc * vs) * gv[j]; }
          *(u32x4*)(Y + row * D + GMW + hv0) = pack8(o); }
        __syncthreads();
    }
}

enum Phase { PH_PRO = 0, PH_G1_0, PH_M1_0, PH_M2_0, PH_M3_0, PH_G2_0, PH_G3_0, PH_G4_0, PH_G1_1, PH_M1_1, PH_M2_1, PH_M3_1, PH_G2_1, PH_CV, PH_R2, PH_GU_A, PH_DN_A, PH_GU_B, PH_DN_B, PH_FIN, PH_COUNT };

__global__ void __launch_bounds__(512, 2) fwd(Args args) {
    extern __shared__ __attribute__((aligned(16))) unsigned char lds_raw[];
    Frame F;
    F.lds = (LAS unsigned char*)lds_raw;
    F.tid = threadIdx.x; F.lane = F.tid & 63; F.wave = __builtin_amdgcn_readfirstlane(F.tid >> 6);
    F.G = gridDim.x; F.gw = blockIdx.x * 8 + F.wave; F.NGW = F.G * 8;
    unsigned char* ws = args.ws;
    gu32* ctl = (gu32*)(ws + WS_CTL);
    volatile LAS unsigned* MISC = (volatile LAS unsigned*)(F.lds + MISC_OFF);
    if (F.tid < 32) ((LAS unsigned*)(F.lds + MISC_OFF))[F.tid] = 0u;
    __syncthreads();
    XcdBarrier bar; bar.bar = (unsigned*)(ctl + CW_BAR); bar.x = 0; bar.st = nullptr;
#if !MK_PER_PHASE
    bar = xcd_barrier_post((unsigned*)(ctl + CW_BAR), MISC + 8);
#endif
    const int lo = args.ph_lo, hi = args.ph_hi;
#define IN(k) (lo <= (k) && (k) < hi)
#define STAGGER_WAIT() do { if (STAGGER_TICKS > 0 && (blockIdx.x & 8)) { const unsigned long long t0_ = __builtin_amdgcn_s_memrealtime(); while (__builtin_amdgcn_s_memrealtime() - t0_ < (unsigned long long)STAGGER_TICKS) __builtin_amdgcn_s_sleep(32); } } while (0)
#define SEAM(k) do { if (IN(k) && IN((k) + 1)) xcd_barrier(bar); } while (0)

    const float* x_in = args.in[I_X];
    bf16* WinT = (bf16*)(ws + WS_WIN); bf16* WoutT = (bf16*)(ws + WS_WOUT); bf16* WguT = (bf16*)(ws + WS_WGU); bf16* WdT = (bf16*)(ws + WS_WD);
    bf16* XB = (bf16*)(ws + WS_XB); bf16* PB = (bf16*)(ws + WS_P); bf16* YB = (bf16*)(ws + WS_Y); bf16* HB = (bf16*)(ws + WS_P);
    bf16* MWgu = (bf16*)(ws + WS_MOEW_GU); bf16* MWd = (bf16*)(ws + (MOE8_GU ? WS_MOEW8_D : WS_MOEW_D)); bf16* MH = (bf16*)(ws + WS_MOEH);
    unsigned char* MWgu8 = ws + WS_MOEW8_GU; unsigned char* MWd8 = ws + WS_MOEW8_D; unsigned char* MH8 = ws + WS_MOEH; unsigned char* MH8b = ws + WS_MOEH + 119 * MiB; unsigned char* XB8 = ws + WS_XB8;
    float* ssq0 = (float*)(ctl + CW_SSQ); float* ssq1 = (float*)(ws + WS_SSQP); float* ssq2 = ssq1 + (size_t)NTOK * 16;
    bf16* WupT = (bf16*)(ws + WS_SMALLW + SW_WUP); bf16* AupT = (bf16*)(ws + WS_SMALLW + SW_AUP); bf16* GupT = (bf16*)(ws + WS_SMALLW + SW_GUP); bf16* WsB = (bf16*)(ws + WS_SMALLW + SW_WS);
    RwkvS RS{(bf16*)(ws + WS_SCR), (bf16*)(ws + WS_SCR + 32 * MiB), (bf16*)(ws + WS_SCR + 64 * MiB), (bf16*)(ws + WS_SCR + 96 * MiB), (bf16*)(ws + WS_SCR + 128 * MiB), (bf16*)((unsigned char*)args.out), (float*)((unsigned char*)args.out + 32 * MiB)};
    unsigned char* misc = ws + WS_MISC;
    int* tok_e = (int*)(misc + MS_TOKE); float* tok_g = (float*)(misc + MS_TOKG); float* rs_moe = (float*)(misc + MS_RS); int* bcnt = (int*)(misc + MS_BCNT);
    int* row_tok = (int*)(misc + MS_ROWTOK); float* row_gate = (float*)(misc + MS_ROWGATE); int* panel = (int*)(misc + MS_PANEL); float* row_rs = (float*)(misc + MS_ROWRS);

#define DEFERRED_CONVERT(FR) do { int itb_ = 0; \
        convert_matrix(FR, args.in[I_W_IN] + (size_t)D * INW, D, INW, WinT + (size_t)INW * D, 0, args.in[I_NORM_MIX] + D, 0, itb_); \
        convert_matrix(FR, args.in[I_W_OUT], D, D, WoutT, 0, nullptr, 0, itb_); convert_matrix(FR, args.in[I_W_OUT] + (size_t)D * D, D, D, WoutT + (size_t)D * D, 0, nullptr, 0, itb_); \
        convert_matrix(FR, args.in[I_FFN_WG], D, FF, WguT, 1, args.in[I_NORM_FFN], 0, itb_); convert_matrix(FR, args.in[I_FFN_WU], D, FF, WguT, 2, args.in[I_NORM_FFN], 0, itb_); \
        convert_matrix(FR, args.in[I_FFN_WD], FF, D, WdT, 0, nullptr, 0, itb_); } while (0)
    if (IN(PH_PRO)) for (int rep = 0; rep < (PROBE_DUP == 4 ? 2 : 1); ++rep) {
        int itb = 0;
        convert_matrix(F, args.in[I_W_IN], D, INW, WinT, 0, args.in[I_NORM_MIX], 0, itb);
        if (!(DEFER_CONVERT && F.G == 256)) { DEFERRED_CONVERT(F); }
        { const size_t gt = (size_t)blockIdx.x * 512 + F.tid, gn = (size_t)F.G * 512;
          for (size_t i = gt; i < (size_t)2 * RWW * 64; i += gn) { const int l = (int)(i / (RWW * 64)), r = (int)(i % (RWW * 64)), ch = r / 64, j = r % 64;
              WupT[i] = (bf16)f2bf(args.in[I_RW_W_UP][(size_t)l * 64 * RWW + (size_t)j * RWW + ch]); AupT[i] = (bf16)f2bf(args.in[I_RW_A_UP][(size_t)l * 64 * RWW + (size_t)j * RWW + ch]); }
          for (size_t i = gt; i < (size_t)2 * RWW * 128; i += gn) { const int l = (int)(i / (RWW * 128)), r = (int)(i % (RWW * 128)), ch = r / 128, j = r % 128;
              GupT[i] = (bf16)f2bf(args.in[I_RW_G_UP][(size_t)l * 128 * RWW + (size_t)j * RWW + ch]); }
          for (size_t i = gt; i < (size_t)2 * NH * GCH * GCH; i += gn) { const int t = (int)((i / GCH) % GCH), s2 = (int)(i % GCH); WsB[i] = (bf16)(s2 <= t ? f2bf(args.in[I_GM_WS][i]) : 0u); } }
        for (int m = F.gw; m < NTOK; m += F.NGW) {
            const GAS f32x4* xr = (const GAS f32x4*)(x_in + (size_t)m * D) + F.lane; GAS u32x2* o8 = (GAS u32x2*)(XB + (size_t)m * D) + F.lane; float s = 0.f;
#pragma unroll
            for (int j = 0; j < 4; ++j) { const f32x4 v = xr[64 * j]; s += (v.x * v.x + v.y * v.y) + (v.z * v.z + v.w * v.w); u32x2 w; w.x = pk2(v.x, v.y); w.y = pk2(v.z, v.w); o8[64 * j] = w; }
            s = wave_sum(s); if (F.lane == 0) ssq0[m] = s;
        }
    }
    SEAM(PH_PRO);
    if (PROBE_DUP == 6) { for (int q_ = 0; q_ < 10; ++q_) xcd_barrier(bar); }

#define LAYER_MIXER(L, PH1, PHA, PHB, PHC, PH2, XBASE, BASE32, SSQ_IN, NP_IN, SSQ_OUT, HAS_OUT) \
    if (IN(PH1)) { pg8::DenseSched S; S.init(XB, WinT + (size_t)(L) * INW * D, NTOK, INW, 2 * D, F.G, (int)blockIdx.x); \
        pg8::EpiScaleBf16<NP_IN> E{PB, INW, SSQ_IN, (LAS float*)(F.lds + RING_BYTES + 4096)}; pg8::gemm_phase(F.lds, 2 * D, S, E); } \
    if (DEFER_CONVERT && (L) == 0 && IN(PH1) && F.G == 256 && (int)blockIdx.x >= 128) { __syncthreads(); Frame F2 = F; F2.gw = ((int)blockIdx.x - 128) * 8 + F.wave; F2.NGW = 128 * 8; DEFERRED_CONVERT(F2); __syncthreads(); } \
    if (PROBE_DUP == 1 && (L) == 0 && IN(PH1)) { pg8::DenseSched S; S.init(XB, WinT + (size_t)(L) * INW * D, NTOK, INW, 2 * D, F.G, (int)blockIdx.x); \
        pg8::EpiScaleBf16<NP_IN> E{PB, INW, SSQ_IN, (LAS float*)(F.lds + RING_BYTES + 4096)}; pg8::gemm_phase(F.lds, 2 * D, S, E); } \
    SEAM(PH1); \
    { RwkvW RW{args.in[I_SHIFT_MU] + (L) * 1792, args.in[I_RW_W0] + (L) * RWW, args.in[I_RW_A0] + (L) * RWW, args.in[I_RW_K_K] + (L) * RWW, args.in[I_RW_K_A] + (L) * RWW, args.in[I_RW_R_K] + (L) * RWW, \
                 args.in[I_RW_LNX_W] + (L) * RWW, args.in[I_RW_LNX_B] + (L) * RWW, WupT + (size_t)(L) * RWW * 64, AupT + (size_t)(L) * RWW * 64, GupT + (size_t)(L) * RWW * 128}; \
      if (IN(PHA)) { if (MIX_MODE != 1) for (int rep = 0; rep < REP_M1; ++rep) { rwkv_m1_consts(F, RW); for (int u = blockIdx.x; u < NB * 64; u += F.G) rwkv_m1v2_unit(F, u, PB, RW, RS); } } \
      SEAM(PHA); \
      if (IN(PHB)) for (int rep = 0; rep < REP_M2; ++rep) { const int nscan = (F.G >= 128 && MIX_MODE != 1) ? 64 : 0; \
          if (MIX_MODE != 1 && MIX_MODE != 3) { if (nscan) { if ((int)blockIdx.x < 64) { rwkv_m2_unit(F, blockIdx.x, RS); hnd_arrive((unsigned*)(ctl + CW_HND + 64 * (L))); } } else { for (int u = blockIdx.x; u < 64; u += F.G) { rwkv_m2_unit(F, u, RS); hnd_arrive((unsigned*)(ctl + CW_HND + 64 * (L))); } } } \
          if (MIX_MODE == 2) gmlp_naive(F, PB, YB, args.in[I_GM_LN_W] + (L) * GMW, args.in[I_GM_LN_B] + (L) * GMW, args.in[I_GM_WS] + (size_t)(L) * NH * GCH * GCH, args.in[I_GM_BS] + (L) * NH * GCH); \
          else { const int NU = NB * (SEQ / GCH) * NH; const int nsplit = (nscan && F.G == 256) ? 1920 : NU;         \
              if ((int)blockIdx.x >= nscan) gmlp_units(F, blockIdx.x - nscan, F.G - nscan, nsplit, PB, YB, args.in[I_GM_LN_W] + (L) * GMW, args.in[I_GM_LN_B] + (L) * GMW, WsB + (size_t)(L) * NH * GCH * GCH, args.in[I_GM_BS] + (L) * NH * GCH); \
              else if (nsplit < NU) gmlp_units(F, nsplit + blockIdx.x, nscan, NU, PB, YB, args.in[I_GM_LN_W] + (L) * GMW, args.in[I_GM_LN_B] + (L) * GMW, WsB + (size_t)(L) * NH * GCH * GCH, args.in[I_GM_BS] + (L) * NH * GCH); } } \
      if (MIX_MODE == 0 && REP_M2 == 1) { if (IN(PHB) && IN(PHC)) hnd_wait((unsigned*)(ctl + CW_HND + 64 * (L)), 64u, bar.bar); } else SEAM(PHB);      \
      if (IN(PHC)) { if (MIX_MODE == 3) { for (int u = blockIdx.x; u < 64; u += F.G) rwkv_apply_naive(F, u, PB, YB, RW, RS); } \
          else if (MIX_MODE != 1) { for (int rep = 0; rep < REP_M3; ++rep) rwkv_m3_units(F, blockIdx.x, F.G, NB * 64, PB, YB, RW, RS); } \
          else rwkv_naive(F, PB, YB, args.in[I_SHIFT_MU] + (L) * 1792, args.in[I_RW_W_UP] + (L) * 64 * RWW, args.in[I_RW_W0] + (L) * RWW, args.in[I_RW_A_UP] + (L) * 64 * RWW, args.in[I_RW_A0] + (L) * RWW, \
                   args.in[I_RW_G_UP] + (L) * 128 * RWW, args.in[I_RW_K_K] + (L) * RWW, args.in[I_RW_K_A] + (L) * RWW, args.in[I_RW_R_K] + (L) * RWW, args.in[I_RW_LNX_W] + (L) * RWW, args.in[I_RW_LNX_B] + (L) * RWW); } \
      SEAM(PHC); } \
    if (IN(PH2)) { STAGGER_WAIT(); pg8::DenseSched S; S.init(YB, WoutT + (size_t)(L) * D * D, NTOK, D, 2 * D, F.G, (int)blockIdx.x); \
        pg8::EpiResid<HAS_OUT, BASE32> E{XBASE, XB, SSQ_OUT}; pg8::gemm_phase(F.lds, 2 * D, S, E); } \
    if (PROBE_DUP == 2 && (L) == 0 && IN(PH2)) { pg8::DenseSched S; S.init(YB, WoutT + (size_t)(L) * D * D, NTOK, D, 2 * D, F.G, (int)blockIdx.x); \
        pg8::EpiResid<HAS_OUT, BASE32> E{XBASE, XB, SSQ_OUT}; pg8::gemm_phase(F.lds, 2 * D, S, E); } \
    SEAM(PH2);

    LAYER_MIXER(0, PH_G1_0, PH_M1_0, PH_M2_0, PH_M3_0, PH_G2_0, nullptr, false, ssq0, 1, ssq1, true)

    if (IN(PH_G3_0)) { pg8::DenseSched S; S.init(XB, WguT, NTOK, 2 * FF, 2 * D, F.G, (int)blockIdx.x);
        pg8::EpiSwiglu<16> E{HB, FF, ssq1, (LAS float*)(F.lds + RING_BYTES + 4096)}; pg8::gemm_phase(F.lds, 2 * D, S, E); }
#if REP_G3 == 2
    if (IN(PH_G3_0)) { pg8::DenseSched S; S.init(XB, WguT, NTOK, 2 * FF, 2 * D, F.G, (int)blockIdx.x);
        pg8::EpiSwiglu<16> E{HB, FF, ssq1, (LAS float*)(F.lds + RING_BYTES + 4096)}; pg8::gemm_phase(F.lds, 2 * D, S, E); }
#endif
    SEAM(PH_G3_0);
    if (IN(PH_G4_0)) { STAGGER_WAIT(); pg8::DenseSched S; S.init(HB, WdT, NTOK, D, 2 * FF, F.G, (int)blockIdx.x);
        pg8::EpiResid<true, false> E{nullptr, XB, ssq2}; pg8::gemm_phase(F.lds, 2 * FF, S, E); }
    SEAM(PH_G4_0);

    LAYER_MIXER(1, PH_G1_1, PH_M1_1, PH_M2_1, PH_M3_1, PH_G2_1, nullptr, false, ssq2, 16, nullptr, false)

    if (IN(PH_CV)) for (int rep = 0; rep < REP_CV; ++rep) {
        const float* gain = args.in[I_NORM_FFN] + D;
        LAS float* RW = (LAS float*)F.lds; LAS int* cnt = (LAS int*)(F.lds + 32768);
        for (int i = F.tid; i < D * NE; i += 512) { const int k = i >> 3, e = i & 7, jj = k >> 9, ln = (k & 511) >> 3, q = k & 7; RW[(((jj * 8 + q) * 64 + ln) << 3) + e] = args.in[I_MOE_ROUTER][i] * gain[k]; }
        for (size_t i = (size_t)blockIdx.x * 512 + F.tid; i < (size_t)2 * MAXPAN * 256; i += (size_t)F.G * 512) { row_tok[i] = -1; row_gate[i] = 0.f; row_rs[i] = 0.f; }
        __syncthreads();
        for (int vb = blockIdx.x; vb < 256; vb += F.G) {
            if (F.tid < 16) cnt[F.tid] = 0;
            __syncthreads();
            u32x4 xv4[2];
            { const GAS u32x4* xr0 = (const GAS u32x4*)(XB + (size_t)(vb * 128 + F.wave * 16) * D) + F.lane; xv4[0] = xr0[0]; xv4[1] = xr0[64]; }
            for (int i = 0; i < 16; ++i) { const int m = vb * 128 + F.wave * 16 + i;
                float s = 0.f; float lg[8]; u32x4 cur4[2]; cur4[0] = xv4[0]; cur4[1] = xv4[1];
                if (i + 1 < 16) { const GAS u32x4* xr1 = (const GAS u32x4*)(XB + (size_t)(m + 1) * D) + F.lane; xv4[0] = xr1[0]; xv4[1] = xr1[64]; }
#pragma unroll
                for (int e = 0; e < 8; ++e) lg[e] = 0.f;
#pragma unroll
                for (int jj = 0; jj < 2; ++jj) { float v[8]; unpack8(cur4[jj], v);
                    if (MOE8_GU && !MOE8_DN) { u32x2 w8; w8.x = pk4_fp8(v[0], v[1], v[2], v[3]); w8.y = pk4_fp8(v[4], v[5], v[6], v[7]); *(u32x2*)(XB8 + (size_t)m * D + 512 * jj + 8 * F.lane) = w8; }
#pragma unroll
                    for (int q = 0; q < 8; ++q) { const float xv = v[q]; s += xv * xv; const LAS f32x4* rw = (const LAS f32x4*)(RW + (((jj * 8 + q) * 64 + F.lane) << 3)); const f32x4 r0 = rw[0], r1 = rw[1];
                        lg[0] += xv * r0.x; lg[1] += xv * r0.y; lg[2] += xv * r0.z; lg[3] += xv * r0.w; lg[4] += xv * r1.x; lg[5] += xv * r1.y; lg[6] += xv * r1.z; lg[7] += xv * r1.w; } }
                s = wave_sum(s);
#pragma unroll
                for (int e = 0; e < 8; ++e) lg[e] = wave_sum(lg[e]);
                const float rs = 1.0f / sqrtf(s * (1.0f / D) + RMS_EPS);
                if (MOE8_GU && MOE8_DN) {
#pragma unroll
                    for (int jj = 0; jj < 2; ++jj) { float v[8]; unpack8(cur4[jj], v); u32x2 w8; w8.x = pk4_fp8(v[0] * rs, v[1] * rs, v[2] * rs, v[3] * rs); w8.y = pk4_fp8(v[4] * rs, v[5] * rs, v[6] * rs, v[7] * rs);
                        *(u32x2*)(XB8 + (size_t)m * D + 512 * jj + 8 * F.lane) = w8; } }
                if (F.lane == 0) {
                    int i1 = 0; float v1 = lg[0];
#pragma unroll
                    for (int e = 1; e < 8; ++e) if (lg[e] > v1) { v1 = lg[e]; i1 = e; }
                    int i2 = -1; float v2 = -3.0e38f;
#pragma unroll
                    for (int e = 0; e < 8; ++e) if (e != i1 && lg[e] > v2) { v2 = lg[e]; i2 = e; }
                    if (i2 < 0) { i2 = (i1 + 1) & 7; v2 = v1; }
                    const float g1 = 1.0f / (1.0f + __expf((v2 - v1) * rs)), g2 = 1.0f - g1;
                    tok_e[2 * m] = i1; tok_e[2 * m + 1] = i2; tok_g[2 * m] = g1; tok_g[2 * m + 1] = g2; rs_moe[m] = rs;
                    __hip_atomic_fetch_add(&cnt[i1], 1, __ATOMIC_RELAXED, __HIP_MEMORY_SCOPE_WORKGROUP); __hip_atomic_fetch_add(&cnt[8 + i2], 1, __ATOMIC_RELAXED, __HIP_MEMORY_SCOPE_WORKGROUP);
                } }
            __syncthreads();
            if (F.tid < 16) bcnt[vb * 16 + F.tid] = cnt[F.tid];
            __syncthreads();
        }
        if (rep == 0) hnd_arrive((unsigned*)(ctl + CW_HND + 128));
        int itb = 0;
        for (int e = 0; e < NE; ++e) {
            if (MOE8_GU) { convert_matrix_fp8(F, args.in[I_MOE_WG] + (size_t)e * D * FFE, D, FFE, MWgu8 + (size_t)e * 2 * FFE * D, 1, gain, MOE8_WSCALE_GU * (MOE8_DN ? -1.44269504f : 1.0f), itb);
                           convert_matrix_fp8(F, args.in[I_MOE_WU] + (size_t)e * D * FFE, D, FFE, MWgu8 + (size_t)e * 2 * FFE * D, 2, gain, MOE8_WSCALE_GU, itb); }
            else { convert_matrix(F, args.in[I_MOE_WG] + (size_t)e * D * FFE, D, FFE, MWgu + (size_t)e * 2 * FFE * D, 1, gain, 0, itb);
                   convert_matrix(F, args.in[I_MOE_WU] + (size_t)e * D * FFE, D, FFE, MWgu + (size_t)e * 2 * FFE * D, 2, gain, 0, itb); }
            if (MOE8_DN) convert_matrix_fp8(F, args.in[I_MOE_WD] + (size_t)e * FFE * D, FFE, D, MWd8 + (size_t)e * D * FFE, 0, nullptr, MOE8_WSCALE_DN, itb);
            else convert_matrix(F, args.in[I_MOE_WD] + (size_t)e * FFE * D, FFE, D, MWd + (size_t)e * D * FFE, 0, nullptr, 0, itb);
        }
    }
    if (IN(PH_CV) && IN(PH_R2)) hnd_wait((unsigned*)(ctl + CW_HND + 128), (unsigned)F.G, bar.bar);

    if (IN(PH_R2)) {
        LAS int* tot = (LAS int*)F.lds;
        LAS int* bc = tot + 64;
        for (int vb = blockIdx.x; vb < 256; vb += F.G) {
            for (int i = F.tid; i < 256 * 16; i += 512) bc[i] = bcnt[i];
            __syncthreads();
            if (F.tid < 16) { int t = 0, mine = 0; for (int b2 = 0; b2 < 256; ++b2) { const int c = bc[b2 * 16 + F.tid]; if (b2 < vb) mine += c; t += c; } tot[F.tid] = t; tot[32 + F.tid] = mine; }
            __syncthreads();
            if (F.tid < 2) { int ps = 0; for (int e = 0; e < 8; ++e) { tot[16 + F.tid * 8 + e] = ps; ps += (tot[F.tid * 8 + e] + 255) / 256; }
                if (vb == 0) { panel[F.tid * 160] = ps; for (int e = 0; e < 8; ++e) { const int np = (tot[F.tid * 8 + e] + 255) / 256; for (int q = 0; q < np; ++q) panel[F.tid * 160 + 16 + tot[16 + F.tid * 8 + e] + q] = e; } } }
            int e01[2] = {0, 0}; float g01[2] = {0.f, 0.f}; float rsv = 0.f; const int m = vb * 128 + F.tid;
            if (F.tid < 128) { e01[0] = tok_e[2 * m]; e01[1] = tok_e[2 * m + 1]; g01[0] = tok_g[2 * m]; g01[1] = tok_g[2 * m + 1]; rsv = rs_moe[m]; }
            int rank[2] = {0, 0};
            if (F.wave < 2) {
#pragma unroll
                for (int set = 0; set < 2; ++set)
#pragma unroll
                    for (int e = 0; e < 8; ++e) { const unsigned long long mk = __ballot(e01[set] == e); if (e01[set] == e) rank[set] = __popcll(mk & ((1ull << F.lane) - 1ull));
                        if (F.wave == 0 && F.lane == 0) tot[48 + set * 8 + e] = __popcll(mk); } }
            __syncthreads();
            if (F.tid < 128) {
#pragma unroll
                for (int set = 0; set < 2; ++set) { const int key = set * 8 + e01[set]; const int slot = tot[16 + key] * 256 + tot[32 + key] + rank[set] + (F.wave == 1 ? tot[48 + key] : 0);
                    row_tok[set * MAXPAN * 256 + slot] = m; row_gate[set * MAXPAN * 256 + slot] = g01[set]; row_rs[set * MAXPAN * 256 + slot] = rsv; } }
            __syncthreads();
        }
    }
    SEAM(PH_R2);

#define MOE_SET(SET, PHGU, PHDN) \
    if (IN(PHGU)) for (int rep = 0; rep < REP_GU; ++rep) { const int np = __builtin_amdgcn_readfirstlane(panel[(SET) * 160]); pg8::MoeSched<true> S; \
        if (MOE8_GU) { S.init(XB8, MWgu8, np, 2 * FFE, D, MOE_PEXP(SET) + 16, row_tok + (SET) * MAXPAN * 256, F.G, (int)blockIdx.x); \
            if (MOE8_DN) { pg8::EpiSwigluMoe8 E{MH8, FFE}; pg8::gemm_phase<pg8::EpiSwigluMoe8, pg8::MoeSched<true>, true>(F.lds, D, S, E); } \
            else { pg8::EpiSwigluMoe E{MH, FFE, rs_moe, row_tok + (SET) * MAXPAN * 256, 1.0f / MOE8_WSCALE_GU}; pg8::gemm_phase<pg8::EpiSwigluMoe, pg8::MoeSched<true>, true>(F.lds, D, S, E); } } \
        else { S.init(XB, MWgu, np, 2 * FFE, 2 * D, MOE_PEXP(SET) + 16, row_tok + (SET) * MAXPAN * 256, F.G, (int)blockIdx.x); \
            pg8::EpiSwigluMoe E{MH, FFE, rs_moe, row_tok + (SET) * MAXPAN * 256, 1.0f}; pg8::gemm_phase(F.lds, 2 * D, S, E); } } \
    SEAM(PHGU); \
    if (IN(PHDN)) { const int np = __builtin_amdgcn_readfirstlane(panel[(SET) * 160]); pg8::MoeSched<false> S; \
        if (MOE8_DN) { S.init(MH8, MWd8, np, D, FFE, MOE_PEXP(SET) + 16, row_tok + (SET) * MAXPAN * 256, F.G, (int)blockIdx.x); \
            pg8::EpiMoeDown E{XB, row_tok + (SET) * MAXPAN * 256, row_gate + (SET) * MAXPAN * 256, 1.0f / MOE8_WSCALE_DN, (LAS int*)(F.lds + RING_BYTES + 4096)}; pg8::gemm_phase<pg8::EpiMoeDown, pg8::MoeSched<false>, true>(F.lds, FFE, S, E); } \
        else { S.init(MH, MWd, np, D, 2 * FFE, MOE_PEXP(SET) + 16, row_tok + (SET) * MAXPAN * 256, F.G, (int)blockIdx.x); \
            pg8::EpiMoeDown E{XB, row_tok + (SET) * MAXPAN * 256, row_gate + (SET) * MAXPAN * 256, 1.0f, (LAS int*)(F.lds + RING_BYTES + 4096)}; pg8::gemm_phase(F.lds, 2 * FFE, S, E); } } \
    SEAM(PHDN);
#if MOE8_GU && MOE8_DN
#define MOE_PEXP(SET) ((const LAS int*)(F.lds + RING_BYTES + (SET) * 1024))
#define MOE_LOAD_PEXP() do { if (F.tid < 2 * 160) ((LAS int*)(F.lds + RING_BYTES))[(F.tid / 160) * 256 + (F.tid % 160)] = panel[F.tid]; __syncthreads(); } while (0)
#define MOE_GU8(SET, HBUF, P0, NP, SKX, SKR) do { pg8::MoeSched<true> S; \
        S.init(XB8, MWgu8, (NP), 2 * FFE, D, MOE_PEXP(SET) + 16, row_tok + (SET) * MAXPAN * 256, F.G, (int)blockIdx.x); S.p0 = (P0); S.T.sx = (SKX); S.T.sr = (SKR); \
        pg8::EpiSwigluMoe8 E{HBUF, FFE}; pg8::gemm_phase<pg8::EpiSwigluMoe8, pg8::MoeSched<true>, true>(F.lds, D, S, E); } while (0)
#define MOE_DN8(SET, HBUF, P0, NP) do { pg8::MoeSched<false> S; \
        S.init(HBUF, MWd8, (NP), D, FFE, MOE_PEXP(SET) + 16, row_tok + (SET) * MAXPAN * 256, F.G, (int)blockIdx.x); S.p0 = (P0); \
        pg8::EpiMoeDown E{XB, row_tok + (SET) * MAXPAN * 256, row_gate + (SET) * MAXPAN * 256, 1.0f / MOE8_WSCALE_DN, (LAS int*)(F.lds + RING_BYTES + 4096)}; pg8::gemm_phase<pg8::EpiMoeDown, pg8::MoeSched<false>, true>(F.lds, FFE, S, E); } while (0)
    const int npA = __builtin_amdgcn_readfirstlane(panel[0]), npB = __builtin_amdgcn_readfirstlane(panel[160]);
    const int nB2 = npB < 64 ? npB : 64, nB1 = npB - nB2;
    if (IN(PH_GU_A)) { MOE_LOAD_PEXP(); MOE_GU8(0, MH8, 0, npA, 0, 0); }
    if (PROBE_DUP == 3 && IN(PH_GU_A)) MOE_GU8(0, MH8, 0, npA, 0, 0);
    SEAM(PH_GU_A);
    if (IN(PH_DN_A)) { MOE_LOAD_PEXP(); MOE_DN8(0, MH8, 0, npA);
        const int sx = (npA * (D / 256)) % F.G;
        if (nB1 > 0) MOE_GU8(1, MH8b, 0, nB1, sx, sx ? 3 : 0); }
    SEAM(PH_DN_A);
    if (IN(PH_GU_B)) { MOE_LOAD_PEXP(); if (nB1 > 0) MOE_DN8(1, MH8b, 0, nB1);
        const int sx = (nB1 * (D / 256)) % F.G;
        MOE_GU8(1, MH8b, nB1, nB2, sx, sx ? 3 : 0); }
    SEAM(PH_GU_B);
    if (IN(PH_DN_B)) { MOE_LOAD_PEXP(); MOE_DN8(1, MH8b, nB1, nB2); }
    SEAM(PH_DN_B);
#else
    MOE_SET(0, PH_GU_A, PH_DN_A)
    MOE_SET(1, PH_GU_B, PH_DN_B)
#endif

    if (IN(PH_FIN)) for (int rep = 0; rep < (PROBE_DUP == 7 ? 2 : 1); ++rep) {
        const float* gf = args.in[I_NORM_FINAL];
        f32x4 gq[2][2];
#pragma unroll
        for (int jj = 0; jj < 2; ++jj) { gq[jj][0] = *((const f32x4*)(gf + 512 * jj + 8 * F.lane)); gq[jj][1] = *((const f32x4*)(gf + 512 * jj + 8 * F.lane + 4)); }
        for (int m = F.gw; m < NTOK; m += F.NGW) {
            const GAS u32x4* xr = (const GAS u32x4*)(XB + (size_t)m * D) + F.lane; float v[2][8]; float s = 0.f;
#pragma unroll
            for (int jj = 0; jj < 2; ++jj) { unpack8(xr[64 * jj], v[jj]);
#pragma unroll
                for (int q = 0; q < 8; ++q) s += v[jj][q] * v[jj][q]; }
            const float rs = 1.0f / sqrtf(wave_sum(s) * (1.0f / D) + RMS_EPS);
#pragma unroll
            for (int jj = 0; jj < 2; ++jj) { const f32x4 g0 = gq[jj][0], g1 = gq[jj][1];
                GAS f32x4* o = (GAS f32x4*)(args.out + (size_t)m * D + 512 * jj + 8 * F.lane);
                o[0] = (f32x4){v[jj][0] * rs * g0.x, v[jj][1] * rs * g0.y, v[jj][2] * rs * g0.z, v[jj][3] * rs * g0.w}; o[1] = (f32x4){v[jj][4] * rs * g1.x, v[jj][5] * rs * g1.y, v[jj][6] * rs * g1.z, v[jj][7] * rs * g1.w}; }
        }
    }
#undef IN
#undef SEAM
}

extern "C" void kernel_launch(void* const* d_in, const int* in_sizes, int n_in, void* d_out, int out_size, void* d_ws, size_t ws_size, hipStream_t stream) {
    static int grid = 0;
    if (grid == 0) {
        if (n_in != NIN || in_sizes[0] != NTOK * D || out_size != NTOK * D || ws_size < WS_END) {
            fprintf(stderr, "kernel_launch: unexpected shapes: n_in %d in0 %d out %d ws %zu (need %zu); nothing launched\n", n_in, n_in > 0 ? in_sizes[0] : -1, out_size, ws_size, (size_t)WS_END); grid = -1; return; }
        int dev = 0, cus = 0, per_cu = 0;
        if (hipGetDevice(&dev) != hipSuccess || hipDeviceGetAttribute(&cus, hipDeviceAttributeMultiprocessorCount, dev) != hipSuccess) { grid = -1; return; }
        if (hipFuncSetAttribute((const void*)fwd, hipFuncAttributeMaxDynamicSharedMemorySize, LDS_BYTES) != hipSuccess) { fprintf(stderr, "kernel_launch: hipFuncSetAttribute failed\n"); grid = -1; return; }
        if (hipOccupancyMaxActiveBlocksPerMultiprocessor(&per_cu, (const void*)fwd, 512, LDS_BYTES) != hipSuccess || per_cu < 1) { fprintf(stderr, "kernel_launch: occupancy query says %d\n", per_cu); }
        (void)hipGetLastError();
        grid = cus;
    }
    if (grid < 0) return;
    if (hipMemsetAsync((char*)d_ws + WS_CTL, 0, CTL_ZERO_BYTES, stream) != hipSuccess) return;
    Args a{};
    for (int i = 0; i < NIN; ++i) a.in[i] = (const float*)d_in[i];
    a.out = (float*)d_out; a.ws = (unsigned char*)d_ws;
#if MK_PER_PHASE
    for (int ph = 0; ph < PH_COUNT; ++ph) { a.ph_lo = ph; a.ph_hi = ph + 1; hipLaunchKernelGGL(fwd, dim3(grid), dim3(512), LDS_BYTES, stream, a); }
#else
    a.ph_lo = 0; a.ph_hi = PH_COUNT; hipLaunchKernelGGL(fwd, dim3(grid), dim3(512), LDS_BYTES, stream, a);
#endif
}
```

```cpp
#include <hip/hip_runtime.h>
#include <cstdio>
#include <cstdint>

#ifndef MK_PER_PHASE
#define MK_PER_PHASE 0
#endif

#ifndef REP_M1
#define REP_M1 1
#endif
#ifndef REP_M2
#define REP_M2 1
#endif
#ifndef REP_M3
#define REP_M3 1
#endif
#ifndef REP_GU
#define REP_GU 1
#endif
#ifndef REP_CH
#define REP_CH 1
#endif
#ifndef PROBE_STAGE
#define PROBE_STAGE 0
#endif
#ifndef REP_CV
#define REP_CV 1
#endif
#ifndef REP_EPI
#define REP_EPI 1
#endif
#ifndef REP_G3
#define REP_G3 1
#endif
#ifndef PROBE_DUP
#define PROBE_DUP 0
#endif
#ifndef STAGGER_TICKS
#define STAGGER_TICKS 0
#endif
#ifndef DEFER_CONVERT
#define DEFER_CONVERT 1
#endif
#ifndef DBG_VAR
#define DBG_VAR 0
#endif
#ifndef MOE8_GU
#define MOE8_GU 1
#endif
#ifndef MOE8_DN
#define MOE8_DN 1
#endif
#ifndef MIX_MODE
#define MIX_MODE 0
#endif
#define GAS __attribute__((address_space(1)))
#define LAS __attribute__((address_space(3)))
typedef unsigned short bf16;
typedef unsigned short bf16_t;
typedef short bf16x8 __attribute__((ext_vector_type(8)));
typedef float f32x4 __attribute__((ext_vector_type(4)));
typedef float f32x2 __attribute__((ext_vector_type(2)));
typedef unsigned u32x4 __attribute__((ext_vector_type(4)));
typedef unsigned u32x2 __attribute__((ext_vector_type(2)));
typedef GAS unsigned gu32;

constexpr int NTOK = 32768, SEQ = 4096, NB = 8, D = 1024, INW = 2816, FF = 2816, FFE = 3584, NE = 8;
constexpr int GMW = 512, RWW = 512, NH = 8, HD = 64, GCH = 128;
constexpr float RMS_EPS = 1e-6f, LN_EPS = 1e-5f, GN_EPS = 64e-5f;
constexpr int MAXPAN = 136;

constexpr size_t MiB = 1u << 20;
constexpr size_t WS_CTL = 0, CTL_ZERO_BYTES = 2 * MiB;
constexpr size_t WS_WIN = 2 * MiB;
constexpr size_t WS_WOUT = 13 * MiB;
constexpr size_t WS_WGU = 17 * MiB;
constexpr size_t WS_WD = 28 * MiB;
constexpr size_t WS_MISC = 34 * MiB;
constexpr size_t WS_SMALLW = 36 * MiB;
constexpr size_t SW_WUP = 0, SW_AUP = 128 * 1024, SW_GUP = 256 * 1024, SW_WS = 512 * 1024;
constexpr size_t WS_XB = 38 * MiB;
constexpr size_t WS_R = 102 * MiB;
constexpr size_t WS_P = WS_R;
constexpr size_t WS_Y = WS_R + 176 * MiB;
constexpr size_t WS_SCR = WS_R + 240 * MiB;
constexpr size_t WS_MOEW_GU = WS_R;
constexpr size_t WS_MOEW_D = WS_R + 112 * MiB;
constexpr size_t WS_MOEH = WS_R + 168 * MiB;
constexpr size_t WS_MOEW8_GU = WS_R;
constexpr size_t WS_MOEW8_D = WS_R + 56 * MiB;
constexpr size_t WS_XB8 = WS_R + 112 * MiB;
constexpr float MOE8_WSCALE_GU = 64.f, MOE8_WSCALE_DN = 128.f;
constexpr size_t WS_SSQP = WS_R + 400 * MiB;
constexpr size_t WS_END = WS_R + 408 * MiB;
static_assert(WS_MOEH + (size_t)MAXPAN * 256 * FFE * 2 <= WS_END, "moe hidden fits");
static_assert(WS_WIN + (size_t)2 * INW * D * 2 <= WS_WOUT && WS_WGU + (size_t)2 * FF * D * 2 <= WS_WD && WS_WD + (size_t)D * FF * 2 <= WS_MISC, "weights fit");
constexpr int CW_TMO = 0;
constexpr int CW_BAR = 4096;
constexpr int CW_HND = 8192;
constexpr int CW_SSQ = 65536;
static_assert((CW_SSQ + 4 * NTOK) * 4 <= (int)CTL_ZERO_BYTES, "ctl fits");
constexpr size_t MS_TOKE = 0;
constexpr size_t MS_TOKG = 256 * 1024;
constexpr size_t MS_RS = 512 * 1024;
constexpr size_t MS_BCNT = 640 * 1024;
constexpr size_t MS_ROWTOK = 704 * 1024;
constexpr size_t MS_ROWGATE = 1024 * 1024;
constexpr size_t MS_PANEL = 1344 * 1024;
constexpr size_t MS_ROWRS = 1408 * 1024;
static_assert(MS_ROWTOK + 2 * MAXPAN * 256 * 4 <= MS_ROWGATE && MS_ROWGATE + 2 * MAXPAN * 256 * 4 <= MS_PANEL && MS_PANEL + 2 * 160 * 4 <= MS_ROWRS && MS_ROWRS + 2 * MAXPAN * 256 * 4 <= 2 * MiB, "misc fits");

constexpr int RING_BYTES = 131072;
constexpr int LDS_BYTES = 147456;
constexpr int MISC_OFF = LDS_BYTES - 128;

#define LDS_WAIT() asm volatile("s_waitcnt lgkmcnt(0)" ::: "memory")
#define VM_WAIT() asm volatile("s_waitcnt vmcnt(0)" ::: "memory")
#define RLX_AGENT __ATOMIC_RELAXED, __HIP_MEMORY_SCOPE_AGENT
#define LDS_BARRIER() do { asm volatile("s_waitcnt lgkmcnt(0)" ::: "memory"); __builtin_amdgcn_s_barrier(); asm volatile("" ::: "memory"); } while (0)

__device__ __forceinline__ unsigned f2bf(float f) { unsigned u = __builtin_bit_cast(unsigned, f); return (u + 0x7fffu + ((u >> 16) & 1u)) >> 16; }
__device__ __forceinline__ unsigned pk2(float lo, float hi) { return f2bf(lo) | (f2bf(hi) << 16); }
__device__ __forceinline__ float bf2f(bf16 b) { return __builtin_bit_cast(float, (unsigned)b << 16); }
__device__ __forceinline__ unsigned cvt_pk_bf16(float lo, float hi) { unsigned r; asm volatile("v_cvt_pk_bf16_f32 %0, %1, %2" : "=v"(r) : "v"(lo), "v"(hi)); return r; }
__device__ __forceinline__ unsigned pk4_fp8(float a, float b, float c, float d) { int v = __builtin_amdgcn_cvt_pk_fp8_f32(a, b, 0, false); v = __builtin_amdgcn_cvt_pk_fp8_f32(c, d, v, true); return (unsigned)v; }
__device__ __forceinline__ float wave_sum(float v) {
#pragma unroll
    for (int o = 1; o < 64; o <<= 1) v += __shfl_xor(v, o);
    return v;
}
__device__ __forceinline__ float gelu_erf(float v) { return 0.5f * v * (1.0f + erff(v * 0.70710678f)); }
__device__ __forceinline__ float sigmoidf_(float v) { return 1.0f / (1.0f + __expf(-v)); }
__device__ __forceinline__ float silu_f(float v) { return v * __builtin_amdgcn_rcpf(1.0f + __expf(-v)); }

__device__ __forceinline__ f32x2 swiglu2(f32x2 g, f32x2 u, float rs) {
    const float c1 = rs * (-1.44269504f), ic2 = rs != 0.f ? __builtin_amdgcn_rcpf(rs * rs) : 1.0e30f;
    const f32x2 a = g * c1, p = g * u;
    f32x2 e; e.x = __builtin_amdgcn_exp2f(a.x); e.y = __builtin_amdgcn_exp2f(a.y);
    const f32x2 d = e * ic2 + ic2; f32x2 r; r.x = __builtin_amdgcn_rcpf(d.x); r.y = __builtin_amdgcn_rcpf(d.y);
    return p * r;
}
namespace pg8 {
constexpr int BM = 256, BK = 64, HALF = 128, HTB = HALF * BK * 2, STAGE_BYTES = 8 * HTB, NXCD = 8, WGM = 8;
__host__ __device__ __forceinline__ int lds_byte(int r, int c) { const int st = (r >> 4) * 2 + (c >> 5), rr = r & 15, cc = c & 31, ob = rr * 64 + cc * 2; return st * 1024 + (ob ^ (((ob >> 9) & 1) << 5)); }
__host__ __device__ __forceinline__ void stage_rc(int b, int& R, int& C) { const int st = b / 1024, sb = b % 1024, swz = sb ^ (((sb >> 9) & 1) << 5); R = (st >> 1) * 16 + swz / 64; C = (st & 1) * 32 + (swz % 64) / 2; }
__host__ __device__ __forceinline__ int perm32(int rho) { const int n = rho >> 4, i = rho & 15; return 8 * (i >> 2) + 4 * n + (i & 3); }

struct Unit { int pm, pn, aux; };

struct TileOrder {
    int nM, nN, nwg, G, c, sx, sr;
    __device__ void init(int nM_, int nN_, int G_, int c_) { nM = nM_; nN = nN_; nwg = nM * nN; G = G_; c = c_; sx = 0; sr = 0; }
    __device__ bool tile(int i, int& pm, int& pn) const {
        long L;
        if (sx == 0) L = (long)i * G + c;
        else if (c < sx) L = (long)sr * (G - sx) + (long)i * G + c;
        else L = i < sr ? (long)i * (G - sx) + (c - sx) : (long)sr * (G - sx) + (long)(i - sr) * G + c;
        if (L >= nwg) return false;
        int wgid = (int)L; { const int q = nwg / NXCD, r = nwg % NXCD, xcd = wgid % NXCD, off = wgid / NXCD; wgid = (xcd < r ? xcd * (q + 1) : r * (q + 1) + (xcd - r) * q) + off; }
        const int nig = WGM * nN, gid = wgid / nig, fm = gid * WGM, gsz = (nM - fm) < WGM ? (nM - fm) : WGM;
        pm = fm + ((wgid % nig) % gsz); pn = (wgid % nig) / gsz; return true;
    }
};
struct DenseSched {
    static constexpr bool GATHER = false;
    TileOrder T; const char* A; const char* Bt; size_t tstep;
    __device__ void init(const void* A_, const void* Bt_, int M, int N, int KB  , int G, int c) { T.init(M / BM, N / BM, G, c); A = (const char*)A_; Bt = (const char*)Bt_; tstep = (size_t)BM * KB; }
    __device__ __forceinline__ bool next(int i, Unit& u) const { u.aux = 0; return T.tile(i, u.pm, u.pn); }
    __device__ __forceinline__ const char* a_ptr(const Unit& u) const { return A + (size_t)u.pm * tstep; }
    __device__ __forceinline__ const char* b_ptr(const Unit& u) const { return Bt + (size_t)u.pn * tstep; }
    __device__ __forceinline__ void gather(const Unit&, int, int, int, int, int, unsigned (&)[2][2]) const {}
};
template <bool GATHER_> struct MoeSched {
    static constexpr bool GATHER = GATHER_;
    TileOrder T; const char* A; const char* Bt; size_t a_tstep, b_tstep, b_estep; const LAS int* pexp; const int* row_tok; int KB; int p0 = 0;
    __device__ void init(const void* A_, const void* Bt_, int npanels, int N, int KB_  , const LAS int* pexp_, const int* row_tok_, int G, int c) {
        T.init(npanels, N / BM, G, c); A = (const char*)A_; Bt = (const char*)Bt_; KB = KB_; a_tstep = (size_t)BM * KB_; b_tstep = (size_t)BM * KB_; b_estep = (size_t)N * KB_; pexp = pexp_; row_tok = row_tok_; }
    __device__ __forceinline__ bool next(int i, Unit& u) const { if (!T.tile(i, u.pm, u.pn)) return false; u.pm += p0; u.aux = __builtin_amdgcn_readfirstlane(pexp[u.pm]); return true; }
    __device__ __forceinline__ const char* a_ptr(const Unit& u) const { return GATHER ? A : A + (size_t)u.pm * a_tstep; }
    __device__ __forceinline__ const char* b_ptr(const Unit& u) const { return Bt + (size_t)u.aux * b_estep + (size_t)u.pn * b_tstep; }
    __device__ __forceinline__ void gather(const Unit& u, int R0, int R1, int C0, int C1, int, unsigned (&v)[2][2]) const {
#pragma unroll
        for (int h = 0; h < 2; ++h) { int t0 = row_tok[u.pm * BM + h * HALF + R0], t1 = row_tok[u.pm * BM + h * HALF + R1]; t0 = t0 < 0 ? 0 : t0; t1 = t1 < 0 ? 0 : t1;
            v[h][0] = (unsigned)(t0 * KB + C0 * 2); v[h][1] = (unsigned)(t1 * KB + C1 * 2); }
    }
};

typedef int v4i_t __attribute__((ext_vector_type(4)));
typedef int v8i_t __attribute__((ext_vector_type(8)));
typedef short s16x16_t __attribute__((ext_vector_type(16)));
__device__ __forceinline__ v8i_t cat8(const bf16x8 lo, const bf16x8 hi) { const v4i_t a = __builtin_bit_cast(v4i_t, lo), b = __builtin_bit_cast(v4i_t, hi); return __builtin_shufflevector(a, b, 0, 1, 2, 3, 4, 5, 6, 7); }
template <class Epi, class Sched, bool FP8 = false>
__device__ __forceinline__ void gemm_phase(LAS unsigned char* lds, const int KB, const Sched& S, const Epi& E) {
    constexpr bool GATHER = Sched::GATHER;
    const int tid = threadIdx.x, wid = __builtin_amdgcn_readfirstlane(tid >> 6), lane = tid & 63, wr = wid >> 2, wc = wid & 3, fr = lane & 15, fq = lane >> 4;
    const int nt = KB / 128;
    unsigned voffA[2], voffB[2], voffBa[2][2]; int sR[2], sC[2];
#pragma unroll
    for (int i = 0; i < 2; ++i) { int R, C; stage_rc(tid * 16 + i * 8192, R, C); const int Rb = Epi::PERM ? ((R & ~31) + perm32(R & 31)) : R; sR[i] = R; sC[i] = C;
        voffA[i] = (unsigned)(R * KB + C * 2); voffB[i] = (unsigned)(Rb * KB + C * 2);
        voffBa[0][i] = (unsigned)((64 * (R >> 5) + perm32(R & 31)) * KB + C * 2); voffBa[1][i] = (unsigned)((64 * (R >> 5) + 32 + perm32(R & 31)) * KB + C * 2); }
    const size_t kstep = (size_t)(BK * 2);
    const size_t hstep = (size_t)HALF * KB;
    const unsigned ldsw = (unsigned)wid * 1024u;
    const int aoff = lds_byte(wr * 64 + fr, fq * 8), boff = lds_byte(wc * 32 + fr, fq * 8);
    const int aoff8 = lds_byte(wr * 64 + fr, (fq >> 1) * 32 + (fq & 1) * 16) & ~31, boff8 = lds_byte(wc * 32 + fr, (fq >> 1) * 32 + (fq & 1) * 16) & ~31;
#define PG8_SA(b, h) (((b) * 2 + (h)) * HTB)
#define PG8_SB(b, h) ((4 + (b) * 2 + (h)) * HTB)
#define PG8_STAGE(bufoff, gbase, voff) do { _Pragma("unroll") for (int _i = 0; _i < 2; ++_i) \
        __builtin_amdgcn_global_load_lds((const unsigned*)((const char*)(gbase) + (voff)[_i]), (LAS unsigned*)(lds + (bufoff) + ldsw + _i * 8192), 16, 0, 0); } while (0)
#define PG8_STAGE_B(bufoff, kptr, half) do { if constexpr (Epi::ADJ) { PG8_STAGE(bufoff, kptr, voffBa[half]); } else { PG8_STAGE(bufoff, (kptr) + (half) * hstep, voffB); } } while (0)
#define PG8_STAGE_A(bufoff, kptr, half, VG) do { if constexpr (GATHER) { PG8_STAGE(bufoff, kptr, (VG)[half]); } else { PG8_STAGE(bufoff, (kptr) + (half) * hstep, voffA); } } while (0)
#define PG8_LDA(dst, b, h) do { if constexpr (FP8) { _Pragma("unroll") for (int m = 0; m < 4; ++m) dst##8[m] = cat8(*(const LAS bf16x8*)(lds + PG8_SA(b, h) + aoff8 + m * 2048), *(const LAS bf16x8*)(lds + PG8_SA(b, h) + aoff8 + m * 2048 + 16)); } \
        else { _Pragma("unroll") for (int m = 0; m < 4; ++m) _Pragma("unroll") for (int k = 0; k < 2; ++k) dst[m][k] = *(const LAS bf16x8*)(lds + PG8_SA(b, h) + aoff + m * 2048 + k * 1024); } } while (0)
#define PG8_LDB(dst, b, h) do { if constexpr (FP8) { _Pragma("unroll") for (int n = 0; n < 2; ++n) dst##8[n] = cat8(*(const LAS bf16x8*)(lds + PG8_SB(b, h) + boff8 + n * 2048), *(const LAS bf16x8*)(lds + PG8_SB(b, h) + boff8 + n * 2048 + 16)); } \
        else { _Pragma("unroll") for (int n = 0; n < 2; ++n) _Pragma("unroll") for (int k = 0; k < 2; ++k) dst[n][k] = *(const LAS bf16x8*)(lds + PG8_SB(b, h) + boff + n * 2048 + k * 1024); } } while (0)
#define PG8_MMA(ai, bj, At, Bt) do { __builtin_amdgcn_s_setprio(1); if constexpr (FP8) { _Pragma("unroll") for (int m = 0; m < 4; ++m) _Pragma("unroll") for (int n = 0; n < 2; ++n) \
        asm volatile("v_mfma_scale_f32_16x16x128_f8f6f4 %0, %1, %2, %0, %3, %4 op_sel_hi:[0,0,0]" : "+v"(acc[ai][bj][m][n]) : "v"(Bt##8[n]), "v"(At##8[m]), "v"(sc8w), "v"(sc8)); } \
        else { _Pragma("unroll") for (int k = 0; k < 2; ++k) _Pragma("unroll") for (int m = 0; m < 4; ++m) _Pragma("unroll") for (int n = 0; n < 2; ++n) \
        asm volatile("v_mfma_f32_16x16x32_bf16 %0, %1, %2, %0" : "+v"(acc[ai][bj][m][n]) : "v"(Bt[n][k]), "v"(At[m][k])); } __builtin_amdgcn_s_setprio(0); } while (0)
#define PG8_MMA0(ai, bj, At, Bt) do { __builtin_amdgcn_s_setprio(1); if constexpr (FP8) { _Pragma("unroll") for (int m = 0; m < 4; ++m) _Pragma("unroll") for (int n = 0; n < 2; ++n) \
        asm volatile("v_mfma_scale_f32_16x16x128_f8f6f4 %0, %1, %2, 0, %3, %4 op_sel_hi:[0,0,0]" : "=v"(acc[ai][bj][m][n]) : "v"(Bt##8[n]), "v"(At##8[m]), "v"(sc8w), "v"(sc8)); } \
        else { _Pragma("unroll") for (int m = 0; m < 4; ++m) _Pragma("unroll") for (int n = 0; n < 2; ++n) \
        asm volatile("v_mfma_f32_16x16x32_bf16 %0, %1, %2, 0" : "=v"(acc[ai][bj][m][n]) : "v"(Bt[n][0]), "v"(At[m][0])); \
        _Pragma("unroll") for (int m = 0; m < 4; ++m) _Pragma("unroll") for (int n = 0; n < 2; ++n) \
        asm volatile("v_mfma_f32_16x16x32_bf16 %0, %1, %2, %0" : "+v"(acc[ai][bj][m][n]) : "v"(Bt[n][1]), "v"(At[m][1])); } __builtin_amdgcn_s_setprio(0); } while (0)
#define PG8_WAIT_V(n) asm volatile("s_waitcnt vmcnt(" #n ")" ::: "memory")
#define PG8_WAIT_L(n) asm volatile("s_waitcnt lgkmcnt(" #n ")" ::: "memory")
#define PG8_BAR __builtin_amdgcn_s_barrier()
#define PG8_SCHED __builtin_amdgcn_sched_barrier(0)
    Unit cur, nxt; int ui = 0;
    if (!S.next(0, cur)) return;
    f32x4 acc[2][2][4][2];
#pragma unroll
    for (int a = 0; a < 2; ++a)
#pragma unroll
        for (int b = 0; b < 2; ++b)
#pragma unroll
            for (int m = 0; m < 4; ++m)
#pragma unroll
                for (int n = 0; n < 2; ++n) asm volatile("" : "=v"(acc[a][b][m][n]));
    bf16x8 At[4][2], B0[2][2], B1[2][2]; v8i_t At8[4], B08[2], B18[2]; const int sc8 = 0x7f7f7f7f; int sc8w = 0x7f7f7f7f; if constexpr (FP8) sc8w = Epi::SCW;
    const char* cA = S.a_ptr(cur); const char* cB = S.b_ptr(cur);
    unsigned vcur[2][2] = {{0u, 0u}, {0u, 0u}}, vnext[2][2] = {{0u, 0u}, {0u, 0u}}, vt2[2][2] = {{0u, 0u}, {0u, 0u}};
    if constexpr (GATHER) S.gather(cur, sR[0], sR[1], sC[0], sC[1], 0, vcur);
    PG8_STAGE_B(PG8_SB(0, 0), cB, 0); PG8_STAGE_B(PG8_SB(0, 1), cB, 1); PG8_STAGE_A(PG8_SA(0, 0), cA, 0, vcur); PG8_STAGE_A(PG8_SA(0, 1), cA, 1, vcur);
    if (wr == 1) PG8_BAR;
    PG8_WAIT_V(2); PG8_BAR;
    PG8_STAGE_B(PG8_SB(1, 0), cB + kstep, 0); PG8_STAGE_A(PG8_SA(1, 0), cA + kstep, 0, vcur); PG8_STAGE_B(PG8_SB(1, 1), cB + kstep, 1);
    PG8_WAIT_V(6); PG8_BAR;
    for (;;) {
        const bool has_next = S.next(ui + 1, nxt);
        const char* nA = has_next ? S.a_ptr(nxt) : cA; const char* nB = has_next ? S.b_ptr(nxt) : cB;
        if constexpr (GATHER) { if (has_next) S.gather(nxt, sR[0], sR[1], sC[0], sC[1], 0, vnext); else {
#pragma unroll
            for (int h = 0; h < 2; ++h) { vnext[h][0] = vcur[h][0]; vnext[h][1] = vcur[h][1]; } } }
#define PG8_KITER(t, MM) do { \
            const bool last = (t == nt - 2); \
            const char* a1 = cA + (size_t)(t + 1) * kstep; \
            const char* a2 = last ? nA : cA + (size_t)(t + 2) * kstep; const char* b2 = last ? nB : cB + (size_t)(t + 2) * kstep; \
            const char* a3 = a2 + kstep; const char* b3 = b2 + kstep; \
            if constexpr (GATHER) { \
            _Pragma("unroll") \
                for (int h = 0; h < 2; ++h) { vt2[h][0] = last ? vnext[h][0] : vcur[h][0]; vt2[h][1] = last ? vnext[h][1] : vcur[h][1]; } } \
            PG8_LDB(B0, 0, 0); PG8_LDB(B1, 0, 1); PG8_SCHED; PG8_LDA(At, 0, 0); PG8_STAGE_A(PG8_SA(1, 1), a1, 1, vcur); \
            PG8_WAIT_V(8); PG8_WAIT_L(0); PG8_BAR; MM(0, 0, At, B0); MM(0, 1, At, B1); PG8_BAR; PG8_SCHED; \
            PG8_LDA(At, 0, 1); PG8_STAGE_B(PG8_SB(0, 0), b2, 0); PG8_STAGE_B(PG8_SB(0, 1), b2, 1); PG8_STAGE_A(PG8_SA(0, 0), a2, 0, vt2); \
            PG8_WAIT_V(8); PG8_WAIT_L(0); PG8_BAR; MM(1, 0, At, B0); MM(1, 1, At, B1); PG8_BAR; PG8_SCHED; \
            PG8_LDB(B0, 1, 0); PG8_LDB(B1, 1, 1); PG8_SCHED; PG8_LDA(At, 1, 0); PG8_STAGE_A(PG8_SA(0, 1), a2, 1, vt2); \
            PG8_WAIT_V(8); PG8_WAIT_L(0); PG8_BAR; PG8_MMA(0, 0, At, B0); PG8_MMA(0, 1, At, B1); PG8_BAR; PG8_SCHED; \
            PG8_LDA(At, 1, 1); PG8_STAGE_B(PG8_SB(1, 0), b3, 0); PG8_STAGE_B(PG8_SB(1, 1), b3, 1); PG8_STAGE_A(PG8_SA(1, 0), a3, 0, vt2); \
            PG8_WAIT_V(8); PG8_WAIT_L(0); PG8_BAR; PG8_MMA(1, 0, At, B0); PG8_MMA(1, 1, At, B1); PG8_BAR; PG8_SCHED; \
        } while (0)
        { const int t = 0; PG8_KITER(t, PG8_MMA0); }
        for (int t = 2; t < nt; t += 2) { PG8_KITER(t, PG8_MMA); }
#undef PG8_KITER
        if (wr == 0) PG8_BAR;
        asm volatile("s_nop 15\n\ts_nop 15" ::: "memory");
        for (int rp_ = 0; rp_ < Epi::REPS; ++rp_) E(acc, cur, wr, wc, fr, fq);
        if (!has_next) break;
        cur = nxt; cA = nA; cB = nB; ++ui;
        if constexpr (GATHER) {
#pragma unroll
            for (int h = 0; h < 2; ++h) { vcur[h][0] = vnext[h][0]; vcur[h][1] = vnext[h][1]; } }
        if (wr == 1) PG8_BAR;
    }
    PG8_WAIT_V(0);
    PG8_BAR;
#undef PG8_SA
#undef PG8_SB
#undef PG8_STAGE
#undef PG8_STAGE_A
#undef PG8_STAGE_B
#undef PG8_LDA
#undef PG8_LDB
#undef PG8_MMA
#undef PG8_MMA0
#undef PG8_WAIT_V
#undef PG8_WAIT_L
#undef PG8_BAR
#undef PG8_SCHED
}

__device__ __forceinline__ void store_lines(unsigned char* rowbase  , size_t pitch, int fr, int fq, const u32x4 w0, const u32x4 w1) {
    const bool lo = fr < 8; const u32x4 snd = lo ? w1 : w0; u32x4 rcv;
    rcv.x = __shfl_xor(snd.x, 8); rcv.y = __shfl_xor(snd.y, 8); rcv.z = __shfl_xor(snd.z, 8); rcv.w = __shfl_xor(snd.w, 8);
    unsigned char* p = rowbase + (size_t)(fr & 7) * pitch + (lo ? 0 : 64) + 16 * fq;
    *(u32x4*)p = lo ? w0 : rcv;
    *(u32x4*)(p + 8 * pitch) = lo ? rcv : w1;
}
template <int NP> __device__ __forceinline__ float row_rs(const float* ssq, int row) {
    float s;
    if constexpr (NP == 1) s = ssq[row];
    else { const f32x4* p = (const f32x4*)(ssq + (size_t)row * 16); const f32x4 a = p[0], b = p[1], c = p[2], d = p[3];
        s = (((a[0] + a[1]) + (a[2] + a[3])) + ((b[0] + b[1]) + (b[2] + b[3]))) + (((c[0] + c[1]) + (c[2] + c[3])) + ((d[0] + d[1]) + (d[2] + d[3]))); }
    return __builtin_amdgcn_rsqf(s * (1.0f / D) + RMS_EPS);
}
__device__ __forceinline__ void panel_rs_to_lds(const float* ssq, int pm, LAS float* rsl) {
    if (threadIdx.x < 256) rsl[threadIdx.x] = row_rs<16>(ssq, pm * 256 + (int)threadIdx.x);
    asm volatile("s_waitcnt lgkmcnt(0)" ::: "memory"); __builtin_amdgcn_s_barrier(); asm volatile("" ::: "memory");
}
template <int NP> struct EpiScaleBf16 {
    static constexpr bool PERM = true; static constexpr bool ADJ = true; static constexpr int REPS = 1;
    bf16_t* O; int ldc; const float* ssq; LAS float* rsl;
    __device__ __forceinline__ void operator()(const f32x4 (&acc)[2][2][4][2], const Unit& u, int wr, int wc, int fr, int fq) const {
        const int rowg = u.pm * BM + wr * 64, colw = u.pn * BM + wc * 64;
        if constexpr (NP == 16) panel_rs_to_lds(ssq, u.pm, rsl);
#pragma unroll
        for (int ai = 0; ai < 2; ++ai)
#pragma unroll
            for (int m = 0; m < 4; ++m) { const int row = rowg + ai * HALF + m * 16 + fr; float rs; if constexpr (NP == 16) rs = rsl[wr * 64 + ai * HALF + m * 16 + fr]; else rs = row_rs<NP>(ssq, row);
                u32x4 w[2];
#pragma unroll
                for (int bj = 0; bj < 2; ++bj) { const f32x4 v0 = acc[ai][bj][m][0] * rs, v1 = acc[ai][bj][m][1] * rs;
                    w[bj].x = cvt_pk_bf16(v0[0], v0[1]); w[bj].y = cvt_pk_bf16(v0[2], v0[3]); w[bj].z = cvt_pk_bf16(v1[0], v1[1]); w[bj].w = cvt_pk_bf16(v1[2], v1[3]); }
                store_lines((unsigned char*)(O + (size_t)(rowg + ai * HALF + m * 16) * ldc + colw), (size_t)ldc * 2, fr, fq, w[0], w[1]); }
    }
};
template <bool SSQ, bool BASE32> struct EpiResid {
    static constexpr bool PERM = true; static constexpr bool ADJ = true; static constexpr int REPS = 1;
    const float* base32; bf16_t* xb; float* ssq;
    __device__ __forceinline__ void operator()(const f32x4 (&acc)[2][2][4][2], const Unit& u, int wr, int wc, int fr, int fq) const {
        const int rowg = u.pm * BM + wr * 64, colw = u.pn * BM + wc * 64;
#pragma unroll
        for (int ai = 0; ai < 2; ++ai) {
            float bs[4][2][8];
#pragma unroll
            for (int m = 0; m < 4; ++m)
#pragma unroll
                for (int bj = 0; bj < 2; ++bj) { const size_t off = (size_t)(rowg + ai * HALF + m * 16 + fr) * D + colw + 32 * bj + 8 * fq;
                    if constexpr (BASE32) { const f32x4 a = *(const f32x4*)(base32 + off), b = *(const f32x4*)(base32 + off + 4);
                        bs[m][bj][0] = a[0]; bs[m][bj][1] = a[1]; bs[m][bj][2] = a[2]; bs[m][bj][3] = a[3]; bs[m][bj][4] = b[0]; bs[m][bj][5] = b[1]; bs[m][bj][6] = b[2]; bs[m][bj][7] = b[3]; }
                    else { const u32x4 r = *(const u32x4*)(xb + off);
                        bs[m][bj][0] = __builtin_bit_cast(float, r.x << 16); bs[m][bj][1] = __builtin_bit_cast(float, r.x & 0xffff0000u); bs[m][bj][2] = __builtin_bit_cast(float, r.y << 16); bs[m][bj][3] = __builtin_bit_cast(float, r.y & 0xffff0000u);
                        bs[m][bj][4] = __builtin_bit_cast(float, r.z << 16); bs[m][bj][5] = __builtin_bit_cast(float, r.z & 0xffff0000u); bs[m][bj][6] = __builtin_bit_cast(float, r.w << 16); bs[m][bj][7] = __builtin_bit_cast(float, r.w & 0xffff0000u); } }
            asm volatile("" ::: "memory");
#pragma unroll
            for (int m = 0; m < 4; ++m) { const int row = rowg + ai * HALF + m * 16 + fr; float s = 0.f; u32x4 w[2];
#pragma unroll
                for (int bj = 0; bj < 2; ++bj) { float o[8];
#pragma unroll
                    for (int n = 0; n < 2; ++n)
#pragma unroll
                        for (int j = 0; j < 4; ++j) o[n * 4 + j] = bs[m][bj][n * 4 + j] + acc[ai][bj][m][n][j];
                    w[bj].x = cvt_pk_bf16(o[0], o[1]); w[bj].y = cvt_pk_bf16(o[2], o[3]); w[bj].z = cvt_pk_bf16(o[4], o[5]); w[bj].w = cvt_pk_bf16(o[6], o[7]);
                    if constexpr (SSQ) { const unsigned ww[4] = {w[bj].x, w[bj].y, w[bj].z, w[bj].w};
#pragma unroll
                        for (int q = 0; q < 4; ++q) { const float r0 = __builtin_bit_cast(float, ww[q] << 16), r1 = __builtin_bit_cast(float, ww[q] & 0xffff0000u); s += r0 * r0 + r1 * r1; } } }
                store_lines((unsigned char*)(xb + (size_t)(rowg + ai * HALF + m * 16) * D + colw), (size_t)D * 2, fr, fq, w[0], w[1]);
                if constexpr (SSQ) { s += __shfl_xor(s, 16); s += __shfl_xor(s, 32);
                    if (fq == 0) ssq[(size_t)row * 16 + u.pn * 4 + wc] = s; } }
            asm volatile("" ::: "memory"); }
    }
};
template <int NP> struct EpiSwiglu {
    static constexpr bool PERM = true; static constexpr bool ADJ = false; static constexpr int REPS = REP_EPI;
    bf16_t* O; int ldc; const float* ssq; LAS float* rsl;
    __device__ __forceinline__ void operator()(const f32x4 (&acc)[2][2][4][2], const Unit& u, int wr, int wc, int fr, int fq) const {
        const int row0 = u.pm * BM + wr * 64 + fr, col0 = u.pn * HALF + wc * 32 + 8 * fq;
        if constexpr (NP == 16) panel_rs_to_lds(ssq, u.pm, rsl);
#pragma unroll
        for (int ai = 0; ai < 2; ++ai)
#pragma unroll
            for (int m = 0; m < 4; ++m) { const int row = row0 + ai * HALF + m * 16; float rs; if constexpr (NP == 16) rs = rsl[wr * 64 + fr + ai * HALF + m * 16]; else rs = row_rs<NP>(ssq, row);
                float h[8];
#pragma unroll
                for (int n = 0; n < 2; ++n)
#pragma unroll
                    for (int j = 0; j < 4; j += 2) { const f32x2 hh = swiglu2((f32x2){acc[ai][0][m][n][j], acc[ai][0][m][n][j + 1]}, (f32x2){acc[ai][1][m][n][j], acc[ai][1][m][n][j + 1]}, rs); h[n * 4 + j] = hh.x; h[n * 4 + j + 1] = hh.y; }
                u32x4 w; w.x = cvt_pk_bf16(h[0], h[1]); w.y = cvt_pk_bf16(h[2], h[3]); w.z = cvt_pk_bf16(h[4], h[5]); w.w = cvt_pk_bf16(h[6], h[7]);
                *(u32x4*)(O + (size_t)row * ldc + col0) = w; }
    }
};
struct EpiSwigluMoe {
    static constexpr bool PERM = true; static constexpr bool ADJ = false; static constexpr int REPS = 1; static constexpr int SCW = 0x7f7f7f7f;
    bf16_t* O; int ldc; const float* rsv; const int* row_tok; float wsinv;
    __device__ __forceinline__ void operator()(const f32x4 (&acc)[2][2][4][2], const Unit& u, int wr, int wc, int fr, int fq) const {
        const int row0 = u.pm * BM + wr * 64 + fr, col0 = u.pn * HALF + wc * 32 + 8 * fq;
#pragma unroll
        for (int ai = 0; ai < 2; ++ai)
#pragma unroll
            for (int m = 0; m < 4; ++m) { const int row = row0 + ai * HALF + m * 16; const int tok = row_tok[row]; const float rs = tok >= 0 ? rsv[tok] * wsinv : 0.f;
                float h[8];
#pragma unroll
                for (int n = 0; n < 2; ++n)
#pragma unroll
                    for (int j = 0; j < 4; j += 2) { const f32x2 hh = swiglu2((f32x2){acc[ai][0][m][n][j], acc[ai][0][m][n][j + 1]}, (f32x2){acc[ai][1][m][n][j], acc[ai][1][m][n][j + 1]}, rs); h[n * 4 + j] = hh.x; h[n * 4 + j + 1] = hh.y; }
                u32x4 w; w.x = cvt_pk_bf16(h[0], h[1]); w.y = cvt_pk_bf16(h[2], h[3]); w.z = cvt_pk_bf16(h[4], h[5]); w.w = cvt_pk_bf16(h[6], h[7]);
                *(u32x4*)(O + (size_t)row * ldc + col0) = w; }
    }
};
struct EpiSwigluMoe8 {
    static constexpr bool PERM = true; static constexpr bool ADJ = false; static constexpr int REPS = 1; static constexpr int SCW = 0x79797979;
    unsigned char* O; int ldc;
    __device__ __forceinline__ void operator()(const f32x4 (&acc)[2][2][4][2], const Unit& u, int wr, int wc, int fr, int fq) const {
        const int row0 = u.pm * BM + wr * 64 + fr, col0 = u.pn * HALF + wc * 32 + 8 * fq;
        constexpr float K = -1.44269504f;
#pragma unroll
        for (int ai = 0; ai < 2; ++ai)
#pragma unroll
            for (int m = 0; m < 4; ++m) { const int row = row0 + ai * HALF + m * 16;
                float h[8];
#pragma unroll
                for (int n = 0; n < 2; ++n)
#pragma unroll
                    for (int j = 0; j < 4; j += 2) { const f32x2 a = {acc[ai][0][m][n][j], acc[ai][0][m][n][j + 1]}, uu = {acc[ai][1][m][n][j], acc[ai][1][m][n][j + 1]};
                        f32x2 e; e.x = __builtin_amdgcn_exp2f(a.x); e.y = __builtin_amdgcn_exp2f(a.y);
                        const f32x2 d = e * K + K, p = a * uu; f32x2 r; r.x = __builtin_amdgcn_rcpf(d.x); r.y = __builtin_amdgcn_rcpf(d.y);
                        const f32x2 hh = p * r; h[n * 4 + j] = hh.x; h[n * 4 + j + 1] = hh.y; }
                u32x2 w; w.x = pk4_fp8(h[0], h[1], h[2], h[3]); w.y = pk4_fp8(h[4], h[5], h[6], h[7]);
                *(u32x2*)(O + (size_t)row * ldc + col0) = w; }
    }
};
struct EpiMoeDown {
    static constexpr bool PERM = false; static constexpr bool ADJ = false; static constexpr int REPS = 1; static constexpr int SCW = 0x7f7f7f7f;
    bf16_t* out; const int* row_tok; const float* row_gate; float sc; LAS int* tkl;
    __device__ __forceinline__ void operator()(const f32x4 (&acc)[2][2][4][2], const Unit& u, int wr, int wc, int fr, int fq) const {
        const int row0 = u.pm * BM + wr * 64 + fr, col0 = u.pn * BM + wc * 32 + 4 * fq;
        if (threadIdx.x < 256) { tkl[threadIdx.x] = row_tok[u.pm * BM + (int)threadIdx.x]; ((LAS float*)tkl)[256 + threadIdx.x] = row_gate[u.pm * BM + (int)threadIdx.x]; }
        asm volatile("s_waitcnt lgkmcnt(0)" ::: "memory"); __builtin_amdgcn_s_barrier(); asm volatile("" ::: "memory");
        int tk[2][4]; float gt[2][4];
#pragma unroll
        for (int ai = 0; ai < 2; ++ai)
#pragma unroll
            for (int m = 0; m < 4; ++m) { const int rl = wr * 64 + fr + ai * HALF + m * 16; tk[ai][m] = tkl[rl]; gt[ai][m] = ((const LAS float*)tkl)[256 + rl]; }
#pragma unroll
        for (int ai = 0; ai < 2; ++ai)
#pragma unroll
            for (int m = 0; m < 4; ++m) { const int tok = tk[ai][m]; const float g = gt[ai][m] * sc;
                if (tok >= 0) { bf16_t* rp = out + (size_t)tok * D + col0; u32x2 cur[2][2];
#pragma unroll
                    for (int bj = 0; bj < 2; ++bj)
#pragma unroll
                        for (int n = 0; n < 2; ++n) cur[bj][n] = *(const u32x2*)(rp + bj * HALF + n * 16);
#pragma unroll
                    for (int bj = 0; bj < 2; ++bj)
#pragma unroll
                        for (int n = 0; n < 2; ++n) { const u32x2 r = cur[bj][n]; const f32x4 a = acc[ai][bj][m][n] * g;
                            u32x2 w; w.x = cvt_pk_bf16(__builtin_bit_cast(float, r.x << 16) + a[0], __builtin_bit_cast(float, r.x & 0xffff0000u) + a[1]);
                            w.y = cvt_pk_bf16(__builtin_bit_cast(float, r.y << 16) + a[2], __builtin_bit_cast(float, r.y & 0xffff0000u) + a[3]); *(u32x2*)(rp + bj * HALF + n * 16) = w; } }
                asm volatile("" ::: "memory"); }
    }
};
}

#define XB_TMO      128
#define XB_XCNT(j)  (256  + 64 * (j))
#define XB_XSUB(j)  (1280 + 64 * (j))
#define XB_XGEN(j)  (2304 + 64 * (j))
#define XB_TOP      3328
#define XB_TOPGEN   3392
#define XCD_BAR_WORDS 3456
#define XB_SPIN_CAP (1u << 18)
__device__ __forceinline__ unsigned xb_ld(unsigned* p)              { return __hip_atomic_load(p, __ATOMIC_RELAXED, __HIP_MEMORY_SCOPE_AGENT); }
__device__ __forceinline__ unsigned xb_add(unsigned* p, unsigned v) { return __hip_atomic_fetch_add(p, v, __ATOMIC_RELAXED, __HIP_MEMORY_SCOPE_AGENT); }
__device__ __forceinline__ unsigned xb_xcc_id() { return (unsigned)__builtin_amdgcn_s_getreg((3 << 11) | 20) & 0xFu; }
#define XB_SPIN(cond, bar) do { unsigned _sp = 0; while (cond) { __builtin_amdgcn_s_sleep(1); \
    if ((++_sp & 255u) == 0u) { if (xb_ld(&(bar)[XB_TMO])) break; if (_sp > XB_SPIN_CAP) { atomicAdd(&(bar)[XB_TMO], 1u); break; } } } } while (0)
struct XcdBarrier { unsigned* bar; unsigned x; volatile LAS unsigned* st; };
__device__ __forceinline__ XcdBarrier xcd_barrier_post(unsigned* bar, volatile LAS unsigned* st) {
    XcdBarrier b; b.bar = bar; b.x = xb_xcc_id(); b.st = st;
    if (threadIdx.x == 0) (void)xb_add(&bar[XB_XCNT(b.x)], 1u);
    return b;
}
__device__ __forceinline__ void xcd_barrier_complete(unsigned* bar, unsigned x, unsigned& nloc, unsigned& nx) {
    const unsigned G = gridDim.x * gridDim.y * gridDim.z;
    unsigned sum, cnt, mine, sp = 0u;
    for (;;) {
        sum = 0u; cnt = 0u; mine = 0u;
#pragma unroll
        for (unsigned j = 0; j < 16; ++j) { const unsigned c = xb_ld(&bar[XB_XCNT(j)]); sum += c; cnt += (c > 0u) ? 1u : 0u; mine = (j == x) ? c : mine; }
        if (sum == G) break;
        __builtin_amdgcn_s_sleep(1);
        if ((++sp & 255u) == 0u) { if (xb_ld(&bar[XB_TMO])) break; if (sp > XB_SPIN_CAP) { atomicAdd(&bar[XB_TMO], 1u); break; } }
    }
    nloc = mine > 0u ? mine : 1u; nx = cnt > 0u ? cnt : 1u;
}
__device__ __forceinline__ void xcd_barrier(const XcdBarrier& b) {
    asm volatile("s_waitcnt vmcnt(0)" ::: "memory");
    __syncthreads();
    if (threadIdx.x == 0) {
        unsigned* bar = b.bar;
        __builtin_amdgcn_s_waitcnt(0);
        unsigned nloc = b.st[0], nx = b.st[1];
        if (nloc == 0u) { xcd_barrier_complete(bar, b.x, nloc, nx); b.st[0] = nloc; b.st[1] = nx; }
        const unsigned old = xb_add(&bar[XB_XSUB(b.x)], 1u);
        const unsigned gen = old / nloc;
        if (old + 1u == (gen + 1u) * nloc) {
            __builtin_amdgcn_fence(__ATOMIC_RELEASE, "agent");
            asm volatile("s_waitcnt vmcnt(0)" ::: "memory");
            const unsigned og = xb_add(&bar[XB_TOP], 1u);
            const unsigned tg = og / nx;
            if (og + 1u == (tg + 1u) * nx) xb_add(&bar[XB_TOPGEN], 1u);
            else XB_SPIN(xb_ld(&bar[XB_TOPGEN]) == tg, bar);
            __builtin_amdgcn_fence(__ATOMIC_ACQUIRE, "agent");
            xb_add(&bar[XB_XGEN(b.x)], 1u);
            asm volatile("s_waitcnt vmcnt(0)" ::: "memory");
        } else {
            XB_SPIN(xb_ld(&bar[XB_XGEN(b.x)]) == gen, bar);
            __builtin_amdgcn_fence(__ATOMIC_ACQUIRE, "agent");
            asm volatile("s_waitcnt vmcnt(0)" ::: "memory");
        }
    }
    __syncthreads();
}

__device__ __forceinline__ void hnd_arrive(unsigned* w) {
    asm volatile("s_waitcnt vmcnt(0)" ::: "memory");
    __syncthreads();
    if (threadIdx.x == 0) { __builtin_amdgcn_fence(__ATOMIC_RELEASE, "agent"); asm volatile("s_waitcnt vmcnt(0)" ::: "memory"); (void)xb_add(w, 1u); }
}
__device__ __forceinline__ void hnd_wait(unsigned* w, unsigned target, unsigned* bar) {
    if (threadIdx.x == 0) { XB_SPIN(xb_ld(w) < target, bar); __builtin_amdgcn_fence(__ATOMIC_ACQUIRE, "agent"); asm volatile("s_waitcnt vmcnt(0)" ::: "memory"); }
    __syncthreads();
}

constexpr int NIN = 28;
struct Args { const float* in[NIN]; float* out; unsigned char* ws; int ph_lo, ph_hi; };
enum { I_X = 0, I_NORM_MIX, I_W_IN, I_W_OUT, I_SHIFT_MU, I_GM_LN_W, I_GM_LN_B, I_GM_WS, I_GM_BS, I_RW_W_UP, I_RW_W0, I_RW_A_UP, I_RW_A0, I_RW_G_UP, I_RW_K_K, I_RW_K_A, I_RW_R_K,
       I_RW_LNX_W, I_RW_LNX_B, I_NORM_FFN, I_FFN_WG, I_FFN_WU, I_FFN_WD, I_MOE_ROUTER, I_MOE_WG, I_MOE_WU, I_MOE_WD, I_NORM_FINAL };

struct Frame {
    LAS unsigned char* lds;
    int tid, lane, wave, G, gw, NGW;
};

struct CvItem { f32x4 v[8]; float gn[8]; };
__device__ __forceinline__ void cv_load(CvItem& it, const float* W, int N, int k0, int n0, const float* gain, float scale, int lane) {
    const int kr = lane >> 3, nq = lane & 7;
#pragma unroll
    for (int i = 0; i < 8; ++i) { it.v[i] = *(const GAS f32x4*)(W + (size_t)(k0 + 8 * i + kr) * N + n0 + 4 * nq); it.gn[i] = gain ? gain[k0 + 8 * i + kr] * scale : scale; }
}
__device__ __forceinline__ void cv_store_fp8(const CvItem& it, int K, unsigned char* WT, int drow0, int k0, LAS float* scr, int lane) {
    { const int kr = lane >> 3, nq = lane & 7;
#pragma unroll
      for (int i = 0; i < 8; ++i) { LAS float* d = scr + (8 * i + kr) * 33 + 4 * nq; d[0] = it.v[i][0] * it.gn[i]; d[1] = it.v[i][1] * it.gn[i]; d[2] = it.v[i][2] * it.gn[i]; d[3] = it.v[i][3] * it.gn[i]; } }
    LDS_WAIT(); asm volatile("" ::: "memory");
    const int n = lane >> 1, hf = lane & 1; const LAS float* sp = scr + (32 * hf) * 33 + n; u32x4 o0, o1;
    o0.x = pk4_fp8(sp[0 * 33], sp[1 * 33], sp[2 * 33], sp[3 * 33]); o0.y = pk4_fp8(sp[4 * 33], sp[5 * 33], sp[6 * 33], sp[7 * 33]); o0.z = pk4_fp8(sp[8 * 33], sp[9 * 33], sp[10 * 33], sp[11 * 33]); o0.w = pk4_fp8(sp[12 * 33], sp[13 * 33], sp[14 * 33], sp[15 * 33]);
    o1.x = pk4_fp8(sp[16 * 33], sp[17 * 33], sp[18 * 33], sp[19 * 33]); o1.y = pk4_fp8(sp[20 * 33], sp[21 * 33], sp[22 * 33], sp[23 * 33]); o1.z = pk4_fp8(sp[24 * 33], sp[25 * 33], sp[26 * 33], sp[27 * 33]); o1.w = pk4_fp8(sp[28 * 33], sp[29 * 33], sp[30 * 33], sp[31 * 33]);
    unsigned char* dst = WT + (size_t)(drow0 + n) * K + k0 + 32 * hf; *(GAS u32x4*)dst = o0; *(GAS u32x4*)(dst + 16) = o1;
    LDS_WAIT(); asm volatile("" ::: "memory");
}
__device__ __forceinline__ void transpose_item(const float* W, int K, int N, bf16* WT, int drow0, int k0, int n0, const float* gain, LAS float* scr, int lane) {
    { const int kr = lane >> 3, nq = lane & 7; f32x4 v[8]; float gn[8];
#pragma unroll
      for (int i = 0; i < 8; ++i) { v[i] = *(const GAS f32x4*)(W + (size_t)(k0 + 8 * i + kr) * N + n0 + 4 * nq); gn[i] = gain ? gain[k0 + 8 * i + kr] : 1.f; }
#pragma unroll
      for (int i = 0; i < 8; ++i) { LAS float* d = scr + (8 * i + kr) * 33 + 4 * nq; d[0] = v[i][0] * gn[i]; d[1] = v[i][1] * gn[i]; d[2] = v[i][2] * gn[i]; d[3] = v[i][3] * gn[i]; } }
    LDS_WAIT(); asm volatile("" ::: "memory");
    const int c = lane & 7;
#pragma unroll
    for (int j = 0; j < 4; ++j) { const int n = (lane >> 3) + 8 * j; const LAS float* s = scr + (8 * c) * 33 + n;
        u32x4 o; o.x = pk2(s[0 * 33], s[1 * 33]); o.y = pk2(s[2 * 33], s[3 * 33]); o.z = pk2(s[4 * 33], s[5 * 33]); o.w = pk2(s[6 * 33], s[7 * 33]);
        *(GAS u32x4*)(WT + (size_t)(drow0 + n) * K + k0 + 8 * c) = o; }
    LDS_WAIT(); asm volatile("" ::: "memory");
}
__device__ __forceinline__ void convert_matrix_fp8(Frame& F, const float* W, int K, int N, unsigned char* WT, int gu_mode  , const float* gain, float scale, int& itbase) {
    LAS float* scr = (LAS float*)(F.lds + F.wave * 16384);
    const int nblk = N / 32, nit = (K / 64) * nblk;
    int first = F.gw - (itbase % F.NGW); if (first < 0) first += F.NGW;
    CvItem nx;
    if (first < nit) cv_load(nx, W, N, 64 * (first / nblk), 32 * (first % nblk), gain, scale, F.lane);
    for (int r = first; r < nit; r += F.NGW) { const int kb = r / nblk, nb = r % nblk, n0 = 32 * nb;
        const int drow0 = gu_mode == 0 ? n0 : (n0 / 128) * 256 + (gu_mode == 2 ? 128 : 0) + (n0 % 128);
        const CvItem cur = nx; const int r2 = r + F.NGW;
        if (r2 < nit) cv_load(nx, W, N, 64 * (r2 / nblk), 32 * (r2 % nblk), gain, scale, F.lane);
        cv_store_fp8(cur, K, WT, drow0, 64 * kb, scr, F.lane); }
    itbase += nit;
}
__device__ __forceinline__ void convert_matrix(Frame& F, const float* W, int K, int N, bf16* WT, int gu_mode  , const float* gain, int it0, int& itbase) {
    LAS float* scr = (LAS float*)(F.lds + F.wave * 16384);
    const int nblk = N / 32, nit = (K / 64) * nblk;
    int first = F.gw - (itbase % F.NGW); if (first < 0) first += F.NGW;
    for (int r = first; r < nit; r += F.NGW) { const int kb = r / nblk, nb = r % nblk, n0 = 32 * nb;
        const int drow0 = gu_mode == 0 ? n0 : (n0 / 128) * 256 + (gu_mode == 2 ? 128 : 0) + (n0 % 128);
        transpose_item(W, K, N, WT, drow0, 64 * kb, n0, gain, scr, F.lane); }
    itbase += nit; (void)it0;
}

__device__ __forceinline__ void gmlp_naive(Frame& F, const bf16* P, bf16* Y, const float* ln_w, const float* ln_b, const float* ws, const float* bs) {
    LAS float* V = (LAS float*)F.lds;
    for (int unit = blockIdx.x; unit < NB * (SEQ / GCH) * NH; unit += F.G) {
        const int h = unit % NH, bc = unit / NH; const size_t row0 = (size_t)bc * GCH;
        const float lw = ln_w[h * HD + F.lane], lb = ln_b[h * HD + F.lane];
        for (int i = 0; i < 16; ++i) { const int t = F.wave * 16 + i;
            const float g = gelu_erf(bf2f(P[(row0 + t) * INW + GMW + h * HD + F.lane]));
            const float mean = wave_sum(g) * (1.f / HD); const float d = g - mean; const float var = wave_sum(d * d) * (1.f / HD);
            V[t * HD + F.lane] = d * __builtin_amdgcn_rsqf(var + LN_EPS) * lw + lb; }
        __syncthreads();
        for (int i = 0; i < 16; ++i) { const int t = F.wave * 16 + i; const float* wrow = ws + ((size_t)h * GCH + t) * GCH; float acc = 0.f;
            for (int s = 0; s <= t; ++s) acc += wrow[s] * V[s * HD + F.lane];
            const float mixed = acc + bs[h * GCH + t];
            const float u = gelu_erf(bf2f(P[(row0 + t) * INW + h * HD + F.lane]));
            Y[(row0 + t) * D + h * HD + F.lane] = (bf16)f2bf(u * mixed); }
        __syncthreads();
    }
}
__device__ __forceinline__ float shifted(const bf16* P, size_t row, int t, int col, const float* mu) {
    const float c = bf2f(P[row * INW + col]); const float pr = t > 0 ? bf2f(P[(row - 1) * INW + col]) : 0.f;
    return c + (pr - c) * mu[col - 1024];
}
constexpr int NC = 32;
__device__ __forceinline__ void rwkv_naive(Frame& F, const bf16* P, bf16* Y, const float* mu, const float* w_up, const float* w0, const float* a_up, const float* a0, const float* g_up,
                                           const float* k_k, const float* k_a, const float* r_k, const float* lnx_w, const float* lnx_b) {
    LAS float* LI = (LAS float*)F.lds;
    LAS float* sR = LI + NC * 256; LAS float* sW = sR + NC * 64; LAS float* sK = sW + NC * 64; LAS float* sV = sK + NC * 64; LAS float* sA = sV + NC * 64; LAS float* sB = sA + NC * 64;
    LAS float* sG = sB + NC * 64; LAS float* sBon = sG + NC * 64;
    for (int unit = blockIdx.x; unit < NB * NH; unit += F.G) {
        const int b = unit / NH, h = unit % NH;
        float S[64];
#pragma unroll
        for (int k = 0; k < 64; ++k) S[k] = 0.f;
        for (int c = 0; c < SEQ / NC; ++c) {
            const int t0 = c * NC; const size_t row0 = (size_t)b * SEQ + t0;
            for (int idx = F.tid; idx < NC * 256; idx += 512) { const int tok = idx >> 8, j = idx & 255;
                const float x = shifted(P, row0 + tok, t0 + tok, 2560 + j, mu);
                LI[idx] = j < 64 ? tanhf(x) : (j < 128 ? x : sigmoidf_(x)); }
            __syncthreads();
            { const int ch = F.lane, hc = h * HD + ch;
              for (int i = 0; i < NC / 8; ++i) { const int tok = F.wave + 8 * i; const size_t row = row0 + tok; const int t = t0 + tok;
                const float rr = shifted(P, row, t, 1024 + hc, mu), kx = shifted(P, row, t, 1536 + hc, mu), vv = shifted(P, row, t, 2048 + hc, mu);
                float dw = w0[hc], da = a0[hc], gg = 0.f;
                for (int j = 0; j < 64; ++j) { dw += LI[tok * 256 + j] * w_up[j * RWW + hc]; da += LI[tok * 256 + 64 + j] * a_up[j * RWW + hc]; }
                for (int j = 0; j < 128; ++j) gg += LI[tok * 256 + 128 + j] * g_up[j * RWW + hc];
                const float z = -dw; const float sp = fmaxf(z, 0.f) + log1pf(__expf(-fabsf(z)));
                const float decay = __expf(-__expf(-sp - 0.5f));
                const float alr = sigmoidf_(da);
                const float kkv = kx * k_k[hc]; const float nrm = sqrtf(wave_sum(kkv * kkv)); const float kkn = kkv / fmaxf(nrm, 1e-12f);
                const float kmod = kx * (1.f + (alr - 1.f) * k_a[hc]);
                const float bsc = wave_sum(rr * kmod * r_k[hc]);
                sR[tok * 64 + ch] = rr; sW[tok * 64 + ch] = decay; sK[tok * 64 + ch] = kmod; sV[tok * 64 + ch] = vv; sA[tok * 64 + ch] = -kkn; sB[tok * 64 + ch] = kkn * alr;
                sG[tok * 64 + ch] = gg; sBon[tok * 64 + ch] = bsc * vv; } }
            __syncthreads();
            if (F.wave == 0) {
                for (int t = 0; t < NC; ++t) { float sa = 0.f;
#pragma unroll
                    for (int k = 0; k < 64; ++k) sa += S[k] * sA[t * 64 + k];
                    const float vv = sV[t * 64 + F.lane]; float yv = 0.f;
#pragma unroll
                    for (int k = 0; k < 64; ++k) { S[k] = S[k] * sW[t * 64 + k] + sa * sB[t * 64 + k] + vv * sK[t * 64 + k]; yv += S[k] * sR[t * 64 + k]; }
                    LI[t * 64 + F.lane] = yv; }
            }
            __syncthreads();
            { const int v = F.lane, hv = h * HD + v;
              for (int i = 0; i < NC / 8; ++i) { const int tok = F.wave + 8 * i; const float yv = LI[tok * 64 + v];
                const float mean = wave_sum(yv) * (1.f / HD); const float d = yv - mean; const float var = wave_sum(d * d) * (1.f / HD);
                const float yn = d * __builtin_amdgcn_rsqf(var + GN_EPS) * lnx_w[hv] + lnx_b[hv];
                Y[(row0 + tok) * D + GMW + hv] = (bf16)f2bf((yn + sBon[tok * 64 + v]) * sG[tok * 64 + v]); } }
            __syncthreads();
        }
    }
}

typedef short s16x4 __attribute__((ext_vector_type(4)));
typedef short v4i16_t __attribute__((ext_vector_type(4)));
#define MFMA32(a, b, c) __builtin_amdgcn_mfma_f32_16x16x32_bf16((a), (b), (c), 0, 0, 0)
#define MFMA16(a, b, c) __builtin_amdgcn_mfma_f32_16x16x16bf16_1k((a), (b), (c), 0, 0, 0)
__device__ __forceinline__ bf16x8 lds_row8(const LAS bf16* T, int ld, int r0, int k0, int lane) { return *(const LAS bf16x8*)(T + (r0 + (lane & 15)) * ld + k0 + 8 * (lane >> 4)); }
__device__ __forceinline__ s16x4 lds_row4(const LAS bf16* T, int ld, int r0, int k0, int lane) { return *(const LAS s16x4*)(T + (r0 + (lane & 15)) * ld + k0 + 4 * (lane >> 4)); }
__device__ __forceinline__ s16x4 lds_tr4(const LAS bf16* T, int ld, int k0, int c0, int lane) { const int i = lane & 15, g = lane >> 4;
    return __builtin_bit_cast(s16x4, __builtin_amdgcn_ds_read_tr16_b64_v4i16((LAS v4i16_t*)(T + (k0 + 4 * g + (i >> 2)) * ld + c0 + 4 * (i & 3)))); }
__device__ __forceinline__ bf16x8 lds_tr8(const LAS bf16* T, int ld, int k0, int c0, int lane) { const int i = lane & 15, g = lane >> 4;
    const LAS bf16* p = T + (k0 + 8 * g + (i >> 2)) * ld + c0 + 4 * (i & 3);
    const s16x4 lo = __builtin_bit_cast(s16x4, __builtin_amdgcn_ds_read_tr16_b64_v4i16((LAS v4i16_t*)p));
    const s16x4 hi = __builtin_bit_cast(s16x4, __builtin_amdgcn_ds_read_tr16_b64_v4i16((LAS v4i16_t*)(p + 4 * ld)));
    bf16x8 r; r[0] = lo[0]; r[1] = lo[1]; r[2] = lo[2]; r[3] = lo[3]; r[4] = hi[0]; r[5] = hi[1]; r[6] = hi[2]; r[7] = hi[3]; return r; }
typedef __bf16 bf16x2_t __attribute__((ext_vector_type(2)));
__device__ __forceinline__ unsigned cvtpk_c(float lo, float hi) { const f32x2 v = {lo, hi}; const bf16x2_t b = __builtin_convertvector(v, bf16x2_t); return __builtin_bit_cast(unsigned, b); }
__device__ __forceinline__ s16x4 pack4(const f32x4 v) { u32x2 w; w.x = cvtpk_c(v[0], v[1]); w.y = cvtpk_c(v[2], v[3]); return __builtin_bit_cast(s16x4, w); }
__device__ __forceinline__ f32x4 unpack4(const s16x4 v) { f32x4 r; r[0] = bf2f((bf16)v[0]); r[1] = bf2f((bf16)v[1]); r[2] = bf2f((bf16)v[2]); r[3] = bf2f((bf16)v[3]); return r; }
__device__ __forceinline__ void unpack8(const u32x4 w, float (&o)[8]) { o[0] = __builtin_bit_cast(float, w.x << 16); o[1] = __builtin_bit_cast(float, w.x & 0xffff0000u); o[2] = __builtin_bit_cast(float, w.y << 16); o[3] = __builtin_bit_cast(float, w.y & 0xffff0000u);
    o[4] = __builtin_bit_cast(float, w.z << 16); o[5] = __builtin_bit_cast(float, w.z & 0xffff0000u); o[6] = __builtin_bit_cast(float, w.w << 16); o[7] = __builtin_bit_cast(float, w.w & 0xffff0000u); }
__device__ __forceinline__ u32x4 pack8(const float (&v)[8]) { u32x4 w; w.x = cvtpk_c(v[0], v[1]); w.y = cvtpk_c(v[2], v[3]); w.z = cvtpk_c(v[4], v[5]); w.w = cvtpk_c(v[6], v[7]); return w; }
__device__ __forceinline__ float gelu_as(float v) {
    const float av = fabsf(v), t = __builtin_amdgcn_rcpf(av * 0.2316418882f + 1.0f);
    float q = t * 0.5307027145f + (-0.7265760135f); q = q * t + 0.7107068705f; q = q * t + (-0.142248368f); q = q * t + 0.127414796f; q = q * t;
    const float e = __builtin_amdgcn_exp2f((v * v) * (-0.72134752044f)); const float m = v * (q * e); return v < 0.f ? m : v - m;
}

__device__ __forceinline__ f32x2 gelu_pk2(f32x2 v) {
    const f32x2 av = __builtin_elementwise_abs(v), d = av * 0.2316418882f + 1.0f;
    f32x2 t; t.x = __builtin_amdgcn_rcpf(d.x); t.y = __builtin_amdgcn_rcpf(d.y);
    f32x2 q = t * 0.5307027145f + (-0.7265760135f); q = q * t + 0.7107068705f; q = q * t + (-0.142248368f); q = q * t + 0.127414796f; q = q * t;
    const f32x2 s2 = (v * v) * (-0.72134752044f);
    f32x2 e; e.x = __builtin_amdgcn_exp2f(s2.x); e.y = __builtin_amdgcn_exp2f(s2.y);
    const f32x2 m = v * (q * e), r = v - m;
    f32x2 o; o.x = v.x < 0.f ? m.x : r.x; o.y = v.y < 0.f ? m.y : r.y; return o;
}
constexpr int GM_V = 0, GM_U = 128 * 72 * 2;
__device__ __forceinline__ void gmlp_unit(Frame& F, int unit, const bf16* P, bf16* Y, const float* ln_w, const float* ln_b, const bf16* WsB, const float* bs) {
    LAS bf16* Vt = (LAS bf16*)(F.lds + GM_V); LAS bf16* Ut = (LAS bf16*)(F.lds + GM_U);
    const int h = unit % NH, bc = unit / NH; const size_t row0 = (size_t)bc * GCH;
    { const int t = F.tid >> 2, cq = F.tid & 3; const bf16* pr = P + (row0 + t) * INW + h * HD + 16 * cq;
      const u32x4 u0 = *(const u32x4*)pr, u1 = *(const u32x4*)(pr + 8), v0 = *(const u32x4*)(pr + GMW), v1 = *(const u32x4*)(pr + GMW + 8);
      float uu[16], vv[16]; { float a[8]; unpack8(u0, a); for (int j = 0; j < 8; ++j) uu[j] = a[j]; unpack8(u1, a); for (int j = 0; j < 8; ++j) uu[8 + j] = a[j]; unpack8(v0, a); for (int j = 0; j < 8; ++j) vv[j] = a[j]; unpack8(v1, a); for (int j = 0; j < 8; ++j) vv[8 + j] = a[j]; }
      float s = 0.f;
#pragma unroll
      for (int j = 0; j < 16; ++j) { uu[j] = gelu_as(uu[j]); vv[j] = gelu_as(vv[j]); s += vv[j]; }
      s += __shfl_xor(s, 1); s += __shfl_xor(s, 2); const float mean = s * (1.f / HD); float q = 0.f;
#pragma unroll
      for (int j = 0; j < 16; ++j) { vv[j] -= mean; q += vv[j] * vv[j]; }
      q += __shfl_xor(q, 1); q += __shfl_xor(q, 2); const float rstd = __builtin_amdgcn_rsqf(q * (1.f / HD) + LN_EPS);
#pragma unroll
      for (int j = 0; j < 16; ++j) vv[j] = vv[j] * rstd * ln_w[h * HD + 16 * cq + j] + ln_b[h * HD + 16 * cq + j];
      float a[8]; for (int j = 0; j < 8; ++j) a[j] = vv[j]; *(LAS u32x4*)(Vt + t * 72 + 16 * cq) = pack8(a); for (int j = 0; j < 8; ++j) a[j] = vv[8 + j]; *(LAS u32x4*)(Vt + t * 72 + 16 * cq + 8) = pack8(a);
      for (int j = 0; j < 8; ++j) a[j] = uu[j]; *(LAS u32x4*)(Ut + t * 72 + 16 * cq) = pack8(a); for (int j = 0; j < 8; ++j) a[j] = uu[8 + j]; *(LAS u32x4*)(Ut + t * 72 + 16 * cq + 8) = pack8(a); }
    __syncthreads();
    { const int w = F.wave, l15 = F.lane & 15, g = F.lane >> 4, t0 = 16 * w, nks = (w >> 1) + 1; const bf16* wrow = WsB + ((size_t)h * GCH + t0 + l15) * GCH + 8 * g;
      f32x4 acc[4] = {{0.f, 0.f, 0.f, 0.f}, {0.f, 0.f, 0.f, 0.f}, {0.f, 0.f, 0.f, 0.f}, {0.f, 0.f, 0.f, 0.f}};
      for (int ks = 0; ks < nks; ++ks) { const bf16x8 a = *(const bf16x8*)(wrow + 32 * ks);
#pragma unroll
          for (int nt = 0; nt < 4; ++nt) acc[nt] = MFMA32(a, lds_tr8(Vt, 72, 32 * ks, 16 * nt, F.lane), acc[nt]); }
#pragma unroll
      for (int reg = 0; reg < 4; ++reg) { const int t = t0 + 4 * g + reg; const float bsv = bs[h * GCH + t];
#pragma unroll
          for (int nt = 0; nt < 4; ++nt) { LAS bf16* up = Ut + t * 72 + 16 * nt + l15; *up = (bf16)f2bf(bf2f(*up) * (acc[nt][reg] + bsv)); } } }
    __syncthreads();
    { const int t = F.tid >> 2, cq = F.tid & 3; bf16* yr = Y + (row0 + t) * D + h * HD + 16 * cq;
      *(u32x4*)yr = *(const LAS u32x4*)(Ut + t * 72 + 16 * cq); *(u32x4*)(yr + 8) = *(const LAS u32x4*)(Ut + t * 72 + 16 * cq + 8); }
    __syncthreads();
}

__device__ __forceinline__ void gmlp_units(Frame& F, int u0, int ustep, int nunits, const bf16* P, bf16* Y, const float* ln_w, const float* ln_b, const bf16* WsB, const float* bs) {
    if (u0 >= nunits) return;
    const int t = F.tid >> 2, cq = F.tid & 3; const int w = F.wave, l15 = F.lane & 15, g = F.lane >> 4, t0 = 16 * w, nks = (w >> 1) + 1;
    LAS float* TB = (LAS float*)(F.lds + 73728);
    TB[F.tid] = ln_w[F.tid]; TB[512 + F.tid] = ln_b[F.tid]; TB[1024 + F.tid] = bs[F.tid]; TB[1536 + F.tid] = bs[512 + F.tid];
    LDS_BARRIER();
    u32x4 pu0, pu1, pv0, pv1;
#define GM_LOAD(uu_) do { const int h_ = (uu_) % NH, bc_ = (uu_) / NH; const bf16* pr_ = P + ((size_t)bc_ * GCH + t) * INW + h_ * HD + 16 * cq; \
        pu0 = *(const u32x4*)pr_; pu1 = *(const u32x4*)(pr_ + 8); pv0 = *(const u32x4*)(pr_ + GMW); pv1 = *(const u32x4*)(pr_ + GMW + 8); } while (0)
    GM_LOAD(u0);
    int it = 0;
    for (int unit = u0; unit < nunits; unit += ustep, ++it) {
        LAS bf16* Vt = (LAS bf16*)(F.lds + (it & 1) * (2 * 128 * 72 * 2)); LAS bf16* Ut = Vt + 128 * 72;
        const int h = unit % NH, bc = unit / NH; const size_t row0 = (size_t)bc * GCH;
        const bf16* wrow = WsB + ((size_t)h * GCH + t0 + l15) * GCH + 8 * g; bf16x8 af[4];
#pragma unroll
        for (int ks = 0; ks < 4; ++ks) af[ks] = *(const bf16x8*)(wrow + 32 * (ks < nks ? ks : 0));
        const f32x4 bsv = *(const LAS f32x4*)(TB + 1024 + h * GCH + t0 + 4 * g);
        float uu[16], vv[16]; { float a[8]; unpack8(pu0, a); for (int j = 0; j < 8; ++j) uu[j] = a[j]; unpack8(pu1, a); for (int j = 0; j < 8; ++j) uu[8 + j] = a[j]; unpack8(pv0, a); for (int j = 0; j < 8; ++j) vv[j] = a[j]; unpack8(pv1, a); for (int j = 0; j < 8; ++j) vv[8 + j] = a[j]; }
        if (unit + ustep < nunits) GM_LOAD(unit + ustep);
        float sm = 0.f;
#pragma unroll
        for (int j = 0; j < 16; j += 2) { const f32x2 gu = gelu_pk2((f32x2){uu[j], uu[j + 1]}), gv = gelu_pk2((f32x2){vv[j], vv[j + 1]}); uu[j] = gu.x; uu[j + 1] = gu.y; vv[j] = gv.x; vv[j + 1] = gv.y; sm += gv.x + gv.y; }
        sm += __shfl_xor(sm, 1); sm += __shfl_xor(sm, 2); const float mean = sm * (1.f / HD); float q = 0.f;
#pragma unroll
        for (int j = 0; j < 16; ++j) { vv[j] -= mean; q += vv[j] * vv[j]; }
        q += __shfl_xor(q, 1); q += __shfl_xor(q, 2); const float rstd = __builtin_amdgcn_rsqf(q * (1.f / HD) + LN_EPS);
#pragma unroll
        for (int j = 0; j < 16; ++j) vv[j] = vv[j] * rstd * TB[h * HD + 16 * cq + j] + TB[512 + h * HD + 16 * cq + j];
        { float a[8]; for (int j = 0; j < 8; ++j) a[j] = vv[j]; *(LAS u32x4*)(Vt + t * 72 + 16 * cq) = pack8(a); for (int j = 0; j < 8; ++j) a[j] = vv[8 + j]; *(LAS u32x4*)(Vt + t * 72 + 16 * cq + 8) = pack8(a);
          for (int j = 0; j < 8; ++j) a[j] = uu[j]; *(LAS u32x4*)(Ut + t * 72 + 16 * cq) = pack8(a); for (int j = 0; j < 8; ++j) a[j] = uu[8 + j]; *(LAS u32x4*)(Ut + t * 72 + 16 * cq + 8) = pack8(a); }
        LDS_BARRIER();
        { f32x4 acc[4] = {{0.f, 0.f, 0.f, 0.f}, {0.f, 0.f, 0.f, 0.f}, {0.f, 0.f, 0.f, 0.f}, {0.f, 0.f, 0.f, 0.f}};
#pragma unroll
          for (int ks = 0; ks < 4; ++ks) if (ks < nks) {
#pragma unroll
              for (int nt = 0; nt < 4; ++nt) acc[nt] = MFMA32(af[ks], lds_tr8(Vt, 72, 32 * ks, 16 * nt, F.lane), acc[nt]); }
#pragma unroll
          for (int reg = 0; reg < 4; ++reg) { const int tt = t0 + 4 * g + reg;
#pragma unroll
              for (int nt = 0; nt < 4; ++nt) { LAS bf16* up = Ut + tt * 72 + 16 * nt + l15; *up = (bf16)f2bf(bf2f(*up) * (acc[nt][reg] + bsv[reg])); } } }
        LDS_BARRIER();
        { bf16* yr = Y + (row0 + t) * D + h * HD + 16 * cq;
          *(u32x4*)yr = *(const LAS u32x4*)(Ut + t * 72 + 16 * cq); *(u32x4*)(yr + 8) = *(const LAS u32x4*)(Ut + t * 72 + 16 * cq + 8); }
    }
#undef GM_LOAD
    LDS_BARRIER();
}

struct RwkvW { const float *mu, *w0, *a0, *k_k, *k_a, *r_k, *lnx_w, *lnx_b; const bf16 *WupT, *AupT, *GupT; };
struct RwkvS { bf16 *SG, *SH, *SQ, *SS, *Sg, *SY0; float* Sbsc; };
constexpr int M1_LI = 0;
constexpr int M1_PR = 33792;
constexpr int M1_TL = M1_PR + 36864;
constexpr int M1_SEG = M1_TL + 7 * 9216;
constexpr int M1_GAM = M1_SEG + 2048;
constexpr int M1_D = M1_GAM + 256;
constexpr int M1_T = M1_D + 4096;
constexpr int M1_END = M1_T + 2048;
static_assert(M1_END <= MISC_OFF, "M1 LDS map");
__device__ __forceinline__ float fast_tanh(float x) { const float e = __expf(2.f * x); return 1.f - 2.f * __builtin_amdgcn_rcpf(e + 1.f); }

__device__ __forceinline__ void rwkv_m1_unit(Frame& F, int unit  , const bf16* P, const RwkvW& W, const RwkvS& Sc) {
    const int b = unit >> 6, c = unit & 63, t0 = c * 64; const size_t row0 = (size_t)b * SEQ + t0;
    const int w = F.wave, lane = F.lane, l15 = lane & 15, g = lane >> 4;
    LAS bf16* LI = (LAS bf16*)(F.lds + M1_LI);
    LAS float* Ef = (LAS float*)(F.lds + M1_PR); LAS float* ALf = Ef + 64 * 64;
    LAS bf16* Lab = (LAS bf16*)(F.lds + M1_PR); LAS bf16* Lak = Lab + 64 * 72; LAS bf16* Mrb = Lak + 64 * 72; LAS bf16* Mrk = Mrb + 64 * 72;
    LAS bf16* At = (LAS bf16*)(F.lds + M1_TL); LAS bf16* Bt = At + 64 * 72; LAS bf16* Kt = Bt + 64 * 72; LAS bf16* Rt = Kt + 64 * 72; LAS bf16* Bh = Rt + 64 * 72; LAS bf16* Kh = Bh + 64 * 72; LAS bf16* Vt = Kh + 64 * 72;
    LAS float* SEG = (LAS float*)(F.lds + M1_SEG); LAS float* GAM = (LAS float*)(F.lds + M1_GAM); LAS float* Dd = (LAS float*)(F.lds + M1_D); LAS bf16* Tt = (LAS bf16*)(F.lds + M1_T);
#pragma unroll
    for (int it = 0; it < 4; ++it) { const int item = F.tid + 512 * it, tok = item >> 5, jc = item & 31, j0 = 8 * jc; const size_t row = row0 + tok;
        float cv[8], pv[8]; unpack8(*(const u32x4*)(P + row * INW + 2560 + j0), cv);
        if (t0 + tok > 0) unpack8(*(const u32x4*)(P + (row - 1) * INW + 2560 + j0), pv); else { for (int j = 0; j < 8; ++j) pv[j] = 0.f; }
        const f32x4 m0 = *(const f32x4*)(W.mu + 1536 + j0), m1 = *(const f32x4*)(W.mu + 1536 + j0 + 4); float o[8];
#pragma unroll
        for (int j = 0; j < 8; ++j) { const float x = cv[j] + (pv[j] - cv[j]) * (j < 4 ? m0[j] : m1[j - 4]); o[j] = jc < 8 ? fast_tanh(x) : (jc < 16 ? x : sigmoidf_(x)); }
        *(LAS u32x4*)(LI + tok * 264 + j0) = pack8(o); }
    __syncthreads();
    for (int h = 0; h < NH; ++h) {
        const size_t uh = ((size_t)unit * NH + h) * 4096;
        { const int mt = w & 3, ntb = 2 * (w >> 2); const int chrow = h * HD + 16 * mt + l15;
          f32x4 aw[2] = {{0.f, 0.f, 0.f, 0.f}, {0.f, 0.f, 0.f, 0.f}}, aa[2] = {{0.f, 0.f, 0.f, 0.f}, {0.f, 0.f, 0.f, 0.f}}, ag[2] = {{0.f, 0.f, 0.f, 0.f}, {0.f, 0.f, 0.f, 0.f}};
#pragma unroll
          for (int ks = 0; ks < 2; ++ks) { const bf16x8 fw = *(const bf16x8*)(W.WupT + (size_t)chrow * 64 + 32 * ks + 8 * g), fa = *(const bf16x8*)(W.AupT + (size_t)chrow * 64 + 32 * ks + 8 * g);
#pragma unroll
              for (int q = 0; q < 2; ++q) { aw[q] = MFMA32(fw, lds_row8(LI, 264, 16 * (ntb + q), 32 * ks, lane), aw[q]); aa[q] = MFMA32(fa, lds_row8(LI, 264, 16 * (ntb + q), 64 + 32 * ks, lane), aa[q]); } }
#pragma unroll
          for (int ks = 0; ks < 4; ++ks) { const bf16x8 fg = *(const bf16x8*)(W.GupT + (size_t)chrow * 128 + 32 * ks + 8 * g);
#pragma unroll
              for (int q = 0; q < 2; ++q) ag[q] = MFMA32(fg, lds_row8(LI, 264, 16 * (ntb + q), 128 + 32 * ks, lane), ag[q]); }
          const int ch0 = 16 * mt + 4 * g; const f32x4 w0v = *(const f32x4*)(W.w0 + h * HD + ch0), a0v = *(const f32x4*)(W.a0 + h * HD + ch0);
#pragma unroll
          for (int q = 0; q < 2; ++q) { const int tok = 16 * (ntb + q) + l15; f32x4 ev, av;
#pragma unroll
              for (int r = 0; r < 4; ++r) { const float z = -(aw[q][r] + w0v[r]); const float sp = fmaxf(z, 0.f) + __logf(1.f + __expf(-fabsf(z))); ev[r] = -__expf(-sp - 0.5f); av[r] = sigmoidf_(aa[q][r] + a0v[r]); }
              *(LAS f32x4*)(Ef + tok * 64 + ch0) = ev; *(LAS f32x4*)(ALf + tok * 64 + ch0) = av;
              u32x2 gw; gw.x = cvtpk_c(ag[q][0], ag[q][1]); gw.y = cvtpk_c(ag[q][2], ag[q][3]); *(u32x2*)(Sc.Sg + (row0 + tok) * RWW + h * HD + ch0) = gw; } }
        __syncthreads();
        { const int ch = F.tid & 63, seg = F.tid >> 6; float run = 0.f;
#pragma unroll
          for (int i = 0; i < 8; ++i) { run += Ef[(8 * seg + i) * 64 + ch]; Ef[(8 * seg + i) * 64 + ch] = run; }
          SEG[seg * 64 + ch] = run; }
        __syncthreads();
        { const int ch = F.tid & 63, seg = F.tid >> 6; float off = 0.f;
          for (int s2 = 0; s2 < seg; ++s2) off += SEG[s2 * 64 + ch];
#pragma unroll
          for (int i = 0; i < 8; ++i) Ef[(8 * seg + i) * 64 + ch] += off; }
        __syncthreads();
        { const int tok = F.tid >> 3, cg = F.tid & 7, ch0 = 8 * cg, hc0 = h * HD + ch0; const size_t row = row0 + tok; const bool has_prev = (t0 + tok) > 0;
          float rr[8], kx[8], vv[8], tmp[8], pr[8];
#define SHIFT_LOAD(dst, col) do { unpack8(*(const u32x4*)(P + row * INW + (col)), dst); if (has_prev) unpack8(*(const u32x4*)(P + (row - 1) * INW + (col)), pr); else { for (int j = 0; j < 8; ++j) pr[j] = 0.f; } \
              const f32x4 m0 = *(const f32x4*)(W.mu + (col) - 1024), m1 = *(const f32x4*)(W.mu + (col) - 1024 + 4); for (int j = 0; j < 8; ++j) dst[j] = dst[j] + (pr[j] - dst[j]) * (j < 4 ? m0[j] : m1[j - 4]); } while (0)
          SHIFT_LOAD(rr, 1024 + hc0); SHIFT_LOAD(kx, 1536 + hc0); SHIFT_LOAD(vv, 2048 + hc0);
          (void)tmp;
          float Lt[8], Lm[8], Lc[8], al[8];
#pragma unroll
          for (int j = 0; j < 8; ++j) { Lt[j] = Ef[tok * 64 + ch0 + j]; Lm[j] = tok > 0 ? Ef[(tok - 1) * 64 + ch0 + j] : 0.f; Lc[j] = Ef[63 * 64 + ch0 + j]; al[j] = ALf[tok * 64 + ch0 + j]; }
          float kk[8], km[8]; float ss = 0.f, bs_ = 0.f;
#pragma unroll
          for (int j = 0; j < 8; ++j) { kk[j] = kx[j] * W.k_k[hc0 + j]; ss += kk[j] * kk[j]; km[j] = kx[j] * (1.f + (al[j] - 1.f) * W.k_a[hc0 + j]); bs_ += rr[j] * km[j] * W.r_k[hc0 + j]; }
          ss += __shfl_xor(ss, 1); ss += __shfl_xor(ss, 2); ss += __shfl_xor(ss, 4); bs_ += __shfl_xor(bs_, 1); bs_ += __shfl_xor(bs_, 2); bs_ += __shfl_xor(bs_, 4);
          const float inv = 1.f / fmaxf(sqrtf(ss), 1e-12f);
          if (cg == 0) Sc.Sbsc[row * NH + h] = bs_;
          float oA[8], oB[8], oK[8], oR[8], oBh[8], oKh[8];
#pragma unroll
          for (int j = 0; j < 8; ++j) { const float kn = kk[j] * inv, bb = kn * al[j]; const float einv = __expf(-Lt[j]), ec = __expf(Lc[j] - Lt[j]);
              oA[j] = -kn * __expf(Lm[j]); oB[j] = bb * einv; oK[j] = km[j] * einv; oR[j] = rr[j] * __expf(Lt[j]); oBh[j] = bb * ec; oKh[j] = km[j] * ec; }
          *(LAS u32x4*)(At + tok * 72 + ch0) = pack8(oA); *(LAS u32x4*)(Bt + tok * 72 + ch0) = pack8(oB); *(LAS u32x4*)(Kt + tok * 72 + ch0) = pack8(oK); *(LAS u32x4*)(Rt + tok * 72 + ch0) = pack8(oR);
          *(LAS u32x4*)(Bh + tok * 72 + ch0) = pack8(oBh); *(LAS u32x4*)(Kh + tok * 72 + ch0) = pack8(oKh); *(LAS u32x4*)(Vt + tok * 72 + ch0) = pack8(vv);
          if (tok == 63) { for (int j = 0; j < 8; ++j) GAM[ch0 + j] = __expf(Lc[j]); } }
        __syncthreads();
        for (int i5 = 0; i5 < 5; ++i5) { const int q = w + 8 * i5, mat = q / 10, idx = q % 10; const int ti = idx < 1 ? 0 : (idx < 3 ? 1 : (idx < 6 ? 2 : 3)), si = idx - ti * (ti + 1) / 2;
            const LAS bf16* X = mat < 2 ? At : Rt; const LAS bf16* Yk = (mat & 1) ? Kt : Bt; LAS bf16* O = Lab + mat * 64 * 72;
            f32x4 acc = {0.f, 0.f, 0.f, 0.f};
#pragma unroll
            for (int ks = 0; ks < 2; ++ks) acc = MFMA32(lds_row8(Yk, 72, 16 * si, 32 * ks, lane), lds_row8(X, 72, 16 * ti, 32 * ks, lane), acc);
            const int t = 16 * ti + l15, s0 = 16 * si + 4 * g;
#pragma unroll
            for (int r = 0; r < 4; ++r) { const bool keep = mat < 2 ? (s0 + r < t) : (s0 + r <= t); if (!keep) acc[r] = 0.f; }
            *(LAS s16x4*)(O + t * 72 + s0) = pack4(acc);
            if (mat == 0 && ti == si) *(LAS f32x4*)(Dd + ti * 256 + l15 * 16 + 4 * g) = acc; }
        __syncthreads();
        if (w == 7) { const int i = lane >> 4, cc = lane & 15; const LAS float* Db = Dd + i * 256; float tv[16];
#pragma unroll
            for (int r = 0; r < 16; ++r) { float sum = (r == cc) ? 1.f : 0.f;
#pragma unroll
                for (int s2 = 0; s2 < r; ++s2) sum += Db[r * 16 + s2] * tv[s2];
                tv[r] = sum; }
#pragma unroll
            for (int r = 0; r < 16; ++r) Tt[i * 256 + r * 16 + cc] = (bf16)f2bf(tv[r]); }
        __syncthreads();
        { const bool isU = w < 4; const int cw = w & 3;
          f32x4 X[4];
#pragma unroll
          for (int i = 0; i < 4; ++i) { f32x4 z = {0.f, 0.f, 0.f, 0.f};
              if (isU) {
#pragma unroll
                  for (int j = 0; j <= i; ++j) z = MFMA16(lds_row4(Lak, 72, 16 * i, 16 * j, lane), lds_tr4(Vt, 72, 16 * j, 16 * cw, lane), z);
              } else z = unpack4(lds_tr4(At, 72, 16 * i, 16 * cw, lane));
#pragma unroll
              for (int j = 0; j < i; ++j) z = MFMA16(lds_row4(Lab, 72, 16 * i, 16 * j, lane), pack4(X[j]), z);
              const f32x4 zero = {0.f, 0.f, 0.f, 0.f};
              X[i] = MFMA16(lds_row4(Tt + i * 256, 16, 0, 0, lane), pack4(z), zero); }
          s16x4 Xp[4];
#pragma unroll
          for (int i = 0; i < 4; ++i) Xp[i] = pack4(X[i]);
          if (isU) {
#pragma unroll
              for (int nt = 0; nt < 4; ++nt) { f32x4 acc = {0.f, 0.f, 0.f, 0.f};
#pragma unroll
                  for (int i = 0; i < 4; ++i) { acc = MFMA16(Xp[i], lds_tr4(Bh, 72, 16 * i, 16 * nt, lane), acc); acc = MFMA16(lds_tr4(Vt, 72, 16 * i, 16 * cw, lane), lds_tr4(Kh, 72, 16 * i, 16 * nt, lane), acc); }
                  *(s16x4*)(Sc.SH + uh + (size_t)(16 * nt + l15) * 64 + 16 * cw + 4 * g) = pack4(acc); }
#pragma unroll
              for (int mt = 0; mt < 4; ++mt) { f32x4 acc = {0.f, 0.f, 0.f, 0.f};
#pragma unroll
                  for (int i = 0; i <= mt; ++i) { acc = MFMA16(lds_row4(Mrb, 72, 16 * mt, 16 * i, lane), Xp[i], acc); acc = MFMA16(lds_row4(Mrk, 72, 16 * mt, 16 * i, lane), lds_tr4(Vt, 72, 16 * i, 16 * cw, lane), acc); }
                  *(s16x4*)(Sc.SY0 + uh + (size_t)(16 * cw + l15) * 64 + 16 * mt + 4 * g) = pack4(acc); }
          } else {
              const float gamv = GAM[16 * cw + l15];
#pragma unroll
              for (int nt = 0; nt < 4; ++nt) { f32x4 acc = {0.f, 0.f, 0.f, 0.f};
#pragma unroll
                  for (int i = 0; i < 4; ++i) acc = MFMA16(Xp[i], lds_tr4(Bh, 72, 16 * i, 16 * nt, lane), acc);
                  { const float gam = (nt == cw) ? gamv : 0.f;
#pragma unroll
                      for (int r = 0; r < 4; ++r) acc[r] += (l15 == 4 * g + r) ? gam : 0.f; }
                  *(s16x4*)(Sc.SG + uh + (size_t)(16 * nt + l15) * 64 + 16 * cw + 4 * g) = pack4(acc); }
#pragma unroll
              for (int mt = 0; mt < 4; ++mt) { f32x4 acc = unpack4(lds_tr4(Rt, 72, 16 * mt, 16 * cw, lane));
#pragma unroll
                  for (int i = 0; i <= mt; ++i) acc = MFMA16(lds_row4(Mrb, 72, 16 * mt, 16 * i, lane), Xp[i], acc);
                  *(s16x4*)(Sc.SQ + uh + (size_t)(16 * cw + l15) * 64 + 16 * mt + 4 * g) = pack4(acc); }
          } }
        __syncthreads();
    }
}

constexpr int M1V_LI = 0;
constexpr int M1V_PR = 33792;
constexpr int M1V_TL = M1V_PR + 36864;
constexpr int M1V_SEG = M1V_TL + 5 * 9216;
constexpr int M1V_GAM = M1V_SEG + 2048;
constexpr int M1V_CST = M1V_GAM + 256;
constexpr int M1V_END = M1V_CST + 8 * 2048;
static_assert(M1V_END <= MISC_OFF, "M1 v2 LDS map");
__device__ __forceinline__ void rwkv_m1_consts(Frame& F, const RwkvW& W) {
    LAS float* CST = (LAS float*)(F.lds + M1V_CST);
    for (int i = F.tid; i < 1536; i += 512) CST[i] = W.mu[i];
    CST[3 * 512 + F.tid] = W.k_k[F.tid]; CST[4 * 512 + F.tid] = W.k_a[F.tid]; CST[5 * 512 + F.tid] = W.r_k[F.tid]; CST[6 * 512 + F.tid] = W.w0[F.tid]; CST[7 * 512 + F.tid] = W.a0[F.tid];
    __syncthreads();
}
__device__ __forceinline__ void rwkv_m1v2_unit(Frame& F, int unit  , const bf16* P, const RwkvW& W, const RwkvS& Sc) {
    const int b = unit >> 6, c = unit & 63, t0 = c * 64; const size_t row0 = (size_t)b * SEQ + t0;
    const int w = F.wave, lane = F.lane, l15 = lane & 15, g = lane >> 4;
    LAS bf16* LI = (LAS bf16*)(F.lds + M1V_LI);
    LAS float* Ef = (LAS float*)(F.lds + M1V_PR); constexpr int ES = 68; LAS float* ALf = Ef + 64 * ES;
    LAS bf16* Lab = (LAS bf16*)(F.lds + M1V_PR); LAS bf16* Lak = Lab + 64 * 72; LAS bf16* Mrb = Lak + 64 * 72; LAS bf16* Mrk = Mrb + 64 * 72;
    LAS bf16* At = (LAS bf16*)(F.lds + M1V_TL); LAS bf16* Bt = At + 64 * 72; LAS bf16* Kt = Bt + 64 * 72; LAS bf16* Rt = Kt + 64 * 72; LAS bf16* Vt = Rt + 64 * 72;
    LAS float* SEG = (LAS float*)(F.lds + M1V_SEG); LAS float* GAM = (LAS float*)(F.lds + M1V_GAM); const LAS float* CST = (const LAS float*)(F.lds + M1V_CST);
    bf16x8 wfw[2], wfa[2], wfg[4]; u32x4 pfc[3], pfp[3];
    const int ea_mt = w & 3, ea_ntb = 2 * (w >> 2);
    const int eb_tok = F.tid >> 3, eb_cg = F.tid & 7; const size_t eb_row = row0 + eb_tok; const bool eb_prev = (t0 + eb_tok) > 0;
#define M1_LOAD_W(hh) do { const int chrow_ = (hh) * HD + 16 * ea_mt + l15; \
        wfw[0] = *(const bf16x8*)(W.WupT + (size_t)chrow_ * 64 + 8 * g); wfw[1] = *(const bf16x8*)(W.WupT + (size_t)chrow_ * 64 + 32 + 8 * g); \
        wfa[0] = *(const bf16x8*)(W.AupT + (size_t)chrow_ * 64 + 8 * g); wfa[1] = *(const bf16x8*)(W.AupT + (size_t)chrow_ * 64 + 32 + 8 * g); \
        _Pragma("unroll") for (int ks_ = 0; ks_ < 4; ++ks_) wfg[ks_] = *(const bf16x8*)(W.GupT + (size_t)chrow_ * 128 + 32 * ks_ + 8 * g); } while (0)
#define M1_LOAD_P(hh) do { const int hc_ = (hh) * HD + 8 * eb_cg; \
        _Pragma("unroll") for (int a_ = 0; a_ < 3; ++a_) { pfc[a_] = *(const u32x4*)(P + eb_row * INW + 1024 + 512 * a_ + hc_); \
            if (eb_prev) pfp[a_] = *(const u32x4*)(P + (eb_row - 1) * INW + 1024 + 512 * a_ + hc_); else pfp[a_] = (u32x4){0u, 0u, 0u, 0u}; } } while (0)
#pragma unroll
    for (int it = 0; it < 4; ++it) { const int item = F.tid + 512 * it, tok = item >> 5, jc = item & 31, j0 = 8 * jc; const size_t row = row0 + tok;
        float cv[8], pv[8]; unpack8(*(const u32x4*)(P + row * INW + 2560 + j0), cv);
        if (t0 + tok > 0) unpack8(*(const u32x4*)(P + (row - 1) * INW + 2560 + j0), pv); else { for (int j = 0; j < 8; ++j) pv[j] = 0.f; }
        const f32x4 m0 = *(const f32x4*)(W.mu + 1536 + j0), m1 = *(const f32x4*)(W.mu + 1536 + j0 + 4); float o[8];
#pragma unroll
        for (int j = 0; j < 8; ++j) { const float x = cv[j] + (pv[j] - cv[j]) * (j < 4 ? m0[j] : m1[j - 4]); o[j] = jc < 8 ? fast_tanh(x) : (jc < 16 ? x : sigmoidf_(x)); }
        *(LAS u32x4*)(LI + tok * 264 + j0) = pack8(o); }
    LDS_BARRIER();
    M1_LOAD_W(((int)blockIdx.x) & (NH - 1));
    const int rp_ea = (PROBE_STAGE == 1) ? 2 - (F.G > 100000) : 1, rp_eb = (PROBE_STAGE == 2) ? 2 - (F.G > 100000) : 1, rp_p1 = (PROBE_STAGE == 3) ? 2 - (F.G > 100000) : 1, rp_ch = (PROBE_STAGE == 4) ? 2 - (F.G > 100000) : 1, rp_cs = (PROBE_STAGE == 5) ? 2 - (F.G > 100000) : 1;
    for (int hi_ = 0; hi_ < NH; ++hi_) { const int h = (hi_ + (int)blockIdx.x) & (NH - 1);
        const size_t uh = ((size_t)unit * NH + h) * 4096;
        for (int rp = 0; rp < rp_ea; ++rp) {
          f32x4 aw[2] = {{0.f, 0.f, 0.f, 0.f}, {0.f, 0.f, 0.f, 0.f}}, aa[2] = {{0.f, 0.f, 0.f, 0.f}, {0.f, 0.f, 0.f, 0.f}}, ag[2] = {{0.f, 0.f, 0.f, 0.f}, {0.f, 0.f, 0.f, 0.f}};
#pragma unroll
          for (int q = 0; q < 2; ++q) { bf16x8 lf[8];
#pragma unroll
              for (int ks = 0; ks < 8; ++ks) lf[ks] = lds_row8(LI, 264, 16 * (ea_ntb + q), 32 * ks, lane);
#pragma unroll
              for (int ks = 0; ks < 2; ++ks) { aw[q] = MFMA32(wfw[ks], lf[ks], aw[q]); aa[q] = MFMA32(wfa[ks], lf[2 + ks], aa[q]); }
#pragma unroll
              for (int ks = 0; ks < 4; ++ks) ag[q] = MFMA32(wfg[ks], lf[4 + ks], ag[q]); }
          const int ch0 = 16 * ea_mt + 4 * g; const f32x4 w0v = *(const LAS f32x4*)(CST + 6 * 512 + h * HD + ch0), a0v = *(const LAS f32x4*)(CST + 7 * 512 + h * HD + ch0);
#pragma unroll
          for (int q = 0; q < 2; ++q) { const int tok = 16 * (ea_ntb + q) + l15; f32x4 ev, av;
#pragma unroll
              for (int r = 0; r < 4; ++r) { ev[r] = -0.60653066f * __builtin_amdgcn_rcpf(1.f + __expf(-(aw[q][r] + w0v[r]))); av[r] = __builtin_amdgcn_rcpf(1.f + __expf(-(aa[q][r] + a0v[r]))); }
              *(LAS f32x4*)(Ef + tok * ES + ch0) = ev; *(LAS f32x4*)(ALf + tok * ES + ch0) = av;
              u32x2 gw; gw.x = cvtpk_c(ag[q][0], ag[q][1]); gw.y = cvtpk_c(ag[q][2], ag[q][3]); *(u32x2*)(Sc.Sg + (row0 + tok) * RWW + h * HD + ch0) = gw; } }
        LDS_BARRIER();
        for (int rp = 0; rp < rp_cs; ++rp) {
        float csv[8];
        { const int ch = F.tid & 63, seg = F.tid >> 6;
#pragma unroll
          for (int i = 0; i < 8; ++i) csv[i] = Ef[(8 * seg + i) * ES + ch];
#pragma unroll
          for (int i = 1; i < 8; ++i) csv[i] += csv[i - 1];
          SEG[seg * 64 + ch] = csv[7]; }
        LDS_BARRIER();
        { const int ch = F.tid & 63, seg = F.tid >> 6; float sg[8];
#pragma unroll
          for (int s2 = 0; s2 < 7; ++s2) sg[s2] = SEG[s2 * 64 + ch];
          float off = 0.f;
#pragma unroll
          for (int s2 = 0; s2 < 7; ++s2) off += (s2 < seg) ? sg[s2] : 0.f;
#pragma unroll
          for (int i = 0; i < 8; ++i) Ef[(8 * seg + i) * ES + ch] = csv[i] + off; }
        LDS_BARRIER();
        }
        for (int rp = 0; rp < rp_eb; ++rp) { const int tok = eb_tok, ch0 = 8 * eb_cg, hc0 = h * HD + ch0;
          float rr[8], kx[8], vv[8], pr[8];
#define M1_SHIFT(dst, a_) do { unpack8(pfc[a_], dst); unpack8(pfp[a_], pr); const f32x4 m0 = *(const LAS f32x4*)(CST + (a_) * 512 + hc0), m1 = *(const LAS f32x4*)(CST + (a_) * 512 + hc0 + 4); \
              _Pragma("unroll") for (int j = 0; j < 8; ++j) dst[j] = dst[j] + (pr[j] - dst[j]) * (j < 4 ? m0[j] : m1[j - 4]); } while (0)
          M1_LOAD_P(h); M1_SHIFT(rr, 0); M1_SHIFT(kx, 1); M1_SHIFT(vv, 2);
          float Lt[8], Lm[8], al[8], ckk[8], cka[8], crk[8];
#pragma unroll
          for (int j = 0; j < 8; ++j) { Lt[j] = Ef[tok * ES + ch0 + j]; Lm[j] = tok > 0 ? Ef[(tok - 1) * ES + ch0 + j] : 0.f; al[j] = ALf[tok * ES + ch0 + j]; ckk[j] = CST[3 * 512 + hc0 + j]; cka[j] = CST[4 * 512 + hc0 + j]; crk[j] = CST[5 * 512 + hc0 + j]; }
          float kk[8], km[8]; float ss = 0.f, bs_ = 0.f;
#pragma unroll
          for (int j = 0; j < 8; ++j) { kk[j] = kx[j] * ckk[j]; ss += kk[j] * kk[j]; km[j] = kx[j] * (1.f + (al[j] - 1.f) * cka[j]); bs_ += rr[j] * km[j] * crk[j]; }
          ss += __shfl_xor(ss, 1); ss += __shfl_xor(ss, 2); ss += __shfl_xor(ss, 4); bs_ += __shfl_xor(bs_, 1); bs_ += __shfl_xor(bs_, 2); bs_ += __shfl_xor(bs_, 4);
          const float inv = 1.f / fmaxf(sqrtf(ss), 1e-12f);
          if (eb_cg == 0) Sc.Sbsc[eb_row * NH + h] = bs_;
          float oA[8], oB[8], oK[8], oR[8];
#pragma unroll
          for (int j = 0; j < 8; ++j) { const float kn = kk[j] * inv, bb = kn * al[j]; const float eL = __expf(Lt[j]), einv = __builtin_amdgcn_rcpf(eL);
              oA[j] = -kn * __expf(Lm[j]); oB[j] = bb * einv; oK[j] = km[j] * einv; oR[j] = rr[j] * eL; if (tok == 63) GAM[ch0 + j] = eL; }
          *(LAS u32x4*)(At + tok * 72 + ch0) = pack8(oA); *(LAS u32x4*)(Bt + tok * 72 + ch0) = pack8(oB); *(LAS u32x4*)(Kt + tok * 72 + ch0) = pack8(oK); *(LAS u32x4*)(Rt + tok * 72 + ch0) = pack8(oR);
          *(LAS u32x4*)(Vt + tok * 72 + ch0) = pack8(vv); }
        { const int hn_ = ((hi_ + 1 < NH ? hi_ + 1 : hi_) + (int)blockIdx.x) & (NH - 1); M1_LOAD_W(hn_); }
        LDS_BARRIER();
        for (int rp = 0; rp < rp_p1; ++rp) for (int i5 = 0; i5 < 5; ++i5) { const int q = w + 8 * i5, mat = q / 10, idx = q % 10; const int ti = idx < 1 ? 0 : (idx < 3 ? 1 : (idx < 6 ? 2 : 3)), si = idx - ti * (ti + 1) / 2;
            const LAS bf16* X = mat < 2 ? At : Rt; const LAS bf16* Yk = (mat & 1) ? Kt : Bt; LAS bf16* O = Lab + mat * 64 * 72;
            f32x4 acc = {0.f, 0.f, 0.f, 0.f};
#pragma unroll
            for (int ks = 0; ks < 2; ++ks) acc = MFMA32(lds_row8(Yk, 72, 16 * si, 32 * ks, lane), lds_row8(X, 72, 16 * ti, 32 * ks, lane), acc);
            const int t = 16 * ti + l15, s0 = 16 * si + 4 * g; const int lim = mat < 2 ? t : t + 1;
#pragma unroll
            for (int r = 0; r < 4; ++r) acc[r] = (s0 + r < lim) ? acc[r] : 0.f;
            *(LAS s16x4*)(O + t * 72 + s0) = pack4(acc); }
        LDS_BARRIER();
        for (int rp = 0; rp < rp_ch; ++rp) { const bool isU = w < 4; const int cw = w & 3; const f32x4 zero = {0.f, 0.f, 0.f, 0.f};
          s16x4 TTp[4];
#pragma unroll
          for (int hb = 0; hb < 2; ++hb) { s16x4 fr[2], ft[2];
#pragma unroll
            for (int i = 0; i < 2; ++i) { fr[i] = lds_row4(Lab, 72, 16 * (2 * hb + i), 16 * (2 * hb + i), lane); ft[i] = lds_tr4(Lab, 72, 16 * (2 * hb + i), 16 * (2 * hb + i), lane); }
            f32x4 L2[2], L2T[2], L4[2], L4T[2], L8[2], TT[2]; s16x4 pL2[2], pL2T[2], pL4[2], pL4T[2];
#pragma unroll
            for (int i = 0; i < 2; ++i) { L2[i] = MFMA16(fr[i], ft[i], zero); L2T[i] = MFMA16(ft[i], fr[i], zero); }
#pragma unroll
            for (int i = 0; i < 2; ++i) { pL2[i] = pack4(L2[i]); pL2T[i] = pack4(L2T[i]); TT[i] = unpack4(fr[i]);
#pragma unroll
                for (int r = 0; r < 4; ++r) TT[i][r] += (l15 == 4 * g + r) ? 1.f : 0.f; }
#pragma unroll
            for (int i = 0; i < 2; ++i) { L4[i] = MFMA16(pL2T[i], pL2[i], zero); L4T[i] = MFMA16(pL2[i], pL2T[i], zero); TT[i] = MFMA16(pL2[i], pack4(TT[i]), TT[i]); }
#pragma unroll
            for (int i = 0; i < 2; ++i) { pL4[i] = pack4(L4[i]); pL4T[i] = pack4(L4T[i]); }
#pragma unroll
            for (int i = 0; i < 2; ++i) { L8[i] = MFMA16(pL4T[i], pL4[i], zero); TT[i] = MFMA16(pL4[i], pack4(TT[i]), TT[i]); }
#pragma unroll
            for (int i = 0; i < 2; ++i) { TT[i] = MFMA16(pack4(L8[i]), pack4(TT[i]), TT[i]); TTp[2 * hb + i] = pack4(TT[i]); } }
          s16x4 Vf[4]; f32x4 z[4];
          if (isU) { s16x4 lk[10];
#pragma unroll
              for (int j = 0; j < 4; ++j) Vf[j] = lds_tr4(Vt, 72, 16 * j, 16 * cw, lane);
#pragma unroll
              for (int i = 0; i < 4; ++i)
#pragma unroll
                  for (int j = 0; j <= i; ++j) lk[i * (i + 1) / 2 + j] = lds_row4(Lak, 72, 16 * i, 16 * j, lane);
#pragma unroll
              for (int i = 0; i < 4; ++i) { z[i] = zero;
#pragma unroll
                  for (int j = 0; j <= i; ++j) z[i] = MFMA16(lk[i * (i + 1) / 2 + j], Vf[j], z[i]); }
          } else {
#pragma unroll
              for (int i = 0; i < 4; ++i) { Vf[i] = (s16x4){0, 0, 0, 0}; z[i] = unpack4(lds_tr4(At, 72, 16 * i, 16 * cw, lane)); } }
          s16x4 Xp[4];
          { s16x4 lb[6];
#pragma unroll
            for (int i = 1; i < 4; ++i)
#pragma unroll
                for (int j = 0; j < i; ++j) lb[i * (i - 1) / 2 + j] = lds_row4(Lab, 72, 16 * i, 16 * j, lane);
#pragma unroll
            for (int i = 0; i < 4; ++i) { f32x4 zz = z[i];
#pragma unroll
                for (int j = 0; j < i; ++j) zz = MFMA16(lb[i * (i - 1) / 2 + j], Xp[j], zz);
                Xp[i] = pack4(MFMA16(TTp[i], pack4(zz), zero)); } }
          if (isU) {
#pragma unroll
              for (int nt = 0; nt < 4; ++nt) { s16x4 bf_[4], kf_[4];
#pragma unroll
                  for (int i = 0; i < 4; ++i) { bf_[i] = lds_tr4(Bt, 72, 16 * i, 16 * nt, lane); kf_[i] = lds_tr4(Kt, 72, 16 * i, 16 * nt, lane); }
                  f32x4 a1 = zero, a2 = zero;
#pragma unroll
                  for (int i = 0; i < 4; ++i) { a1 = MFMA16(Xp[i], bf_[i], a1); a2 = MFMA16(Vf[i], kf_[i], a2); }
                  const float gm = GAM[16 * nt + l15]; const f32x4 acc = (a1 + a2) * gm;
                  *(s16x4*)(Sc.SH + uh + (size_t)(16 * nt + l15) * 64 + 16 * cw + 4 * g) = pack4(acc); }
#pragma unroll
              for (int mt = 0; mt < 4; ++mt) { s16x4 mb[4], mk[4];
#pragma unroll
                  for (int i = 0; i <= mt; ++i) { mb[i] = lds_row4(Mrb, 72, 16 * mt, 16 * i, lane); mk[i] = lds_row4(Mrk, 72, 16 * mt, 16 * i, lane); }
                  f32x4 a1 = zero, a2 = zero;
#pragma unroll
                  for (int i = 0; i <= mt; ++i) { a1 = MFMA16(mb[i], Xp[i], a1); a2 = MFMA16(mk[i], Vf[i], a2); }
                  *(s16x4*)(Sc.SY0 + uh + (size_t)(16 * cw + l15) * 64 + 16 * mt + 4 * g) = pack4(a1 + a2); }
          } else {
#pragma unroll
              for (int nt = 0; nt < 4; ++nt) { s16x4 bf_[4];
#pragma unroll
                  for (int i = 0; i < 4; ++i) bf_[i] = lds_tr4(Bt, 72, 16 * i, 16 * nt, lane);
                  f32x4 a1 = zero, a2 = zero;
                  a1 = MFMA16(Xp[0], bf_[0], a1); a2 = MFMA16(Xp[1], bf_[1], a2); a1 = MFMA16(Xp[2], bf_[2], a1); a2 = MFMA16(Xp[3], bf_[3], a2);
                  f32x4 acc = a1 + a2; const float gm = GAM[16 * nt + l15]; const float dg = (nt == cw) ? 1.f : 0.f;
#pragma unroll
                  for (int r = 0; r < 4; ++r) acc[r] = (acc[r] + ((l15 == 4 * g + r) ? dg : 0.f)) * gm;
                  *(s16x4*)(Sc.SG + uh + (size_t)(16 * nt + l15) * 64 + 16 * cw + 4 * g) = pack4(acc); }
#pragma unroll
              for (int mt = 0; mt < 4; ++mt) { s16x4 mb[4]; const s16x4 rf = lds_tr4(Rt, 72, 16 * mt, 16 * cw, lane);
#pragma unroll
                  for (int i = 0; i <= mt; ++i) mb[i] = lds_row4(Mrb, 72, 16 * mt, 16 * i, lane);
                  f32x4 acc = unpack4(rf);
#pragma unroll
                  for (int i = 0; i <= mt; ++i) acc = MFMA16(mb[i], Xp[i], acc);
                  *(s16x4*)(Sc.SQ + uh + (size_t)(16 * cw + l15) * 64 + 16 * mt + 4 * g) = pack4(acc); }
          } }
        LDS_BARRIER();
    }
#undef M1_LOAD_W
#undef M1_LOAD_P
#undef M1_SHIFT
}

constexpr int M2_S = 0;
__device__ __forceinline__ void rwkv_m2_unit(Frame& F, int unit  , const RwkvS& Sc) {
    const int b = unit >> 3, h = unit & 7; const int w = F.wave, lane = F.lane, l15 = lane & 15, g = lane >> 4; const int mt = w >> 1, ntb = 2 * (w & 1);
    LAS bf16* Sb = (LAS bf16*)(F.lds + M2_S);
    f32x4 acc[2] = {{0.f, 0.f, 0.f, 0.f}, {0.f, 0.f, 0.f, 0.f}};
    constexpr int PF = 8;
    bf16x8 Gf[PF][2][2]; u32x2 Hf[PF][2];
#define M2_LOAD(slot, cc) do { const size_t uh_ = ((size_t)(b * 64 + (cc)) * NH + h) * 4096; _Pragma("unroll") for (int q = 0; q < 2; ++q) { const size_t ro = uh_ + (size_t)(16 * (ntb + q) + l15) * 64; \
        Gf[slot][q][0] = *(const bf16x8*)(Sc.SG + ro + 8 * g); Gf[slot][q][1] = *(const bf16x8*)(Sc.SG + ro + 32 + 8 * g); Hf[slot][q] = *(const u32x2*)(Sc.SH + ro + 16 * mt + 4 * g); } } while (0)
#pragma unroll
    for (int u = 0; u < PF; ++u) M2_LOAD(u, u);
    for (int c0 = 0; c0 < 64; c0 += PF) {
#pragma unroll
        for (int u = 0; u < PF; ++u) { const int c = c0 + u;
            const size_t uh = ((size_t)(b * 64 + c) * NH + h) * 4096; LAS bf16* buf = Sb + (u & 1) * 64 * 72;
#pragma unroll
            for (int q = 0; q < 2; ++q) { const s16x4 p = pack4(acc[q]); *(LAS s16x4*)(buf + (16 * (ntb + q) + l15) * 72 + 16 * mt + 4 * g) = p; *(s16x4*)(Sc.SS + uh + (size_t)(16 * (ntb + q) + l15) * 64 + 16 * mt + 4 * g) = p; }
            LDS_BARRIER();
            const bf16x8 a0 = lds_tr8(buf, 72, 0, 16 * mt, lane), a1 = lds_tr8(buf, 72, 32, 16 * mt, lane);
#pragma unroll
            for (int q = 0; q < 2; ++q) { f32x4 z; z[0] = __builtin_bit_cast(float, Hf[u][q].x << 16); z[1] = __builtin_bit_cast(float, Hf[u][q].x & 0xffff0000u); z[2] = __builtin_bit_cast(float, Hf[u][q].y << 16); z[3] = __builtin_bit_cast(float, Hf[u][q].y & 0xffff0000u);
                z = MFMA32(a0, Gf[u][q][0], z); acc[q] = MFMA32(a1, Gf[u][q][1], z); }
            { const int cn = c + PF < 64 ? c + PF : 63; M2_LOAD(u, cn); } }
    }
#undef M2_LOAD
    LDS_BARRIER();
}

constexpr int M3_SLOT = 9216 * 2 + 64 * 68 * 4;
__device__ __forceinline__ void rwkv_m3_unit(Frame& F, int unit  , const bf16* P, bf16* Y, const RwkvW& W, const RwkvS& Sc) {
    const int b = unit >> 6, c = unit & 63, t0 = c * 64; const size_t row0 = (size_t)b * SEQ + t0;
    const int w = F.wave, lane = F.lane, l15 = lane & 15, g = lane >> 4, hw = w >> 2, mt = w & 3, tl = F.tid & 255;
    LAS bf16* Qt = (LAS bf16*)(F.lds + hw * M3_SLOT); LAS bf16* St = Qt + 64 * 72; LAS float* Out = (LAS float*)(F.lds + hw * M3_SLOT + 2 * 9216);
    for (int hp = 0; hp < 4; ++hp) { const int h = 2 * hp + hw; const size_t uh = ((size_t)unit * NH + h) * 4096;
#pragma unroll
        for (int r = 0; r < 2; ++r) { const int off = 8 * (tl + 256 * r), rr = off >> 6, cc = off & 63;
            *(LAS u32x4*)(Qt + rr * 72 + cc) = *(const u32x4*)(Sc.SQ + uh + off); *(LAS u32x4*)(St + rr * 72 + cc) = *(const u32x4*)(Sc.SS + uh + off); }
        LDS_BARRIER();
        f32x4 acc[4];
#pragma unroll
        for (int nt = 0; nt < 4; ++nt) acc[nt] = unpack4(*(const s16x4*)(Sc.SY0 + uh + (size_t)(16 * nt + l15) * 64 + 16 * mt + 4 * g));
#pragma unroll
        for (int ks = 0; ks < 2; ++ks) { const bf16x8 a = lds_tr8(Qt, 72, 32 * ks, 16 * mt, lane);
#pragma unroll
            for (int nt = 0; nt < 4; ++nt) acc[nt] = MFMA32(a, lds_tr8(St, 72, 32 * ks, 16 * nt, lane), acc[nt]); }
#pragma unroll
        for (int r = 0; r < 4; ++r) { float s = (acc[0][r] + acc[1][r]) + (acc[2][r] + acc[3][r]);
            s += __shfl_xor(s, 1); s += __shfl_xor(s, 2); s += __shfl_xor(s, 4); s += __shfl_xor(s, 8); const float mean = s * (1.f / HD); float q = 0.f;
#pragma unroll
            for (int nt = 0; nt < 4; ++nt) { const float d = acc[nt][r] - mean; q += d * d; }
            q += __shfl_xor(q, 1); q += __shfl_xor(q, 2); q += __shfl_xor(q, 4); q += __shfl_xor(q, 8); const float rstd = __builtin_amdgcn_rsqf(q * (1.f / HD) + GN_EPS);
#pragma unroll
            for (int nt = 0; nt < 4; ++nt) { const int v = 16 * nt + l15; Out[(16 * mt + 4 * g + r) * 68 + v] = (acc[nt][r] - mean) * rstd * W.lnx_w[h * HD + v] + W.lnx_b[h * HD + v]; } }
        LDS_BARRIER();
        { const int t = tl >> 2, cq = tl & 3, v0 = 16 * cq, hv0 = h * HD + v0; const size_t row = row0 + t; const bool has_prev = (t0 + t) > 0; const float bsc = Sc.Sbsc[row * NH + h];
#pragma unroll
          for (int half = 0; half < 2; ++half) { float cv[8], pv[8], gv[8], o[8]; const int col = 2048 + hv0 + 8 * half;
              unpack8(*(const u32x4*)(P + row * INW + col), cv); if (has_prev) unpack8(*(const u32x4*)(P + (row - 1) * INW + col), pv); else { for (int j = 0; j < 8; ++j) pv[j] = 0.f; }
              unpack8(*(const u32x4*)(Sc.Sg + row * RWW + hv0 + 8 * half), gv);
              const f32x4 m0 = *(const f32x4*)(W.mu + col - 1024), m1 = *(const f32x4*)(W.mu + col - 1024 + 4);
#pragma unroll
              for (int j = 0; j < 8; ++j) { const float vs = cv[j] + (pv[j] - cv[j]) * (j < 4 ? m0[j] : m1[j - 4]); o[j] = (Out[t * 68 + v0 + 8 * half + j] + bsc * vs) * gv[j]; }
              *(u32x4*)(Y + row * D + GMW + hv0 + 8 * half) = pack8(o); } }
        LDS_BARRIER();
    }
}


__device__ __forceinline__ void rwkv_m3_units(Frame& F, int u0, int ustep, int nunits, const bf16* P, bf16* Y, const RwkvW& W, const RwkvS& Sc) {
    if (u0 >= nunits) return;
    const int w = F.wave, lane = F.lane, l15 = lane & 15, g = lane >> 4, hw = w >> 2, mt = w & 3, tl = F.tid & 255;
    LAS bf16* Qt = (LAS bf16*)(F.lds + hw * M3_SLOT); LAS bf16* St = Qt + 64 * 72; LAS float* Out = (LAS float*)(F.lds + hw * M3_SLOT + 2 * 9216);
    const int nu = (nunits - u0 + ustep - 1) / ustep, niter = nu * 4;
    LAS float* TB = (LAS float*)(F.lds + 73728);
    TB[F.tid] = W.lnx_w[F.tid]; TB[512 + F.tid] = W.lnx_b[F.tid]; TB[1024 + F.tid] = W.mu[1024 + F.tid];
    u32x4 qf[2], sf[2]; s16x4 y0f[4];
#define M3_PREF(itn) do { const int un_ = u0 + ((itn) >> 2) * ustep, hn_ = 2 * ((itn) & 3) + hw; const size_t uhn_ = ((size_t)un_ * NH + hn_) * 4096; \
        _Pragma("unroll") for (int r = 0; r < 2; ++r) { qf[r] = *(const u32x4*)(Sc.SQ + uhn_ + 8 * (tl + 256 * r)); sf[r] = *(const u32x4*)(Sc.SS + uhn_ + 8 * (tl + 256 * r)); } \
        _Pragma("unroll") for (int nt = 0; nt < 4; ++nt) y0f[nt] = *(const s16x4*)(Sc.SY0 + uhn_ + (size_t)(16 * nt + l15) * 64 + 16 * mt + 4 * g); } while (0)
    M3_PREF(0);
    for (int it = 0; it < niter; ++it) {
        const int unit = u0 + (it >> 2) * ustep, h = 2 * (it & 3) + hw; const int b = unit >> 6, c = unit & 63, t0 = c * 64; const size_t row0 = (size_t)b * SEQ + t0;
#pragma unroll
        for (int r = 0; r < 2; ++r) { const int off = 8 * (tl + 256 * r), rr = off >> 6, cc = off & 63; *(LAS u32x4*)(Qt + rr * 72 + cc) = qf[r]; *(LAS u32x4*)(St + rr * 72 + cc) = sf[r]; }
        f32x4 acc[4];
#pragma unroll
        for (int nt = 0; nt < 4; ++nt) acc[nt] = unpack4(y0f[nt]);
        const int t = tl >> 2, cq = tl & 3, v0 = 16 * cq, hv0 = h * HD + v0; const size_t row = row0 + t; const bool has_prev = (t0 + t) > 0;
        u32x4 cvr[2], pvr[2], gvr[2]; const float bsc = Sc.Sbsc[row * NH + h];
#pragma unroll
        for (int half = 0; half < 2; ++half) { const int col = 2048 + hv0 + 8 * half; cvr[half] = *(const u32x4*)(P + row * INW + col);
            pvr[half] = *(const u32x4*)(P + (has_prev ? row - 1 : row) * INW + col); gvr[half] = *(const u32x4*)(Sc.Sg + row * RWW + hv0 + 8 * half); }
        { const int itn = it + 1 < niter ? it + 1 : it; M3_PREF(itn); }
        LDS_BARRIER();
#pragma unroll
        for (int ks = 0; ks < 2; ++ks) { const bf16x8 a = lds_tr8(Qt, 72, 32 * ks, 16 * mt, lane);
#pragma unroll
            for (int nt = 0; nt < 4; ++nt) acc[nt] = MFMA32(a, lds_tr8(St, 72, 32 * ks, 16 * nt, lane), acc[nt]); }
#pragma unroll
        for (int r = 0; r < 4; ++r) { float s2 = (acc[0][r] + acc[1][r]) + (acc[2][r] + acc[3][r]);
            s2 += __shfl_xor(s2, 1); s2 += __shfl_xor(s2, 2); s2 += __shfl_xor(s2, 4); s2 += __shfl_xor(s2, 8); const float mean = s2 * (1.f / HD); float q = 0.f;
#pragma unroll
            for (int nt = 0; nt < 4; ++nt) { const float d = acc[nt][r] - mean; q += d * d; }
            q += __shfl_xor(q, 1); q += __shfl_xor(q, 2); q += __shfl_xor(q, 4); q += __shfl_xor(q, 8); const float rstd = __builtin_amdgcn_rsqf(q * (1.f / HD) + GN_EPS);
#pragma unroll
            for (int nt = 0; nt < 4; ++nt) { const int v = 16 * nt + l15; Out[(16 * mt + 4 * g + r) * 68 + v] = (acc[nt][r] - mean) * rstd * TB[h * HD + v] + TB[512 + h * HD + v]; } }
        LDS_BARRIER();
#pragma unroll
        for (int half = 0; half < 2; ++half) { float cv[8], pv[8], gv[8], o[8];
            unpack8(cvr[half], cv); unpack8(pvr[half], pv); unpack8(gvr[half], gv);
            const f32x4 m0 = *(const LAS f32x4*)(TB + 1024 + hv0 + 8 * half), m1 = *(const LAS f32x4*)(TB + 1024 + hv0 + 8 * half + 4);
#pragma unroll
            for (int j = 0; j < 8; ++j) { const float pvj = has_prev ? pv[j] : 0.f; const float vs = cv[j] + (pvj - cv[j]) * (j < 4 ? m0[j] : m1[j - 4]); o[j] = (Out[t * 68 + v0 + 8 * half + j] + bsc * vs) * gv[j]; }
            *(u32x4*)(Y + row * D + GMW + hv0 + 8 * half) = pack8(o); }
    }
#undef M3_PREF
    LDS_BARRIER();
}

__device__ __forceinline__ void rwkv_apply_naive(Frame& F, int unit, const bf16* P, bf16* Y, const RwkvW& W, const RwkvS& Sc) {
    const int b = unit >> 3, h = unit & 7;
    LAS float* S = (LAS float*)F.lds; LAS float* Gs = S + 64 * 65; LAS float* Hs = Gs + 64 * 65; LAS float* Qs = Hs + 64 * 65; LAS float* Ys = Qs + 64 * 65; LAS float* Sn = Ys + 64 * 65;
    for (int i = F.tid; i < 64 * 65; i += 512) S[i] = 0.f;
    __syncthreads();
    for (int c = 0; c < 64; ++c) { const size_t uh = ((size_t)(b * 64 + c) * NH + h) * 4096; const size_t row0 = (size_t)b * SEQ + c * 64;
        for (int i = F.tid; i < 4096; i += 512) { const int r = i >> 6, cc = i & 63;
            Gs[cc * 65 + r] = bf2f(Sc.SG[uh + i]);
            Hs[cc * 65 + r] = bf2f(Sc.SH[uh + i]);
            Qs[cc * 65 + r] = bf2f(Sc.SQ[uh + i]);
            Ys[cc * 65 + r] = bf2f(Sc.SY0[uh + i]); }
        __syncthreads();
        for (int i = F.tid; i < 4096; i += 512) { const int t = i >> 6, v = i & 63; float a = Ys[t * 65 + v];
            if (DBG_VAR != 1) for (int k = 0; k < 64; ++k) a += Qs[t * 65 + k] * S[v * 65 + k];
            if (DBG_VAR == 2) a = 0.f;
            Ys[t * 65 + v] = a; }
        for (int i = F.tid; i < 4096; i += 512) { const int v = i >> 6, k2 = i & 63; float a = Hs[v * 65 + k2];
            if (DBG_VAR == 6) a += S[v * 65 + k2] * Gs[k2 * 65 + k2]; else if (DBG_VAR != 3) for (int k = 0; k < 64; ++k) a += S[v * 65 + k] * Gs[k * 65 + k2];
            if (DBG_VAR == 7) a = Hs[v * 65 + k2] + 0.5f * (a - Hs[v * 65 + k2]);
            Sn[v * 65 + k2] = a; }
        __syncthreads();
        for (int i = F.tid; i < 4096; i += 512) { const int v = i >> 6, k2 = i & 63; S[v * 65 + k2] = Sn[v * 65 + k2]; }
        { const int t = F.tid >> 3, cg = F.tid & 7, v0 = 8 * cg, hv0 = h * HD + v0; const size_t row = row0 + t; const bool has_prev = (c * 64 + t) > 0; const float bsc = Sc.Sbsc[row * NH + h];
          float yv[8]; float sm = 0.f;
          for (int j = 0; j < 8; ++j) { yv[j] = Ys[t * 65 + v0 + j]; sm += yv[j]; }
          sm += __shfl_xor(sm, 1); sm += __shfl_xor(sm, 2); sm += __shfl_xor(sm, 4); const float mean = sm * (1.f / HD); float q = 0.f;
          for (int j = 0; j < 8; ++j) { yv[j] -= mean; q += yv[j] * yv[j]; }
          q += __shfl_xor(q, 1); q += __shfl_xor(q, 2); q += __shfl_xor(q, 4); const float rstd = __builtin_amdgcn_rsqf(q * (1.f / HD) + GN_EPS);
          float cv[8], pv[8], gv[8], o[8]; const int col = 2048 + hv0;
          unpack8(*(const u32x4*)(P + row * INW + col), cv); if (has_prev) unpack8(*(const u32x4*)(P + (row - 1) * INW + col), pv); else { for (int j = 0; j < 8; ++j) pv[j] = 0.f; }
          unpack8(*(const u32x4*)(Sc.Sg + row * RWW + hv0), gv);
          for (int j = 0; j < 8; ++j) { const float vs = cv[j] + (pv[j] - cv[j]) * W.mu[col - 1024 + j]; o[j] = (yv[j] * rstd * W.lnx_w[hv0 + j] + W.lnx_b[hv0 + j] + bsc * vs) * gv[j]; }
          *(u32x4*)(Y + row * D + GMW + hv0) = pack8(o); }
        __syncthreads();
    }
}

enum Phase { PH_PRO = 0, PH_G1_0, PH_M1_0, PH_M2_0, PH_M3_0, PH_G2_0, PH_G3_0, PH_G4_0, PH_G1_1, PH_M1_1, PH_M2_1, PH_M3_1, PH_G2_1, PH_CV, PH_R2, PH_GU_A, PH_DN_A, PH_GU_B, PH_DN_B, PH_FIN, PH_COUNT };

__global__ void __launch_bounds__(512, 2) fwd(Args args) {
    extern __shared__ __attribute__((aligned(16))) unsigned char lds_raw[];
    Frame F;
    F.lds = (LAS unsigned char*)lds_raw;
    F.tid = threadIdx.x; F.lane = F.tid & 63; F.wave = __builtin_amdgcn_readfirstlane(F.tid >> 6);
    F.G = gridDim.x; F.gw = blockIdx.x * 8 + F.wave; F.NGW = F.G * 8;
    unsigned char* ws = args.ws;
    gu32* ctl = (gu32*)(ws + WS_CTL);
    volatile LAS unsigned* MISC = (volatile LAS unsigned*)(F.lds + MISC_OFF);
    if (F.tid < 32) ((LAS unsigned*)(F.lds + MISC_OFF))[F.tid] = 0u;
    __syncthreads();
    XcdBarrier bar; bar.bar = (unsigned*)(ctl + CW_BAR); bar.x = 0; bar.st = nullptr;
#if !MK_PER_PHASE
    bar = xcd_barrier_post((unsigned*)(ctl + CW_BAR), MISC + 8);
#endif
    const int lo = args.ph_lo, hi = args.ph_hi;
#define IN(k) (lo <= (k) && (k) < hi)
#define STAGGER_WAIT() do { if (STAGGER_TICKS > 0 && (blockIdx.x & 8)) { const unsigned long long t0_ = __builtin_amdgcn_s_memrealtime(); while (__builtin_amdgcn_s_memrealtime() - t0_ < (unsigned long long)STAGGER_TICKS) __builtin_amdgcn_s_sleep(32); } } while (0)
#define SEAM(k) do { if (IN(k) && IN((k) + 1)) xcd_barrier(bar); } while (0)

    const float* x_in = args.in[I_X];
    bf16* WinT = (bf16*)(ws + WS_WIN); bf16* WoutT = (bf16*)(ws + WS_WOUT); bf16* WguT = (bf16*)(ws + WS_WGU); bf16* WdT = (bf16*)(ws + WS_WD);
    bf16* XB = (bf16*)(ws + WS_XB); bf16* PB = (bf16*)(ws + WS_P); bf16* YB = (bf16*)(ws + WS_Y); bf16* HB = (bf16*)(ws + WS_P);
    bf16* MWgu = (bf16*)(ws + WS_MOEW_GU); bf16* MWd = (bf16*)(ws + (MOE8_GU ? WS_MOEW8_D : WS_MOEW_D)); bf16* MH = (bf16*)(ws + WS_MOEH);
    unsigned char* MWgu8 = (unsigned char*)args.out + 40 * MiB; unsigned char* MWd8 = (unsigned char*)args.out + 96 * MiB;     unsigned char* MH8 = ws + WS_MOEH; unsigned char* MH8b = ws + WS_MOEH + 119 * MiB; unsigned char* XB8 = ws + WS_XB8;
    float* ssq0 = (float*)(ctl + CW_SSQ); float* ssq1 = (float*)(ws + WS_SSQP); float* ssq2 = ssq1 + (size_t)NTOK * 16;
    bf16* WupT = (bf16*)(ws + WS_SMALLW + SW_WUP); bf16* AupT = (bf16*)(ws + WS_SMALLW + SW_AUP); bf16* GupT = (bf16*)(ws + WS_SMALLW + SW_GUP); bf16* WsB = (bf16*)(ws + WS_SMALLW + SW_WS);
    RwkvS RS{(bf16*)(ws + WS_SCR), (bf16*)(ws + WS_SCR + 32 * MiB), (bf16*)(ws + WS_SCR + 64 * MiB), (bf16*)(ws + WS_SCR + 96 * MiB), (bf16*)(ws + WS_SCR + 128 * MiB), (bf16*)((unsigned char*)args.out), (float*)((unsigned char*)args.out + 32 * MiB)};
    unsigned char* misc = ws + WS_MISC;
    int* tok_e = (int*)(misc + MS_TOKE); float* tok_g = (float*)(misc + MS_TOKG); float* rs_moe = (float*)(misc + MS_RS); int* bcnt = (int*)(misc + MS_BCNT);
    int* row_tok = (int*)(misc + MS_ROWTOK); float* row_gate = (float*)(misc + MS_ROWGATE); int* panel = (int*)(misc + MS_PANEL); float* row_rs = (float*)(misc + MS_ROWRS);

#define MOE_CONVERT(FR, E0, E1) do { int itm_ = 0; const float* gain_ = args.in[I_NORM_FFN] + D; \
        for (int e = (E0); e < (E1); ++e) { \
            convert_matrix_fp8(FR, args.in[I_MOE_WG] + (size_t)e * D * FFE, D, FFE, MWgu8 + (size_t)e * 2 * FFE * D, 1, gain_, MOE8_WSCALE_GU * -1.44269504f, itm_); \
            convert_matrix_fp8(FR, args.in[I_MOE_WU] + (size_t)e * D * FFE, D, FFE, MWgu8 + (size_t)e * 2 * FFE * D, 2, gain_, MOE8_WSCALE_GU, itm_); \
            convert_matrix_fp8(FR, args.in[I_MOE_WD] + (size_t)e * FFE * D, FFE, D, MWd8 + (size_t)e * D * FFE, 0, nullptr, MOE8_WSCALE_DN, itm_); } } while (0)
    const bool early_moe = DEFER_CONVERT && MOE8_GU && MOE8_DN && F.G == 256;
#define DEFERRED_CONVERT(FR) do { int itb_ = 0; \
        convert_matrix(FR, args.in[I_W_IN] + (size_t)D * INW, D, INW, WinT + (size_t)INW * D, 0, args.in[I_NORM_MIX] + D, 0, itb_); \
        convert_matrix(FR, args.in[I_W_OUT], D, D, WoutT, 0, nullptr, 0, itb_); convert_matrix(FR, args.in[I_W_OUT] + (size_t)D * D, D, D, WoutT + (size_t)D * D, 0, nullptr, 0, itb_); \
        convert_matrix(FR, args.in[I_FFN_WG], D, FF, WguT, 1, args.in[I_NORM_FFN], 0, itb_); convert_matrix(FR, args.in[I_FFN_WU], D, FF, WguT, 2, args.in[I_NORM_FFN], 0, itb_); \
        convert_matrix(FR, args.in[I_FFN_WD], FF, D, WdT, 0, nullptr, 0, itb_); } while (0)
    if (IN(PH_PRO)) for (int rep = 0; rep < (PROBE_DUP == 4 ? 2 : 1); ++rep) {
        int itb = 0;
        convert_matrix(F, args.in[I_W_IN], D, INW, WinT, 0, args.in[I_NORM_MIX], 0, itb);
        if (!(DEFER_CONVERT && F.G == 256)) { DEFERRED_CONVERT(F); }
        { const size_t gt = (size_t)blockIdx.x * 512 + F.tid, gn = (size_t)F.G * 512;
          for (size_t i = gt; i < (size_t)2 * RWW * 64; i += gn) { const int l = (int)(i / (RWW * 64)), r = (int)(i % (RWW * 64)), ch = r / 64, j = r % 64;
              WupT[i] = (bf16)f2bf(args.in[I_RW_W_UP][(size_t)l * 64 * RWW + (size_t)j * RWW + ch]); AupT[i] = (bf16)f2bf(args.in[I_RW_A_UP][(size_t)l * 64 * RWW + (size_t)j * RWW + ch]); }
          for (size_t i = gt; i < (size_t)2 * RWW * 128; i += gn) { const int l = (int)(i / (RWW * 128)), r = (int)(i % (RWW * 128)), ch = r / 128, j = r % 128;
              GupT[i] = (bf16)f2bf(args.in[I_RW_G_UP][(size_t)l * 128 * RWW + (size_t)j * RWW + ch]); }
          for (size_t i = gt; i < (size_t)2 * NH * GCH * GCH; i += gn) { const int t = (int)((i / GCH) % GCH), s2 = (int)(i % GCH); WsB[i] = (bf16)(s2 <= t ? f2bf(args.in[I_GM_WS][i]) : 0u); } }
        for (int m = F.gw; m < NTOK; m += F.NGW) {
            const GAS f32x4* xr = (const GAS f32x4*)(x_in + (size_t)m * D) + F.lane; GAS u32x2* o8 = (GAS u32x2*)(XB + (size_t)m * D) + F.lane; float s = 0.f;
#pragma unroll
            for (int j = 0; j < 4; ++j) { const f32x4 v = xr[64 * j]; s += (v.x * v.x + v.y * v.y) + (v.z * v.z + v.w * v.w); u32x2 w; w.x = pk2(v.x, v.y); w.y = pk2(v.z, v.w); o8[64 * j] = w; }
            s = wave_sum(s); if (F.lane == 0) ssq0[m] = s;
        }
    }
    SEAM(PH_PRO);
    if (PROBE_DUP == 6) { for (int q_ = 0; q_ < 10; ++q_) xcd_barrier(bar); }

#define LAYER_MIXER(L, PH1, PHA, PHB, PHC, PH2, XBASE, BASE32, SSQ_IN, NP_IN, SSQ_OUT, HAS_OUT) \
    if (IN(PH1)) { pg8::DenseSched S; S.init(XB, WinT + (size_t)(L) * INW * D, NTOK, INW, 2 * D, F.G, (int)blockIdx.x); \
        pg8::EpiScaleBf16<NP_IN> E{PB, INW, SSQ_IN, (LAS float*)(F.lds + RING_BYTES + 4096)}; pg8::gemm_phase(F.lds, 2 * D, S, E); } \
    if (DEFER_CONVERT && (L) == 0 && IN(PH1) && F.G == 256 && (int)blockIdx.x >= 128) { __syncthreads(); Frame F2 = F; F2.gw = ((int)blockIdx.x - 128) * 8 + F.wave; F2.NGW = 128 * 8; DEFERRED_CONVERT(F2); if (early_moe) MOE_CONVERT(F2, 7, 8); __syncthreads(); } \
    if (early_moe && (L) == 1 && IN(PH1) && (int)blockIdx.x >= 128) { __syncthreads(); Frame F2 = F; F2.gw = ((int)blockIdx.x - 128) * 8 + F.wave; F2.NGW = 128 * 8; MOE_CONVERT(F2, 5, 7); __syncthreads(); } \
    if (PROBE_DUP == 1 && (L) == 0 && IN(PH1)) { pg8::DenseSched S; S.init(XB, WinT + (size_t)(L) * INW * D, NTOK, INW, 2 * D, F.G, (int)blockIdx.x); \
        pg8::EpiScaleBf16<NP_IN> E{PB, INW, SSQ_IN, (LAS float*)(F.lds + RING_BYTES + 4096)}; pg8::gemm_phase(F.lds, 2 * D, S, E); } \
    SEAM(PH1); \
    { RwkvW RW{args.in[I_SHIFT_MU] + (L) * 1792, args.in[I_RW_W0] + (L) * RWW, args.in[I_RW_A0] + (L) * RWW, args.in[I_RW_K_K] + (L) * RWW, args.in[I_RW_K_A] + (L) * RWW, args.in[I_RW_R_K] + (L) * RWW, \
                 args.in[I_RW_LNX_W] + (L) * RWW, args.in[I_RW_LNX_B] + (L) * RWW, WupT + (size_t)(L) * RWW * 64, AupT + (size_t)(L) * RWW * 64, GupT + (size_t)(L) * RWW * 128}; \
      if (IN(PHA)) { if (MIX_MODE != 1) for (int rep = 0; rep < REP_M1; ++rep) { rwkv_m1_consts(F, RW); for (int u = blockIdx.x; u < NB * 64; u += F.G) rwkv_m1v2_unit(F, u, PB, RW, RS); } } \
      SEAM(PHA); \
      if (IN(PHB)) for (int rep = 0; rep < REP_M2; ++rep) { const int nscan = (F.G >= 128 && MIX_MODE != 1) ? 64 : 0; \
          if (MIX_MODE != 1 && MIX_MODE != 3) { if (nscan) { if ((int)blockIdx.x < 64) { rwkv_m2_unit(F, blockIdx.x, RS); hnd_arrive((unsigned*)(ctl + CW_HND + 64 * (L))); } } else { for (int u = blockIdx.x; u < 64; u += F.G) { rwkv_m2_unit(F, u, RS); hnd_arrive((unsigned*)(ctl + CW_HND + 64 * (L))); } } } \
          if (MIX_MODE == 2) gmlp_naive(F, PB, YB, args.in[I_GM_LN_W] + (L) * GMW, args.in[I_GM_LN_B] + (L) * GMW, args.in[I_GM_WS] + (size_t)(L) * NH * GCH * GCH, args.in[I_GM_BS] + (L) * NH * GCH); \
          else { const int NU = NB * (SEQ / GCH) * NH; const int nsplit = (nscan && F.G == 256) ? 1920 : NU;         \
              if ((int)blockIdx.x >= nscan) gmlp_units(F, blockIdx.x - nscan, F.G - nscan, nsplit, PB, YB, args.in[I_GM_LN_W] + (L) * GMW, args.in[I_GM_LN_B] + (L) * GMW, WsB + (size_t)(L) * NH * GCH * GCH, args.in[I_GM_BS] + (L) * NH * GCH); \
              else if (nsplit < NU) gmlp_units(F, nsplit + blockIdx.x, nscan, NU, PB, YB, args.in[I_GM_LN_W] + (L) * GMW, args.in[I_GM_LN_B] + (L) * GMW, WsB + (size_t)(L) * NH * GCH * GCH, args.in[I_GM_BS] + (L) * NH * GCH); } } \
      if (MIX_MODE == 0 && REP_M2 == 1) { if (IN(PHB) && IN(PHC)) hnd_wait((unsigned*)(ctl + CW_HND + 64 * (L)), 64u, bar.bar); } else SEAM(PHB);      \
      if (IN(PHC)) { if (MIX_MODE == 3) { for (int u = blockIdx.x; u < 64; u += F.G) rwkv_apply_naive(F, u, PB, YB, RW, RS); } \
          else if (MIX_MODE != 1) { for (int rep = 0; rep < REP_M3; ++rep) rwkv_m3_units(F, blockIdx.x, F.G, NB * 64, PB, YB, RW, RS); } \
          else rwkv_naive(F, PB, YB, args.in[I_SHIFT_MU] + (L) * 1792, args.in[I_RW_W_UP] + (L) * 64 * RWW, args.in[I_RW_W0] + (L) * RWW, args.in[I_RW_A_UP] + (L) * 64 * RWW, args.in[I_RW_A0] + (L) * RWW, \
                   args.in[I_RW_G_UP] + (L) * 128 * RWW, args.in[I_RW_K_K] + (L) * RWW, args.in[I_RW_K_A] + (L) * RWW, args.in[I_RW_R_K] + (L) * RWW, args.in[I_RW_LNX_W] + (L) * RWW, args.in[I_RW_LNX_B] + (L) * RWW); } \
      SEAM(PHC); } \
    if (IN(PH2)) { STAGGER_WAIT(); pg8::DenseSched S; S.init(YB, WoutT + (size_t)(L) * D * D, NTOK, D, 2 * D, F.G, (int)blockIdx.x); \
        pg8::EpiResid<HAS_OUT, BASE32> E{XBASE, XB, SSQ_OUT}; pg8::gemm_phase(F.lds, 2 * D, S, E); } \
    if (PROBE_DUP == 2 && (L) == 0 && IN(PH2)) { pg8::DenseSched S; S.init(YB, WoutT + (size_t)(L) * D * D, NTOK, D, 2 * D, F.G, (int)blockIdx.x); \
        pg8::EpiResid<HAS_OUT, BASE32> E{XBASE, XB, SSQ_OUT}; pg8::gemm_phase(F.lds, 2 * D, S, E); } \
    SEAM(PH2);

    LAYER_MIXER(0, PH_G1_0, PH_M1_0, PH_M2_0, PH_M3_0, PH_G2_0, nullptr, false, ssq0, 1, ssq1, true)

    if (IN(PH_G3_0)) { pg8::DenseSched S; S.init(XB, WguT, NTOK, 2 * FF, 2 * D, F.G, (int)blockIdx.x);
        pg8::EpiSwiglu<16> E{HB, FF, ssq1, (LAS float*)(F.lds + RING_BYTES + 4096)}; pg8::gemm_phase(F.lds, 2 * D, S, E); }
#if REP_G3 == 2
    if (IN(PH_G3_0)) { pg8::DenseSched S; S.init(XB, WguT, NTOK, 2 * FF, 2 * D, F.G, (int)blockIdx.x);
        pg8::EpiSwiglu<16> E{HB, FF, ssq1, (LAS float*)(F.lds + RING_BYTES + 4096)}; pg8::gemm_phase(F.lds, 2 * D, S, E); }
#endif
    SEAM(PH_G3_0);
    if (IN(PH_G4_0)) { STAGGER_WAIT(); pg8::DenseSched S; S.init(HB, WdT, NTOK, D, 2 * FF, F.G, (int)blockIdx.x);
        pg8::EpiResid<true, false> E{nullptr, XB, ssq2}; pg8::gemm_phase(F.lds, 2 * FF, S, E); }
    SEAM(PH_G4_0);

    LAYER_MIXER(1, PH_G1_1, PH_M1_1, PH_M2_1, PH_M3_1, PH_G2_1, nullptr, false, ssq2, 16, nullptr, false)

    if (IN(PH_CV)) for (int rep = 0; rep < REP_CV; ++rep) {
        const float* gain = args.in[I_NORM_FFN] + D;
        LAS float* RW = (LAS float*)F.lds; LAS int* cnt = (LAS int*)(F.lds + 32768);
        for (int i = F.tid; i < D * NE; i += 512) { const int k = i >> 3, e = i & 7, jj = k >> 9, ln = (k & 511) >> 3, q = k & 7; RW[(((jj * 8 + q) * 64 + ln) << 3) + e] = args.in[I_MOE_ROUTER][i] * gain[k]; }
        for (size_t i = (size_t)blockIdx.x * 512 + F.tid; i < (size_t)2 * MAXPAN * 256; i += (size_t)F.G * 512) { row_tok[i] = -1; row_gate[i] = 0.f; row_rs[i] = 0.f; }
        __syncthreads();
        for (int vb = blockIdx.x; vb < 256; vb += F.G) {
            if (F.tid < 16) cnt[F.tid] = 0;
            __syncthreads();
            u32x4 xv4[2];
            { const GAS u32x4* xr0 = (const GAS u32x4*)(XB + (size_t)(vb * 128 + F.wave * 16) * D) + F.lane; xv4[0] = xr0[0]; xv4[1] = xr0[64]; }
            for (int i = 0; i < 16; ++i) { const int m = vb * 128 + F.wave * 16 + i;
                float s = 0.f; float lg[8]; u32x4 cur4[2]; cur4[0] = xv4[0]; cur4[1] = xv4[1];
                if (i + 1 < 16) { const GAS u32x4* xr1 = (const GAS u32x4*)(XB + (size_t)(m + 1) * D) + F.lane; xv4[0] = xr1[0]; xv4[1] = xr1[64]; }
#pragma unroll
                for (int e = 0; e < 8; ++e) lg[e] = 0.f;
#pragma unroll
                for (int jj = 0; jj < 2; ++jj) { float v[8]; unpack8(cur4[jj], v);
                    if (MOE8_GU && !MOE8_DN) { u32x2 w8; w8.x = pk4_fp8(v[0], v[1], v[2], v[3]); w8.y = pk4_fp8(v[4], v[5], v[6], v[7]); *(u32x2*)(XB8 + (size_t)m * D + 512 * jj + 8 * F.lane) = w8; }
#pragma unroll
                    for (int q = 0; q < 8; ++q) { const float xv = v[q]; s += xv * xv; const LAS f32x4* rw = (const LAS f32x4*)(RW + (((jj * 8 + q) * 64 + F.lane) << 3)); const f32x4 r0 = rw[0], r1 = rw[1];
                        lg[0] += xv * r0.x; lg[1] += xv * r0.y; lg[2] += xv * r0.z; lg[3] += xv * r0.w; lg[4] += xv * r1.x; lg[5] += xv * r1.y; lg[6] += xv * r1.z; lg[7] += xv * r1.w; } }
                s = wave_sum(s);
#pragma unroll
                for (int e = 0; e < 8; ++e) lg[e] = wave_sum(lg[e]);
                const float rs = 1.0f / sqrtf(s * (1.0f / D) + RMS_EPS);
                if (MOE8_GU && MOE8_DN) {
#pragma unroll
                    for (int jj = 0; jj < 2; ++jj) { float v[8]; unpack8(cur4[jj], v); u32x2 w8; w8.x = pk4_fp8(v[0] * rs, v[1] * rs, v[2] * rs, v[3] * rs); w8.y = pk4_fp8(v[4] * rs, v[5] * rs, v[6] * rs, v[7] * rs);
                        *(u32x2*)(XB8 + (size_t)m * D + 512 * jj + 8 * F.lane) = w8; } }
                if (F.lane == 0) {
                    int i1 = 0; float v1 = lg[0];
#pragma unroll
                    for (int e = 1; e < 8; ++e) if (lg[e] > v1) { v1 = lg[e]; i1 = e; }
                    int i2 = -1; float v2 = -3.0e38f;
#pragma unroll
                    for (int e = 0; e < 8; ++e) if (e != i1 && lg[e] > v2) { v2 = lg[e]; i2 = e; }
                    if (i2 < 0) { i2 = (i1 + 1) & 7; v2 = v1; }
                    const float g1 = 1.0f / (1.0f + __expf((v2 - v1) * rs)), g2 = 1.0f - g1;
                    tok_e[2 * m] = i1; tok_e[2 * m + 1] = i2; tok_g[2 * m] = g1; tok_g[2 * m + 1] = g2; rs_moe[m] = rs;
                    __hip_atomic_fetch_add(&cnt[i1], 1, __ATOMIC_RELAXED, __HIP_MEMORY_SCOPE_WORKGROUP); __hip_atomic_fetch_add(&cnt[8 + i2], 1, __ATOMIC_RELAXED, __HIP_MEMORY_SCOPE_WORKGROUP);
                } }
            __syncthreads();
            if (F.tid < 16) bcnt[vb * 16 + F.tid] = cnt[F.tid];
            __syncthreads();
        }
        if (rep == 0) hnd_arrive((unsigned*)(ctl + CW_HND + 128));
        int itb = 0;
        for (int e = 0; e < (early_moe ? 5 : NE); ++e) {
            if (MOE8_GU) { convert_matrix_fp8(F, args.in[I_MOE_WG] + (size_t)e * D * FFE, D, FFE, MWgu8 + (size_t)e * 2 * FFE * D, 1, gain, MOE8_WSCALE_GU * (MOE8_DN ? -1.44269504f : 1.0f), itb);
                           convert_matrix_fp8(F, args.in[I_MOE_WU] + (size_t)e * D * FFE, D, FFE, MWgu8 + (size_t)e * 2 * FFE * D, 2, gain, MOE8_WSCALE_GU, itb); }
            else { convert_matrix(F, args.in[I_MOE_WG] + (size_t)e * D * FFE, D, FFE, MWgu + (size_t)e * 2 * FFE * D, 1, gain, 0, itb);
                   convert_matrix(F, args.in[I_MOE_WU] + (size_t)e * D * FFE, D, FFE, MWgu + (size_t)e * 2 * FFE * D, 2, gain, 0, itb); }
            if (MOE8_DN) convert_matrix_fp8(F, args.in[I_MOE_WD] + (size_t)e * FFE * D, FFE, D, MWd8 + (size_t)e * D * FFE, 0, nullptr, MOE8_WSCALE_DN, itb);
            else convert_matrix(F, args.in[I_MOE_WD] + (size_t)e * FFE * D, FFE, D, MWd + (size_t)e * D * FFE, 0, nullptr, 0, itb);
        }
    }
    if (IN(PH_CV) && IN(PH_R2)) hnd_wait((unsigned*)(ctl + CW_HND + 128), (unsigned)F.G, bar.bar);

    if (IN(PH_R2)) {
        LAS int* tot = (LAS int*)F.lds;
        LAS int* bc = tot + 64;
        for (int vb = blockIdx.x; vb < 256; vb += F.G) {
            for (int i = F.tid; i < 256 * 16; i += 512) bc[i] = bcnt[i];
            __syncthreads();
            if (F.tid < 16) { int t = 0, mine = 0; for (int b2 = 0; b2 < 256; ++b2) { const int c = bc[b2 * 16 + F.tid]; if (b2 < vb) mine += c; t += c; } tot[F.tid] = t; tot[32 + F.tid] = mine; }
            __syncthreads();
            if (F.tid < 2) { int ps = 0; for (int e = 0; e < 8; ++e) { tot[16 + F.tid * 8 + e] = ps; ps += (tot[F.tid * 8 + e] + 255) / 256; }
                if (vb == 0) { panel[F.tid * 160] = ps; for (int e = 0; e < 8; ++e) { const int np = (tot[F.tid * 8 + e] + 255) / 256; for (int q = 0; q < np; ++q) panel[F.tid * 160 + 16 + tot[16 + F.tid * 8 + e] + q] = e; } } }
            int e01[2] = {0, 0}; float g01[2] = {0.f, 0.f}; float rsv = 0.f; const int m = vb * 128 + F.tid;
            if (F.tid < 128) { e01[0] = tok_e[2 * m]; e01[1] = tok_e[2 * m + 1]; g01[0] = tok_g[2 * m]; g01[1] = tok_g[2 * m + 1]; rsv = rs_moe[m]; }
            int rank[2] = {0, 0};
            if (F.wave < 2) {
#pragma unroll
                for (int set = 0; set < 2; ++set)
#pragma unroll
                    for (int e = 0; e < 8; ++e) { const unsigned long long mk = __ballot(e01[set] == e); if (e01[set] == e) rank[set] = __popcll(mk & ((1ull << F.lane) - 1ull));
                        if (F.wave == 0 && F.lane == 0) tot[48 + set * 8 + e] = __popcll(mk); } }
            __syncthreads();
            if (F.tid < 128) {
#pragma unroll
                for (int set = 0; set < 2; ++set) { const int key = set * 8 + e01[set]; const int slot = tot[16 + key] * 256 + tot[32 + key] + rank[set] + (F.wave == 1 ? tot[48 + key] : 0);
                    row_tok[set * MAXPAN * 256 + slot] = m; row_gate[set * MAXPAN * 256 + slot] = g01[set]; row_rs[set * MAXPAN * 256 + slot] = rsv; } }
            __syncthreads();
        }
    }
    SEAM(PH_R2);

#define MOE_SET(SET, PHGU, PHDN) \
    if (IN(PHGU)) for (int rep = 0; rep < REP_GU; ++rep) { const int np = __builtin_amdgcn_readfirstlane(panel[(SET) * 160]); pg8::MoeSched<true> S; \
        if (MOE8_GU) { S.init(XB8, MWgu8, np, 2 * FFE, D, MOE_PEXP(SET) + 16, row_tok + (SET) * MAXPAN * 256, F.G, (int)blockIdx.x); \
            if (MOE8_DN) { pg8::EpiSwigluMoe8 E{MH8, FFE}; pg8::gemm_phase<pg8::EpiSwigluMoe8, pg8::MoeSched<true>, true>(F.lds, D, S, E); } \
            else { pg8::EpiSwigluMoe E{MH, FFE, rs_moe, row_tok + (SET) * MAXPAN * 256, 1.0f / MOE8_WSCALE_GU}; pg8::gemm_phase<pg8::EpiSwigluMoe, pg8::MoeSched<true>, true>(F.lds, D, S, E); } } \
        else { S.init(XB, MWgu, np, 2 * FFE, 2 * D, MOE_PEXP(SET) + 16, row_tok + (SET) * MAXPAN * 256, F.G, (int)blockIdx.x); \
            pg8::EpiSwigluMoe E{MH, FFE, rs_moe, row_tok + (SET) * MAXPAN * 256, 1.0f}; pg8::gemm_phase(F.lds, 2 * D, S, E); } } \
    SEAM(PHGU); \
    if (IN(PHDN)) { const int np = __builtin_amdgcn_readfirstlane(panel[(SET) * 160]); pg8::MoeSched<false> S; \
        if (MOE8_DN) { S.init(MH8, MWd8, np, D, FFE, MOE_PEXP(SET) + 16, row_tok + (SET) * MAXPAN * 256, F.G, (int)blockIdx.x); \
            pg8::EpiMoeDown E{XB, row_tok + (SET) * MAXPAN * 256, row_gate + (SET) * MAXPAN * 256, 1.0f / MOE8_WSCALE_DN, (LAS int*)(F.lds + RING_BYTES + 4096)}; pg8::gemm_phase<pg8::EpiMoeDown, pg8::MoeSched<false>, true>(F.lds, FFE, S, E); } \
        else { S.init(MH, MWd, np, D, 2 * FFE, MOE_PEXP(SET) + 16, row_tok + (SET) * MAXPAN * 256, F.G, (int)blockIdx.x); \
            pg8::EpiMoeDown E{XB, row_tok + (SET) * MAXPAN * 256, row_gate + (SET) * MAXPAN * 256, 1.0f, (LAS int*)(F.lds + RING_BYTES + 4096)}; pg8::gemm_phase(F.lds, 2 * FFE, S, E); } } \
    SEAM(PHDN);
#if MOE8_GU && MOE8_DN
#define MOE_PEXP(SET) ((const LAS int*)(F.lds + RING_BYTES + (SET) * 1024))
#define MOE_LOAD_PEXP() do { if (F.tid < 2 * 160) ((LAS int*)(F.lds + RING_BYTES))[(F.tid / 160) * 256 + (F.tid % 160)] = panel[F.tid]; __syncthreads(); } while (0)
#define MOE_GU8(SET, HBUF, P0, NP, SKX, SKR) do { pg8::MoeSched<true> S; \
        S.init(XB8, MWgu8, (NP), 2 * FFE, D, MOE_PEXP(SET) + 16, row_tok + (SET) * MAXPAN * 256, F.G, (int)blockIdx.x); S.p0 = (P0); S.T.sx = (SKX); S.T.sr = (SKR); \
        pg8::EpiSwigluMoe8 E{HBUF, FFE}; pg8::gemm_phase<pg8::EpiSwigluMoe8, pg8::MoeSched<true>, true>(F.lds, D, S, E); } while (0)
#define MOE_DN8(SET, HBUF, P0, NP) do { pg8::MoeSched<false> S; \
        S.init(HBUF, MWd8, (NP), D, FFE, MOE_PEXP(SET) + 16, row_tok + (SET) * MAXPAN * 256, F.G, (int)blockIdx.x); S.p0 = (P0); \
        pg8::EpiMoeDown E{XB, row_tok + (SET) * MAXPAN * 256, row_gate + (SET) * MAXPAN * 256, 1.0f / MOE8_WSCALE_DN, (LAS int*)(F.lds + RING_BYTES + 4096)}; pg8::gemm_phase<pg8::EpiMoeDown, pg8::MoeSched<false>, true>(F.lds, FFE, S, E); } while (0)
    const int npA = __builtin_amdgcn_readfirstlane(panel[0]), npB = __builtin_amdgcn_readfirstlane(panel[160]);
    const int nB2 = npB < 64 ? npB : 64, nB1 = npB - nB2;
    if (IN(PH_GU_A)) { MOE_LOAD_PEXP(); MOE_GU8(0, MH8, 0, npA, 0, 0); }
    if (PROBE_DUP == 3 && IN(PH_GU_A)) MOE_GU8(0, MH8, 0, npA, 0, 0);
    SEAM(PH_GU_A);
    if (IN(PH_DN_A)) { MOE_LOAD_PEXP(); MOE_DN8(0, MH8, 0, npA);
        const int sx = (npA * (D / 256)) % F.G;
        if (nB1 > 0) MOE_GU8(1, MH8b, 0, nB1, sx, sx ? 3 : 0); }
    SEAM(PH_DN_A);
    if (IN(PH_GU_B)) { MOE_LOAD_PEXP(); if (nB1 > 0) MOE_DN8(1, MH8b, 0, nB1);
        const int sx = (nB1 * (D / 256)) % F.G;
        MOE_GU8(1, MH8b, nB1, nB2, sx, sx ? 3 : 0); }
    SEAM(PH_GU_B);
    if (IN(PH_DN_B)) { MOE_LOAD_PEXP(); MOE_DN8(1, MH8b, nB1, nB2); }
    SEAM(PH_DN_B);
#else
    MOE_SET(0, PH_GU_A, PH_DN_A)
    MOE_SET(1, PH_GU_B, PH_DN_B)
#endif

    if (IN(PH_FIN)) for (int rep = 0; rep < (PROBE_DUP == 7 ? 2 : 1); ++rep) {
        const float* gf = args.in[I_NORM_FINAL];
        f32x4 gq[2][2];
#pragma unroll
        for (int jj = 0; jj < 2; ++jj) { gq[jj][0] = *((const f32x4*)(gf + 512 * jj + 8 * F.lane)); gq[jj][1] = *((const f32x4*)(gf + 512 * jj + 8 * F.lane + 4)); }
        for (int m = F.gw; m < NTOK; m += F.NGW) {
            const GAS u32x4* xr = (const GAS u32x4*)(XB + (size_t)m * D) + F.lane; float v[2][8]; float s = 0.f;
#pragma unroll
            for (int jj = 0; jj < 2; ++jj) { unpack8(xr[64 * jj], v[jj]);
#pragma unroll
                for (int q = 0; q < 8; ++q) s += v[jj][q] * v[jj][q]; }
            const float rs = 1.0f / sqrtf(wave_sum(s) * (1.0f / D) + RMS_EPS);
#pragma unroll
            for (int jj = 0; jj < 2; ++jj) { const f32x4 g0 = gq[jj][0], g1 = gq[jj][1];
                GAS f32x4* o = (GAS f32x4*)(args.out + (size_t)m * D + 512 * jj + 8 * F.lane);
                o[0] = (f32x4){v[jj][0] * rs * g0.x, v[jj][1] * rs * g0.y, v[jj][2] * rs * g0.z, v[jj][3] * rs * g0.w}; o[1] = (f32x4){v[jj][4] * rs * g1.x, v[jj][5] * rs * g1.y, v[jj][6] * rs * g1.z, v[jj][7] * rs * g1.w}; }
        }
    }
#undef IN
#undef SEAM
}

extern "C" void kernel_launch(void* const* d_in, const int* in_sizes, int n_in, void* d_out, int out_size, void* d_ws, size_t ws_size, hipStream_t stream) {
    static int grid = 0;
    if (grid == 0) {
        if (n_in != NIN || in_sizes[0] != NTOK * D || out_size != NTOK * D || ws_size < WS_END) {
            fprintf(stderr, "kernel_launch: unexpected shapes: n_in %d in0 %d out %d ws %zu (need %zu); nothing launched\n", n_in, n_in > 0 ? in_sizes[0] : -1, out_size, ws_size, (size_t)WS_END); grid = -1; return; }
        int dev = 0, cus = 0, per_cu = 0;
        if (hipGetDevice(&dev) != hipSuccess || hipDeviceGetAttribute(&cus, hipDeviceAttributeMultiprocessorCount, dev) != hipSuccess) { grid = -1; return; }
        if (hipFuncSetAttribute((const void*)fwd, hipFuncAttributeMaxDynamicSharedMemorySize, LDS_BYTES) != hipSuccess) { fprintf(stderr, "kernel_launch: hipFuncSetAttribute failed\n"); grid = -1; return; }
        if (hipOccupancyMaxActiveBlocksPerMultiprocessor(&per_cu, (const void*)fwd, 512, LDS_BYTES) != hipSuccess || per_cu < 1) { fprintf(stderr, "kernel_launch: occupancy query says %d\n", per_cu); }
        (void)hipGetLastError();
        grid = cus;
    }
    if (grid < 0) return;
    if (hipMemsetAsync((char*)d_ws + WS_CTL, 0, CTL_ZERO_BYTES, stream) != hipSuccess) return;
    Args a{};
    for (int i = 0; i < NIN; ++i) a.in[i] = (const float*)d_in[i];
    a.out = (float*)d_out; a.ws = (unsigned char*)d_ws;
#if MK_PER_PHASE
    for (int ph = 0; ph < PH_COUNT; ++ph) { a.ph_lo = ph; a.ph_hi = ph + 1; hipLaunchKernelGGL(fwd, dim3(grid), dim3(512), LDS_BYTES, stream, a); }
#else
    a.ph_lo = 0; a.ph_hi = PH_COUNT; hipLaunchKernelGGL(fwd, dim3(grid), dim3(512), LDS_BYTES, stream, a);
#endif
}
```

```cpp
#include <hip/hip_runtime.h>
#include <cstdio>
#include <cstdint>

#ifndef MK_PER_PHASE
#define MK_PER_PHASE 0
#endif

#ifndef REP_M1
#define REP_M1 1
#endif
#ifndef REP_M2
#define REP_M2 1
#endif
#ifndef REP_M3
#define REP_M3 1
#endif
#ifndef REP_GU
#define REP_GU 1
#endif
#ifndef REP_CH
#define REP_CH 1
#endif
#ifndef PROBE_STAGE
#define PROBE_STAGE 0
#endif
#ifndef REP_CV
#define REP_CV 1
#endif
#ifndef REP_EPI
#define REP_EPI 1
#endif
#ifndef REP_G3
#define REP_G3 1
#endif
#ifndef PROBE_DUP
#define PROBE_DUP 0
#endif
#ifndef STAGGER_TICKS
#define STAGGER_TICKS 0
#endif
#ifndef DEFER_CONVERT
#define DEFER_CONVERT 1
#endif
#ifndef DBG_VAR
#define DBG_VAR 0
#endif
#ifndef MOE8_GU
#define MOE8_GU 1
#endif
#ifndef MOE8_DN
#define MOE8_DN 1
#endif
#ifndef MIX_MODE
#define MIX_MODE 0
#endif
#define GAS __attribute__((address_space(1)))
#define LAS __attribute__((address_space(3)))
typedef unsigned short bf16;
typedef unsigned short bf16_t;
typedef short bf16x8 __attribute__((ext_vector_type(8)));
typedef float f32x4 __attribute__((ext_vector_type(4)));
typedef float f32x2 __attribute__((ext_vector_type(2)));
typedef unsigned u32x4 __attribute__((ext_vector_type(4)));
typedef unsigned u32x2 __attribute__((ext_vector_type(2)));
typedef GAS unsigned gu32;

constexpr int NTOK = 32768, SEQ = 4096, NB = 8, D = 1024, INW = 2816, FF = 2816, FFE = 3584, NE = 8;
constexpr int GMW = 512, RWW = 512, NH = 8, HD = 64, GCH = 128;
constexpr float RMS_EPS = 1e-6f, LN_EPS = 1e-5f, GN_EPS = 64e-5f;
constexpr int MAXPAN = 136;

constexpr size_t MiB = 1u << 20;
constexpr size_t WS_CTL = 0, CTL_ZERO_BYTES = 2 * MiB;
constexpr size_t WS_WIN = 2 * MiB;
constexpr size_t WS_WOUT = 13 * MiB;
constexpr size_t WS_WGU = 17 * MiB;
constexpr size_t WS_WD = 28 * MiB;
constexpr size_t WS_MISC = 34 * MiB;
constexpr size_t WS_SMALLW = 36 * MiB;
constexpr size_t SW_WUP = 0, SW_AUP = 128 * 1024, SW_GUP = 256 * 1024, SW_WS = 512 * 1024;
constexpr size_t WS_XB = 38 * MiB;
constexpr size_t WS_R = 102 * MiB;
constexpr size_t WS_P = WS_R;
constexpr size_t WS_Y = WS_R + 176 * MiB;
constexpr size_t WS_SCR = WS_R + 240 * MiB;
constexpr size_t WS_MOEW_GU = WS_R;
constexpr size_t WS_MOEW_D = WS_R + 112 * MiB;
constexpr size_t WS_MOEH = WS_R + 168 * MiB;
constexpr size_t WS_MOEW8_GU = WS_R;
constexpr size_t WS_MOEW8_D = WS_R + 56 * MiB;
constexpr size_t WS_XB8 = WS_R + 112 * MiB;
constexpr float MOE8_WSCALE_GU = 64.f, MOE8_WSCALE_DN = 128.f;
constexpr size_t WS_SSQP = WS_R + 400 * MiB;
constexpr size_t WS_END = WS_R + 408 * MiB;
static_assert(WS_MOEH + (size_t)MAXPAN * 256 * FFE * 2 <= WS_END, "moe hidden fits");
static_assert(WS_WIN + (size_t)2 * INW * D * 2 <= WS_WOUT && WS_WGU + (size_t)2 * FF * D * 2 <= WS_WD && WS_WD + (size_t)D * FF * 2 <= WS_MISC, "weights fit");
constexpr int CW_TMO = 0;
constexpr int CW_BAR = 4096;
constexpr int CW_HND = 8192;
constexpr int CW_SSQ = 65536;
static_assert((CW_SSQ + 4 * NTOK) * 4 <= (int)CTL_ZERO_BYTES, "ctl fits");
constexpr size_t MS_TOKE = 0;
constexpr size_t MS_TOKG = 256 * 1024;
constexpr size_t MS_RS = 512 * 1024;
constexpr size_t MS_BCNT = 640 * 1024;
constexpr size_t MS_ROWTOK = 704 * 1024;
constexpr size_t MS_ROWGATE = 1024 * 1024;
constexpr size_t MS_PANEL = 1344 * 1024;
constexpr size_t MS_ROWRS = 1408 * 1024;
static_assert(MS_ROWTOK + 2 * MAXPAN * 256 * 4 <= MS_ROWGATE && MS_ROWGATE + 2 * MAXPAN * 256 * 4 <= MS_PANEL && MS_PANEL + 2 * 160 * 4 <= MS_ROWRS && MS_ROWRS + 2 * MAXPAN * 256 * 4 <= 2 * MiB, "misc fits");

constexpr int RING_BYTES = 131072;
constexpr int LDS_BYTES = 147456;
constexpr int MISC_OFF = LDS_BYTES - 128;

#define LDS_WAIT() asm volatile("s_waitcnt lgkmcnt(0)" ::: "memory")
#define VM_WAIT() asm volatile("s_waitcnt vmcnt(0)" ::: "memory")
#define RLX_AGENT __ATOMIC_RELAXED, __HIP_MEMORY_SCOPE_AGENT
#define LDS_BARRIER() do { asm volatile("s_waitcnt lgkmcnt(0)" ::: "memory"); __builtin_amdgcn_s_barrier(); asm volatile("" ::: "memory"); } while (0)

__device__ __forceinline__ unsigned f2bf(float f) { unsigned u = __builtin_bit_cast(unsigned, f); return (u + 0x7fffu + ((u >> 16) & 1u)) >> 16; }
__device__ __forceinline__ unsigned pk2(float lo, float hi) { return f2bf(lo) | (f2bf(hi) << 16); }
__device__ __forceinline__ float bf2f(bf16 b) { return __builtin_bit_cast(float, (unsigned)b << 16); }
__device__ __forceinline__ unsigned cvt_pk_bf16(float lo, float hi) { unsigned r; asm volatile("v_cvt_pk_bf16_f32 %0, %1, %2" : "=v"(r) : "v"(lo), "v"(hi)); return r; }
__device__ __forceinline__ unsigned pk4_fp8(float a, float b, float c, float d) { int v = __builtin_amdgcn_cvt_pk_fp8_f32(a, b, 0, false); v = __builtin_amdgcn_cvt_pk_fp8_f32(c, d, v, true); return (unsigned)v; }
__device__ __forceinline__ float wave_sum(float v) {
#pragma unroll
    for (int o = 1; o < 64; o <<= 1) v += __shfl_xor(v, o);
    return v;
}
__device__ __forceinline__ float gelu_erf(float v) { return 0.5f * v * (1.0f + erff(v * 0.70710678f)); }
__device__ __forceinline__ float sigmoidf_(float v) { return 1.0f / (1.0f + __expf(-v)); }
__device__ __forceinline__ float silu_f(float v) { return v * __builtin_amdgcn_rcpf(1.0f + __expf(-v)); }

__device__ __forceinline__ f32x2 swiglu2(f32x2 g, f32x2 u, float rs) {
    const float c1 = rs * (-1.44269504f), ic2 = rs != 0.f ? __builtin_amdgcn_rcpf(rs * rs) : 1.0e30f;
    const f32x2 a = g * c1, p = g * u;
    f32x2 e; e.x = __builtin_amdgcn_exp2f(a.x); e.y = __builtin_amdgcn_exp2f(a.y);
    const f32x2 d = e * ic2 + ic2; f32x2 r; r.x = __builtin_amdgcn_rcpf(d.x); r.y = __builtin_amdgcn_rcpf(d.y);
    return p * r;
}
namespace pg8 {
constexpr int BM = 256, BK = 64, HALF = 128, HTB = HALF * BK * 2, STAGE_BYTES = 8 * HTB, NXCD = 8, WGM = 8;
__host__ __device__ __forceinline__ int lds_byte(int r, int c) { const int st = (r >> 4) * 2 + (c >> 5), rr = r & 15, cc = c & 31, ob = rr * 64 + cc * 2; return st * 1024 + (ob ^ (((ob >> 9) & 1) << 5)); }
__host__ __device__ __forceinline__ void stage_rc(int b, int& R, int& C) { const int st = b / 1024, sb = b % 1024, swz = sb ^ (((sb >> 9) & 1) << 5); R = (st >> 1) * 16 + swz / 64; C = (st & 1) * 32 + (swz % 64) / 2; }
__host__ __device__ __forceinline__ int perm32(int rho) { const int n = rho >> 4, i = rho & 15; return 8 * (i >> 2) + 4 * n + (i & 3); }

struct Unit { int pm, pn, aux; };

struct TileOrder {
    int nM, nN, nwg, G, c, sx, sr;
    __device__ void init(int nM_, int nN_, int G_, int c_) { nM = nM_; nN = nN_; nwg = nM * nN; G = G_; c = c_; sx = 0; sr = 0; }
    __device__ bool tile(int i, int& pm, int& pn) const {
        long L;
        if (sx == 0) L = (long)i * G + c;
        else if (c < sx) L = (long)sr * (G - sx) + (long)i * G + c;
        else L = i < sr ? (long)i * (G - sx) + (c - sx) : (long)sr * (G - sx) + (long)(i - sr) * G + c;
        if (L >= nwg) return false;
        int wgid = (int)L; { const int q = nwg / NXCD, r = nwg % NXCD, xcd = wgid % NXCD, off = wgid / NXCD; wgid = (xcd < r ? xcd * (q + 1) : r * (q + 1) + (xcd - r) * q) + off; }
        const int nig = WGM * nN, gid = wgid / nig, fm = gid * WGM, gsz = (nM - fm) < WGM ? (nM - fm) : WGM;
        pm = fm + ((wgid % nig) % gsz); pn = (wgid % nig) / gsz; return true;
    }
};
struct DenseSched {
    static constexpr bool GATHER = false;
    TileOrder T; const char* A; const char* Bt; size_t tstep;
    __device__ void init(const void* A_, const void* Bt_, int M, int N, int KB  , int G, int c) { T.init(M / BM, N / BM, G, c); A = (const char*)A_; Bt = (const char*)Bt_; tstep = (size_t)BM * KB; }
    __device__ __forceinline__ bool next(int i, Unit& u) const { u.aux = 0; return T.tile(i, u.pm, u.pn); }
    __device__ __forceinline__ const char* a_ptr(const Unit& u) const { return A + (size_t)u.pm * tstep; }
    __device__ __forceinline__ const char* b_ptr(const Unit& u) const { return Bt + (size_t)u.pn * tstep; }
    __device__ __forceinline__ void gather(const Unit&, int, int, int, int, int, unsigned (&)[2][2]) const {}
};
template <bool GATHER_> struct MoeSched {
    static constexpr bool GATHER = GATHER_;
    TileOrder T; const char* A; const char* Bt; size_t a_tstep, b_tstep, b_estep; const LAS int* pexp; const int* row_tok; int KB; int p0 = 0;
    __device__ void init(const void* A_, const void* Bt_, int npanels, int N, int KB_  , const LAS int* pexp_, const int* row_tok_, int G, int c) {
        T.init(npanels, N / BM, G, c); A = (const char*)A_; Bt = (const char*)Bt_; KB = KB_; a_tstep = (size_t)BM * KB_; b_tstep = (size_t)BM * KB_; b_estep = (size_t)N * KB_; pexp = pexp_; row_tok = row_tok_; }
    __device__ __forceinline__ bool next(int i, Unit& u) const { if (!T.tile(i, u.pm, u.pn)) return false; u.pm += p0; u.aux = __builtin_amdgcn_readfirstlane(pexp[u.pm]); return true; }
    __device__ __forceinline__ const char* a_ptr(const Unit& u) const { return GATHER ? A : A + (size_t)u.pm * a_tstep; }
    __device__ __forceinline__ const char* b_ptr(const Unit& u) const { return Bt + (size_t)u.aux * b_estep + (size_t)u.pn * b_tstep; }
    __device__ __forceinline__ void gather(const Unit& u, int R0, int R1, int C0, int C1, int, unsigned (&v)[2][2]) const {
#pragma unroll
        for (int h = 0; h < 2; ++h) { int t0 = row_tok[u.pm * BM + h * HALF + R0], t1 = row_tok[u.pm * BM + h * HALF + R1]; t0 = t0 < 0 ? 0 : t0; t1 = t1 < 0 ? 0 : t1;
            v[h][0] = (unsigned)(t0 * KB + C0 * 2); v[h][1] = (unsigned)(t1 * KB + C1 * 2); }
    }
};

typedef int v4i_t __attribute__((ext_vector_type(4)));
typedef int v8i_t __attribute__((ext_vector_type(8)));
typedef short s16x16_t __attribute__((ext_vector_type(16)));
__device__ __forceinline__ v8i_t cat8(const bf16x8 lo, const bf16x8 hi) { const v4i_t a = __builtin_bit_cast(v4i_t, lo), b = __builtin_bit_cast(v4i_t, hi); return __builtin_shufflevector(a, b, 0, 1, 2, 3, 4, 5, 6, 7); }
template <class Epi, class Sched, bool FP8 = false>
__device__ __forceinline__ void gemm_phase(LAS unsigned char* lds, const int KB, const Sched& S, const Epi& E) {
    constexpr bool GATHER = Sched::GATHER;
    const int tid = threadIdx.x, wid = __builtin_amdgcn_readfirstlane(tid >> 6), lane = tid & 63, wr = wid >> 2, wc = wid & 3, fr = lane & 15, fq = lane >> 4;
    const int nt = KB / 128;
    unsigned voffA[2], voffB[2], voffBa[2][2]; int sR[2], sC[2];
#pragma unroll
    for (int i = 0; i < 2; ++i) { int R, C; stage_rc(tid * 16 + i * 8192, R, C); const int Rb = Epi::PERM ? ((R & ~31) + perm32(R & 31)) : R; sR[i] = R; sC[i] = C;
        voffA[i] = (unsigned)(R * KB + C * 2); voffB[i] = (unsigned)(Rb * KB + C * 2);
        voffBa[0][i] = (unsigned)((64 * (R >> 5) + perm32(R & 31)) * KB + C * 2); voffBa[1][i] = (unsigned)((64 * (R >> 5) + 32 + perm32(R & 31)) * KB + C * 2); }
    const size_t kstep = (size_t)(BK * 2);
    const size_t hstep = (size_t)HALF * KB;
    const unsigned ldsw = (unsigned)wid * 1024u;
    const int aoff = lds_byte(wr * 64 + fr, fq * 8), boff = lds_byte(wc * 32 + fr, fq * 8);
    const int aoff8 = lds_byte(wr * 64 + fr, (fq >> 1) * 32 + (fq & 1) * 16) & ~31, boff8 = lds_byte(wc * 32 + fr, (fq >> 1) * 32 + (fq & 1) * 16) & ~31;
#define PG8_SA(b, h) (((b) * 2 + (h)) * HTB)
#define PG8_SB(b, h) ((4 + (b) * 2 + (h)) * HTB)
#define PG8_STAGE(bufoff, gbase, voff) do { _Pragma("unroll") for (int _i = 0; _i < 2; ++_i) \
        __builtin_amdgcn_global_load_lds((const unsigned*)((const char*)(gbase) + (voff)[_i]), (LAS unsigned*)(lds + (bufoff) + ldsw + _i * 8192), 16, 0, 0); } while (0)
#define PG8_STAGE_B(bufoff, kptr, half) do { if constexpr (Epi::ADJ) { PG8_STAGE(bufoff, kptr, voffBa[half]); } else { PG8_STAGE(bufoff, (kptr) + (half) * hstep, voffB); } } while (0)
#define PG8_STAGE_A(bufoff, kptr, half, VG) do { if constexpr (GATHER) { PG8_STAGE(bufoff, kptr, (VG)[half]); } else { PG8_STAGE(bufoff, (kptr) + (half) * hstep, voffA); } } while (0)
#define PG8_LDA(dst, b, h) do { if constexpr (FP8) { _Pragma("unroll") for (int m = 0; m < 4; ++m) dst##8[m] = cat8(*(const LAS bf16x8*)(lds + PG8_SA(b, h) + aoff8 + m * 2048), *(const LAS bf16x8*)(lds + PG8_SA(b, h) + aoff8 + m * 2048 + 16)); } \
        else { _Pragma("unroll") for (int m = 0; m < 4; ++m) _Pragma("unroll") for (int k = 0; k < 2; ++k) dst[m][k] = *(const LAS bf16x8*)(lds + PG8_SA(b, h) + aoff + m * 2048 + k * 1024); } } while (0)
#define PG8_LDB(dst, b, h) do { if constexpr (FP8) { _Pragma("unroll") for (int n = 0; n < 2; ++n) dst##8[n] = cat8(*(const LAS bf16x8*)(lds + PG8_SB(b, h) + boff8 + n * 2048), *(const LAS bf16x8*)(lds + PG8_SB(b, h) + boff8 + n * 2048 + 16)); } \
        else { _Pragma("unroll") for (int n = 0; n < 2; ++n) _Pragma("unroll") for (int k = 0; k < 2; ++k) dst[n][k] = *(const LAS bf16x8*)(lds + PG8_SB(b, h) + boff + n * 2048 + k * 1024); } } while (0)
#define PG8_MMA(ai, bj, At, Bt) do { __builtin_amdgcn_s_setprio(1); if constexpr (FP8) { _Pragma("unroll") for (int m = 0; m < 4; ++m) _Pragma("unroll") for (int n = 0; n < 2; ++n) \
        asm volatile("v_mfma_scale_f32_16x16x128_f8f6f4 %0, %1, %2, %0, %3, %4 op_sel_hi:[0,0,0]" : "+v"(acc[ai][bj][m][n]) : "v"(Bt##8[n]), "v"(At##8[m]), "v"(sc8w), "v"(sc8)); } \
        else { _Pragma("unroll") for (int k = 0; k < 2; ++k) _Pragma("unroll") for (int m = 0; m < 4; ++m) _Pragma("unroll") for (int n = 0; n < 2; ++n) \
        asm volatile("v_mfma_f32_16x16x32_bf16 %0, %1, %2, %0" : "+v"(acc[ai][bj][m][n]) : "v"(Bt[n][k]), "v"(At[m][k])); } __builtin_amdgcn_s_setprio(0); } while (0)
#define PG8_MMA0(ai, bj, At, Bt) do { __builtin_amdgcn_s_setprio(1); if constexpr (FP8) { _Pragma("unroll") for (int m = 0; m < 4; ++m) _Pragma("unroll") for (int n = 0; n < 2; ++n) \
        asm volatile("v_mfma_scale_f32_16x16x128_f8f6f4 %0, %1, %2, 0, %3, %4 op_sel_hi:[0,0,0]" : "=v"(acc[ai][bj][m][n]) : "v"(Bt##8[n]), "v"(At##8[m]), "v"(sc8w), "v"(sc8)); } \
        else { _Pragma("unroll") for (int m = 0; m < 4; ++m) _Pragma("unroll") for (int n = 0; n < 2; ++n) \
        asm volatile("v_mfma_f32_16x16x32_bf16 %0, %1, %2, 0" : "=v"(acc[ai][bj][m][n]) : "v"(Bt[n][0]), "v"(At[m][0])); \
        _Pragma("unroll") for (int m = 0; m < 4; ++m) _Pragma("unroll") for (int n = 0; n < 2; ++n) \
        asm volatile("v_mfma_f32_16x16x32_bf16 %0, %1, %2, %0" : "+v"(acc[ai][bj][m][n]) : "v"(Bt[n][1]), "v"(At[m][1])); } __builtin_amdgcn_s_setprio(0); } while (0)
#define PG8_WAIT_V(n) asm volatile("s_waitcnt vmcnt(" #n ")" ::: "memory")
#define PG8_WAIT_L(n) asm volatile("s_waitcnt lgkmcnt(" #n ")" ::: "memory")
#define PG8_BAR __builtin_amdgcn_s_barrier()
#define PG8_SCHED __builtin_amdgcn_sched_barrier(0)
    Unit cur, nxt; int ui = 0;
    if (!S.next(0, cur)) return;
    f32x4 acc[2][2][4][2];
#pragma unroll
    for (int a = 0; a < 2; ++a)
#pragma unroll
        for (int b = 0; b < 2; ++b)
#pragma unroll
            for (int m = 0; m < 4; ++m)
#pragma unroll
                for (int n = 0; n < 2; ++n) asm volatile("" : "=v"(acc[a][b][m][n]));
    bf16x8 At[4][2], B0[2][2], B1[2][2]; v8i_t At8[4], B08[2], B18[2]; const int sc8 = 0x7f7f7f7f; int sc8w = 0x7f7f7f7f; if constexpr (FP8) sc8w = Epi::SCW;
    const char* cA = S.a_ptr(cur); const char* cB = S.b_ptr(cur);
    unsigned vcur[2][2] = {{0u, 0u}, {0u, 0u}}, vnext[2][2] = {{0u, 0u}, {0u, 0u}}, vt2[2][2] = {{0u, 0u}, {0u, 0u}};
    if constexpr (GATHER) S.gather(cur, sR[0], sR[1], sC[0], sC[1], 0, vcur);
    PG8_STAGE_B(PG8_SB(0, 0), cB, 0); PG8_STAGE_B(PG8_SB(0, 1), cB, 1); PG8_STAGE_A(PG8_SA(0, 0), cA, 0, vcur); PG8_STAGE_A(PG8_SA(0, 1), cA, 1, vcur);
    if (wr == 1) PG8_BAR;
    PG8_WAIT_V(2); PG8_BAR;
    PG8_STAGE_B(PG8_SB(1, 0), cB + kstep, 0); PG8_STAGE_A(PG8_SA(1, 0), cA + kstep, 0, vcur); PG8_STAGE_B(PG8_SB(1, 1), cB + kstep, 1);
    PG8_WAIT_V(6); PG8_BAR;
    for (;;) {
        const bool has_next = S.next(ui + 1, nxt);
        const char* nA = has_next ? S.a_ptr(nxt) : cA; const char* nB = has_next ? S.b_ptr(nxt) : cB;
        if constexpr (GATHER) { if (has_next) S.gather(nxt, sR[0], sR[1], sC[0], sC[1], 0, vnext); else {
#pragma unroll
            for (int h = 0; h < 2; ++h) { vnext[h][0] = vcur[h][0]; vnext[h][1] = vcur[h][1]; } } }
#define PG8_KITER(t, MM) do { \
            const bool last = (t == nt - 2); \
            const char* a1 = cA + (size_t)(t + 1) * kstep; \
            const char* a2 = last ? nA : cA + (size_t)(t + 2) * kstep; const char* b2 = last ? nB : cB + (size_t)(t + 2) * kstep; \
            const char* a3 = a2 + kstep; const char* b3 = b2 + kstep; \
            if constexpr (GATHER) { \
            _Pragma("unroll") \
                for (int h = 0; h < 2; ++h) { vt2[h][0] = last ? vnext[h][0] : vcur[h][0]; vt2[h][1] = last ? vnext[h][1] : vcur[h][1]; } } \
            PG8_LDB(B0, 0, 0); PG8_LDB(B1, 0, 1); PG8_SCHED; PG8_LDA(At, 0, 0); PG8_STAGE_A(PG8_SA(1, 1), a1, 1, vcur); \
            PG8_WAIT_V(8); PG8_WAIT_L(0); PG8_BAR; MM(0, 0, At, B0); MM(0, 1, At, B1); PG8_BAR; PG8_SCHED; \
            PG8_LDA(At, 0, 1); PG8_STAGE_B(PG8_SB(0, 0), b2, 0); PG8_STAGE_B(PG8_SB(0, 1), b2, 1); PG8_STAGE_A(PG8_SA(0, 0), a2, 0, vt2); \
            PG8_WAIT_V(8); PG8_WAIT_L(0); PG8_BAR; MM(1, 0, At, B0); MM(1, 1, At, B1); PG8_BAR; PG8_SCHED; \
            PG8_LDB(B0, 1, 0); PG8_LDB(B1, 1, 1); PG8_SCHED; PG8_LDA(At, 1, 0); PG8_STAGE_A(PG8_SA(0, 1), a2, 1, vt2); \
            PG8_WAIT_V(8); PG8_WAIT_L(0); PG8_BAR; PG8_MMA(0, 0, At, B0); PG8_MMA(0, 1, At, B1); PG8_BAR; PG8_SCHED; \
            PG8_LDA(At, 1, 1); PG8_STAGE_B(PG8_SB(1, 0), b3, 0); PG8_STAGE_B(PG8_SB(1, 1), b3, 1); PG8_STAGE_A(PG8_SA(1, 0), a3, 0, vt2); \
            PG8_WAIT_V(8); PG8_WAIT_L(0); PG8_BAR; PG8_MMA(1, 0, At, B0); PG8_MMA(1, 1, At, B1); PG8_BAR; PG8_SCHED; \
        } while (0)
        { const int t = 0; PG8_KITER(t, PG8_MMA0); }
        for (int t = 2; t < nt; t += 2) { PG8_KITER(t, PG8_MMA); }
#undef PG8_KITER
        if (wr == 0) PG8_BAR;
        asm volatile("s_nop 15\n\ts_nop 15" ::: "memory");
        for (int rp_ = 0; rp_ < Epi::REPS; ++rp_) E(acc, cur, wr, wc, fr, fq);
        if (!has_next) break;
        cur = nxt; cA = nA; cB = nB; ++ui;
        if constexpr (GATHER) {
#pragma unroll
            for (int h = 0; h < 2; ++h) { vcur[h][0] = vnext[h][0]; vcur[h][1] = vnext[h][1]; } }
        if (wr == 1) PG8_BAR;
    }
    PG8_WAIT_V(0);
    PG8_BAR;
#undef PG8_SA
#undef PG8_SB
#undef PG8_STAGE
#undef PG8_STAGE_A
#undef PG8_STAGE_B
#undef PG8_LDA
#undef PG8_LDB
#undef PG8_MMA
#undef PG8_MMA0
#undef PG8_WAIT_V
#undef PG8_WAIT_L
#undef PG8_BAR
#undef PG8_SCHED
}

__device__ __forceinline__ void store_lines(unsigned char* rowbase  , size_t pitch, int fr, int fq, const u32x4 w0, const u32x4 w1) {
    const bool lo = fr < 8; const u32x4 snd = lo ? w1 : w0; u32x4 rcv;
    rcv.x = __shfl_xor(snd.x, 8); rcv.y = __shfl_xor(snd.y, 8); rcv.z = __shfl_xor(snd.z, 8); rcv.w = __shfl_xor(snd.w, 8);
    unsigned char* p = rowbase + (size_t)(fr & 7) * pitch + (lo ? 0 : 64) + 16 * fq;
    *(u32x4*)p = lo ? w0 : rcv;
    *(u32x4*)(p + 8 * pitch) = lo ? rcv : w1;
}
template <int NP> __device__ __forceinline__ float row_rs(const float* ssq, int row) {
    float s;
    if constexpr (NP == 1) s = ssq[row];
    else { const f32x4* p = (const f32x4*)(ssq + (size_t)row * 16); const f32x4 a = p[0], b = p[1], c = p[2], d = p[3];
        s = (((a[0] + a[1]) + (a[2] + a[3])) + ((b[0] + b[1]) + (b[2] + b[3]))) + (((c[0] + c[1]) + (c[2] + c[3])) + ((d[0] + d[1]) + (d[2] + d[3]))); }
    return __builtin_amdgcn_rsqf(s * (1.0f / D) + RMS_EPS);
}
__device__ __forceinline__ void panel_rs_to_lds(const float* ssq, int pm, LAS float* rsl) {
    if (threadIdx.x < 256) rsl[threadIdx.x] = row_rs<16>(ssq, pm * 256 + (int)threadIdx.x);
    asm volatile("s_waitcnt lgkmcnt(0)" ::: "memory"); __builtin_amdgcn_s_barrier(); asm volatile("" ::: "memory");
}
template <int NP> struct EpiScaleBf16 {
    static constexpr bool PERM = true; static constexpr bool ADJ = true; static constexpr int REPS = 1;
    bf16_t* O; int ldc; const float* ssq; LAS float* rsl;
    __device__ __forceinline__ void operator()(const f32x4 (&acc)[2][2][4][2], const Unit& u, int wr, int wc, int fr, int fq) const {
        const int rowg = u.pm * BM + wr * 64, colw = u.pn * BM + wc * 64;
        if constexpr (NP == 16) panel_rs_to_lds(ssq, u.pm, rsl);
#pragma unroll
        for (int ai = 0; ai < 2; ++ai)
#pragma unroll
            for (int m = 0; m < 4; ++m) { const int row = rowg + ai * HALF + m * 16 + fr; float rs; if constexpr (NP == 16) rs = rsl[wr * 64 + ai * HALF + m * 16 + fr]; else rs = row_rs<NP>(ssq, row);
                u32x4 w[2];
#pragma unroll
                for (int bj = 0; bj < 2; ++bj) { const f32x4 v0 = acc[ai][bj][m][0] * rs, v1 = acc[ai][bj][m][1] * rs;
                    w[bj].x = cvt_pk_bf16(v0[0], v0[1]); w[bj].y = cvt_pk_bf16(v0[2], v0[3]); w[bj].z = cvt_pk_bf16(v1[0], v1[1]); w[bj].w = cvt_pk_bf16(v1[2], v1[3]); }
                store_lines((unsigned char*)(O + (size_t)(rowg + ai * HALF + m * 16) * ldc + colw), (size_t)ldc * 2, fr, fq, w[0], w[1]); }
    }
};
template <bool SSQ, bool BASE32> struct EpiResid {
    static constexpr bool PERM = true; static constexpr bool ADJ = true; static constexpr int REPS = 1;
    const float* base32; bf16_t* xb; float* ssq;
    __device__ __forceinline__ void operator()(const f32x4 (&acc)[2][2][4][2], const Unit& u, int wr, int wc, int fr, int fq) const {
        const int rowg = u.pm * BM + wr * 64, colw = u.pn * BM + wc * 64;
#pragma unroll
        for (int ai = 0; ai < 2; ++ai) {
            float bs[4][2][8];
#pragma unroll
            for (int m = 0; m < 4; ++m)
#pragma unroll
                for (int bj = 0; bj < 2; ++bj) { const size_t off = (size_t)(rowg + ai * HALF + m * 16 + fr) * D + colw + 32 * bj + 8 * fq;
                    if constexpr (BASE32) { const f32x4 a = *(const f32x4*)(base32 + off), b = *(const f32x4*)(base32 + off + 4);
                        bs[m][bj][0] = a[0]; bs[m][bj][1] = a[1]; bs[m][bj][2] = a[2]; bs[m][bj][3] = a[3]; bs[m][bj][4] = b[0]; bs[m][bj][5] = b[1]; bs[m][bj][6] = b[2]; bs[m][bj][7] = b[3]; }
                    else { const u32x4 r = *(const u32x4*)(xb + off);
                        bs[m][bj][0] = __builtin_bit_cast(float, r.x << 16); bs[m][bj][1] = __builtin_bit_cast(float, r.x & 0xffff0000u); bs[m][bj][2] = __builtin_bit_cast(float, r.y << 16); bs[m][bj][3] = __builtin_bit_cast(float, r.y & 0xffff0000u);
                        bs[m][bj][4] = __builtin_bit_cast(float, r.z << 16); bs[m][bj][5] = __builtin_bit_cast(float, r.z & 0xffff0000u); bs[m][bj][6] = __builtin_bit_cast(float, r.w << 16); bs[m][bj][7] = __builtin_bit_cast(float, r.w & 0xffff0000u); } }
            asm volatile("" ::: "memory");
#pragma unroll
            for (int m = 0; m < 4; ++m) { const int row = rowg + ai * HALF + m * 16 + fr; float s = 0.f; u32x4 w[2];
#pragma unroll
                for (int bj = 0; bj < 2; ++bj) { float o[8];
#pragma unroll
                    for (int n = 0; n < 2; ++n)
#pragma unroll
                        for (int j = 0; j < 4; ++j) o[n * 4 + j] = bs[m][bj][n * 4 + j] + acc[ai][bj][m][n][j];
                    w[bj].x = cvt_pk_bf16(o[0], o[1]); w[bj].y = cvt_pk_bf16(o[2], o[3]); w[bj].z = cvt_pk_bf16(o[4], o[5]); w[bj].w = cvt_pk_bf16(o[6], o[7]);
                    if constexpr (SSQ) { const unsigned ww[4] = {w[bj].x, w[bj].y, w[bj].z, w[bj].w};
#pragma unroll
                        for (int q = 0; q < 4; ++q) { const float r0 = __builtin_bit_cast(float, ww[q] << 16), r1 = __builtin_bit_cast(float, ww[q] & 0xffff0000u); s += r0 * r0 + r1 * r1; } } }
                store_lines((unsigned char*)(xb + (size_t)(rowg + ai * HALF + m * 16) * D + colw), (size_t)D * 2, fr, fq, w[0], w[1]);
                if constexpr (SSQ) { s += __shfl_xor(s, 16); s += __shfl_xor(s, 32);
                    if (fq == 0) ssq[(size_t)row * 16 + u.pn * 4 + wc] = s; } }
            asm volatile("" ::: "memory"); }
    }
};
template <int NP> struct EpiSwiglu {
    static constexpr bool PERM = true; static constexpr bool ADJ = false; static constexpr int REPS = REP_EPI;
    bf16_t* O; int ldc; const float* ssq; LAS float* rsl;
    __device__ __forceinline__ void operator()(const f32x4 (&acc)[2][2][4][2], const Unit& u, int wr, int wc, int fr, int fq) const {
        const int row0 = u.pm * BM + wr * 64 + fr, col0 = u.pn * HALF + wc * 32 + 8 * fq;
        if constexpr (NP == 16) panel_rs_to_lds(ssq, u.pm, rsl);
#pragma unroll
        for (int ai = 0; ai < 2; ++ai)
#pragma unroll
            for (int m = 0; m < 4; ++m) { const int row = row0 + ai * HALF + m * 16; float rs; if constexpr (NP == 16) rs = rsl[wr * 64 + fr + ai * HALF + m * 16]; else rs = row_rs<NP>(ssq, row);
                float h[8];
#pragma unroll
                for (int n = 0; n < 2; ++n)
#pragma unroll
                    for (int j = 0; j < 4; j += 2) { const f32x2 hh = swiglu2((f32x2){acc[ai][0][m][n][j], acc[ai][0][m][n][j + 1]}, (f32x2){acc[ai][1][m][n][j], acc[ai][1][m][n][j + 1]}, rs); h[n * 4 + j] = hh.x; h[n * 4 + j + 1] = hh.y; }
                u32x4 w; w.x = cvt_pk_bf16(h[0], h[1]); w.y = cvt_pk_bf16(h[2], h[3]); w.z = cvt_pk_bf16(h[4], h[5]); w.w = cvt_pk_bf16(h[6], h[7]);
                *(u32x4*)(O + (size_t)row * ldc + col0) = w; }
    }
};
struct EpiSwigluMoe {
    static constexpr bool PERM = true; static constexpr bool ADJ = false; static constexpr int REPS = 1; static constexpr int SCW = 0x7f7f7f7f;
    bf16_t* O; int ldc; const float* rsv; const int* row_tok; float wsinv;
    __device__ __forceinline__ void operator()(const f32x4 (&acc)[2][2][4][2], const Unit& u, int wr, int wc, int fr, int fq) const {
        const int row0 = u.pm * BM + wr * 64 + fr, col0 = u.pn * HALF + wc * 32 + 8 * fq;
#pragma unroll
        for (int ai = 0; ai < 2; ++ai)
#pragma unroll
            for (int m = 0; m < 4; ++m) { const int row = row0 + ai * HALF + m * 16; const int tok = row_tok[row]; const float rs = tok >= 0 ? rsv[tok] * wsinv : 0.f;
                float h[8];
#pragma unroll
                for (int n = 0; n < 2; ++n)
#pragma unroll
                    for (int j = 0; j < 4; j += 2) { const f32x2 hh = swiglu2((f32x2){acc[ai][0][m][n][j], acc[ai][0][m][n][j + 1]}, (f32x2){acc[ai][1][m][n][j], acc[ai][1][m][n][j + 1]}, rs); h[n * 4 + j] = hh.x; h[n * 4 + j + 1] = hh.y; }
                u32x4 w; w.x = cvt_pk_bf16(h[0], h[1]); w.y = cvt_pk_bf16(h[2], h[3]); w.z = cvt_pk_bf16(h[4], h[5]); w.w = cvt_pk_bf16(h[6], h[7]);
                *(u32x4*)(O + (size_t)row * ldc + col0) = w; }
    }
};
struct EpiSwigluMoe8 {
    static constexpr bool PERM = true; static constexpr bool ADJ = false; static constexpr int REPS = 1; static constexpr int SCW = 0x79797979;
    unsigned char* O; int ldc;
    __device__ __forceinline__ void operator()(const f32x4 (&acc)[2][2][4][2], const Unit& u, int wr, int wc, int fr, int fq) const {
        const int row0 = u.pm * BM + wr * 64 + fr, col0 = u.pn * HALF + wc * 32 + 8 * fq;
        constexpr float K = -1.44269504f;
#pragma unroll
        for (int ai = 0; ai < 2; ++ai)
#pragma unroll
            for (int m = 0; m < 4; ++m) { const int row = row0 + ai * HALF + m * 16;
                float h[8];
#pragma unroll
                for (int n = 0; n < 2; ++n)
#pragma unroll
                    for (int j = 0; j < 4; j += 2) { const f32x2 a = {acc[ai][0][m][n][j], acc[ai][0][m][n][j + 1]}, uu = {acc[ai][1][m][n][j], acc[ai][1][m][n][j + 1]};
                        f32x2 e; e.x = __builtin_amdgcn_exp2f(a.x); e.y = __builtin_amdgcn_exp2f(a.y);
                        const f32x2 d = e * K + K, p = a * uu; f32x2 r; r.x = __builtin_amdgcn_rcpf(d.x); r.y = __builtin_amdgcn_rcpf(d.y);
                        const f32x2 hh = p * r; h[n * 4 + j] = hh.x; h[n * 4 + j + 1] = hh.y; }
                u32x2 w; w.x = pk4_fp8(h[0], h[1], h[2], h[3]); w.y = pk4_fp8(h[4], h[5], h[6], h[7]);
                *(u32x2*)(O + (size_t)row * ldc + col0) = w; }
    }
};
struct EpiMoeDown {
    static constexpr bool PERM = true; static constexpr bool ADJ = false; static constexpr int REPS = 1; static constexpr int SCW = 0x7f7f7f7f;
    bf16_t* out; const int* row_tok; const float* row_gate; float sc; LAS int* tkl;
    __device__ __forceinline__ void operator()(const f32x4 (&acc)[2][2][4][2], const Unit& u, int wr, int wc, int fr, int fq) const {
        const int col0 = u.pn * BM + wc * 32 + 8 * fq;
        if (threadIdx.x < 256) { tkl[threadIdx.x] = row_tok[u.pm * BM + (int)threadIdx.x]; ((LAS float*)tkl)[256 + threadIdx.x] = row_gate[u.pm * BM + (int)threadIdx.x]; }
        asm volatile("s_waitcnt lgkmcnt(0)" ::: "memory"); __builtin_amdgcn_s_barrier(); asm volatile("" ::: "memory");
        int tk[2][4]; float gt[2][4];
#pragma unroll
        for (int ai = 0; ai < 2; ++ai)
#pragma unroll
            for (int m = 0; m < 4; ++m) { const int rl = wr * 64 + fr + ai * HALF + m * 16; tk[ai][m] = tkl[rl]; gt[ai][m] = ((const LAS float*)tkl)[256 + rl]; }
#pragma unroll
        for (int ai = 0; ai < 2; ++ai) {
            u32x4 cur[4][2];
#pragma unroll
            for (int m = 0; m < 4; ++m) { const int tok = tk[ai][m] < 0 ? 0 : tk[ai][m];
#pragma unroll
                for (int bj = 0; bj < 2; ++bj) cur[m][bj] = *(const u32x4*)(out + (size_t)tok * D + col0 + bj * HALF); }
            asm volatile("" ::: "memory");
#pragma unroll
            for (int m = 0; m < 4; ++m) { const int tok = tk[ai][m]; const float g = gt[ai][m] * sc;
                if (tok >= 0) { bf16_t* rp = out + (size_t)tok * D + col0;
#pragma unroll
                    for (int bj = 0; bj < 2; ++bj) { const u32x4 r = cur[m][bj]; const f32x4 a0 = acc[ai][bj][m][0] * g, a1 = acc[ai][bj][m][1] * g; u32x4 w;
                        w.x = cvt_pk_bf16(__builtin_bit_cast(float, r.x << 16) + a0[0], __builtin_bit_cast(float, r.x & 0xffff0000u) + a0[1]);
                        w.y = cvt_pk_bf16(__builtin_bit_cast(float, r.y << 16) + a0[2], __builtin_bit_cast(float, r.y & 0xffff0000u) + a0[3]);
                        w.z = cvt_pk_bf16(__builtin_bit_cast(float, r.z << 16) + a1[0], __builtin_bit_cast(float, r.z & 0xffff0000u) + a1[1]);
                        w.w = cvt_pk_bf16(__builtin_bit_cast(float, r.w << 16) + a1[2], __builtin_bit_cast(float, r.w & 0xffff0000u) + a1[3]);
                        *(u32x4*)(rp + bj * HALF) = w; } } }
            asm volatile("" ::: "memory"); }
    }
};
}

#define XB_TMO      128
#define XB_XCNT(j)  (256  + 64 * (j))
#define XB_XSUB(j)  (1280 + 64 * (j))
#define XB_XGEN(j)  (2304 + 64 * (j))
#define XB_TOP      3328
#define XB_TOPGEN   3392
#define XCD_BAR_WORDS 3456
#define XB_SPIN_CAP (1u << 18)
__device__ __forceinline__ unsigned xb_ld(unsigned* p)              { return __hip_atomic_load(p, __ATOMIC_RELAXED, __HIP_MEMORY_SCOPE_AGENT); }
__device__ __forceinline__ unsigned xb_add(unsigned* p, unsigned v) { return __hip_atomic_fetch_add(p, v, __ATOMIC_RELAXED, __HIP_MEMORY_SCOPE_AGENT); }
__device__ __forceinline__ unsigned xb_xcc_id() { return (unsigned)__builtin_amdgcn_s_getreg((3 << 11) | 20) & 0xFu; }
#define XB_SPIN(cond, bar) do { unsigned _sp = 0; while (cond) { __builtin_amdgcn_s_sleep(1); \
    if ((++_sp & 255u) == 0u) { if (xb_ld(&(bar)[XB_TMO])) break; if (_sp > XB_SPIN_CAP) { atomicAdd(&(bar)[XB_TMO], 1u); break; } } } } while (0)
struct XcdBarrier { unsigned* bar; unsigned x; volatile LAS unsigned* st; };
__device__ __forceinline__ XcdBarrier xcd_barrier_post(unsigned* bar, volatile LAS unsigned* st) {
    XcdBarrier b; b.bar = bar; b.x = xb_xcc_id(); b.st = st;
    if (threadIdx.x == 0) (void)xb_add(&bar[XB_XCNT(b.x)], 1u);
    return b;
}
__device__ __forceinline__ void xcd_barrier_complete(unsigned* bar, unsigned x, unsigned& nloc, unsigned& nx) {
    const unsigned G = gridDim.x * gridDim.y * gridDim.z;
    unsigned sum, cnt, mine, sp = 0u;
    for (;;) {
        sum = 0u; cnt = 0u; mine = 0u;
#pragma unroll
        for (unsigned j = 0; j < 16; ++j) { const unsigned c = xb_ld(&bar[XB_XCNT(j)]); sum += c; cnt += (c > 0u) ? 1u : 0u; mine = (j == x) ? c : mine; }
        if (sum == G) break;
        __builtin_amdgcn_s_sleep(1);
        if ((++sp & 255u) == 0u) { if (xb_ld(&bar[XB_TMO])) break; if (sp > XB_SPIN_CAP) { atomicAdd(&bar[XB_TMO], 1u); break; } }
    }
    nloc = mine > 0u ? mine : 1u; nx = cnt > 0u ? cnt : 1u;
}
__device__ __forceinline__ void xcd_barrier(const XcdBarrier& b) {
    asm volatile("s_waitcnt vmcnt(0)" ::: "memory");
    __syncthreads();
    if (threadIdx.x == 0) {
        unsigned* bar = b.bar;
        __builtin_amdgcn_s_waitcnt(0);
        unsigned nloc = b.st[0], nx = b.st[1];
        if (nloc == 0u) { xcd_barrier_complete(bar, b.x, nloc, nx); b.st[0] = nloc; b.st[1] = nx; }
        const unsigned old = xb_add(&bar[XB_XSUB(b.x)], 1u);
        const unsigned gen = old / nloc;
        if (old + 1u == (gen + 1u) * nloc) {
            __builtin_amdgcn_fence(__ATOMIC_RELEASE, "agent");
            asm volatile("s_waitcnt vmcnt(0)" ::: "memory");
            const unsigned og = xb_add(&bar[XB_TOP], 1u);
            const unsigned tg = og / nx;
            if (og + 1u == (tg + 1u) * nx) xb_add(&bar[XB_TOPGEN], 1u);
            else XB_SPIN(xb_ld(&bar[XB_TOPGEN]) == tg, bar);
            __builtin_amdgcn_fence(__ATOMIC_ACQUIRE, "agent");
            xb_add(&bar[XB_XGEN(b.x)], 1u);
            asm volatile("s_waitcnt vmcnt(0)" ::: "memory");
        } else {
            XB_SPIN(xb_ld(&bar[XB_XGEN(b.x)]) == gen, bar);
            __builtin_amdgcn_fence(__ATOMIC_ACQUIRE, "agent");
            asm volatile("s_waitcnt vmcnt(0)" ::: "memory");
        }
    }
    __syncthreads();
}

__device__ __forceinline__ void hnd_arrive(unsigned* w) {
    asm volatile("s_waitcnt vmcnt(0)" ::: "memory");
    __syncthreads();
    if (threadIdx.x == 0) { __builtin_amdgcn_fence(__ATOMIC_RELEASE, "agent"); asm volatile("s_waitcnt vmcnt(0)" ::: "memory"); (void)xb_add(w, 1u); }
}
__device__ __forceinline__ void hnd_wait(unsigned* w, unsigned target, unsigned* bar) {
    if (threadIdx.x == 0) { XB_SPIN(xb_ld(w) < target, bar); __builtin_amdgcn_fence(__ATOMIC_ACQUIRE, "agent"); asm volatile("s_waitcnt vmcnt(0)" ::: "memory"); }
    __syncthreads();
}

constexpr int NIN = 28;
struct Args { const float* in[NIN]; float* out; unsigned char* ws; int ph_lo, ph_hi; };
enum { I_X = 0, I_NORM_MIX, I_W_IN, I_W_OUT, I_SHIFT_MU, I_GM_LN_W, I_GM_LN_B, I_GM_WS, I_GM_BS, I_RW_W_UP, I_RW_W0, I_RW_A_UP, I_RW_A0, I_RW_G_UP, I_RW_K_K, I_RW_K_A, I_RW_R_K,
       I_RW_LNX_W, I_RW_LNX_B, I_NORM_FFN, I_FFN_WG, I_FFN_WU, I_FFN_WD, I_MOE_ROUTER, I_MOE_WG, I_MOE_WU, I_MOE_WD, I_NORM_FINAL };

struct Frame {
    LAS unsigned char* lds;
    int tid, lane, wave, G, gw, NGW;
};

struct CvItem { f32x4 v[8]; float gn[8]; };
__device__ __forceinline__ void cv_load(CvItem& it, const float* W, int N, int k0, int n0, const float* gain, float scale, int lane) {
    const int kr = lane >> 3, nq = lane & 7;
#pragma unroll
    for (int i = 0; i < 8; ++i) { it.v[i] = *(const GAS f32x4*)(W + (size_t)(k0 + 8 * i + kr) * N + n0 + 4 * nq); it.gn[i] = gain ? gain[k0 + 8 * i + kr] * scale : scale; }
}
__device__ __forceinline__ void cv_store_fp8(const CvItem& it, int K, unsigned char* WT, int drow0, int k0, LAS float* scr, int lane) {
    { const int kr = lane >> 3, nq = lane & 7;
#pragma unroll
      for (int i = 0; i < 8; ++i) { LAS float* d = scr + (8 * i + kr) * 33 + 4 * nq; d[0] = it.v[i][0] * it.gn[i]; d[1] = it.v[i][1] * it.gn[i]; d[2] = it.v[i][2] * it.gn[i]; d[3] = it.v[i][3] * it.gn[i]; } }
    LDS_WAIT(); asm volatile("" ::: "memory");
    const int n = lane >> 1, hf = lane & 1; const LAS float* sp = scr + (32 * hf) * 33 + n; u32x4 o0, o1;
    o0.x = pk4_fp8(sp[0 * 33], sp[1 * 33], sp[2 * 33], sp[3 * 33]); o0.y = pk4_fp8(sp[4 * 33], sp[5 * 33], sp[6 * 33], sp[7 * 33]); o0.z = pk4_fp8(sp[8 * 33], sp[9 * 33], sp[10 * 33], sp[11 * 33]); o0.w = pk4_fp8(sp[12 * 33], sp[13 * 33], sp[14 * 33], sp[15 * 33]);
    o1.x = pk4_fp8(sp[16 * 33], sp[17 * 33], sp[18 * 33], sp[19 * 33]); o1.y = pk4_fp8(sp[20 * 33], sp[21 * 33], sp[22 * 33], sp[23 * 33]); o1.z = pk4_fp8(sp[24 * 33], sp[25 * 33], sp[26 * 33], sp[27 * 33]); o1.w = pk4_fp8(sp[28 * 33], sp[29 * 33], sp[30 * 33], sp[31 * 33]);
    unsigned char* dst = WT + (size_t)(drow0 + n) * K + k0 + 32 * hf; *(GAS u32x4*)dst = o0; *(GAS u32x4*)(dst + 16) = o1;
    LDS_WAIT(); asm volatile("" ::: "memory");
}
__device__ __forceinline__ void transpose_item(const float* W, int K, int N, bf16* WT, int drow0, int k0, int n0, const float* gain, LAS float* scr, int lane) {
    { const int kr = lane >> 3, nq = lane & 7; f32x4 v[8]; float gn[8];
#pragma unroll
      for (int i = 0; i < 8; ++i) { v[i] = *(const GAS f32x4*)(W + (size_t)(k0 + 8 * i + kr) * N + n0 + 4 * nq); gn[i] = gain ? gain[k0 + 8 * i + kr] : 1.f; }
#pragma unroll
      for (int i = 0; i < 8; ++i) { LAS float* d = scr + (8 * i + kr) * 33 + 4 * nq; d[0] = v[i][0] * gn[i]; d[1] = v[i][1] * gn[i]; d[2] = v[i][2] * gn[i]; d[3] = v[i][3] * gn[i]; } }
    LDS_WAIT(); asm volatile("" ::: "memory");
    const int c = lane & 7;
#pragma unroll
    for (int j = 0; j < 4; ++j) { const int n = (lane >> 3) + 8 * j; const LAS float* s = scr + (8 * c) * 33 + n;
        u32x4 o; o.x = pk2(s[0 * 33], s[1 * 33]); o.y = pk2(s[2 * 33], s[3 * 33]); o.z = pk2(s[4 * 33], s[5 * 33]); o.w = pk2(s[6 * 33], s[7 * 33]);
        *(GAS u32x4*)(WT + (size_t)(drow0 + n) * K + k0 + 8 * c) = o; }
    LDS_WAIT(); asm volatile("" ::: "memory");
}
__device__ __forceinline__ void convert_matrix_fp8(Frame& F, const float* W, int K, int N, unsigned char* WT, int gu_mode  , const float* gain, float scale, int& itbase) {
    LAS float* scr = (LAS float*)(F.lds + F.wave * 16384);
    const int nblk = N / 32, nit = (K / 64) * nblk;
    int first = F.gw - (itbase % F.NGW); if (first < 0) first += F.NGW;
    CvItem nx;
    if (first < nit) cv_load(nx, W, N, 64 * (first / nblk), 32 * (first % nblk), gain, scale, F.lane);
    for (int r = first; r < nit; r += F.NGW) { const int kb = r / nblk, nb = r % nblk, n0 = 32 * nb;
        const int drow0 = gu_mode == 0 ? n0 : (n0 / 128) * 256 + (gu_mode == 2 ? 128 : 0) + (n0 % 128);
        const CvItem cur = nx; const int r2 = r + F.NGW;
        if (r2 < nit) cv_load(nx, W, N, 64 * (r2 / nblk), 32 * (r2 % nblk), gain, scale, F.lane);
        cv_store_fp8(cur, K, WT, drow0, 64 * kb, scr, F.lane); }
    itbase += nit;
}
__device__ __forceinline__ void convert_matrix(Frame& F, const float* W, int K, int N, bf16* WT, int gu_mode  , const float* gain, int it0, int& itbase) {
    LAS float* scr = (LAS float*)(F.lds + F.wave * 16384);
    const int nblk = N / 32, nit = (K / 64) * nblk;
    int first = F.gw - (itbase % F.NGW); if (first < 0) first += F.NGW;
    for (int r = first; r < nit; r += F.NGW) { const int kb = r / nblk, nb = r % nblk, n0 = 32 * nb;
        const int drow0 = gu_mode == 0 ? n0 : (n0 / 128) * 256 + (gu_mode == 2 ? 128 : 0) + (n0 % 128);
        transpose_item(W, K, N, WT, drow0, 64 * kb, n0, gain, scr, F.lane); }
    itbase += nit; (void)it0;
}

__device__ __forceinline__ void gmlp_naive(Frame& F, const bf16* P, bf16* Y, const float* ln_w, const float* ln_b, const float* ws, const float* bs) {
    LAS float* V = (LAS float*)F.lds;
    for (int unit = blockIdx.x; unit < NB * (SEQ / GCH) * NH; unit += F.G) {
        const int h = unit % NH, bc = unit / NH; const size_t row0 = (size_t)bc * GCH;
        const float lw = ln_w[h * HD + F.lane], lb = ln_b[h * HD + F.lane];
        for (int i = 0; i < 16; ++i) { const int t = F.wave * 16 + i;
            const float g = gelu_erf(bf2f(P[(row0 + t) * INW + GMW + h * HD + F.lane]));
            const float mean = wave_sum(g) * (1.f / HD); const float d = g - mean; const float var = wave_sum(d * d) * (1.f / HD);
            V[t * HD + F.lane] = d * __builtin_amdgcn_rsqf(var + LN_EPS) * lw + lb; }
        __syncthreads();
        for (int i = 0; i < 16; ++i) { const int t = F.wave * 16 + i; const float* wrow = ws + ((size_t)h * GCH + t) * GCH; float acc = 0.f;
            for (int s = 0; s <= t; ++s) acc += wrow[s] * V[s * HD + F.lane];
            const float mixed = acc + bs[h * GCH + t];
            const float u = gelu_erf(bf2f(P[(row0 + t) * INW + h * HD + F.lane]));
            Y[(row0 + t) * D + h * HD + F.lane] = (bf16)f2bf(u * mixed); }
        __syncthreads();
    }
}
__device__ __forceinline__ float shifted(const bf16* P, size_t row, int t, int col, const float* mu) {
    const float c = bf2f(P[row * INW + col]); const float pr = t > 0 ? bf2f(P[(row - 1) * INW + col]) : 0.f;
    return c + (pr - c) * mu[col - 1024];
}
constexpr int NC = 32;
__device__ __forceinline__ void rwkv_naive(Frame& F, const bf16* P, bf16* Y, const float* mu, const float* w_up, const float* w0, const float* a_up, const float* a0, const float* g_up,
                                           const float* k_k, const float* k_a, const float* r_k, const float* lnx_w, const float* lnx_b) {
    LAS float* LI = (LAS float*)F.lds;
    LAS float* sR = LI + NC * 256; LAS float* sW = sR + NC * 64; LAS float* sK = sW + NC * 64; LAS float* sV = sK + NC * 64; LAS float* sA = sV + NC * 64; LAS float* sB = sA + NC * 64;
    LAS float* sG = sB + NC * 64; LAS float* sBon = sG + NC * 64;
    for (int unit = blockIdx.x; unit < NB * NH; unit += F.G) {
        const int b = unit / NH, h = unit % NH;
        float S[64];
#pragma unroll
        for (int k = 0; k < 64; ++k) S[k] = 0.f;
        for (int c = 0; c < SEQ / NC; ++c) {
            const int t0 = c * NC; const size_t row0 = (size_t)b * SEQ + t0;
            for (int idx = F.tid; idx < NC * 256; idx += 512) { const int tok = idx >> 8, j = idx & 255;
                const float x = shifted(P, row0 + tok, t0 + tok, 2560 + j, mu);
                LI[idx] = j < 64 ? tanhf(x) : (j < 128 ? x : sigmoidf_(x)); }
            __syncthreads();
            { const int ch = F.lane, hc = h * HD + ch;
              for (int i = 0; i < NC / 8; ++i) { const int tok = F.wave + 8 * i; const size_t row = row0 + tok; const int t = t0 + tok;
                const float rr = shifted(P, row, t, 1024 + hc, mu), kx = shifted(P, row, t, 1536 + hc, mu), vv = shifted(P, row, t, 2048 + hc, mu);
                float dw = w0[hc], da = a0[hc], gg = 0.f;
                for (int j = 0; j < 64; ++j) { dw += LI[tok * 256 + j] * w_up[j * RWW + hc]; da += LI[tok * 256 + 64 + j] * a_up[j * RWW + hc]; }
                for (int j = 0; j < 128; ++j) gg += LI[tok * 256 + 128 + j] * g_up[j * RWW + hc];
                const float z = -dw; const float sp = fmaxf(z, 0.f) + log1pf(__expf(-fabsf(z)));
                const float decay = __expf(-__expf(-sp - 0.5f));
                const float alr = sigmoidf_(da);
                const float kkv = kx * k_k[hc]; const float nrm = sqrtf(wave_sum(kkv * kkv)); const float kkn = kkv / fmaxf(nrm, 1e-12f);
                const float kmod = kx * (1.f + (alr - 1.f) * k_a[hc]);
                const float bsc = wave_sum(rr * kmod * r_k[hc]);
                sR[tok * 64 + ch] = rr; sW[tok * 64 + ch] = decay; sK[tok * 64 + ch] = kmod; sV[tok * 64 + ch] = vv; sA[tok * 64 + ch] = -kkn; sB[tok * 64 + ch] = kkn * alr;
                sG[tok * 64 + ch] = gg; sBon[tok * 64 + ch] = bsc * vv; } }
            __syncthreads();
            if (F.wave == 0) {
                for (int t = 0; t < NC; ++t) { float sa = 0.f;
#pragma unroll
                    for (int k = 0; k < 64; ++k) sa += S[k] * sA[t * 64 + k];
                    const float vv = sV[t * 64 + F.lane]; float yv = 0.f;
#pragma unroll
                    for (int k = 0; k < 64; ++k) { S[k] = S[k] * sW[t * 64 + k] + sa * sB[t * 64 + k] + vv * sK[t * 64 + k]; yv += S[k] * sR[t * 64 + k]; }
                    LI[t * 64 + F.lane] = yv; }
            }
            __syncthreads();
            { const int v = F.lane, hv = h * HD + v;
              for (int i = 0; i < NC / 8; ++i) { const int tok = F.wave + 8 * i; const float yv = LI[tok * 64 + v];
                const float mean = wave_sum(yv) * (1.f / HD); const float d = yv - mean; const float var = wave_sum(d * d) * (1.f / HD);
                const float yn = d * __builtin_amdgcn_rsqf(var + GN_EPS) * lnx_w[hv] + lnx_b[hv];
                Y[(row0 + tok) * D + GMW + hv] = (bf16)f2bf((yn + sBon[tok * 64 + v]) * sG[tok * 64 + v]); } }
            __syncthreads();
        }
    }
}

typedef short s16x4 __attribute__((ext_vector_type(4)));
typedef short v4i16_t __attribute__((ext_vector_type(4)));
#define MFMA32(a, b, c) __builtin_amdgcn_mfma_f32_16x16x32_bf16((a), (b), (c), 0, 0, 0)
#define MFMA16(a, b, c) __builtin_amdgcn_mfma_f32_16x16x16bf16_1k((a), (b), (c), 0, 0, 0)
__device__ __forceinline__ bf16x8 lds_row8(const LAS bf16* T, int ld, int r0, int k0, int lane) { return *(const LAS bf16x8*)(T + (r0 + (lane & 15)) * ld + k0 + 8 * (lane >> 4)); }
__device__ __forceinline__ s16x4 lds_row4(const LAS bf16* T, int ld, int r0, int k0, int lane) { return *(const LAS s16x4*)(T + (r0 + (lane & 15)) * ld + k0 + 4 * (lane >> 4)); }
__device__ __forceinline__ s16x4 lds_tr4(const LAS bf16* T, int ld, int k0, int c0, int lane) { const int i = lane & 15, g = lane >> 4;
    return __builtin_bit_cast(s16x4, __builtin_amdgcn_ds_read_tr16_b64_v4i16((LAS v4i16_t*)(T + (k0 + 4 * g + (i >> 2)) * ld + c0 + 4 * (i & 3)))); }
__device__ __forceinline__ bf16x8 lds_tr8(const LAS bf16* T, int ld, int k0, int c0, int lane) { const int i = lane & 15, g = lane >> 4;
    const LAS bf16* p = T + (k0 + 8 * g + (i >> 2)) * ld + c0 + 4 * (i & 3);
    const s16x4 lo = __builtin_bit_cast(s16x4, __builtin_amdgcn_ds_read_tr16_b64_v4i16((LAS v4i16_t*)p));
    const s16x4 hi = __builtin_bit_cast(s16x4, __builtin_amdgcn_ds_read_tr16_b64_v4i16((LAS v4i16_t*)(p + 4 * ld)));
    bf16x8 r; r[0] = lo[0]; r[1] = lo[1]; r[2] = lo[2]; r[3] = lo[3]; r[4] = hi[0]; r[5] = hi[1]; r[6] = hi[2]; r[7] = hi[3]; return r; }
typedef __bf16 bf16x2_t __attribute__((ext_vector_type(2)));
__device__ __forceinline__ unsigned cvtpk_c(float lo, float hi) { const f32x2 v = {lo, hi}; const bf16x2_t b = __builtin_convertvector(v, bf16x2_t); return __builtin_bit_cast(unsigned, b); }
__device__ __forceinline__ s16x4 pack4(const f32x4 v) { u32x2 w; w.x = cvtpk_c(v[0], v[1]); w.y = cvtpk_c(v[2], v[3]); return __builtin_bit_cast(s16x4, w); }
__device__ __forceinline__ f32x4 unpack4(const s16x4 v) { f32x4 r; r[0] = bf2f((bf16)v[0]); r[1] = bf2f((bf16)v[1]); r[2] = bf2f((bf16)v[2]); r[3] = bf2f((bf16)v[3]); return r; }
__device__ __forceinline__ void unpack8(const u32x4 w, float (&o)[8]) { o[0] = __builtin_bit_cast(float, w.x << 16); o[1] = __builtin_bit_cast(float, w.x & 0xffff0000u); o[2] = __builtin_bit_cast(float, w.y << 16); o[3] = __builtin_bit_cast(float, w.y & 0xffff0000u);
    o[4] = __builtin_bit_cast(float, w.z << 16); o[5] = __builtin_bit_cast(float, w.z & 0xffff0000u); o[6] = __builtin_bit_cast(float, w.w << 16); o[7] = __builtin_bit_cast(float, w.w & 0xffff0000u); }
__device__ __forceinline__ u32x4 pack8(const float (&v)[8]) { u32x4 w; w.x = cvtpk_c(v[0], v[1]); w.y = cvtpk_c(v[2], v[3]); w.z = cvtpk_c(v[4], v[5]); w.w = cvtpk_c(v[6], v[7]); return w; }
__device__ __forceinline__ float gelu_as(float v) {
    const float av = fabsf(v), t = __builtin_amdgcn_rcpf(av * 0.2316418882f + 1.0f);
    float q = t * 0.5307027145f + (-0.7265760135f); q = q * t + 0.7107068705f; q = q * t + (-0.142248368f); q = q * t + 0.127414796f; q = q * t;
    const float e = __builtin_amdgcn_exp2f((v * v) * (-0.72134752044f)); const float m = v * (q * e); return v < 0.f ? m : v - m;
}

__device__ __forceinline__ f32x2 gelu_pk2(f32x2 v) {
    const f32x2 av = __builtin_elementwise_abs(v), d = av * 0.2316418882f + 1.0f;
    f32x2 t; t.x = __builtin_amdgcn_rcpf(d.x); t.y = __builtin_amdgcn_rcpf(d.y);
    f32x2 q = t * 0.5307027145f + (-0.7265760135f); q = q * t + 0.7107068705f; q = q * t + (-0.142248368f); q = q * t + 0.127414796f; q = q * t;
    const f32x2 s2 = (v * v) * (-0.72134752044f);
    f32x2 e; e.x = __builtin_amdgcn_exp2f(s2.x); e.y = __builtin_amdgcn_exp2f(s2.y);
    const f32x2 m = v * (q * e), r = v - m;
    f32x2 o; o.x = v.x < 0.f ? m.x : r.x; o.y = v.y < 0.f ? m.y : r.y; return o;
}
constexpr int GM_V = 0, GM_U = 128 * 72 * 2;
__device__ __forceinline__ void gmlp_unit(Frame& F, int unit, const bf16* P, bf16* Y, const float* ln_w, const float* ln_b, const bf16* WsB, const float* bs) {
    LAS bf16* Vt = (LAS bf16*)(F.lds + GM_V); LAS bf16* Ut = (LAS bf16*)(F.lds + GM_U);
    const int h = unit % NH, bc = unit / NH; const size_t row0 = (size_t)bc * GCH;
    { const int t = F.tid >> 2, cq = F.tid & 3; const bf16* pr = P + (row0 + t) * INW + h * HD + 16 * cq;
      const u32x4 u0 = *(const u32x4*)pr, u1 = *(const u32x4*)(pr + 8), v0 = *(const u32x4*)(pr + GMW), v1 = *(const u32x4*)(pr + GMW + 8);
      float uu[16], vv[16]; { float a[8]; unpack8(u0, a); for (int j = 0; j < 8; ++j) uu[j] = a[j]; unpack8(u1, a); for (int j = 0; j < 8; ++j) uu[8 + j] = a[j]; unpack8(v0, a); for (int j = 0; j < 8; ++j) vv[j] = a[j]; unpack8(v1, a); for (int j = 0; j < 8; ++j) vv[8 + j] = a[j]; }
      float s = 0.f;
#pragma unroll
      for (int j = 0; j < 16; ++j) { uu[j] = gelu_as(uu[j]); vv[j] = gelu_as(vv[j]); s += vv[j]; }
      s += __shfl_xor(s, 1); s += __shfl_xor(s, 2); const float mean = s * (1.f / HD); float q = 0.f;
#pragma unroll
      for (int j = 0; j < 16; ++j) { vv[j] -= mean; q += vv[j] * vv[j]; }
      q += __shfl_xor(q, 1); q += __shfl_xor(q, 2); const float rstd = __builtin_amdgcn_rsqf(q * (1.f / HD) + LN_EPS);
#pragma unroll
      for (int j = 0; j < 16; ++j) vv[j] = vv[j] * rstd * ln_w[h * HD + 16 * cq + j] + ln_b[h * HD + 16 * cq + j];
      float a[8]; for (int j = 0; j < 8; ++j) a[j] = vv[j]; *(LAS u32x4*)(Vt + t * 72 + 16 * cq) = pack8(a); for (int j = 0; j < 8; ++j) a[j] = vv[8 + j]; *(LAS u32x4*)(Vt + t * 72 + 16 * cq + 8) = pack8(a);
      for (int j = 0; j < 8; ++j) a[j] = uu[j]; *(LAS u32x4*)(Ut + t * 72 + 16 * cq) = pack8(a); for (int j = 0; j < 8; ++j) a[j] = uu[8 + j]; *(LAS u32x4*)(Ut + t * 72 + 16 * cq + 8) = pack8(a); }
    __syncthreads();
    { const int w = F.wave, l15 = F.lane & 15, g = F.lane >> 4, t0 = 16 * w, nks = (w >> 1) + 1; const bf16* wrow = WsB + ((size_t)h * GCH + t0 + l15) * GCH + 8 * g;
      f32x4 acc[4] = {{0.f, 0.f, 0.f, 0.f}, {0.f, 0.f, 0.f, 0.f}, {0.f, 0.f, 0.f, 0.f}, {0.f, 0.f, 0.f, 0.f}};
      for (int ks = 0; ks < nks; ++ks) { const bf16x8 a = *(const bf16x8*)(wrow + 32 * ks);
#pragma unroll
          for (int nt = 0; nt < 4; ++nt) acc[nt] = MFMA32(a, lds_tr8(Vt, 72, 32 * ks, 16 * nt, F.lane), acc[nt]); }
#pragma unroll
      for (int reg = 0; reg < 4; ++reg) { const int t = t0 + 4 * g + reg; const float bsv = bs[h * GCH + t];
#pragma unroll
          for (int nt = 0; nt < 4; ++nt) { LAS bf16* up = Ut + t * 72 + 16 * nt + l15; *up = (bf16)f2bf(bf2f(*up) * (acc[nt][reg] + bsv)); } } }
    __syncthreads();
    { const int t = F.tid >> 2, cq = F.tid & 3; bf16* yr = Y + (row0 + t) * D + h * HD + 16 * cq;
      *(u32x4*)yr = *(const LAS u32x4*)(Ut + t * 72 + 16 * cq); *(u32x4*)(yr + 8) = *(const LAS u32x4*)(Ut + t * 72 + 16 * cq + 8); }
    __syncthreads();
}

__device__ __forceinline__ void gmlp_units(Frame& F, int u0, int ustep, int nunits, const bf16* P, bf16* Y, const float* ln_w, const float* ln_b, const bf16* WsB, const float* bs) {
    if (u0 >= nunits) return;
    const int t = F.tid >> 2, cq = F.tid & 3; const int w = F.wave, l15 = F.lane & 15, g = F.lane >> 4, t0 = 16 * w, nks = (w >> 1) + 1;
    LAS float* TB = (LAS float*)(F.lds + 73728);
    TB[F.tid] = ln_w[F.tid]; TB[512 + F.tid] = ln_b[F.tid]; TB[1024 + F.tid] = bs[F.tid]; TB[1536 + F.tid] = bs[512 + F.tid];
    LDS_BARRIER();
    u32x4 pu0, pu1, pv0, pv1;
#define GM_LOAD(uu_) do { const int h_ = (uu_) % NH, bc_ = (uu_) / NH; const bf16* pr_ = P + ((size_t)bc_ * GCH + t) * INW + h_ * HD + 16 * cq; \
        pu0 = *(const u32x4*)pr_; pu1 = *(const u32x4*)(pr_ + 8); pv0 = *(const u32x4*)(pr_ + GMW); pv1 = *(const u32x4*)(pr_ + GMW + 8); } while (0)
    GM_LOAD(u0);
    int it = 0;
    for (int unit = u0; unit < nunits; unit += ustep, ++it) {
        LAS bf16* Vt = (LAS bf16*)(F.lds + (it & 1) * (2 * 128 * 72 * 2)); LAS bf16* Ut = Vt + 128 * 72;
        const int h = unit % NH, bc = unit / NH; const size_t row0 = (size_t)bc * GCH;
        const bf16* wrow = WsB + ((size_t)h * GCH + t0 + l15) * GCH + 8 * g; bf16x8 af[4];
#pragma unroll
        for (int ks = 0; ks < 4; ++ks) af[ks] = *(const bf16x8*)(wrow + 32 * (ks < nks ? ks : 0));
        const f32x4 bsv = *(const LAS f32x4*)(TB + 1024 + h * GCH + t0 + 4 * g);
        float uu[16], vv[16]; { float a[8]; unpack8(pu0, a); for (int j = 0; j < 8; ++j) uu[j] = a[j]; unpack8(pu1, a); for (int j = 0; j < 8; ++j) uu[8 + j] = a[j]; unpack8(pv0, a); for (int j = 0; j < 8; ++j) vv[j] = a[j]; unpack8(pv1, a); for (int j = 0; j < 8; ++j) vv[8 + j] = a[j]; }
        if (unit + ustep < nunits) GM_LOAD(unit + ustep);
        float sm = 0.f;
#pragma unroll
        for (int j = 0; j < 16; j += 2) { const f32x2 gu = gelu_pk2((f32x2){uu[j], uu[j + 1]}), gv = gelu_pk2((f32x2){vv[j], vv[j + 1]}); uu[j] = gu.x; uu[j + 1] = gu.y; vv[j] = gv.x; vv[j + 1] = gv.y; sm += gv.x + gv.y; }
        sm += __shfl_xor(sm, 1); sm += __shfl_xor(sm, 2); const float mean = sm * (1.f / HD); float q = 0.f;
#pragma unroll
        for (int j = 0; j < 16; ++j) { vv[j] -= mean; q += vv[j] * vv[j]; }
        q += __shfl_xor(q, 1); q += __shfl_xor(q, 2); const float rstd = __builtin_amdgcn_rsqf(q * (1.f / HD) + LN_EPS);
#pragma unroll
        for (int j = 0; j < 16; ++j) vv[j] = vv[j] * rstd * TB[h * HD + 16 * cq + j] + TB[512 + h * HD + 16 * cq + j];
        { float a[8]; for (int j = 0; j < 8; ++j) a[j] = vv[j]; *(LAS u32x4*)(Vt + t * 72 + 16 * cq) = pack8(a); for (int j = 0; j < 8; ++j) a[j] = vv[8 + j]; *(LAS u32x4*)(Vt + t * 72 + 16 * cq + 8) = pack8(a);
          for (int j = 0; j < 8; ++j) a[j] = uu[j]; *(LAS u32x4*)(Ut + t * 72 + 16 * cq) = pack8(a); for (int j = 0; j < 8; ++j) a[j] = uu[8 + j]; *(LAS u32x4*)(Ut + t * 72 + 16 * cq + 8) = pack8(a); }
        LDS_BARRIER();
        { f32x4 acc[4] = {{0.f, 0.f, 0.f, 0.f}, {0.f, 0.f, 0.f, 0.f}, {0.f, 0.f, 0.f, 0.f}, {0.f, 0.f, 0.f, 0.f}};
#pragma unroll
          for (int ks = 0; ks < 4; ++ks) if (ks < nks) {
#pragma unroll
              for (int nt = 0; nt < 4; ++nt) acc[nt] = MFMA32(af[ks], lds_tr8(Vt, 72, 32 * ks, 16 * nt, F.lane), acc[nt]); }
#pragma unroll
          for (int reg = 0; reg < 4; ++reg) { const int tt = t0 + 4 * g + reg;
#pragma unroll
              for (int nt = 0; nt < 4; ++nt) { LAS bf16* up = Ut + tt * 72 + 16 * nt + l15; *up = (bf16)f2bf(bf2f(*up) * (acc[nt][reg] + bsv[reg])); } } }
        LDS_BARRIER();
        { bf16* yr = Y + (row0 + t) * D + h * HD + 16 * cq;
          *(u32x4*)yr = *(const LAS u32x4*)(Ut + t * 72 + 16 * cq); *(u32x4*)(yr + 8) = *(const LAS u32x4*)(Ut + t * 72 + 16 * cq + 8); }
    }
#undef GM_LOAD
    LDS_BARRIER();
}

struct RwkvW { const float *mu, *w0, *a0, *k_k, *k_a, *r_k, *lnx_w, *lnx_b; const bf16 *WupT, *AupT, *GupT; };
struct RwkvS { bf16 *SG, *SH, *SQ, *SS, *Sg, *SY0; float* Sbsc; };
constexpr int M1_LI = 0;
constexpr int M1_PR = 33792;
constexpr int M1_TL = M1_PR + 36864;
constexpr int M1_SEG = M1_TL + 7 * 9216;
constexpr int M1_GAM = M1_SEG + 2048;
constexpr int M1_D = M1_GAM + 256;
constexpr int M1_T = M1_D + 4096;
constexpr int M1_END = M1_T + 2048;
static_assert(M1_END <= MISC_OFF, "M1 LDS map");
__device__ __forceinline__ float fast_tanh(float x) { const float e = __expf(2.f * x); return 1.f - 2.f * __builtin_amdgcn_rcpf(e + 1.f); }

__device__ __forceinline__ void rwkv_m1_unit(Frame& F, int unit  , const bf16* P, const RwkvW& W, const RwkvS& Sc) {
    const int b = unit >> 6, c = unit & 63, t0 = c * 64; const size_t row0 = (size_t)b * SEQ + t0;
    const int w = F.wave, lane = F.lane, l15 = lane & 15, g = lane >> 4;
    LAS bf16* LI = (LAS bf16*)(F.lds + M1_LI);
    LAS float* Ef = (LAS float*)(F.lds + M1_PR); LAS float* ALf = Ef + 64 * 64;
    LAS bf16* Lab = (LAS bf16*)(F.lds + M1_PR); LAS bf16* Lak = Lab + 64 * 72; LAS bf16* Mrb = Lak + 64 * 72; LAS bf16* Mrk = Mrb + 64 * 72;
    LAS bf16* At = (LAS bf16*)(F.lds + M1_TL); LAS bf16* Bt = At + 64 * 72; LAS bf16* Kt = Bt + 64 * 72; LAS bf16* Rt = Kt + 64 * 72; LAS bf16* Bh = Rt + 64 * 72; LAS bf16* Kh = Bh + 64 * 72; LAS bf16* Vt = Kh + 64 * 72;
    LAS float* SEG = (LAS float*)(F.lds + M1_SEG); LAS float* GAM = (LAS float*)(F.lds + M1_GAM); LAS float* Dd = (LAS float*)(F.lds + M1_D); LAS bf16* Tt = (LAS bf16*)(F.lds + M1_T);
#pragma unroll
    for (int it = 0; it < 4; ++it) { const int item = F.tid + 512 * it, tok = item >> 5, jc = item & 31, j0 = 8 * jc; const size_t row = row0 + tok;
        float cv[8], pv[8]; unpack8(*(const u32x4*)(P + row * INW + 2560 + j0), cv);
        if (t0 + tok > 0) unpack8(*(const u32x4*)(P + (row - 1) * INW + 2560 + j0), pv); else { for (int j = 0; j < 8; ++j) pv[j] = 0.f; }
        const f32x4 m0 = *(const f32x4*)(W.mu + 1536 + j0), m1 = *(const f32x4*)(W.mu + 1536 + j0 + 4); float o[8];
#pragma unroll
        for (int j = 0; j < 8; ++j) { const float x = cv[j] + (pv[j] - cv[j]) * (j < 4 ? m0[j] : m1[j - 4]); o[j] = jc < 8 ? fast_tanh(x) : (jc < 16 ? x : sigmoidf_(x)); }
        *(LAS u32x4*)(LI + tok * 264 + j0) = pack8(o); }
    __syncthreads();
    for (int h = 0; h < NH; ++h) {
        const size_t uh = ((size_t)unit * NH + h) * 4096;
        { const int mt = w & 3, ntb = 2 * (w >> 2); const int chrow = h * HD + 16 * mt + l15;
          f32x4 aw[2] = {{0.f, 0.f, 0.f, 0.f}, {0.f, 0.f, 0.f, 0.f}}, aa[2] = {{0.f, 0.f, 0.f, 0.f}, {0.f, 0.f, 0.f, 0.f}}, ag[2] = {{0.f, 0.f, 0.f, 0.f}, {0.f, 0.f, 0.f, 0.f}};
#pragma unroll
          for (int ks = 0; ks < 2; ++ks) { const bf16x8 fw = *(const bf16x8*)(W.WupT + (size_t)chrow * 64 + 32 * ks + 8 * g), fa = *(const bf16x8*)(W.AupT + (size_t)chrow * 64 + 32 * ks + 8 * g);
#pragma unroll
              for (int q = 0; q < 2; ++q) { aw[q] = MFMA32(fw, lds_row8(LI, 264, 16 * (ntb + q), 32 * ks, lane), aw[q]); aa[q] = MFMA32(fa, lds_row8(LI, 264, 16 * (ntb + q), 64 + 32 * ks, lane), aa[q]); } }
#pragma unroll
          for (int ks = 0; ks < 4; ++ks) { const bf16x8 fg = *(const bf16x8*)(W.GupT + (size_t)chrow * 128 + 32 * ks + 8 * g);
#pragma unroll
              for (int q = 0; q < 2; ++q) ag[q] = MFMA32(fg, lds_row8(LI, 264, 16 * (ntb + q), 128 + 32 * ks, lane), ag[q]); }
          const int ch0 = 16 * mt + 4 * g; const f32x4 w0v = *(const f32x4*)(W.w0 + h * HD + ch0), a0v = *(const f32x4*)(W.a0 + h * HD + ch0);
#pragma unroll
          for (int q = 0; q < 2; ++q) { const int tok = 16 * (ntb + q) + l15; f32x4 ev, av;
#pragma unroll
              for (int r = 0; r < 4; ++r) { const float z = -(aw[q][r] + w0v[r]); const float sp = fmaxf(z, 0.f) + __logf(1.f + __expf(-fabsf(z))); ev[r] = -__expf(-sp - 0.5f); av[r] = sigmoidf_(aa[q][r] + a0v[r]); }
              *(LAS f32x4*)(Ef + tok * 64 + ch0) = ev; *(LAS f32x4*)(ALf + tok * 64 + ch0) = av;
              u32x2 gw; gw.x = cvtpk_c(ag[q][0], ag[q][1]); gw.y = cvtpk_c(ag[q][2], ag[q][3]); *(u32x2*)(Sc.Sg + (row0 + tok) * RWW + h * HD + ch0) = gw; } }
        __syncthreads();
        { const int ch = F.tid & 63, seg = F.tid >> 6; float run = 0.f;
#pragma unroll
          for (int i = 0; i < 8; ++i) { run += Ef[(8 * seg + i) * 64 + ch]; Ef[(8 * seg + i) * 64 + ch] = run; }
          SEG[seg * 64 + ch] = run; }
        __syncthreads();
        { const int ch = F.tid & 63, seg = F.tid >> 6; float off = 0.f;
          for (int s2 = 0; s2 < seg; ++s2) off += SEG[s2 * 64 + ch];
#pragma unroll
          for (int i = 0; i < 8; ++i) Ef[(8 * seg + i) * 64 + ch] += off; }
        __syncthreads();
        { const int tok = F.tid >> 3, cg = F.tid & 7, ch0 = 8 * cg, hc0 = h * HD + ch0; const size_t row = row0 + tok; const bool has_prev = (t0 + tok) > 0;
          float rr[8], kx[8], vv[8], tmp[8], pr[8];
#define SHIFT_LOAD(dst, col) do { unpack8(*(const u32x4*)(P + row * INW + (col)), dst); if (has_prev) unpack8(*(const u32x4*)(P + (row - 1) * INW + (col)), pr); else { for (int j = 0; j < 8; ++j) pr[j] = 0.f; } \
              const f32x4 m0 = *(const f32x4*)(W.mu + (col) - 1024), m1 = *(const f32x4*)(W.mu + (col) - 1024 + 4); for (int j = 0; j < 8; ++j) dst[j] = dst[j] + (pr[j] - dst[j]) * (j < 4 ? m0[j] : m1[j - 4]); } while (0)
          SHIFT_LOAD(rr, 1024 + hc0); SHIFT_LOAD(kx, 1536 + hc0); SHIFT_LOAD(vv, 2048 + hc0);
          (void)tmp;
          float Lt[8], Lm[8], Lc[8], al[8];
#pragma unroll
          for (int j = 0; j < 8; ++j) { Lt[j] = Ef[tok * 64 + ch0 + j]; Lm[j] = tok > 0 ? Ef[(tok - 1) * 64 + ch0 + j] : 0.f; Lc[j] = Ef[63 * 64 + ch0 + j]; al[j] = ALf[tok * 64 + ch0 + j]; }
          float kk[8], km[8]; float ss = 0.f, bs_ = 0.f;
#pragma unroll
          for (int j = 0; j < 8; ++j) { kk[j] = kx[j] * W.k_k[hc0 + j]; ss += kk[j] * kk[j]; km[j] = kx[j] * (1.f + (al[j] - 1.f) * W.k_a[hc0 + j]); bs_ += rr[j] * km[j] * W.r_k[hc0 + j]; }
          ss += __shfl_xor(ss, 1); ss += __shfl_xor(ss, 2); ss += __shfl_xor(ss, 4); bs_ += __shfl_xor(bs_, 1); bs_ += __shfl_xor(bs_, 2); bs_ += __shfl_xor(bs_, 4);
          const float inv = 1.f / fmaxf(sqrtf(ss), 1e-12f);
          if (cg == 0) Sc.Sbsc[row * NH + h] = bs_;
          float oA[8], oB[8], oK[8], oR[8], oBh[8], oKh[8];
#pragma unroll
          for (int j = 0; j < 8; ++j) { const float kn = kk[j] * inv, bb = kn * al[j]; const float einv = __expf(-Lt[j]), ec = __expf(Lc[j] - Lt[j]);
              oA[j] = -kn * __expf(Lm[j]); oB[j] = bb * einv; oK[j] = km[j] * einv; oR[j] = rr[j] * __expf(Lt[j]); oBh[j] = bb * ec; oKh[j] = km[j] * ec; }
          *(LAS u32x4*)(At + tok * 72 + ch0) = pack8(oA); *(LAS u32x4*)(Bt + tok * 72 + ch0) = pack8(oB); *(LAS u32x4*)(Kt + tok * 72 + ch0) = pack8(oK); *(LAS u32x4*)(Rt + tok * 72 + ch0) = pack8(oR);
          *(LAS u32x4*)(Bh + tok * 72 + ch0) = pack8(oBh); *(LAS u32x4*)(Kh + tok * 72 + ch0) = pack8(oKh); *(LAS u32x4*)(Vt + tok * 72 + ch0) = pack8(vv);
          if (tok == 63) { for (int j = 0; j < 8; ++j) GAM[ch0 + j] = __expf(Lc[j]); } }
        __syncthreads();
        for (int i5 = 0; i5 < 5; ++i5) { const int q = w + 8 * i5, mat = q / 10, idx = q % 10; const int ti = idx < 1 ? 0 : (idx < 3 ? 1 : (idx < 6 ? 2 : 3)), si = idx - ti * (ti + 1) / 2;
            const LAS bf16* X = mat < 2 ? At : Rt; const LAS bf16* Yk = (mat & 1) ? Kt : Bt; LAS bf16* O = Lab + mat * 64 * 72;
            f32x4 acc = {0.f, 0.f, 0.f, 0.f};
#pragma unroll
            for (int ks = 0; ks < 2; ++ks) acc = MFMA32(lds_row8(Yk, 72, 16 * si, 32 * ks, lane), lds_row8(X, 72, 16 * ti, 32 * ks, lane), acc);
            const int t = 16 * ti + l15, s0 = 16 * si + 4 * g;
#pragma unroll
            for (int r = 0; r < 4; ++r) { const bool keep = mat < 2 ? (s0 + r < t) : (s0 + r <= t); if (!keep) acc[r] = 0.f; }
            *(LAS s16x4*)(O + t * 72 + s0) = pack4(acc);
            if (mat == 0 && ti == si) *(LAS f32x4*)(Dd + ti * 256 + l15 * 16 + 4 * g) = acc; }
        __syncthreads();
        if (w == 7) { const int i = lane >> 4, cc = lane & 15; const LAS float* Db = Dd + i * 256; float tv[16];
#pragma unroll
            for (int r = 0; r < 16; ++r) { float sum = (r == cc) ? 1.f : 0.f;
#pragma unroll
                for (int s2 = 0; s2 < r; ++s2) sum += Db[r * 16 + s2] * tv[s2];
                tv[r] = sum; }
#pragma unroll
            for (int r = 0; r < 16; ++r) Tt[i * 256 + r * 16 + cc] = (bf16)f2bf(tv[r]); }
        __syncthreads();
        { const bool isU = w < 4; const int cw = w & 3;
          f32x4 X[4];
#pragma unroll
          for (int i = 0; i < 4; ++i) { f32x4 z = {0.f, 0.f, 0.f, 0.f};
              if (isU) {
#pragma unroll
                  for (int j = 0; j <= i; ++j) z = MFMA16(lds_row4(Lak, 72, 16 * i, 16 * j, lane), lds_tr4(Vt, 72, 16 * j, 16 * cw, lane), z);
              } else z = unpack4(lds_tr4(At, 72, 16 * i, 16 * cw, lane));
#pragma unroll
              for (int j = 0; j < i; ++j) z = MFMA16(lds_row4(Lab, 72, 16 * i, 16 * j, lane), pack4(X[j]), z);
              const f32x4 zero = {0.f, 0.f, 0.f, 0.f};
              X[i] = MFMA16(lds_row4(Tt + i * 256, 16, 0, 0, lane), pack4(z), zero); }
          s16x4 Xp[4];
#pragma unroll
          for (int i = 0; i < 4; ++i) Xp[i] = pack4(X[i]);
          if (isU) {
#pragma unroll
              for (int nt = 0; nt < 4; ++nt) { f32x4 acc = {0.f, 0.f, 0.f, 0.f};
#pragma unroll
                  for (int i = 0; i < 4; ++i) { acc = MFMA16(Xp[i], lds_tr4(Bh, 72, 16 * i, 16 * nt, lane), acc); acc = MFMA16(lds_tr4(Vt, 72, 16 * i, 16 * cw, lane), lds_tr4(Kh, 72, 16 * i, 16 * nt, lane), acc); }
                  *(s16x4*)(Sc.SH + uh + (size_t)(16 * nt + l15) * 64 + 16 * cw + 4 * g) = pack4(acc); }
#pragma unroll
              for (int mt = 0; mt < 4; ++mt) { f32x4 acc = {0.f, 0.f, 0.f, 0.f};
#pragma unroll
                  for (int i = 0; i <= mt; ++i) { acc = MFMA16(lds_row4(Mrb, 72, 16 * mt, 16 * i, lane), Xp[i], acc); acc = MFMA16(lds_row4(Mrk, 72, 16 * mt, 16 * i, lane), lds_tr4(Vt, 72, 16 * i, 16 * cw, lane), acc); }
                  *(s16x4*)(Sc.SY0 + uh + (size_t)(16 * cw + l15) * 64 + 16 * mt + 4 * g) = pack4(acc); }
          } else {
              const float gamv = GAM[16 * cw + l15];
#pragma unroll
              for (int nt = 0; nt < 4; ++nt) { f32x4 acc = {0.f, 0.f, 0.f, 0.f};
#pragma unroll
                  for (int i = 0; i < 4; ++i) acc = MFMA16(Xp[i], lds_tr4(Bh, 72, 16 * i, 16 * nt, lane), acc);
                  { const float gam = (nt == cw) ? gamv : 0.f;
#pragma unroll
                      for (int r = 0; r < 4; ++r) acc[r] += (l15 == 4 * g + r) ? gam : 0.f; }
                  *(s16x4*)(Sc.SG + uh + (size_t)(16 * nt + l15) * 64 + 16 * cw + 4 * g) = pack4(acc); }
#pragma unroll
              for (int mt = 0; mt < 4; ++mt) { f32x4 acc = unpack4(lds_tr4(Rt, 72, 16 * mt, 16 * cw, lane));
#pragma unroll
                  for (int i = 0; i <= mt; ++i) acc = MFMA16(lds_row4(Mrb, 72, 16 * mt, 16 * i, lane), Xp[i], acc);
                  *(s16x4*)(Sc.SQ + uh + (size_t)(16 * cw + l15) * 64 + 16 * mt + 4 * g) = pack4(acc); }
          } }
        __syncthreads();
    }
}

constexpr int M1V_LI = 0;
constexpr int M1V_PR = 33792;
constexpr int M1V_TL = M1V_PR + 36864;
constexpr int M1V_SEG = M1V_TL + 5 * 9216;
constexpr int M1V_GAM = M1V_SEG + 2048;
constexpr int M1V_CST = M1V_GAM + 256;
constexpr int M1V_END = M1V_CST + 8 * 2048;
static_assert(M1V_END <= MISC_OFF, "M1 v2 LDS map");
__device__ __forceinline__ void rwkv_m1_consts(Frame& F, const RwkvW& W) {
    LAS float* CST = (LAS float*)(F.lds + M1V_CST);
    for (int i = F.tid; i < 1536; i += 512) CST[i] = W.mu[i];
    CST[3 * 512 + F.tid] = W.k_k[F.tid]; CST[4 * 512 + F.tid] = W.k_a[F.tid]; CST[5 * 512 + F.tid] = W.r_k[F.tid]; CST[6 * 512 + F.tid] = W.w0[F.tid]; CST[7 * 512 + F.tid] = W.a0[F.tid];
    __syncthreads();
}
__device__ __forceinline__ void rwkv_m1v2_unit(Frame& F, int unit  , const bf16* P, const RwkvW& W, const RwkvS& Sc) {
    const int b = unit >> 6, c = unit & 63, t0 = c * 64; const size_t row0 = (size_t)b * SEQ + t0;
    const int w = F.wave, lane = F.lane, l15 = lane & 15, g = lane >> 4;
    LAS bf16* LI = (LAS bf16*)(F.lds + M1V_LI);
    LAS float* Ef = (LAS float*)(F.lds + M1V_PR); constexpr int ES = 68; LAS float* ALf = Ef + 64 * ES;
    LAS bf16* Lab = (LAS bf16*)(F.lds + M1V_PR); LAS bf16* Lak = Lab + 64 * 72; LAS bf16* Mrb = Lak + 64 * 72; LAS bf16* Mrk = Mrb + 64 * 72;
    LAS bf16* At = (LAS bf16*)(F.lds + M1V_TL); LAS bf16* Bt = At + 64 * 72; LAS bf16* Kt = Bt + 64 * 72; LAS bf16* Rt = Kt + 64 * 72; LAS bf16* Vt = Rt + 64 * 72;
    LAS float* SEG = (LAS float*)(F.lds + M1V_SEG); LAS float* GAM = (LAS float*)(F.lds + M1V_GAM); const LAS float* CST = (const LAS float*)(F.lds + M1V_CST);
    bf16x8 wfw[2], wfa[2], wfg[4]; u32x4 pfc[3], pfp[3];
    const int ea_mt = w & 3, ea_ntb = 2 * (w >> 2);
    const int eb_tok = F.tid >> 3, eb_cg = F.tid & 7; const size_t eb_row = row0 + eb_tok; const bool eb_prev = (t0 + eb_tok) > 0;
#define M1_LOAD_W(hh) do { const int chrow_ = (hh) * HD + 16 * ea_mt + l15; \
        wfw[0] = *(const bf16x8*)(W.WupT + (size_t)chrow_ * 64 + 8 * g); wfw[1] = *(const bf16x8*)(W.WupT + (size_t)chrow_ * 64 + 32 + 8 * g); \
        wfa[0] = *(const bf16x8*)(W.AupT + (size_t)chrow_ * 64 + 8 * g); wfa[1] = *(const bf16x8*)(W.AupT + (size_t)chrow_ * 64 + 32 + 8 * g); \
        _Pragma("unroll") for (int ks_ = 0; ks_ < 4; ++ks_) wfg[ks_] = *(const bf16x8*)(W.GupT + (size_t)chrow_ * 128 + 32 * ks_ + 8 * g); } while (0)
#define M1_LOAD_P(hh) do { const int hc_ = (hh) * HD + 8 * eb_cg; \
        _Pragma("unroll") for (int a_ = 0; a_ < 3; ++a_) { pfc[a_] = *(const u32x4*)(P + eb_row * INW + 1024 + 512 * a_ + hc_); \
            if (eb_prev) pfp[a_] = *(const u32x4*)(P + (eb_row - 1) * INW + 1024 + 512 * a_ + hc_); else pfp[a_] = (u32x4){0u, 0u, 0u, 0u}; } } while (0)
#pragma unroll
    for (int it = 0; it < 4; ++it) { const int item = F.tid + 512 * it, tok = item >> 5, jc = item & 31, j0 = 8 * jc; const size_t row = row0 + tok;
        float cv[8], pv[8]; unpack8(*(const u32x4*)(P + row * INW + 2560 + j0), cv);
        if (t0 + tok > 0) unpack8(*(const u32x4*)(P + (row - 1) * INW + 2560 + j0), pv); else { for (int j = 0; j < 8; ++j) pv[j] = 0.f; }
        const f32x4 m0 = *(const f32x4*)(W.mu + 1536 + j0), m1 = *(const f32x4*)(W.mu + 1536 + j0 + 4); float o[8];
#pragma unroll
        for (int j = 0; j < 8; ++j) { const float x = cv[j] + (pv[j] - cv[j]) * (j < 4 ? m0[j] : m1[j - 4]); o[j] = jc < 8 ? fast_tanh(x) : (jc < 16 ? x : sigmoidf_(x)); }
        *(LAS u32x4*)(LI + tok * 264 + j0) = pack8(o); }
    LDS_BARRIER();
    M1_LOAD_W(((int)blockIdx.x) & (NH - 1));
    const int rp_ea = (PROBE_STAGE == 1) ? 2 - (F.G > 100000) : 1, rp_eb = (PROBE_STAGE == 2) ? 2 - (F.G > 100000) : 1, rp_p1 = (PROBE_STAGE == 3) ? 2 - (F.G > 100000) : 1, rp_ch = (PROBE_STAGE == 4) ? 2 - (F.G > 100000) : 1, rp_cs = (PROBE_STAGE == 5) ? 2 - (F.G > 100000) : 1;
    for (int hi_ = 0; hi_ < NH; ++hi_) { const int h = (hi_ + (int)blockIdx.x) & (NH - 1);
        const size_t uh = ((size_t)unit * NH + h) * 4096;
        for (int rp = 0; rp < rp_ea; ++rp) {
          f32x4 aw[2] = {{0.f, 0.f, 0.f, 0.f}, {0.f, 0.f, 0.f, 0.f}}, aa[2] = {{0.f, 0.f, 0.f, 0.f}, {0.f, 0.f, 0.f, 0.f}}, ag[2] = {{0.f, 0.f, 0.f, 0.f}, {0.f, 0.f, 0.f, 0.f}};
#pragma unroll
          for (int q = 0; q < 2; ++q) { bf16x8 lf[8];
#pragma unroll
              for (int ks = 0; ks < 8; ++ks) lf[ks] = lds_row8(LI, 264, 16 * (ea_ntb + q), 32 * ks, lane);
#pragma unroll
              for (int ks = 0; ks < 2; ++ks) { aw[q] = MFMA32(wfw[ks], lf[ks], aw[q]); aa[q] = MFMA32(wfa[ks], lf[2 + ks], aa[q]); }
#pragma unroll
              for (int ks = 0; ks < 4; ++ks) ag[q] = MFMA32(wfg[ks], lf[4 + ks], ag[q]); }
          const int ch0 = 16 * ea_mt + 4 * g; const f32x4 w0v = *(const LAS f32x4*)(CST + 6 * 512 + h * HD + ch0), a0v = *(const LAS f32x4*)(CST + 7 * 512 + h * HD + ch0);
#pragma unroll
          for (int q = 0; q < 2; ++q) { const int tok = 16 * (ea_ntb + q) + l15; f32x4 ev, av;
#pragma unroll
              for (int r = 0; r < 4; ++r) { ev[r] = -0.60653066f * __builtin_amdgcn_rcpf(1.f + __expf(-(aw[q][r] + w0v[r]))); av[r] = __builtin_amdgcn_rcpf(1.f + __expf(-(aa[q][r] + a0v[r]))); }
              *(LAS f32x4*)(Ef + tok * ES + ch0) = ev; *(LAS f32x4*)(ALf + tok * ES + ch0) = av;
              u32x2 gw; gw.x = cvtpk_c(ag[q][0], ag[q][1]); gw.y = cvtpk_c(ag[q][2], ag[q][3]); *(u32x2*)(Sc.Sg + (row0 + tok) * RWW + h * HD + ch0) = gw; } }
        LDS_BARRIER();
        for (int rp = 0; rp < rp_cs; ++rp) {
        float csv[8];
        { const int ch = F.tid & 63, seg = F.tid >> 6;
#pragma unroll
          for (int i = 0; i < 8; ++i) csv[i] = Ef[(8 * seg + i) * ES + ch];
#pragma unroll
          for (int i = 1; i < 8; ++i) csv[i] += csv[i - 1];
          SEG[seg * 64 + ch] = csv[7]; }
        LDS_BARRIER();
        { const int ch = F.tid & 63, seg = F.tid >> 6; float sg[8];
#pragma unroll
          for (int s2 = 0; s2 < 7; ++s2) sg[s2] = SEG[s2 * 64 + ch];
          float off = 0.f;
#pragma unroll
          for (int s2 = 0; s2 < 7; ++s2) off += (s2 < seg) ? sg[s2] : 0.f;
#pragma unroll
          for (int i = 0; i < 8; ++i) Ef[(8 * seg + i) * ES + ch] = csv[i] + off; }
        LDS_BARRIER();
        }
        for (int rp = 0; rp < rp_eb; ++rp) { const int tok = eb_tok, ch0 = 8 * eb_cg, hc0 = h * HD + ch0;
          float rr[8], kx[8], vv[8], pr[8];
#define M1_SHIFT(dst, a_) do { unpack8(pfc[a_], dst); unpack8(pfp[a_], pr); const f32x4 m0 = *(const LAS f32x4*)(CST + (a_) * 512 + hc0), m1 = *(const LAS f32x4*)(CST + (a_) * 512 + hc0 + 4); \
              _Pragma("unroll") for (int j = 0; j < 8; ++j) dst[j] = dst[j] + (pr[j] - dst[j]) * (j < 4 ? m0[j] : m1[j - 4]); } while (0)
          M1_LOAD_P(h); M1_SHIFT(rr, 0); M1_SHIFT(kx, 1); M1_SHIFT(vv, 2);
          float Lt[8], Lm[8], al[8], ckk[8], cka[8], crk[8];
#pragma unroll
          for (int j = 0; j < 8; ++j) { Lt[j] = Ef[tok * ES + ch0 + j]; Lm[j] = tok > 0 ? Ef[(tok - 1) * ES + ch0 + j] : 0.f; al[j] = ALf[tok * ES + ch0 + j]; ckk[j] = CST[3 * 512 + hc0 + j]; cka[j] = CST[4 * 512 + hc0 + j]; crk[j] = CST[5 * 512 + hc0 + j]; }
          float kk[8], km[8]; float ss = 0.f, bs_ = 0.f;
#pragma unroll
          for (int j = 0; j < 8; ++j) { kk[j] = kx[j] * ckk[j]; ss += kk[j] * kk[j]; km[j] = kx[j] * (1.f + (al[j] - 1.f) * cka[j]); bs_ += rr[j] * km[j] * crk[j]; }
          ss += __shfl_xor(ss, 1); ss += __shfl_xor(ss, 2); ss += __shfl_xor(ss, 4); bs_ += __shfl_xor(bs_, 1); bs_ += __shfl_xor(bs_, 2); bs_ += __shfl_xor(bs_, 4);
          const float inv = 1.f / fmaxf(sqrtf(ss), 1e-12f);
          if (eb_cg == 0) Sc.Sbsc[eb_row * NH + h] = bs_;
          float oA[8], oB[8], oK[8], oR[8];
#pragma unroll
          for (int j = 0; j < 8; ++j) { const float kn = kk[j] * inv, bb = kn * al[j]; const float eL = __expf(Lt[j]), einv = __builtin_amdgcn_rcpf(eL);
              oA[j] = -kn * __expf(Lm[j]); oB[j] = bb * einv; oK[j] = km[j] * einv; oR[j] = rr[j] * eL; if (tok == 63) GAM[ch0 + j] = eL; }
          *(LAS u32x4*)(At + tok * 72 + ch0) = pack8(oA); *(LAS u32x4*)(Bt + tok * 72 + ch0) = pack8(oB); *(LAS u32x4*)(Kt + tok * 72 + ch0) = pack8(oK); *(LAS u32x4*)(Rt + tok * 72 + ch0) = pack8(oR);
          *(LAS u32x4*)(Vt + tok * 72 + ch0) = pack8(vv); }
        { const int hn_ = ((hi_ + 1 < NH ? hi_ + 1 : hi_) + (int)blockIdx.x) & (NH - 1); M1_LOAD_W(hn_); }
        LDS_BARRIER();
        for (int rp = 0; rp < rp_p1; ++rp) for (int i5 = 0; i5 < 5; ++i5) { const int q = w + 8 * i5, mat = q / 10, idx = q % 10; const int ti = idx < 1 ? 0 : (idx < 3 ? 1 : (idx < 6 ? 2 : 3)), si = idx - ti * (ti + 1) / 2;
            const LAS bf16* X = mat < 2 ? At : Rt; const LAS bf16* Yk = (mat & 1) ? Kt : Bt; LAS bf16* O = Lab + mat * 64 * 72;
            f32x4 acc = {0.f, 0.f, 0.f, 0.f};
#pragma unroll
            for (int ks = 0; ks < 2; ++ks) acc = MFMA32(lds_row8(Yk, 72, 16 * si, 32 * ks, lane), lds_row8(X, 72, 16 * ti, 32 * ks, lane), acc);
            const int t = 16 * ti + l15, s0 = 16 * si + 4 * g; const int lim = mat < 2 ? t : t + 1;
#pragma unroll
            for (int r = 0; r < 4; ++r) acc[r] = (s0 + r < lim) ? acc[r] : 0.f;
            *(LAS s16x4*)(O + t * 72 + s0) = pack4(acc); }
        LDS_BARRIER();
        for (int rp = 0; rp < rp_ch; ++rp) { const bool isU = w < 4; const int cw = w & 3; const f32x4 zero = {0.f, 0.f, 0.f, 0.f};
          s16x4 TTp[4];
#pragma unroll
          for (int hb = 0; hb < 2; ++hb) { s16x4 fr[2], ft[2];
#pragma unroll
            for (int i = 0; i < 2; ++i) { fr[i] = lds_row4(Lab, 72, 16 * (2 * hb + i), 16 * (2 * hb + i), lane); ft[i] = lds_tr4(Lab, 72, 16 * (2 * hb + i), 16 * (2 * hb + i), lane); }
            f32x4 L2[2], L2T[2], L4[2], L4T[2], L8[2], TT[2]; s16x4 pL2[2], pL2T[2], pL4[2], pL4T[2];
#pragma unroll
            for (int i = 0; i < 2; ++i) { L2[i] = MFMA16(fr[i], ft[i], zero); L2T[i] = MFMA16(ft[i], fr[i], zero); }
#pragma unroll
            for (int i = 0; i < 2; ++i) { pL2[i] = pack4(L2[i]); pL2T[i] = pack4(L2T[i]); TT[i] = unpack4(fr[i]);
#pragma unroll
                for (int r = 0; r < 4; ++r) TT[i][r] += (l15 == 4 * g + r) ? 1.f : 0.f; }
#pragma unroll
            for (int i = 0; i < 2; ++i) { L4[i] = MFMA16(pL2T[i], pL2[i], zero); L4T[i] = MFMA16(pL2[i], pL2T[i], zero); TT[i] = MFMA16(pL2[i], pack4(TT[i]), TT[i]); }
#pragma unroll
            for (int i = 0; i < 2; ++i) { pL4[i] = pack4(L4[i]); pL4T[i] = pack4(L4T[i]); }
#pragma unroll
            for (int i = 0; i < 2; ++i) { L8[i] = MFMA16(pL4T[i], pL4[i], zero); TT[i] = MFMA16(pL4[i], pack4(TT[i]), TT[i]); }
#pragma unroll
            for (int i = 0; i < 2; ++i) { TT[i] = MFMA16(pack4(L8[i]), pack4(TT[i]), TT[i]); TTp[2 * hb + i] = pack4(TT[i]); } }
          s16x4 Vf[4]; f32x4 z[4];
          if (isU) { s16x4 lk[10];
#pragma unroll
              for (int j = 0; j < 4; ++j) Vf[j] = lds_tr4(Vt, 72, 16 * j, 16 * cw, lane);
#pragma unroll
              for (int i = 0; i < 4; ++i)
#pragma unroll
                  for (int j = 0; j <= i; ++j) lk[i * (i + 1) / 2 + j] = lds_row4(Lak, 72, 16 * i, 16 * j, lane);
#pragma unroll
              for (int i = 0; i < 4; ++i) { z[i] = zero;
#pragma unroll
                  for (int j = 0; j <= i; ++j) z[i] = MFMA16(lk[i * (i + 1) / 2 + j], Vf[j], z[i]); }
          } else {
#pragma unroll
              for (int i = 0; i < 4; ++i) { Vf[i] = (s16x4){0, 0, 0, 0}; z[i] = unpack4(lds_tr4(At, 72, 16 * i, 16 * cw, lane)); } }
          s16x4 Xp[4];
          { s16x4 lb[6];
#pragma unroll
            for (int i = 1; i < 4; ++i)
#pragma unroll
                for (int j = 0; j < i; ++j) lb[i * (i - 1) / 2 + j] = lds_row4(Lab, 72, 16 * i, 16 * j, lane);
#pragma unroll
            for (int i = 0; i < 4; ++i) { f32x4 zz = z[i];
#pragma unroll
                for (int j = 0; j < i; ++j) zz = MFMA16(lb[i * (i - 1) / 2 + j], Xp[j], zz);
                Xp[i] = pack4(MFMA16(TTp[i], pack4(zz), zero)); } }
          if (isU) {
#pragma unroll
              for (int nt = 0; nt < 4; ++nt) { s16x4 bf_[4], kf_[4];
#pragma unroll
                  for (int i = 0; i < 4; ++i) { bf_[i] = lds_tr4(Bt, 72, 16 * i, 16 * nt, lane); kf_[i] = lds_tr4(Kt, 72, 16 * i, 16 * nt, lane); }
                  f32x4 a1 = zero, a2 = zero;
#pragma unroll
                  for (int i = 0; i < 4; ++i) { a1 = MFMA16(Xp[i], bf_[i], a1); a2 = MFMA16(Vf[i], kf_[i], a2); }
                  const float gm = GAM[16 * nt + l15]; const f32x4 acc = (a1 + a2) * gm;
                  *(s16x4*)(Sc.SH + uh + (size_t)(16 * nt + l15) * 64 + 16 * cw + 4 * g) = pack4(acc); }
#pragma unroll
              for (int mt = 0; mt < 4; ++mt) { s16x4 mb[4], mk[4];
#pragma unroll
                  for (int i = 0; i <= mt; ++i) { mb[i] = lds_row4(Mrb, 72, 16 * mt, 16 * i, lane); mk[i] = lds_row4(Mrk, 72, 16 * mt, 16 * i, lane); }
                  f32x4 a1 = zero, a2 = zero;
#pragma unroll
                  for (int i = 0; i <= mt; ++i) { a1 = MFMA16(mb[i], Xp[i], a1); a2 = MFMA16(mk[i], Vf[i], a2); }
                  *(s16x4*)(Sc.SY0 + uh + (size_t)(16 * cw + l15) * 64 + 16 * mt + 4 * g) = pack4(a1 + a2); }
          } else {
#pragma unroll
              for (int nt = 0; nt < 4; ++nt) { s16x4 bf_[4];
#pragma unroll
                  for (int i = 0; i < 4; ++i) bf_[i] = lds_tr4(Bt, 72, 16 * i, 16 * nt, lane);
                  f32x4 a1 = zero, a2 = zero;
                  a1 = MFMA16(Xp[0], bf_[0], a1); a2 = MFMA16(Xp[1], bf_[1], a2); a1 = MFMA16(Xp[2], bf_[2], a1); a2 = MFMA16(Xp[3], bf_[3], a2);
                  f32x4 acc = a1 + a2; const float gm = GAM[16 * nt + l15]; const float dg = (nt == cw) ? 1.f : 0.f;
#pragma unroll
                  for (int r = 0; r < 4; ++r) acc[r] = (acc[r] + ((l15 == 4 * g + r) ? dg : 0.f)) * gm;
                  *(s16x4*)(Sc.SG + uh + (size_t)(16 * nt + l15) * 64 + 16 * cw + 4 * g) = pack4(acc); }
#pragma unroll
              for (int mt = 0; mt < 4; ++mt) { s16x4 mb[4]; const s16x4 rf = lds_tr4(Rt, 72, 16 * mt, 16 * cw, lane);
#pragma unroll
                  for (int i = 0; i <= mt; ++i) mb[i] = lds_row4(Mrb, 72, 16 * mt, 16 * i, lane);
                  f32x4 acc = unpack4(rf);
#pragma unroll
                  for (int i = 0; i <= mt; ++i) acc = MFMA16(mb[i], Xp[i], acc);
                  *(s16x4*)(Sc.SQ + uh + (size_t)(16 * cw + l15) * 64 + 16 * mt + 4 * g) = pack4(acc); }
          } }
        LDS_BARRIER();
    }
#undef M1_LOAD_W
#undef M1_LOAD_P
#undef M1_SHIFT
}

constexpr int M2_S = 0;
__device__ __forceinline__ void rwkv_m2_unit(Frame& F, int unit  , const RwkvS& Sc) {
    const int b = unit >> 3, h = unit & 7; const int w = F.wave, lane = F.lane, l15 = lane & 15, g = lane >> 4; const int mt = w >> 1, ntb = 2 * (w & 1);
    LAS bf16* Sb = (LAS bf16*)(F.lds + M2_S);
    f32x4 acc[2] = {{0.f, 0.f, 0.f, 0.f}, {0.f, 0.f, 0.f, 0.f}};
    constexpr int PF = 8;
    bf16x8 Gf[PF][2][2]; u32x2 Hf[PF][2];
#define M2_LOAD(slot, cc) do { const size_t uh_ = ((size_t)(b * 64 + (cc)) * NH + h) * 4096; _Pragma("unroll") for (int q = 0; q < 2; ++q) { const size_t ro = uh_ + (size_t)(16 * (ntb + q) + l15) * 64; \
        Gf[slot][q][0] = *(const bf16x8*)(Sc.SG + ro + 8 * g); Gf[slot][q][1] = *(const bf16x8*)(Sc.SG + ro + 32 + 8 * g); Hf[slot][q] = *(const u32x2*)(Sc.SH + ro + 16 * mt + 4 * g); } } while (0)
#pragma unroll
    for (int u = 0; u < PF; ++u) M2_LOAD(u, u);
    for (int c0 = 0; c0 < 64; c0 += PF) {
#pragma unroll
        for (int u = 0; u < PF; ++u) { const int c = c0 + u;
            const size_t uh = ((size_t)(b * 64 + c) * NH + h) * 4096; LAS bf16* buf = Sb + (u & 1) * 64 * 72;
#pragma unroll
            for (int q = 0; q < 2; ++q) { const s16x4 p = pack4(acc[q]); *(LAS s16x4*)(buf + (16 * (ntb + q) + l15) * 72 + 16 * mt + 4 * g) = p; *(s16x4*)(Sc.SS + uh + (size_t)(16 * (ntb + q) + l15) * 64 + 16 * mt + 4 * g) = p; }
            LDS_BARRIER();
            const bf16x8 a0 = lds_tr8(buf, 72, 0, 16 * mt, lane), a1 = lds_tr8(buf, 72, 32, 16 * mt, lane);
#pragma unroll
            for (int q = 0; q < 2; ++q) { f32x4 z; z[0] = __builtin_bit_cast(float, Hf[u][q].x << 16); z[1] = __builtin_bit_cast(float, Hf[u][q].x & 0xffff0000u); z[2] = __builtin_bit_cast(float, Hf[u][q].y << 16); z[3] = __builtin_bit_cast(float, Hf[u][q].y & 0xffff0000u);
                z = MFMA32(a0, Gf[u][q][0], z); acc[q] = MFMA32(a1, Gf[u][q][1], z); }
            { const int cn = c + PF < 64 ? c + PF : 63; M2_LOAD(u, cn); } }
    }
#undef M2_LOAD
    LDS_BARRIER();
}

constexpr int M3_SLOT = 9216 * 2 + 64 * 68 * 4;
__device__ __forceinline__ void rwkv_m3_unit(Frame& F, int unit  , const bf16* P, bf16* Y, const RwkvW& W, const RwkvS& Sc) {
    const int b = unit >> 6, c = unit & 63, t0 = c * 64; const size_t row0 = (size_t)b * SEQ + t0;
    const int w = F.wave, lane = F.lane, l15 = lane & 15, g = lane >> 4, hw = w >> 2, mt = w & 3, tl = F.tid & 255;
    LAS bf16* Qt = (LAS bf16*)(F.lds + hw * M3_SLOT); LAS bf16* St = Qt + 64 * 72; LAS float* Out = (LAS float*)(F.lds + hw * M3_SLOT + 2 * 9216);
    for (int hp = 0; hp < 4; ++hp) { const int h = 2 * hp + hw; const size_t uh = ((size_t)unit * NH + h) * 4096;
#pragma unroll
        for (int r = 0; r < 2; ++r) { const int off = 8 * (tl + 256 * r), rr = off >> 6, cc = off & 63;
            *(LAS u32x4*)(Qt + rr * 72 + cc) = *(const u32x4*)(Sc.SQ + uh + off); *(LAS u32x4*)(St + rr * 72 + cc) = *(const u32x4*)(Sc.SS + uh + off); }
        LDS_BARRIER();
        f32x4 acc[4];
#pragma unroll
        for (int nt = 0; nt < 4; ++nt) acc[nt] = unpack4(*(const s16x4*)(Sc.SY0 + uh + (size_t)(16 * nt + l15) * 64 + 16 * mt + 4 * g));
#pragma unroll
        for (int ks = 0; ks < 2; ++ks) { const bf16x8 a = lds_tr8(Qt, 72, 32 * ks, 16 * mt, lane);
#pragma unroll
            for (int nt = 0; nt < 4; ++nt) acc[nt] = MFMA32(a, lds_tr8(St, 72, 32 * ks, 16 * nt, lane), acc[nt]); }
#pragma unroll
        for (int r = 0; r < 4; ++r) { float s = (acc[0][r] + acc[1][r]) + (acc[2][r] + acc[3][r]);
            s += __shfl_xor(s, 1); s += __shfl_xor(s, 2); s += __shfl_xor(s, 4); s += __shfl_xor(s, 8); const float mean = s * (1.f / HD); float q = 0.f;
#pragma unroll
            for (int nt = 0; nt < 4; ++nt) { const float d = acc[nt][r] - mean; q += d * d; }
            q += __shfl_xor(q, 1); q += __shfl_xor(q, 2); q += __shfl_xor(q, 4); q += __shfl_xor(q, 8); const float rstd = __builtin_amdgcn_rsqf(q * (1.f / HD) + GN_EPS);
#pragma unroll
            for (int nt = 0; nt < 4; ++nt) { const int v = 16 * nt + l15; Out[(16 * mt + 4 * g + r) * 68 + v] = (acc[nt][r] - mean) * rstd * W.lnx_w[h * HD + v] + W.lnx_b[h * HD + v]; } }
        LDS_BARRIER();
        { const int t = tl >> 2, cq = tl & 3, v0 = 16 * cq, hv0 = h * HD + v0; const size_t row = row0 + t; const bool has_prev = (t0 + t) > 0; const float bsc = Sc.Sbsc[row * NH + h];
#pragma unroll
          for (int half = 0; half < 2; ++half) { float cv[8], pv[8], gv[8], o[8]; const int col = 2048 + hv0 + 8 * half;
              unpack8(*(const u32x4*)(P + row * INW + col), cv); if (has_prev) unpack8(*(const u32x4*)(P + (row - 1) * INW + col), pv); else { for (int j = 0; j < 8; ++j) pv[j] = 0.f; }
              unpack8(*(const u32x4*)(Sc.Sg + row * RWW + hv0 + 8 * half), gv);
              const f32x4 m0 = *(const f32x4*)(W.mu + col - 1024), m1 = *(const f32x4*)(W.mu + col - 1024 + 4);
#pragma unroll
              for (int j = 0; j < 8; ++j) { const float vs = cv[j] + (pv[j] - cv[j]) * (j < 4 ? m0[j] : m1[j - 4]); o[j] = (Out[t * 68 + v0 + 8 * half + j] + bsc * vs) * gv[j]; }
              *(u32x4*)(Y + row * D + GMW + hv0 + 8 * half) = pack8(o); } }
        LDS_BARRIER();
    }
}


__device__ __forceinline__ void rwkv_m3_units(Frame& F, int u0, int ustep, int nunits, const bf16* P, bf16* Y, const RwkvW& W, const RwkvS& Sc) {
    if (u0 >= nunits) return;
    const int w = F.wave, lane = F.lane, l15 = lane & 15, g = lane >> 4, hw = w >> 2, mt = w & 3, tl = F.tid & 255;
    LAS bf16* Qt = (LAS bf16*)(F.lds + hw * M3_SLOT); LAS bf16* St = Qt + 64 * 72; LAS float* Out = (LAS float*)(F.lds + hw * M3_SLOT + 2 * 9216);
    const int nu = (nunits - u0 + ustep - 1) / ustep, niter = nu * 4;
    LAS float* TB = (LAS float*)(F.lds + 73728);
    TB[F.tid] = W.lnx_w[F.tid]; TB[512 + F.tid] = W.lnx_b[F.tid]; TB[1024 + F.tid] = W.mu[1024 + F.tid];
    u32x4 qf[2], sf[2]; s16x4 y0f[4];
#define M3_PREF(itn) do { const int un_ = u0 + ((itn) >> 2) * ustep, hn_ = 2 * ((itn) & 3) + hw; const size_t uhn_ = ((size_t)un_ * NH + hn_) * 4096; \
        _Pragma("unroll") for (int r = 0; r < 2; ++r) { qf[r] = *(const u32x4*)(Sc.SQ + uhn_ + 8 * (tl + 256 * r)); sf[r] = *(const u32x4*)(Sc.SS + uhn_ + 8 * (tl + 256 * r)); } \
        _Pragma("unroll") for (int nt = 0; nt < 4; ++nt) y0f[nt] = *(const s16x4*)(Sc.SY0 + uhn_ + (size_t)(16 * nt + l15) * 64 + 16 * mt + 4 * g); } while (0)
    M3_PREF(0);
    for (int it = 0; it < niter; ++it) {
        const int unit = u0 + (it >> 2) * ustep, h = 2 * (it & 3) + hw; const int b = unit >> 6, c = unit & 63, t0 = c * 64; const size_t row0 = (size_t)b * SEQ + t0;
#pragma unroll
        for (int r = 0; r < 2; ++r) { const int off = 8 * (tl + 256 * r), rr = off >> 6, cc = off & 63; *(LAS u32x4*)(Qt + rr * 72 + cc) = qf[r]; *(LAS u32x4*)(St + rr * 72 + cc) = sf[r]; }
        f32x4 acc[4];
#pragma unroll
        for (int nt = 0; nt < 4; ++nt) acc[nt] = unpack4(y0f[nt]);
        const int t = tl >> 2, cq = tl & 3, v0 = 16 * cq, hv0 = h * HD + v0; const size_t row = row0 + t; const bool has_prev = (t0 + t) > 0;
        u32x4 cvr[2], pvr[2], gvr[2]; const float bsc = Sc.Sbsc[row * NH + h];
#pragma unroll
        for (int half = 0; half < 2; ++half) { const int col = 2048 + hv0 + 8 * half; cvr[half] = *(const u32x4*)(P + row * INW + col);
            pvr[half] = *(const u32x4*)(P + (has_prev ? row - 1 : row) * INW + col); gvr[half] = *(const u32x4*)(Sc.Sg + row * RWW + hv0 + 8 * half); }
        { const int itn = it + 1 < niter ? it + 1 : it; M3_PREF(itn); }
        LDS_BARRIER();
#pragma unroll
        for (int ks = 0; ks < 2; ++ks) { const bf16x8 a = lds_tr8(Qt, 72, 32 * ks, 16 * mt, lane);
#pragma unroll
            for (int nt = 0; nt < 4; ++nt) acc[nt] = MFMA32(a, lds_tr8(St, 72, 32 * ks, 16 * nt, lane), acc[nt]); }
#pragma unroll
        for (int r = 0; r < 4; ++r) { float s2 = (acc[0][r] + acc[1][r]) + (acc[2][r] + acc[3][r]);
            s2 += __shfl_xor(s2, 1); s2 += __shfl_xor(s2, 2); s2 += __shfl_xor(s2, 4); s2 += __shfl_xor(s2, 8); const float mean = s2 * (1.f / HD); float q = 0.f;
#pragma unroll
            for (int nt = 0; nt < 4; ++nt) { const float d = acc[nt][r] - mean; q += d * d; }
            q += __shfl_xor(q, 1); q += __shfl_xor(q, 2); q += __shfl_xor(q, 4); q += __shfl_xor(q, 8); const float rstd = __builtin_amdgcn_rsqf(q * (1.f / HD) + GN_EPS);
#pragma unroll
            for (int nt = 0; nt < 4; ++nt) { const int v = 16 * nt + l15; Out[(16 * mt + 4 * g + r) * 68 + v] = (acc[nt][r] - mean) * rstd * TB[h * HD + v] + TB[512 + h * HD + v]; } }
        LDS_BARRIER();
#pragma unroll
        for (int half = 0; half < 2; ++half) { float cv[8], pv[8], gv[8], o[8];
            unpack8(cvr[half], cv); unpack8(pvr[half], pv); unpack8(gvr[half], gv);
            const f32x4 m0 = *(const LAS f32x4*)(TB + 1024 + hv0 + 8 * half), m1 = *(const LAS f32x4*)(TB + 1024 + hv0 + 8 * half + 4);
#pragma unroll
            for (int j = 0; j < 8; ++j) { const float pvj = has_prev ? pv[j] : 0.f; const float vs = cv[j] + (pvj - cv[j]) * (j < 4 ? m0[j] : m1[j - 4]); o[j] = (Out[t * 68 + v0 + 8 * half + j] + bsc * vs) * gv[j]; }
            *(u32x4*)(Y + row * D + GMW + hv0 + 8 * half) = pack8(o); }
    }
#undef M3_PREF
    LDS_BARRIER();
}

__device__ __forceinline__ void rwkv_apply_naive(Frame& F, int unit, const bf16* P, bf16* Y, const RwkvW& W, const RwkvS& Sc) {
    const int b = unit >> 3, h = unit & 7;
    LAS float* S = (LAS float*)F.lds; LAS float* Gs = S + 64 * 65; LAS float* Hs = Gs + 64 * 65; LAS float* Qs = Hs + 64 * 65; LAS float* Ys = Qs + 64 * 65; LAS float* Sn = Ys + 64 * 65;
    for (int i = F.tid; i < 64 * 65; i += 512) S[i] = 0.f;
    __syncthreads();
    for (int c = 0; c < 64; ++c) { const size_t uh = ((size_t)(b * 64 + c) * NH + h) * 4096; const size_t row0 = (size_t)b * SEQ + c * 64;
        for (int i = F.tid; i < 4096; i += 512) { const int r = i >> 6, cc = i & 63;
            Gs[cc * 65 + r] = bf2f(Sc.SG[uh + i]);
            Hs[cc * 65 + r] = bf2f(Sc.SH[uh + i]);
            Qs[cc * 65 + r] = bf2f(Sc.SQ[uh + i]);
            Ys[cc * 65 + r] = bf2f(Sc.SY0[uh + i]); }
        __syncthreads();
        for (int i = F.tid; i < 4096; i += 512) { const int t = i >> 6, v = i & 63; float a = Ys[t * 65 + v];
            if (DBG_VAR != 1) for (int k = 0; k < 64; ++k) a += Qs[t * 65 + k] * S[v * 65 + k];
            if (DBG_VAR == 2) a = 0.f;
            Ys[t * 65 + v] = a; }
        for (int i = F.tid; i < 4096; i += 512) { const int v = i >> 6, k2 = i & 63; float a = Hs[v * 65 + k2];
            if (DBG_VAR == 6) a += S[v * 65 + k2] * Gs[k2 * 65 + k2]; else if (DBG_VAR != 3) for (int k = 0; k < 64; ++k) a += S[v * 65 + k] * Gs[k * 65 + k2];
            if (DBG_VAR == 7) a = Hs[v * 65 + k2] + 0.5f * (a - Hs[v * 65 + k2]);
            Sn[v * 65 + k2] = a; }
        __syncthreads();
        for (int i = F.tid; i < 4096; i += 512) { const int v = i >> 6, k2 = i & 63; S[v * 65 + k2] = Sn[v * 65 + k2]; }
        { const int t = F.tid >> 3, cg = F.tid & 7, v0 = 8 * cg, hv0 = h * HD + v0; const size_t row = row0 + t; const bool has_prev = (c * 64 + t) > 0; const float bsc = Sc.Sbsc[row * NH + h];
          float yv[8]; float sm = 0.f;
          for (int j = 0; j < 8; ++j) { yv[j] = Ys[t * 65 + v0 + j]; sm += yv[j]; }
          sm += __shfl_xor(sm, 1); sm += __shfl_xor(sm, 2); sm += __shfl_xor(sm, 4); const float mean = sm * (1.f / HD); float q = 0.f;
          for (int j = 0; j < 8; ++j) { yv[j] -= mean; q += yv[j] * yv[j]; }
          q += __shfl_xor(q, 1); q += __shfl_xor(q, 2); q += __shfl_xor(q, 4); const float rstd = __builtin_amdgcn_rsqf(q * (1.f / HD) + GN_EPS);
          float cv[8], pv[8], gv[8], o[8]; const int col = 2048 + hv0;
          unpack8(*(const u32x4*)(P + row * INW + col), cv); if (has_prev) unpack8(*(const u32x4*)(P + (row - 1) * INW + col), pv); else { for (int j = 0; j < 8; ++j) pv[j] = 0.f; }
          unpack8(*(const u32x4*)(Sc.Sg + row * RWW + hv0), gv);
          for (int j = 0; j < 8; ++j) { const float vs = cv[j] + (pv[j] - cv[j]) * W.mu[col - 1024 + j]; o[j] = (yv[j] * rstd * W.lnx_w[hv0 + j] + W.lnx_b[hv0 + j] + bsc * vs) * gv[j]; }
          *(u32x4*)(Y + row * D + GMW + hv0) = pack8(o); }
        __syncthreads();
    }
}

enum Phase { PH_PRO = 0, PH_G1_0, PH_M1_0, PH_M2_0, PH_M3_0, PH_G2_0, PH_G3_0, PH_G4_0, PH_G1_1, PH_M1_1, PH_M2_1, PH_M3_1, PH_G2_1, PH_CV, PH_R2, PH_GU_A, PH_DN_A, PH_GU_B, PH_DN_B, PH_FIN, PH_COUNT };

__global__ void __launch_bounds__(512, 2) fwd(Args args) {
    extern __shared__ __attribute__((aligned(16))) unsigned char lds_raw[];
    Frame F;
    F.lds = (LAS unsigned char*)lds_raw;
    F.tid = threadIdx.x; F.lane = F.tid & 63; F.wave = __builtin_amdgcn_readfirstlane(F.tid >> 6);
    F.G = gridDim.x; F.gw = blockIdx.x * 8 + F.wave; F.NGW = F.G * 8;
    unsigned char* ws = args.ws;
    gu32* ctl = (gu32*)(ws + WS_CTL);
    volatile LAS unsigned* MISC = (volatile LAS unsigned*)(F.lds + MISC_OFF);
    if (F.tid < 32) ((LAS unsigned*)(F.lds + MISC_OFF))[F.tid] = 0u;
    __syncthreads();
    XcdBarrier bar; bar.bar = (unsigned*)(ctl + CW_BAR); bar.x = 0; bar.st = nullptr;
#if !MK_PER_PHASE
    bar = xcd_barrier_post((unsigned*)(ctl + CW_BAR), MISC + 8);
#endif
    const int lo = args.ph_lo, hi = args.ph_hi;
#define IN(k) (lo <= (k) && (k) < hi)
#define STAGGER_WAIT() do { if (STAGGER_TICKS > 0 && (blockIdx.x & 8)) { const unsigned long long t0_ = __builtin_amdgcn_s_memrealtime(); while (__builtin_amdgcn_s_memrealtime() - t0_ < (unsigned long long)STAGGER_TICKS) __builtin_amdgcn_s_sleep(32); } } while (0)
#define SEAM(k) do { if (IN(k) && IN((k) + 1)) xcd_barrier(bar); } while (0)

    const float* x_in = args.in[I_X];
    bf16* WinT = (bf16*)(ws + WS_WIN); bf16* WoutT = (bf16*)(ws + WS_WOUT); bf16* WguT = (bf16*)(ws + WS_WGU); bf16* WdT = (bf16*)(ws + WS_WD);
    bf16* XB = (bf16*)(ws + WS_XB); bf16* PB = (bf16*)(ws + WS_P); bf16* YB = (bf16*)(ws + WS_Y); bf16* HB = (bf16*)(ws + WS_P);
    bf16* MWgu = (bf16*)(ws + WS_MOEW_GU); bf16* MWd = (bf16*)(ws + (MOE8_GU ? WS_MOEW8_D : WS_MOEW_D)); bf16* MH = (bf16*)(ws + WS_MOEH);
    unsigned char* MWgu8 = ws + WS_MOEW8_GU; unsigned char* MWd8 = ws + WS_MOEW8_D; unsigned char* MH8 = ws + WS_MOEH; unsigned char* MH8b = ws + WS_MOEH + 119 * MiB; unsigned char* XB8 = ws + WS_XB8;
    float* ssq0 = (float*)(ctl + CW_SSQ); float* ssq1 = (float*)(ws + WS_SSQP); float* ssq2 = ssq1 + (size_t)NTOK * 16;
    bf16* WupT = (bf16*)(ws + WS_SMALLW + SW_WUP); bf16* AupT = (bf16*)(ws + WS_SMALLW + SW_AUP); bf16* GupT = (bf16*)(ws + WS_SMALLW + SW_GUP); bf16* WsB = (bf16*)(ws + WS_SMALLW + SW_WS);
    RwkvS RS{(bf16*)(ws + WS_SCR), (bf16*)(ws + WS_SCR + 32 * MiB), (bf16*)(ws + WS_SCR + 64 * MiB), (bf16*)(ws + WS_SCR + 96 * MiB), (bf16*)(ws + WS_SCR + 128 * MiB), (bf16*)((unsigned char*)args.out), (float*)((unsigned char*)args.out + 32 * MiB)};
    unsigned char* misc = ws + WS_MISC;
    int* tok_e = (int*)(misc + MS_TOKE); float* tok_g = (float*)(misc + MS_TOKG); float* rs_moe = (float*)(misc + MS_RS); int* bcnt = (int*)(misc + MS_BCNT);
    int* row_tok = (int*)(misc + MS_ROWTOK); float* row_gate = (float*)(misc + MS_ROWGATE); int* panel = (int*)(misc + MS_PANEL); float* row_rs = (float*)(misc + MS_ROWRS);

#define DEFERRED_CONVERT(FR) do { int itb_ = 0; \
        convert_matrix(FR, args.in[I_W_IN] + (size_t)D * INW, D, INW, WinT + (size_t)INW * D, 0, args.in[I_NORM_MIX] + D, 0, itb_); \
        convert_matrix(FR, args.in[I_W_OUT], D, D, WoutT, 0, nullptr, 0, itb_); convert_matrix(FR, args.in[I_W_OUT] + (size_t)D * D, D, D, WoutT + (size_t)D * D, 0, nullptr, 0, itb_); \
        convert_matrix(FR, args.in[I_FFN_WG], D, FF, WguT, 1, args.in[I_NORM_FFN], 0, itb_); convert_matrix(FR, args.in[I_FFN_WU], D, FF, WguT, 2, args.in[I_NORM_FFN], 0, itb_); \
        convert_matrix(FR, args.in[I_FFN_WD], FF, D, WdT, 0, nullptr, 0, itb_); } while (0)
    if (IN(PH_PRO)) for (int rep = 0; rep < (PROBE_DUP == 4 ? 2 : 1); ++rep) {
        int itb = 0;
        convert_matrix(F, args.in[I_W_IN], D, INW, WinT, 0, args.in[I_NORM_MIX], 0, itb);
        if (!(DEFER_CONVERT && F.G == 256)) { DEFERRED_CONVERT(F); }
        { const size_t gt = (size_t)blockIdx.x * 512 + F.tid, gn = (size_t)F.G * 512;
          for (size_t i = gt; i < (size_t)2 * RWW * 64; i += gn) { const int l = (int)(i / (RWW * 64)), r = (int)(i % (RWW * 64)), ch = r / 64, j = r % 64;
              WupT[i] = (bf16)f2bf(args.in[I_RW_W_UP][(size_t)l * 64 * RWW + (size_t)j * RWW + ch]); AupT[i] = (bf16)f2bf(args.in[I_RW_A_UP][(size_t)l * 64 * RWW + (size_t)j * RWW + ch]); }
          for (size_t i = gt; i < (size_t)2 * RWW * 128; i += gn) { const int l = (int)(i / (RWW * 128)), r = (int)(i % (RWW * 128)), ch = r / 128, j = r % 128;
              GupT[i] = (bf16)f2bf(args.in[I_RW_G_UP][(size_t)l * 128 * RWW + (size_t)j * RWW + ch]); }
          for (size_t i = gt; i < (size_t)2 * NH * GCH * GCH; i += gn) { const int t = (int)((i / GCH) % GCH), s2 = (int)(i % GCH); WsB[i] = (bf16)(s2 <= t ? f2bf(args.in[I_GM_WS][i]) : 0u); } }
        for (int m = F.gw; m < NTOK; m += F.NGW) {
            const GAS f32x4* xr = (const GAS f32x4*)(x_in + (size_t)m * D) + F.lane; GAS u32x2* o8 = (GAS u32x2*)(XB + (size_t)m * D) + F.lane; float s = 0.f;
#pragma unroll
            for (int j = 0; j < 4; ++j) { const f32x4 v = xr[64 * j]; s += (v.x * v.x + v.y * v.y) + (v.z * v.z + v.w * v.w); u32x2 w; w.x = pk2(v.x, v.y); w.y = pk2(v.z, v.w); o8[64 * j] = w; }
            s = wave_sum(s); if (F.lane == 0) ssq0[m] = s;
        }
    }
    SEAM(PH_PRO);
    if (PROBE_DUP == 6) { for (int q_ = 0; q_ < 10; ++q_) xcd_barrier(bar); }

#define LAYER_MIXER(L, PH1, PHA, PHB, PHC, PH2, XBASE, BASE32, SSQ_IN, NP_IN, SSQ_OUT, HAS_OUT) \
    if (IN(PH1)) { pg8::DenseSched S; S.init(XB, WinT + (size_t)(L) * INW * D, NTOK, INW, 2 * D, F.G, (int)blockIdx.x); \
        pg8::EpiScaleBf16<NP_IN> E{PB, INW, SSQ_IN, (LAS float*)(F.lds + RING_BYTES + 4096)}; pg8::gemm_phase(F.lds, 2 * D, S, E); } \
    if (DEFER_CONVERT && (L) == 0 && IN(PH1) && F.G == 256 && (int)blockIdx.x >= 128) { __syncthreads(); Frame F2 = F; F2.gw = ((int)blockIdx.x - 128) * 8 + F.wave; F2.NGW = 128 * 8; DEFERRED_CONVERT(F2); __syncthreads(); } \
    if (PROBE_DUP == 1 && (L) == 0 && IN(PH1)) { pg8::DenseSched S; S.init(XB, WinT + (size_t)(L) * INW * D, NTOK, INW, 2 * D, F.G, (int)blockIdx.x); \
        pg8::EpiScaleBf16<NP_IN> E{PB, INW, SSQ_IN, (LAS float*)(F.lds + RING_BYTES + 4096)}; pg8::gemm_phase(F.lds, 2 * D, S, E); } \
    SEAM(PH1); \
    { RwkvW RW{args.in[I_SHIFT_MU] + (L) * 1792, args.in[I_RW_W0] + (L) * RWW, args.in[I_RW_A0] + (L) * RWW, args.in[I_RW_K_K] + (L) * RWW, args.in[I_RW_K_A] + (L) * RWW, args.in[I_RW_R_K] + (L) * RWW, \
                 args.in[I_RW_LNX_W] + (L) * RWW, args.in[I_RW_LNX_B] + (L) * RWW, WupT + (size_t)(L) * RWW * 64, AupT + (size_t)(L) * RWW * 64, GupT + (size_t)(L) * RWW * 128}; \
      if (IN(PHA)) { if (MIX_MODE != 1) for (int rep = 0; rep < REP_M1; ++rep) { rwkv_m1_consts(F, RW); for (int u = blockIdx.x; u < NB * 64; u += F.G) rwkv_m1v2_unit(F, u, PB, RW, RS); } } \
      SEAM(PHA); \
      if (IN(PHB)) for (int rep = 0; rep < REP_M2; ++rep) { const int nscan = (F.G >= 128 && MIX_MODE != 1) ? 64 : 0; \
          if (MIX_MODE != 1 && MIX_MODE != 3) { if (nscan) { if ((int)blockIdx.x < 64) { rwkv_m2_unit(F, blockIdx.x, RS); hnd_arrive((unsigned*)(ctl + CW_HND + 64 * (L))); } } else { for (int u = blockIdx.x; u < 64; u += F.G) { rwkv_m2_unit(F, u, RS); hnd_arrive((unsigned*)(ctl + CW_HND + 64 * (L))); } } } \
          if (MIX_MODE == 2) gmlp_naive(F, PB, YB, args.in[I_GM_LN_W] + (L) * GMW, args.in[I_GM_LN_B] + (L) * GMW, args.in[I_GM_WS] + (size_t)(L) * NH * GCH * GCH, args.in[I_GM_BS] + (L) * NH * GCH); \
          else { const int NU = NB * (SEQ / GCH) * NH; const int nsplit = (nscan && F.G == 256) ? 1920 : NU;         \
              if ((int)blockIdx.x >= nscan) gmlp_units(F, blockIdx.x - nscan, F.G - nscan, nsplit, PB, YB, args.in[I_GM_LN_W] + (L) * GMW, args.in[I_GM_LN_B] + (L) * GMW, WsB + (size_t)(L) * NH * GCH * GCH, args.in[I_GM_BS] + (L) * NH * GCH); \
              else if (nsplit < NU) gmlp_units(F, nsplit + blockIdx.x, nscan, NU, PB, YB, args.in[I_GM_LN_W] + (L) * GMW, args.in[I_GM_LN_B] + (L) * GMW, WsB + (size_t)(L) * NH * GCH * GCH, args.in[I_GM_BS] + (L) * NH * GCH); } } \
      if (MIX_MODE == 0 && REP_M2 == 1) { if (IN(PHB) && IN(PHC)) hnd_wait((unsigned*)(ctl + CW_HND + 64 * (L)), 64u, bar.bar); } else SEAM(PHB);      \
      if (IN(PHC)) { if (MIX_MODE == 3) { for (int u = blockIdx.x; u < 64; u += F.G) rwkv_apply_naive(F, u, PB, YB, RW, RS); } \
          else if (MIX_MODE != 1) { for (int rep = 0; rep < REP_M3; ++rep) rwkv_m3_units(F, blockIdx.x, F.G, NB * 64, PB, YB, RW, RS); } \
          else rwkv_naive(F, PB, YB, args.in[I_SHIFT_MU] + (L) * 1792, args.in[I_RW_W_UP] + (L) * 64 * RWW, args.in[I_RW_W0] + (L) * RWW, args.in[I_RW_A_UP] + (L) * 64 * RWW, args.in[I_RW_A0] + (L) * RWW, \
                   args.in[I_RW_G_UP] + (L) * 128 * RWW, args.in[I_RW_K_K] + (L) * RWW, args.in[I_RW_K_A] + (L) * RWW, args.in[I_RW_R_K] + (L) * RWW, args.in[I_RW_LNX_W] + (L) * RWW, args.in[I_RW_LNX_B] + (L) * RWW); } \
      SEAM(PHC); } \
    if (IN(PH2)) { STAGGER_WAIT(); pg8::DenseSched S; S.init(YB, WoutT + (size_t)(L) * D * D, NTOK, D, 2 * D, F.G, (int)blockIdx.x); \
        pg8::EpiResid<HAS_OUT, BASE32> E{XBASE, XB, SSQ_OUT}; pg8::gemm_phase(F.lds, 2 * D, S, E); } \
    if (PROBE_DUP == 2 && (L) == 0 && IN(PH2)) { pg8::DenseSched S; S.init(YB, WoutT + (size_t)(L) * D * D, NTOK, D, 2 * D, F.G, (int)blockIdx.x); \
        pg8::EpiResid<HAS_OUT, BASE32> E{XBASE, XB, SSQ_OUT}; pg8::gemm_phase(F.lds, 2 * D, S, E); } \
    SEAM(PH2);

    LAYER_MIXER(0, PH_G1_0, PH_M1_0, PH_M2_0, PH_M3_0, PH_G2_0, nullptr, false, ssq0, 1, ssq1, true)

    if (IN(PH_G3_0)) { pg8::DenseSched S; S.init(XB, WguT, NTOK, 2 * FF, 2 * D, F.G, (int)blockIdx.x);
        pg8::EpiSwiglu<16> E{HB, FF, ssq1, (LAS float*)(F.lds + RING_BYTES + 4096)}; pg8::gemm_phase(F.lds, 2 * D, S, E); }
#if REP_G3 == 2
    if (IN(PH_G3_0)) { pg8::DenseSched S; S.init(XB, WguT, NTOK, 2 * FF, 2 * D, F.G, (int)blockIdx.x);
        pg8::EpiSwiglu<16> E{HB, FF, ssq1, (LAS float*)(F.lds + RING_BYTES + 4096)}; pg8::gemm_phase(F.lds, 2 * D, S, E); }
#endif
    SEAM(PH_G3_0);
    if (IN(PH_G4_0)) { STAGGER_WAIT(); pg8::DenseSched S; S.init(HB, WdT, NTOK, D, 2 * FF, F.G, (int)blockIdx.x);
        pg8::EpiResid<true, false> E{nullptr, XB, ssq2}; pg8::gemm_phase(F.lds, 2 * FF, S, E); }
    SEAM(PH_G4_0);

    LAYER_MIXER(1, PH_G1_1, PH_M1_1, PH_M2_1, PH_M3_1, PH_G2_1, nullptr, false, ssq2, 16, nullptr, false)

    if (IN(PH_CV)) for (int rep = 0; rep < REP_CV; ++rep) {
        const float* gain = args.in[I_NORM_FFN] + D;
        LAS float* RW = (LAS float*)F.lds; LAS int* cnt = (LAS int*)(F.lds + 32768);
        for (int i = F.tid; i < D * NE; i += 512) { const int k = i >> 3, e = i & 7, jj = k >> 9, ln = (k & 511) >> 3, q = k & 7; RW[(((jj * 8 + q) * 64 + ln) << 3) + e] = args.in[I_MOE_ROUTER][i] * gain[k]; }
        for (size_t i = (size_t)blockIdx.x * 512 + F.tid; i < (size_t)2 * MAXPAN * 256; i += (size_t)F.G * 512) { row_tok[i] = -1; row_gate[i] = 0.f; row_rs[i] = 0.f; }
        __syncthreads();
        for (int vb = blockIdx.x; vb < 256; vb += F.G) {
            if (F.tid < 16) cnt[F.tid] = 0;
            __syncthreads();
            u32x4 xv4[2];
            { const GAS u32x4* xr0 = (const GAS u32x4*)(XB + (size_t)(vb * 128 + F.wave * 16) * D) + F.lane; xv4[0] = xr0[0]; xv4[1] = xr0[64]; }
            for (int i = 0; i < 16; ++i) { const int m = vb * 128 + F.wave * 16 + i;
                float s = 0.f; float lg[8]; u32x4 cur4[2]; cur4[0] = xv4[0]; cur4[1] = xv4[1];
                if (i + 1 < 16) { const GAS u32x4* xr1 = (const GAS u32x4*)(XB + (size_t)(m + 1) * D) + F.lane; xv4[0] = xr1[0]; xv4[1] = xr1[64]; }
#pragma unroll
                for (int e = 0; e < 8; ++e) lg[e] = 0.f;
#pragma unroll
                for (int jj = 0; jj < 2; ++jj) { float v[8]; unpack8(cur4[jj], v);
                    if (MOE8_GU && !MOE8_DN) { u32x2 w8; w8.x = pk4_fp8(v[0], v[1], v[2], v[3]); w8.y = pk4_fp8(v[4], v[5], v[6], v[7]); *(u32x2*)(XB8 + (size_t)m * D + 512 * jj + 8 * F.lane) = w8; }
#pragma unroll
                    for (int q = 0; q < 8; ++q) { const float xv = v[q]; s += xv * xv; const LAS f32x4* rw = (const LAS f32x4*)(RW + (((jj * 8 + q) * 64 + F.lane) << 3)); const f32x4 r0 = rw[0], r1 = rw[1];
                        lg[0] += xv * r0.x; lg[1] += xv * r0.y; lg[2] += xv * r0.z; lg[3] += xv * r0.w; lg[4] += xv * r1.x; lg[5] += xv * r1.y; lg[6] += xv * r1.z; lg[7] += xv * r1.w; } }
                s = wave_sum(s);
#pragma unroll
                for (int e = 0; e < 8; ++e) lg[e] = wave_sum(lg[e]);
                const float rs = 1.0f / sqrtf(s * (1.0f / D) + RMS_EPS);
                if (MOE8_GU && MOE8_DN) {
#pragma unroll
                    for (int jj = 0; jj < 2; ++jj) { float v[8]; unpack8(cur4[jj], v); u32x2 w8; w8.x = pk4_fp8(v[0] * rs, v[1] * rs, v[2] * rs, v[3] * rs); w8.y = pk4_fp8(v[4] * rs, v[5] * rs, v[6] * rs, v[7] * rs);
                        *(u32x2*)(XB8 + (size_t)m * D + 512 * jj + 8 * F.lane) = w8; } }
                if (F.lane == 0) {
                    int i1 = 0; float v1 = lg[0];
#pragma unroll
                    for (int e = 1; e < 8; ++e) if (lg[e] > v1) { v1 = lg[e]; i1 = e; }
                    int i2 = -1; float v2 = -3.0e38f;
#pragma unroll
                    for (int e = 0; e < 8; ++e) if (e != i1 && lg[e] > v2) { v2 = lg[e]; i2 = e; }
                    if (i2 < 0) { i2 = (i1 + 1) & 7; v2 = v1; }
                    const float g1 = 1.0f / (1.0f + __expf((v2 - v1) * rs)), g2 = 1.0f - g1;
                    tok_e[2 * m] = i1; tok_e[2 * m + 1] = i2; tok_g[2 * m] = g1; tok_g[2 * m + 1] = g2; rs_moe[m] = rs;
                    __hip_atomic_fetch_add(&cnt[i1], 1, __ATOMIC_RELAXED, __HIP_MEMORY_SCOPE_WORKGROUP); __hip_atomic_fetch_add(&cnt[8 + i2], 1, __ATOMIC_RELAXED, __HIP_MEMORY_SCOPE_WORKGROUP);
                } }
            __syncthreads();
            if (F.tid < 16) bcnt[vb * 16 + F.tid] = cnt[F.tid];
            __syncthreads();
        }
        if (rep == 0) hnd_arrive((unsigned*)(ctl + CW_HND + 128));
        int itb = 0;
        for (int e = 0; e < NE; ++e) {
            if (MOE8_GU) { convert_matrix_fp8(F, args.in[I_MOE_WG] + (size_t)e * D * FFE, D, FFE, MWgu8 + (size_t)e * 2 * FFE * D, 1, gain, MOE8_WSCALE_GU * (MOE8_DN ? -1.44269504f : 1.0f), itb);
                           convert_matrix_fp8(F, args.in[I_MOE_WU] + (size_t)e * D * FFE, D, FFE, MWgu8 + (size_t)e * 2 * FFE * D, 2, gain, MOE8_WSCALE_GU, itb); }
            else { convert_matrix(F, args.in[I_MOE_WG] + (size_t)e * D * FFE, D, FFE, MWgu + (size_t)e * 2 * FFE * D, 1, gain, 0, itb);
                   convert_matrix(F, args.in[I_MOE_WU] + (size_t)e * D * FFE, D, FFE, MWgu + (size_t)e * 2 * FFE * D, 2, gain, 0, itb); }
            if (MOE8_DN) convert_matrix_fp8(F, args.in[I_MOE_WD] + (size_t)e * FFE * D, FFE, D, MWd8 + (size_t)e * D * FFE, 0, nullptr, MOE8_WSCALE_DN, itb);
            else convert_matrix(F, args.in[I_MOE_WD] + (size_t)e * FFE * D, FFE, D, MWd + (size_t)e * D * FFE, 0, nullptr, 0, itb);
        }
    }
    if (IN(PH_CV) && IN(PH_R2)) hnd_wait((unsigned*)(ctl + CW_HND + 128), (unsigned)F.G, bar.bar);

    if (IN(PH_R2)) {
        LAS int* tot = (LAS int*)F.lds;
        LAS int* bc = tot + 64;
        for (int vb = blockIdx.x; vb < 256; vb += F.G) {
            for (int i = F.tid; i < 256 * 16; i += 512) bc[i] = bcnt[i];
            __syncthreads();
            if (F.tid < 16) { int t = 0, mine = 0; for (int b2 = 0; b2 < 256; ++b2) { const int c = bc[b2 * 16 + F.tid]; if (b2 < vb) mine += c; t += c; } tot[F.tid] = t; tot[32 + F.tid] = mine; }
            __syncthreads();
            if (F.tid < 2) { int ps = 0; for (int e = 0; e < 8; ++e) { tot[16 + F.tid * 8 + e] = ps; ps += (tot[F.tid * 8 + e] + 255) / 256; }
                if (vb == 0) { panel[F.tid * 160] = ps; for (int e = 0; e < 8; ++e) { const int np = (tot[F.tid * 8 + e] + 255) / 256; for (int q = 0; q < np; ++q) panel[F.tid * 160 + 16 + tot[16 + F.tid * 8 + e] + q] = e; } } }
            int e01[2] = {0, 0}; float g01[2] = {0.f, 0.f}; float rsv = 0.f; const int m = vb * 128 + F.tid;
            if (F.tid < 128) { e01[0] = tok_e[2 * m]; e01[1] = tok_e[2 * m + 1]; g01[0] = tok_g[2 * m]; g01[1] = tok_g[2 * m + 1]; rsv = rs_moe[m]; }
            int rank[2] = {0, 0};
            if (F.wave < 2) {
#pragma unroll
                for (int set = 0; set < 2; ++set)
#pragma unroll
                    for (int e = 0; e < 8; ++e) { const unsigned long long mk = __ballot(e01[set] == e); if (e01[set] == e) rank[set] = __popcll(mk & ((1ull << F.lane) - 1ull));
                        if (F.wave == 0 && F.lane == 0) tot[48 + set * 8 + e] = __popcll(mk); } }
            __syncthreads();
            if (F.tid < 128) {
#pragma unroll
                for (int set = 0; set < 2; ++set) { const int key = set * 8 + e01[set]; const int slot = tot[16 + key] * 256 + tot[32 + key] + rank[set] + (F.wave == 1 ? tot[48 + key] : 0);
                    row_tok[set * MAXPAN * 256 + slot] = m; row_gate[set * MAXPAN * 256 + slot] = g01[set]; row_rs[set * MAXPAN * 256 + slot] = rsv; } }
            __syncthreads();
        }
    }
    SEAM(PH_R2);

#define MOE_SET(SET, PHGU, PHDN) \
    if (IN(PHGU)) for (int rep = 0; rep < REP_GU; ++rep) { const int np = __builtin_amdgcn_readfirstlane(panel[(SET) * 160]); pg8::MoeSched<true> S; \
        if (MOE8_GU) { S.init(XB8, MWgu8, np, 2 * FFE, D, MOE_PEXP(SET) + 16, row_tok + (SET) * MAXPAN * 256, F.G, (int)blockIdx.x); \
            if (MOE8_DN) { pg8::EpiSwigluMoe8 E{MH8, FFE}; pg8::gemm_phase<pg8::EpiSwigluMoe8, pg8::MoeSched<true>, true>(F.lds, D, S, E); } \
            else { pg8::EpiSwigluMoe E{MH, FFE, rs_moe, row_tok + (SET) * MAXPAN * 256, 1.0f / MOE8_WSCALE_GU}; pg8::gemm_phase<pg8::EpiSwigluMoe, pg8::MoeSched<true>, true>(F.lds, D, S, E); } } \
        else { S.init(XB, MWgu, np, 2 * FFE, 2 * D, MOE_PEXP(SET) + 16, row_tok + (SET) * MAXPAN * 256, F.G, (int)blockIdx.x); \
            pg8::EpiSwigluMoe E{MH, FFE, rs_moe, row_tok + (SET) * MAXPAN * 256, 1.0f}; pg8::gemm_phase(F.lds, 2 * D, S, E); } } \
    SEAM(PHGU); \
    if (IN(PHDN)) { const int np = __builtin_amdgcn_readfirstlane(panel[(SET) * 160]); pg8::MoeSched<false> S; \
        if (MOE8_DN) { S.init(MH8, MWd8, np, D, FFE, MOE_PEXP(SET) + 16, row_tok + (SET) * MAXPAN * 256, F.G, (int)blockIdx.x); \
            pg8::EpiMoeDown E{XB, row_tok + (SET) * MAXPAN * 256, row_gate + (SET) * MAXPAN * 256, 1.0f / MOE8_WSCALE_DN, (LAS int*)(F.lds + RING_BYTES + 4096)}; pg8::gemm_phase<pg8::EpiMoeDown, pg8::MoeSched<false>, true>(F.lds, FFE, S, E); } \
        else { S.init(MH, MWd, np, D, 2 * FFE, MOE_PEXP(SET) + 16, row_tok + (SET) * MAXPAN * 256, F.G, (int)blockIdx.x); \
            pg8::EpiMoeDown E{XB, row_tok + (SET) * MAXPAN * 256, row_gate + (SET) * MAXPAN * 256, 1.0f, (LAS int*)(F.lds + RING_BYTES + 4096)}; pg8::gemm_phase(F.lds, 2 * FFE, S, E); } } \
    SEAM(PHDN);
#if MOE8_GU && MOE8_DN
#define MOE_PEXP(SET) ((const LAS int*)(F.lds + RING_BYTES + (SET) * 1024))
#define MOE_LOAD_PEXP() do { if (F.tid < 2 * 160) ((LAS int*)(F.lds + RING_BYTES))[(F.tid / 160) * 256 + (F.tid % 160)] = panel[F.tid]; __syncthreads(); } while (0)
#define MOE_GU8(SET, HBUF, P0, NP, SKX, SKR) do { pg8::MoeSched<true> S; \
        S.init(XB8, MWgu8, (NP), 2 * FFE, D, MOE_PEXP(SET) + 16, row_tok + (SET) * MAXPAN * 256, F.G, (int)blockIdx.x); S.p0 = (P0); S.T.sx = (SKX); S.T.sr = (SKR); \
        pg8::EpiSwigluMoe8 E{HBUF, FFE}; pg8::gemm_phase<pg8::EpiSwigluMoe8, pg8::MoeSched<true>, true>(F.lds, D, S, E); } while (0)
#define MOE_DN8(SET, HBUF, P0, NP) do { pg8::MoeSched<false> S; \
        S.init(HBUF, MWd8, (NP), D, FFE, MOE_PEXP(SET) + 16, row_tok + (SET) * MAXPAN * 256, F.G, (int)blockIdx.x); S.p0 = (P0); \
        pg8::EpiMoeDown E{XB, row_tok + (SET) * MAXPAN * 256, row_gate + (SET) * MAXPAN * 256, 1.0f / MOE8_WSCALE_DN, (LAS int*)(F.lds + RING_BYTES + 4096)}; pg8::gemm_phase<pg8::EpiMoeDown, pg8::MoeSched<false>, true>(F.lds, FFE, S, E); } while (0)
    const int npA = __builtin_amdgcn_readfirstlane(panel[0]), npB = __builtin_amdgcn_readfirstlane(panel[160]);
    const int nB2 = npB < 64 ? npB : 64, nB1 = npB - nB2;
    if (IN(PH_GU_A)) { MOE_LOAD_PEXP(); MOE_GU8(0, MH8, 0, npA, 0, 0); }
    if (PROBE_DUP == 3 && IN(PH_GU_A)) MOE_GU8(0, MH8, 0, npA, 0, 0);
    SEAM(PH_GU_A);
    if (IN(PH_DN_A)) { MOE_LOAD_PEXP(); MOE_DN8(0, MH8, 0, npA);
        const int sx = (npA * (D / 256)) % F.G;
        if (nB1 > 0) MOE_GU8(1, MH8b, 0, nB1, sx, sx ? 3 : 0); }
    SEAM(PH_DN_A);
    if (IN(PH_GU_B)) { MOE_LOAD_PEXP(); if (nB1 > 0) MOE_DN8(1, MH8b, 0, nB1);
        const int sx = (nB1 * (D / 256)) % F.G;
        MOE_GU8(1, MH8b, nB1, nB2, sx, sx ? 3 : 0); }
    SEAM(PH_GU_B);
    if (IN(PH_DN_B)) { MOE_LOAD_PEXP(); MOE_DN8(1, MH8b, nB1, nB2); }
    SEAM(PH_DN_B);
#else
    MOE_SET(0, PH_GU_A, PH_DN_A)
    MOE_SET(1, PH_GU_B, PH_DN_B)
#endif

    if (IN(PH_FIN)) for (int rep = 0; rep < (PROBE_DUP == 7 ? 2 : 1); ++rep) {
        const float* gf = args.in[I_NORM_FINAL];
        f32x4 gq[2][2];
#pragma unroll
        for (int jj = 0; jj < 2; ++jj) { gq[jj][0] = *((const f32x4*)(gf + 512 * jj + 8 * F.lane)); gq[jj][1] = *((const f32x4*)(gf + 512 * jj + 8 * F.lane + 4)); }
        for (int m = F.gw; m < NTOK; m += F.NGW) {
            const GAS u32x4* xr = (const GAS u32x4*)(XB + (size_t)m * D) + F.lane; float v[2][8]; float s = 0.f;
#pragma unroll
            for (int jj = 0; jj < 2; ++jj) { unpack8(xr[64 * jj], v[jj]);
#pragma unroll
                for (int q = 0; q < 8; ++q) s += v[jj][q] * v[jj][q]; }
            const float rs = 1.0f / sqrtf(wave_sum(s) * (1.0f / D) + RMS_EPS);
#pragma unroll
            for (int jj = 0; jj < 2; ++jj) { const f32x4 g0 = gq[jj][0], g1 = gq[jj][1];
                GAS f32x4* o = (GAS f32x4*)(args.out + (size_t)m * D + 512 * jj + 8 * F.lane);
                o[0] = (f32x4){v[jj][0] * rs * g0.x, v[jj][1] * rs * g0.y, v[jj][2] * rs * g0.z, v[jj][3] * rs * g0.w}; o[1] = (f32x4){v[jj][4] * rs * g1.x, v[jj][5] * rs * g1.y, v[jj][6] * rs * g1.z, v[jj][7] * rs * g1.w}; }
        }
    }
#undef IN
#undef SEAM
}

extern "C" void kernel_launch(void* const* d_in, const int* in_sizes, int n_in, void* d_out, int out_size, void* d_ws, size_t ws_size, hipStream_t stream) {
    static int grid = 0;
    if (grid == 0) {
        if (n_in != NIN || in_sizes[0] != NTOK * D || out_size != NTOK * D || ws_size < WS_END) {
            fprintf(stderr, "kernel_launch: unexpected shapes: n_in %d in0 %d out %d ws %zu (need %zu); nothing launched\n", n_in, n_in > 0 ? in_sizes[0] : -1, out_size, ws_size, (size_t)WS_END); grid = -1; return; }
        int dev = 0, cus = 0, per_cu = 0;
        if (hipGetDevice(&dev) != hipSuccess || hipDeviceGetAttribute(&cus, hipDeviceAttributeMultiprocessorCount, dev) != hipSuccess) { grid = -1; return; }
        if (hipFuncSetAttribute((const void*)fwd, hipFuncAttributeMaxDynamicSharedMemorySize, LDS_BYTES) != hipSuccess) { fprintf(stderr, "kernel_launch: hipFuncSetAttribute failed\n"); grid = -1; return; }
        if (hipOccupancyMaxActiveBlocksPerMultiprocessor(&per_cu, (const void*)fwd, 512, LDS_BYTES) != hipSuccess || per_cu < 1) { fprintf(stderr, "kernel_launch: occupancy query says %d\n", per_cu); }
        (void)hipGetLastError();
        grid = cus;
    }
    if (grid < 0) return;
    if (hipMemsetAsync((char*)d_ws + WS_CTL, 0, CTL_ZERO_BYTES, stream) != hipSuccess) return;
    Args a{};
    for (int i = 0; i < NIN; ++i) a.in[i] = (const float*)d_in[i];
    a.out = (float*)d_out; a.ws = (unsigned char*)d_ws;
#if MK_PER_PHASE
    for (int ph = 0; ph < PH_COUNT; ++ph) { a.ph_lo = ph; a.ph_hi = ph + 1; hipLaunchKernelGGL(fwd, dim3(grid), dim3(512), LDS_BYTES, stream, a); }
#else
    a.ph_lo = 0; a.ph_hi = PH_COUNT; hipLaunchKernelGGL(fwd, dim3(grid), dim3(512), LDS_BYTES, stream, a);
#endif
}
```

```cpp
#include <hip/hip_runtime.h>
#include <cstdio>
#include <cstdint>

#ifndef MK_PER_PHASE
#define MK_PER_PHASE 0
#endif

#ifndef REP_M1
#define REP_M1 1
#endif
#ifndef REP_M2
#define REP_M2 1
#endif
#ifndef REP_M3
#define REP_M3 1
#endif
#ifndef REP_GU
#define REP_GU 1
#endif
#ifndef REP_CH
#define REP_CH 1
#endif
#ifndef PROBE_STAGE
#define PROBE_STAGE 0
#endif
#ifndef REP_CV
#define REP_CV 1
#endif
#ifndef REP_EPI
#define REP_EPI 1
#endif
#ifndef REP_G3
#define REP_G3 1
#endif
#ifndef PROBE_DUP
#define PROBE_DUP 0
#endif
#ifndef STAGGER_TICKS
#define STAGGER_TICKS 0
#endif
#ifndef DEFER_CONVERT
#define DEFER_CONVERT 1
#endif
#ifndef DBG_VAR
#define DBG_VAR 0
#endif
#ifndef MOE8_GU
#define MOE8_GU 1
#endif
#ifndef MOE8_DN
#define MOE8_DN 1
#endif
#ifndef MIX_MODE
#define MIX_MODE 0
#endif
#define GAS __attribute__((address_space(1)))
#define LAS __attribute__((address_space(3)))
typedef unsigned short bf16;
typedef unsigned short bf16_t;
typedef short bf16x8 __attribute__((ext_vector_type(8)));
typedef float f32x4 __attribute__((ext_vector_type(4)));
typedef float f32x2 __attribute__((ext_vector_type(2)));
typedef unsigned u32x4 __attribute__((ext_vector_type(4)));
typedef unsigned u32x2 __attribute__((ext_vector_type(2)));
typedef GAS unsigned gu32;

constexpr int NTOK = 32768, SEQ = 4096, NB = 8, D = 1024, INW = 2816, FF = 2816, FFE = 3584, NE = 8;
constexpr int GMW = 512, RWW = 512, NH = 8, HD = 64, GCH = 128;
constexpr float RMS_EPS = 1e-6f, LN_EPS = 1e-5f, GN_EPS = 64e-5f;
constexpr int MAXPAN = 136;

constexpr size_t MiB = 1u << 20;
constexpr size_t WS_CTL = 0, CTL_ZERO_BYTES = 2 * MiB;
constexpr size_t WS_WIN = 2 * MiB;
constexpr size_t WS_WOUT = 13 * MiB;
constexpr size_t WS_WGU = 17 * MiB;
constexpr size_t WS_WD = 28 * MiB;
constexpr size_t WS_MISC = 34 * MiB;
constexpr size_t WS_SMALLW = 36 * MiB;
constexpr size_t SW_WUP = 0, SW_AUP = 128 * 1024, SW_GUP = 256 * 1024, SW_WS = 512 * 1024;
constexpr size_t WS_XB = 38 * MiB;
constexpr size_t WS_R = 102 * MiB;
constexpr size_t WS_P = WS_R;
constexpr size_t WS_Y = WS_R + 176 * MiB;
constexpr size_t WS_SCR = WS_R + 240 * MiB;
constexpr size_t WS_MOEW_GU = WS_R;
constexpr size_t WS_MOEW_D = WS_R + 112 * MiB;
constexpr size_t WS_MOEH = WS_R + 168 * MiB;
constexpr size_t WS_MOEW8_GU = WS_R;
constexpr size_t WS_MOEW8_D = WS_R + 56 * MiB;
constexpr size_t WS_XB8 = WS_R + 112 * MiB;
constexpr float MOE8_WSCALE_GU = 64.f, MOE8_WSCALE_DN = 128.f;
constexpr size_t WS_SSQP = WS_R + 400 * MiB;
constexpr size_t WS_END = WS_R + 408 * MiB;
static_assert(WS_MOEH + (size_t)MAXPAN * 256 * FFE * 2 <= WS_END, "moe hidden fits");
static_assert(WS_WIN + (size_t)2 * INW * D * 2 <= WS_WOUT && WS_WGU + (size_t)2 * FF * D * 2 <= WS_WD && WS_WD + (size_t)D * FF * 2 <= WS_MISC, "weights fit");
constexpr int CW_TMO = 0;
constexpr int CW_BAR = 4096;
constexpr int CW_HND = 8192;
constexpr int CW_SSQ = 65536;
static_assert((CW_SSQ + 4 * NTOK) * 4 <= (int)CTL_ZERO_BYTES, "ctl fits");
constexpr size_t MS_TOKE = 0;
constexpr size_t MS_TOKG = 256 * 1024;
constexpr size_t MS_RS = 512 * 1024;
constexpr size_t MS_BCNT = 640 * 1024;
constexpr size_t MS_ROWTOK = 704 * 1024;
constexpr size_t MS_ROWGATE = 1024 * 1024;
constexpr size_t MS_PANEL = 1344 * 1024;
constexpr size_t MS_ROWRS = 1408 * 1024;
static_assert(MS_ROWTOK + 2 * MAXPAN * 256 * 4 <= MS_ROWGATE && MS_ROWGATE + 2 * MAXPAN * 256 * 4 <= MS_PANEL && MS_PANEL + 2 * 160 * 4 <= MS_ROWRS && MS_ROWRS + 2 * MAXPAN * 256 * 4 <= 2 * MiB, "misc fits");

constexpr int RING_BYTES = 131072;
constexpr int LDS_BYTES = 147456;
constexpr int MISC_OFF = LDS_BYTES - 128;

#define LDS_WAIT() asm volatile("s_waitcnt lgkmcnt(0)" ::: "memory")
#define VM_WAIT() asm volatile("s_waitcnt vmcnt(0)" ::: "memory")
#define RLX_AGENT __ATOMIC_RELAXED, __HIP_MEMORY_SCOPE_AGENT
#define LDS_BARRIER() do { asm volatile("s_waitcnt lgkmcnt(0)" ::: "memory"); __builtin_amdgcn_s_barrier(); asm volatile("" ::: "memory"); } while (0)

__device__ __forceinline__ unsigned f2bf(float f) { unsigned u = __builtin_bit_cast(unsigned, f); return (u + 0x7fffu + ((u >> 16) & 1u)) >> 16; }
__device__ __forceinline__ unsigned pk2(float lo, float hi) { return f2bf(lo) | (f2bf(hi) << 16); }
__device__ __forceinline__ float bf2f(bf16 b) { return __builtin_bit_cast(float, (unsigned)b << 16); }
__device__ __forceinline__ unsigned cvt_pk_bf16(float lo, float hi) { unsigned r; asm volatile("v_cvt_pk_bf16_f32 %0, %1, %2" : "=v"(r) : "v"(lo), "v"(hi)); return r; }
__device__ __forceinline__ unsigned pk4_fp8(float a, float b, float c, float d) { int v = __builtin_amdgcn_cvt_pk_fp8_f32(a, b, 0, false); v = __builtin_amdgcn_cvt_pk_fp8_f32(c, d, v, true); return (unsigned)v; }
__device__ __forceinline__ float wave_sum(float v) {
#pragma unroll
    for (int o = 1; o < 64; o <<= 1) v += __shfl_xor(v, o);
    return v;
}
__device__ __forceinline__ float gelu_erf(float v) { return 0.5f * v * (1.0f + erff(v * 0.70710678f)); }
__device__ __forceinline__ float sigmoidf_(float v) { return 1.0f / (1.0f + __expf(-v)); }
__device__ __forceinline__ float silu_f(float v) { return v * __builtin_amdgcn_rcpf(1.0f + __expf(-v)); }

__device__ __forceinline__ f32x2 swiglu2(f32x2 g, f32x2 u, float rs) {
    const float c1 = rs * (-1.44269504f), ic2 = rs != 0.f ? __builtin_amdgcn_rcpf(rs * rs) : 1.0e30f;
    const f32x2 a = g * c1, p = g * u;
    f32x2 e; e.x = __builtin_amdgcn_exp2f(a.x); e.y = __builtin_amdgcn_exp2f(a.y);
    const f32x2 d = e * ic2 + ic2; f32x2 r; r.x = __builtin_amdgcn_rcpf(d.x); r.y = __builtin_amdgcn_rcpf(d.y);
    return p * r;
}
namespace pg8 {
constexpr int BM = 256, BK = 64, HALF = 128, HTB = HALF * BK * 2, STAGE_BYTES = 8 * HTB, NXCD = 8, WGM = 8;
__host__ __device__ __forceinline__ int lds_byte(int r, int c) { const int st = (r >> 4) * 2 + (c >> 5), rr = r & 15, cc = c & 31, ob = rr * 64 + cc * 2; return st * 1024 + (ob ^ (((ob >> 9) & 1) << 5)); }
__host__ __device__ __forceinline__ void stage_rc(int b, int& R, int& C) { const int st = b / 1024, sb = b % 1024, swz = sb ^ (((sb >> 9) & 1) << 5); R = (st >> 1) * 16 + swz / 64; C = (st & 1) * 32 + (swz % 64) / 2; }
__host__ __device__ __forceinline__ int perm32(int rho) { const int n = rho >> 4, i = rho & 15; return 8 * (i >> 2) + 4 * n + (i & 3); }

struct Unit { int pm, pn, aux; };

struct TileOrder {
    int nM, nN, nwg, G, c, sx, sr;
    __device__ void init(int nM_, int nN_, int G_, int c_) { nM = nM_; nN = nN_; nwg = nM * nN; G = G_; c = c_; sx = 0; sr = 0; }
    __device__ bool tile(int i, int& pm, int& pn) const {
        long L;
        if (sx == 0) L = (long)i * G + c;
        else if (c < sx) L = (long)sr * (G - sx) + (long)i * G + c;
        else L = i < sr ? (long)i * (G - sx) + (c - sx) : (long)sr * (G - sx) + (long)(i - sr) * G + c;
        if (L >= nwg) return false;
        int wgid = (int)L; { const int q = nwg / NXCD, r = nwg % NXCD, xcd = wgid % NXCD, off = wgid / NXCD; wgid = (xcd < r ? xcd * (q + 1) : r * (q + 1) + (xcd - r) * q) + off; }
        const int nig = WGM * nN, gid = wgid / nig, fm = gid * WGM, gsz = (nM - fm) < WGM ? (nM - fm) : WGM;
        pm = fm + ((wgid % nig) % gsz); pn = (wgid % nig) / gsz; return true;
    }
};
struct DenseSched {
    static constexpr bool GATHER = false;
    TileOrder T; const char* A; const char* Bt; size_t tstep;
    __device__ void init(const void* A_, const void* Bt_, int M, int N, int KB  , int G, int c) { T.init(M / BM, N / BM, G, c); A = (const char*)A_; Bt = (const char*)Bt_; tstep = (size_t)BM * KB; }
    __device__ __forceinline__ bool next(int i, Unit& u) const { u.aux = 0; return T.tile(i, u.pm, u.pn); }
    __device__ __forceinline__ const char* a_ptr(const Unit& u) const { return A + (size_t)u.pm * tstep; }
    __device__ __forceinline__ const char* b_ptr(const Unit& u) const { return Bt + (size_t)u.pn * tstep; }
    __device__ __forceinline__ void gather(const Unit&, int, int, int, int, int, unsigned (&)[2][2]) const {}
};
template <bool GATHER_> struct MoeSched {
    static constexpr bool GATHER = GATHER_;
    TileOrder T; const char* A; const char* Bt; size_t a_tstep, b_tstep, b_estep; const LAS int* pexp; const int* row_tok; int KB; int p0 = 0;
    __device__ void init(const void* A_, const void* Bt_, int npanels, int N, int KB_  , const LAS int* pexp_, const int* row_tok_, int G, int c) {
        T.init(npanels, N / BM, G, c); A = (const char*)A_; Bt = (const char*)Bt_; KB = KB_; a_tstep = (size_t)BM * KB_; b_tstep = (size_t)BM * KB_; b_estep = (size_t)N * KB_; pexp = pexp_; row_tok = row_tok_; }
    __device__ __forceinline__ bool next(int i, Unit& u) const { if (!T.tile(i, u.pm, u.pn)) return false; u.pm += p0; u.aux = __builtin_amdgcn_readfirstlane(pexp[u.pm]); return true; }
    __device__ __forceinline__ const char* a_ptr(const Unit& u) const { return GATHER ? A : A + (size_t)u.pm * a_tstep; }
    __device__ __forceinline__ const char* b_ptr(const Unit& u) const { return Bt + (size_t)u.aux * b_estep + (size_t)u.pn * b_tstep; }
    __device__ __forceinline__ void gather(const Unit& u, int R0, int R1, int C0, int C1, int, unsigned (&v)[2][2]) const {
#pragma unroll
        for (int h = 0; h < 2; ++h) { int t0 = row_tok[u.pm * BM + h * HALF + R0], t1 = row_tok[u.pm * BM + h * HALF + R1]; t0 = t0 < 0 ? 0 : t0; t1 = t1 < 0 ? 0 : t1;
            v[h][0] = (unsigned)(t0 * KB + C0 * 2); v[h][1] = (unsigned)(t1 * KB + C1 * 2); }
    }
};

typedef int v4i_t __attribute__((ext_vector_type(4)));
typedef int v8i_t __attribute__((ext_vector_type(8)));
typedef short s16x16_t __attribute__((ext_vector_type(16)));
__device__ __forceinline__ v8i_t cat8(const bf16x8 lo, const bf16x8 hi) { const v4i_t a = __builtin_bit_cast(v4i_t, lo), b = __builtin_bit_cast(v4i_t, hi); return __builtin_shufflevector(a, b, 0, 1, 2, 3, 4, 5, 6, 7); }
template <class Epi, class Sched, bool FP8 = false>
__device__ __forceinline__ void gemm_phase(LAS unsigned char* lds, const int KB, const Sched& S, const Epi& E) {
    constexpr bool GATHER = Sched::GATHER;
    const int tid = threadIdx.x, wid = __builtin_amdgcn_readfirstlane(tid >> 6), lane = tid & 63, wr = wid >> 2, wc = wid & 3, fr = lane & 15, fq = lane >> 4;
    const int nt = KB / 128;
    unsigned voffA[2], voffB[2], voffBa[2][2]; int sR[2], sC[2];
#pragma unroll
    for (int i = 0; i < 2; ++i) { int R, C; stage_rc(tid * 16 + i * 8192, R, C); const int Rb = Epi::PERM ? ((R & ~31) + perm32(R & 31)) : R; sR[i] = R; sC[i] = C;
        voffA[i] = (unsigned)(R * KB + C * 2); voffB[i] = (unsigned)(Rb * KB + C * 2);
        voffBa[0][i] = (unsigned)((64 * (R >> 5) + perm32(R & 31)) * KB + C * 2); voffBa[1][i] = (unsigned)((64 * (R >> 5) + 32 + perm32(R & 31)) * KB + C * 2); }
    const size_t kstep = (size_t)(BK * 2);
    const size_t hstep = (size_t)HALF * KB;
    const unsigned ldsw = (unsigned)wid * 1024u;
    const int aoff = lds_byte(wr * 64 + fr, fq * 8), boff = lds_byte(wc * 32 + fr, fq * 8);
    const int aoff8 = lds_byte(wr * 64 + fr, (fq >> 1) * 32 + (fq & 1) * 16) & ~31, boff8 = lds_byte(wc * 32 + fr, (fq >> 1) * 32 + (fq & 1) * 16) & ~31;
#define PG8_SA(b, h) (((b) * 2 + (h)) * HTB)
#define PG8_SB(b, h) ((4 + (b) * 2 + (h)) * HTB)
#define PG8_STAGE(bufoff, gbase, voff) do { _Pragma("unroll") for (int _i = 0; _i < 2; ++_i) \
        __builtin_amdgcn_global_load_lds((const unsigned*)((const char*)(gbase) + (voff)[_i]), (LAS unsigned*)(lds + (bufoff) + ldsw + _i * 8192), 16, 0, 0); } while (0)
#define PG8_STAGE_B(bufoff, kptr, half) do { if constexpr (Epi::ADJ) { PG8_STAGE(bufoff, kptr, voffBa[half]); } else { PG8_STAGE(bufoff, (kptr) + (half) * hstep, voffB); } } while (0)
#define PG8_STAGE_A(bufoff, kptr, half, VG) do { if constexpr (GATHER) { PG8_STAGE(bufoff, kptr, (VG)[half]); } else { PG8_STAGE(bufoff, (kptr) + (half) * hstep, voffA); } } while (0)
#define PG8_LDA(dst, b, h) do { if constexpr (FP8) { _Pragma("unroll") for (int m = 0; m < 4; ++m) dst##8[m] = cat8(*(const LAS bf16x8*)(lds + PG8_SA(b, h) + aoff8 + m * 2048), *(const LAS bf16x8*)(lds + PG8_SA(b, h) + aoff8 + m * 2048 + 16)); } \
        else { _Pragma("unroll") for (int m = 0; m < 4; ++m) _Pragma("unroll") for (int k = 0; k < 2; ++k) dst[m][k] = *(const LAS bf16x8*)(lds + PG8_SA(b, h) + aoff + m * 2048 + k * 1024); } } while (0)
#define PG8_LDB(dst, b, h) do { if constexpr (FP8) { _Pragma("unroll") for (int n = 0; n < 2; ++n) dst##8[n] = cat8(*(const LAS bf16x8*)(lds + PG8_SB(b, h) + boff8 + n * 2048), *(const LAS bf16x8*)(lds + PG8_SB(b, h) + boff8 + n * 2048 + 16)); } \
        else { _Pragma("unroll") for (int n = 0; n < 2; ++n) _Pragma("unroll") for (int k = 0; k < 2; ++k) dst[n][k] = *(const LAS bf16x8*)(lds + PG8_SB(b, h) + boff + n * 2048 + k * 1024); } } while (0)
#define PG8_MMA(ai, bj, At, Bt) do { __builtin_amdgcn_s_setprio(1); if constexpr (FP8) { _Pragma("unroll") for (int m = 0; m < 4; ++m) _Pragma("unroll") for (int n = 0; n < 2; ++n) \
        asm volatile("v_mfma_scale_f32_16x16x128_f8f6f4 %0, %1, %2, %0, %3, %4 op_sel_hi:[0,0,0]" : "+v"(acc[ai][bj][m][n]) : "v"(Bt##8[n]), "v"(At##8[m]), "v"(sc8w), "v"(sc8)); } \
        else { _Pragma("unroll") for (int k = 0; k < 2; ++k) _Pragma("unroll") for (int m = 0; m < 4; ++m) _Pragma("unroll") for (int n = 0; n < 2; ++n) \
        asm volatile("v_mfma_f32_16x16x32_bf16 %0, %1, %2, %0" : "+v"(acc[ai][bj][m][n]) : "v"(Bt[n][k]), "v"(At[m][k])); } __builtin_amdgcn_s_setprio(0); } while (0)
#define PG8_MMA0(ai, bj, At, Bt) do { __builtin_amdgcn_s_setprio(1); if constexpr (FP8) { _Pragma("unroll") for (int m = 0; m < 4; ++m) _Pragma("unroll") for (int n = 0; n < 2; ++n) \
        asm volatile("v_mfma_scale_f32_16x16x128_f8f6f4 %0, %1, %2, 0, %3, %4 op_sel_hi:[0,0,0]" : "=v"(acc[ai][bj][m][n]) : "v"(Bt##8[n]), "v"(At##8[m]), "v"(sc8w), "v"(sc8)); } \
        else { _Pragma("unroll") for (int m = 0; m < 4; ++m) _Pragma("unroll") for (int n = 0; n < 2; ++n) \
        asm volatile("v_mfma_f32_16x16x32_bf16 %0, %1, %2, 0" : "=v"(acc[ai][bj][m][n]) : "v"(Bt[n][0]), "v"(At[m][0])); \
        _Pragma("unroll") for (int m = 0; m < 4; ++m) _Pragma("unroll") for (int n = 0; n < 2; ++n) \
        asm volatile("v_mfma_f32_16x16x32_bf16 %0, %1, %2, %0" : "+v"(acc[ai][bj][m][n]) : "v"(Bt[n][1]), "v"(At[m][1])); } __builtin_amdgcn_s_setprio(0); } while (0)
#define PG8_WAIT_V(n) asm volatile("s_waitcnt vmcnt(" #n ")" ::: "memory")
#define PG8_WAIT_L(n) asm volatile("s_waitcnt lgkmcnt(" #n ")" ::: "memory")
#define PG8_BAR __builtin_amdgcn_s_barrier()
#define PG8_SCHED __builtin_amdgcn_sched_barrier(0)
    Unit cur, nxt; int ui = 0;
    if (!S.next(0, cur)) return;
    f32x4 acc[2][2][4][2];
#pragma unroll
    for (int a = 0; a < 2; ++a)
#pragma unroll
        for (int b = 0; b < 2; ++b)
#pragma unroll
            for (int m = 0; m < 4; ++m)
#pragma unroll
                for (int n = 0; n < 2; ++n) asm volatile("" : "=v"(acc[a][b][m][n]));
    bf16x8 At[4][2], B0[2][2], B1[2][2]; v8i_t At8[4], B08[2], B18[2]; const int sc8 = 0x7f7f7f7f; int sc8w = 0x7f7f7f7f; if constexpr (FP8) sc8w = Epi::SCW;
    const char* cA = S.a_ptr(cur); const char* cB = S.b_ptr(cur);
    unsigned vcur[2][2] = {{0u, 0u}, {0u, 0u}}, vnext[2][2] = {{0u, 0u}, {0u, 0u}}, vt2[2][2] = {{0u, 0u}, {0u, 0u}};
    if constexpr (GATHER) S.gather(cur, sR[0], sR[1], sC[0], sC[1], 0, vcur);
    PG8_STAGE_B(PG8_SB(0, 0), cB, 0); PG8_STAGE_B(PG8_SB(0, 1), cB, 1); PG8_STAGE_A(PG8_SA(0, 0), cA, 0, vcur); PG8_STAGE_A(PG8_SA(0, 1), cA, 1, vcur);
    if (wr == 1) PG8_BAR;
    PG8_WAIT_V(2); PG8_BAR;
    PG8_STAGE_B(PG8_SB(1, 0), cB + kstep, 0); PG8_STAGE_A(PG8_SA(1, 0), cA + kstep, 0, vcur); PG8_STAGE_B(PG8_SB(1, 1), cB + kstep, 1);
    PG8_WAIT_V(6); PG8_BAR;
    for (;;) {
        const bool has_next = S.next(ui + 1, nxt);
        const char* nA = has_next ? S.a_ptr(nxt) : cA; const char* nB = has_next ? S.b_ptr(nxt) : cB;
        if constexpr (GATHER) { if (has_next) S.gather(nxt, sR[0], sR[1], sC[0], sC[1], 0, vnext); else {
#pragma unroll
            for (int h = 0; h < 2; ++h) { vnext[h][0] = vcur[h][0]; vnext[h][1] = vcur[h][1]; } } }
#define PG8_KITER(t, MM) do { \
            const bool last = (t == nt - 2); \
            const char* a1 = cA + (size_t)(t + 1) * kstep; \
            const char* a2 = last ? nA : cA + (size_t)(t + 2) * kstep; const char* b2 = last ? nB : cB + (size_t)(t + 2) * kstep; \
            const char* a3 = a2 + kstep; const char* b3 = b2 + kstep; \
            if constexpr (GATHER) { \
            _Pragma("unroll") \
                for (int h = 0; h < 2; ++h) { vt2[h][0] = last ? vnext[h][0] : vcur[h][0]; vt2[h][1] = last ? vnext[h][1] : vcur[h][1]; } } \
            PG8_LDB(B0, 0, 0); PG8_LDB(B1, 0, 1); PG8_SCHED; PG8_LDA(At, 0, 0); PG8_STAGE_A(PG8_SA(1, 1), a1, 1, vcur); \
            PG8_WAIT_V(8); PG8_WAIT_L(0); PG8_BAR; MM(0, 0, At, B0); MM(0, 1, At, B1); PG8_BAR; PG8_SCHED; \
            PG8_LDA(At, 0, 1); PG8_STAGE_B(PG8_SB(0, 0), b2, 0); PG8_STAGE_B(PG8_SB(0, 1), b2, 1); PG8_STAGE_A(PG8_SA(0, 0), a2, 0, vt2); \
            PG8_WAIT_V(8); PG8_WAIT_L(0); PG8_BAR; MM(1, 0, At, B0); MM(1, 1, At, B1); PG8_BAR; PG8_SCHED; \
            PG8_LDB(B0, 1, 0); PG8_LDB(B1, 1, 1); PG8_SCHED; PG8_LDA(At, 1, 0); PG8_STAGE_A(PG8_SA(0, 1), a2, 1, vt2); \
            PG8_WAIT_V(8); PG8_WAIT_L(0); PG8_BAR; PG8_MMA(0, 0, At, B0); PG8_MMA(0, 1, At, B1); PG8_BAR; PG8_SCHED; \
            PG8_LDA(At, 1, 1); PG8_STAGE_B(PG8_SB(1, 0), b3, 0); PG8_STAGE_B(PG8_SB(1, 1), b3, 1); PG8_STAGE_A(PG8_SA(1, 0), a3, 0, vt2); \
            PG8_WAIT_V(8); PG8_WAIT_L(0); PG8_BAR; PG8_MMA(1, 0, At, B0); PG8_MMA(1, 1, At, B1); PG8_BAR; PG8_SCHED; \
        } while (0)
        { const int t = 0; PG8_KITER(t, PG8_MMA0); }
        for (int t = 2; t < nt; t += 2) { PG8_KITER(t, PG8_MMA); }
#undef PG8_KITER
        if (wr == 0) PG8_BAR;
        asm volatile("s_nop 15\n\ts_nop 15" ::: "memory");
        for (int rp_ = 0; rp_ < Epi::REPS; ++rp_) E(acc, cur, wr, wc, fr, fq);
        if (!has_next) break;
        cur = nxt; cA = nA; cB = nB; ++ui;
        if constexpr (GATHER) {
#pragma unroll
            for (int h = 0; h < 2; ++h) { vcur[h][0] = vnext[h][0]; vcur[h][1] = vnext[h][1]; } }
        if (wr == 1) PG8_BAR;
    }
    PG8_WAIT_V(0);
    PG8_BAR;
#undef PG8_SA
#undef PG8_SB
#undef PG8_STAGE
#undef PG8_STAGE_A
#undef PG8_STAGE_B
#undef PG8_LDA
#undef PG8_LDB
#undef PG8_MMA
#undef PG8_MMA0
#undef PG8_WAIT_V
#undef PG8_WAIT_L
#undef PG8_BAR
#undef PG8_SCHED
}

__device__ __forceinline__ void store_lines(unsigned char* rowbase  , size_t pitch, int fr, int fq, const u32x4 w0, const u32x4 w1) {
    const bool lo = fr < 8; const u32x4 snd = lo ? w1 : w0; u32x4 rcv;
    rcv.x = __shfl_xor(snd.x, 8); rcv.y = __shfl_xor(snd.y, 8); rcv.z = __shfl_xor(snd.z, 8); rcv.w = __shfl_xor(snd.w, 8);
    unsigned char* p = rowbase + (size_t)(fr & 7) * pitch + (lo ? 0 : 64) + 16 * fq;
    *(u32x4*)p = lo ? w0 : rcv;
    *(u32x4*)(p + 8 * pitch) = lo ? rcv : w1;
}
template <int NP> __device__ __forceinline__ float row_rs(const float* ssq, int row) {
    float s;
    if constexpr (NP == 1) s = ssq[row];
    else { const f32x4* p = (const f32x4*)(ssq + (size_t)row * 16); const f32x4 a = p[0], b = p[1], c = p[2], d = p[3];
        s = (((a[0] + a[1]) + (a[2] + a[3])) + ((b[0] + b[1]) + (b[2] + b[3]))) + (((c[0] + c[1]) + (c[2] + c[3])) + ((d[0] + d[1]) + (d[2] + d[3]))); }
    return __builtin_amdgcn_rsqf(s * (1.0f / D) + RMS_EPS);
}
__device__ __forceinline__ void panel_rs_to_lds(const float* ssq, int pm, LAS float* rsl) {
    if (threadIdx.x < 256) rsl[threadIdx.x] = row_rs<16>(ssq, pm * 256 + (int)threadIdx.x);
    asm volatile("s_waitcnt lgkmcnt(0)" ::: "memory"); __builtin_amdgcn_s_barrier(); asm volatile("" ::: "memory");
}
template <int NP> struct EpiScaleBf16 {
    static constexpr bool PERM = true; static constexpr bool ADJ = true; static constexpr int REPS = 1;
    bf16_t* O; int ldc; const float* ssq; LAS float* rsl;
    __device__ __forceinline__ void operator()(const f32x4 (&acc)[2][2][4][2], const Unit& u, int wr, int wc, int fr, int fq) const {
        const int rowg = u.pm * BM + wr * 64, colw = u.pn * BM + wc * 64;
        if constexpr (NP == 16) panel_rs_to_lds(ssq, u.pm, rsl);
#pragma unroll
        for (int ai = 0; ai < 2; ++ai)
#pragma unroll
            for (int m = 0; m < 4; ++m) { const int row = rowg + ai * HALF + m * 16 + fr; float rs; if constexpr (NP == 16) rs = rsl[wr * 64 + ai * HALF + m * 16 + fr]; else rs = row_rs<NP>(ssq, row);
                u32x4 w[2];
#pragma unroll
                for (int bj = 0; bj < 2; ++bj) { const f32x4 v0 = acc[ai][bj][m][0] * rs, v1 = acc[ai][bj][m][1] * rs;
                    w[bj].x = cvt_pk_bf16(v0[0], v0[1]); w[bj].y = cvt_pk_bf16(v0[2], v0[3]); w[bj].z = cvt_pk_bf16(v1[0], v1[1]); w[bj].w = cvt_pk_bf16(v1[2], v1[3]); }
                store_lines((unsigned char*)(O + (size_t)(rowg + ai * HALF + m * 16) * ldc + colw), (size_t)ldc * 2, fr, fq, w[0], w[1]); }
    }
};
template <bool SSQ, bool BASE32> struct EpiResid {
    static constexpr bool PERM = true; static constexpr bool ADJ = true; static constexpr int REPS = 1;
    const float* base32; bf16_t* xb; float* ssq;
    __device__ __forceinline__ void operator()(const f32x4 (&acc)[2][2][4][2], const Unit& u, int wr, int wc, int fr, int fq) const {
        const int rowg = u.pm * BM + wr * 64, colw = u.pn * BM + wc * 64;
#pragma unroll
        for (int ai = 0; ai < 2; ++ai) {
            float bs[4][2][8];
#pragma unroll
            for (int m = 0; m < 4; ++m)
#pragma unroll
                for (int bj = 0; bj < 2; ++bj) { const size_t off = (size_t)(rowg + ai * HALF + m * 16 + fr) * D + colw + 32 * bj + 8 * fq;
                    if constexpr (BASE32) { const f32x4 a = *(const f32x4*)(base32 + off), b = *(const f32x4*)(base32 + off + 4);
                        bs[m][bj][0] = a[0]; bs[m][bj][1] = a[1]; bs[m][bj][2] = a[2]; bs[m][bj][3] = a[3]; bs[m][bj][4] = b[0]; bs[m][bj][5] = b[1]; bs[m][bj][6] = b[2]; bs[m][bj][7] = b[3]; }
                    else { const u32x4 r = *(const u32x4*)(xb + off);
                        bs[m][bj][0] = __builtin_bit_cast(float, r.x << 16); bs[m][bj][1] = __builtin_bit_cast(float, r.x & 0xffff0000u); bs[m][bj][2] = __builtin_bit_cast(float, r.y << 16); bs[m][bj][3] = __builtin_bit_cast(float, r.y & 0xffff0000u);
                        bs[m][bj][4] = __builtin_bit_cast(float, r.z << 16); bs[m][bj][5] = __builtin_bit_cast(float, r.z & 0xffff0000u); bs[m][bj][6] = __builtin_bit_cast(float, r.w << 16); bs[m][bj][7] = __builtin_bit_cast(float, r.w & 0xffff0000u); } }
            asm volatile("" ::: "memory");
#pragma unroll
            for (int m = 0; m < 4; ++m) { const int row = rowg + ai * HALF + m * 16 + fr; float s = 0.f; u32x4 w[2];
#pragma unroll
                for (int bj = 0; bj < 2; ++bj) { float o[8];
#pragma unroll
                    for (int n = 0; n < 2; ++n)
#pragma unroll
                        for (int j = 0; j < 4; ++j) o[n * 4 + j] = bs[m][bj][n * 4 + j] + acc[ai][bj][m][n][j];
                    w[bj].x = cvt_pk_bf16(o[0], o[1]); w[bj].y = cvt_pk_bf16(o[2], o[3]); w[bj].z = cvt_pk_bf16(o[4], o[5]); w[bj].w = cvt_pk_bf16(o[6], o[7]);
                    if constexpr (SSQ) { const unsigned ww[4] = {w[bj].x, w[bj].y, w[bj].z, w[bj].w};
#pragma unroll
                        for (int q = 0; q < 4; ++q) { const float r0 = __builtin_bit_cast(float, ww[q] << 16), r1 = __builtin_bit_cast(float, ww[q] & 0xffff0000u); s += r0 * r0 + r1 * r1; } } }
                store_lines((unsigned char*)(xb + (size_t)(rowg + ai * HALF + m * 16) * D + colw), (size_t)D * 2, fr, fq, w[0], w[1]);
                if constexpr (SSQ) { s += __shfl_xor(s, 16); s += __shfl_xor(s, 32);
                    if (fq == 0) ssq[(size_t)row * 16 + u.pn * 4 + wc] = s; } }
            asm volatile("" ::: "memory"); }
    }
};
template <int NP> struct EpiSwiglu {
    static constexpr bool PERM = true; static constexpr bool ADJ = false; static constexpr int REPS = REP_EPI;
    bf16_t* O; int ldc; const float* ssq; LAS float* rsl;
    __device__ __forceinline__ void operator()(const f32x4 (&acc)[2][2][4][2], const Unit& u, int wr, int wc, int fr, int fq) const {
        const int row0 = u.pm * BM + wr * 64 + fr, col0 = u.pn * HALF + wc * 32 + 8 * fq;
        if constexpr (NP == 16) panel_rs_to_lds(ssq, u.pm, rsl);
#pragma unroll
        for (int ai = 0; ai < 2; ++ai)
#pragma unroll
            for (int m = 0; m < 4; ++m) { const int row = row0 + ai * HALF + m * 16; float rs; if constexpr (NP == 16) rs = rsl[wr * 64 + fr + ai * HALF + m * 16]; else rs = row_rs<NP>(ssq, row);
                float h[8];
#pragma unroll
                for (int n = 0; n < 2; ++n)
#pragma unroll
                    for (int j = 0; j < 4; j += 2) { const f32x2 hh = swiglu2((f32x2){acc[ai][0][m][n][j], acc[ai][0][m][n][j + 1]}, (f32x2){acc[ai][1][m][n][j], acc[ai][1][m][n][j + 1]}, rs); h[n * 4 + j] = hh.x; h[n * 4 + j + 1] = hh.y; }
                u32x4 w; w.x = cvt_pk_bf16(h[0], h[1]); w.y = cvt_pk_bf16(h[2], h[3]); w.z = cvt_pk_bf16(h[4], h[5]); w.w = cvt_pk_bf16(h[6], h[7]);
                *(u32x4*)(O + (size_t)row * ldc + col0) = w; }
    }
};
struct EpiSwigluMoe {
    static constexpr bool PERM = true; static constexpr bool ADJ = false; static constexpr int REPS = 1; static constexpr int SCW = 0x7f7f7f7f;
    bf16_t* O; int ldc; const float* rsv; const int* row_tok; float wsinv;
    __device__ __forceinline__ void operator()(const f32x4 (&acc)[2][2][4][2], const Unit& u, int wr, int wc, int fr, int fq) const {
        const int row0 = u.pm * BM + wr * 64 + fr, col0 = u.pn * HALF + wc * 32 + 8 * fq;
#pragma unroll
        for (int ai = 0; ai < 2; ++ai)
#pragma unroll
            for (int m = 0; m < 4; ++m) { const int row = row0 + ai * HALF + m * 16; const int tok = row_tok[row]; const float rs = tok >= 0 ? rsv[tok] * wsinv : 0.f;
                float h[8];
#pragma unroll
                for (int n = 0; n < 2; ++n)
#pragma unroll
                    for (int j = 0; j < 4; j += 2) { const f32x2 hh = swiglu2((f32x2){acc[ai][0][m][n][j], acc[ai][0][m][n][j + 1]}, (f32x2){acc[ai][1][m][n][j], acc[ai][1][m][n][j + 1]}, rs); h[n * 4 + j] = hh.x; h[n * 4 + j + 1] = hh.y; }
                u32x4 w; w.x = cvt_pk_bf16(h[0], h[1]); w.y = cvt_pk_bf16(h[2], h[3]); w.z = cvt_pk_bf16(h[4], h[5]); w.w = cvt_pk_bf16(h[6], h[7]);
                *(u32x4*)(O + (size_t)row * ldc + col0) = w; }
    }
};
struct EpiSwigluMoe8 {
    static constexpr bool PERM = true; static constexpr bool ADJ = false; static constexpr int REPS = 1; static constexpr int SCW = 0x79797979;
    unsigned char* O; int ldc;
    __device__ __forceinline__ void operator()(const f32x4 (&acc)[2][2][4][2], const Unit& u, int wr, int wc, int fr, int fq) const {
        const int row0 = u.pm * BM + wr * 64 + fr, col0 = u.pn * HALF + wc * 32 + 8 * fq;
        constexpr float K = -1.44269504f;
#pragma unroll
        for (int ai = 0; ai < 2; ++ai)
#pragma unroll
            for (int mp = 0; mp < 4; mp += 2) { u32x2 w[2];
#pragma unroll
                for (int mm = 0; mm < 2; ++mm) { const int m = mp + mm; float h[8];
#pragma unroll
                    for (int n = 0; n < 2; ++n)
#pragma unroll
                        for (int j = 0; j < 4; j += 2) { const f32x2 a = {acc[ai][0][m][n][j], acc[ai][0][m][n][j + 1]}, uu = {acc[ai][1][m][n][j], acc[ai][1][m][n][j + 1]};
                            f32x2 e; e.x = __builtin_amdgcn_exp2f(a.x); e.y = __builtin_amdgcn_exp2f(a.y);
                            const f32x2 d = e * K + K, p = a * uu; f32x2 r; r.x = __builtin_amdgcn_rcpf(d.x); r.y = __builtin_amdgcn_rcpf(d.y);
                            const f32x2 hh = p * r; h[n * 4 + j] = hh.x; h[n * 4 + j + 1] = hh.y; }
                    w[mm].x = pk4_fp8(h[0], h[1], h[2], h[3]); w[mm].y = pk4_fp8(h[4], h[5], h[6], h[7]); }
                const auto sx = __builtin_amdgcn_permlane16_swap(w[0].x, w[1].x, false, false), sy = __builtin_amdgcn_permlane16_swap(w[0].y, w[1].y, false, false);
                u32x4 o; o.x = sx[0]; o.y = sy[0]; o.z = sx[1]; o.w = sy[1];
                *(u32x4*)(O + (size_t)(row0 + ai * HALF + (mp + (fq & 1)) * 16) * ldc + col0 - 8 * (fq & 1)) = o; }
    }
};
struct EpiMoeDown {
    static constexpr bool PERM = true; static constexpr bool ADJ = false; static constexpr int REPS = 1; static constexpr int SCW = 0x7f7f7f7f;
    bf16_t* out; const int* row_tok; const float* row_gate; float sc; LAS int* tkl;
    __device__ __forceinline__ void operator()(const f32x4 (&acc)[2][2][4][2], const Unit& u, int wr, int wc, int fr, int fq) const {
        const int col0 = u.pn * BM + wc * 32 + 8 * fq;
        if (threadIdx.x < 256) { tkl[threadIdx.x] = row_tok[u.pm * BM + (int)threadIdx.x]; ((LAS float*)tkl)[256 + threadIdx.x] = row_gate[u.pm * BM + (int)threadIdx.x]; }
        asm volatile("s_waitcnt lgkmcnt(0)" ::: "memory"); __builtin_amdgcn_s_barrier(); asm volatile("" ::: "memory");
        int tk[2][4]; float gt[2][4];
#pragma unroll
        for (int ai = 0; ai < 2; ++ai)
#pragma unroll
            for (int m = 0; m < 4; ++m) { const int rl = wr * 64 + fr + ai * HALF + m * 16; tk[ai][m] = tkl[rl]; gt[ai][m] = ((const LAS float*)tkl)[256 + rl]; }
#pragma unroll
        for (int ai = 0; ai < 2; ++ai) {
            u32x4 cur[4][2];
#pragma unroll
            for (int m = 0; m < 4; ++m) { const int tok = tk[ai][m] < 0 ? 0 : tk[ai][m];
#pragma unroll
                for (int bj = 0; bj < 2; ++bj) cur[m][bj] = *(const u32x4*)(out + (size_t)tok * D + col0 + bj * HALF); }
            asm volatile("" ::: "memory");
#pragma unroll
            for (int m = 0; m < 4; ++m) { const int tok = tk[ai][m]; const float g = gt[ai][m] * sc;
                if (tok >= 0) { bf16_t* rp = out + (size_t)tok * D + col0;
#pragma unroll
                    for (int bj = 0; bj < 2; ++bj) { const u32x4 r = cur[m][bj]; const f32x4 a0 = acc[ai][bj][m][0] * g, a1 = acc[ai][bj][m][1] * g; u32x4 w;
                        w.x = cvt_pk_bf16(__builtin_bit_cast(float, r.x << 16) + a0[0], __builtin_bit_cast(float, r.x & 0xffff0000u) + a0[1]);
                        w.y = cvt_pk_bf16(__builtin_bit_cast(float, r.y << 16) + a0[2], __builtin_bit_cast(float, r.y & 0xffff0000u) + a0[3]);
                        w.z = cvt_pk_bf16(__builtin_bit_cast(float, r.z << 16) + a1[0], __builtin_bit_cast(float, r.z & 0xffff0000u) + a1[1]);
                        w.w = cvt_pk_bf16(__builtin_bit_cast(float, r.w << 16) + a1[2], __builtin_bit_cast(float, r.w & 0xffff0000u) + a1[3]);
                        *(u32x4*)(rp + bj * HALF) = w; } } }
            asm volatile("" ::: "memory"); }
    }
};
}

#define XB_TMO      128
#define XB_XCNT(j)  (256  + 64 * (j))
#define XB_XSUB(j)  (1280 + 64 * (j))
#define XB_XGEN(j)  (2304 + 64 * (j))
#define XB_TOP      3328
#define XB_TOPGEN   3392
#define XCD_BAR_WORDS 3456
#define XB_SPIN_CAP (1u << 18)
__device__ __forceinline__ unsigned xb_ld(unsigned* p)              { return __hip_atomic_load(p, __ATOMIC_RELAXED, __HIP_MEMORY_SCOPE_AGENT); }
__device__ __forceinline__ unsigned xb_add(unsigned* p, unsigned v) { return __hip_atomic_fetch_add(p, v, __ATOMIC_RELAXED, __HIP_MEMORY_SCOPE_AGENT); }
__device__ __forceinline__ unsigned xb_xcc_id() { return (unsigned)__builtin_amdgcn_s_getreg((3 << 11) | 20) & 0xFu; }
#define XB_SPIN(cond, bar) do { unsigned _sp = 0; while (cond) { __builtin_amdgcn_s_sleep(1); \
    if ((++_sp & 255u) == 0u) { if (xb_ld(&(bar)[XB_TMO])) break; if (_sp > XB_SPIN_CAP) { atomicAdd(&(bar)[XB_TMO], 1u); break; } } } } while (0)
struct XcdBarrier { unsigned* bar; unsigned x; volatile LAS unsigned* st; };
__device__ __forceinline__ XcdBarrier xcd_barrier_post(unsigned* bar, volatile LAS unsigned* st) {
    XcdBarrier b; b.bar = bar; b.x = xb_xcc_id(); b.st = st;
    if (threadIdx.x == 0) (void)xb_add(&bar[XB_XCNT(b.x)], 1u);
    return b;
}
__device__ __forceinline__ void xcd_barrier_complete(unsigned* bar, unsigned x, unsigned& nloc, unsigned& nx) {
    const unsigned G = gridDim.x * gridDim.y * gridDim.z;
    unsigned sum, cnt, mine, sp = 0u;
    for (;;) {
        sum = 0u; cnt = 0u; mine = 0u;
#pragma unroll
        for (unsigned j = 0; j < 16; ++j) { const unsigned c = xb_ld(&bar[XB_XCNT(j)]); sum += c; cnt += (c > 0u) ? 1u : 0u; mine = (j == x) ? c : mine; }
        if (sum == G) break;
        __builtin_amdgcn_s_sleep(1);
        if ((++sp & 255u) == 0u) { if (xb_ld(&bar[XB_TMO])) break; if (sp > XB_SPIN_CAP) { atomicAdd(&bar[XB_TMO], 1u); break; } }
    }
    nloc = mine > 0u ? mine : 1u; nx = cnt > 0u ? cnt : 1u;
}
__device__ __forceinline__ void xcd_barrier(const XcdBarrier& b) {
    asm volatile("s_waitcnt vmcnt(0)" ::: "memory");
    __syncthreads();
    if (threadIdx.x == 0) {
        unsigned* bar = b.bar;
        __builtin_amdgcn_s_waitcnt(0);
        unsigned nloc = b.st[0], nx = b.st[1];
        if (nloc == 0u) { xcd_barrier_complete(bar, b.x, nloc, nx); b.st[0] = nloc; b.st[1] = nx; }
        const unsigned old = xb_add(&bar[XB_XSUB(b.x)], 1u);
        const unsigned gen = old / nloc;
        if (old + 1u == (gen + 1u) * nloc) {
            __builtin_amdgcn_fence(__ATOMIC_RELEASE, "agent");
            asm volatile("s_waitcnt vmcnt(0)" ::: "memory");
            const unsigned og = xb_add(&bar[XB_TOP], 1u);
            const unsigned tg = og / nx;
            if (og + 1u == (tg + 1u) * nx) xb_add(&bar[XB_TOPGEN], 1u);
            else XB_SPIN(xb_ld(&bar[XB_TOPGEN]) == tg, bar);
            __builtin_amdgcn_fence(__ATOMIC_ACQUIRE, "agent");
            xb_add(&bar[XB_XGEN(b.x)], 1u);
            asm volatile("s_waitcnt vmcnt(0)" ::: "memory");
        } else {
            XB_SPIN(xb_ld(&bar[XB_XGEN(b.x)]) == gen, bar);
            __builtin_amdgcn_fence(__ATOMIC_ACQUIRE, "agent");
            asm volatile("s_waitcnt vmcnt(0)" ::: "memory");
        }
    }
    __syncthreads();
}

__device__ __forceinline__ void hnd_arrive(unsigned* w) {
    asm volatile("s_waitcnt vmcnt(0)" ::: "memory");
    __syncthreads();
    if (threadIdx.x == 0) { __builtin_amdgcn_fence(__ATOMIC_RELEASE, "agent"); asm volatile("s_waitcnt vmcnt(0)" ::: "memory"); (void)xb_add(w, 1u); }
}
__device__ __forceinline__ void hnd_wait(unsigned* w, unsigned target, unsigned* bar) {
    if (threadIdx.x == 0) { XB_SPIN(xb_ld(w) < target, bar); __builtin_amdgcn_fence(__ATOMIC_ACQUIRE, "agent"); asm volatile("s_waitcnt vmcnt(0)" ::: "memory"); }
    __syncthreads();
}

constexpr int NIN = 28;
struct Args { const float* in[NIN]; float* out; unsigned char* ws; int ph_lo, ph_hi; };
enum { I_X = 0, I_NORM_MIX, I_W_IN, I_W_OUT, I_SHIFT_MU, I_GM_LN_W, I_GM_LN_B, I_GM_WS, I_GM_BS, I_RW_W_UP, I_RW_W0, I_RW_A_UP, I_RW_A0, I_RW_G_UP, I_RW_K_K, I_RW_K_A, I_RW_R_K,
       I_RW_LNX_W, I_RW_LNX_B, I_NORM_FFN, I_FFN_WG, I_FFN_WU, I_FFN_WD, I_MOE_ROUTER, I_MOE_WG, I_MOE_WU, I_MOE_WD, I_NORM_FINAL };

struct Frame {
    LAS unsigned char* lds;
    int tid, lane, wave, G, gw, NGW;
};

struct CvItem { f32x4 v[8]; float gn[8]; };
__device__ __forceinline__ void cv_load(CvItem& it, const float* W, int N, int k0, int n0, const float* gain, float scale, int lane) {
    const int kr = lane >> 3, nq = lane & 7;
#pragma unroll
    for (int i = 0; i < 8; ++i) { it.v[i] = *(const GAS f32x4*)(W + (size_t)(k0 + 8 * i + kr) * N + n0 + 4 * nq); it.gn[i] = gain ? gain[k0 + 8 * i + kr] * scale : scale; }
}
__device__ __forceinline__ void cv_store_fp8(const CvItem& it, int K, unsigned char* WT, int drow0, int k0, LAS float* scr, int lane) {
    { const int kr = lane >> 3, nq = lane & 7;
#pragma unroll
      for (int i = 0; i < 8; ++i) { LAS float* d = scr + (8 * i + kr) * 33 + 4 * nq; d[0] = it.v[i][0] * it.gn[i]; d[1] = it.v[i][1] * it.gn[i]; d[2] = it.v[i][2] * it.gn[i]; d[3] = it.v[i][3] * it.gn[i]; } }
    LDS_WAIT(); asm volatile("" ::: "memory");
    const int n = lane >> 1, hf = lane & 1; const LAS float* sp = scr + (32 * hf) * 33 + n; u32x4 o0, o1;
    o0.x = pk4_fp8(sp[0 * 33], sp[1 * 33], sp[2 * 33], sp[3 * 33]); o0.y = pk4_fp8(sp[4 * 33], sp[5 * 33], sp[6 * 33], sp[7 * 33]); o0.z = pk4_fp8(sp[8 * 33], sp[9 * 33], sp[10 * 33], sp[11 * 33]); o0.w = pk4_fp8(sp[12 * 33], sp[13 * 33], sp[14 * 33], sp[15 * 33]);
    o1.x = pk4_fp8(sp[16 * 33], sp[17 * 33], sp[18 * 33], sp[19 * 33]); o1.y = pk4_fp8(sp[20 * 33], sp[21 * 33], sp[22 * 33], sp[23 * 33]); o1.z = pk4_fp8(sp[24 * 33], sp[25 * 33], sp[26 * 33], sp[27 * 33]); o1.w = pk4_fp8(sp[28 * 33], sp[29 * 33], sp[30 * 33], sp[31 * 33]);
    unsigned char* dst = WT + (size_t)(drow0 + n) * K + k0 + 32 * hf; *(GAS u32x4*)dst = o0; *(GAS u32x4*)(dst + 16) = o1;
    LDS_WAIT(); asm volatile("" ::: "memory");
}
__device__ __forceinline__ void transpose_item(const float* W, int K, int N, bf16* WT, int drow0, int k0, int n0, const float* gain, LAS float* scr, int lane) {
    { const int kr = lane >> 3, nq = lane & 7; f32x4 v[8]; float gn[8];
#pragma unroll
      for (int i = 0; i < 8; ++i) { v[i] = *(const GAS f32x4*)(W + (size_t)(k0 + 8 * i + kr) * N + n0 + 4 * nq); gn[i] = gain ? gain[k0 + 8 * i + kr] : 1.f; }
#pragma unroll
      for (int i = 0; i < 8; ++i) { LAS float* d = scr + (8 * i + kr) * 33 + 4 * nq; d[0] = v[i][0] * gn[i]; d[1] = v[i][1] * gn[i]; d[2] = v[i][2] * gn[i]; d[3] = v[i][3] * gn[i]; } }
    LDS_WAIT(); asm volatile("" ::: "memory");
    const int c = lane & 7;
#pragma unroll
    for (int j = 0; j < 4; ++j) { const int n = (lane >> 3) + 8 * j; const LAS float* s = scr + (8 * c) * 33 + n;
        u32x4 o; o.x = pk2(s[0 * 33], s[1 * 33]); o.y = pk2(s[2 * 33], s[3 * 33]); o.z = pk2(s[4 * 33], s[5 * 33]); o.w = pk2(s[6 * 33], s[7 * 33]);
        *(GAS u32x4*)(WT + (size_t)(drow0 + n) * K + k0 + 8 * c) = o; }
    LDS_WAIT(); asm volatile("" ::: "memory");
}
__device__ __forceinline__ void convert_matrix_fp8(Frame& F, const float* W, int K, int N, unsigned char* WT, int gu_mode  , const float* gain, float scale, int& itbase) {
    LAS float* scr = (LAS float*)(F.lds + F.wave * 16384);
    const int nblk = N / 32, nit = (K / 64) * nblk;
    int first = F.gw - (itbase % F.NGW); if (first < 0) first += F.NGW;
    CvItem nx;
    if (first < nit) cv_load(nx, W, N, 64 * (first / nblk), 32 * (first % nblk), gain, scale, F.lane);
    for (int r = first; r < nit; r += F.NGW) { const int kb = r / nblk, nb = r % nblk, n0 = 32 * nb;
        const int drow0 = gu_mode == 0 ? n0 : (n0 / 128) * 256 + (gu_mode == 2 ? 128 : 0) + (n0 % 128);
        const CvItem cur = nx; const int r2 = r + F.NGW;
        if (r2 < nit) cv_load(nx, W, N, 64 * (r2 / nblk), 32 * (r2 % nblk), gain, scale, F.lane);
        cv_store_fp8(cur, K, WT, drow0, 64 * kb, scr, F.lane); }
    itbase += nit;
}
__device__ __forceinline__ void convert_matrix(Frame& F, const float* W, int K, int N, bf16* WT, int gu_mode  , const float* gain, int it0, int& itbase) {
    LAS float* scr = (LAS float*)(F.lds + F.wave * 16384);
    const int nblk = N / 32, nit = (K / 64) * nblk;
    int first = F.gw - (itbase % F.NGW); if (first < 0) first += F.NGW;
    for (int r = first; r < nit; r += F.NGW) { const int kb = r / nblk, nb = r % nblk, n0 = 32 * nb;
        const int drow0 = gu_mode == 0 ? n0 : (n0 / 128) * 256 + (gu_mode == 2 ? 128 : 0) + (n0 % 128);
        transpose_item(W, K, N, WT, drow0, 64 * kb, n0, gain, scr, F.lane); }
    itbase += nit; (void)it0;
}

__device__ __forceinline__ void gmlp_naive(Frame& F, const bf16* P, bf16* Y, const float* ln_w, const float* ln_b, const float* ws, const float* bs) {
    LAS float* V = (LAS float*)F.lds;
    for (int unit = blockIdx.x; unit < NB * (SEQ / GCH) * NH; unit += F.G) {
        const int h = unit % NH, bc = unit / NH; const size_t row0 = (size_t)bc * GCH;
        const float lw = ln_w[h * HD + F.lane], lb = ln_b[h * HD + F.lane];
        for (int i = 0; i < 16; ++i) { const int t = F.wave * 16 + i;
            const float g = gelu_erf(bf2f(P[(row0 + t) * INW + GMW + h * HD + F.lane]));
            const float mean = wave_sum(g) * (1.f / HD); const float d = g - mean; const float var = wave_sum(d * d) * (1.f / HD);
            V[t * HD + F.lane] = d * __builtin_amdgcn_rsqf(var + LN_EPS) * lw + lb; }
        __syncthreads();
        for (int i = 0; i < 16; ++i) { const int t = F.wave * 16 + i; const float* wrow = ws + ((size_t)h * GCH + t) * GCH; float acc = 0.f;
            for (int s = 0; s <= t; ++s) acc += wrow[s] * V[s * HD + F.lane];
            const float mixed = acc + bs[h * GCH + t];
            const float u = gelu_erf(bf2f(P[(row0 + t) * INW + h * HD + F.lane]));
            Y[(row0 + t) * D + h * HD + F.lane] = (bf16)f2bf(u * mixed); }
        __syncthreads();
    }
}
__device__ __forceinline__ float shifted(const bf16* P, size_t row, int t, int col, const float* mu) {
    const float c = bf2f(P[row * INW + col]); const float pr = t > 0 ? bf2f(P[(row - 1) * INW + col]) : 0.f;
    return c + (pr - c) * mu[col - 1024];
}
constexpr int NC = 32;
__device__ __forceinline__ void rwkv_naive(Frame& F, const bf16* P, bf16* Y, const float* mu, const float* w_up, const float* w0, const float* a_up, const float* a0, const float* g_up,
                                           const float* k_k, const float* k_a, const float* r_k, const float* lnx_w, const float* lnx_b) {
    LAS float* LI = (LAS float*)F.lds;
    LAS float* sR = LI + NC * 256; LAS float* sW = sR + NC * 64; LAS float* sK = sW + NC * 64; LAS float* sV = sK + NC * 64; LAS float* sA = sV + NC * 64; LAS float* sB = sA + NC * 64;
    LAS float* sG = sB + NC * 64; LAS float* sBon = sG + NC * 64;
    for (int unit = blockIdx.x; unit < NB * NH; unit += F.G) {
        const int b = unit / NH, h = unit % NH;
        float S[64];
#pragma unroll
        for (int k = 0; k < 64; ++k) S[k] = 0.f;
        for (int c = 0; c < SEQ / NC; ++c) {
            const int t0 = c * NC; const size_t row0 = (size_t)b * SEQ + t0;
            for (int idx = F.tid; idx < NC * 256; idx += 512) { const int tok = idx >> 8, j = idx & 255;
                const float x = shifted(P, row0 + tok, t0 + tok, 2560 + j, mu);
                LI[idx] = j < 64 ? tanhf(x) : (j < 128 ? x : sigmoidf_(x)); }
            __syncthreads();
            { const int ch = F.lane, hc = h * HD + ch;
              for (int i = 0; i < NC / 8; ++i) { const int tok = F.wave + 8 * i; const size_t row = row0 + tok; const int t = t0 + tok;
                const float rr = shifted(P, row, t, 1024 + hc, mu), kx = shifted(P, row, t, 1536 + hc, mu), vv = shifted(P, row, t, 2048 + hc, mu);
                float dw = w0[hc], da = a0[hc], gg = 0.f;
                for (int j = 0; j < 64; ++j) { dw += LI[tok * 256 + j] * w_up[j * RWW + hc]; da += LI[tok * 256 + 64 + j] * a_up[j * RWW + hc]; }
                for (int j = 0; j < 128; ++j) gg += LI[tok * 256 + 128 + j] * g_up[j * RWW + hc];
                const float z = -dw; const float sp = fmaxf(z, 0.f) + log1pf(__expf(-fabsf(z)));
                const float decay = __expf(-__expf(-sp - 0.5f));
                const float alr = sigmoidf_(da);
                const float kkv = kx * k_k[hc]; const float nrm = sqrtf(wave_sum(kkv * kkv)); const float kkn = kkv / fmaxf(nrm, 1e-12f);
                const float kmod = kx * (1.f + (alr - 1.f) * k_a[hc]);
                const float bsc = wave_sum(rr * kmod * r_k[hc]);
                sR[tok * 64 + ch] = rr; sW[tok * 64 + ch] = decay; sK[tok * 64 + ch] = kmod; sV[tok * 64 + ch] = vv; sA[tok * 64 + ch] = -kkn; sB[tok * 64 + ch] = kkn * alr;
                sG[tok * 64 + ch] = gg; sBon[tok * 64 + ch] = bsc * vv; } }
            __syncthreads();
            if (F.wave == 0) {
                for (int t = 0; t < NC; ++t) { float sa = 0.f;
#pragma unroll
                    for (int k = 0; k < 64; ++k) sa += S[k] * sA[t * 64 + k];
                    const float vv = sV[t * 64 + F.lane]; float yv = 0.f;
#pragma unroll
                    for (int k = 0; k < 64; ++k) { S[k] = S[k] * sW[t * 64 + k] + sa * sB[t * 64 + k] + vv * sK[t * 64 + k]; yv += S[k] * sR[t * 64 + k]; }
                    LI[t * 64 + F.lane] = yv; }
            }
            __syncthreads();
            { const int v = F.lane, hv = h * HD + v;
              for (int i = 0; i < NC / 8; ++i) { const int tok = F.wave + 8 * i; const float yv = LI[tok * 64 + v];
                const float mean = wave_sum(yv) * (1.f / HD); const float d = yv - mean; const float var = wave_sum(d * d) * (1.f / HD);
                const float yn = d * __builtin_amdgcn_rsqf(var + GN_EPS) * lnx_w[hv] + lnx_b[hv];
                Y[(row0 + tok) * D + GMW + hv] = (bf16)f2bf((yn + sBon[tok * 64 + v]) * sG[tok * 64 + v]); } }
            __syncthreads();
        }
    }
}

typedef short s16x4 __attribute__((ext_vector_type(4)));
typedef short v4i16_t __attribute__((ext_vector_type(4)));
#define MFMA32(a, b, c) __builtin_amdgcn_mfma_f32_16x16x32_bf16((a), (b), (c), 0, 0, 0)
#define MFMA16(a, b, c) __builtin_amdgcn_mfma_f32_16x16x16bf16_1k((a), (b), (c), 0, 0, 0)
__device__ __forceinline__ bf16x8 lds_row8(const LAS bf16* T, int ld, int r0, int k0, int lane) { return *(const LAS bf16x8*)(T + (r0 + (lane & 15)) * ld + k0 + 8 * (lane >> 4)); }
__device__ __forceinline__ s16x4 lds_row4(const LAS bf16* T, int ld, int r0, int k0, int lane) { return *(const LAS s16x4*)(T + (r0 + (lane & 15)) * ld + k0 + 4 * (lane >> 4)); }
__device__ __forceinline__ s16x4 lds_tr4(const LAS bf16* T, int ld, int k0, int c0, int lane) { const int i = lane & 15, g = lane >> 4;
    return __builtin_bit_cast(s16x4, __builtin_amdgcn_ds_read_tr16_b64_v4i16((LAS v4i16_t*)(T + (k0 + 4 * g + (i >> 2)) * ld + c0 + 4 * (i & 3)))); }
__device__ __forceinline__ bf16x8 lds_tr8(const LAS bf16* T, int ld, int k0, int c0, int lane) { const int i = lane & 15, g = lane >> 4;
    const LAS bf16* p = T + (k0 + 8 * g + (i >> 2)) * ld + c0 + 4 * (i & 3);
    const s16x4 lo = __builtin_bit_cast(s16x4, __builtin_amdgcn_ds_read_tr16_b64_v4i16((LAS v4i16_t*)p));
    const s16x4 hi = __builtin_bit_cast(s16x4, __builtin_amdgcn_ds_read_tr16_b64_v4i16((LAS v4i16_t*)(p + 4 * ld)));
    bf16x8 r; r[0] = lo[0]; r[1] = lo[1]; r[2] = lo[2]; r[3] = lo[3]; r[4] = hi[0]; r[5] = hi[1]; r[6] = hi[2]; r[7] = hi[3]; return r; }
typedef __bf16 bf16x2_t __attribute__((ext_vector_type(2)));
__device__ __forceinline__ unsigned cvtpk_c(float lo, float hi) { const f32x2 v = {lo, hi}; const bf16x2_t b = __builtin_convertvector(v, bf16x2_t); return __builtin_bit_cast(unsigned, b); }
__device__ __forceinline__ s16x4 pack4(const f32x4 v) { u32x2 w; w.x = cvtpk_c(v[0], v[1]); w.y = cvtpk_c(v[2], v[3]); return __builtin_bit_cast(s16x4, w); }
__device__ __forceinline__ f32x4 unpack4(const s16x4 v) { f32x4 r; r[0] = bf2f((bf16)v[0]); r[1] = bf2f((bf16)v[1]); r[2] = bf2f((bf16)v[2]); r[3] = bf2f((bf16)v[3]); return r; }
__device__ __forceinline__ void unpack8(const u32x4 w, float (&o)[8]) { o[0] = __builtin_bit_cast(float, w.x << 16); o[1] = __builtin_bit_cast(float, w.x & 0xffff0000u); o[2] = __builtin_bit_cast(float, w.y << 16); o[3] = __builtin_bit_cast(float, w.y & 0xffff0000u);
    o[4] = __builtin_bit_cast(float, w.z << 16); o[5] = __builtin_bit_cast(float, w.z & 0xffff0000u); o[6] = __builtin_bit_cast(float, w.w << 16); o[7] = __builtin_bit_cast(float, w.w & 0xffff0000u); }
__device__ __forceinline__ u32x4 pack8(const float (&v)[8]) { u32x4 w; w.x = cvtpk_c(v[0], v[1]); w.y = cvtpk_c(v[2], v[3]); w.z = cvtpk_c(v[4], v[5]); w.w = cvtpk_c(v[6], v[7]); return w; }
__device__ __forceinline__ float gelu_as(float v) {
    const float av = fabsf(v), t = __builtin_amdgcn_rcpf(av * 0.2316418882f + 1.0f);
    float q = t * 0.5307027145f + (-0.7265760135f); q = q * t + 0.7107068705f; q = q * t + (-0.142248368f); q = q * t + 0.127414796f; q = q * t;
    const float e = __builtin_amdgcn_exp2f((v * v) * (-0.72134752044f)); const float m = v * (q * e); return v < 0.f ? m : v - m;
}

__device__ __forceinline__ f32x2 gelu_pk2(f32x2 v) {
    const f32x2 av = __builtin_elementwise_abs(v), d = av * 0.2316418882f + 1.0f;
    f32x2 t; t.x = __builtin_amdgcn_rcpf(d.x); t.y = __builtin_amdgcn_rcpf(d.y);
    f32x2 q = t * 0.5307027145f + (-0.7265760135f); q = q * t + 0.7107068705f; q = q * t + (-0.142248368f); q = q * t + 0.127414796f; q = q * t;
    const f32x2 s2 = (v * v) * (-0.72134752044f);
    f32x2 e; e.x = __builtin_amdgcn_exp2f(s2.x); e.y = __builtin_amdgcn_exp2f(s2.y);
    const f32x2 m = v * (q * e), r = v - m;
    f32x2 o; o.x = v.x < 0.f ? m.x : r.x; o.y = v.y < 0.f ? m.y : r.y; return o;
}
constexpr int GM_V = 0, GM_U = 128 * 72 * 2;
__device__ __forceinline__ void gmlp_unit(Frame& F, int unit, const bf16* P, bf16* Y, const float* ln_w, const float* ln_b, const bf16* WsB, const float* bs) {
    LAS bf16* Vt = (LAS bf16*)(F.lds + GM_V); LAS bf16* Ut = (LAS bf16*)(F.lds + GM_U);
    const int h = unit % NH, bc = unit / NH; const size_t row0 = (size_t)bc * GCH;
    { const int t = F.tid >> 2, cq = F.tid & 3; const bf16* pr = P + (row0 + t) * INW + h * HD + 16 * cq;
      const u32x4 u0 = *(const u32x4*)pr, u1 = *(const u32x4*)(pr + 8), v0 = *(const u32x4*)(pr + GMW), v1 = *(const u32x4*)(pr + GMW + 8);
      float uu[16], vv[16]; { float a[8]; unpack8(u0, a); for (int j = 0; j < 8; ++j) uu[j] = a[j]; unpack8(u1, a); for (int j = 0; j < 8; ++j) uu[8 + j] = a[j]; unpack8(v0, a); for (int j = 0; j < 8; ++j) vv[j] = a[j]; unpack8(v1, a); for (int j = 0; j < 8; ++j) vv[8 + j] = a[j]; }
      float s = 0.f;
#pragma unroll
      for (int j = 0; j < 16; ++j) { uu[j] = gelu_as(uu[j]); vv[j] = gelu_as(vv[j]); s += vv[j]; }
      s += __shfl_xor(s, 1); s += __shfl_xor(s, 2); const float mean = s * (1.f / HD); float q = 0.f;
#pragma unroll
      for (int j = 0; j < 16; ++j) { vv[j] -= mean; q += vv[j] * vv[j]; }
      q += __shfl_xor(q, 1); q += __shfl_xor(q, 2); const float rstd = __builtin_amdgcn_rsqf(q * (1.f / HD) + LN_EPS);
#pragma unroll
      for (int j = 0; j < 16; ++j) vv[j] = vv[j] * rstd * ln_w[h * HD + 16 * cq + j] + ln_b[h * HD + 16 * cq + j];
      float a[8]; for (int j = 0; j < 8; ++j) a[j] = vv[j]; *(LAS u32x4*)(Vt + t * 72 + 16 * cq) = pack8(a); for (int j = 0; j < 8; ++j) a[j] = vv[8 + j]; *(LAS u32x4*)(Vt + t * 72 + 16 * cq + 8) = pack8(a);
      for (int j = 0; j < 8; ++j) a[j] = uu[j]; *(LAS u32x4*)(Ut + t * 72 + 16 * cq) = pack8(a); for (int j = 0; j < 8; ++j) a[j] = uu[8 + j]; *(LAS u32x4*)(Ut + t * 72 + 16 * cq + 8) = pack8(a); }
    __syncthreads();
    { const int w = F.wave, l15 = F.lane & 15, g = F.lane >> 4, t0 = 16 * w, nks = (w >> 1) + 1; const bf16* wrow = WsB + ((size_t)h * GCH + t0 + l15) * GCH + 8 * g;
      f32x4 acc[4] = {{0.f, 0.f, 0.f, 0.f}, {0.f, 0.f, 0.f, 0.f}, {0.f, 0.f, 0.f, 0.f}, {0.f, 0.f, 0.f, 0.f}};
      for (int ks = 0; ks < nks; ++ks) { const bf16x8 a = *(const bf16x8*)(wrow + 32 * ks);
#pragma unroll
          for (int nt = 0; nt < 4; ++nt) acc[nt] = MFMA32(a, lds_tr8(Vt, 72, 32 * ks, 16 * nt, F.lane), acc[nt]); }
#pragma unroll
      for (int reg = 0; reg < 4; ++reg) { const int t = t0 + 4 * g + reg; const float bsv = bs[h * GCH + t];
#pragma unroll
          for (int nt = 0; nt < 4; ++nt) { LAS bf16* up = Ut + t * 72 + 16 * nt + l15; *up = (bf16)f2bf(bf2f(*up) * (acc[nt][reg] + bsv)); } } }
    __syncthreads();
    { const int t = F.tid >> 2, cq = F.tid & 3; bf16* yr = Y + (row0 + t) * D + h * HD + 16 * cq;
      *(u32x4*)yr = *(const LAS u32x4*)(Ut + t * 72 + 16 * cq); *(u32x4*)(yr + 8) = *(const LAS u32x4*)(Ut + t * 72 + 16 * cq + 8); }
    __syncthreads();
}

__device__ __forceinline__ void gmlp_units(Frame& F, int u0, int ustep, int nunits, const bf16* P, bf16* Y, const float* ln_w, const float* ln_b, const bf16* WsB, const float* bs) {
    if (u0 >= nunits) return;
    const int t = F.tid >> 2, cq = F.tid & 3; const int w = F.wave, l15 = F.lane & 15, g = F.lane >> 4, t0 = 16 * w, nks = (w >> 1) + 1;
    LAS float* TB = (LAS float*)(F.lds + 73728);
    TB[F.tid] = ln_w[F.tid]; TB[512 + F.tid] = ln_b[F.tid]; TB[1024 + F.tid] = bs[F.tid]; TB[1536 + F.tid] = bs[512 + F.tid];
    LDS_BARRIER();
    u32x4 pu0, pu1, pv0, pv1;
#define GM_LOAD(uu_) do { const int h_ = (uu_) % NH, bc_ = (uu_) / NH; const bf16* pr_ = P + ((size_t)bc_ * GCH + t) * INW + h_ * HD + 16 * cq; \
        pu0 = *(const u32x4*)pr_; pu1 = *(const u32x4*)(pr_ + 8); pv0 = *(const u32x4*)(pr_ + GMW); pv1 = *(const u32x4*)(pr_ + GMW + 8); } while (0)
    GM_LOAD(u0);
    int it = 0;
    for (int unit = u0; unit < nunits; unit += ustep, ++it) {
        LAS bf16* Vt = (LAS bf16*)(F.lds + (it & 1) * (2 * 128 * 72 * 2)); LAS bf16* Ut = Vt + 128 * 72;
        const int h = unit % NH, bc = unit / NH; const size_t row0 = (size_t)bc * GCH;
        const bf16* wrow = WsB + ((size_t)h * GCH + t0 + l15) * GCH + 8 * g; bf16x8 af[4];
#pragma unroll
        for (int ks = 0; ks < 4; ++ks) af[ks] = *(const bf16x8*)(wrow + 32 * (ks < nks ? ks : 0));
        const f32x4 bsv = *(const LAS f32x4*)(TB + 1024 + h * GCH + t0 + 4 * g);
        float uu[16], vv[16]; { float a[8]; unpack8(pu0, a); for (int j = 0; j < 8; ++j) uu[j] = a[j]; unpack8(pu1, a); for (int j = 0; j < 8; ++j) uu[8 + j] = a[j]; unpack8(pv0, a); for (int j = 0; j < 8; ++j) vv[j] = a[j]; unpack8(pv1, a); for (int j = 0; j < 8; ++j) vv[8 + j] = a[j]; }
        if (unit + ustep < nunits) GM_LOAD(unit + ustep);
        float sm = 0.f;
#pragma unroll
        for (int j = 0; j < 16; j += 2) { const f32x2 gu = gelu_pk2((f32x2){uu[j], uu[j + 1]}), gv = gelu_pk2((f32x2){vv[j], vv[j + 1]}); uu[j] = gu.x; uu[j + 1] = gu.y; vv[j] = gv.x; vv[j + 1] = gv.y; sm += gv.x + gv.y; }
        sm += __shfl_xor(sm, 1); sm += __shfl_xor(sm, 2); const float mean = sm * (1.f / HD); float q = 0.f;
#pragma unroll
        for (int j = 0; j < 16; ++j) { vv[j] -= mean; q += vv[j] * vv[j]; }
        q += __shfl_xor(q, 1); q += __shfl_xor(q, 2); const float rstd = __builtin_amdgcn_rsqf(q * (1.f / HD) + LN_EPS);
#pragma unroll
        for (int j = 0; j < 16; ++j) vv[j] = vv[j] * rstd * TB[h * HD + 16 * cq + j] + TB[512 + h * HD + 16 * cq + j];
        { float a[8]; for (int j = 0; j < 8; ++j) a[j] = vv[j]; *(LAS u32x4*)(Vt + t * 72 + 16 * cq) = pack8(a); for (int j = 0; j < 8; ++j) a[j] = vv[8 + j]; *(LAS u32x4*)(Vt + t * 72 + 16 * cq + 8) = pack8(a);
          for (int j = 0; j < 8; ++j) a[j] = uu[j]; *(LAS u32x4*)(Ut + t * 72 + 16 * cq) = pack8(a); for (int j = 0; j < 8; ++j) a[j] = uu[8 + j]; *(LAS u32x4*)(Ut + t * 72 + 16 * cq + 8) = pack8(a); }
        LDS_BARRIER();
        { f32x4 acc[4] = {{0.f, 0.f, 0.f, 0.f}, {0.f, 0.f, 0.f, 0.f}, {0.f, 0.f, 0.f, 0.f}, {0.f, 0.f, 0.f, 0.f}};
#pragma unroll
          for (int ks = 0; ks < 4; ++ks) if (ks < nks) {
#pragma unroll
              for (int nt = 0; nt < 4; ++nt) acc[nt] = MFMA32(af[ks], lds_tr8(Vt, 72, 32 * ks, 16 * nt, F.lane), acc[nt]); }
#pragma unroll
          for (int reg = 0; reg < 4; ++reg) { const int tt = t0 + 4 * g + reg;
#pragma unroll
              for (int nt = 0; nt < 4; ++nt) { LAS bf16* up = Ut + tt * 72 + 16 * nt + l15; *up = (bf16)f2bf(bf2f(*up) * (acc[nt][reg] + bsv[reg])); } } }
        LDS_BARRIER();
        { bf16* yr = Y + (row0 + t) * D + h * HD + 16 * cq;
          *(u32x4*)yr = *(const LAS u32x4*)(Ut + t * 72 + 16 * cq); *(u32x4*)(yr + 8) = *(const LAS u32x4*)(Ut + t * 72 + 16 * cq + 8); }
    }
#undef GM_LOAD
    LDS_BARRIER();
}

struct RwkvW { const float *mu, *w0, *a0, *k_k, *k_a, *r_k, *lnx_w, *lnx_b; const bf16 *WupT, *AupT, *GupT; };
struct RwkvS { bf16 *SG, *SH, *SQ, *SS, *Sg, *SY0; float* Sbsc; };
constexpr int M1_LI = 0;
constexpr int M1_PR = 33792;
constexpr int M1_TL = M1_PR + 36864;
constexpr int M1_SEG = M1_TL + 7 * 9216;
constexpr int M1_GAM = M1_SEG + 2048;
constexpr int M1_D = M1_GAM + 256;
constexpr int M1_T = M1_D + 4096;
constexpr int M1_END = M1_T + 2048;
static_assert(M1_END <= MISC_OFF, "M1 LDS map");
__device__ __forceinline__ float fast_tanh(float x) { const float e = __expf(2.f * x); return 1.f - 2.f * __builtin_amdgcn_rcpf(e + 1.f); }

__device__ __forceinline__ void rwkv_m1_unit(Frame& F, int unit  , const bf16* P, const RwkvW& W, const RwkvS& Sc) {
    const int b = unit >> 6, c = unit & 63, t0 = c * 64; const size_t row0 = (size_t)b * SEQ + t0;
    const int w = F.wave, lane = F.lane, l15 = lane & 15, g = lane >> 4;
    LAS bf16* LI = (LAS bf16*)(F.lds + M1_LI);
    LAS float* Ef = (LAS float*)(F.lds + M1_PR); LAS float* ALf = Ef + 64 * 64;
    LAS bf16* Lab = (LAS bf16*)(F.lds + M1_PR); LAS bf16* Lak = Lab + 64 * 72; LAS bf16* Mrb = Lak + 64 * 72; LAS bf16* Mrk = Mrb + 64 * 72;
    LAS bf16* At = (LAS bf16*)(F.lds + M1_TL); LAS bf16* Bt = At + 64 * 72; LAS bf16* Kt = Bt + 64 * 72; LAS bf16* Rt = Kt + 64 * 72; LAS bf16* Bh = Rt + 64 * 72; LAS bf16* Kh = Bh + 64 * 72; LAS bf16* Vt = Kh + 64 * 72;
    LAS float* SEG = (LAS float*)(F.lds + M1_SEG); LAS float* GAM = (LAS float*)(F.lds + M1_GAM); LAS float* Dd = (LAS float*)(F.lds + M1_D); LAS bf16* Tt = (LAS bf16*)(F.lds + M1_T);
#pragma unroll
    for (int it = 0; it < 4; ++it) { const int item = F.tid + 512 * it, tok = item >> 5, jc = item & 31, j0 = 8 * jc; const size_t row = row0 + tok;
        float cv[8], pv[8]; unpack8(*(const u32x4*)(P + row * INW + 2560 + j0), cv);
        if (t0 + tok > 0) unpack8(*(const u32x4*)(P + (row - 1) * INW + 2560 + j0), pv); else { for (int j = 0; j < 8; ++j) pv[j] = 0.f; }
        const f32x4 m0 = *(const f32x4*)(W.mu + 1536 + j0), m1 = *(const f32x4*)(W.mu + 1536 + j0 + 4); float o[8];
#pragma unroll
        for (int j = 0; j < 8; ++j) { const float x = cv[j] + (pv[j] - cv[j]) * (j < 4 ? m0[j] : m1[j - 4]); o[j] = jc < 8 ? fast_tanh(x) : (jc < 16 ? x : sigmoidf_(x)); }
        *(LAS u32x4*)(LI + tok * 264 + j0) = pack8(o); }
    __syncthreads();
    for (int h = 0; h < NH; ++h) {
        const size_t uh = ((size_t)unit * NH + h) * 4096;
        { const int mt = w & 3, ntb = 2 * (w >> 2); const int chrow = h * HD + 16 * mt + l15;
          f32x4 aw[2] = {{0.f, 0.f, 0.f, 0.f}, {0.f, 0.f, 0.f, 0.f}}, aa[2] = {{0.f, 0.f, 0.f, 0.f}, {0.f, 0.f, 0.f, 0.f}}, ag[2] = {{0.f, 0.f, 0.f, 0.f}, {0.f, 0.f, 0.f, 0.f}};
#pragma unroll
          for (int ks = 0; ks < 2; ++ks) { const bf16x8 fw = *(const bf16x8*)(W.WupT + (size_t)chrow * 64 + 32 * ks + 8 * g), fa = *(const bf16x8*)(W.AupT + (size_t)chrow * 64 + 32 * ks + 8 * g);
#pragma unroll
              for (int q = 0; q < 2; ++q) { aw[q] = MFMA32(fw, lds_row8(LI, 264, 16 * (ntb + q), 32 * ks, lane), aw[q]); aa[q] = MFMA32(fa, lds_row8(LI, 264, 16 * (ntb + q), 64 + 32 * ks, lane), aa[q]); } }
#pragma unroll
          for (int ks = 0; ks < 4; ++ks) { const bf16x8 fg = *(const bf16x8*)(W.GupT + (size_t)chrow * 128 + 32 * ks + 8 * g);
#pragma unroll
              for (int q = 0; q < 2; ++q) ag[q] = MFMA32(fg, lds_row8(LI, 264, 16 * (ntb + q), 128 + 32 * ks, lane), ag[q]); }
          const int ch0 = 16 * mt + 4 * g; const f32x4 w0v = *(const f32x4*)(W.w0 + h * HD + ch0), a0v = *(const f32x4*)(W.a0 + h * HD + ch0);
#pragma unroll
          for (int q = 0; q < 2; ++q) { const int tok = 16 * (ntb + q) + l15; f32x4 ev, av;
#pragma unroll
              for (int r = 0; r < 4; ++r) { const float z = -(aw[q][r] + w0v[r]); const float sp = fmaxf(z, 0.f) + __logf(1.f + __expf(-fabsf(z))); ev[r] = -__expf(-sp - 0.5f); av[r] = sigmoidf_(aa[q][r] + a0v[r]); }
              *(LAS f32x4*)(Ef + tok * 64 + ch0) = ev; *(LAS f32x4*)(ALf + tok * 64 + ch0) = av;
              u32x2 gw; gw.x = cvtpk_c(ag[q][0], ag[q][1]); gw.y = cvtpk_c(ag[q][2], ag[q][3]); *(u32x2*)(Sc.Sg + (row0 + tok) * RWW + h * HD + ch0) = gw; } }
        __syncthreads();
        { const int ch = F.tid & 63, seg = F.tid >> 6; float run = 0.f;
#pragma unroll
          for (int i = 0; i < 8; ++i) { run += Ef[(8 * seg + i) * 64 + ch]; Ef[(8 * seg + i) * 64 + ch] = run; }
          SEG[seg * 64 + ch] = run; }
        __syncthreads();
        { const int ch = F.tid & 63, seg = F.tid >> 6; float off = 0.f;
          for (int s2 = 0; s2 < seg; ++s2) off += SEG[s2 * 64 + ch];
#pragma unroll
          for (int i = 0; i < 8; ++i) Ef[(8 * seg + i) * 64 + ch] += off; }
        __syncthreads();
        { const int tok = F.tid >> 3, cg = F.tid & 7, ch0 = 8 * cg, hc0 = h * HD + ch0; const size_t row = row0 + tok; const bool has_prev = (t0 + tok) > 0;
          float rr[8], kx[8], vv[8], tmp[8], pr[8];
#define SHIFT_LOAD(dst, col) do { unpack8(*(const u32x4*)(P + row * INW + (col)), dst); if (has_prev) unpack8(*(const u32x4*)(P + (row - 1) * INW + (col)), pr); else { for (int j = 0; j < 8; ++j) pr[j] = 0.f; } \
              const f32x4 m0 = *(const f32x4*)(W.mu + (col) - 1024), m1 = *(const f32x4*)(W.mu + (col) - 1024 + 4); for (int j = 0; j < 8; ++j) dst[j] = dst[j] + (pr[j] - dst[j]) * (j < 4 ? m0[j] : m1[j - 4]); } while (0)
          SHIFT_LOAD(rr, 1024 + hc0); SHIFT_LOAD(kx, 1536 + hc0); SHIFT_LOAD(vv, 2048 + hc0);
          (void)tmp;
          float Lt[8], Lm[8], Lc[8], al[8];
#pragma unroll
          for (int j = 0; j < 8; ++j) { Lt[j] = Ef[tok * 64 + ch0 + j]; Lm[j] = tok > 0 ? Ef[(tok - 1) * 64 + ch0 + j] : 0.f; Lc[j] = Ef[63 * 64 + ch0 + j]; al[j] = ALf[tok * 64 + ch0 + j]; }
          float kk[8], km[8]; float ss = 0.f, bs_ = 0.f;
#pragma unroll
          for (int j = 0; j < 8; ++j) { kk[j] = kx[j] * W.k_k[hc0 + j]; ss += kk[j] * kk[j]; km[j] = kx[j] * (1.f + (al[j] - 1.f) * W.k_a[hc0 + j]); bs_ += rr[j] * km[j] * W.r_k[hc0 + j]; }
          ss += __shfl_xor(ss, 1); ss += __shfl_xor(ss, 2); ss += __shfl_xor(ss, 4); bs_ += __shfl_xor(bs_, 1); bs_ += __shfl_xor(bs_, 2); bs_ += __shfl_xor(bs_, 4);
          const float inv = 1.f / fmaxf(sqrtf(ss), 1e-12f);
          if (cg == 0) Sc.Sbsc[row * NH + h] = bs_;
          float oA[8], oB[8], oK[8], oR[8], oBh[8], oKh[8];
#pragma unroll
          for (int j = 0; j < 8; ++j) { const float kn = kk[j] * inv, bb = kn * al[j]; const float einv = __expf(-Lt[j]), ec = __expf(Lc[j] - Lt[j]);
              oA[j] = -kn * __expf(Lm[j]); oB[j] = bb * einv; oK[j] = km[j] * einv; oR[j] = rr[j] * __expf(Lt[j]); oBh[j] = bb * ec; oKh[j] = km[j] * ec; }
          *(LAS u32x4*)(At + tok * 72 + ch0) = pack8(oA); *(LAS u32x4*)(Bt + tok * 72 + ch0) = pack8(oB); *(LAS u32x4*)(Kt + tok * 72 + ch0) = pack8(oK); *(LAS u32x4*)(Rt + tok * 72 + ch0) = pack8(oR);
          *(LAS u32x4*)(Bh + tok * 72 + ch0) = pack8(oBh); *(LAS u32x4*)(Kh + tok * 72 + ch0) = pack8(oKh); *(LAS u32x4*)(Vt + tok * 72 + ch0) = pack8(vv);
          if (tok == 63) { for (int j = 0; j < 8; ++j) GAM[ch0 + j] = __expf(Lc[j]); } }
        __syncthreads();
        for (int i5 = 0; i5 < 5; ++i5) { const int q = w + 8 * i5, mat = q / 10, idx = q % 10; const int ti = idx < 1 ? 0 : (idx < 3 ? 1 : (idx < 6 ? 2 : 3)), si = idx - ti * (ti + 1) / 2;
            const LAS bf16* X = mat < 2 ? At : Rt; const LAS bf16* Yk = (mat & 1) ? Kt : Bt; LAS bf16* O = Lab + mat * 64 * 72;
            f32x4 acc = {0.f, 0.f, 0.f, 0.f};
#pragma unroll
            for (int ks = 0; ks < 2; ++ks) acc = MFMA32(lds_row8(Yk, 72, 16 * si, 32 * ks, lane), lds_row8(X, 72, 16 * ti, 32 * ks, lane), acc);
            const int t = 16 * ti + l15, s0 = 16 * si + 4 * g;
#pragma unroll
            for (int r = 0; r < 4; ++r) { const bool keep = mat < 2 ? (s0 + r < t) : (s0 + r <= t); if (!keep) acc[r] = 0.f; }
            *(LAS s16x4*)(O + t * 72 + s0) = pack4(acc);
            if (mat == 0 && ti == si) *(LAS f32x4*)(Dd + ti * 256 + l15 * 16 + 4 * g) = acc; }
        __syncthreads();
        if (w == 7) { const int i = lane >> 4, cc = lane & 15; const LAS float* Db = Dd + i * 256; float tv[16];
#pragma unroll
            for (int r = 0; r < 16; ++r) { float sum = (r == cc) ? 1.f : 0.f;
#pragma unroll
                for (int s2 = 0; s2 < r; ++s2) sum += Db[r * 16 + s2] * tv[s2];
                tv[r] = sum; }
#pragma unroll
            for (int r = 0; r < 16; ++r) Tt[i * 256 + r * 16 + cc] = (bf16)f2bf(tv[r]); }
        __syncthreads();
        { const bool isU = w < 4; const int cw = w & 3;
          f32x4 X[4];
#pragma unroll
          for (int i = 0; i < 4; ++i) { f32x4 z = {0.f, 0.f, 0.f, 0.f};
              if (isU) {
#pragma unroll
                  for (int j = 0; j <= i; ++j) z = MFMA16(lds_row4(Lak, 72, 16 * i, 16 * j, lane), lds_tr4(Vt, 72, 16 * j, 16 * cw, lane), z);
              } else z = unpack4(lds_tr4(At, 72, 16 * i, 16 * cw, lane));
#pragma unroll
              for (int j = 0; j < i; ++j) z = MFMA16(lds_row4(Lab, 72, 16 * i, 16 * j, lane), pack4(X[j]), z);
              const f32x4 zero = {0.f, 0.f, 0.f, 0.f};
              X[i] = MFMA16(lds_row4(Tt + i * 256, 16, 0, 0, lane), pack4(z), zero); }
          s16x4 Xp[4];
#pragma unroll
          for (int i = 0; i < 4; ++i) Xp[i] = pack4(X[i]);
          if (isU) {
#pragma unroll
              for (int nt = 0; nt < 4; ++nt) { f32x4 acc = {0.f, 0.f, 0.f, 0.f};
#pragma unroll
                  for (int i = 0; i < 4; ++i) { acc = MFMA16(Xp[i], lds_tr4(Bh, 72, 16 * i, 16 * nt, lane), acc); acc = MFMA16(lds_tr4(Vt, 72, 16 * i, 16 * cw, lane), lds_tr4(Kh, 72, 16 * i, 16 * nt, lane), acc); }
                  *(s16x4*)(Sc.SH + uh + (size_t)(16 * nt + l15) * 64 + 16 * cw + 4 * g) = pack4(acc); }
#pragma unroll
              for (int mt = 0; mt < 4; ++mt) { f32x4 acc = {0.f, 0.f, 0.f, 0.f};
#pragma unroll
                  for (int i = 0; i <= mt; ++i) { acc = MFMA16(lds_row4(Mrb, 72, 16 * mt, 16 * i, lane), Xp[i], acc); acc = MFMA16(lds_row4(Mrk, 72, 16 * mt, 16 * i, lane), lds_tr4(Vt, 72, 16 * i, 16 * cw, lane), acc); }
                  *(s16x4*)(Sc.SY0 + uh + (size_t)(16 * cw + l15) * 64 + 16 * mt + 4 * g) = pack4(acc); }
          } else {
              const float gamv = GAM[16 * cw + l15];
#pragma unroll
              for (int nt = 0; nt < 4; ++nt) { f32x4 acc = {0.f, 0.f, 0.f, 0.f};
#pragma unroll
                  for (int i = 0; i < 4; ++i) acc = MFMA16(Xp[i], lds_tr4(Bh, 72, 16 * i, 16 * nt, lane), acc);
                  { const float gam = (nt == cw) ? gamv : 0.f;
#pragma unroll
                      for (int r = 0; r < 4; ++r) acc[r] += (l15 == 4 * g + r) ? gam : 0.f; }
                  *(s16x4*)(Sc.SG + uh + (size_t)(16 * nt + l15) * 64 + 16 * cw + 4 * g) = pack4(acc); }
#pragma unroll
              for (int mt = 0; mt < 4; ++mt) { f32x4 acc = unpack4(lds_tr4(Rt, 72, 16 * mt, 16 * cw, lane));
#pragma unroll
                  for (int i = 0; i <= mt; ++i) acc = MFMA16(lds_row4(Mrb, 72, 16 * mt, 16 * i, lane), Xp[i], acc);
                  *(s16x4*)(Sc.SQ + uh + (size_t)(16 * cw + l15) * 64 + 16 * mt + 4 * g) = pack4(acc); }
          } }
        __syncthreads();
    }
}

constexpr int M1V_LI = 0;
constexpr int M1V_PR = 33792;
constexpr int M1V_TL = M1V_PR + 36864;
constexpr int M1V_SEG = M1V_TL + 5 * 9216;
constexpr int M1V_GAM = M1V_SEG + 2048;
constexpr int M1V_CST = M1V_GAM + 256;
constexpr int M1V_END = M1V_CST + 8 * 2048;
static_assert(M1V_END <= MISC_OFF, "M1 v2 LDS map");
__device__ __forceinline__ void rwkv_m1_consts(Frame& F, const RwkvW& W) {
    LAS float* CST = (LAS float*)(F.lds + M1V_CST);
    for (int i = F.tid; i < 1536; i += 512) CST[i] = W.mu[i];
    CST[3 * 512 + F.tid] = W.k_k[F.tid]; CST[4 * 512 + F.tid] = W.k_a[F.tid]; CST[5 * 512 + F.tid] = W.r_k[F.tid]; CST[6 * 512 + F.tid] = W.w0[F.tid]; CST[7 * 512 + F.tid] = W.a0[F.tid];
    __syncthreads();
}
__device__ __forceinline__ void rwkv_m1v2_unit(Frame& F, int unit  , const bf16* P, const RwkvW& W, const RwkvS& Sc) {
    const int b = unit >> 6, c = unit & 63, t0 = c * 64; const size_t row0 = (size_t)b * SEQ + t0;
    const int w = F.wave, lane = F.lane, l15 = lane & 15, g = lane >> 4;
    LAS bf16* LI = (LAS bf16*)(F.lds + M1V_LI);
    LAS float* Ef = (LAS float*)(F.lds + M1V_PR); constexpr int ES = 68; LAS float* ALf = Ef + 64 * ES;
    LAS bf16* Lab = (LAS bf16*)(F.lds + M1V_PR); LAS bf16* Lak = Lab + 64 * 72; LAS bf16* Mrb = Lak + 64 * 72; LAS bf16* Mrk = Mrb + 64 * 72;
    LAS bf16* At = (LAS bf16*)(F.lds + M1V_TL); LAS bf16* Bt = At + 64 * 72; LAS bf16* Kt = Bt + 64 * 72; LAS bf16* Rt = Kt + 64 * 72; LAS bf16* Vt = Rt + 64 * 72;
    LAS float* SEG = (LAS float*)(F.lds + M1V_SEG); LAS float* GAM = (LAS float*)(F.lds + M1V_GAM); const LAS float* CST = (const LAS float*)(F.lds + M1V_CST);
    bf16x8 wfw[2], wfa[2], wfg[4]; u32x4 pfc[3], pfp[3];
    const int ea_mt = w & 3, ea_ntb = 2 * (w >> 2);
    const int eb_tok = F.tid >> 3, eb_cg = F.tid & 7; const size_t eb_row = row0 + eb_tok; const bool eb_prev = (t0 + eb_tok) > 0;
#define M1_LOAD_W(hh) do { const int chrow_ = (hh) * HD + 16 * ea_mt + l15; \
        wfw[0] = *(const bf16x8*)(W.WupT + (size_t)chrow_ * 64 + 8 * g); wfw[1] = *(const bf16x8*)(W.WupT + (size_t)chrow_ * 64 + 32 + 8 * g); \
        wfa[0] = *(const bf16x8*)(W.AupT + (size_t)chrow_ * 64 + 8 * g); wfa[1] = *(const bf16x8*)(W.AupT + (size_t)chrow_ * 64 + 32 + 8 * g); \
        _Pragma("unroll") for (int ks_ = 0; ks_ < 4; ++ks_) wfg[ks_] = *(const bf16x8*)(W.GupT + (size_t)chrow_ * 128 + 32 * ks_ + 8 * g); } while (0)
#define M1_LOAD_P(hh) do { const int hc_ = (hh) * HD + 8 * eb_cg; \
        _Pragma("unroll") for (int a_ = 0; a_ < 3; ++a_) { pfc[a_] = *(const u32x4*)(P + eb_row * INW + 1024 + 512 * a_ + hc_); \
            if (eb_prev) pfp[a_] = *(const u32x4*)(P + (eb_row - 1) * INW + 1024 + 512 * a_ + hc_); else pfp[a_] = (u32x4){0u, 0u, 0u, 0u}; } } while (0)
#pragma unroll
    for (int it = 0; it < 4; ++it) { const int item = F.tid + 512 * it, tok = item >> 5, jc = item & 31, j0 = 8 * jc; const size_t row = row0 + tok;
        float cv[8], pv[8]; unpack8(*(const u32x4*)(P + row * INW + 2560 + j0), cv);
        if (t0 + tok > 0) unpack8(*(const u32x4*)(P + (row - 1) * INW + 2560 + j0), pv); else { for (int j = 0; j < 8; ++j) pv[j] = 0.f; }
        const f32x4 m0 = *(const f32x4*)(W.mu + 1536 + j0), m1 = *(const f32x4*)(W.mu + 1536 + j0 + 4); float o[8];
#pragma unroll
        for (int j = 0; j < 8; ++j) { const float x = cv[j] + (pv[j] - cv[j]) * (j < 4 ? m0[j] : m1[j - 4]); o[j] = jc < 8 ? fast_tanh(x) : (jc < 16 ? x : sigmoidf_(x)); }
        *(LAS u32x4*)(LI + tok * 264 + j0) = pack8(o); }
    LDS_BARRIER();
    M1_LOAD_W(((int)blockIdx.x) & (NH - 1));
    const int rp_ea = (PROBE_STAGE == 1) ? 2 - (F.G > 100000) : 1, rp_eb = (PROBE_STAGE == 2) ? 2 - (F.G > 100000) : 1, rp_p1 = (PROBE_STAGE == 3) ? 2 - (F.G > 100000) : 1, rp_ch = (PROBE_STAGE == 4) ? 2 - (F.G > 100000) : 1, rp_cs = (PROBE_STAGE == 5) ? 2 - (F.G > 100000) : 1;
    for (int hi_ = 0; hi_ < NH; ++hi_) { const int h = (hi_ + (int)blockIdx.x) & (NH - 1);
        const size_t uh = ((size_t)unit * NH + h) * 4096;
        for (int rp = 0; rp < rp_ea; ++rp) {
          f32x4 aw[2] = {{0.f, 0.f, 0.f, 0.f}, {0.f, 0.f, 0.f, 0.f}}, aa[2] = {{0.f, 0.f, 0.f, 0.f}, {0.f, 0.f, 0.f, 0.f}}, ag[2] = {{0.f, 0.f, 0.f, 0.f}, {0.f, 0.f, 0.f, 0.f}};
#pragma unroll
          for (int q = 0; q < 2; ++q) { bf16x8 lf[8];
#pragma unroll
              for (int ks = 0; ks < 8; ++ks) lf[ks] = lds_row8(LI, 264, 16 * (ea_ntb + q), 32 * ks, lane);
#pragma unroll
              for (int ks = 0; ks < 2; ++ks) { aw[q] = MFMA32(wfw[ks], lf[ks], aw[q]); aa[q] = MFMA32(wfa[ks], lf[2 + ks], aa[q]); }
#pragma unroll
              for (int ks = 0; ks < 4; ++ks) ag[q] = MFMA32(wfg[ks], lf[4 + ks], ag[q]); }
          const int ch0 = 16 * ea_mt + 4 * g; const f32x4 w0v = *(const LAS f32x4*)(CST + 6 * 512 + h * HD + ch0), a0v = *(const LAS f32x4*)(CST + 7 * 512 + h * HD + ch0);
#pragma unroll
          for (int q = 0; q < 2; ++q) { const int tok = 16 * (ea_ntb + q) + l15; f32x4 ev, av;
#pragma unroll
              for (int r = 0; r < 4; ++r) { ev[r] = -0.60653066f * __builtin_amdgcn_rcpf(1.f + __expf(-(aw[q][r] + w0v[r]))); av[r] = __builtin_amdgcn_rcpf(1.f + __expf(-(aa[q][r] + a0v[r]))); }
              *(LAS f32x4*)(Ef + tok * ES + ch0) = ev; *(LAS f32x4*)(ALf + tok * ES + ch0) = av;
              u32x2 gw; gw.x = cvtpk_c(ag[q][0], ag[q][1]); gw.y = cvtpk_c(ag[q][2], ag[q][3]); *(u32x2*)(Sc.Sg + (row0 + tok) * RWW + h * HD + ch0) = gw; } }
        LDS_BARRIER();
        for (int rp = 0; rp < rp_cs; ++rp) {
        float csv[8];
        { const int ch = F.tid & 63, seg = F.tid >> 6;
#pragma unroll
          for (int i = 0; i < 8; ++i) csv[i] = Ef[(8 * seg + i) * ES + ch];
#pragma unroll
          for (int i = 1; i < 8; ++i) csv[i] += csv[i - 1];
          SEG[seg * 64 + ch] = csv[7]; }
        LDS_BARRIER();
        { const int ch = F.tid & 63, seg = F.tid >> 6; float sg[8];
#pragma unroll
          for (int s2 = 0; s2 < 7; ++s2) sg[s2] = SEG[s2 * 64 + ch];
          float off = 0.f;
#pragma unroll
          for (int s2 = 0; s2 < 7; ++s2) off += (s2 < seg) ? sg[s2] : 0.f;
#pragma unroll
          for (int i = 0; i < 8; ++i) Ef[(8 * seg + i) * ES + ch] = csv[i] + off; }
        LDS_BARRIER();
        }
        for (int rp = 0; rp < rp_eb; ++rp) { const int tok = eb_tok, ch0 = 8 * eb_cg, hc0 = h * HD + ch0;
          float rr[8], kx[8], vv[8], pr[8];
#define M1_SHIFT(dst, a_) do { unpack8(pfc[a_], dst); unpack8(pfp[a_], pr); const f32x4 m0 = *(const LAS f32x4*)(CST + (a_) * 512 + hc0), m1 = *(const LAS f32x4*)(CST + (a_) * 512 + hc0 + 4); \
              _Pragma("unroll") for (int j = 0; j < 8; ++j) dst[j] = dst[j] + (pr[j] - dst[j]) * (j < 4 ? m0[j] : m1[j - 4]); } while (0)
          M1_LOAD_P(h); M1_SHIFT(rr, 0); M1_SHIFT(kx, 1); M1_SHIFT(vv, 2);
          float Lt[8], Lm[8], al[8], ckk[8], cka[8], crk[8];
#pragma unroll
          for (int j = 0; j < 8; ++j) { Lt[j] = Ef[tok * ES + ch0 + j]; Lm[j] = tok > 0 ? Ef[(tok - 1) * ES + ch0 + j] : 0.f; al[j] = ALf[tok * ES + ch0 + j]; ckk[j] = CST[3 * 512 + hc0 + j]; cka[j] = CST[4 * 512 + hc0 + j]; crk[j] = CST[5 * 512 + hc0 + j]; }
          float kk[8], km[8]; float ss = 0.f, bs_ = 0.f;
#pragma unroll
          for (int j = 0; j < 8; ++j) { kk[j] = kx[j] * ckk[j]; ss += kk[j] * kk[j]; km[j] = kx[j] * (1.f + (al[j] - 1.f) * cka[j]); bs_ += rr[j] * km[j] * crk[j]; }
          ss += __shfl_xor(ss, 1); ss += __shfl_xor(ss, 2); ss += __shfl_xor(ss, 4); bs_ += __shfl_xor(bs_, 1); bs_ += __shfl_xor(bs_, 2); bs_ += __shfl_xor(bs_, 4);
          const float inv = 1.f / fmaxf(sqrtf(ss), 1e-12f);
          if (eb_cg == 0) Sc.Sbsc[eb_row * NH + h] = bs_;
          float oA[8], oB[8], oK[8], oR[8];
#pragma unroll
          for (int j = 0; j < 8; ++j) { const float kn = kk[j] * inv, bb = kn * al[j]; const float eL = __expf(Lt[j]), einv = __builtin_amdgcn_rcpf(eL);
              oA[j] = -kn * __expf(Lm[j]); oB[j] = bb * einv; oK[j] = km[j] * einv; oR[j] = rr[j] * eL; if (tok == 63) GAM[ch0 + j] = eL; }
          *(LAS u32x4*)(At + tok * 72 + ch0) = pack8(oA); *(LAS u32x4*)(Bt + tok * 72 + ch0) = pack8(oB); *(LAS u32x4*)(Kt + tok * 72 + ch0) = pack8(oK); *(LAS u32x4*)(Rt + tok * 72 + ch0) = pack8(oR);
          *(LAS u32x4*)(Vt + tok * 72 + ch0) = pack8(vv); }
        { const int hn_ = ((hi_ + 1 < NH ? hi_ + 1 : hi_) + (int)blockIdx.x) & (NH - 1); M1_LOAD_W(hn_); }
        LDS_BARRIER();
        for (int rp = 0; rp < rp_p1; ++rp) for (int i5 = 0; i5 < 5; ++i5) { const int q = w + 8 * i5, mat = q / 10, idx = q % 10; const int ti = idx < 1 ? 0 : (idx < 3 ? 1 : (idx < 6 ? 2 : 3)), si = idx - ti * (ti + 1) / 2;
            const LAS bf16* X = mat < 2 ? At : Rt; const LAS bf16* Yk = (mat & 1) ? Kt : Bt; LAS bf16* O = Lab + mat * 64 * 72;
            f32x4 acc = {0.f, 0.f, 0.f, 0.f};
#pragma unroll
            for (int ks = 0; ks < 2; ++ks) acc = MFMA32(lds_row8(Yk, 72, 16 * si, 32 * ks, lane), lds_row8(X, 72, 16 * ti, 32 * ks, lane), acc);
            const int t = 16 * ti + l15, s0 = 16 * si + 4 * g; const int lim = mat < 2 ? t : t + 1;
#pragma unroll
            for (int r = 0; r < 4; ++r) acc[r] = (s0 + r < lim) ? acc[r] : 0.f;
            *(LAS s16x4*)(O + t * 72 + s0) = pack4(acc); }
        LDS_BARRIER();
        for (int rp = 0; rp < rp_ch; ++rp) { const bool isU = w < 4; const int cw = w & 3; const f32x4 zero = {0.f, 0.f, 0.f, 0.f};
          s16x4 TTp[4];
#pragma unroll
          for (int hb = 0; hb < 2; ++hb) { s16x4 fr[2], ft[2];
#pragma unroll
            for (int i = 0; i < 2; ++i) { fr[i] = lds_row4(Lab, 72, 16 * (2 * hb + i), 16 * (2 * hb + i), lane); ft[i] = lds_tr4(Lab, 72, 16 * (2 * hb + i), 16 * (2 * hb + i), lane); }
            f32x4 L2[2], L2T[2], L4[2], L4T[2], L8[2], TT[2]; s16x4 pL2[2], pL2T[2], pL4[2], pL4T[2];
#pragma unroll
            for (int i = 0; i < 2; ++i) { L2[i] = MFMA16(fr[i], ft[i], zero); L2T[i] = MFMA16(ft[i], fr[i], zero); }
#pragma unroll
            for (int i = 0; i < 2; ++i) { pL2[i] = pack4(L2[i]); pL2T[i] = pack4(L2T[i]); TT[i] = unpack4(fr[i]);
#pragma unroll
                for (int r = 0; r < 4; ++r) TT[i][r] += (l15 == 4 * g + r) ? 1.f : 0.f; }
#pragma unroll
            for (int i = 0; i < 2; ++i) { L4[i] = MFMA16(pL2T[i], pL2[i], zero); L4T[i] = MFMA16(pL2[i], pL2T[i], zero); TT[i] = MFMA16(pL2[i], pack4(TT[i]), TT[i]); }
#pragma unroll
            for (int i = 0; i < 2; ++i) { pL4[i] = pack4(L4[i]); pL4T[i] = pack4(L4T[i]); }
#pragma unroll
            for (int i = 0; i < 2; ++i) { L8[i] = MFMA16(pL4T[i], pL4[i], zero); TT[i] = MFMA16(pL4[i], pack4(TT[i]), TT[i]); }
#pragma unroll
            for (int i = 0; i < 2; ++i) { TT[i] = MFMA16(pack4(L8[i]), pack4(TT[i]), TT[i]); TTp[2 * hb + i] = pack4(TT[i]); } }
          s16x4 Vf[4]; f32x4 z[4];
          if (isU) { s16x4 lk[10];
#pragma unroll
              for (int j = 0; j < 4; ++j) Vf[j] = lds_tr4(Vt, 72, 16 * j, 16 * cw, lane);
#pragma unroll
              for (int i = 0; i < 4; ++i)
#pragma unroll
                  for (int j = 0; j <= i; ++j) lk[i * (i + 1) / 2 + j] = lds_row4(Lak, 72, 16 * i, 16 * j, lane);
#pragma unroll
              for (int i = 0; i < 4; ++i) { z[i] = zero;
#pragma unroll
                  for (int j = 0; j <= i; ++j) z[i] = MFMA16(lk[i * (i + 1) / 2 + j], Vf[j], z[i]); }
          } else {
#pragma unroll
              for (int i = 0; i < 4; ++i) { Vf[i] = (s16x4){0, 0, 0, 0}; z[i] = unpack4(lds_tr4(At, 72, 16 * i, 16 * cw, lane)); } }
          s16x4 Xp[4];
          { s16x4 lb[6];
#pragma unroll
            for (int i = 1; i < 4; ++i)
#pragma unroll
                for (int j = 0; j < i; ++j) lb[i * (i - 1) / 2 + j] = lds_row4(Lab, 72, 16 * i, 16 * j, lane);
#pragma unroll
            for (int i = 0; i < 4; ++i) { f32x4 zz = z[i];
#pragma unroll
                for (int j = 0; j < i; ++j) zz = MFMA16(lb[i * (i - 1) / 2 + j], Xp[j], zz);
                Xp[i] = pack4(MFMA16(TTp[i], pack4(zz), zero)); } }
          if (isU) {
#pragma unroll
              for (int nt = 0; nt < 4; ++nt) { s16x4 bf_[4], kf_[4];
#pragma unroll
                  for (int i = 0; i < 4; ++i) { bf_[i] = lds_tr4(Bt, 72, 16 * i, 16 * nt, lane); kf_[i] = lds_tr4(Kt, 72, 16 * i, 16 * nt, lane); }
                  f32x4 a1 = zero, a2 = zero;
#pragma unroll
                  for (int i = 0; i < 4; ++i) { a1 = MFMA16(Xp[i], bf_[i], a1); a2 = MFMA16(Vf[i], kf_[i], a2); }
                  const float gm = GAM[16 * nt + l15]; const f32x4 acc = (a1 + a2) * gm;
                  *(s16x4*)(Sc.SH + uh + (size_t)(16 * nt + l15) * 64 + 16 * cw + 4 * g) = pack4(acc); }
#pragma unroll
              for (int mt = 0; mt < 4; ++mt) { s16x4 mb[4], mk[4];
#pragma unroll
                  for (int i = 0; i <= mt; ++i) { mb[i] = lds_row4(Mrb, 72, 16 * mt, 16 * i, lane); mk[i] = lds_row4(Mrk, 72, 16 * mt, 16 * i, lane); }
                  f32x4 a1 = zero, a2 = zero;
#pragma unroll
                  for (int i = 0; i <= mt; ++i) { a1 = MFMA16(mb[i], Xp[i], a1); a2 = MFMA16(mk[i], Vf[i], a2); }
                  *(s16x4*)(Sc.SY0 + uh + (size_t)(16 * cw + l15) * 64 + 16 * mt + 4 * g) = pack4(a1 + a2); }
          } else {
#pragma unroll
              for (int nt = 0; nt < 4; ++nt) { s16x4 bf_[4];
#pragma unroll
                  for (int i = 0; i < 4; ++i) bf_[i] = lds_tr4(Bt, 72, 16 * i, 16 * nt, lane);
                  f32x4 a1 = zero, a2 = zero;
                  a1 = MFMA16(Xp[0], bf_[0], a1); a2 = MFMA16(Xp[1], bf_[1], a2); a1 = MFMA16(Xp[2], bf_[2], a1); a2 = MFMA16(Xp[3], bf_[3], a2);
                  f32x4 acc = a1 + a2; const float gm = GAM[16 * nt + l15]; const float dg = (nt == cw) ? 1.f : 0.f;
#pragma unroll
                  for (int r = 0; r < 4; ++r) acc[r] = (acc[r] + ((l15 == 4 * g + r) ? dg : 0.f)) * gm;
                  *(s16x4*)(Sc.SG + uh + (size_t)(16 * nt + l15) * 64 + 16 * cw + 4 * g) = pack4(acc); }
#pragma unroll
              for (int mt = 0; mt < 4; ++mt) { s16x4 mb[4]; const s16x4 rf = lds_tr4(Rt, 72, 16 * mt, 16 * cw, lane);
#pragma unroll
                  for (int i = 0; i <= mt; ++i) mb[i] = lds_row4(Mrb, 72, 16 * mt, 16 * i, lane);
                  f32x4 acc = unpack4(rf);
#pragma unroll
                  for (int i = 0; i <= mt; ++i) acc = MFMA16(mb[i], Xp[i], acc);
                  *(s16x4*)(Sc.SQ + uh + (size_t)(16 * cw + l15) * 64 + 16 * mt + 4 * g) = pack4(acc); }
          } }
        LDS_BARRIER();
    }
#undef M1_LOAD_W
#undef M1_LOAD_P
#undef M1_SHIFT
}

constexpr int M2_S = 0;
__device__ __forceinline__ void rwkv_m2_unit(Frame& F, int unit  , const RwkvS& Sc) {
    const int b = unit >> 3, h = unit & 7; const int w = F.wave, lane = F.lane, l15 = lane & 15, g = lane >> 4; const int mt = w >> 1, ntb = 2 * (w & 1);
    LAS bf16* Sb = (LAS bf16*)(F.lds + M2_S);
    f32x4 acc[2] = {{0.f, 0.f, 0.f, 0.f}, {0.f, 0.f, 0.f, 0.f}};
    constexpr int PF = 8;
    bf16x8 Gf[PF][2][2]; u32x2 Hf[PF][2];
#define M2_LOAD(slot, cc) do { const size_t uh_ = ((size_t)(b * 64 + (cc)) * NH + h) * 4096; _Pragma("unroll") for (int q = 0; q < 2; ++q) { const size_t ro = uh_ + (size_t)(16 * (ntb + q) + l15) * 64; \
        Gf[slot][q][0] = *(const bf16x8*)(Sc.SG + ro + 8 * g); Gf[slot][q][1] = *(const bf16x8*)(Sc.SG + ro + 32 + 8 * g); Hf[slot][q] = *(const u32x2*)(Sc.SH + ro + 16 * mt + 4 * g); } } while (0)
#pragma unroll
    for (int u = 0; u < PF; ++u) M2_LOAD(u, u);
    for (int c0 = 0; c0 < 64; c0 += PF) {
#pragma unroll
        for (int u = 0; u < PF; ++u) { const int c = c0 + u;
            const size_t uh = ((size_t)(b * 64 + c) * NH + h) * 4096; LAS bf16* buf = Sb + (u & 1) * 64 * 72;
#pragma unroll
            for (int q = 0; q < 2; ++q) { const s16x4 p = pack4(acc[q]); *(LAS s16x4*)(buf + (16 * (ntb + q) + l15) * 72 + 16 * mt + 4 * g) = p; *(s16x4*)(Sc.SS + uh + (size_t)(16 * (ntb + q) + l15) * 64 + 16 * mt + 4 * g) = p; }
            LDS_BARRIER();
            const bf16x8 a0 = lds_tr8(buf, 72, 0, 16 * mt, lane), a1 = lds_tr8(buf, 72, 32, 16 * mt, lane);
#pragma unroll
            for (int q = 0; q < 2; ++q) { f32x4 z; z[0] = __builtin_bit_cast(float, Hf[u][q].x << 16); z[1] = __builtin_bit_cast(float, Hf[u][q].x & 0xffff0000u); z[2] = __builtin_bit_cast(float, Hf[u][q].y << 16); z[3] = __builtin_bit_cast(float, Hf[u][q].y & 0xffff0000u);
                z = MFMA32(a0, Gf[u][q][0], z); acc[q] = MFMA32(a1, Gf[u][q][1], z); }
            { const int cn = c + PF < 64 ? c + PF : 63; M2_LOAD(u, cn); } }
    }
#undef M2_LOAD
    LDS_BARRIER();
}

constexpr int M3_SLOT = 9216 * 2 + 64 * 68 * 4;
__device__ __forceinline__ void rwkv_m3_unit(Frame& F, int unit  , const bf16* P, bf16* Y, const RwkvW& W, const RwkvS& Sc) {
    const int b = unit >> 6, c = unit & 63, t0 = c * 64; const size_t row0 = (size_t)b * SEQ + t0;
    const int w = F.wave, lane = F.lane, l15 = lane & 15, g = lane >> 4, hw = w >> 2, mt = w & 3, tl = F.tid & 255;
    LAS bf16* Qt = (LAS bf16*)(F.lds + hw * M3_SLOT); LAS bf16* St = Qt + 64 * 72; LAS float* Out = (LAS float*)(F.lds + hw * M3_SLOT + 2 * 9216);
    for (int hp = 0; hp < 4; ++hp) { const int h = 2 * hp + hw; const size_t uh = ((size_t)unit * NH + h) * 4096;
#pragma unroll
        for (int r = 0; r < 2; ++r) { const int off = 8 * (tl + 256 * r), rr = off >> 6, cc = off & 63;
            *(LAS u32x4*)(Qt + rr * 72 + cc) = *(const u32x4*)(Sc.SQ + uh + off); *(LAS u32x4*)(St + rr * 72 + cc) = *(const u32x4*)(Sc.SS + uh + off); }
        LDS_BARRIER();
        f32x4 acc[4];
#pragma unroll
        for (int nt = 0; nt < 4; ++nt) acc[nt] = unpack4(*(const s16x4*)(Sc.SY0 + uh + (size_t)(16 * nt + l15) * 64 + 16 * mt + 4 * g));
#pragma unroll
        for (int ks = 0; ks < 2; ++ks) { const bf16x8 a = lds_tr8(Qt, 72, 32 * ks, 16 * mt, lane);
#pragma unroll
            for (int nt = 0; nt < 4; ++nt) acc[nt] = MFMA32(a, lds_tr8(St, 72, 32 * ks, 16 * nt, lane), acc[nt]); }
#pragma unroll
        for (int r = 0; r < 4; ++r) { float s = (acc[0][r] + acc[1][r]) + (acc[2][r] + acc[3][r]);
            s += __shfl_xor(s, 1); s += __shfl_xor(s, 2); s += __shfl_xor(s, 4); s += __shfl_xor(s, 8); const float mean = s * (1.f / HD); float q = 0.f;
#pragma unroll
            for (int nt = 0; nt < 4; ++nt) { const float d = acc[nt][r] - mean; q += d * d; }
            q += __shfl_xor(q, 1); q += __shfl_xor(q, 2); q += __shfl_xor(q, 4); q += __shfl_xor(q, 8); const float rstd = __builtin_amdgcn_rsqf(q * (1.f / HD) + GN_EPS);
#pragma unroll
            for (int nt = 0; nt < 4; ++nt) { const int v = 16 * nt + l15; Out[(16 * mt + 4 * g + r) * 68 + v] = (acc[nt][r] - mean) * rstd * W.lnx_w[h * HD + v] + W.lnx_b[h * HD + v]; } }
        LDS_BARRIER();
        { const int t = tl >> 2, cq = tl & 3, v0 = 16 * cq, hv0 = h * HD + v0; const size_t row = row0 + t; const bool has_prev = (t0 + t) > 0; const float bsc = Sc.Sbsc[row * NH + h];
#pragma unroll
          for (int half = 0; half < 2; ++half) { float cv[8], pv[8], gv[8], o[8]; const int col = 2048 + hv0 + 8 * half;
              unpack8(*(const u32x4*)(P + row * INW + col), cv); if (has_prev) unpack8(*(const u32x4*)(P + (row - 1) * INW + col), pv); else { for (int j = 0; j < 8; ++j) pv[j] = 0.f; }
              unpack8(*(const u32x4*)(Sc.Sg + row * RWW + hv0 + 8 * half), gv);
              const f32x4 m0 = *(const f32x4*)(W.mu + col - 1024), m1 = *(const f32x4*)(W.mu + col - 1024 + 4);
#pragma unroll
              for (int j = 0; j < 8; ++j) { const float vs = cv[j] + (pv[j] - cv[j]) * (j < 4 ? m0[j] : m1[j - 4]); o[j] = (Out[t * 68 + v0 + 8 * half + j] + bsc * vs) * gv[j]; }
              *(u32x4*)(Y + row * D + GMW + hv0 + 8 * half) = pack8(o); } }
        LDS_BARRIER();
    }
}


__device__ __forceinline__ void rwkv_m3_units(Frame& F, int u0, int ustep, int nunits, const bf16* P, bf16* Y, const RwkvW& W, const RwkvS& Sc) {
    if (u0 >= nunits) return;
    const int w = F.wave, lane = F.lane, l15 = lane & 15, g = lane >> 4, hw = w >> 2, mt = w & 3, tl = F.tid & 255;
    LAS bf16* Qt = (LAS bf16*)(F.lds + hw * M3_SLOT); LAS bf16* St = Qt + 64 * 72; LAS float* Out = (LAS float*)(F.lds + hw * M3_SLOT + 2 * 9216);
    const int nu = (nunits - u0 + ustep - 1) / ustep, niter = nu * 4;
    LAS float* TB = (LAS float*)(F.lds + 73728);
    TB[F.tid] = W.lnx_w[F.tid]; TB[512 + F.tid] = W.lnx_b[F.tid]; TB[1024 + F.tid] = W.mu[1024 + F.tid];
    u32x4 qf[2], sf[2]; s16x4 y0f[4];
#define M3_PREF(itn) do { const int un_ = u0 + ((itn) >> 2) * ustep, hn_ = 2 * ((itn) & 3) + hw; const size_t uhn_ = ((size_t)un_ * NH + hn_) * 4096; \
        _Pragma("unroll") for (int r = 0; r < 2; ++r) { qf[r] = *(const u32x4*)(Sc.SQ + uhn_ + 8 * (tl + 256 * r)); sf[r] = *(const u32x4*)(Sc.SS + uhn_ + 8 * (tl + 256 * r)); } \
        _Pragma("unroll") for (int nt = 0; nt < 4; ++nt) y0f[nt] = *(const s16x4*)(Sc.SY0 + uhn_ + (size_t)(16 * nt + l15) * 64 + 16 * mt + 4 * g); } while (0)
    M3_PREF(0);
    for (int it = 0; it < niter; ++it) {
        const int unit = u0 + (it >> 2) * ustep, h = 2 * (it & 3) + hw; const int b = unit >> 6, c = unit & 63, t0 = c * 64; const size_t row0 = (size_t)b * SEQ + t0;
#pragma unroll
        for (int r = 0; r < 2; ++r) { const int off = 8 * (tl + 256 * r), rr = off >> 6, cc = off & 63; *(LAS u32x4*)(Qt + rr * 72 + cc) = qf[r]; *(LAS u32x4*)(St + rr * 72 + cc) = sf[r]; }
        f32x4 acc[4];
#pragma unroll
        for (int nt = 0; nt < 4; ++nt) acc[nt] = unpack4(y0f[nt]);
        const int t = tl >> 2, cq = tl & 3, v0 = 16 * cq, hv0 = h * HD + v0; const size_t row = row0 + t; const bool has_prev = (t0 + t) > 0;
        u32x4 cvr[2], pvr[2], gvr[2]; const float bsc = Sc.Sbsc[row * NH + h];
#pragma unroll
        for (int half = 0; half < 2; ++half) { const int col = 2048 + hv0 + 8 * half; cvr[half] = *(const u32x4*)(P + row * INW + col);
            pvr[half] = *(const u32x4*)(P + (has_prev ? row - 1 : row) * INW + col); gvr[half] = *(const u32x4*)(Sc.Sg + row * RWW + hv0 + 8 * half); }
        { const int itn = it + 1 < niter ? it + 1 : it; M3_PREF(itn); }
        LDS_BARRIER();
#pragma unroll
        for (int ks = 0; ks < 2; ++ks) { const bf16x8 a = lds_tr8(Qt, 72, 32 * ks, 16 * mt, lane);
#pragma unroll
            for (int nt = 0; nt < 4; ++nt) acc[nt] = MFMA32(a, lds_tr8(St, 72, 32 * ks, 16 * nt, lane), acc[nt]); }
#pragma unroll
        for (int r = 0; r < 4; ++r) { float s2 = (acc[0][r] + acc[1][r]) + (acc[2][r] + acc[3][r]);
            s2 += __shfl_xor(s2, 1); s2 += __shfl_xor(s2, 2); s2 += __shfl_xor(s2, 4); s2 += __shfl_xor(s2, 8); const float mean = s2 * (1.f / HD); float q = 0.f;
#pragma unroll
            for (int nt = 0; nt < 4; ++nt) { const float d = acc[nt][r] - mean; q += d * d; }
            q += __shfl_xor(q, 1); q += __shfl_xor(q, 2); q += __shfl_xor(q, 4); q += __shfl_xor(q, 8); const float rstd = __builtin_amdgcn_rsqf(q * (1.f / HD) + GN_EPS);
#pragma unroll
            for (int nt = 0; nt < 4; ++nt) { const int v = 16 * nt + l15; Out[(16 * mt + 4 * g + r) * 68 + v] = (acc[nt][r] - mean) * rstd * TB[h * HD + v] + TB[512 + h * HD + v]; } }
        LDS_BARRIER();
#pragma unroll
        for (int half = 0; half < 2; ++half) { float cv[8], pv[8], gv[8], o[8];
            unpack8(cvr[half], cv); unpack8(pvr[half], pv); unpack8(gvr[half], gv);
            const f32x4 m0 = *(const LAS f32x4*)(TB + 1024 + hv0 + 8 * half), m1 = *(const LAS f32x4*)(TB + 1024 + hv0 + 8 * half + 4);
#pragma unroll
            for (int j = 0; j < 8; ++j) { const float pvj = has_prev ? pv[j] : 0.f; const float vs = cv[j] + (pvj - cv[j]) * (j < 4 ? m0[j] : m1[j - 4]); o[j] = (Out[t * 68 + v0 + 8 * half + j] + bsc * vs) * gv[j]; }
            *(u32x4*)(Y + row * D + GMW + hv0 + 8 * half) = pack8(o); }
    }
#undef M3_PREF
    LDS_BARRIER();
}

__device__ __forceinline__ void rwkv_apply_naive(Frame& F, int unit, const bf16* P, bf16* Y, const RwkvW& W, const RwkvS& Sc) {
    const int b = unit >> 3, h = unit & 7;
    LAS float* S = (LAS float*)F.lds; LAS float* Gs = S + 64 * 65; LAS float* Hs = Gs + 64 * 65; LAS float* Qs = Hs + 64 * 65; LAS float* Ys = Qs + 64 * 65; LAS float* Sn = Ys + 64 * 65;
    for (int i = F.tid; i < 64 * 65; i += 512) S[i] = 0.f;
    __syncthreads();
    for (int c = 0; c < 64; ++c) { const size_t uh = ((size_t)(b * 64 + c) * NH + h) * 4096; const size_t row0 = (size_t)b * SEQ + c * 64;
        for (int i = F.tid; i < 4096; i += 512) { const int r = i >> 6, cc = i & 63;
            Gs[cc * 65 + r] = bf2f(Sc.SG[uh + i]);
            Hs[cc * 65 + r] = bf2f(Sc.SH[uh + i]);
            Qs[cc * 65 + r] = bf2f(Sc.SQ[uh + i]);
            Ys[cc * 65 + r] = bf2f(Sc.SY0[uh + i]); }
        __syncthreads();
        for (int i = F.tid; i < 4096; i += 512) { const int t = i >> 6, v = i & 63; float a = Ys[t * 65 + v];
            if (DBG_VAR != 1) for (int k = 0; k < 64; ++k) a += Qs[t * 65 + k] * S[v * 65 + k];
            if (DBG_VAR == 2) a = 0.f;
            Ys[t * 65 + v] = a; }
        for (int i = F.tid; i < 4096; i += 512) { const int v = i >> 6, k2 = i & 63; float a = Hs[v * 65 + k2];
            if (DBG_VAR == 6) a += S[v * 65 + k2] * Gs[k2 * 65 + k2]; else if (DBG_VAR != 3) for (int k = 0; k < 64; ++k) a += S[v * 65 + k] * Gs[k * 65 + k2];
            if (DBG_VAR == 7) a = Hs[v * 65 + k2] + 0.5f * (a - Hs[v * 65 + k2]);
            Sn[v * 65 + k2] = a; }
        __syncthreads();
        for (int i = F.tid; i < 4096; i += 512) { const int v = i >> 6, k2 = i & 63; S[v * 65 + k2] = Sn[v * 65 + k2]; }
        { const int t = F.tid >> 3, cg = F.tid & 7, v0 = 8 * cg, hv0 = h * HD + v0; const size_t row = row0 + t; const bool has_prev = (c * 64 + t) > 0; const float bsc = Sc.Sbsc[row * NH + h];
          float yv[8]; float sm = 0.f;
          for (int j = 0; j < 8; ++j) { yv[j] = Ys[t * 65 + v0 + j]; sm += yv[j]; }
          sm += __shfl_xor(sm, 1); sm += __shfl_xor(sm, 2); sm += __shfl_xor(sm, 4); const float mean = sm * (1.f / HD); float q = 0.f;
          for (int j = 0; j < 8; ++j) { yv[j] -= mean; q += yv[j] * yv[j]; }
          q += __shfl_xor(q, 1); q += __shfl_xor(q, 2); q += __shfl_xor(q, 4); const float rstd = __builtin_amdgcn_rsqf(q * (1.f / HD) + GN_EPS);
          float cv[8], pv[8], gv[8], o[8]; const int col = 2048 + hv0;
          unpack8(*(const u32x4*)(P + row * INW + col), cv); if (has_prev) unpack8(*(const u32x4*)(P + (row - 1) * INW + col), pv); else { for (int j = 0; j < 8; ++j) pv[j] = 0.f; }
          unpack8(*(const u32x4*)(Sc.Sg + row * RWW + hv0), gv);
          for (int j = 0; j < 8; ++j) { const float vs = cv[j] + (pv[j] - cv[j]) * W.mu[col - 1024 + j]; o[j] = (yv[j] * rstd * W.lnx_w[hv0 + j] + W.lnx_b[hv0 + j] + bsc * vs) * gv[j]; }
          *(u32x4*)(Y + row * D + GMW + hv0) = pack8(o); }
        __syncthreads();
    }
}

enum Phase { PH_PRO = 0, PH_G1_0, PH_M1_0, PH_M2_0, PH_M3_0, PH_G2_0, PH_G3_0, PH_G4_0, PH_G1_1, PH_M1_1, PH_M2_1, PH_M3_1, PH_G2_1, PH_CV, PH_R2, PH_GU_A, PH_DN_A, PH_GU_B, PH_DN_B, PH_FIN, PH_COUNT };

__global__ void __launch_bounds__(512, 2) fwd(Args args) {
    extern __shared__ __attribute__((aligned(16))) unsigned char lds_raw[];
    Frame F;
    F.lds = (LAS unsigned char*)lds_raw;
    F.tid = threadIdx.x; F.lane = F.tid & 63; F.wave = __builtin_amdgcn_readfirstlane(F.tid >> 6);
    F.G = gridDim.x; F.gw = blockIdx.x * 8 + F.wave; F.NGW = F.G * 8;
    unsigned char* ws = args.ws;
    gu32* ctl = (gu32*)(ws + WS_CTL);
    volatile LAS unsigned* MISC = (volatile LAS unsigned*)(F.lds + MISC_OFF);
    if (F.tid < 32) ((LAS unsigned*)(F.lds + MISC_OFF))[F.tid] = 0u;
    __syncthreads();
    XcdBarrier bar; bar.bar = (unsigned*)(ctl + CW_BAR); bar.x = 0; bar.st = nullptr;
#if !MK_PER_PHASE
    bar = xcd_barrier_post((unsigned*)(ctl + CW_BAR), MISC + 8);
#endif
    const int lo = args.ph_lo, hi = args.ph_hi;
#define IN(k) (lo <= (k) && (k) < hi)
#define STAGGER_WAIT() do { if (STAGGER_TICKS > 0 && (blockIdx.x & 8)) { const unsigned long long t0_ = __builtin_amdgcn_s_memrealtime(); while (__builtin_amdgcn_s_memrealtime() - t0_ < (unsigned long long)STAGGER_TICKS) __builtin_amdgcn_s_sleep(32); } } while (0)
#define SEAM(k) do { if (IN(k) && IN((k) + 1)) xcd_barrier(bar); } while (0)

    const float* x_in = args.in[I_X];
    bf16* WinT = (bf16*)(ws + WS_WIN); bf16* WoutT = (bf16*)(ws + WS_WOUT); bf16* WguT = (bf16*)(ws + WS_WGU); bf16* WdT = (bf16*)(ws + WS_WD);
    bf16* XB = (bf16*)(ws + WS_XB); bf16* PB = (bf16*)(ws + WS_P); bf16* YB = (bf16*)(ws + WS_Y); bf16* HB = (bf16*)(ws + WS_P);
    bf16* MWgu = (bf16*)(ws + WS_MOEW_GU); bf16* MWd = (bf16*)(ws + (MOE8_GU ? WS_MOEW8_D : WS_MOEW_D)); bf16* MH = (bf16*)(ws + WS_MOEH);
    unsigned char* MWgu8 = ws + WS_MOEW8_GU; unsigned char* MWd8 = ws + WS_MOEW8_D; unsigned char* MH8 = ws + WS_MOEH; unsigned char* MH8b = ws + WS_MOEH + 119 * MiB; unsigned char* XB8 = ws + WS_XB8;
    float* ssq0 = (float*)(ctl + CW_SSQ); float* ssq1 = (float*)(ws + WS_SSQP); float* ssq2 = ssq1 + (size_t)NTOK * 16;
    bf16* WupT = (bf16*)(ws + WS_SMALLW + SW_WUP); bf16* AupT = (bf16*)(ws + WS_SMALLW + SW_AUP); bf16* GupT = (bf16*)(ws + WS_SMALLW + SW_GUP); bf16* WsB = (bf16*)(ws + WS_SMALLW + SW_WS);
    RwkvS RS{(bf16*)(ws + WS_SCR), (bf16*)(ws + WS_SCR + 32 * MiB), (bf16*)(ws + WS_SCR + 64 * MiB), (bf16*)(ws + WS_SCR + 96 * MiB), (bf16*)(ws + WS_SCR + 128 * MiB), (bf16*)((unsigned char*)args.out), (float*)((unsigned char*)args.out + 32 * MiB)};
    unsigned char* misc = ws + WS_MISC;
    int* tok_e = (int*)(misc + MS_TOKE); float* tok_g = (float*)(misc + MS_TOKG); float* rs_moe = (float*)(misc + MS_RS); int* bcnt = (int*)(misc + MS_BCNT);
    int* row_tok = (int*)(misc + MS_ROWTOK); float* row_gate = (float*)(misc + MS_ROWGATE); int* panel = (int*)(misc + MS_PANEL); float* row_rs = (float*)(misc + MS_ROWRS);

#define DEFERRED_CONVERT(FR) do { int itb_ = 0; \
        convert_matrix(FR, args.in[I_W_IN] + (size_t)D * INW, D, INW, WinT + (size_t)INW * D, 0, args.in[I_NORM_MIX] + D, 0, itb_); \
        convert_matrix(FR, args.in[I_W_OUT], D, D, WoutT, 0, nullptr, 0, itb_); convert_matrix(FR, args.in[I_W_OUT] + (size_t)D * D, D, D, WoutT + (size_t)D * D, 0, nullptr, 0, itb_); \
        convert_matrix(FR, args.in[I_FFN_WG], D, FF, WguT, 1, args.in[I_NORM_FFN], 0, itb_); convert_matrix(FR, args.in[I_FFN_WU], D, FF, WguT, 2, args.in[I_NORM_FFN], 0, itb_); \
        convert_matrix(FR, args.in[I_FFN_WD], FF, D, WdT, 0, nullptr, 0, itb_); } while (0)
    if (IN(PH_PRO)) for (int rep = 0; rep < (PROBE_DUP == 4 ? 2 : 1); ++rep) {
        int itb = 0;
        convert_matrix(F, args.in[I_W_IN], D, INW, WinT, 0, args.in[I_NORM_MIX], 0, itb);
        if (!(DEFER_CONVERT && F.G == 256)) { DEFERRED_CONVERT(F); }
        { const size_t gt = (size_t)blockIdx.x * 512 + F.tid, gn = (size_t)F.G * 512;
          for (size_t i = gt; i < (size_t)2 * RWW * 64; i += gn) { const int l = (int)(i / (RWW * 64)), r = (int)(i % (RWW * 64)), ch = r / 64, j = r % 64;
              WupT[i] = (bf16)f2bf(args.in[I_RW_W_UP][(size_t)l * 64 * RWW + (size_t)j * RWW + ch]); AupT[i] = (bf16)f2bf(args.in[I_RW_A_UP][(size_t)l * 64 * RWW + (size_t)j * RWW + ch]); }
          for (size_t i = gt; i < (size_t)2 * RWW * 128; i += gn) { const int l = (int)(i / (RWW * 128)), r = (int)(i % (RWW * 128)), ch = r / 128, j = r % 128;
              GupT[i] = (bf16)f2bf(args.in[I_RW_G_UP][(size_t)l * 128 * RWW + (size_t)j * RWW + ch]); }
          for (size_t i = gt; i < (size_t)2 * NH * GCH * GCH; i += gn) { const int t = (int)((i / GCH) % GCH), s2 = (int)(i % GCH); WsB[i] = (bf16)(s2 <= t ? f2bf(args.in[I_GM_WS][i]) : 0u); } }
        for (int m = F.gw; m < NTOK; m += F.NGW) {
            const GAS f32x4* xr = (const GAS f32x4*)(x_in + (size_t)m * D) + F.lane; GAS u32x2* o8 = (GAS u32x2*)(XB + (size_t)m * D) + F.lane; float s = 0.f;
#pragma unroll
            for (int j = 0; j < 4; ++j) { const f32x4 v = xr[64 * j]; s += (v.x * v.x + v.y * v.y) + (v.z * v.z + v.w * v.w); u32x2 w; w.x = pk2(v.x, v.y); w.y = pk2(v.z, v.w); o8[64 * j] = w; }
            s = wave_sum(s); if (F.lane == 0) ssq0[m] = s;
        }
    }
    SEAM(PH_PRO);
    if (PROBE_DUP == 6) { for (int q_ = 0; q_ < 10; ++q_) xcd_barrier(bar); }

#define LAYER_MIXER(L, PH1, PHA, PHB, PHC, PH2, XBASE, BASE32, SSQ_IN, NP_IN, SSQ_OUT, HAS_OUT) \
    if (IN(PH1)) { pg8::DenseSched S; S.init(XB, WinT + (size_t)(L) * INW * D, NTOK, INW, 2 * D, F.G, (int)blockIdx.x); \
        pg8::EpiScaleBf16<NP_IN> E{PB, INW, SSQ_IN, (LAS float*)(F.lds + RING_BYTES + 4096)}; pg8::gemm_phase(F.lds, 2 * D, S, E); } \
    if (DEFER_CONVERT && (L) == 0 && IN(PH1) && F.G == 256 && (int)blockIdx.x >= 128) { __syncthreads(); Frame F2 = F; F2.gw = ((int)blockIdx.x - 128) * 8 + F.wave; F2.NGW = 128 * 8; DEFERRED_CONVERT(F2); __syncthreads(); } \
    if (PROBE_DUP == 1 && (L) == 0 && IN(PH1)) { pg8::DenseSched S; S.init(XB, WinT + (size_t)(L) * INW * D, NTOK, INW, 2 * D, F.G, (int)blockIdx.x); \
        pg8::EpiScaleBf16<NP_IN> E{PB, INW, SSQ_IN, (LAS float*)(F.lds + RING_BYTES + 4096)}; pg8::gemm_phase(F.lds, 2 * D, S, E); } \
    SEAM(PH1); \
    { RwkvW RW{args.in[I_SHIFT_MU] + (L) * 1792, args.in[I_RW_W0] + (L) * RWW, args.in[I_RW_A0] + (L) * RWW, args.in[I_RW_K_K] + (L) * RWW, args.in[I_RW_K_A] + (L) * RWW, args.in[I_RW_R_K] + (L) * RWW, \
                 args.in[I_RW_LNX_W] + (L) * RWW, args.in[I_RW_LNX_B] + (L) * RWW, WupT + (size_t)(L) * RWW * 64, AupT + (size_t)(L) * RWW * 64, GupT + (size_t)(L) * RWW * 128}; \
      if (IN(PHA)) { if (MIX_MODE != 1) for (int rep = 0; rep < REP_M1; ++rep) { rwkv_m1_consts(F, RW); for (int u = blockIdx.x; u < NB * 64; u += F.G) rwkv_m1v2_unit(F, u, PB, RW, RS); } } \
      SEAM(PHA); \
      if (IN(PHB)) for (int rep = 0; rep < REP_M2; ++rep) { const int nscan = (F.G >= 128 && MIX_MODE != 1) ? 64 : 0; \
          if (MIX_MODE != 1 && MIX_MODE != 3) { if (nscan) { if ((int)blockIdx.x < 64) { rwkv_m2_unit(F, blockIdx.x, RS); hnd_arrive((unsigned*)(ctl + CW_HND + 64 * (L))); } } else { for (int u = blockIdx.x; u < 64; u += F.G) { rwkv_m2_unit(F, u, RS); hnd_arrive((unsigned*)(ctl + CW_HND + 64 * (L))); } } } \
          if (MIX_MODE == 2) gmlp_naive(F, PB, YB, args.in[I_GM_LN_W] + (L) * GMW, args.in[I_GM_LN_B] + (L) * GMW, args.in[I_GM_WS] + (size_t)(L) * NH * GCH * GCH, args.in[I_GM_BS] + (L) * NH * GCH); \
          else { const int NU = NB * (SEQ / GCH) * NH; const int nsplit = (nscan && F.G == 256) ? 1920 : NU;         \
              if ((int)blockIdx.x >= nscan) gmlp_units(F, blockIdx.x - nscan, F.G - nscan, nsplit, PB, YB, args.in[I_GM_LN_W] + (L) * GMW, args.in[I_GM_LN_B] + (L) * GMW, WsB + (size_t)(L) * NH * GCH * GCH, args.in[I_GM_BS] + (L) * NH * GCH); \
              else if (nsplit < NU) gmlp_units(F, nsplit + blockIdx.x, nscan, NU, PB, YB, args.in[I_GM_LN_W] + (L) * GMW, args.in[I_GM_LN_B] + (L) * GMW, WsB + (size_t)(L) * NH * GCH * GCH, args.in[I_GM_BS] + (L) * NH * GCH); } } \
      if (MIX_MODE == 0 && REP_M2 == 1) { if (IN(PHB) && IN(PHC)) hnd_wait((unsigned*)(ctl + CW_HND + 64 * (L)), 64u, bar.bar); } else SEAM(PHB);      \
      if (IN(PHC)) { if (MIX_MODE == 3) { for (int u = blockIdx.x; u < 64; u += F.G) rwkv_apply_naive(F, u, PB, YB, RW, RS); } \
          else if (MIX_MODE != 1) { for (int rep = 0; rep < REP_M3; ++rep) rwkv_m3_units(F, blockIdx.x, F.G, NB * 64, PB, YB, RW, RS); } \
          else rwkv_naive(F, PB, YB, args.in[I_SHIFT_MU] + (L) * 1792, args.in[I_RW_W_UP] + (L) * 64 * RWW, args.in[I_RW_W0] + (L) * RWW, args.in[I_RW_A_UP] + (L) * 64 * RWW, args.in[I_RW_A0] + (L) * RWW, \
                   args.in[I_RW_G_UP] + (L) * 128 * RWW, args.in[I_RW_K_K] + (L) * RWW, args.in[I_RW_K_A] + (L) * RWW, args.in[I_RW_R_K] + (L) * RWW, args.in[I_RW_LNX_W] + (L) * RWW, args.in[I_RW_LNX_B] + (L) * RWW); } \
      SEAM(PHC); } \
    if (IN(PH2)) { STAGGER_WAIT(); pg8::DenseSched S; S.init(YB, WoutT + (size_t)(L) * D * D, NTOK, D, 2 * D, F.G, (int)blockIdx.x); \
        pg8::EpiResid<HAS_OUT, BASE32> E{XBASE, XB, SSQ_OUT}; pg8::gemm_phase(F.lds, 2 * D, S, E); } \
    if (PROBE_DUP == 2 && (L) == 0 && IN(PH2)) { pg8::DenseSched S; S.init(YB, WoutT + (size_t)(L) * D * D, NTOK, D, 2 * D, F.G, (int)blockIdx.x); \
        pg8::EpiResid<HAS_OUT, BASE32> E{XBASE, XB, SSQ_OUT}; pg8::gemm_phase(F.lds, 2 * D, S, E); } \
    SEAM(PH2);

    LAYER_MIXER(0, PH_G1_0, PH_M1_0, PH_M2_0, PH_M3_0, PH_G2_0, nullptr, false, ssq0, 1, ssq1, true)

    if (IN(PH_G3_0)) { pg8::DenseSched S; S.init(XB, WguT, NTOK, 2 * FF, 2 * D, F.G, (int)blockIdx.x);
        pg8::EpiSwiglu<16> E{HB, FF, ssq1, (LAS float*)(F.lds + RING_BYTES + 4096)}; pg8::gemm_phase(F.lds, 2 * D, S, E); }
#if REP_G3 == 2
    if (IN(PH_G3_0)) { pg8::DenseSched S; S.init(XB, WguT, NTOK, 2 * FF, 2 * D, F.G, (int)blockIdx.x);
        pg8::EpiSwiglu<16> E{HB, FF, ssq1, (LAS float*)(F.lds + RING_BYTES + 4096)}; pg8::gemm_phase(F.lds, 2 * D, S, E); }
#endif
    SEAM(PH_G3_0);
    if (IN(PH_G4_0)) { STAGGER_WAIT(); pg8::DenseSched S; S.init(HB, WdT, NTOK, D, 2 * FF, F.G, (int)blockIdx.x);
        pg8::EpiResid<true, false> E{nullptr, XB, ssq2}; pg8::gemm_phase(F.lds, 2 * FF, S, E); }
    SEAM(PH_G4_0);

    LAYER_MIXER(1, PH_G1_1, PH_M1_1, PH_M2_1, PH_M3_1, PH_G2_1, nullptr, false, ssq2, 16, nullptr, false)

    if (IN(PH_CV)) for (int rep = 0; rep < REP_CV; ++rep) {
        const float* gain = args.in[I_NORM_FFN] + D;
        LAS float* RW = (LAS float*)F.lds; LAS int* cnt = (LAS int*)(F.lds + 32768);
        for (int i = F.tid; i < D * NE; i += 512) { const int k = i >> 3, e = i & 7, jj = k >> 9, ln = (k & 511) >> 3, q = k & 7; RW[(((jj * 8 + q) * 64 + ln) << 3) + e] = args.in[I_MOE_ROUTER][i] * gain[k]; }
        for (size_t i = (size_t)blockIdx.x * 512 + F.tid; i < (size_t)2 * MAXPAN * 256; i += (size_t)F.G * 512) { row_tok[i] = -1; row_gate[i] = 0.f; row_rs[i] = 0.f; }
        __syncthreads();
        for (int vb = blockIdx.x; vb < 256; vb += F.G) {
            if (F.tid < 16) cnt[F.tid] = 0;
            __syncthreads();
            u32x4 xv4[2];
            { const GAS u32x4* xr0 = (const GAS u32x4*)(XB + (size_t)(vb * 128 + F.wave * 16) * D) + F.lane; xv4[0] = xr0[0]; xv4[1] = xr0[64]; }
            for (int i = 0; i < 16; ++i) { const int m = vb * 128 + F.wave * 16 + i;
                float s = 0.f; float lg[8]; u32x4 cur4[2]; cur4[0] = xv4[0]; cur4[1] = xv4[1];
                if (i + 1 < 16) { const GAS u32x4* xr1 = (const GAS u32x4*)(XB + (size_t)(m + 1) * D) + F.lane; xv4[0] = xr1[0]; xv4[1] = xr1[64]; }
#pragma unroll
                for (int e = 0; e < 8; ++e) lg[e] = 0.f;
#pragma unroll
                for (int jj = 0; jj < 2; ++jj) { float v[8]; unpack8(cur4[jj], v);
                    if (MOE8_GU && !MOE8_DN) { u32x2 w8; w8.x = pk4_fp8(v[0], v[1], v[2], v[3]); w8.y = pk4_fp8(v[4], v[5], v[6], v[7]); *(u32x2*)(XB8 + (size_t)m * D + 512 * jj + 8 * F.lane) = w8; }
#pragma unroll
                    for (int q = 0; q < 8; ++q) { const float xv = v[q]; s += xv * xv; const LAS f32x4* rw = (const LAS f32x4*)(RW + (((jj * 8 + q) * 64 + F.lane) << 3)); const f32x4 r0 = rw[0], r1 = rw[1];
                        lg[0] += xv * r0.x; lg[1] += xv * r0.y; lg[2] += xv * r0.z; lg[3] += xv * r0.w; lg[4] += xv * r1.x; lg[5] += xv * r1.y; lg[6] += xv * r1.z; lg[7] += xv * r1.w; } }
                s = wave_sum(s);
#pragma unroll
                for (int e = 0; e < 8; ++e) lg[e] = wave_sum(lg[e]);
                const float rs = 1.0f / sqrtf(s * (1.0f / D) + RMS_EPS);
                if (MOE8_GU && MOE8_DN) {
#pragma unroll
                    for (int jj = 0; jj < 2; ++jj) { float v[8]; unpack8(cur4[jj], v); u32x2 w8; w8.x = pk4_fp8(v[0] * rs, v[1] * rs, v[2] * rs, v[3] * rs); w8.y = pk4_fp8(v[4] * rs, v[5] * rs, v[6] * rs, v[7] * rs);
                        *(u32x2*)(XB8 + (size_t)m * D + 512 * jj + 8 * F.lane) = w8; } }
                if (F.lane == 0) {
                    int i1 = 0; float v1 = lg[0];
#pragma unroll
                    for (int e = 1; e < 8; ++e) if (lg[e] > v1) { v1 = lg[e]; i1 = e; }
                    int i2 = -1; float v2 = -3.0e38f;
#pragma unroll
                    for (int e = 0; e < 8; ++e) if (e != i1 && lg[e] > v2) { v2 = lg[e]; i2 = e; }
                    if (i2 < 0) { i2 = (i1 + 1) & 7; v2 = v1; }
                    const float g1 = 1.0f / (1.0f + __expf((v2 - v1) * rs)), g2 = 1.0f - g1;
                    tok_e[2 * m] = i1; tok_e[2 * m + 1] = i2; tok_g[2 * m] = g1; tok_g[2 * m + 1] = g2; rs_moe[m] = rs;
                    __hip_atomic_fetch_add(&cnt[i1], 1, __ATOMIC_RELAXED, __HIP_MEMORY_SCOPE_WORKGROUP); __hip_atomic_fetch_add(&cnt[8 + i2], 1, __ATOMIC_RELAXED, __HIP_MEMORY_SCOPE_WORKGROUP);
                } }
            __syncthreads();
            if (F.tid < 16) bcnt[vb * 16 + F.tid] = cnt[F.tid];
            __syncthreads();
        }
        if (rep == 0) hnd_arrive((unsigned*)(ctl + CW_HND + 128));
        int itb = 0;
        for (int e = 0; e < NE; ++e) {
            if (MOE8_GU) { convert_matrix_fp8(F, args.in[I_MOE_WG] + (size_t)e * D * FFE, D, FFE, MWgu8 + (size_t)e * 2 * FFE * D, 1, gain, MOE8_WSCALE_GU * (MOE8_DN ? -1.44269504f : 1.0f), itb);
                           convert_matrix_fp8(F, args.in[I_MOE_WU] + (size_t)e * D * FFE, D, FFE, MWgu8 + (size_t)e * 2 * FFE * D, 2, gain, MOE8_WSCALE_GU, itb); }
            else { convert_matrix(F, args.in[I_MOE_WG] + (size_t)e * D * FFE, D, FFE, MWgu + (size_t)e * 2 * FFE * D, 1, gain, 0, itb);
                   convert_matrix(F, args.in[I_MOE_WU] + (size_t)e * D * FFE, D, FFE, MWgu + (size_t)e * 2 * FFE * D, 2, gain, 0, itb); }
            if (MOE8_DN) convert_matrix_fp8(F, args.in[I_MOE_WD] + (size_t)e * FFE * D, FFE, D, MWd8 + (size_t)e * D * FFE, 0, nullptr, MOE8_WSCALE_DN, itb);
            else convert_matrix(F, args.in[I_MOE_WD] + (size_t)e * FFE * D, FFE, D, MWd + (size_t)e * D * FFE, 0, nullptr, 0, itb);
        }
    }
    if (IN(PH_CV) && IN(PH_R2)) hnd_wait((unsigned*)(ctl + CW_HND + 128), (unsigned)F.G, bar.bar);

    if (IN(PH_R2)) {
        LAS int* tot = (LAS int*)F.lds;
        LAS int* bc = tot + 64;
        for (int vb = blockIdx.x; vb < 256; vb += F.G) {
            for (int i = F.tid; i < 256 * 16; i += 512) bc[i] = bcnt[i];
            __syncthreads();
            if (F.tid < 16) { int t = 0, mine = 0; for (int b2 = 0; b2 < 256; ++b2) { const int c = bc[b2 * 16 + F.tid]; if (b2 < vb) mine += c; t += c; } tot[F.tid] = t; tot[32 + F.tid] = mine; }
            __syncthreads();
            if (F.tid < 2) { int ps = 0; for (int e = 0; e < 8; ++e) { tot[16 + F.tid * 8 + e] = ps; ps += (tot[F.tid * 8 + e] + 255) / 256; }
                if (vb == 0) { panel[F.tid * 160] = ps; for (int e = 0; e < 8; ++e) { const int np = (tot[F.tid * 8 + e] + 255) / 256; for (int q = 0; q < np; ++q) panel[F.tid * 160 + 16 + tot[16 + F.tid * 8 + e] + q] = e; } } }
            int e01[2] = {0, 0}; float g01[2] = {0.f, 0.f}; float rsv = 0.f; const int m = vb * 128 + F.tid;
            if (F.tid < 128) { e01[0] = tok_e[2 * m]; e01[1] = tok_e[2 * m + 1]; g01[0] = tok_g[2 * m]; g01[1] = tok_g[2 * m + 1]; rsv = rs_moe[m]; }
            int rank[2] = {0, 0};
            if (F.wave < 2) {
#pragma unroll
                for (int set = 0; set < 2; ++set)
#pragma unroll
                    for (int e = 0; e < 8; ++e) { const unsigned long long mk = __ballot(e01[set] == e); if (e01[set] == e) rank[set] = __popcll(mk & ((1ull << F.lane) - 1ull));
                        if (F.wave == 0 && F.lane == 0) tot[48 + set * 8 + e] = __popcll(mk); } }
            __syncthreads();
            if (F.tid < 128) {
#pragma unroll
                for (int set = 0; set < 2; ++set) { const int key = set * 8 + e01[set]; const int slot = tot[16 + key] * 256 + tot[32 + key] + rank[set] + (F.wave == 1 ? tot[48 + key] : 0);
                    row_tok[set * MAXPAN * 256 + slot] = m; row_gate[set * MAXPAN * 256 + slot] = g01[set]; row_rs[set * MAXPAN * 256 + slot] = rsv; } }
            __syncthreads();
        }
    }
    SEAM(PH_R2);

#define MOE_SET(SET, PHGU, PHDN) \
    if (IN(PHGU)) for (int rep = 0; rep < REP_GU; ++rep) { const int np = __builtin_amdgcn_readfirstlane(panel[(SET) * 160]); pg8::MoeSched<true> S; \
        if (MOE8_GU) { S.init(XB8, MWgu8, np, 2 * FFE, D, MOE_PEXP(SET) + 16, row_tok + (SET) * MAXPAN * 256, F.G, (int)blockIdx.x); \
            if (MOE8_DN) { pg8::EpiSwigluMoe8 E{MH8, FFE}; pg8::gemm_phase<pg8::EpiSwigluMoe8, pg8::MoeSched<true>, true>(F.lds, D, S, E); } \
            else { pg8::EpiSwigluMoe E{MH, FFE, rs_moe, row_tok + (SET) * MAXPAN * 256, 1.0f / MOE8_WSCALE_GU}; pg8::gemm_phase<pg8::EpiSwigluMoe, pg8::MoeSched<true>, true>(F.lds, D, S, E); } } \
        else { S.init(XB, MWgu, np, 2 * FFE, 2 * D, MOE_PEXP(SET) + 16, row_tok + (SET) * MAXPAN * 256, F.G, (int)blockIdx.x); \
            pg8::EpiSwigluMoe E{MH, FFE, rs_moe, row_tok + (SET) * MAXPAN * 256, 1.0f}; pg8::gemm_phase(F.lds, 2 * D, S, E); } } \
    SEAM(PHGU); \
    if (IN(PHDN)) { const int np = __builtin_amdgcn_readfirstlane(panel[(SET) * 160]); pg8::MoeSched<false> S; \
        if (MOE8_DN) { S.init(MH8, MWd8, np, D, FFE, MOE_PEXP(SET) + 16, row_tok + (SET) * MAXPAN * 256, F.G, (int)blockIdx.x); \
            pg8::EpiMoeDown E{XB, row_tok + (SET) * MAXPAN * 256, row_gate + (SET) * MAXPAN * 256, 1.0f / MOE8_WSCALE_DN, (LAS int*)(F.lds + RING_BYTES + 4096)}; pg8::gemm_phase<pg8::EpiMoeDown, pg8::MoeSched<false>, true>(F.lds, FFE, S, E); } \
        else { S.init(MH, MWd, np, D, 2 * FFE, MOE_PEXP(SET) + 16, row_tok + (SET) * MAXPAN * 256, F.G, (int)blockIdx.x); \
            pg8::EpiMoeDown E{XB, row_tok + (SET) * MAXPAN * 256, row_gate + (SET) * MAXPAN * 256, 1.0f, (LAS int*)(F.lds + RING_BYTES + 4096)}; pg8::gemm_phase(F.lds, 2 * FFE, S, E); } } \
    SEAM(PHDN);
#if MOE8_GU && MOE8_DN
#define MOE_PEXP(SET) ((const LAS int*)(F.lds + RING_BYTES + (SET) * 1024))
#define MOE_LOAD_PEXP() do { if (F.tid < 2 * 160) ((LAS int*)(F.lds + RING_BYTES))[(F.tid / 160) * 256 + (F.tid % 160)] = panel[F.tid]; __syncthreads(); } while (0)
#define MOE_GU8(SET, HBUF, P0, NP, SKX, SKR) do { pg8::MoeSched<true> S; \
        S.init(XB8, MWgu8, (NP), 2 * FFE, D, MOE_PEXP(SET) + 16, row_tok + (SET) * MAXPAN * 256, F.G, (int)blockIdx.x); S.p0 = (P0); S.T.sx = (SKX); S.T.sr = (SKR); \
        pg8::EpiSwigluMoe8 E{HBUF, FFE}; pg8::gemm_phase<pg8::EpiSwigluMoe8, pg8::MoeSched<true>, true>(F.lds, D, S, E); } while (0)
#define MOE_DN8(SET, HBUF, P0, NP) do { pg8::MoeSched<false> S; \
        S.init(HBUF, MWd8, (NP), D, FFE, MOE_PEXP(SET) + 16, row_tok + (SET) * MAXPAN * 256, F.G, (int)blockIdx.x); S.p0 = (P0); \
        pg8::EpiMoeDown E{XB, row_tok + (SET) * MAXPAN * 256, row_gate + (SET) * MAXPAN * 256, 1.0f / MOE8_WSCALE_DN, (LAS int*)(F.lds + RING_BYTES + 4096)}; pg8::gemm_phase<pg8::EpiMoeDown, pg8::MoeSched<false>, true>(F.lds, FFE, S, E); } while (0)
    const int npA = __builtin_amdgcn_readfirstlane(panel[0]), npB = __builtin_amdgcn_readfirstlane(panel[160]);
    const int nB2 = npB < 64 ? npB : 64, nB1 = npB - nB2;
    if (IN(PH_GU_A)) { MOE_LOAD_PEXP(); MOE_GU8(0, MH8, 0, npA, 0, 0); }
    if (PROBE_DUP == 3 && IN(PH_GU_A)) MOE_GU8(0, MH8, 0, npA, 0, 0);
    SEAM(PH_GU_A);
    if (IN(PH_DN_A)) { MOE_LOAD_PEXP(); MOE_DN8(0, MH8, 0, npA);
        const int sx = (npA * (D / 256)) % F.G;
        if (nB1 > 0) MOE_GU8(1, MH8b, 0, nB1, sx, sx ? 3 : 0); }
    SEAM(PH_DN_A);
    if (IN(PH_GU_B)) { MOE_LOAD_PEXP(); if (nB1 > 0) MOE_DN8(1, MH8b, 0, nB1);
        const int sx = (nB1 * (D / 256)) % F.G;
        MOE_GU8(1, MH8b, nB1, nB2, sx, sx ? 3 : 0); }
    SEAM(PH_GU_B);
    if (IN(PH_DN_B)) { MOE_LOAD_PEXP(); MOE_DN8(1, MH8b, nB1, nB2); }
    SEAM(PH_DN_B);
#else
    MOE_SET(0, PH_GU_A, PH_DN_A)
    MOE_SET(1, PH_GU_B, PH_DN_B)
#endif

    if (IN(PH_FIN)) for (int rep = 0; rep < (PROBE_DUP == 7 ? 2 : 1); ++rep) {
        const float* gf = args.in[I_NORM_FINAL];
        f32x4 gq[2][2];
#pragma unroll
        for (int jj = 0; jj < 2; ++jj) { gq[jj][0] = *((const f32x4*)(gf + 512 * jj + 8 * F.lane)); gq[jj][1] = *((const f32x4*)(gf + 512 * jj + 8 * F.lane + 4)); }
        for (int m = F.gw; m < NTOK; m += F.NGW) {
            const GAS u32x4* xr = (const GAS u32x4*)(XB + (size_t)m * D) + F.lane; float v[2][8]; float s = 0.f;
#pragma unroll
            for (int jj = 0; jj < 2; ++jj) { unpack8(xr[64 * jj], v[jj]);
#pragma unroll
                for (int q = 0; q < 8; ++q) s += v[jj][q] * v[jj][q]; }
            const float rs = 1.0f / sqrtf(wave_sum(s) * (1.0f / D) + RMS_EPS);
#pragma unroll
            for (int jj = 0; jj < 2; ++jj) { const f32x4 g0 = gq[jj][0], g1 = gq[jj][1];
                GAS f32x4* o = (GAS f32x4*)(args.out + (size_t)m * D + 512 * jj + 8 * F.lane);
                o[0] = (f32x4){v[jj][0] * rs * g0.x, v[jj][1] * rs * g0.y, v[jj][2] * rs * g0.z, v[jj][3] * rs * g0.w}; o[1] = (f32x4){v[jj][4] * rs * g1.x, v[jj][5] * rs * g1.y, v[jj][6] * rs * g1.z, v[jj][7] * rs * g1.w}; }
        }
    }
#undef IN
#undef SEAM
}

extern "C" void kernel_launch(void* const* d_in, const int* in_sizes, int n_in, void* d_out, int out_size, void* d_ws, size_t ws_size, hipStream_t stream) {
    static int grid = 0;
    if (grid == 0) {
        if (n_in != NIN || in_sizes[0] != NTOK * D || out_size != NTOK * D || ws_size < WS_END) {
            fprintf(stderr, "kernel_launch: unexpected shapes: n_in %d in0 %d out %d ws %zu (need %zu); nothing launched\n", n_in, n_in > 0 ? in_sizes[0] : -1, out_size, ws_size, (size_t)WS_END); grid = -1; return; }
        int dev = 0, cus = 0, per_cu = 0;
        if (hipGetDevice(&dev) != hipSuccess || hipDeviceGetAttribute(&cus, hipDeviceAttributeMultiprocessorCount, dev) != hipSuccess) { grid = -1; return; }
        if (hipFuncSetAttribute((const void*)fwd, hipFuncAttributeMaxDynamicSharedMemorySize, LDS_BYTES) != hipSuccess) { fprintf(stderr, "kernel_launch: hipFuncSetAttribute failed\n"); grid = -1; return; }
        if (hipOccupancyMaxActiveBlocksPerMultiprocessor(&per_cu, (const void*)fwd, 512, LDS_BYTES) != hipSuccess || per_cu < 1) { fprintf(stderr, "kernel_launch: occupancy query says %d\n", per_cu); }
        (void)hipGetLastError();
        grid = cus;
    }
    if (grid < 0) return;
    if (hipMemsetAsync((char*)d_ws + WS_CTL, 0, CTL_ZERO_BYTES, stream) != hipSuccess) return;
    Args a{};
    for (int i = 0; i < NIN; ++i) a.in[i] = (const float*)d_in[i];
    a.out = (float*)d_out; a.ws = (unsigned char*)d_ws;
#if MK_PER_PHASE
    for (int ph = 0; ph < PH_COUNT; ++ph) { a.ph_lo = ph; a.ph_hi = ph + 1; hipLaunchKernelGGL(fwd, dim3(grid), dim3(512), LDS_BYTES, stream, a); }
#else
    a.ph_lo = 0; a.ph_hi = PH_COUNT; hipLaunchKernelGGL(fwd, dim3(grid), dim3(512), LDS_BYTES, stream, a);
#endif
}
```

```cpp
#include <hip/hip_runtime.h>
#include <cstdio>
#include <cstdint>

#ifndef MK_PER_PHASE
#define MK_PER_PHASE 0
#endif

#ifndef REP_M1
#define REP_M1 1
#endif
#ifndef REP_M2
#define REP_M2 1
#endif
#ifndef REP_M3
#define REP_M3 1
#endif
#ifndef REP_GU
#define REP_GU 1
#endif
#ifndef REP_CH
#define REP_CH 1
#endif
#ifndef PROBE_STAGE
#define PROBE_STAGE 0
#endif
#ifndef REP_CV
#define REP_CV 1
#endif
#ifndef REP_EPI
#define REP_EPI 1
#endif
#ifndef REP_G3
#define REP_G3 1
#endif
#ifndef PROBE_DUP
#define PROBE_DUP 0
#endif
#ifndef STAGGER_TICKS
#define STAGGER_TICKS 0
#endif
#ifndef DEFER_CONVERT
#define DEFER_CONVERT 1
#endif
#ifndef DBG_VAR
#define DBG_VAR 0
#endif
#ifndef MOE8_GU
#define MOE8_GU 1
#endif
#ifndef MOE8_DN
#define MOE8_DN 1
#endif
#ifndef MIX_MODE
#define MIX_MODE 0
#endif
#define GAS __attribute__((address_space(1)))
#define LAS __attribute__((address_space(3)))
typedef unsigned short bf16;
typedef unsigned short bf16_t;
typedef short bf16x8 __attribute__((ext_vector_type(8)));
typedef float f32x4 __attribute__((ext_vector_type(4)));
typedef float f32x2 __attribute__((ext_vector_type(2)));
typedef unsigned u32x4 __attribute__((ext_vector_type(4)));
typedef unsigned u32x2 __attribute__((ext_vector_type(2)));
typedef GAS unsigned gu32;

constexpr int NTOK = 32768, SEQ = 4096, NB = 8, D = 1024, INW = 2816, FF = 2816, FFE = 3584, NE = 8;
constexpr int GMW = 512, RWW = 512, NH = 8, HD = 64, GCH = 128;
constexpr float RMS_EPS = 1e-6f, LN_EPS = 1e-5f, GN_EPS = 64e-5f;
constexpr int MAXPAN = 136;

constexpr size_t MiB = 1u << 20;
constexpr size_t WS_CTL = 0, CTL_ZERO_BYTES = 2 * MiB;
constexpr size_t WS_WIN = 2 * MiB;
constexpr size_t WS_WOUT = 13 * MiB;
constexpr size_t WS_WGU = 17 * MiB;
constexpr size_t WS_WD = 28 * MiB;
constexpr size_t WS_MISC = 34 * MiB;
constexpr size_t WS_SMALLW = 36 * MiB;
constexpr size_t SW_WUP = 0, SW_AUP = 128 * 1024, SW_GUP = 256 * 1024, SW_WS = 512 * 1024;
constexpr size_t WS_XB = 38 * MiB;
constexpr size_t WS_R = 102 * MiB;
constexpr size_t WS_P = WS_R;
constexpr size_t WS_Y = WS_R + 176 * MiB;
constexpr size_t WS_SCR = WS_R + 240 * MiB;
constexpr size_t WS_MOEW_GU = WS_R;
constexpr size_t WS_MOEW_D = WS_R + 112 * MiB;
constexpr size_t WS_MOEH = WS_R + 168 * MiB;
constexpr size_t WS_MOEW8_GU = WS_R;
constexpr size_t WS_MOEW8_D = WS_R + 56 * MiB;
constexpr size_t WS_XB8 = WS_R + 112 * MiB;
constexpr float MOE8_WSCALE_GU = 64.f, MOE8_WSCALE_DN = 128.f;
constexpr size_t WS_SSQP = WS_R + 400 * MiB;
constexpr size_t WS_END = WS_R + 408 * MiB;
static_assert(WS_MOEH + (size_t)MAXPAN * 256 * FFE * 2 <= WS_END, "moe hidden fits");
static_assert(WS_WIN + (size_t)2 * INW * D * 2 <= WS_WOUT && WS_WGU + (size_t)2 * FF * D * 2 <= WS_WD && WS_WD + (size_t)D * FF * 2 <= WS_MISC, "weights fit");
constexpr int CW_TMO = 0;
constexpr int CW_BAR = 4096;
constexpr int CW_HND = 8192;
constexpr int CW_SSQ = 65536;
static_assert((CW_SSQ + 4 * NTOK) * 4 <= (int)CTL_ZERO_BYTES, "ctl fits");
constexpr size_t MS_TOKE = 0;
constexpr size_t MS_TOKG = 256 * 1024;
constexpr size_t MS_RS = 512 * 1024;
constexpr size_t MS_BCNT = 640 * 1024;
constexpr size_t MS_ROWTOK = 704 * 1024;
constexpr size_t MS_ROWGATE = 1024 * 1024;
constexpr size_t MS_PANEL = 1344 * 1024;
constexpr size_t MS_ROWRS = 1408 * 1024;
static_assert(MS_ROWTOK + 2 * MAXPAN * 256 * 4 <= MS_ROWGATE && MS_ROWGATE + 2 * MAXPAN * 256 * 4 <= MS_PANEL && MS_PANEL + 2 * 160 * 4 <= MS_ROWRS && MS_ROWRS + 2 * MAXPAN * 256 * 4 <= 2 * MiB, "misc fits");

constexpr int RING_BYTES = 131072;
constexpr int LDS_BYTES = 147456;
constexpr int MISC_OFF = LDS_BYTES - 128;

#define LDS_WAIT() asm volatile("s_waitcnt lgkmcnt(0)" ::: "memory")
#define VM_WAIT() asm volatile("s_waitcnt vmcnt(0)" ::: "memory")
#define RLX_AGENT __ATOMIC_RELAXED, __HIP_MEMORY_SCOPE_AGENT
#define LDS_BARRIER() do { asm volatile("s_waitcnt lgkmcnt(0)" ::: "memory"); __builtin_amdgcn_s_barrier(); asm volatile("" ::: "memory"); } while (0)

__device__ __forceinline__ unsigned f2bf(float f) { unsigned u = __builtin_bit_cast(unsigned, f); return (u + 0x7fffu + ((u >> 16) & 1u)) >> 16; }
__device__ __forceinline__ unsigned pk2(float lo, float hi) { return f2bf(lo) | (f2bf(hi) << 16); }
__device__ __forceinline__ float bf2f(bf16 b) { return __builtin_bit_cast(float, (unsigned)b << 16); }
__device__ __forceinline__ unsigned cvt_pk_bf16(float lo, float hi) { unsigned r; asm volatile("v_cvt_pk_bf16_f32 %0, %1, %2" : "=v"(r) : "v"(lo), "v"(hi)); return r; }
__device__ __forceinline__ unsigned pk4_fp8(float a, float b, float c, float d) { int v = __builtin_amdgcn_cvt_pk_fp8_f32(a, b, 0, false); v = __builtin_amdgcn_cvt_pk_fp8_f32(c, d, v, true); return (unsigned)v; }
__device__ __forceinline__ float wave_sum(float v) {
#pragma unroll
    for (int o = 1; o < 64; o <<= 1) v += __shfl_xor(v, o);
    return v;
}
__device__ __forceinline__ float gelu_erf(float v) { return 0.5f * v * (1.0f + erff(v * 0.70710678f)); }
__device__ __forceinline__ float sigmoidf_(float v) { return 1.0f / (1.0f + __expf(-v)); }
__device__ __forceinline__ float silu_f(float v) { return v * __builtin_amdgcn_rcpf(1.0f + __expf(-v)); }

__device__ __forceinline__ f32x2 swiglu2(f32x2 g, f32x2 u, float rs) {
    const float c1 = rs * (-1.44269504f), ic2 = rs != 0.f ? __builtin_amdgcn_rcpf(rs * rs) : 1.0e30f;
    const f32x2 a = g * c1, p = g * u;
    f32x2 e; e.x = __builtin_amdgcn_exp2f(a.x); e.y = __builtin_amdgcn_exp2f(a.y);
    const f32x2 d = e * ic2 + ic2; f32x2 r; r.x = __builtin_amdgcn_rcpf(d.x); r.y = __builtin_amdgcn_rcpf(d.y);
    return p * r;
}
namespace pg8 {
constexpr int BM = 256, BK = 64, HALF = 128, HTB = HALF * BK * 2, STAGE_BYTES = 8 * HTB, NXCD = 8, WGM = 8;
__host__ __device__ __forceinline__ int lds_byte(int r, int c) { const int st = (r >> 4) * 2 + (c >> 5), rr = r & 15, cc = c & 31, ob = rr * 64 + cc * 2; return st * 1024 + (ob ^ (((ob >> 9) & 1) << 5)); }
__host__ __device__ __forceinline__ void stage_rc(int b, int& R, int& C) { const int st = b / 1024, sb = b % 1024, swz = sb ^ (((sb >> 9) & 1) << 5); R = (st >> 1) * 16 + swz / 64; C = (st & 1) * 32 + (swz % 64) / 2; }
__host__ __device__ __forceinline__ int perm32(int rho) { const int n = rho >> 4, i = rho & 15; return 8 * (i >> 2) + 4 * n + (i & 3); }

struct Unit { int pm, pn, aux; };

struct TileOrder {
    int nM, nN, nwg, G, c, sx, sr;
    __device__ void init(int nM_, int nN_, int G_, int c_) { nM = nM_; nN = nN_; nwg = nM * nN; G = G_; c = c_; sx = 0; sr = 0; }
    __device__ bool tile(int i, int& pm, int& pn) const {
        long L;
        if (sx == 0) L = (long)i * G + c;
        else if (c < sx) L = (long)sr * (G - sx) + (long)i * G + c;
        else L = i < sr ? (long)i * (G - sx) + (c - sx) : (long)sr * (G - sx) + (long)(i - sr) * G + c;
        if (L >= nwg) return false;
        int wgid = (int)L; { const int q = nwg / NXCD, r = nwg % NXCD, xcd = wgid % NXCD, off = wgid / NXCD; wgid = (xcd < r ? xcd * (q + 1) : r * (q + 1) + (xcd - r) * q) + off; }
        const int nig = WGM * nN, gid = wgid / nig, fm = gid * WGM, gsz = (nM - fm) < WGM ? (nM - fm) : WGM;
        pm = fm + ((wgid % nig) % gsz); pn = (wgid % nig) / gsz; return true;
    }
};
struct DenseSched {
    static constexpr bool GATHER = false;
    TileOrder T; const char* A; const char* Bt; size_t tstep;
    __device__ void init(const void* A_, const void* Bt_, int M, int N, int KB  , int G, int c) { T.init(M / BM, N / BM, G, c); A = (const char*)A_; Bt = (const char*)Bt_; tstep = (size_t)BM * KB; }
    __device__ __forceinline__ bool next(int i, Unit& u) const { u.aux = 0; return T.tile(i, u.pm, u.pn); }
    __device__ __forceinline__ const char* a_ptr(const Unit& u) const { return A + (size_t)u.pm * tstep; }
    __device__ __forceinline__ const char* b_ptr(const Unit& u) const { return Bt + (size_t)u.pn * tstep; }
    __device__ __forceinline__ void gather(const Unit&, int, int, int, int, int, unsigned (&)[2][2]) const {}
};
template <bool GATHER_> struct MoeSched {
    static constexpr bool GATHER = GATHER_;
    TileOrder T; const char* A; const char* Bt; size_t a_tstep, b_tstep, b_estep; const LAS int* pexp; const int* row_tok; int KB; int p0 = 0;
    __device__ void init(const void* A_, const void* Bt_, int npanels, int N, int KB_  , const LAS int* pexp_, const int* row_tok_, int G, int c) {
        T.init(npanels, N / BM, G, c); A = (const char*)A_; Bt = (const char*)Bt_; KB = KB_; a_tstep = (size_t)BM * KB_; b_tstep = (size_t)BM * KB_; b_estep = (size_t)N * KB_; pexp = pexp_; row_tok = row_tok_; }
    __device__ __forceinline__ bool next(int i, Unit& u) const { if (!T.tile(i, u.pm, u.pn)) return false; u.pm += p0; u.aux = __builtin_amdgcn_readfirstlane(pexp[u.pm]); return true; }
    __device__ __forceinline__ const char* a_ptr(const Unit& u) const { return GATHER ? A : A + (size_t)u.pm * a_tstep; }
    __device__ __forceinline__ const char* b_ptr(const Unit& u) const { return Bt + (size_t)u.aux * b_estep + (size_t)u.pn * b_tstep; }
    __device__ __forceinline__ void gather(const Unit& u, int R0, int R1, int C0, int C1, int, unsigned (&v)[2][2]) const {
#pragma unroll
        for (int h = 0; h < 2; ++h) { int t0 = row_tok[u.pm * BM + h * HALF + R0], t1 = row_tok[u.pm * BM + h * HALF + R1]; t0 = t0 < 0 ? 0 : t0; t1 = t1 < 0 ? 0 : t1;
            v[h][0] = (unsigned)(t0 * KB + C0 * 2); v[h][1] = (unsigned)(t1 * KB + C1 * 2); }
    }
};

typedef int v4i_t __attribute__((ext_vector_type(4)));
typedef int v8i_t __attribute__((ext_vector_type(8)));
typedef short s16x16_t __attribute__((ext_vector_type(16)));
__device__ __forceinline__ v8i_t cat8(const bf16x8 lo, const bf16x8 hi) { const v4i_t a = __builtin_bit_cast(v4i_t, lo), b = __builtin_bit_cast(v4i_t, hi); return __builtin_shufflevector(a, b, 0, 1, 2, 3, 4, 5, 6, 7); }
template <class Epi, class Sched, bool FP8 = false>
__device__ __forceinline__ void gemm_phase(LAS unsigned char* lds, const int KB, const Sched& S, const Epi& E) {
    constexpr bool GATHER = Sched::GATHER;
    const int tid = threadIdx.x, wid = __builtin_amdgcn_readfirstlane(tid >> 6), lane = tid & 63, wr = wid >> 2, wc = wid & 3, fr = lane & 15, fq = lane >> 4;
    const int nt = KB / 128;
    unsigned voffA[2], voffB[2], voffBa[2][2]; int sR[2], sC[2];
#pragma unroll
    for (int i = 0; i < 2; ++i) { int R, C; stage_rc(tid * 16 + i * 8192, R, C); const int Rb = Epi::PERM ? ((R & ~31) + perm32(R & 31)) : R; sR[i] = R; sC[i] = C;
        voffA[i] = (unsigned)(R * KB + C * 2); voffB[i] = (unsigned)(Rb * KB + C * 2);
        voffBa[0][i] = (unsigned)((64 * (R >> 5) + perm32(R & 31)) * KB + C * 2); voffBa[1][i] = (unsigned)((64 * (R >> 5) + 32 + perm32(R & 31)) * KB + C * 2); }
    const size_t kstep = (size_t)(BK * 2);
    const size_t hstep = (size_t)HALF * KB;
    const unsigned ldsw = (unsigned)wid * 1024u;
    const int aoff = lds_byte(wr * 64 + fr, fq * 8), boff = lds_byte(wc * 32 + fr, fq * 8);
    const int aoff8 = lds_byte(wr * 64 + fr, (fq >> 1) * 32 + (fq & 1) * 16) & ~31, boff8 = lds_byte(wc * 32 + fr, (fq >> 1) * 32 + (fq & 1) * 16) & ~31;
#define PG8_SA(b, h) (((b) * 2 + (h)) * HTB)
#define PG8_SB(b, h) ((4 + (b) * 2 + (h)) * HTB)
#define PG8_STAGE(bufoff, gbase, voff) do { _Pragma("unroll") for (int _i = 0; _i < 2; ++_i) \
        __builtin_amdgcn_global_load_lds((const unsigned*)((const char*)(gbase) + (voff)[_i]), (LAS unsigned*)(lds + (bufoff) + ldsw + _i * 8192), 16, 0, 0); } while (0)
#define PG8_STAGE_B(bufoff, kptr, half) do { if constexpr (Epi::ADJ) { PG8_STAGE(bufoff, kptr, voffBa[half]); } else { PG8_STAGE(bufoff, (kptr) + (half) * hstep, voffB); } } while (0)
#define PG8_STAGE_A(bufoff, kptr, half, VG) do { if constexpr (GATHER) { PG8_STAGE(bufoff, kptr, (VG)[half]); } else { PG8_STAGE(bufoff, (kptr) + (half) * hstep, voffA); } } while (0)
#define PG8_LDA(dst, b, h) do { if constexpr (FP8) { _Pragma("unroll") for (int m = 0; m < 4; ++m) dst##8[m] = cat8(*(const LAS bf16x8*)(lds + PG8_SA(b, h) + aoff8 + m * 2048), *(const LAS bf16x8*)(lds + PG8_SA(b, h) + aoff8 + m * 2048 + 16)); } \
        else { _Pragma("unroll") for (int m = 0; m < 4; ++m) _Pragma("unroll") for (int k = 0; k < 2; ++k) dst[m][k] = *(const LAS bf16x8*)(lds + PG8_SA(b, h) + aoff + m * 2048 + k * 1024); } } while (0)
#define PG8_LDB(dst, b, h) do { if constexpr (FP8) { _Pragma("unroll") for (int n = 0; n < 2; ++n) dst##8[n] = cat8(*(const LAS bf16x8*)(lds + PG8_SB(b, h) + boff8 + n * 2048), *(const LAS bf16x8*)(lds + PG8_SB(b, h) + boff8 + n * 2048 + 16)); } \
        else { _Pragma("unroll") for (int n = 0; n < 2; ++n) _Pragma("unroll") for (int k = 0; k < 2; ++k) dst[n][k] = *(const LAS bf16x8*)(lds + PG8_SB(b, h) + boff + n * 2048 + k * 1024); } } while (0)
#define PG8_MMA(ai, bj, At, Bt) do { __builtin_amdgcn_s_setprio(1); if constexpr (FP8) { _Pragma("unroll") for (int m = 0; m < 4; ++m) _Pragma("unroll") for (int n = 0; n < 2; ++n) \
        asm volatile("v_mfma_scale_f32_16x16x128_f8f6f4 %0, %1, %2, %0, %3, %4 op_sel_hi:[0,0,0]" : "+v"(acc[ai][bj][m][n]) : "v"(Bt##8[n]), "v"(At##8[m]), "v"(sc8w), "v"(sc8)); } \
        else { _Pragma("unroll") for (int k = 0; k < 2; ++k) _Pragma("unroll") for (int m = 0; m < 4; ++m) _Pragma("unroll") for (int n = 0; n < 2; ++n) \
        asm volatile("v_mfma_f32_16x16x32_bf16 %0, %1, %2, %0" : "+v"(acc[ai][bj][m][n]) : "v"(Bt[n][k]), "v"(At[m][k])); } __builtin_amdgcn_s_setprio(0); } while (0)
#define PG8_MMA0(ai, bj, At, Bt) do { __builtin_amdgcn_s_setprio(1); if constexpr (FP8) { _Pragma("unroll") for (int m = 0; m < 4; ++m) _Pragma("unroll") for (int n = 0; n < 2; ++n) \
        asm volatile("v_mfma_scale_f32_16x16x128_f8f6f4 %0, %1, %2, 0, %3, %4 op_sel_hi:[0,0,0]" : "=v"(acc[ai][bj][m][n]) : "v"(Bt##8[n]), "v"(At##8[m]), "v"(sc8w), "v"(sc8)); } \
        else { _Pragma("unroll") for (int m = 0; m < 4; ++m) _Pragma("unroll") for (int n = 0; n < 2; ++n) \
        asm volatile("v_mfma_f32_16x16x32_bf16 %0, %1, %2, 0" : "=v"(acc[ai][bj][m][n]) : "v"(Bt[n][0]), "v"(At[m][0])); \
        _Pragma("unroll") for (int m = 0; m < 4; ++m) _Pragma("unroll") for (int n = 0; n < 2; ++n) \
        asm volatile("v_mfma_f32_16x16x32_bf16 %0, %1, %2, %0" : "+v"(acc[ai][bj][m][n]) : "v"(Bt[n][1]), "v"(At[m][1])); } __builtin_amdgcn_s_setprio(0); } while (0)
#define PG8_WAIT_V(n) asm volatile("s_waitcnt vmcnt(" #n ")" ::: "memory")
#define PG8_WAIT_L(n) asm volatile("s_waitcnt lgkmcnt(" #n ")" ::: "memory")
#define PG8_BAR __builtin_amdgcn_s_barrier()
#define PG8_SCHED __builtin_amdgcn_sched_barrier(0)
    Unit cur, nxt; int ui = 0;
    if (!S.next(0, cur)) return;
    f32x4 acc[2][2][4][2];
#pragma unroll
    for (int a = 0; a < 2; ++a)
#pragma unroll
        for (int b = 0; b < 2; ++b)
#pragma unroll
            for (int m = 0; m < 4; ++m)
#pragma unroll
                for (int n = 0; n < 2; ++n) asm volatile("" : "=v"(acc[a][b][m][n]));
    bf16x8 At[4][2], B0[2][2], B1[2][2]; v8i_t At8[4], B08[2], B18[2]; const int sc8 = 0x7f7f7f7f; int sc8w = 0x7f7f7f7f; if constexpr (FP8) sc8w = Epi::SCW;
    const char* cA = S.a_ptr(cur); const char* cB = S.b_ptr(cur);
    unsigned vcur[2][2] = {{0u, 0u}, {0u, 0u}}, vnext[2][2] = {{0u, 0u}, {0u, 0u}}, vt2[2][2] = {{0u, 0u}, {0u, 0u}};
    if constexpr (GATHER) S.gather(cur, sR[0], sR[1], sC[0], sC[1], 0, vcur);
    PG8_STAGE_B(PG8_SB(0, 0), cB, 0); PG8_STAGE_B(PG8_SB(0, 1), cB, 1); PG8_STAGE_A(PG8_SA(0, 0), cA, 0, vcur); PG8_STAGE_A(PG8_SA(0, 1), cA, 1, vcur);
    if (wr == 1) PG8_BAR;
    PG8_WAIT_V(2); PG8_BAR;
    PG8_STAGE_B(PG8_SB(1, 0), cB + kstep, 0); PG8_STAGE_A(PG8_SA(1, 0), cA + kstep, 0, vcur); PG8_STAGE_B(PG8_SB(1, 1), cB + kstep, 1);
    PG8_WAIT_V(6); PG8_BAR;
    for (;;) {
        const bool has_next = S.next(ui + 1, nxt);
        const char* nA = has_next ? S.a_ptr(nxt) : cA; const char* nB = has_next ? S.b_ptr(nxt) : cB;
        if constexpr (GATHER) { if (has_next) S.gather(nxt, sR[0], sR[1], sC[0], sC[1], 0, vnext); else {
#pragma unroll
            for (int h = 0; h < 2; ++h) { vnext[h][0] = vcur[h][0]; vnext[h][1] = vcur[h][1]; } } }
#define PG8_KITER(t, MM) do { \
            const bool last = (t == nt - 2); \
            const char* a1 = cA + (size_t)(t + 1) * kstep; \
            const char* a2 = last ? nA : cA + (size_t)(t + 2) * kstep; const char* b2 = last ? nB : cB + (size_t)(t + 2) * kstep; \
            const char* a3 = a2 + kstep; const char* b3 = b2 + kstep; \
            if constexpr (GATHER) { \
            _Pragma("unroll") \
                for (int h = 0; h < 2; ++h) { vt2[h][0] = last ? vnext[h][0] : vcur[h][0]; vt2[h][1] = last ? vnext[h][1] : vcur[h][1]; } } \
            PG8_LDB(B0, 0, 0); PG8_LDB(B1, 0, 1); PG8_SCHED; PG8_LDA(At, 0, 0); PG8_STAGE_A(PG8_SA(1, 1), a1, 1, vcur); \
            PG8_WAIT_V(8); PG8_WAIT_L(0); PG8_BAR; MM(0, 0, At, B0); MM(0, 1, At, B1); PG8_BAR; PG8_SCHED; \
            PG8_LDA(At, 0, 1); PG8_STAGE_B(PG8_SB(0, 0), b2, 0); PG8_STAGE_B(PG8_SB(0, 1), b2, 1); PG8_STAGE_A(PG8_SA(0, 0), a2, 0, vt2); \
            PG8_WAIT_V(8); PG8_WAIT_L(0); PG8_BAR; MM(1, 0, At, B0); MM(1, 1, At, B1); PG8_BAR; PG8_SCHED; \
            PG8_LDB(B0, 1, 0); PG8_LDB(B1, 1, 1); PG8_SCHED; PG8_LDA(At, 1, 0); PG8_STAGE_A(PG8_SA(0, 1), a2, 1, vt2); \
            PG8_WAIT_V(8); PG8_WAIT_L(0); PG8_BAR; PG8_MMA(0, 0, At, B0); PG8_MMA(0, 1, At, B1); PG8_BAR; PG8_SCHED; \
            PG8_LDA(At, 1, 1); PG8_STAGE_B(PG8_SB(1, 0), b3, 0); PG8_STAGE_B(PG8_SB(1, 1), b3, 1); PG8_STAGE_A(PG8_SA(1, 0), a3, 0, vt2); \
            PG8_WAIT_V(8); PG8_WAIT_L(0); PG8_BAR; PG8_MMA(1, 0, At, B0); PG8_MMA(1, 1, At, B1); PG8_BAR; PG8_SCHED; \
        } while (0)
        { const int t = 0; PG8_KITER(t, PG8_MMA0); }
        for (int t = 2; t < nt; t += 2) { PG8_KITER(t, PG8_MMA); }
#undef PG8_KITER
        if (wr == 0) PG8_BAR;
        asm volatile("s_nop 15\n\ts_nop 15" ::: "memory");
        for (int rp_ = 0; rp_ < Epi::REPS; ++rp_) E(acc, cur, wr, wc, fr, fq);
        if (!has_next) break;
        cur = nxt; cA = nA; cB = nB; ++ui;
        if constexpr (GATHER) {
#pragma unroll
            for (int h = 0; h < 2; ++h) { vcur[h][0] = vnext[h][0]; vcur[h][1] = vnext[h][1]; } }
        if (wr == 1) PG8_BAR;
    }
    PG8_WAIT_V(0);
    PG8_BAR;
#undef PG8_SA
#undef PG8_SB
#undef PG8_STAGE
#undef PG8_STAGE_A
#undef PG8_STAGE_B
#undef PG8_LDA
#undef PG8_LDB
#undef PG8_MMA
#undef PG8_MMA0
#undef PG8_WAIT_V
#undef PG8_WAIT_L
#undef PG8_BAR
#undef PG8_SCHED
}

__device__ __forceinline__ void store_lines(unsigned char* rowbase  , size_t pitch, int fr, int fq, const u32x4 w0, const u32x4 w1) {
    const bool lo = fr < 8; const u32x4 snd = lo ? w1 : w0; u32x4 rcv;
    rcv.x = __shfl_xor(snd.x, 8); rcv.y = __shfl_xor(snd.y, 8); rcv.z = __shfl_xor(snd.z, 8); rcv.w = __shfl_xor(snd.w, 8);
    unsigned char* p = rowbase + (size_t)(fr & 7) * pitch + (lo ? 0 : 64) + 16 * fq;
    *(u32x4*)p = lo ? w0 : rcv;
    *(u32x4*)(p + 8 * pitch) = lo ? rcv : w1;
}
template <int NP> __device__ __forceinline__ float row_rs(const float* ssq, int row) {
    float s;
    if constexpr (NP == 1) s = ssq[row];
    else { const f32x4* p = (const f32x4*)(ssq + (size_t)row * 16); const f32x4 a = p[0], b = p[1], c = p[2], d = p[3];
        s = (((a[0] + a[1]) + (a[2] + a[3])) + ((b[0] + b[1]) + (b[2] + b[3]))) + (((c[0] + c[1]) + (c[2] + c[3])) + ((d[0] + d[1]) + (d[2] + d[3]))); }
    return __builtin_amdgcn_rsqf(s * (1.0f / D) + RMS_EPS);
}
__device__ __forceinline__ void panel_rs_to_lds(const float* ssq, int pm, LAS float* rsl) {
    if (threadIdx.x < 256) rsl[threadIdx.x] = row_rs<16>(ssq, pm * 256 + (int)threadIdx.x);
    asm volatile("s_waitcnt lgkmcnt(0)" ::: "memory"); __builtin_amdgcn_s_barrier(); asm volatile("" ::: "memory");
}
template <int NP> struct EpiScaleBf16 {
    static constexpr bool PERM = true; static constexpr bool ADJ = true; static constexpr int REPS = 1;
    bf16_t* O; int ldc; const float* ssq; LAS float* rsl;
    __device__ __forceinline__ void operator()(const f32x4 (&acc)[2][2][4][2], const Unit& u, int wr, int wc, int fr, int fq) const {
        const int rowg = u.pm * BM + wr * 64, colw = u.pn * BM + wc * 64;
        if constexpr (NP == 16) panel_rs_to_lds(ssq, u.pm, rsl);
#pragma unroll
        for (int ai = 0; ai < 2; ++ai)
#pragma unroll
            for (int m = 0; m < 4; ++m) { const int row = rowg + ai * HALF + m * 16 + fr; float rs; if constexpr (NP == 16) rs = rsl[wr * 64 + ai * HALF + m * 16 + fr]; else rs = row_rs<NP>(ssq, row);
                u32x4 w[2];
#pragma unroll
                for (int bj = 0; bj < 2; ++bj) { const f32x4 v0 = acc[ai][bj][m][0] * rs, v1 = acc[ai][bj][m][1] * rs;
                    w[bj].x = cvt_pk_bf16(v0[0], v0[1]); w[bj].y = cvt_pk_bf16(v0[2], v0[3]); w[bj].z = cvt_pk_bf16(v1[0], v1[1]); w[bj].w = cvt_pk_bf16(v1[2], v1[3]); }
                store_lines((unsigned char*)(O + (size_t)(rowg + ai * HALF + m * 16) * ldc + colw), (size_t)ldc * 2, fr, fq, w[0], w[1]); }
    }
};
template <bool SSQ, bool BASE32> struct EpiResid {
    static constexpr bool PERM = true; static constexpr bool ADJ = true; static constexpr int REPS = 1;
    const float* base32; bf16_t* xb; float* ssq;
    __device__ __forceinline__ void operator()(const f32x4 (&acc)[2][2][4][2], const Unit& u, int wr, int wc, int fr, int fq) const {
        const int rowg = u.pm * BM + wr * 64, colw = u.pn * BM + wc * 64;
#pragma unroll
        for (int ai = 0; ai < 2; ++ai) {
            float bs[4][2][8];
#pragma unroll
            for (int m = 0; m < 4; ++m)
#pragma unroll
                for (int bj = 0; bj < 2; ++bj) { const size_t off = (size_t)(rowg + ai * HALF + m * 16 + fr) * D + colw + 32 * bj + 8 * fq;
                    if constexpr (BASE32) { const f32x4 a = *(const f32x4*)(base32 + off), b = *(const f32x4*)(base32 + off + 4);
                        bs[m][bj][0] = a[0]; bs[m][bj][1] = a[1]; bs[m][bj][2] = a[2]; bs[m][bj][3] = a[3]; bs[m][bj][4] = b[0]; bs[m][bj][5] = b[1]; bs[m][bj][6] = b[2]; bs[m][bj][7] = b[3]; }
                    else { const u32x4 r = *(const u32x4*)(xb + off);
                        bs[m][bj][0] = __builtin_bit_cast(float, r.x << 16); bs[m][bj][1] = __builtin_bit_cast(float, r.x & 0xffff0000u); bs[m][bj][2] = __builtin_bit_cast(float, r.y << 16); bs[m][bj][3] = __builtin_bit_cast(float, r.y & 0xffff0000u);
                        bs[m][bj][4] = __builtin_bit_cast(float, r.z << 16); bs[m][bj][5] = __builtin_bit_cast(float, r.z & 0xffff0000u); bs[m][bj][6] = __builtin_bit_cast(float, r.w << 16); bs[m][bj][7] = __builtin_bit_cast(float, r.w & 0xffff0000u); } }
            asm volatile("" ::: "memory");
#pragma unroll
            for (int m = 0; m < 4; ++m) { const int row = rowg + ai * HALF + m * 16 + fr; float s = 0.f; u32x4 w[2];
#pragma unroll
                for (int bj = 0; bj < 2; ++bj) { float o[8];
#pragma unroll
                    for (int n = 0; n < 2; ++n)
#pragma unroll
                        for (int j = 0; j < 4; ++j) o[n * 4 + j] = bs[m][bj][n * 4 + j] + acc[ai][bj][m][n][j];
                    w[bj].x = cvt_pk_bf16(o[0], o[1]); w[bj].y = cvt_pk_bf16(o[2], o[3]); w[bj].z = cvt_pk_bf16(o[4], o[5]); w[bj].w = cvt_pk_bf16(o[6], o[7]);
                    if constexpr (SSQ) { const unsigned ww[4] = {w[bj].x, w[bj].y, w[bj].z, w[bj].w};
#pragma unroll
                        for (int q = 0; q < 4; ++q) { const float r0 = __builtin_bit_cast(float, ww[q] << 16), r1 = __builtin_bit_cast(float, ww[q] & 0xffff0000u); s += r0 * r0 + r1 * r1; } } }
                store_lines((unsigned char*)(xb + (size_t)(rowg + ai * HALF + m * 16) * D + colw), (size_t)D * 2, fr, fq, w[0], w[1]);
                if constexpr (SSQ) { s += __shfl_xor(s, 16); s += __shfl_xor(s, 32);
                    if (fq == 0) ssq[(size_t)row * 16 + u.pn * 4 + wc] = s; } }
            asm volatile("" ::: "memory"); }
    }
};
template <int NP> struct EpiSwiglu {
    static constexpr bool PERM = true; static constexpr bool ADJ = false; static constexpr int REPS = REP_EPI;
    bf16_t* O; int ldc; const float* ssq; LAS float* rsl;
    __device__ __forceinline__ void operator()(const f32x4 (&acc)[2][2][4][2], const Unit& u, int wr, int wc, int fr, int fq) const {
        const int row0 = u.pm * BM + wr * 64 + fr, col0 = u.pn * HALF + wc * 32 + 8 * fq;
        if constexpr (NP == 16) panel_rs_to_lds(ssq, u.pm, rsl);
#pragma unroll
        for (int ai = 0; ai < 2; ++ai)
#pragma unroll
            for (int m = 0; m < 4; ++m) { const int row = row0 + ai * HALF + m * 16; float rs; if constexpr (NP == 16) rs = rsl[wr * 64 + fr + ai * HALF + m * 16]; else rs = row_rs<NP>(ssq, row);
                float h[8];
#pragma unroll
                for (int n = 0; n < 2; ++n)
#pragma unroll
                    for (int j = 0; j < 4; j += 2) { const f32x2 hh = swiglu2((f32x2){acc[ai][0][m][n][j], acc[ai][0][m][n][j + 1]}, (f32x2){acc[ai][1][m][n][j], acc[ai][1][m][n][j + 1]}, rs); h[n * 4 + j] = hh.x; h[n * 4 + j + 1] = hh.y; }
                u32x4 w; w.x = cvt_pk_bf16(h[0], h[1]); w.y = cvt_pk_bf16(h[2], h[3]); w.z = cvt_pk_bf16(h[4], h[5]); w.w = cvt_pk_bf16(h[6], h[7]);
                *(u32x4*)(O + (size_t)row * ldc + col0) = w; }
    }
};
struct EpiSwigluMoe {
    static constexpr bool PERM = true; static constexpr bool ADJ = false; static constexpr int REPS = 1; static constexpr int SCW = 0x7f7f7f7f;
    bf16_t* O; int ldc; const float* rsv; const int* row_tok; float wsinv;
    __device__ __forceinline__ void operator()(const f32x4 (&acc)[2][2][4][2], const Unit& u, int wr, int wc, int fr, int fq) const {
        const int row0 = u.pm * BM + wr * 64 + fr, col0 = u.pn * HALF + wc * 32 + 8 * fq;
#pragma unroll
        for (int ai = 0; ai < 2; ++ai)
#pragma unroll
            for (int m = 0; m < 4; ++m) { const int row = row0 + ai * HALF + m * 16; const int tok = row_tok[row]; const float rs = tok >= 0 ? rsv[tok] * wsinv : 0.f;
                float h[8];
#pragma unroll
                for (int n = 0; n < 2; ++n)
#pragma unroll
                    for (int j = 0; j < 4; j += 2) { const f32x2 hh = swiglu2((f32x2){acc[ai][0][m][n][j], acc[ai][0][m][n][j + 1]}, (f32x2){acc[ai][1][m][n][j], acc[ai][1][m][n][j + 1]}, rs); h[n * 4 + j] = hh.x; h[n * 4 + j + 1] = hh.y; }
                u32x4 w; w.x = cvt_pk_bf16(h[0], h[1]); w.y = cvt_pk_bf16(h[2], h[3]); w.z = cvt_pk_bf16(h[4], h[5]); w.w = cvt_pk_bf16(h[6], h[7]);
                *(u32x4*)(O + (size_t)row * ldc + col0) = w; }
    }
};
struct EpiSwigluMoe8 {
    static constexpr bool PERM = true; static constexpr bool ADJ = false; static constexpr int REPS = 1; static constexpr int SCW = 0x79797979;
    unsigned char* O; int ldc;
    __device__ __forceinline__ void operator()(const f32x4 (&acc)[2][2][4][2], const Unit& u, int wr, int wc, int fr, int fq) const {
        const int row0 = u.pm * BM + wr * 64 + fr, col0 = u.pn * HALF + wc * 32 + 8 * fq;
        constexpr float K = -1.44269504f;
#pragma unroll
        for (int ai = 0; ai < 2; ++ai)
#pragma unroll
            for (int mp = 0; mp < 4; mp += 2) { u32x2 w[2];
#pragma unroll
                for (int mm = 0; mm < 2; ++mm) { const int m = mp + mm; float h[8];
#pragma unroll
                    for (int n = 0; n < 2; ++n)
#pragma unroll
                        for (int j = 0; j < 4; j += 2) { const f32x2 a = {acc[ai][0][m][n][j], acc[ai][0][m][n][j + 1]}, uu = {acc[ai][1][m][n][j], acc[ai][1][m][n][j + 1]};
                            f32x2 e; e.x = __builtin_amdgcn_exp2f(a.x); e.y = __builtin_amdgcn_exp2f(a.y);
                            const f32x2 d = e * K + K, p = a * uu; f32x2 r; r.x = __builtin_amdgcn_rcpf(d.x); r.y = __builtin_amdgcn_rcpf(d.y);
                            const f32x2 hh = p * r; h[n * 4 + j] = hh.x; h[n * 4 + j + 1] = hh.y; }
                    w[mm].x = pk4_fp8(h[0], h[1], h[2], h[3]); w[mm].y = pk4_fp8(h[4], h[5], h[6], h[7]); }
                const auto sx = __builtin_amdgcn_permlane16_swap(w[0].x, w[1].x, false, false), sy = __builtin_amdgcn_permlane16_swap(w[0].y, w[1].y, false, false);
                u32x4 o; o.x = sx[0]; o.y = sy[0]; o.z = sx[1]; o.w = sy[1];
                *(u32x4*)(O + (size_t)(row0 + ai * HALF + (mp + (fq & 1)) * 16) * ldc + col0 - 8 * (fq & 1)) = o; }
    }
};
struct EpiMoeDown {
    static constexpr bool PERM = true; static constexpr bool ADJ = false; static constexpr int REPS = 1; static constexpr int SCW = 0x7f7f7f7f;
    bf16_t* out; const int* row_tok; const float* row_gate; float sc; LAS int* tkl;
    __device__ __forceinline__ void operator()(const f32x4 (&acc)[2][2][4][2], const Unit& u, int wr, int wc, int fr, int fq) const {
        const int col0 = u.pn * BM + wc * 32 + 8 * fq;
        if (threadIdx.x < 256) { tkl[threadIdx.x] = row_tok[u.pm * BM + (int)threadIdx.x]; ((LAS float*)tkl)[256 + threadIdx.x] = row_gate[u.pm * BM + (int)threadIdx.x]; }
        asm volatile("s_waitcnt lgkmcnt(0)" ::: "memory"); __builtin_amdgcn_s_barrier(); asm volatile("" ::: "memory");
        int tk[2][4]; float gt[2][4];
#pragma unroll
        for (int ai = 0; ai < 2; ++ai)
#pragma unroll
            for (int m = 0; m < 4; ++m) { const int rl = wr * 64 + fr + ai * HALF + m * 16; tk[ai][m] = tkl[rl]; gt[ai][m] = ((const LAS float*)tkl)[256 + rl]; }
#pragma unroll
        for (int ai = 0; ai < 2; ++ai) {
            u32x4 cur[4][2];
#pragma unroll
            for (int m = 0; m < 4; ++m) { const int tok = tk[ai][m] < 0 ? 0 : tk[ai][m];
#pragma unroll
                for (int bj = 0; bj < 2; ++bj) cur[m][bj] = *(const u32x4*)(out + (size_t)tok * D + col0 + bj * HALF); }
            asm volatile("" ::: "memory");
#pragma unroll
            for (int m = 0; m < 4; ++m) { const int tok = tk[ai][m]; const float g = gt[ai][m] * sc;
                if (tok >= 0) { bf16_t* rp = out + (size_t)tok * D + col0;
#pragma unroll
                    for (int bj = 0; bj < 2; ++bj) { const u32x4 r = cur[m][bj]; const f32x4 a0 = acc[ai][bj][m][0] * g, a1 = acc[ai][bj][m][1] * g; u32x4 w;
                        w.x = cvt_pk_bf16(__builtin_bit_cast(float, r.x << 16) + a0[0], __builtin_bit_cast(float, r.x & 0xffff0000u) + a0[1]);
                        w.y = cvt_pk_bf16(__builtin_bit_cast(float, r.y << 16) + a0[2], __builtin_bit_cast(float, r.y & 0xffff0000u) + a0[3]);
                        w.z = cvt_pk_bf16(__builtin_bit_cast(float, r.z << 16) + a1[0], __builtin_bit_cast(float, r.z & 0xffff0000u) + a1[1]);
                        w.w = cvt_pk_bf16(__builtin_bit_cast(float, r.w << 16) + a1[2], __builtin_bit_cast(float, r.w & 0xffff0000u) + a1[3]);
                        *(u32x4*)(rp + bj * HALF) = w; } } }
            asm volatile("" ::: "memory"); }
    }
};
}

#define XB_TMO      128
#define XB_XCNT(j)  (256  + 64 * (j))
#define XB_XSUB(j)  (1280 + 64 * (j))
#define XB_XGEN(j)  (2304 + 64 * (j))
#define XB_TOP      3328
#define XB_TOPGEN   3392
#define XCD_BAR_WORDS 3456
#define XB_SPIN_CAP (1u << 18)
__device__ __forceinline__ unsigned xb_ld(unsigned* p)              { return __hip_atomic_load(p, __ATOMIC_RELAXED, __HIP_MEMORY_SCOPE_AGENT); }
__device__ __forceinline__ unsigned xb_add(unsigned* p, unsigned v) { return __hip_atomic_fetch_add(p, v, __ATOMIC_RELAXED, __HIP_MEMORY_SCOPE_AGENT); }
__device__ __forceinline__ unsigned xb_xcc_id() { return (unsigned)__builtin_amdgcn_s_getreg((3 << 11) | 20) & 0xFu; }
#define XB_SPIN(cond, bar) do { unsigned _sp = 0; while (cond) { __builtin_amdgcn_s_sleep(1); \
    if ((++_sp & 255u) == 0u) { if (xb_ld(&(bar)[XB_TMO])) break; if (_sp > XB_SPIN_CAP) { atomicAdd(&(bar)[XB_TMO], 1u); break; } } } } while (0)
struct XcdBarrier { unsigned* bar; unsigned x; volatile LAS unsigned* st; };
__device__ __forceinline__ XcdBarrier xcd_barrier_post(unsigned* bar, volatile LAS unsigned* st) {
    XcdBarrier b; b.bar = bar; b.x = xb_xcc_id(); b.st = st;
    if (threadIdx.x == 0) (void)xb_add(&bar[XB_XCNT(b.x)], 1u);
    return b;
}
__device__ __forceinline__ void xcd_barrier_complete(unsigned* bar, unsigned x, unsigned& nloc, unsigned& nx) {
    const unsigned G = gridDim.x * gridDim.y * gridDim.z;
    unsigned sum, cnt, mine, sp = 0u;
    for (;;) {
        sum = 0u; cnt = 0u; mine = 0u;
#pragma unroll
        for (unsigned j = 0; j < 16; ++j) { const unsigned c = xb_ld(&bar[XB_XCNT(j)]); sum += c; cnt += (c > 0u) ? 1u : 0u; mine = (j == x) ? c : mine; }
        if (sum == G) break;
        __builtin_amdgcn_s_sleep(1);
        if ((++sp & 255u) == 0u) { if (xb_ld(&bar[XB_TMO])) break; if (sp > XB_SPIN_CAP) { atomicAdd(&bar[XB_TMO], 1u); break; } }
    }
    nloc = mine > 0u ? mine : 1u; nx = cnt > 0u ? cnt : 1u;
}
__device__ __forceinline__ void xcd_barrier(const XcdBarrier& b) {
    asm volatile("s_waitcnt vmcnt(0)" ::: "memory");
    __syncthreads();
    if (threadIdx.x == 0) {
        unsigned* bar = b.bar;
        __builtin_amdgcn_s_waitcnt(0);
        unsigned nloc = b.st[0], nx = b.st[1];
        if (nloc == 0u) { xcd_barrier_complete(bar, b.x, nloc, nx); b.st[0] = nloc; b.st[1] = nx; }
        const unsigned old = xb_add(&bar[XB_XSUB(b.x)], 1u);
        const unsigned gen = old / nloc;
        if (old + 1u == (gen + 1u) * nloc) {
            __builtin_amdgcn_fence(__ATOMIC_RELEASE, "agent");
            asm volatile("s_waitcnt vmcnt(0)" ::: "memory");
            const unsigned og = xb_add(&bar[XB_TOP], 1u);
            const unsigned tg = og / nx;
            if (og + 1u == (tg + 1u) * nx) xb_add(&bar[XB_TOPGEN], 1u);
            else XB_SPIN(xb_ld(&bar[XB_TOPGEN]) == tg, bar);
            __builtin_amdgcn_fence(__ATOMIC_ACQUIRE, "agent");
            xb_add(&bar[XB_XGEN(b.x)], 1u);
            asm volatile("s_waitcnt vmcnt(0)" ::: "memory");
        } else {
            XB_SPIN(xb_ld(&bar[XB_XGEN(b.x)]) == gen, bar);
            __builtin_amdgcn_fence(__ATOMIC_ACQUIRE, "agent");
            asm volatile("s_waitcnt vmcnt(0)" ::: "memory");
        }
    }
    __syncthreads();
}

__device__ __forceinline__ void hnd_arrive(unsigned* w) {
    asm volatile("s_waitcnt vmcnt(0)" ::: "memory");
    __syncthreads();
    if (threadIdx.x == 0) { __builtin_amdgcn_fence(__ATOMIC_RELEASE, "agent"); asm volatile("s_waitcnt vmcnt(0)" ::: "memory"); (void)xb_add(w, 1u); }
}
__device__ __forceinline__ void hnd_wait(unsigned* w, unsigned target, unsigned* bar) {
    if (threadIdx.x == 0) { XB_SPIN(xb_ld(w) < target, bar); __builtin_amdgcn_fence(__ATOMIC_ACQUIRE, "agent"); asm volatile("s_waitcnt vmcnt(0)" ::: "memory"); }
    __syncthreads();
}

constexpr int NIN = 28;
struct Args { const float* in[NIN]; float* out; unsigned char* ws; int ph_lo, ph_hi; };
enum { I_X = 0, I_NORM_MIX, I_W_IN, I_W_OUT, I_SHIFT_MU, I_GM_LN_W, I_GM_LN_B, I_GM_WS, I_GM_BS, I_RW_W_UP, I_RW_W0, I_RW_A_UP, I_RW_A0, I_RW_G_UP, I_RW_K_K, I_RW_K_A, I_RW_R_K,
       I_RW_LNX_W, I_RW_LNX_B, I_NORM_FFN, I_FFN_WG, I_FFN_WU, I_FFN_WD, I_MOE_ROUTER, I_MOE_WG, I_MOE_WU, I_MOE_WD, I_NORM_FINAL };

struct Frame {
    LAS unsigned char* lds;
    int tid, lane, wave, G, gw, NGW;
};

struct CvItem { f32x4 v[8]; float gn[8]; };
__device__ __forceinline__ void cv_load(CvItem& it, const float* W, int N, int k0, int n0, const float* gain, float scale, int lane) {
    const int kr = lane >> 3, nq = lane & 7;
#pragma unroll
    for (int i = 0; i < 8; ++i) { it.v[i] = *(const GAS f32x4*)(W + (size_t)(k0 + 8 * i + kr) * N + n0 + 4 * nq); it.gn[i] = gain ? gain[k0 + 8 * i + kr] * scale : scale; }
}
__device__ __forceinline__ void cv_store_fp8(const CvItem& it, int K, unsigned char* WT, int drow0, int k0, LAS float* scr, int lane) {
    { const int kr = lane >> 3, nq = lane & 7;
#pragma unroll
      for (int i = 0; i < 8; ++i) { LAS float* d = scr + (8 * i + kr) * 33 + 4 * nq; d[0] = it.v[i][0] * it.gn[i]; d[1] = it.v[i][1] * it.gn[i]; d[2] = it.v[i][2] * it.gn[i]; d[3] = it.v[i][3] * it.gn[i]; } }
    LDS_WAIT(); asm volatile("" ::: "memory");
    const int n = lane >> 1, hf = lane & 1; const LAS float* sp = scr + (32 * hf) * 33 + n; u32x4 o0, o1;
    o0.x = pk4_fp8(sp[0 * 33], sp[1 * 33], sp[2 * 33], sp[3 * 33]); o0.y = pk4_fp8(sp[4 * 33], sp[5 * 33], sp[6 * 33], sp[7 * 33]); o0.z = pk4_fp8(sp[8 * 33], sp[9 * 33], sp[10 * 33], sp[11 * 33]); o0.w = pk4_fp8(sp[12 * 33], sp[13 * 33], sp[14 * 33], sp[15 * 33]);
    o1.x = pk4_fp8(sp[16 * 33], sp[17 * 33], sp[18 * 33], sp[19 * 33]); o1.y = pk4_fp8(sp[20 * 33], sp[21 * 33], sp[22 * 33], sp[23 * 33]); o1.z = pk4_fp8(sp[24 * 33], sp[25 * 33], sp[26 * 33], sp[27 * 33]); o1.w = pk4_fp8(sp[28 * 33], sp[29 * 33], sp[30 * 33], sp[31 * 33]);
    unsigned char* dst = WT + (size_t)(drow0 + n) * K + k0 + 32 * hf; *(GAS u32x4*)dst = o0; *(GAS u32x4*)(dst + 16) = o1;
    LDS_WAIT(); asm volatile("" ::: "memory");
}
__device__ __forceinline__ void transpose_item(const float* W, int K, int N, bf16* WT, int drow0, int k0, int n0, const float* gain, LAS float* scr, int lane) {
    { const int kr = lane >> 3, nq = lane & 7; f32x4 v[8]; float gn[8];
#pragma unroll
      for (int i = 0; i < 8; ++i) { v[i] = *(const GAS f32x4*)(W + (size_t)(k0 + 8 * i + kr) * N + n0 + 4 * nq); gn[i] = gain ? gain[k0 + 8 * i + kr] : 1.f; }
#pragma unroll
      for (int i = 0; i < 8; ++i) { LAS float* d = scr + (8 * i + kr) * 33 + 4 * nq; d[0] = v[i][0] * gn[i]; d[1] = v[i][1] * gn[i]; d[2] = v[i][2] * gn[i]; d[3] = v[i][3] * gn[i]; } }
    LDS_WAIT(); asm volatile("" ::: "memory");
    const int c = lane & 7;
#pragma unroll
    for (int j = 0; j < 4; ++j) { const int n = (lane >> 3) + 8 * j; const LAS float* s = scr + (8 * c) * 33 + n;
        u32x4 o; o.x = pk2(s[0 * 33], s[1 * 33]); o.y = pk2(s[2 * 33], s[3 * 33]); o.z = pk2(s[4 * 33], s[5 * 33]); o.w = pk2(s[6 * 33], s[7 * 33]);
        *(GAS u32x4*)(WT + (size_t)(drow0 + n) * K + k0 + 8 * c) = o; }
    LDS_WAIT(); asm volatile("" ::: "memory");
}
__device__ __forceinline__ void convert_matrix_fp8(Frame& F, const float* W, int K, int N, unsigned char* WT, int gu_mode  , const float* gain, float scale, int& itbase) {
    LAS float* scr = (LAS float*)(F.lds + F.wave * 16384);
    const int nblk = N / 32, nit = (K / 64) * nblk;
    int first = F.gw - (itbase % F.NGW); if (first < 0) first += F.NGW;
    CvItem nx;
    if (first < nit) cv_load(nx, W, N, 64 * (first / nblk), 32 * (first % nblk), gain, scale, F.lane);
    for (int r = first; r < nit; r += F.NGW) { const int kb = r / nblk, nb = r % nblk, n0 = 32 * nb;
        const int drow0 = gu_mode == 0 ? n0 : (n0 / 128) * 256 + (gu_mode == 2 ? 128 : 0) + (n0 % 128);
        const CvItem cur = nx; const int r2 = r + F.NGW;
        if (r2 < nit) cv_load(nx, W, N, 64 * (r2 / nblk), 32 * (r2 % nblk), gain, scale, F.lane);
        cv_store_fp8(cur, K, WT, drow0, 64 * kb, scr, F.lane); }
    itbase += nit;
}
__device__ __forceinline__ void convert_matrix(Frame& F, const float* W, int K, int N, bf16* WT, int gu_mode  , const float* gain, int it0, int& itbase) {
    LAS float* scr = (LAS float*)(F.lds + F.wave * 16384);
    const int nblk = N / 32, nit = (K / 64) * nblk;
    int first = F.gw - (itbase % F.NGW); if (first < 0) first += F.NGW;
    for (int r = first; r < nit; r += F.NGW) { const int kb = r / nblk, nb = r % nblk, n0 = 32 * nb;
        const int drow0 = gu_mode == 0 ? n0 : (n0 / 128) * 256 + (gu_mode == 2 ? 128 : 0) + (n0 % 128);
        transpose_item(W, K, N, WT, drow0, 64 * kb, n0, gain, scr, F.lane); }
    itbase += nit; (void)it0;
}

__device__ __forceinline__ void gmlp_naive(Frame& F, const bf16* P, bf16* Y, const float* ln_w, const float* ln_b, const float* ws, const float* bs) {
    LAS float* V = (LAS float*)F.lds;
    for (int unit = blockIdx.x; unit < NB * (SEQ / GCH) * NH; unit += F.G) {
        const int h = unit % NH, bc = unit / NH; const size_t row0 = (size_t)bc * GCH;
        const float lw = ln_w[h * HD + F.lane], lb = ln_b[h * HD + F.lane];
        for (int i = 0; i < 16; ++i) { const int t = F.wave * 16 + i;
            const float g = gelu_erf(bf2f(P[(row0 + t) * INW + GMW + h * HD + F.lane]));
            const float mean = wave_sum(g) * (1.f / HD); const float d = g - mean; const float var = wave_sum(d * d) * (1.f / HD);
            V[t * HD + F.lane] = d * __builtin_amdgcn_rsqf(var + LN_EPS) * lw + lb; }
        __syncthreads();
        for (int i = 0; i < 16; ++i) { const int t = F.wave * 16 + i; const float* wrow = ws + ((size_t)h * GCH + t) * GCH; float acc = 0.f;
            for (int s = 0; s <= t; ++s) acc += wrow[s] * V[s * HD + F.lane];
            const float mixed = acc + bs[h * GCH + t];
            const float u = gelu_erf(bf2f(P[(row0 + t) * INW + h * HD + F.lane]));
            Y[(row0 + t) * D + h * HD + F.lane] = (bf16)f2bf(u * mixed); }
        __syncthreads();
    }
}
__device__ __forceinline__ float shifted(const bf16* P, size_t row, int t, int col, const float* mu) {
    const float c = bf2f(P[row * INW + col]); const float pr = t > 0 ? bf2f(P[(row - 1) * INW + col]) : 0.f;
    return c + (pr - c) * mu[col - 1024];
}
constexpr int NC = 32;
__device__ __forceinline__ void rwkv_naive(Frame& F, const bf16* P, bf16* Y, const float* mu, const float* w_up, const float* w0, const float* a_up, const float* a0, const float* g_up,
                                           const float* k_k, const float* k_a, const float* r_k, const float* lnx_w, const float* lnx_b) {
    LAS float* LI = (LAS float*)F.lds;
    LAS float* sR = LI + NC * 256; LAS float* sW = sR + NC * 64; LAS float* sK = sW + NC * 64; LAS float* sV = sK + NC * 64; LAS float* sA = sV + NC * 64; LAS float* sB = sA + NC * 64;
    LAS float* sG = sB + NC * 64; LAS float* sBon = sG + NC * 64;
    for (int unit = blockIdx.x; unit < NB * NH; unit += F.G) {
        const int b = unit / NH, h = unit % NH;
        float S[64];
#pragma unroll
        for (int k = 0; k < 64; ++k) S[k] = 0.f;
        for (int c = 0; c < SEQ / NC; ++c) {
            const int t0 = c * NC; const size_t row0 = (size_t)b * SEQ + t0;
            for (int idx = F.tid; idx < NC * 256; idx += 512) { const int tok = idx >> 8, j = idx & 255;
                const float x = shifted(P, row0 + tok, t0 + tok, 2560 + j, mu);
                LI[idx] = j < 64 ? tanhf(x) : (j < 128 ? x : sigmoidf_(x)); }
            __syncthreads();
            { const int ch = F.lane, hc = h * HD + ch;
              for (int i = 0; i < NC / 8; ++i) { const int tok = F.wave + 8 * i; const size_t row = row0 + tok; const int t = t0 + tok;
                const float rr = shifted(P, row, t, 1024 + hc, mu), kx = shifted(P, row, t, 1536 + hc, mu), vv = shifted(P, row, t, 2048 + hc, mu);
                float dw = w0[hc], da = a0[hc], gg = 0.f;
                for (int j = 0; j < 64; ++j) { dw += LI[tok * 256 + j] * w_up[j * RWW + hc]; da += LI[tok * 256 + 64 + j] * a_up[j * RWW + hc]; }
                for (int j = 0; j < 128; ++j) gg += LI[tok * 256 + 128 + j] * g_up[j * RWW + hc];
                const float z = -dw; const float sp = fmaxf(z, 0.f) + log1pf(__expf(-fabsf(z)));
                const float decay = __expf(-__expf(-sp - 0.5f));
                const float alr = sigmoidf_(da);
                const float kkv = kx * k_k[hc]; const float nrm = sqrtf(wave_sum(kkv * kkv)); const float kkn = kkv / fmaxf(nrm, 1e-12f);
                const float kmod = kx * (1.f + (alr - 1.f) * k_a[hc]);
                const float bsc = wave_sum(rr * kmod * r_k[hc]);
                sR[tok * 64 + ch] = rr; sW[tok * 64 + ch] = decay; sK[tok * 64 + ch] = kmod; sV[tok * 64 + ch] = vv; sA[tok * 64 + ch] = -kkn; sB[tok * 64 + ch] = kkn * alr;
                sG[tok * 64 + ch] = gg; sBon[tok * 64 + ch] = bsc * vv; } }
            __syncthreads();
            if (F.wave == 0) {
                for (int t = 0; t < NC; ++t) { float sa = 0.f;
#pragma unroll
                    for (int k = 0; k < 64; ++k) sa += S[k] * sA[t * 64 + k];
                    const float vv = sV[t * 64 + F.lane]; float yv = 0.f;
#pragma unroll
                    for (int k = 0; k < 64; ++k) { S[k] = S[k] * sW[t * 64 + k] + sa * sB[t * 64 + k] + vv * sK[t * 64 + k]; yv += S[k] * sR[t * 64 + k]; }
                    LI[t * 64 + F.lane] = yv; }
            }
            __syncthreads();
            { const int v = F.lane, hv = h * HD + v;
              for (int i = 0; i < NC / 8; ++i) { const int tok = F.wave + 8 * i; const float yv = LI[tok * 64 + v];
                const float mean = wave_sum(yv) * (1.f / HD); const float d = yv - mean; const float var = wave_sum(d * d) * (1.f / HD);
                const float yn = d * __builtin_amdgcn_rsqf(var + GN_EPS) * lnx_w[hv] + lnx_b[hv];
                Y[(row0 + tok) * D + GMW + hv] = (bf16)f2bf((yn + sBon[tok * 64 + v]) * sG[tok * 64 + v]); } }
            __syncthreads();
        }
    }
}

typedef short s16x4 __attribute__((ext_vector_type(4)));
typedef short v4i16_t __attribute__((ext_vector_type(4)));
#define MFMA32(a, b, c) __builtin_amdgcn_mfma_f32_16x16x32_bf16((a), (b), (c), 0, 0, 0)
#define MFMA16(a, b, c) __builtin_amdgcn_mfma_f32_16x16x16bf16_1k((a), (b), (c), 0, 0, 0)
__device__ __forceinline__ bf16x8 lds_row8(const LAS bf16* T, int ld, int r0, int k0, int lane) { return *(const LAS bf16x8*)(T + (r0 + (lane & 15)) * ld + k0 + 8 * (lane >> 4)); }
__device__ __forceinline__ s16x4 lds_row4(const LAS bf16* T, int ld, int r0, int k0, int lane) { return *(const LAS s16x4*)(T + (r0 + (lane & 15)) * ld + k0 + 4 * (lane >> 4)); }
__device__ __forceinline__ s16x4 lds_tr4(const LAS bf16* T, int ld, int k0, int c0, int lane) { const int i = lane & 15, g = lane >> 4;
    return __builtin_bit_cast(s16x4, __builtin_amdgcn_ds_read_tr16_b64_v4i16((LAS v4i16_t*)(T + (k0 + 4 * g + (i >> 2)) * ld + c0 + 4 * (i & 3)))); }
__device__ __forceinline__ bf16x8 lds_tr8(const LAS bf16* T, int ld, int k0, int c0, int lane) { const int i = lane & 15, g = lane >> 4;
    const LAS bf16* p = T + (k0 + 8 * g + (i >> 2)) * ld + c0 + 4 * (i & 3);
    const s16x4 lo = __builtin_bit_cast(s16x4, __builtin_amdgcn_ds_read_tr16_b64_v4i16((LAS v4i16_t*)p));
    const s16x4 hi = __builtin_bit_cast(s16x4, __builtin_amdgcn_ds_read_tr16_b64_v4i16((LAS v4i16_t*)(p + 4 * ld)));
    bf16x8 r; r[0] = lo[0]; r[1] = lo[1]; r[2] = lo[2]; r[3] = lo[3]; r[4] = hi[0]; r[5] = hi[1]; r[6] = hi[2]; r[7] = hi[3]; return r; }
typedef __bf16 bf16x2_t __attribute__((ext_vector_type(2)));
__device__ __forceinline__ unsigned cvtpk_c(float lo, float hi) { const f32x2 v = {lo, hi}; const bf16x2_t b = __builtin_convertvector(v, bf16x2_t); return __builtin_bit_cast(unsigned, b); }
__device__ __forceinline__ s16x4 pack4(const f32x4 v) { u32x2 w; w.x = cvtpk_c(v[0], v[1]); w.y = cvtpk_c(v[2], v[3]); return __builtin_bit_cast(s16x4, w); }
__device__ __forceinline__ f32x4 unpack4(const s16x4 v) { f32x4 r; r[0] = bf2f((bf16)v[0]); r[1] = bf2f((bf16)v[1]); r[2] = bf2f((bf16)v[2]); r[3] = bf2f((bf16)v[3]); return r; }
__device__ __forceinline__ void unpack8(const u32x4 w, float (&o)[8]) { o[0] = __builtin_bit_cast(float, w.x << 16); o[1] = __builtin_bit_cast(float, w.x & 0xffff0000u); o[2] = __builtin_bit_cast(float, w.y << 16); o[3] = __builtin_bit_cast(float, w.y & 0xffff0000u);
    o[4] = __builtin_bit_cast(float, w.z << 16); o[5] = __builtin_bit_cast(float, w.z & 0xffff0000u); o[6] = __builtin_bit_cast(float, w.w << 16); o[7] = __builtin_bit_cast(float, w.w & 0xffff0000u); }
__device__ __forceinline__ u32x4 pack8(const float (&v)[8]) { u32x4 w; w.x = cvtpk_c(v[0], v[1]); w.y = cvtpk_c(v[2], v[3]); w.z = cvtpk_c(v[4], v[5]); w.w = cvtpk_c(v[6], v[7]); return w; }
__device__ __forceinline__ float gelu_as(float v) {
    const float av = fabsf(v), t = __builtin_amdgcn_rcpf(av * 0.2316418882f + 1.0f);
    float q = t * 0.5307027145f + (-0.7265760135f); q = q * t + 0.7107068705f; q = q * t + (-0.142248368f); q = q * t + 0.127414796f; q = q * t;
    const float e = __builtin_amdgcn_exp2f((v * v) * (-0.72134752044f)); const float m = v * (q * e); return v < 0.f ? m : v - m;
}

__device__ __forceinline__ f32x2 gelu_pk2(f32x2 v) {
    const f32x2 av = __builtin_elementwise_abs(v), d = av * 0.2316418882f + 1.0f;
    f32x2 t; t.x = __builtin_amdgcn_rcpf(d.x); t.y = __builtin_amdgcn_rcpf(d.y);
    f32x2 q = t * 0.5307027145f + (-0.7265760135f); q = q * t + 0.7107068705f; q = q * t + (-0.142248368f); q = q * t + 0.127414796f; q = q * t;
    const f32x2 s2 = (v * v) * (-0.72134752044f);
    f32x2 e; e.x = __builtin_amdgcn_exp2f(s2.x); e.y = __builtin_amdgcn_exp2f(s2.y);
    const f32x2 m = v * (q * e), r = v - m;
    f32x2 o; o.x = v.x < 0.f ? m.x : r.x; o.y = v.y < 0.f ? m.y : r.y; return o;
}
constexpr int GM_V = 0, GM_U = 128 * 72 * 2;
__device__ __forceinline__ void gmlp_unit(Frame& F, int unit, const bf16* P, bf16* Y, const float* ln_w, const float* ln_b, const bf16* WsB, const float* bs) {
    LAS bf16* Vt = (LAS bf16*)(F.lds + GM_V); LAS bf16* Ut = (LAS bf16*)(F.lds + GM_U);
    const int h = unit % NH, bc = unit / NH; const size_t row0 = (size_t)bc * GCH;
    { const int t = F.tid >> 2, cq = F.tid & 3; const bf16* pr = P + (row0 + t) * INW + h * HD + 16 * cq;
      const u32x4 u0 = *(const u32x4*)pr, u1 = *(const u32x4*)(pr + 8), v0 = *(const u32x4*)(pr + GMW), v1 = *(const u32x4*)(pr + GMW + 8);
      float uu[16], vv[16]; { float a[8]; unpack8(u0, a); for (int j = 0; j < 8; ++j) uu[j] = a[j]; unpack8(u1, a); for (int j = 0; j < 8; ++j) uu[8 + j] = a[j]; unpack8(v0, a); for (int j = 0; j < 8; ++j) vv[j] = a[j]; unpack8(v1, a); for (int j = 0; j < 8; ++j) vv[8 + j] = a[j]; }
      float s = 0.f;
#pragma unroll
      for (int j = 0; j < 16; ++j) { uu[j] = gelu_as(uu[j]); vv[j] = gelu_as(vv[j]); s += vv[j]; }
      s += __shfl_xor(s, 1); s += __shfl_xor(s, 2); const float mean = s * (1.f / HD); float q = 0.f;
#pragma unroll
      for (int j = 0; j < 16; ++j) { vv[j] -= mean; q += vv[j] * vv[j]; }
      q += __shfl_xor(q, 1); q += __shfl_xor(q, 2); const float rstd = __builtin_amdgcn_rsqf(q * (1.f / HD) + LN_EPS);
#pragma unroll
      for (int j = 0; j < 16; ++j) vv[j] = vv[j] * rstd * ln_w[h * HD + 16 * cq + j] + ln_b[h * HD + 16 * cq + j];
      float a[8]; for (int j = 0; j < 8; ++j) a[j] = vv[j]; *(LAS u32x4*)(Vt + t * 72 + 16 * cq) = pack8(a); for (int j = 0; j < 8; ++j) a[j] = vv[8 + j]; *(LAS u32x4*)(Vt + t * 72 + 16 * cq + 8) = pack8(a);
      for (int j = 0; j < 8; ++j) a[j] = uu[j]; *(LAS u32x4*)(Ut + t * 72 + 16 * cq) = pack8(a); for (int j = 0; j < 8; ++j) a[j] = uu[8 + j]; *(LAS u32x4*)(Ut + t * 72 + 16 * cq + 8) = pack8(a); }
    __syncthreads();
    { const int w = F.wave, l15 = F.lane & 15, g = F.lane >> 4, t0 = 16 * w, nks = (w >> 1) + 1; const bf16* wrow = WsB + ((size_t)h * GCH + t0 + l15) * GCH + 8 * g;
      f32x4 acc[4] = {{0.f, 0.f, 0.f, 0.f}, {0.f, 0.f, 0.f, 0.f}, {0.f, 0.f, 0.f, 0.f}, {0.f, 0.f, 0.f, 0.f}};
      for (int ks = 0; ks < nks; ++ks) { const bf16x8 a = *(const bf16x8*)(wrow + 32 * ks);
#pragma unroll
          for (int nt = 0; nt < 4; ++nt) acc[nt] = MFMA32(a, lds_tr8(Vt, 72, 32 * ks, 16 * nt, F.lane), acc[nt]); }
#pragma unroll
      for (int reg = 0; reg < 4; ++reg) { const int t = t0 + 4 * g + reg; const float bsv = bs[h * GCH + t];
#pragma unroll
          for (int nt = 0; nt < 4; ++nt) { LAS bf16* up = Ut + t * 72 + 16 * nt + l15; *up = (bf16)f2bf(bf2f(*up) * (acc[nt][reg] + bsv)); } } }
    __syncthreads();
    { const int t = F.tid >> 2, cq = F.tid & 3; bf16* yr = Y + (row0 + t) * D + h * HD + 16 * cq;
      *(u32x4*)yr = *(const LAS u32x4*)(Ut + t * 72 + 16 * cq); *(u32x4*)(yr + 8) = *(const LAS u32x4*)(Ut + t * 72 + 16 * cq + 8); }
    __syncthreads();
}

__device__ __forceinline__ void gmlp_units(Frame& F, int u0, int ustep, int nunits, const bf16* P, bf16* Y, const float* ln_w, const float* ln_b, const bf16* WsB, const float* bs) {
    if (u0 >= nunits) return;
    const int t = F.tid >> 2, cq = F.tid & 3; const int w = F.wave, l15 = F.lane & 15, g = F.lane >> 4, t0 = 16 * w, nks = (w >> 1) + 1;
    LAS float* TB = (LAS float*)(F.lds + 73728);
    TB[F.tid] = ln_w[F.tid]; TB[512 + F.tid] = ln_b[F.tid]; TB[1024 + F.tid] = bs[F.tid]; TB[1536 + F.tid] = bs[512 + F.tid];
    LDS_BARRIER();
    u32x4 pu0, pu1, pv0, pv1;
#define GM_LOAD(uu_) do { const int h_ = (uu_) % NH, bc_ = (uu_) / NH; const bf16* pr_ = P + ((size_t)bc_ * GCH + t) * INW + h_ * HD + 16 * cq; \
        pu0 = *(const u32x4*)pr_; pu1 = *(const u32x4*)(pr_ + 8); pv0 = *(const u32x4*)(pr_ + GMW); pv1 = *(const u32x4*)(pr_ + GMW + 8); } while (0)
    GM_LOAD(u0);
    int it = 0;
    for (int unit = u0; unit < nunits; unit += ustep, ++it) {
        LAS bf16* Vt = (LAS bf16*)(F.lds + (it & 1) * (2 * 128 * 72 * 2)); LAS bf16* Ut = Vt + 128 * 72;
        const int h = unit % NH, bc = unit / NH; const size_t row0 = (size_t)bc * GCH;
        const bf16* wrow = WsB + ((size_t)h * GCH + t0 + l15) * GCH + 8 * g; bf16x8 af[4];
#pragma unroll
        for (int ks = 0; ks < 4; ++ks) af[ks] = *(const bf16x8*)(wrow + 32 * (ks < nks ? ks : 0));
        const f32x4 bsv = *(const LAS f32x4*)(TB + 1024 + h * GCH + t0 + 4 * g);
        float uu[16], vv[16]; { float a[8]; unpack8(pu0, a); for (int j = 0; j < 8; ++j) uu[j] = a[j]; unpack8(pu1, a); for (int j = 0; j < 8; ++j) uu[8 + j] = a[j]; unpack8(pv0, a); for (int j = 0; j < 8; ++j) vv[j] = a[j]; unpack8(pv1, a); for (int j = 0; j < 8; ++j) vv[8 + j] = a[j]; }
        if (unit + ustep < nunits) GM_LOAD(unit + ustep);
        float sm = 0.f;
#pragma unroll
        for (int j = 0; j < 16; j += 2) { const f32x2 gu = gelu_pk2((f32x2){uu[j], uu[j + 1]}), gv = gelu_pk2((f32x2){vv[j], vv[j + 1]}); uu[j] = gu.x; uu[j + 1] = gu.y; vv[j] = gv.x; vv[j + 1] = gv.y; sm += gv.x + gv.y; }
        sm += __shfl_xor(sm, 1); sm += __shfl_xor(sm, 2); const float mean = sm * (1.f / HD); float q = 0.f;
#pragma unroll
        for (int j = 0; j < 16; ++j) { vv[j] -= mean; q += vv[j] * vv[j]; }
        q += __shfl_xor(q, 1); q += __shfl_xor(q, 2); const float rstd = __builtin_amdgcn_rsqf(q * (1.f / HD) + LN_EPS);
#pragma unroll
        for (int j = 0; j < 16; ++j) vv[j] = vv[j] * rstd * TB[h * HD + 16 * cq + j] + TB[512 + h * HD + 16 * cq + j];
        { float a[8]; for (int j = 0; j < 8; ++j) a[j] = vv[j]; *(LAS u32x4*)(Vt + t * 72 + 16 * cq) = pack8(a); for (int j = 0; j < 8; ++j) a[j] = vv[8 + j]; *(LAS u32x4*)(Vt + t * 72 + 16 * cq + 8) = pack8(a);
          for (int j = 0; j < 8; ++j) a[j] = uu[j]; *(LAS u32x4*)(Ut + t * 72 + 16 * cq) = pack8(a); for (int j = 0; j < 8; ++j) a[j] = uu[8 + j]; *(LAS u32x4*)(Ut + t * 72 + 16 * cq + 8) = pack8(a); }
        LDS_BARRIER();
        { f32x4 acc[4] = {{0.f, 0.f, 0.f, 0.f}, {0.f, 0.f, 0.f, 0.f}, {0.f, 0.f, 0.f, 0.f}, {0.f, 0.f, 0.f, 0.f}};
#pragma unroll
          for (int ks = 0; ks < 4; ++ks) if (ks < nks) {
#pragma unroll
              for (int nt = 0; nt < 4; ++nt) acc[nt] = MFMA32(af[ks], lds_tr8(Vt, 72, 32 * ks, 16 * nt, F.lane), acc[nt]); }
#pragma unroll
          for (int reg = 0; reg < 4; ++reg) { const int tt = t0 + 4 * g + reg;
#pragma unroll
              for (int nt = 0; nt < 4; ++nt) { LAS bf16* up = Ut + tt * 72 + 16 * nt + l15; *up = (bf16)f2bf(bf2f(*up) * (acc[nt][reg] + bsv[reg])); } } }
        LDS_BARRIER();
        { bf16* yr = Y + (row0 + t) * D + h * HD + 16 * cq;
          *(u32x4*)yr = *(const LAS u32x4*)(Ut + t * 72 + 16 * cq); *(u32x4*)(yr + 8) = *(const LAS u32x4*)(Ut + t * 72 + 16 * cq + 8); }
    }
#undef GM_LOAD
    LDS_BARRIER();
}

struct RwkvW { const float *mu, *w0, *a0, *k_k, *k_a, *r_k, *lnx_w, *lnx_b; const bf16 *WupT, *AupT, *GupT; };
struct RwkvS { bf16 *SG, *SH, *SQ, *SS, *Sg, *SY0; float* Sbsc; };
constexpr int M1_LI = 0;
constexpr int M1_PR = 33792;
constexpr int M1_TL = M1_PR + 36864;
constexpr int M1_SEG = M1_TL + 7 * 9216;
constexpr int M1_GAM = M1_SEG + 2048;
constexpr int M1_D = M1_GAM + 256;
constexpr int M1_T = M1_D + 4096;
constexpr int M1_END = M1_T + 2048;
static_assert(M1_END <= MISC_OFF, "M1 LDS map");
__device__ __forceinline__ float fast_tanh(float x) { const float e = __expf(2.f * x); return 1.f - 2.f * __builtin_amdgcn_rcpf(e + 1.f); }

__device__ __forceinline__ void rwkv_m1_unit(Frame& F, int unit  , const bf16* P, const RwkvW& W, const RwkvS& Sc) {
    const int b = unit >> 6, c = unit & 63, t0 = c * 64; const size_t row0 = (size_t)b * SEQ + t0;
    const int w = F.wave, lane = F.lane, l15 = lane & 15, g = lane >> 4;
    LAS bf16* LI = (LAS bf16*)(F.lds + M1_LI);
    LAS float* Ef = (LAS float*)(F.lds + M1_PR); LAS float* ALf = Ef + 64 * 64;
    LAS bf16* Lab = (LAS bf16*)(F.lds + M1_PR); LAS bf16* Lak = Lab + 64 * 72; LAS bf16* Mrb = Lak + 64 * 72; LAS bf16* Mrk = Mrb + 64 * 72;
    LAS bf16* At = (LAS bf16*)(F.lds + M1_TL); LAS bf16* Bt = At + 64 * 72; LAS bf16* Kt = Bt + 64 * 72; LAS bf16* Rt = Kt + 64 * 72; LAS bf16* Bh = Rt + 64 * 72; LAS bf16* Kh = Bh + 64 * 72; LAS bf16* Vt = Kh + 64 * 72;
    LAS float* SEG = (LAS float*)(F.lds + M1_SEG); LAS float* GAM = (LAS float*)(F.lds + M1_GAM); LAS float* Dd = (LAS float*)(F.lds + M1_D); LAS bf16* Tt = (LAS bf16*)(F.lds + M1_T);
#pragma unroll
    for (int it = 0; it < 4; ++it) { const int item = F.tid + 512 * it, tok = item >> 5, jc = item & 31, j0 = 8 * jc; const size_t row = row0 + tok;
        float cv[8], pv[8]; unpack8(*(const u32x4*)(P + row * INW + 2560 + j0), cv);
        if (t0 + tok > 0) unpack8(*(const u32x4*)(P + (row - 1) * INW + 2560 + j0), pv); else { for (int j = 0; j < 8; ++j) pv[j] = 0.f; }
        const f32x4 m0 = *(const f32x4*)(W.mu + 1536 + j0), m1 = *(const f32x4*)(W.mu + 1536 + j0 + 4); float o[8];
#pragma unroll
        for (int j = 0; j < 8; ++j) { const float x = cv[j] + (pv[j] - cv[j]) * (j < 4 ? m0[j] : m1[j - 4]); o[j] = jc < 8 ? fast_tanh(x) : (jc < 16 ? x : sigmoidf_(x)); }
        *(LAS u32x4*)(LI + tok * 264 + j0) = pack8(o); }
    __syncthreads();
    for (int h = 0; h < NH; ++h) {
        const size_t uh = ((size_t)unit * NH + h) * 4096;
        { const int mt = w & 3, ntb = 2 * (w >> 2); const int chrow = h * HD + 16 * mt + l15;
          f32x4 aw[2] = {{0.f, 0.f, 0.f, 0.f}, {0.f, 0.f, 0.f, 0.f}}, aa[2] = {{0.f, 0.f, 0.f, 0.f}, {0.f, 0.f, 0.f, 0.f}}, ag[2] = {{0.f, 0.f, 0.f, 0.f}, {0.f, 0.f, 0.f, 0.f}};
#pragma unroll
          for (int ks = 0; ks < 2; ++ks) { const bf16x8 fw = *(const bf16x8*)(W.WupT + (size_t)chrow * 64 + 32 * ks + 8 * g), fa = *(const bf16x8*)(W.AupT + (size_t)chrow * 64 + 32 * ks + 8 * g);
#pragma unroll
              for (int q = 0; q < 2; ++q) { aw[q] = MFMA32(fw, lds_row8(LI, 264, 16 * (ntb + q), 32 * ks, lane), aw[q]); aa[q] = MFMA32(fa, lds_row8(LI, 264, 16 * (ntb + q), 64 + 32 * ks, lane), aa[q]); } }
#pragma unroll
          for (int ks = 0; ks < 4; ++ks) { const bf16x8 fg = *(const bf16x8*)(W.GupT + (size_t)chrow * 128 + 32 * ks + 8 * g);
#pragma unroll
              for (int q = 0; q < 2; ++q) ag[q] = MFMA32(fg, lds_row8(LI, 264, 16 * (ntb + q), 128 + 32 * ks, lane), ag[q]); }
          const int ch0 = 16 * mt + 4 * g; const f32x4 w0v = *(const f32x4*)(W.w0 + h * HD + ch0), a0v = *(const f32x4*)(W.a0 + h * HD + ch0);
#pragma unroll
          for (int q = 0; q < 2; ++q) { const int tok = 16 * (ntb + q) + l15; f32x4 ev, av;
#pragma unroll
              for (int r = 0; r < 4; ++r) { const float z = -(aw[q][r] + w0v[r]); const float sp = fmaxf(z, 0.f) + __logf(1.f + __expf(-fabsf(z))); ev[r] = -__expf(-sp - 0.5f); av[r] = sigmoidf_(aa[q][r] + a0v[r]); }
              *(LAS f32x4*)(Ef + tok * 64 + ch0) = ev; *(LAS f32x4*)(ALf + tok * 64 + ch0) = av;
              u32x2 gw; gw.x = cvtpk_c(ag[q][0], ag[q][1]); gw.y = cvtpk_c(ag[q][2], ag[q][3]); *(u32x2*)(Sc.Sg + (row0 + tok) * RWW + h * HD + ch0) = gw; } }
        __syncthreads();
        { const int ch = F.tid & 63, seg = F.tid >> 6; float run = 0.f;
#pragma unroll
          for (int i = 0; i < 8; ++i) { run += Ef[(8 * seg + i) * 64 + ch]; Ef[(8 * seg + i) * 64 + ch] = run; }
          SEG[seg * 64 + ch] = run; }
        __syncthreads();
        { const int ch = F.tid & 63, seg = F.tid >> 6; float off = 0.f;
          for (int s2 = 0; s2 < seg; ++s2) off += SEG[s2 * 64 + ch];
#pragma unroll
          for (int i = 0; i < 8; ++i) Ef[(8 * seg + i) * 64 + ch] += off; }
        __syncthreads();
        { const int tok = F.tid >> 3, cg = F.tid & 7, ch0 = 8 * cg, hc0 = h * HD + ch0; const size_t row = row0 + tok; const bool has_prev = (t0 + tok) > 0;
          float rr[8], kx[8], vv[8], tmp[8], pr[8];
#define SHIFT_LOAD(dst, col) do { unpack8(*(const u32x4*)(P + row * INW + (col)), dst); if (has_prev) unpack8(*(const u32x4*)(P + (row - 1) * INW + (col)), pr); else { for (int j = 0; j < 8; ++j) pr[j] = 0.f; } \
              const f32x4 m0 = *(const f32x4*)(W.mu + (col) - 1024), m1 = *(const f32x4*)(W.mu + (col) - 1024 + 4); for (int j = 0; j < 8; ++j) dst[j] = dst[j] + (pr[j] - dst[j]) * (j < 4 ? m0[j] : m1[j - 4]); } while (0)
          SHIFT_LOAD(rr, 1024 + hc0); SHIFT_LOAD(kx, 1536 + hc0); SHIFT_LOAD(vv, 2048 + hc0);
          (void)tmp;
          float Lt[8], Lm[8], Lc[8], al[8];
#pragma unroll
          for (int j = 0; j < 8; ++j) { Lt[j] = Ef[tok * 64 + ch0 + j]; Lm[j] = tok > 0 ? Ef[(tok - 1) * 64 + ch0 + j] : 0.f; Lc[j] = Ef[63 * 64 + ch0 + j]; al[j] = ALf[tok * 64 + ch0 + j]; }
          float kk[8], km[8]; float ss = 0.f, bs_ = 0.f;
#pragma unroll
          for (int j = 0; j < 8; ++j) { kk[j] = kx[j] * W.k_k[hc0 + j]; ss += kk[j] * kk[j]; km[j] = kx[j] * (1.f + (al[j] - 1.f) * W.k_a[hc0 + j]); bs_ += rr[j] * km[j] * W.r_k[hc0 + j]; }
          ss += __shfl_xor(ss, 1); ss += __shfl_xor(ss, 2); ss += __shfl_xor(ss, 4); bs_ += __shfl_xor(bs_, 1); bs_ += __shfl_xor(bs_, 2); bs_ += __shfl_xor(bs_, 4);
          const float inv = 1.f / fmaxf(sqrtf(ss), 1e-12f);
          if (cg == 0) Sc.Sbsc[row * NH + h] = bs_;
          float oA[8], oB[8], oK[8], oR[8], oBh[8], oKh[8];
#pragma unroll
          for (int j = 0; j < 8; ++j) { const float kn = kk[j] * inv, bb = kn * al[j]; const float einv = __expf(-Lt[j]), ec = __expf(Lc[j] - Lt[j]);
              oA[j] = -kn * __expf(Lm[j]); oB[j] = bb * einv; oK[j] = km[j] * einv; oR[j] = rr[j] * __expf(Lt[j]); oBh[j] = bb * ec; oKh[j] = km[j] * ec; }
          *(LAS u32x4*)(At + tok * 72 + ch0) = pack8(oA); *(LAS u32x4*)(Bt + tok * 72 + ch0) = pack8(oB); *(LAS u32x4*)(Kt + tok * 72 + ch0) = pack8(oK); *(LAS u32x4*)(Rt + tok * 72 + ch0) = pack8(oR);
          *(LAS u32x4*)(Bh + tok * 72 + ch0) = pack8(oBh); *(LAS u32x4*)(Kh + tok * 72 + ch0) = pack8(oKh); *(LAS u32x4*)(Vt + tok * 72 + ch0) = pack8(vv);
          if (tok == 63) { for (int j = 0; j < 8; ++j) GAM[ch0 + j] = __expf(Lc[j]); } }
        __syncthreads();
        for (int i5 = 0; i5 < 5; ++i5) { const int q = w + 8 * i5, mat = q / 10, idx = q % 10; const int ti = idx < 1 ? 0 : (idx < 3 ? 1 : (idx < 6 ? 2 : 3)), si = idx - ti * (ti + 1) / 2;
            const LAS bf16* X = mat < 2 ? At : Rt; const LAS bf16* Yk = (mat & 1) ? Kt : Bt; LAS bf16* O = Lab + mat * 64 * 72;
            f32x4 acc = {0.f, 0.f, 0.f, 0.f};
#pragma unroll
            for (int ks = 0; ks < 2; ++ks) acc = MFMA32(lds_row8(Yk, 72, 16 * si, 32 * ks, lane), lds_row8(X, 72, 16 * ti, 32 * ks, lane), acc);
            const int t = 16 * ti + l15, s0 = 16 * si + 4 * g;
#pragma unroll
            for (int r = 0; r < 4; ++r) { const bool keep = mat < 2 ? (s0 + r < t) : (s0 + r <= t); if (!keep) acc[r] = 0.f; }
            *(LAS s16x4*)(O + t * 72 + s0) = pack4(acc);
            if (mat == 0 && ti == si) *(LAS f32x4*)(Dd + ti * 256 + l15 * 16 + 4 * g) = acc; }
        __syncthreads();
        if (w == 7) { const int i = lane >> 4, cc = lane & 15; const LAS float* Db = Dd + i * 256; float tv[16];
#pragma unroll
            for (int r = 0; r < 16; ++r) { float sum = (r == cc) ? 1.f : 0.f;
#pragma unroll
                for (int s2 = 0; s2 < r; ++s2) sum += Db[r * 16 + s2] * tv[s2];
                tv[r] = sum; }
#pragma unroll
            for (int r = 0; r < 16; ++r) Tt[i * 256 + r * 16 + cc] = (bf16)f2bf(tv[r]); }
        __syncthreads();
        { const bool isU = w < 4; const int cw = w & 3;
          f32x4 X[4];
#pragma unroll
          for (int i = 0; i < 4; ++i) { f32x4 z = {0.f, 0.f, 0.f, 0.f};
              if (isU) {
#pragma unroll
                  for (int j = 0; j <= i; ++j) z = MFMA16(lds_row4(Lak, 72, 16 * i, 16 * j, lane), lds_tr4(Vt, 72, 16 * j, 16 * cw, lane), z);
              } else z = unpack4(lds_tr4(At, 72, 16 * i, 16 * cw, lane));
#pragma unroll
              for (int j = 0; j < i; ++j) z = MFMA16(lds_row4(Lab, 72, 16 * i, 16 * j, lane), pack4(X[j]), z);
              const f32x4 zero = {0.f, 0.f, 0.f, 0.f};
              X[i] = MFMA16(lds_row4(Tt + i * 256, 16, 0, 0, lane), pack4(z), zero); }
          s16x4 Xp[4];
#pragma unroll
          for (int i = 0; i < 4; ++i) Xp[i] = pack4(X[i]);
          if (isU) {
#pragma unroll
              for (int nt = 0; nt < 4; ++nt) { f32x4 acc = {0.f, 0.f, 0.f, 0.f};
#pragma unroll
                  for (int i = 0; i < 4; ++i) { acc = MFMA16(Xp[i], lds_tr4(Bh, 72, 16 * i, 16 * nt, lane), acc); acc = MFMA16(lds_tr4(Vt, 72, 16 * i, 16 * cw, lane), lds_tr4(Kh, 72, 16 * i, 16 * nt, lane), acc); }
                  *(s16x4*)(Sc.SH + uh + (size_t)(16 * nt + l15) * 64 + 16 * cw + 4 * g) = pack4(acc); }
#pragma unroll
              for (int mt = 0; mt < 4; ++mt) { f32x4 acc = {0.f, 0.f, 0.f, 0.f};
#pragma unroll
                  for (int i = 0; i <= mt; ++i) { acc = MFMA16(lds_row4(Mrb, 72, 16 * mt, 16 * i, lane), Xp[i], acc); acc = MFMA16(lds_row4(Mrk, 72, 16 * mt, 16 * i, lane), lds_tr4(Vt, 72, 16 * i, 16 * cw, lane), acc); }
                  *(s16x4*)(Sc.SY0 + uh + (size_t)(16 * cw + l15) * 64 + 16 * mt + 4 * g) = pack4(acc); }
          } else {
              const float gamv = GAM[16 * cw + l15];
#pragma unroll
              for (int nt = 0; nt < 4; ++nt) { f32x4 acc = {0.f, 0.f, 0.f, 0.f};
#pragma unroll
                  for (int i = 0; i < 4; ++i) acc = MFMA16(Xp[i], lds_tr4(Bh, 72, 16 * i, 16 * nt, lane), acc);
                  { const float gam = (nt == cw) ? gamv : 0.f;
#pragma unroll
                      for (int r = 0; r < 4; ++r) acc[r] += (l15 == 4 * g + r) ? gam : 0.f; }
                  *(s16x4*)(Sc.SG + uh + (size_t)(16 * nt + l15) * 64 + 16 * cw + 4 * g) = pack4(acc); }
#pragma unroll
              for (int mt = 0; mt < 4; ++mt) { f32x4 acc = unpack4(lds_tr4(Rt, 72, 16 * mt, 16 * cw, lane));
#pragma unroll
                  for (int i = 0; i <= mt; ++i) acc = MFMA16(lds_row4(Mrb, 72, 16 * mt, 16 * i, lane), Xp[i], acc);
                  *(s16x4*)(Sc.SQ + uh + (size_t)(16 * cw + l15) * 64 + 16 * mt + 4 * g) = pack4(acc); }
          } }
        __syncthreads();
    }
}

__device__ __forceinline__ u32x4 pair16(const s16x4 a, const s16x4 b) {
    const u32x2 A = __builtin_bit_cast(u32x2, a), B = __builtin_bit_cast(u32x2, b);
    const auto sx = __builtin_amdgcn_permlane16_swap(A.x, B.x, false, false), sy = __builtin_amdgcn_permlane16_swap(A.y, B.y, false, false);
    u32x4 o; o.x = sx[0]; o.y = sy[0]; o.z = sx[1]; o.w = sy[1]; return o;
}
constexpr int M1V_LI = 0;
constexpr int M1V_PR = 33792;
constexpr int M1V_TL = M1V_PR + 36864;
constexpr int M1V_SEG = M1V_TL + 5 * 9216;
constexpr int M1V_GAM = M1V_SEG + 2048;
constexpr int M1V_CST = M1V_GAM + 256;
constexpr int M1V_END = M1V_CST + 8 * 2048;
static_assert(M1V_END <= MISC_OFF, "M1 v2 LDS map");
__device__ __forceinline__ void rwkv_m1_consts(Frame& F, const RwkvW& W) {
    LAS float* CST = (LAS float*)(F.lds + M1V_CST);
    for (int i = F.tid; i < 1536; i += 512) CST[i] = W.mu[i];
    CST[3 * 512 + F.tid] = W.k_k[F.tid]; CST[4 * 512 + F.tid] = W.k_a[F.tid]; CST[5 * 512 + F.tid] = W.r_k[F.tid]; CST[6 * 512 + F.tid] = W.w0[F.tid]; CST[7 * 512 + F.tid] = W.a0[F.tid];
    __syncthreads();
}
__device__ __forceinline__ void rwkv_m1v2_unit(Frame& F, int unit  , const bf16* P, const RwkvW& W, const RwkvS& Sc) {
    const int b = unit >> 6, c = unit & 63, t0 = c * 64; const size_t row0 = (size_t)b * SEQ + t0;
    const int w = F.wave, lane = F.lane, l15 = lane & 15, g = lane >> 4;
    LAS bf16* LI = (LAS bf16*)(F.lds + M1V_LI);
    LAS float* Ef = (LAS float*)(F.lds + M1V_PR); constexpr int ES = 68; LAS float* ALf = Ef + 64 * ES;
    LAS bf16* Lab = (LAS bf16*)(F.lds + M1V_PR); LAS bf16* Lak = Lab + 64 * 72; LAS bf16* Mrb = Lak + 64 * 72; LAS bf16* Mrk = Mrb + 64 * 72;
    LAS bf16* At = (LAS bf16*)(F.lds + M1V_TL); LAS bf16* Bt = At + 64 * 72; LAS bf16* Kt = Bt + 64 * 72; LAS bf16* Rt = Kt + 64 * 72; LAS bf16* Vt = Rt + 64 * 72;
    LAS float* SEG = (LAS float*)(F.lds + M1V_SEG); LAS float* GAM = (LAS float*)(F.lds + M1V_GAM); const LAS float* CST = (const LAS float*)(F.lds + M1V_CST);
    bf16x8 wfw[2], wfa[2], wfg[4]; u32x4 pfc[3], pfp[3];
    const int ea_mt = w & 3, ea_ntb = 2 * (w >> 2);
    const int eb_tok = F.tid >> 3, eb_cg = F.tid & 7; const size_t eb_row = row0 + eb_tok; const bool eb_prev = (t0 + eb_tok) > 0;
#define M1_LOAD_W(hh) do { const int chrow_ = (hh) * HD + 16 * ea_mt + l15; \
        wfw[0] = *(const bf16x8*)(W.WupT + (size_t)chrow_ * 64 + 8 * g); wfw[1] = *(const bf16x8*)(W.WupT + (size_t)chrow_ * 64 + 32 + 8 * g); \
        wfa[0] = *(const bf16x8*)(W.AupT + (size_t)chrow_ * 64 + 8 * g); wfa[1] = *(const bf16x8*)(W.AupT + (size_t)chrow_ * 64 + 32 + 8 * g); \
        _Pragma("unroll") for (int ks_ = 0; ks_ < 4; ++ks_) wfg[ks_] = *(const bf16x8*)(W.GupT + (size_t)chrow_ * 128 + 32 * ks_ + 8 * g); } while (0)
#define M1_LOAD_P(hh) do { const int hc_ = (hh) * HD + 8 * eb_cg; \
        _Pragma("unroll") for (int a_ = 0; a_ < 3; ++a_) { pfc[a_] = *(const u32x4*)(P + eb_row * INW + 1024 + 512 * a_ + hc_); \
            if (eb_prev) pfp[a_] = *(const u32x4*)(P + (eb_row - 1) * INW + 1024 + 512 * a_ + hc_); else pfp[a_] = (u32x4){0u, 0u, 0u, 0u}; } } while (0)
#pragma unroll
    for (int it = 0; it < 4; ++it) { const int item = F.tid + 512 * it, tok = item >> 5, jc = item & 31, j0 = 8 * jc; const size_t row = row0 + tok;
        float cv[8], pv[8]; unpack8(*(const u32x4*)(P + row * INW + 2560 + j0), cv);
        if (t0 + tok > 0) unpack8(*(const u32x4*)(P + (row - 1) * INW + 2560 + j0), pv); else { for (int j = 0; j < 8; ++j) pv[j] = 0.f; }
        const f32x4 m0 = *(const f32x4*)(W.mu + 1536 + j0), m1 = *(const f32x4*)(W.mu + 1536 + j0 + 4); float o[8];
#pragma unroll
        for (int j = 0; j < 8; ++j) { const float x = cv[j] + (pv[j] - cv[j]) * (j < 4 ? m0[j] : m1[j - 4]); o[j] = jc < 8 ? fast_tanh(x) : (jc < 16 ? x : sigmoidf_(x)); }
        *(LAS u32x4*)(LI + tok * 264 + j0) = pack8(o); }
    LDS_BARRIER();
    M1_LOAD_W(((int)blockIdx.x) & (NH - 1));
    const int rp_ea = (PROBE_STAGE == 1) ? 2 - (F.G > 100000) : 1, rp_eb = (PROBE_STAGE == 2) ? 2 - (F.G > 100000) : 1, rp_p1 = (PROBE_STAGE == 3) ? 2 - (F.G > 100000) : 1, rp_ch = (PROBE_STAGE == 4) ? 2 - (F.G > 100000) : 1, rp_cs = (PROBE_STAGE == 5) ? 2 - (F.G > 100000) : 1;
    for (int hi_ = 0; hi_ < NH; ++hi_) { const int h = (hi_ + (int)blockIdx.x) & (NH - 1);
        const size_t uh = ((size_t)unit * NH + h) * 4096;
        for (int rp = 0; rp < rp_ea; ++rp) {
          f32x4 aw[2] = {{0.f, 0.f, 0.f, 0.f}, {0.f, 0.f, 0.f, 0.f}}, aa[2] = {{0.f, 0.f, 0.f, 0.f}, {0.f, 0.f, 0.f, 0.f}}, ag[2] = {{0.f, 0.f, 0.f, 0.f}, {0.f, 0.f, 0.f, 0.f}};
#pragma unroll
          for (int q = 0; q < 2; ++q) { bf16x8 lf[8];
#pragma unroll
              for (int ks = 0; ks < 8; ++ks) lf[ks] = lds_row8(LI, 264, 16 * (ea_ntb + q), 32 * ks, lane);
#pragma unroll
              for (int ks = 0; ks < 2; ++ks) { aw[q] = MFMA32(wfw[ks], lf[ks], aw[q]); aa[q] = MFMA32(wfa[ks], lf[2 + ks], aa[q]); }
#pragma unroll
              for (int ks = 0; ks < 4; ++ks) ag[q] = MFMA32(wfg[ks], lf[4 + ks], ag[q]); }
          const int ch0 = 16 * ea_mt + 4 * g; const f32x4 w0v = *(const LAS f32x4*)(CST + 6 * 512 + h * HD + ch0), a0v = *(const LAS f32x4*)(CST + 7 * 512 + h * HD + ch0);
#pragma unroll
          for (int q = 0; q < 2; ++q) { const int tok = 16 * (ea_ntb + q) + l15; f32x4 ev, av;
#pragma unroll
              for (int r = 0; r < 4; ++r) { ev[r] = -0.60653066f * __builtin_amdgcn_rcpf(1.f + __expf(-(aw[q][r] + w0v[r]))); av[r] = __builtin_amdgcn_rcpf(1.f + __expf(-(aa[q][r] + a0v[r]))); }
              *(LAS f32x4*)(Ef + tok * ES + ch0) = ev; *(LAS f32x4*)(ALf + tok * ES + ch0) = av; }
          *(u32x4*)(Sc.Sg + (row0 + 16 * (ea_ntb + (g & 1)) + l15) * RWW + h * HD + 16 * ea_mt + 4 * (g & ~1)) = pair16(pack4(ag[0]), pack4(ag[1])); }
        LDS_BARRIER();
        for (int rp = 0; rp < rp_cs; ++rp) {
        float csv[8];
        { const int ch = F.tid & 63, seg = F.tid >> 6;
#pragma unroll
          for (int i = 0; i < 8; ++i) csv[i] = Ef[(8 * seg + i) * ES + ch];
#pragma unroll
          for (int i = 1; i < 8; ++i) csv[i] += csv[i - 1];
          SEG[seg * 64 + ch] = csv[7]; }
        LDS_BARRIER();
        { const int ch = F.tid & 63, seg = F.tid >> 6; float sg[8];
#pragma unroll
          for (int s2 = 0; s2 < 7; ++s2) sg[s2] = SEG[s2 * 64 + ch];
          float off = 0.f;
#pragma unroll
          for (int s2 = 0; s2 < 7; ++s2) off += (s2 < seg) ? sg[s2] : 0.f;
#pragma unroll
          for (int i = 0; i < 8; ++i) Ef[(8 * seg + i) * ES + ch] = csv[i] + off; }
        LDS_BARRIER();
        }
        for (int rp = 0; rp < rp_eb; ++rp) { const int tok = eb_tok, ch0 = 8 * eb_cg, hc0 = h * HD + ch0;
          float rr[8], kx[8], vv[8], pr[8];
#define M1_SHIFT(dst, a_) do { unpack8(pfc[a_], dst); unpack8(pfp[a_], pr); const f32x4 m0 = *(const LAS f32x4*)(CST + (a_) * 512 + hc0), m1 = *(const LAS f32x4*)(CST + (a_) * 512 + hc0 + 4); \
              _Pragma("unroll") for (int j = 0; j < 8; ++j) dst[j] = dst[j] + (pr[j] - dst[j]) * (j < 4 ? m0[j] : m1[j - 4]); } while (0)
          M1_LOAD_P(h); M1_SHIFT(rr, 0); M1_SHIFT(kx, 1); M1_SHIFT(vv, 2);
          float Lt[8], Lm[8], al[8], ckk[8], cka[8], crk[8];
#pragma unroll
          for (int j = 0; j < 8; ++j) { Lt[j] = Ef[tok * ES + ch0 + j]; Lm[j] = tok > 0 ? Ef[(tok - 1) * ES + ch0 + j] : 0.f; al[j] = ALf[tok * ES + ch0 + j]; ckk[j] = CST[3 * 512 + hc0 + j]; cka[j] = CST[4 * 512 + hc0 + j]; crk[j] = CST[5 * 512 + hc0 + j]; }
          float kk[8], km[8]; float ss = 0.f, bs_ = 0.f;
#pragma unroll
          for (int j = 0; j < 8; ++j) { kk[j] = kx[j] * ckk[j]; ss += kk[j] * kk[j]; km[j] = kx[j] * (1.f + (al[j] - 1.f) * cka[j]); bs_ += rr[j] * km[j] * crk[j]; }
          ss += __shfl_xor(ss, 1); ss += __shfl_xor(ss, 2); ss += __shfl_xor(ss, 4); bs_ += __shfl_xor(bs_, 1); bs_ += __shfl_xor(bs_, 2); bs_ += __shfl_xor(bs_, 4);
          const float inv = 1.f / fmaxf(sqrtf(ss), 1e-12f);
          if (eb_cg == 0) Sc.Sbsc[eb_row * NH + h] = bs_;
          float oA[8], oB[8], oK[8], oR[8];
#pragma unroll
          for (int j = 0; j < 8; ++j) { const float kn = kk[j] * inv, bb = kn * al[j]; const float eL = __expf(Lt[j]), einv = __builtin_amdgcn_rcpf(eL);
              oA[j] = -kn * __expf(Lm[j]); oB[j] = bb * einv; oK[j] = km[j] * einv; oR[j] = rr[j] * eL; if (tok == 63) GAM[ch0 + j] = eL; }
          *(LAS u32x4*)(At + tok * 72 + ch0) = pack8(oA); *(LAS u32x4*)(Bt + tok * 72 + ch0) = pack8(oB); *(LAS u32x4*)(Kt + tok * 72 + ch0) = pack8(oK); *(LAS u32x4*)(Rt + tok * 72 + ch0) = pack8(oR);
          *(LAS u32x4*)(Vt + tok * 72 + ch0) = pack8(vv); }
        { const int hn_ = ((hi_ + 1 < NH ? hi_ + 1 : hi_) + (int)blockIdx.x) & (NH - 1); M1_LOAD_W(hn_); }
        LDS_BARRIER();
        for (int rp = 0; rp < rp_p1; ++rp) for (int i5 = 0; i5 < 5; ++i5) { const int q = w + 8 * i5, mat = q / 10, idx = q % 10; const int ti = idx < 1 ? 0 : (idx < 3 ? 1 : (idx < 6 ? 2 : 3)), si = idx - ti * (ti + 1) / 2;
            const LAS bf16* X = mat < 2 ? At : Rt; const LAS bf16* Yk = (mat & 1) ? Kt : Bt; LAS bf16* O = Lab + mat * 64 * 72;
            f32x4 acc = {0.f, 0.f, 0.f, 0.f};
#pragma unroll
            for (int ks = 0; ks < 2; ++ks) acc = MFMA32(lds_row8(Yk, 72, 16 * si, 32 * ks, lane), lds_row8(X, 72, 16 * ti, 32 * ks, lane), acc);
            const int t = 16 * ti + l15, s0 = 16 * si + 4 * g; const int lim = mat < 2 ? t : t + 1;
#pragma unroll
            for (int r = 0; r < 4; ++r) acc[r] = (s0 + r < lim) ? acc[r] : 0.f;
            *(LAS s16x4*)(O + t * 72 + s0) = pack4(acc); }
        LDS_BARRIER();
        for (int rp = 0; rp < rp_ch; ++rp) { const bool isU = w < 4; const int cw = w & 3; const f32x4 zero = {0.f, 0.f, 0.f, 0.f};
          s16x4 TTp[4];
#pragma unroll
          for (int hb = 0; hb < 2; ++hb) { s16x4 fr[2], ft[2];
#pragma unroll
            for (int i = 0; i < 2; ++i) { fr[i] = lds_row4(Lab, 72, 16 * (2 * hb + i), 16 * (2 * hb + i), lane); ft[i] = lds_tr4(Lab, 72, 16 * (2 * hb + i), 16 * (2 * hb + i), lane); }
            f32x4 L2[2], L2T[2], L4[2], L4T[2], L8[2], TT[2]; s16x4 pL2[2], pL2T[2], pL4[2], pL4T[2];
#pragma unroll
            for (int i = 0; i < 2; ++i) { L2[i] = MFMA16(fr[i], ft[i], zero); L2T[i] = MFMA16(ft[i], fr[i], zero); }
#pragma unroll
            for (int i = 0; i < 2; ++i) { pL2[i] = pack4(L2[i]); pL2T[i] = pack4(L2T[i]); TT[i] = unpack4(fr[i]);
#pragma unroll
                for (int r = 0; r < 4; ++r) TT[i][r] += (l15 == 4 * g + r) ? 1.f : 0.f; }
#pragma unroll
            for (int i = 0; i < 2; ++i) { L4[i] = MFMA16(pL2T[i], pL2[i], zero); L4T[i] = MFMA16(pL2[i], pL2T[i], zero); TT[i] = MFMA16(pL2[i], pack4(TT[i]), TT[i]); }
#pragma unroll
            for (int i = 0; i < 2; ++i) { pL4[i] = pack4(L4[i]); pL4T[i] = pack4(L4T[i]); }
#pragma unroll
            for (int i = 0; i < 2; ++i) { L8[i] = MFMA16(pL4T[i], pL4[i], zero); TT[i] = MFMA16(pL4[i], pack4(TT[i]), TT[i]); }
#pragma unroll
            for (int i = 0; i < 2; ++i) { TT[i] = MFMA16(pack4(L8[i]), pack4(TT[i]), TT[i]); TTp[2 * hb + i] = pack4(TT[i]); } }
          s16x4 Vf[4]; f32x4 z[4];
          if (isU) { s16x4 lk[10];
#pragma unroll
              for (int j = 0; j < 4; ++j) Vf[j] = lds_tr4(Vt, 72, 16 * j, 16 * cw, lane);
#pragma unroll
              for (int i = 0; i < 4; ++i)
#pragma unroll
                  for (int j = 0; j <= i; ++j) lk[i * (i + 1) / 2 + j] = lds_row4(Lak, 72, 16 * i, 16 * j, lane);
#pragma unroll
              for (int i = 0; i < 4; ++i) { z[i] = zero;
#pragma unroll
                  for (int j = 0; j <= i; ++j) z[i] = MFMA16(lk[i * (i + 1) / 2 + j], Vf[j], z[i]); }
          } else {
#pragma unroll
              for (int i = 0; i < 4; ++i) { Vf[i] = (s16x4){0, 0, 0, 0}; z[i] = unpack4(lds_tr4(At, 72, 16 * i, 16 * cw, lane)); } }
          s16x4 Xp[4];
          { s16x4 lb[6];
#pragma unroll
            for (int i = 1; i < 4; ++i)
#pragma unroll
                for (int j = 0; j < i; ++j) lb[i * (i - 1) / 2 + j] = lds_row4(Lab, 72, 16 * i, 16 * j, lane);
#pragma unroll
            for (int i = 0; i < 4; ++i) { f32x4 zz = z[i];
#pragma unroll
                for (int j = 0; j < i; ++j) zz = MFMA16(lb[i * (i - 1) / 2 + j], Xp[j], zz);
                Xp[i] = pack4(MFMA16(TTp[i], pack4(zz), zero)); } }
          if (isU) {
              s16x4 pkh[4];
#pragma unroll
              for (int nt = 0; nt < 4; ++nt) { s16x4 bf_[4], kf_[4];
#pragma unroll
                  for (int i = 0; i < 4; ++i) { bf_[i] = lds_tr4(Bt, 72, 16 * i, 16 * nt, lane); kf_[i] = lds_tr4(Kt, 72, 16 * i, 16 * nt, lane); }
                  f32x4 a1 = zero, a2 = zero;
#pragma unroll
                  for (int i = 0; i < 4; ++i) { a1 = MFMA16(Xp[i], bf_[i], a1); a2 = MFMA16(Vf[i], kf_[i], a2); }
                  const float gm = GAM[16 * nt + l15]; const f32x4 acc = (a1 + a2) * gm;
                  pkh[nt] = pack4(acc); }
#pragma unroll
              for (int np = 0; np < 4; np += 2) *(u32x4*)(Sc.SH + uh + (size_t)(16 * (np + (g & 1)) + l15) * 64 + 16 * cw + 4 * (g & ~1)) = pair16(pkh[np], pkh[np + 1]);
              s16x4 pky[4];
#pragma unroll
              for (int mt = 0; mt < 4; ++mt) { s16x4 mb[4], mk[4];
#pragma unroll
                  for (int i = 0; i <= mt; ++i) { mb[i] = lds_row4(Mrb, 72, 16 * mt, 16 * i, lane); mk[i] = lds_row4(Mrk, 72, 16 * mt, 16 * i, lane); }
                  f32x4 a1 = zero, a2 = zero;
#pragma unroll
                  for (int i = 0; i <= mt; ++i) { a1 = MFMA16(mb[i], Xp[i], a1); a2 = MFMA16(mk[i], Vf[i], a2); }
                  pky[mt] = pack4(a1 + a2); }
#pragma unroll
              for (int mp = 0; mp < 4; mp += 2) *(u32x4*)(Sc.SY0 + uh + (size_t)(16 * cw + l15) * 64 + 16 * (mp + (g & 1)) + 4 * (g & ~1)) = pair16(pky[mp], pky[mp + 1]);
          } else {
              s16x4 pkg[4];
#pragma unroll
              for (int nt = 0; nt < 4; ++nt) { s16x4 bf_[4];
#pragma unroll
                  for (int i = 0; i < 4; ++i) bf_[i] = lds_tr4(Bt, 72, 16 * i, 16 * nt, lane);
                  f32x4 a1 = zero, a2 = zero;
                  a1 = MFMA16(Xp[0], bf_[0], a1); a2 = MFMA16(Xp[1], bf_[1], a2); a1 = MFMA16(Xp[2], bf_[2], a1); a2 = MFMA16(Xp[3], bf_[3], a2);
                  f32x4 acc = a1 + a2; const float gm = GAM[16 * nt + l15]; const float dg = (nt == cw) ? 1.f : 0.f;
#pragma unroll
                  for (int r = 0; r < 4; ++r) acc[r] = (acc[r] + ((l15 == 4 * g + r) ? dg : 0.f)) * gm;
                  pkg[nt] = pack4(acc); }
#pragma unroll
              for (int np = 0; np < 4; np += 2) *(u32x4*)(Sc.SG + uh + (size_t)(16 * (np + (g & 1)) + l15) * 64 + 16 * cw + 4 * (g & ~1)) = pair16(pkg[np], pkg[np + 1]);
              s16x4 pkq[4];
#pragma unroll
              for (int mt = 0; mt < 4; ++mt) { s16x4 mb[4]; const s16x4 rf = lds_tr4(Rt, 72, 16 * mt, 16 * cw, lane);
#pragma unroll
                  for (int i = 0; i <= mt; ++i) mb[i] = lds_row4(Mrb, 72, 16 * mt, 16 * i, lane);
                  f32x4 acc = unpack4(rf);
#pragma unroll
                  for (int i = 0; i <= mt; ++i) acc = MFMA16(mb[i], Xp[i], acc);
                  pkq[mt] = pack4(acc); }
#pragma unroll
              for (int mp = 0; mp < 4; mp += 2) *(u32x4*)(Sc.SQ + uh + (size_t)(16 * cw + l15) * 64 + 16 * (mp + (g & 1)) + 4 * (g & ~1)) = pair16(pkq[mp], pkq[mp + 1]);
          } }
        LDS_BARRIER();
    }
#undef M1_LOAD_W
#undef M1_LOAD_P
#undef M1_SHIFT
}

constexpr int M2_S = 0;
__device__ __forceinline__ void rwkv_m2_unit(Frame& F, int unit  , const RwkvS& Sc) {
    const int b = unit >> 3, h = unit & 7; const int w = F.wave, lane = F.lane, l15 = lane & 15, g = lane >> 4; const int mt = w >> 1, ntb = 2 * (w & 1);
    LAS bf16* Sb = (LAS bf16*)(F.lds + M2_S);
    f32x4 acc[2] = {{0.f, 0.f, 0.f, 0.f}, {0.f, 0.f, 0.f, 0.f}};
    constexpr int PF = 8;
    bf16x8 Gf[PF][2][2]; u32x2 Hf[PF][2];
#define M2_LOAD(slot, cc) do { const size_t uh_ = ((size_t)(b * 64 + (cc)) * NH + h) * 4096; _Pragma("unroll") for (int q = 0; q < 2; ++q) { const size_t ro = uh_ + (size_t)(16 * (ntb + q) + l15) * 64; \
        Gf[slot][q][0] = *(const bf16x8*)(Sc.SG + ro + 8 * g); Gf[slot][q][1] = *(const bf16x8*)(Sc.SG + ro + 32 + 8 * g); Hf[slot][q] = *(const u32x2*)(Sc.SH + ro + 16 * mt + 4 * g); } } while (0)
#pragma unroll
    for (int u = 0; u < PF; ++u) M2_LOAD(u, u);
    for (int c0 = 0; c0 < 64; c0 += PF) {
#pragma unroll
        for (int u = 0; u < PF; ++u) { const int c = c0 + u;
            const size_t uh = ((size_t)(b * 64 + c) * NH + h) * 4096; LAS bf16* buf = Sb + (u & 1) * 64 * 72;
#pragma unroll
            for (int q = 0; q < 2; ++q) { const s16x4 p = pack4(acc[q]); *(LAS s16x4*)(buf + (16 * (ntb + q) + l15) * 72 + 16 * mt + 4 * g) = p; *(s16x4*)(Sc.SS + uh + (size_t)(16 * (ntb + q) + l15) * 64 + 16 * mt + 4 * g) = p; }
            LDS_BARRIER();
            const bf16x8 a0 = lds_tr8(buf, 72, 0, 16 * mt, lane), a1 = lds_tr8(buf, 72, 32, 16 * mt, lane);
#pragma unroll
            for (int q = 0; q < 2; ++q) { f32x4 z; z[0] = __builtin_bit_cast(float, Hf[u][q].x << 16); z[1] = __builtin_bit_cast(float, Hf[u][q].x & 0xffff0000u); z[2] = __builtin_bit_cast(float, Hf[u][q].y << 16); z[3] = __builtin_bit_cast(float, Hf[u][q].y & 0xffff0000u);
                z = MFMA32(a0, Gf[u][q][0], z); acc[q] = MFMA32(a1, Gf[u][q][1], z); }
            { const int cn = c + PF < 64 ? c + PF : 63; M2_LOAD(u, cn); } }
    }
#undef M2_LOAD
    LDS_BARRIER();
}

constexpr int M3_SLOT = 9216 * 2 + 64 * 68 * 4;
__device__ __forceinline__ void rwkv_m3_unit(Frame& F, int unit  , const bf16* P, bf16* Y, const RwkvW& W, const RwkvS& Sc) {
    const int b = unit >> 6, c = unit & 63, t0 = c * 64; const size_t row0 = (size_t)b * SEQ + t0;
    const int w = F.wave, lane = F.lane, l15 = lane & 15, g = lane >> 4, hw = w >> 2, mt = w & 3, tl = F.tid & 255;
    LAS bf16* Qt = (LAS bf16*)(F.lds + hw * M3_SLOT); LAS bf16* St = Qt + 64 * 72; LAS float* Out = (LAS float*)(F.lds + hw * M3_SLOT + 2 * 9216);
    for (int hp = 0; hp < 4; ++hp) { const int h = 2 * hp + hw; const size_t uh = ((size_t)unit * NH + h) * 4096;
#pragma unroll
        for (int r = 0; r < 2; ++r) { const int off = 8 * (tl + 256 * r), rr = off >> 6, cc = off & 63;
            *(LAS u32x4*)(Qt + rr * 72 + cc) = *(const u32x4*)(Sc.SQ + uh + off); *(LAS u32x4*)(St + rr * 72 + cc) = *(const u32x4*)(Sc.SS + uh + off); }
        LDS_BARRIER();
        f32x4 acc[4];
#pragma unroll
        for (int nt = 0; nt < 4; ++nt) acc[nt] = unpack4(*(const s16x4*)(Sc.SY0 + uh + (size_t)(16 * nt + l15) * 64 + 16 * mt + 4 * g));
#pragma unroll
        for (int ks = 0; ks < 2; ++ks) { const bf16x8 a = lds_tr8(Qt, 72, 32 * ks, 16 * mt, lane);
#pragma unroll
            for (int nt = 0; nt < 4; ++nt) acc[nt] = MFMA32(a, lds_tr8(St, 72, 32 * ks, 16 * nt, lane), acc[nt]); }
#pragma unroll
        for (int r = 0; r < 4; ++r) { float s = (acc[0][r] + acc[1][r]) + (acc[2][r] + acc[3][r]);
            s += __shfl_xor(s, 1); s += __shfl_xor(s, 2); s += __shfl_xor(s, 4); s += __shfl_xor(s, 8); const float mean = s * (1.f / HD); float q = 0.f;
#pragma unroll
            for (int nt = 0; nt < 4; ++nt) { const float d = acc[nt][r] - mean; q += d * d; }
            q += __shfl_xor(q, 1); q += __shfl_xor(q, 2); q += __shfl_xor(q, 4); q += __shfl_xor(q, 8); const float rstd = __builtin_amdgcn_rsqf(q * (1.f / HD) + GN_EPS);
#pragma unroll
            for (int nt = 0; nt < 4; ++nt) { const int v = 16 * nt + l15; Out[(16 * mt + 4 * g + r) * 68 + v] = (acc[nt][r] - mean) * rstd * W.lnx_w[h * HD + v] + W.lnx_b[h * HD + v]; } }
        LDS_BARRIER();
        { const int t = tl >> 2, cq = tl & 3, v0 = 16 * cq, hv0 = h * HD + v0; const size_t row = row0 + t; const bool has_prev = (t0 + t) > 0; const float bsc = Sc.Sbsc[row * NH + h];
#pragma unroll
          for (int half = 0; half < 2; ++half) { float cv[8], pv[8], gv[8], o[8]; const int col = 2048 + hv0 + 8 * half;
              unpack8(*(const u32x4*)(P + row * INW + col), cv); if (has_prev) unpack8(*(const u32x4*)(P + (row - 1) * INW + col), pv); else { for (int j = 0; j < 8; ++j) pv[j] = 0.f; }
              unpack8(*(const u32x4*)(Sc.Sg + row * RWW + hv0 + 8 * half), gv);
              const f32x4 m0 = *(const f32x4*)(W.mu + col - 1024), m1 = *(const f32x4*)(W.mu + col - 1024 + 4);
#pragma unroll
              for (int j = 0; j < 8; ++j) { const float vs = cv[j] + (pv[j] - cv[j]) * (j < 4 ? m0[j] : m1[j - 4]); o[j] = (Out[t * 68 + v0 + 8 * half + j] + bsc * vs) * gv[j]; }
              *(u32x4*)(Y + row * D + GMW + hv0 + 8 * half) = pack8(o); } }
        LDS_BARRIER();
    }
}


__device__ __forceinline__ void rwkv_m3_units(Frame& F, int u0, int ustep, int nunits, const bf16* P, bf16* Y, const RwkvW& W, const RwkvS& Sc) {
    if (u0 >= nunits) return;
    const int w = F.wave, lane = F.lane, l15 = lane & 15, g = lane >> 4, hw = w >> 2, mt = w & 3, tl = F.tid & 255;
    LAS bf16* Qt = (LAS bf16*)(F.lds + hw * M3_SLOT); LAS bf16* St = Qt + 64 * 72; LAS float* Out = (LAS float*)(F.lds + hw * M3_SLOT + 2 * 9216);
    const int nu = (nunits - u0 + ustep - 1) / ustep, niter = nu * 4;
    LAS float* TB = (LAS float*)(F.lds + 73728);
    TB[F.tid] = W.lnx_w[F.tid]; TB[512 + F.tid] = W.lnx_b[F.tid]; TB[1024 + F.tid] = W.mu[1024 + F.tid];
    u32x4 qf[2], sf[2]; s16x4 y0f[4];
#define M3_PREF(itn) do { const int un_ = u0 + ((itn) >> 2) * ustep, hn_ = 2 * ((itn) & 3) + hw; const size_t uhn_ = ((size_t)un_ * NH + hn_) * 4096; \
        _Pragma("unroll") for (int r = 0; r < 2; ++r) { qf[r] = *(const u32x4*)(Sc.SQ + uhn_ + 8 * (tl + 256 * r)); sf[r] = *(const u32x4*)(Sc.SS + uhn_ + 8 * (tl + 256 * r)); } \
        _Pragma("unroll") for (int nt = 0; nt < 4; ++nt) y0f[nt] = *(const s16x4*)(Sc.SY0 + uhn_ + (size_t)(16 * nt + l15) * 64 + 16 * mt + 4 * g); } while (0)
    M3_PREF(0);
    for (int it = 0; it < niter; ++it) {
        const int unit = u0 + (it >> 2) * ustep, h = 2 * (it & 3) + hw; const int b = unit >> 6, c = unit & 63, t0 = c * 64; const size_t row0 = (size_t)b * SEQ + t0;
#pragma unroll
        for (int r = 0; r < 2; ++r) { const int off = 8 * (tl + 256 * r), rr = off >> 6, cc = off & 63; *(LAS u32x4*)(Qt + rr * 72 + cc) = qf[r]; *(LAS u32x4*)(St + rr * 72 + cc) = sf[r]; }
        f32x4 acc[4];
#pragma unroll
        for (int nt = 0; nt < 4; ++nt) acc[nt] = unpack4(y0f[nt]);
        const int t = tl >> 2, cq = tl & 3, v0 = 16 * cq, hv0 = h * HD + v0; const size_t row = row0 + t; const bool has_prev = (t0 + t) > 0;
        u32x4 cvr[2], pvr[2], gvr[2]; const float bsc = Sc.Sbsc[row * NH + h];
#pragma unroll
        for (int half = 0; half < 2; ++half) { const int col = 2048 + hv0 + 8 * half; cvr[half] = *(const u32x4*)(P + row * INW + col);
            pvr[half] = *(const u32x4*)(P + (has_prev ? row - 1 : row) * INW + col); gvr[half] = *(const u32x4*)(Sc.Sg + row * RWW + hv0 + 8 * half); }
        { const int itn = it + 1 < niter ? it + 1 : it; M3_PREF(itn); }
        LDS_BARRIER();
#pragma unroll
        for (int ks = 0; ks < 2; ++ks) { const bf16x8 a = lds_tr8(Qt, 72, 32 * ks, 16 * mt, lane);
#pragma unroll
            for (int nt = 0; nt < 4; ++nt) acc[nt] = MFMA32(a, lds_tr8(St, 72, 32 * ks, 16 * nt, lane), acc[nt]); }
#pragma unroll
        for (int r = 0; r < 4; ++r) { float s2 = (acc[0][r] + acc[1][r]) + (acc[2][r] + acc[3][r]);
            s2 += __shfl_xor(s2, 1); s2 += __shfl_xor(s2, 2); s2 += __shfl_xor(s2, 4); s2 += __shfl_xor(s2, 8); const float mean = s2 * (1.f / HD); float q = 0.f;
#pragma unroll
            for (int nt = 0; nt < 4; ++nt) { const float d = acc[nt][r] - mean; q += d * d; }
            q += __shfl_xor(q, 1); q += __shfl_xor(q, 2); q += __shfl_xor(q, 4); q += __shfl_xor(q, 8); const float rstd = __builtin_amdgcn_rsqf(q * (1.f / HD) + GN_EPS);
#pragma unroll
            for (int nt = 0; nt < 4; ++nt) { const int v = 16 * nt + l15; Out[(16 * mt + 4 * g + r) * 68 + v] = (acc[nt][r] - mean) * rstd * TB[h * HD + v] + TB[512 + h * HD + v]; } }
        LDS_BARRIER();
#pragma unroll
        for (int half = 0; half < 2; ++half) { float cv[8], pv[8], gv[8], o[8];
            unpack8(cvr[half], cv); unpack8(pvr[half], pv); unpack8(gvr[half], gv);
            const f32x4 m0 = *(const LAS f32x4*)(TB + 1024 + hv0 + 8 * half), m1 = *(const LAS f32x4*)(TB + 1024 + hv0 + 8 * half + 4);
#pragma unroll
            for (int j = 0; j < 8; ++j) { const float pvj = has_prev ? pv[j] : 0.f; const float vs = cv[j] + (pvj - cv[j]) * (j < 4 ? m0[j] : m1[j - 4]); o[j] = (Out[t * 68 + v0 + 8 * half + j] + bsc * vs) * gv[j]; }
            *(u32x4*)(Y + row * D + GMW + hv0 + 8 * half) = pack8(o); }
    }
#undef M3_PREF
    LDS_BARRIER();
}

__device__ __forceinline__ void rwkv_apply_naive(Frame& F, int unit, const bf16* P, bf16* Y, const RwkvW& W, const RwkvS& Sc) {
    const int b = unit >> 3, h = unit & 7;
    LAS float* S = (LAS float*)F.lds; LAS float* Gs = S + 64 * 65; LAS float* Hs = Gs + 64 * 65; LAS float* Qs = Hs + 64 * 65; LAS float* Ys = Qs + 64 * 65; LAS float* Sn = Ys + 64 * 65;
    for (int i = F.tid; i < 64 * 65; i += 512) S[i] = 0.f;
    __syncthreads();
    for (int c = 0; c < 64; ++c) { const size_t uh = ((size_t)(b * 64 + c) * NH + h) * 4096; const size_t row0 = (size_t)b * SEQ + c * 64;
        for (int i = F.tid; i < 4096; i += 512) { const int r = i >> 6, cc = i & 63;
            Gs[cc * 65 + r] = bf2f(Sc.SG[uh + i]);
            Hs[cc * 65 + r] = bf2f(Sc.SH[uh + i]);
            Qs[cc * 65 + r] = bf2f(Sc.SQ[uh + i]);
            Ys[cc * 65 + r] = bf2f(Sc.SY0[uh + i]); }
        __syncthreads();
        for (int i = F.tid; i < 4096; i += 512) { const int t = i >> 6, v = i & 63; float a = Ys[t * 65 + v];
            if (DBG_VAR != 1) for (int k = 0; k < 64; ++k) a += Qs[t * 65 + k] * S[v * 65 + k];
            if (DBG_VAR == 2) a = 0.f;
            Ys[t * 65 + v] = a; }
        for (int i = F.tid; i < 4096; i += 512) { const int v = i >> 6, k2 = i & 63; float a = Hs[v * 65 + k2];
            if (DBG_VAR == 6) a += S[v * 65 + k2] * Gs[k2 * 65 + k2]; else if (DBG_VAR != 3) for (int k = 0; k < 64; ++k) a += S[v * 65 + k] * Gs[k * 65 + k2];
            if (DBG_VAR == 7) a = Hs[v * 65 + k2] + 0.5f * (a - Hs[v * 65 + k2]);
            Sn[v * 65 + k2] = a; }
        __syncthreads();
        for (int i = F.tid; i < 4096; i += 512) { const int v = i >> 6, k2 = i & 63; S[v * 65 + k2] = Sn[v * 65 + k2]; }
        { const int t = F.tid >> 3, cg = F.tid & 7, v0 = 8 * cg, hv0 = h * HD + v0; const size_t row = row0 + t; const bool has_prev = (c * 64 + t) > 0; const float bsc = Sc.Sbsc[row * NH + h];
          float yv[8]; float sm = 0.f;
          for (int j = 0; j < 8; ++j) { yv[j] = Ys[t * 65 + v0 + j]; sm += yv[j]; }
          sm += __shfl_xor(sm, 1); sm += __shfl_xor(sm, 2); sm += __shfl_xor(sm, 4); const float mean = sm * (1.f / HD); float q = 0.f;
          for (int j = 0; j < 8; ++j) { yv[j] -= mean; q += yv[j] * yv[j]; }
          q += __shfl_xor(q, 1); q += __shfl_xor(q, 2); q += __shfl_xor(q, 4); const float rstd = __builtin_amdgcn_rsqf(q * (1.f / HD) + GN_EPS);
          float cv[8], pv[8], gv[8], o[8]; const int col = 2048 + hv0;
          unpack8(*(const u32x4*)(P + row * INW + col), cv); if (has_prev) unpack8(*(const u32x4*)(P + (row - 1) * INW + col), pv); else { for (int j = 0; j < 8; ++j) pv[j] = 0.f; }
          unpack8(*(const u32x4*)(Sc.Sg + row * RWW + hv0), gv);
          for (int j = 0; j < 8; ++j) { const float vs = cv[j] + (pv[j] - cv[j]) * W.mu[col - 1024 + j]; o[j] = (yv[j] * rstd * W.lnx_w[hv0 + j] + W.lnx_b[hv0 + j] + bsc * vs) * gv[j]; }
          *(u32x4*)(Y + row * D + GMW + hv0) = pack8(o); }
        __syncthreads();
    }
}

enum Phase { PH_PRO = 0, PH_G1_0, PH_M1_0, PH_M2_0, PH_M3_0, PH_G2_0, PH_G3_0, PH_G4_0, PH_G1_1, PH_M1_1, PH_M2_1, PH_M3_1, PH_G2_1, PH_CV, PH_R2, PH_GU_A, PH_DN_A, PH_GU_B, PH_DN_B, PH_FIN, PH_COUNT };

__global__ void __launch_bounds__(512, 2) fwd(Args args) {
    extern __shared__ __attribute__((aligned(16))) unsigned char lds_raw[];
    Frame F;
    F.lds = (LAS unsigned char*)lds_raw;
    F.tid = threadIdx.x; F.lane = F.tid & 63; F.wave = __builtin_amdgcn_readfirstlane(F.tid >> 6);
    F.G = gridDim.x; F.gw = blockIdx.x * 8 + F.wave; F.NGW = F.G * 8;
    unsigned char* ws = args.ws;
    gu32* ctl = (gu32*)(ws + WS_CTL);
    volatile LAS unsigned* MISC = (volatile LAS unsigned*)(F.lds + MISC_OFF);
    if (F.tid < 32) ((LAS unsigned*)(F.lds + MISC_OFF))[F.tid] = 0u;
    __syncthreads();
    XcdBarrier bar; bar.bar = (unsigned*)(ctl + CW_BAR); bar.x = 0; bar.st = nullptr;
#if !MK_PER_PHASE
    bar = xcd_barrier_post((unsigned*)(ctl + CW_BAR), MISC + 8);
#endif
    const int lo = args.ph_lo, hi = args.ph_hi;
#define IN(k) (lo <= (k) && (k) < hi)
#define STAGGER_WAIT() do { if (STAGGER_TICKS > 0 && (blockIdx.x & 8)) { const unsigned long long t0_ = __builtin_amdgcn_s_memrealtime(); while (__builtin_amdgcn_s_memrealtime() - t0_ < (unsigned long long)STAGGER_TICKS) __builtin_amdgcn_s_sleep(32); } } while (0)
#define SEAM(k) do { if (IN(k) && IN((k) + 1)) xcd_barrier(bar); } while (0)

    const float* x_in = args.in[I_X];
    bf16* WinT = (bf16*)(ws + WS_WIN); bf16* WoutT = (bf16*)(ws + WS_WOUT); bf16* WguT = (bf16*)(ws + WS_WGU); bf16* WdT = (bf16*)(ws + WS_WD);
    bf16* XB = (bf16*)(ws + WS_XB); bf16* PB = (bf16*)(ws + WS_P); bf16* YB = (bf16*)(ws + WS_Y); bf16* HB = (bf16*)(ws + WS_P);
    bf16* MWgu = (bf16*)(ws + WS_MOEW_GU); bf16* MWd = (bf16*)(ws + (MOE8_GU ? WS_MOEW8_D : WS_MOEW_D)); bf16* MH = (bf16*)(ws + WS_MOEH);
    unsigned char* MWgu8 = ws + WS_MOEW8_GU; unsigned char* MWd8 = ws + WS_MOEW8_D; unsigned char* MH8 = ws + WS_MOEH; unsigned char* MH8b = ws + WS_MOEH + 119 * MiB; unsigned char* XB8 = ws + WS_XB8;
    float* ssq0 = (float*)(ctl + CW_SSQ); float* ssq1 = (float*)(ws + WS_SSQP); float* ssq2 = ssq1 + (size_t)NTOK * 16;
    bf16* WupT = (bf16*)(ws + WS_SMALLW + SW_WUP); bf16* AupT = (bf16*)(ws + WS_SMALLW + SW_AUP); bf16* GupT = (bf16*)(ws + WS_SMALLW + SW_GUP); bf16* WsB = (bf16*)(ws + WS_SMALLW + SW_WS);
    RwkvS RS{(bf16*)(ws + WS_SCR), (bf16*)(ws + WS_SCR + 32 * MiB), (bf16*)(ws + WS_SCR + 64 * MiB), (bf16*)(ws + WS_SCR + 96 * MiB), (bf16*)(ws + WS_SCR + 128 * MiB), (bf16*)((unsigned char*)args.out), (float*)((unsigned char*)args.out + 32 * MiB)};
    unsigned char* misc = ws + WS_MISC;
    int* tok_e = (int*)(misc + MS_TOKE); float* tok_g = (float*)(misc + MS_TOKG); float* rs_moe = (float*)(misc + MS_RS); int* bcnt = (int*)(misc + MS_BCNT);
    int* row_tok = (int*)(misc + MS_ROWTOK); float* row_gate = (float*)(misc + MS_ROWGATE); int* panel = (int*)(misc + MS_PANEL); float* row_rs = (float*)(misc + MS_ROWRS);

#define DEFERRED_CONVERT(FR) do { int itb_ = 0; \
        convert_matrix(FR, args.in[I_W_IN] + (size_t)D * INW, D, INW, WinT + (size_t)INW * D, 0, args.in[I_NORM_MIX] + D, 0, itb_); \
        convert_matrix(FR, args.in[I_W_OUT], D, D, WoutT, 0, nullptr, 0, itb_); convert_matrix(FR, args.in[I_W_OUT] + (size_t)D * D, D, D, WoutT + (size_t)D * D, 0, nullptr, 0, itb_); \
        convert_matrix(FR, args.in[I_FFN_WG], D, FF, WguT, 1, args.in[I_NORM_FFN], 0, itb_); convert_matrix(FR, args.in[I_FFN_WU], D, FF, WguT, 2, args.in[I_NORM_FFN], 0, itb_); \
        convert_matrix(FR, args.in[I_FFN_WD], FF, D, WdT, 0, nullptr, 0, itb_); } while (0)
    if (IN(PH_PRO)) for (int rep = 0; rep < (PROBE_DUP == 4 ? 2 : 1); ++rep) {
        int itb = 0;
        convert_matrix(F, args.in[I_W_IN], D, INW, WinT, 0, args.in[I_NORM_MIX], 0, itb);
        if (!(DEFER_CONVERT && F.G == 256)) { DEFERRED_CONVERT(F); }
        { const size_t gt = (size_t)blockIdx.x * 512 + F.tid, gn = (size_t)F.G * 512;
          for (size_t i = gt; i < (size_t)2 * RWW * 64; i += gn) { const int l = (int)(i / (RWW * 64)), r = (int)(i % (RWW * 64)), ch = r / 64, j = r % 64;
              WupT[i] = (bf16)f2bf(args.in[I_RW_W_UP][(size_t)l * 64 * RWW + (size_t)j * RWW + ch]); AupT[i] = (bf16)f2bf(args.in[I_RW_A_UP][(size_t)l * 64 * RWW + (size_t)j * RWW + ch]); }
          for (size_t i = gt; i < (size_t)2 * RWW * 128; i += gn) { const int l = (int)(i / (RWW * 128)), r = (int)(i % (RWW * 128)), ch = r / 128, j = r % 128;
              GupT[i] = (bf16)f2bf(args.in[I_RW_G_UP][(size_t)l * 128 * RWW + (size_t)j * RWW + ch]); }
          for (size_t i = gt; i < (size_t)2 * NH * GCH * GCH; i += gn) { const int t = (int)((i / GCH) % GCH), s2 = (int)(i % GCH); WsB[i] = (bf16)(s2 <= t ? f2bf(args.in[I_GM_WS][i]) : 0u); } }
        for (int m = F.gw; m < NTOK; m += F.NGW) {
            const GAS f32x4* xr = (const GAS f32x4*)(x_in + (size_t)m * D) + F.lane; GAS u32x2* o8 = (GAS u32x2*)(XB + (size_t)m * D) + F.lane; float s = 0.f;
#pragma unroll
            for (int j = 0; j < 4; ++j) { const f32x4 v = xr[64 * j]; s += (v.x * v.x + v.y * v.y) + (v.z * v.z + v.w * v.w); u32x2 w; w.x = pk2(v.x, v.y); w.y = pk2(v.z, v.w); o8[64 * j] = w; }
            s = wave_sum(s); if (F.lane == 0) ssq0[m] = s;
        }
    }
    SEAM(PH_PRO);
    if (PROBE_DUP == 6) { for (int q_ = 0; q_ < 10; ++q_) xcd_barrier(bar); }

#define LAYER_MIXER(L, PH1, PHA, PHB, PHC, PH2, XBASE, BASE32, SSQ_IN, NP_IN, SSQ_OUT, HAS_OUT) \
    if (IN(PH1)) { pg8::DenseSched S; S.init(XB, WinT + (size_t)(L) * INW * D, NTOK, INW, 2 * D, F.G, (int)blockIdx.x); \
        pg8::EpiScaleBf16<NP_IN> E{PB, INW, SSQ_IN, (LAS float*)(F.lds + RING_BYTES + 4096)}; pg8::gemm_phase(F.lds, 2 * D, S, E); } \
    if (DEFER_CONVERT && (L) == 0 && IN(PH1) && F.G == 256 && (int)blockIdx.x >= 128) { __syncthreads(); Frame F2 = F; F2.gw = ((int)blockIdx.x - 128) * 8 + F.wave; F2.NGW = 128 * 8; DEFERRED_CONVERT(F2); __syncthreads(); } \
    if (PROBE_DUP == 1 && (L) == 0 && IN(PH1)) { pg8::DenseSched S; S.init(XB, WinT + (size_t)(L) * INW * D, NTOK, INW, 2 * D, F.G, (int)blockIdx.x); \
        pg8::EpiScaleBf16<NP_IN> E{PB, INW, SSQ_IN, (LAS float*)(F.lds + RING_BYTES + 4096)}; pg8::gemm_phase(F.lds, 2 * D, S, E); } \
    SEAM(PH1); \
    { RwkvW RW{args.in[I_SHIFT_MU] + (L) * 1792, args.in[I_RW_W0] + (L) * RWW, args.in[I_RW_A0] + (L) * RWW, args.in[I_RW_K_K] + (L) * RWW, args.in[I_RW_K_A] + (L) * RWW, args.in[I_RW_R_K] + (L) * RWW, \
                 args.in[I_RW_LNX_W] + (L) * RWW, args.in[I_RW_LNX_B] + (L) * RWW, WupT + (size_t)(L) * RWW * 64, AupT + (size_t)(L) * RWW * 64, GupT + (size_t)(L) * RWW * 128}; \
      if (IN(PHA)) { if (MIX_MODE != 1) for (int rep = 0; rep < REP_M1; ++rep) { rwkv_m1_consts(F, RW); for (int u = blockIdx.x; u < NB * 64; u += F.G) rwkv_m1v2_unit(F, u, PB, RW, RS); } } \
      SEAM(PHA); \
      if (IN(PHB)) for (int rep = 0; rep < REP_M2; ++rep) { const int nscan = (F.G >= 128 && MIX_MODE != 1) ? 64 : 0; \
          if (MIX_MODE != 1 && MIX_MODE != 3) { if (nscan) { if ((int)blockIdx.x < 64) { rwkv_m2_unit(F, blockIdx.x, RS); hnd_arrive((unsigned*)(ctl + CW_HND + 64 * (L))); } } else { for (int u = blockIdx.x; u < 64; u += F.G) { rwkv_m2_unit(F, u, RS); hnd_arrive((unsigned*)(ctl + CW_HND + 64 * (L))); } } } \
          if (MIX_MODE == 2) gmlp_naive(F, PB, YB, args.in[I_GM_LN_W] + (L) * GMW, args.in[I_GM_LN_B] + (L) * GMW, args.in[I_GM_WS] + (size_t)(L) * NH * GCH * GCH, args.in[I_GM_BS] + (L) * NH * GCH); \
          else { const int NU = NB * (SEQ / GCH) * NH; const int nsplit = (nscan && F.G == 256) ? 1920 : NU;         \
              if ((int)blockIdx.x >= nscan) gmlp_units(F, blockIdx.x - nscan, F.G - nscan, nsplit, PB, YB, args.in[I_GM_LN_W] + (L) * GMW, args.in[I_GM_LN_B] + (L) * GMW, WsB + (size_t)(L) * NH * GCH * GCH, args.in[I_GM_BS] + (L) * NH * GCH); \
              else if (nsplit < NU) gmlp_units(F, nsplit + blockIdx.x, nscan, NU, PB, YB, args.in[I_GM_LN_W] + (L) * GMW, args.in[I_GM_LN_B] + (L) * GMW, WsB + (size_t)(L) * NH * GCH * GCH, args.in[I_GM_BS] + (L) * NH * GCH); } } \
      if (MIX_MODE == 0 && REP_M2 == 1) { if (IN(PHB) && IN(PHC)) hnd_wait((unsigned*)(ctl + CW_HND + 64 * (L)), 64u, bar.bar); } else SEAM(PHB);      \
      if (IN(PHC)) { if (MIX_MODE == 3) { for (int u = blockIdx.x; u < 64; u += F.G) rwkv_apply_naive(F, u, PB, YB, RW, RS); } \
          else if (MIX_MODE != 1) { for (int rep = 0; rep < REP_M3; ++rep) rwkv_m3_units(F, blockIdx.x, F.G, NB * 64, PB, YB, RW, RS); } \
          else rwkv_naive(F, PB, YB, args.in[I_SHIFT_MU] + (L) * 1792, args.in[I_RW_W_UP] + (L) * 64 * RWW, args.in[I_RW_W0] + (L) * RWW, args.in[I_RW_A_UP] + (L) * 64 * RWW, args.in[I_RW_A0] + (L) * RWW, \
                   args.in[I_RW_G_UP] + (L) * 128 * RWW, args.in[I_RW_K_K] + (L) * RWW, args.in[I_RW_K_A] + (L) * RWW, args.in[I_RW_R_K] + (L) * RWW, args.in[I_RW_LNX_W] + (L) * RWW, args.in[I_RW_LNX_B] + (L) * RWW); } \
      SEAM(PHC); } \
    if (IN(PH2)) { STAGGER_WAIT(); pg8::DenseSched S; S.init(YB, WoutT + (size_t)(L) * D * D, NTOK, D, 2 * D, F.G, (int)blockIdx.x); \
        pg8::EpiResid<HAS_OUT, BASE32> E{XBASE, XB, SSQ_OUT}; pg8::gemm_phase(F.lds, 2 * D, S, E); } \
    if (PROBE_DUP == 2 && (L) == 0 && IN(PH2)) { pg8::DenseSched S; S.init(YB, WoutT + (size_t)(L) * D * D, NTOK, D, 2 * D, F.G, (int)blockIdx.x); \
        pg8::EpiResid<HAS_OUT, BASE32> E{XBASE, XB, SSQ_OUT}; pg8::gemm_phase(F.lds, 2 * D, S, E); } \
    SEAM(PH2);

    LAYER_MIXER(0, PH_G1_0, PH_M1_0, PH_M2_0, PH_M3_0, PH_G2_0, nullptr, false, ssq0, 1, ssq1, true)

    if (IN(PH_G3_0)) { pg8::DenseSched S; S.init(XB, WguT, NTOK, 2 * FF, 2 * D, F.G, (int)blockIdx.x);
        pg8::EpiSwiglu<16> E{HB, FF, ssq1, (LAS float*)(F.lds + RING_BYTES + 4096)}; pg8::gemm_phase(F.lds, 2 * D, S, E); }
#if REP_G3 == 2
    if (IN(PH_G3_0)) { pg8::DenseSched S; S.init(XB, WguT, NTOK, 2 * FF, 2 * D, F.G, (int)blockIdx.x);
        pg8::EpiSwiglu<16> E{HB, FF, ssq1, (LAS float*)(F.lds + RING_BYTES + 4096)}; pg8::gemm_phase(F.lds, 2 * D, S, E); }
#endif
    SEAM(PH_G3_0);
    if (IN(PH_G4_0)) { STAGGER_WAIT(); pg8::DenseSched S; S.init(HB, WdT, NTOK, D, 2 * FF, F.G, (int)blockIdx.x);
        pg8::EpiResid<true, false> E{nullptr, XB, ssq2}; pg8::gemm_phase(F.lds, 2 * FF, S, E); }
    SEAM(PH_G4_0);

    LAYER_MIXER(1, PH_G1_1, PH_M1_1, PH_M2_1, PH_M3_1, PH_G2_1, nullptr, false, ssq2, 16, nullptr, false)

    if (IN(PH_CV)) for (int rep = 0; rep < REP_CV; ++rep) {
        const float* gain = args.in[I_NORM_FFN] + D;
        LAS float* RW = (LAS float*)F.lds; LAS int* cnt = (LAS int*)(F.lds + 32768);
        for (int i = F.tid; i < D * NE; i += 512) { const int k = i >> 3, e = i & 7, jj = k >> 9, ln = (k & 511) >> 3, q = k & 7; RW[(((jj * 8 + q) * 64 + ln) << 3) + e] = args.in[I_MOE_ROUTER][i] * gain[k]; }
        for (size_t i = (size_t)blockIdx.x * 512 + F.tid; i < (size_t)2 * MAXPAN * 256; i += (size_t)F.G * 512) { row_tok[i] = -1; row_gate[i] = 0.f; row_rs[i] = 0.f; }
        __syncthreads();
        for (int vb = blockIdx.x; vb < 256; vb += F.G) {
            if (F.tid < 16) cnt[F.tid] = 0;
            __syncthreads();
            u32x4 xv4[2];
            { const GAS u32x4* xr0 = (const GAS u32x4*)(XB + (size_t)(vb * 128 + F.wave * 16) * D) + F.lane; xv4[0] = xr0[0]; xv4[1] = xr0[64]; }
            for (int i = 0; i < 16; ++i) { const int m = vb * 128 + F.wave * 16 + i;
                float s = 0.f; float lg[8]; u32x4 cur4[2]; cur4[0] = xv4[0]; cur4[1] = xv4[1];
                if (i + 1 < 16) { const GAS u32x4* xr1 = (const GAS u32x4*)(XB + (size_t)(m + 1) * D) + F.lane; xv4[0] = xr1[0]; xv4[1] = xr1[64]; }
#pragma unroll
                for (int e = 0; e < 8; ++e) lg[e] = 0.f;
#pragma unroll
                for (int jj = 0; jj < 2; ++jj) { float v[8]; unpack8(cur4[jj], v);
                    if (MOE8_GU && !MOE8_DN) { u32x2 w8; w8.x = pk4_fp8(v[0], v[1], v[2], v[3]); w8.y = pk4_fp8(v[4], v[5], v[6], v[7]); *(u32x2*)(XB8 + (size_t)m * D + 512 * jj + 8 * F.lane) = w8; }
#pragma unroll
                    for (int q = 0; q < 8; ++q) { const float xv = v[q]; s += xv * xv; const LAS f32x4* rw = (const LAS f32x4*)(RW + (((jj * 8 + q) * 64 + F.lane) << 3)); const f32x4 r0 = rw[0], r1 = rw[1];
                        lg[0] += xv * r0.x; lg[1] += xv * r0.y; lg[2] += xv * r0.z; lg[3] += xv * r0.w; lg[4] += xv * r1.x; lg[5] += xv * r1.y; lg[6] += xv * r1.z; lg[7] += xv * r1.w; } }
                s = wave_sum(s);
#pragma unroll
                for (int e = 0; e < 8; ++e) lg[e] = wave_sum(lg[e]);
                const float rs = 1.0f / sqrtf(s * (1.0f / D) + RMS_EPS);
                if (MOE8_GU && MOE8_DN) {
#pragma unroll
                    for (int jj = 0; jj < 2; ++jj) { float v[8]; unpack8(cur4[jj], v); u32x2 w8; w8.x = pk4_fp8(v[0] * rs, v[1] * rs, v[2] * rs, v[3] * rs); w8.y = pk4_fp8(v[4] * rs, v[5] * rs, v[6] * rs, v[7] * rs);
                        *(u32x2*)(XB8 + (size_t)m * D + 512 * jj + 8 * F.lane) = w8; } }
                if (F.lane == 0) {
                    int i1 = 0; float v1 = lg[0];
#pragma unroll
                    for (int e = 1; e < 8; ++e) if (lg[e] > v1) { v1 = lg[e]; i1 = e; }
                    int i2 = -1; float v2 = -3.0e38f;
#pragma unroll
                    for (int e = 0; e < 8; ++e) if (e != i1 && lg[e] > v2) { v2 = lg[e]; i2 = e; }
                    if (i2 < 0) { i2 = (i1 + 1) & 7; v2 = v1; }
                    const float g1 = 1.0f / (1.0f + __expf((v2 - v1) * rs)), g2 = 1.0f - g1;
                    tok_e[2 * m] = i1; tok_e[2 * m + 1] = i2; tok_g[2 * m] = g1; tok_g[2 * m + 1] = g2; rs_moe[m] = rs;
                    __hip_atomic_fetch_add(&cnt[i1], 1, __ATOMIC_RELAXED, __HIP_MEMORY_SCOPE_WORKGROUP); __hip_atomic_fetch_add(&cnt[8 + i2], 1, __ATOMIC_RELAXED, __HIP_MEMORY_SCOPE_WORKGROUP);
                } }
            __syncthreads();
            if (F.tid < 16) bcnt[vb * 16 + F.tid] = cnt[F.tid];
            __syncthreads();
        }
        if (rep == 0) hnd_arrive((unsigned*)(ctl + CW_HND + 128));
        int itb = 0;
        for (int e = 0; e < NE; ++e) {
            if (MOE8_GU) { convert_matrix_fp8(F, args.in[I_MOE_WG] + (size_t)e * D * FFE, D, FFE, MWgu8 + (size_t)e * 2 * FFE * D, 1, gain, MOE8_WSCALE_GU * (MOE8_DN ? -1.44269504f : 1.0f), itb);
                           convert_matrix_fp8(F, args.in[I_MOE_WU] + (size_t)e * D * FFE, D, FFE, MWgu8 + (size_t)e * 2 * FFE * D, 2, gain, MOE8_WSCALE_GU, itb); }
            else { convert_matrix(F, args.in[I_MOE_WG] + (size_t)e * D * FFE, D, FFE, MWgu + (size_t)e * 2 * FFE * D, 1, gain, 0, itb);
                   convert_matrix(F, args.in[I_MOE_WU] + (size_t)e * D * FFE, D, FFE, MWgu + (size_t)e * 2 * FFE * D, 2, gain, 0, itb); }
            if (MOE8_DN) convert_matrix_fp8(F, args.in[I_MOE_WD] + (size_t)e * FFE * D, FFE, D, MWd8 + (size_t)e * D * FFE, 0, nullptr, MOE8_WSCALE_DN, itb);
            else convert_matrix(F, args.in[I_MOE_WD] + (size_t)e * FFE * D, FFE, D, MWd + (size_t)e * D * FFE, 0, nullptr, 0, itb);
        }
    }
    if (IN(PH_CV) && IN(PH_R2)) hnd_wait((unsigned*)(ctl + CW_HND + 128), (unsigned)F.G, bar.bar);

    if (IN(PH_R2)) {
        LAS int* tot = (LAS int*)F.lds;
        LAS int* bc = tot + 64;
        for (int vb = blockIdx.x; vb < 256; vb += F.G) {
            for (int i = F.tid; i < 256 * 16; i += 512) bc[i] = bcnt[i];
            __syncthreads();
            if (F.tid < 16) { int t = 0, mine = 0; for (int b2 = 0; b2 < 256; ++b2) { const int c = bc[b2 * 16 + F.tid]; if (b2 < vb) mine += c; t += c; } tot[F.tid] = t; tot[32 + F.tid] = mine; }
            __syncthreads();
            if (F.tid < 2) { int ps = 0; for (int e = 0; e < 8; ++e) { tot[16 + F.tid * 8 + e] = ps; ps += (tot[F.tid * 8 + e] + 255) / 256; }
                if (vb == 0) { panel[F.tid * 160] = ps; for (int e = 0; e < 8; ++e) { const int np = (tot[F.tid * 8 + e] + 255) / 256; for (int q = 0; q < np; ++q) panel[F.tid * 160 + 16 + tot[16 + F.tid * 8 + e] + q] = e; } } }
            int e01[2] = {0, 0}; float g01[2] = {0.f, 0.f}; float rsv = 0.f; const int m = vb * 128 + F.tid;
            if (F.tid < 128) { e01[0] = tok_e[2 * m]; e01[1] = tok_e[2 * m + 1]; g01[0] = tok_g[2 * m]; g01[1] = tok_g[2 * m + 1]; rsv = rs_moe[m]; }
            int rank[2] = {0, 0};
            if (F.wave < 2) {
#pragma unroll
                for (int set = 0; set < 2; ++set)
#pragma unroll
                    for (int e = 0; e < 8; ++e) { const unsigned long long mk = __ballot(e01[set] == e); if (e01[set] == e) rank[set] = __popcll(mk & ((1ull << F.lane) - 1ull));
                        if (F.wave == 0 && F.lane == 0) tot[48 + set * 8 + e] = __popcll(mk); } }
            __syncthreads();
            if (F.tid < 128) {
#pragma unroll
                for (int set = 0; set < 2; ++set) { const int key = set * 8 + e01[set]; const int slot = tot[16 + key] * 256 + tot[32 + key] + rank[set] + (F.wave == 1 ? tot[48 + key] : 0);
                    row_tok[set * MAXPAN * 256 + slot] = m; row_gate[set * MAXPAN * 256 + slot] = g01[set]; row_rs[set * MAXPAN * 256 + slot] = rsv; } }
            __syncthreads();
        }
    }
    SEAM(PH_R2);

#define MOE_SET(SET, PHGU, PHDN) \
    if (IN(PHGU)) for (int rep = 0; rep < REP_GU; ++rep) { const int np = __builtin_amdgcn_readfirstlane(panel[(SET) * 160]); pg8::MoeSched<true> S; \
        if (MOE8_GU) { S.init(XB8, MWgu8, np, 2 * FFE, D, MOE_PEXP(SET) + 16, row_tok + (SET) * MAXPAN * 256, F.G, (int)blockIdx.x); \
            if (MOE8_DN) { pg8::EpiSwigluMoe8 E{MH8, FFE}; pg8::gemm_phase<pg8::EpiSwigluMoe8, pg8::MoeSched<true>, true>(F.lds, D, S, E); } \
            else { pg8::EpiSwigluMoe E{MH, FFE, rs_moe, row_tok + (SET) * MAXPAN * 256, 1.0f / MOE8_WSCALE_GU}; pg8::gemm_phase<pg8::EpiSwigluMoe, pg8::MoeSched<true>, true>(F.lds, D, S, E); } } \
        else { S.init(XB, MWgu, np, 2 * FFE, 2 * D, MOE_PEXP(SET) + 16, row_tok + (SET) * MAXPAN * 256, F.G, (int)blockIdx.x); \
            pg8::EpiSwigluMoe E{MH, FFE, rs_moe, row_tok + (SET) * MAXPAN * 256, 1.0f}; pg8::gemm_phase(F.lds, 2 * D, S, E); } } \
    SEAM(PHGU); \
    if (IN(PHDN)) { const int np = __builtin_amdgcn_readfirstlane(panel[(SET) * 160]); pg8::MoeSched<false> S; \
        if (MOE8_DN) { S.init(MH8, MWd8, np, D, FFE, MOE_PEXP(SET) + 16, row_tok + (SET) * MAXPAN * 256, F.G, (int)blockIdx.x); \
            pg8::EpiMoeDown E{XB, row_tok + (SET) * MAXPAN * 256, row_gate + (SET) * MAXPAN * 256, 1.0f / MOE8_WSCALE_DN, (LAS int*)(F.lds + RING_BYTES + 4096)}; pg8::gemm_phase<pg8::EpiMoeDown, pg8::MoeSched<false>, true>(F.lds, FFE, S, E); } \
        else { S.init(MH, MWd, np, D, 2 * FFE, MOE_PEXP(SET) + 16, row_tok + (SET) * MAXPAN * 256, F.G, (int)blockIdx.x); \
            pg8::EpiMoeDown E{XB, row_tok + (SET) * MAXPAN * 256, row_gate + (SET) * MAXPAN * 256, 1.0f, (LAS int*)(F.lds + RING_BYTES + 4096)}; pg8::gemm_phase(F.lds, 2 * FFE, S, E); } } \
    SEAM(PHDN);
#if MOE8_GU && MOE8_DN
#define MOE_PEXP(SET) ((const LAS int*)(F.lds + RING_BYTES + (SET) * 1024))
#define MOE_LOAD_PEXP() do { if (F.tid < 2 * 160) ((LAS int*)(F.lds + RING_BYTES))[(F.tid / 160) * 256 + (F.tid % 160)] = panel[F.tid]; __syncthreads(); } while (0)
#define MOE_GU8(SET, HBUF, P0, NP, SKX, SKR) do { pg8::MoeSched<true> S; \
        S.init(XB8, MWgu8, (NP), 2 * FFE, D, MOE_PEXP(SET) + 16, row_tok + (SET) * MAXPAN * 256, F.G, (int)blockIdx.x); S.p0 = (P0); S.T.sx = (SKX); S.T.sr = (SKR); \
        pg8::EpiSwigluMoe8 E{HBUF, FFE}; pg8::gemm_phase<pg8::EpiSwigluMoe8, pg8::MoeSched<true>, true>(F.lds, D, S, E); } while (0)
#define MOE_DN8(SET, HBUF, P0, NP) do { pg8::MoeSched<false> S; \
        S.init(HBUF, MWd8, (NP), D, FFE, MOE_PEXP(SET) + 16, row_tok + (SET) * MAXPAN * 256, F.G, (int)blockIdx.x); S.p0 = (P0); \
        pg8::EpiMoeDown E{XB, row_tok + (SET) * MAXPAN * 256, row_gate + (SET) * MAXPAN * 256, 1.0f / MOE8_WSCALE_DN, (LAS int*)(F.lds + RING_BYTES + 4096)}; pg8::gemm_phase<pg8::EpiMoeDown, pg8::MoeSched<false>, true>(F.lds, FFE, S, E); } while (0)
    const int npA = __builtin_amdgcn_readfirstlane(panel[0]), npB = __builtin_amdgcn_readfirstlane(panel[160]);
    const int nB2 = npB < 64 ? npB : 64, nB1 = npB - nB2;
    if (IN(PH_GU_A)) { MOE_LOAD_PEXP(); MOE_GU8(0, MH8, 0, npA, 0, 0); }
    if (PROBE_DUP == 3 && IN(PH_GU_A)) MOE_GU8(0, MH8, 0, npA, 0, 0);
    SEAM(PH_GU_A);
    if (IN(PH_DN_A)) { MOE_LOAD_PEXP(); MOE_DN8(0, MH8, 0, npA);
        const int sx = (npA * (D / 256)) % F.G;
        if (nB1 > 0) MOE_GU8(1, MH8b, 0, nB1, sx, sx ? 3 : 0); }
    SEAM(PH_DN_A);
    if (IN(PH_GU_B)) { MOE_LOAD_PEXP(); if (nB1 > 0) MOE_DN8(1, MH8b, 0, nB1);
        const int sx = (nB1 * (D / 256)) % F.G;
        MOE_GU8(1, MH8b, nB1, nB2, sx, sx ? 3 : 0); }
    SEAM(PH_GU_B);
    if (IN(PH_DN_B)) { MOE_LOAD_PEXP(); MOE_DN8(1, MH8b, nB1, nB2); }
    SEAM(PH_DN_B);
#else
    MOE_SET(0, PH_GU_A, PH_DN_A)
    MOE_SET(1, PH_GU_B, PH_DN_B)
#endif

    if (IN(PH_FIN)) for (int rep = 0; rep < (PROBE_DUP == 7 ? 2 : 1); ++rep) {
        const float* gf = args.in[I_NORM_FINAL];
        f32x4 gq[2][2];
#pragma unroll
        for (int jj = 0; jj < 2; ++jj) { gq[jj][0] = *((const f32x4*)(gf + 512 * jj + 8 * F.lane)); gq[jj][1] = *((const f32x4*)(gf + 512 * jj + 8 * F.lane + 4)); }
        for (int m = F.gw; m < NTOK; m += F.NGW) {
            const GAS u32x4* xr = (const GAS u32x4*)(XB + (size_t)m * D) + F.lane; float v[2][8]; float s = 0.f;
#pragma unroll
            for (int jj = 0; jj < 2; ++jj) { unpack8(xr[64 * jj], v[jj]);
#pragma unroll
                for (int q = 0; q < 8; ++q) s += v[jj][q] * v[jj][q]; }
            const float rs = 1.0f / sqrtf(wave_sum(s) * (1.0f / D) + RMS_EPS);
#pragma unroll
            for (int jj = 0; jj < 2; ++jj) { const f32x4 g0 = gq[jj][0], g1 = gq[jj][1];
                GAS f32x4* o = (GAS f32x4*)(args.out + (size_t)m * D + 512 * jj + 8 * F.lane);
                o[0] = (f32x4){v[jj][0] * rs * g0.x, v[jj][1] * rs * g0.y, v[jj][2] * rs * g0.z, v[jj][3] * rs * g0.w}; o[1] = (f32x4){v[jj][4] * rs * g1.x, v[jj][5] * rs * g1.y, v[jj][6] * rs * g1.z, v[jj][7] * rs * g1.w}; }
        }
    }
#undef IN
#undef SEAM
}

extern "C" void kernel_launch(void* const* d_in, const int* in_sizes, int n_in, void* d_out, int out_size, void* d_ws, size_t ws_size, hipStream_t stream) {
    static int grid = 0;
    if (grid == 0) {
        if (n_in != NIN || in_sizes[0] != NTOK * D || out_size != NTOK * D || ws_size < WS_END) {
            fprintf(stderr, "kernel_launch: unexpected shapes: n_in %d in0 %d out %d ws %zu (need %zu); nothing launched\n", n_in, n_in > 0 ? in_sizes[0] : -1, out_size, ws_size, (size_t)WS_END); grid = -1; return; }
        int dev = 0, cus = 0, per_cu = 0;
        if (hipGetDevice(&dev) != hipSuccess || hipDeviceGetAttribute(&cus, hipDeviceAttributeMultiprocessorCount, dev) != hipSuccess) { grid = -1; return; }
        if (hipFuncSetAttribute((const void*)fwd, hipFuncAttributeMaxDynamicSharedMemorySize, LDS_BYTES) != hipSuccess) { fprintf(stderr, "kernel_launch: hipFuncSetAttribute failed\n"); grid = -1; return; }
        if (hipOccupancyMaxActiveBlocksPerMultiprocessor(&per_cu, (const void*)fwd, 512, LDS_BYTES) != hipSuccess || per_cu < 1) { fprintf(stderr, "kernel_launch: occupancy query says %d\n", per_cu); }
        (void)hipGetLastError();
        grid = cus;
    }
    if (grid < 0) return;
    if (hipMemsetAsync((char*)d_ws + WS_CTL, 0, CTL_ZERO_BYTES, stream) != hipSuccess) return;
    Args a{};
    for (int i = 0; i < NIN; ++i) a.in[i] = (const float*)d_in[i];
    a.out = (float*)d_out; a.ws = (unsigned char*)d_ws;
#if MK_PER_PHASE
    for (int ph = 0; ph < PH_COUNT; ++ph) { a.ph_lo = ph; a.ph_hi = ph + 1; hipLaunchKernelGGL(fwd, dim3(grid), dim3(512), LDS_BYTES, stream, a); }
#else
    a.ph_lo = 0; a.ph_hi = PH_COUNT; hipLaunchKernelGGL(fwd, dim3(grid), dim3(512), LDS_BYTES, stream, a);
#endif
}
```
